# Optimizing an MI355X kernel written in HIP

```python
import math
import jax, jax.numpy as jnp
from jax import lax
import numpy as np

D_MODEL = 1024
BATCH = 2
SEQ = 8192
DEPTH = 2
DEC_BATCH = 128
DEC_SEQ = 8
PAST_LEN = 2048
PAGE_SIZE = 128

N_MIXERS = 4
GROUP_W = D_MODEL // N_MIXERS
A_HEADS = 4
A_HALF = GROUP_W // (2 * A_HEADS)
A_VDIM = 2 * A_HALF
ROPE_THETA = 10000.0
Q_BLOCK = 128
NEG_BIG = -1e30
B_GROUPS = 4
B_GDIM = GROUP_W // B_GROUPS
SG_CHUNK = 128
CONV_W = 31
D_HEADS = 4
D_KDIM = GROUP_W // D_HEADS
D_VDIM = GROUP_W // D_HEADS
HGRN_CHUNK = 16
F_FLOOR = 1e-30
ALPHA = (2.0 * DEPTH) ** 0.25
BETA = (8.0 * DEPTH) ** -0.25
EPS = 1e-5
IN_SIZES = (GROUP_W, GROUP_W, GROUP_W, GROUP_W,
            GROUP_W, GROUP_W, GROUP_W,
            2 * GROUP_W, GROUP_W,
            GROUP_W, GROUP_W, GROUP_W, GROUP_W)
D_IN = sum(IN_SIZES)
SPLITS = [int(s) for s in np.cumsum(IN_SIZES)[:-1]]

kernel_name = 'hymba_diffattn_gmlp_conformer_hgrn2_step'

F32 = jnp.float32


def _layer_norm(x, g, b):
    xf = x.astype(F32)
    xc = xf - xf.mean(-1, keepdims=True)
    var = (xc * xc).mean(-1, keepdims=True)
    return xc * lax.rsqrt(var + EPS) * g.astype(F32) + b.astype(F32)


def _rms_norm(x, g):
    xf = x.astype(F32)
    return xf * lax.rsqrt((xf * xf).mean(-1, keepdims=True) + EPS) * g.astype(F32)


def _rope(x, pos):
    d = x.shape[-1]
    half = d // 2
    inv = ROPE_THETA ** (-jnp.arange(half, dtype=F32) * 2.0 / d)
    ang = pos.astype(F32)[:, None] * inv[None, :]
    cos = jnp.cos(ang)[:, None, :]
    sin = jnp.sin(ang)[:, None, :]
    xf = x.astype(F32)
    x1, x2 = xf[..., :half], xf[..., half:]
    return jnp.concatenate([x1 * cos - x2 * sin, x2 * cos + x1 * sin], -1)


def _diff_attend(q1, q2, k1, k2, v, qpos, kpos, lam):
    scale = q1.shape[-1] ** -0.5
    visible = kpos[None, :] <= qpos[:, None]

    def probs(q, k):
        s = jnp.einsum('bqhd,bkhd->bhqk', q.astype(F32), k.astype(F32)) * scale
        return jax.nn.softmax(jnp.where(visible, s, NEG_BIG), axis=-1)

    p = probs(q1, k1) - lam * probs(q2, k2)
    return jnp.einsum('bhqk,bkhd->bqhd', p, v.astype(F32))


def _diff_attn_blocks(q1, q2, k1, k2, v, lam):
    B, T, H, _ = q1.shape
    nb = T // Q_BLOCK
    kpos = jnp.arange(T)

    def to_blocks(a):
        return a.reshape(B, nb, Q_BLOCK, H, a.shape[-1]).swapaxes(0, 1)

    def one(args):
        qa, qb, qp = args
        return _diff_attend(qa, qb, k1, k2, v, qp, kpos, lam)

    out = lax.map(one, (to_blocks(q1), to_blocks(q2), kpos.reshape(nb, Q_BLOCK)))
    return out.swapaxes(0, 1).reshape(B, T, H, v.shape[-1])


def _spatial_gate(u, v, ws, bs, g, b):
    Bn, T, W = v.shape
    vn = _layer_norm(v, g, b)
    Tp = -(-T // SG_CHUNK) * SG_CHUNK
    vc = jnp.pad(vn, ((0, 0), (0, Tp - T), (0, 0))).reshape(Bn, Tp // SG_CHUNK, SG_CHUNK, B_GROUPS, B_GDIM)
    wm = jnp.tril(ws.astype(F32))
    mixed = jnp.einsum('gts,bcsgd->bctgd', wm, vc) + bs.astype(F32).T[None, None, :, :, None]
    mixed = mixed.reshape(Bn, Tp, W)[:, :T]
    return u.astype(F32) * mixed, vn


def _conformer_conv(a, buf, cw, cb, ng, nb, wpw):
    glu = a[..., :GROUP_W] * jax.nn.sigmoid(a[..., GROUP_W:])
    hc = jnp.concatenate([buf.astype(glu.dtype), glu], 1)
    y = lax.conv_general_dilated(hc, cw[:, None, :].astype(hc.dtype), window_strides=(1,), padding='VALID',
                                 dimension_numbers=('NWC', 'WIO', 'NWC'), feature_group_count=GROUP_W)
    y = jax.nn.silu(_layer_norm(y + cb, ng, nb))
    return jnp.einsum('btc,cd->btd', y, wpw), hc[:, -(CONV_W - 1):]


def _hgrn2(q, log_f, k, v, S0):
    Bn, T, H, _ = q.shape
    dv = v.shape[-1]
    C = HGRN_CHUNK
    Tp = -(-T // C) * C

    def chunks(a):
        a = jnp.pad(a, ((0, 0), (0, Tp - T), (0, 0), (0, 0)))
        return a.reshape(Bn, Tp // C, C, H, a.shape[-1]).transpose(1, 0, 3, 2, 4)

    causal = jnp.tril(jnp.ones((C, C), bool))[:, :, None]

    def step(S, inp):
        qc, lfc, kc, vc = inp
        cum = jnp.cumsum(lfc, axis=2)
        o_inter = jnp.einsum('bhtk,bhkv->bhtv', qc * jnp.exp(cum), S)
        diff = jnp.where(causal, cum[:, :, :, None, :] - cum[:, :, None, :, :], 0.0)
        decay = jnp.where(causal, jnp.exp(diff), 0.0)
        att = jnp.einsum('bhtk,bhtsk,bhsk->bhts', qc, decay, kc)
        o = o_inter + jnp.einsum('bhts,bhsv->bhtv', att, vc)
        last = cum[:, :, -1:, :]
        S_new = jnp.exp(last[:, :, 0, :])[..., None] * S + jnp.einsum('bhsk,bhsv->bhkv', kc * jnp.exp(last - cum), vc)
        return S_new, o

    S_fin, o = lax.scan(step, S0, (chunks(q), chunks(log_f), chunks(k), chunks(v)))
    o = o.transpose(1, 0, 3, 2, 4).reshape(Bn, Tp, H, dv)[:, :T]
    return o, S_fin


def _mixer_layer(l, x, c, pos, kv_past, buf, S0, lb, wts):
    (w_ada, b_ada, w_in, lam_qk, attn_norm_g, sg_norm_g, sg_norm_b, w_s, b_s, conv_w, conv_b,
     conv_norm_g, conv_norm_b, w_pw, hgrn_norm_g, w_out, ln_g, ln_b) = wts
    dt = x.dtype
    Bn, T, _ = x.shape
    mod = jax.nn.silu(c) @ w_ada[l] + b_ada[l]
    shift, scale, gate = jnp.split(mod, 3, axis=-1)
    h = x * (1 + scale[:, None, :]) + shift[:, None, :]
    z = h @ w_in[l]
    aq, ak, av, ag, bu, bv, bg, cin, cg, dq, df, di, dg = jnp.split(z, SPLITS, axis=-1)

    aq = aq.reshape(Bn, T, A_HEADS, 2 * A_HALF)
    ak = ak.reshape(Bn, T, A_HEADS, 2 * A_HALF)
    q1 = _rope(aq[..., :A_HALF], pos)
    q2 = _rope(aq[..., A_HALF:], pos)
    k_rows = jnp.concatenate([_rope(ak[..., :A_HALF], pos), _rope(ak[..., A_HALF:], pos)], -1).astype(dt)
    v_rows = av.reshape(Bn, T, A_HEADS, A_VDIM)
    lp = lam_qk[l].astype(F32)
    lam_init = 0.8 - 0.6 * math.exp(-0.3 * l)
    lam = jnp.exp(jnp.sum(lp[0] * lp[1])) - jnp.exp(jnp.sum(lp[2] * lp[3])) + lam_init
    if kv_past is None:
        o_a = _diff_attn_blocks(q1, q2, k_rows[..., :A_HALF], k_rows[..., A_HALF:], v_rows, lam)
    else:
        k_all = jnp.concatenate([kv_past[0].astype(dt), k_rows], 1)
        v_all = jnp.concatenate([kv_past[1].astype(dt), v_rows], 1)
        kpos = jnp.arange(k_all.shape[1])
        o_a = _diff_attend(q1, q2, k_all[..., :A_HALF], k_all[..., A_HALF:], v_all, pos, kpos, lam)
    o_a = (_rms_norm(o_a, attn_norm_g[l]) * (1.0 - lam_init)).reshape(Bn, T, GROUP_W)
    o_a = o_a * jax.nn.silu(ag.astype(F32))

    o_b, v_state = _spatial_gate(jax.nn.gelu(bu, approximate=False), jax.nn.gelu(bv, approximate=False),
                                 w_s[l], b_s[l], sg_norm_g[l], sg_norm_b[l])
    o_b = o_b * jax.nn.silu(bg.astype(F32))

    o_c, new_buf = _conformer_conv(cin, buf, conv_w[l], conv_b[l], conv_norm_g[l], conv_norm_b[l], w_pw[l])
    o_c = o_c * jax.nn.silu(cg.astype(F32))

    dff = df.astype(F32)
    f = lb + (1.0 - lb) * jax.nn.sigmoid(dff)
    log_f = jnp.log(jnp.maximum(f, F_FLOOR)).reshape(Bn, T, D_HEADS, D_KDIM)
    qd = jax.nn.silu(dq.astype(F32)).reshape(Bn, T, D_HEADS, D_KDIM)
    kd = (1.0 - f).reshape(Bn, T, D_HEADS, D_KDIM)
    vd = di.astype(F32).reshape(Bn, T, D_HEADS, D_VDIM)
    o_d, S_new = _hgrn2(qd, log_f, kd, vd, S0.astype(F32))
    o_d = _rms_norm(o_d, hgrn_norm_g[l]).reshape(Bn, T, GROUP_W) * jax.nn.silu(dg.astype(F32))

    mixed = jnp.concatenate([o_a, o_b, o_c, o_d], -1).astype(dt) @ w_out[l]
    y = _layer_norm(ALPHA * x + gate[:, None, :] * mixed, ln_g[l], ln_b[l]).astype(dt)
    return y, k_rows, v_rows.astype(dt), v_state.astype(dt), new_buf.astype(dt), S_new.astype(dt)


def setup_inputs(seed: int = 0) -> dict:
    key = jax.random.key(seed)
    ks = jax.random.split(key, 28)
    n_pages = PAST_LEN // PAGE_SIZE
    n_used = DEC_BATCH * n_pages
    n_pool = n_used + max(1, n_used // 4)

    def nrm(k, shape, s):
        return s * jax.random.normal(k, shape, F32)

    page_table = jax.random.permutation(ks[0], n_pool)[:n_used].reshape(DEC_BATCH, n_pages).astype(jnp.int32)
    return {
        'x_prompt': nrm(ks[1], (BATCH, SEQ, D_MODEL), 1.0),
        'x_sample': nrm(ks[2], (DEC_BATCH, DEC_SEQ, D_MODEL), 1.0),
        'cache_k': nrm(ks[3], (DEPTH, n_pool, PAGE_SIZE, A_HEADS, 2 * A_HALF), 1.0),
        'cache_v': nrm(ks[4], (DEPTH, n_pool, PAGE_SIZE, A_HEADS, A_VDIM), 1.0),
        'state_conv': nrm(ks[5], (DEPTH, DEC_BATCH, CONV_W - 1, GROUP_W), 0.5),
        'state_hgrn': nrm(ks[6], (DEPTH, DEC_BATCH, D_HEADS, D_KDIM, D_VDIM), 0.3),
        'page_table': page_table,
        'c_prompt': nrm(ks[7], (BATCH, D_MODEL), 1.0),
        'c_sample': nrm(ks[8], (DEC_BATCH, D_MODEL), 1.0),
        'w_ada': nrm(ks[9], (DEPTH, D_MODEL, 3 * D_MODEL), 0.5 * D_MODEL ** -0.5),
        'b_ada': nrm(ks[10], (DEPTH, 3 * D_MODEL), 0.01),
        'w_in': nrm(ks[11], (DEPTH, D_MODEL, D_IN), D_MODEL ** -0.5),
        'lam_qk': nrm(ks[12], (DEPTH, 4, A_HALF), 0.1),
        'attn_norm_g': 1.0 + nrm(ks[13], (DEPTH, A_VDIM), 0.02),
        'sg_norm_g': 1.0 + nrm(ks[14], (DEPTH, GROUP_W), 0.02),
        'sg_norm_b': nrm(ks[15], (DEPTH, GROUP_W), 0.01),
        'w_s': nrm(ks[16], (DEPTH, B_GROUPS, SG_CHUNK, SG_CHUNK), SG_CHUNK ** -0.5),
        'b_s': 1.0 + nrm(ks[17], (DEPTH, B_GROUPS, SG_CHUNK), 0.02),
        'conv_w': nrm(ks[18], (DEPTH, CONV_W, GROUP_W), CONV_W ** -0.5),
        'conv_b': nrm(ks[19], (DEPTH, GROUP_W), 0.01),
        'conv_norm_g': 1.0 + nrm(ks[20], (DEPTH, GROUP_W), 0.02),
        'conv_norm_b': nrm(ks[21], (DEPTH, GROUP_W), 0.01),
        'w_pw': nrm(ks[22], (DEPTH, GROUP_W, GROUP_W), GROUP_W ** -0.5),
        'lower_bounds': nrm(ks[23], (DEPTH, GROUP_W), 0.5),
        'hgrn_norm_g': 1.0 + nrm(ks[24], (DEPTH, D_VDIM), 0.02),
        'w_out': nrm(ks[25], (DEPTH, D_MODEL, D_MODEL), BETA * D_MODEL ** -0.5),
        'ln_g': 1.0 + nrm(ks[26], (DEPTH, D_MODEL), 0.02),
        'ln_b': nrm(ks[27], (DEPTH, D_MODEL), 0.01),
    }


def reference(x_prompt, x_sample, cache_k, cache_v, state_conv, state_hgrn, page_table, c_prompt, c_sample,
              w_ada, b_ada, w_in, lam_qk, attn_norm_g, sg_norm_g, sg_norm_b, w_s, b_s, conv_w, conv_b,
              conv_norm_g, conv_norm_b, w_pw, lower_bounds, hgrn_norm_g, w_out, ln_g, ln_b):
    wts = (w_ada, b_ada, w_in, lam_qk, attn_norm_g, sg_norm_g, sg_norm_b, w_s, b_s, conv_w, conv_b,
           conv_norm_g, conv_norm_b, w_pw, hgrn_norm_g, w_out, ln_g, ln_b)
    lb_soft = jax.nn.softmax(lower_bounds.astype(F32), axis=0)
    lbs = jnp.cumsum(lb_soft, axis=0) - lb_soft[0:1]

    Bp, T = x_prompt.shape[:2]
    Bs, Ts = x_sample.shape[:2]
    past_len = page_table.shape[1] * cache_k.shape[2]
    pos_p = jnp.arange(T)
    pos_s = past_len + jnp.arange(Ts)
    buf0 = jnp.zeros((Bp, CONV_W - 1, GROUP_W), x_prompt.dtype)
    S0 = jnp.zeros((Bp, D_HEADS, D_KDIM, D_VDIM), F32)

    xp, xs = x_prompt, x_sample
    kp_l, vp_l, ks_l, vs_l, ch_l, cbp_l, cbs_l, sp_l, ss_l = [], [], [], [], [], [], [], [], []
    for l in range(DEPTH):
        xp, kp, vp, _, cbp, Sp = _mixer_layer(l, xp, c_prompt, pos_p, None, buf0, S0, lbs[l], wts)
        k_past = cache_k[l][page_table].reshape(Bs, past_len, A_HEADS, 2 * A_HALF)
        v_past = cache_v[l][page_table].reshape(Bs, past_len, A_HEADS, A_VDIM)
        xs, kss, vss, chs, cbs, Ss = _mixer_layer(l, xs, c_sample, pos_s, (k_past, v_past),
                                                 state_conv[l], state_hgrn[l], lbs[l], wts)
        kp_l.append(kp); vp_l.append(vp); cbp_l.append(cbp); sp_l.append(Sp)
        ks_l.append(kss); vs_l.append(vss); ch_l.append(chs); cbs_l.append(cbs); ss_l.append(Ss)

    return (xp, xs, jnp.stack(kp_l), jnp.stack(vp_l), jnp.stack(ks_l), jnp.stack(vs_l), jnp.stack(ch_l),
            jnp.stack(cbp_l), jnp.stack(cbs_l), jnp.stack(sp_l), jnp.stack(ss_l))
```

```cpp
#include <hip/hip_runtime.h>
#include <cstdio>
#include <cstdint>
namespace pg8 {
#define PG8_LAS __attribute__((address_space(3)))
typedef unsigned short bf16_t;
typedef short bf16x8 __attribute__((ext_vector_type(8)));
typedef float f32x4 __attribute__((ext_vector_type(4)));
typedef unsigned u32x4 __attribute__((ext_vector_type(4)));
constexpr int BM = 256, BK = 64, HALF = 128, HTB = HALF * BK * 2  , STAGE_BYTES = 8 * HTB, NXCD = 8, WGM = 8;

__host__ __device__ __forceinline__ int lds_byte(int r, int c) { const int st = (r >> 4) * 2 + (c >> 5), rr = r & 15, cc = c & 31, ob = rr * 64 + cc * 2; return st * 1024 + (ob ^ (((ob >> 9) & 1) << 5)); }
__host__ __device__ __forceinline__ void stage_rc(int b, int& R, int& C) { const int st = b / 1024, sb = b % 1024, swz = sb ^ (((sb >> 9) & 1) << 5); R = (st >> 1) * 16 + swz / 64; C = (st & 1) * 32 + (swz % 64) / 2; }
__host__ __device__ __forceinline__ int perm32(int rho) { const int n = rho >> 4, i = rho & 15; return 8 * (i >> 2) + 4 * n + (i & 3); }

struct Unit { int pm, pn; };
struct Gemm { const bf16_t* A; const bf16_t* Bt; int M, N, K; };

struct StaticOrder {
    int nM, nN, nwg, G, c;
    __host__ __device__ void init(int M, int N, int G_, int c_) { nM = M / BM; nN = N / BM; nwg = nM * nN; G = G_; c = c_; }
    __host__ __device__ bool next(int i, Unit& u) const {
        const long L = (long)i * G + c; if (L >= nwg) return false;
        int wgid = (int)L; { const int q = nwg / NXCD, r = nwg % NXCD, xcd = wgid % NXCD, off = wgid / NXCD; wgid = (xcd < r ? xcd * (q + 1) : r * (q + 1) + (xcd - r) * q) + off; }
        const int nig = WGM * nN, gid = wgid / nig, fm = gid * WGM, gsz = (nM - fm) < WGM ? (nM - fm) : WGM;
        u.pm = fm + ((wgid % nig) % gsz); u.pn = (wgid % nig) / gsz; return true;
    }
    __device__ __forceinline__ void a_ready(const Unit&) const {}
    __device__ __forceinline__ void done(const Unit&) const {}
};

__device__ __forceinline__ unsigned cvt_pk_bf16(float lo, float hi) { unsigned r; asm volatile("v_cvt_pk_bf16_f32 %0, %1, %2" : "=v"(r) : "v"(lo), "v"(hi)); return r; }
typedef float f32x2 __attribute__((ext_vector_type(2)));
template <class Epi, class Sched, bool ALIGN_EPI = false, bool SP2 = false>
__device__ __forceinline__ void gemm_phase(PG8_LAS unsigned char* lds, const Gemm g, const Sched& S, const Epi& E, const int tid) {
    const int wid = __builtin_amdgcn_readfirstlane(tid >> 6), lane = tid & 63, wr = wid >> 2, wc = wid & 3, fr = lane & 15, fq = lane >> 4;
    const int K = g.K, nt = K / BK;
    unsigned voffA[2], voffB[2];
#pragma unroll
    for (int i = 0; i < 2; ++i) { int R, C; stage_rc(tid * 16 + i * 8192, R, C); const int Rb = Epi::PERM ? ((R & ~31) + perm32(R & 31)) : R;
        voffA[i] = (unsigned)(R * K + C) * 2u; voffB[i] = (unsigned)(Rb * K + C) * 2u; }
    const size_t kstep = (size_t)(BK * 2);
    const size_t hstep = (size_t)HALF * K * 2;
    const size_t tstep = 2 * hstep;
    const unsigned ldsw = (unsigned)wid * 1024u;
    const int aoff = lds_byte(wr * 64 + fr, fq * 8), boff = lds_byte(wc * 32 + fr, fq * 8);
#define PG8_SA(b, h) (((b) * 2 + (h)) * HTB)
#define PG8_SB(b, h) ((4 + (b) * 2 + (h)) * HTB)
#define PG8_STAGE(bufoff, gbase, voff) do { _Pragma("unroll") for (int _i = 0; _i < 2; ++_i) \
        __builtin_amdgcn_global_load_lds((const unsigned*)((const char*)(gbase) + (voff)[_i]), (PG8_LAS unsigned*)(lds + (bufoff) + ldsw + _i * 8192), 16, 0, 0); } while (0)
#define PG8_LDA(dst, b, h) do { _Pragma("unroll") for (int m = 0; m < 4; ++m) _Pragma("unroll") for (int k = 0; k < 2; ++k) dst[m][k] = *(const PG8_LAS bf16x8*)(lds + PG8_SA(b, h) + aoff + m * 2048 + k * 1024); } while (0)
#define PG8_LDB(dst, b, h) do { _Pragma("unroll") for (int n = 0; n < 2; ++n) _Pragma("unroll") for (int k = 0; k < 2; ++k) dst[n][k] = *(const PG8_LAS bf16x8*)(lds + PG8_SB(b, h) + boff + n * 2048 + k * 1024); } while (0)
#define PG8_MMA(ai, bj, At, Bt) do { __builtin_amdgcn_s_setprio(1); _Pragma("unroll") for (int m = 0; m < 4; ++m) _Pragma("unroll") for (int n = 0; n < 2; ++n) _Pragma("unroll") for (int k = 0; k < 2; ++k) \
        acc[ai][bj][m][n] = __builtin_amdgcn_mfma_f32_16x16x32_bf16(Bt[n][k], At[m][k], acc[ai][bj][m][n], 0, 0, 0); __builtin_amdgcn_s_setprio(0); } while (0)
#define PG8_WAIT_V(n) asm volatile("s_waitcnt vmcnt(" #n ")" ::: "memory")
#define PG8_WAIT_L(n) asm volatile("s_waitcnt lgkmcnt(" #n ")" ::: "memory")
#define PG8_BAR __builtin_amdgcn_s_barrier()
#define PG8_SCHED __builtin_amdgcn_sched_barrier(0)
    Unit cur, nxt; int ui = 0;
    if (!S.next(0, cur)) return;
    f32x4 acc[2][2][4][2];
#pragma unroll
    for (int a = 0; a < 2; ++a)
#pragma unroll
        for (int b = 0; b < 2; ++b)
#pragma unroll
            for (int m = 0; m < 4; ++m)
#pragma unroll
                for (int n = 0; n < 2; ++n) acc[a][b][m][n] = (f32x4){0.f, 0.f, 0.f, 0.f};
    bf16x8 At[4][2], B0[2][2], B1[2][2];
    const char* cA = (const char*)g.A + (size_t)cur.pm * tstep; const char* cB = (const char*)g.Bt + (size_t)cur.pn * tstep;
    S.a_ready(cur);
    if constexpr (SP2) {
        PG8_STAGE(PG8_SB(0, 0), cB, voffB); PG8_STAGE(PG8_SB(0, 1), cB + hstep, voffB); PG8_STAGE(PG8_SA(0, 0), cA, voffA); PG8_STAGE(PG8_SA(0, 1), cA + hstep, voffA);
        if (wr == 1) PG8_BAR;
        PG8_WAIT_V(2); PG8_BAR;
        PG8_STAGE(PG8_SB(1, 0), cB + kstep, voffB); PG8_STAGE(PG8_SA(1, 0), cA + kstep, voffA); PG8_STAGE(PG8_SB(1, 1), cB + hstep + kstep, voffB);
        PG8_WAIT_V(6); PG8_BAR;
    } else {
        PG8_STAGE(PG8_SB(0, 0), cB, voffB); PG8_STAGE(PG8_SA(0, 0), cA, voffA); PG8_STAGE(PG8_SB(0, 1), cB + hstep, voffB); PG8_STAGE(PG8_SA(0, 1), cA + hstep, voffA);
        if (wr == 1) PG8_BAR;
        PG8_WAIT_V(4); PG8_BAR;
        PG8_STAGE(PG8_SB(1, 0), cB + kstep, voffB); PG8_STAGE(PG8_SA(1, 0), cA + kstep, voffA); PG8_STAGE(PG8_SB(1, 1), cB + hstep + kstep, voffB);
        PG8_WAIT_V(6); PG8_BAR;
    }
    for (;;) {
        const bool has_next = S.next(ui + 1, nxt);
        const char* nA = has_next ? (const char*)g.A + (size_t)nxt.pm * tstep : cA; const char* nB = has_next ? (const char*)g.Bt + (size_t)nxt.pn * tstep : cB;
        for (int t = 0; t < nt; t += 2) {
            const bool last = (t == nt - 2);
            const char* a1 = cA + (size_t)(t + 1) * kstep;
            const char* a2 = last ? nA : cA + (size_t)(t + 2) * kstep; const char* b2 = last ? nB : cB + (size_t)(t + 2) * kstep;
            const char* a3 = a2 + kstep; const char* b3 = b2 + kstep;
            if (last && has_next) S.a_ready(nxt);
            if constexpr (SP2) {
            PG8_LDB(B0, 0, 0); PG8_LDB(B1, 0, 1); PG8_SCHED; PG8_LDA(At, 0, 0); PG8_STAGE(PG8_SA(1, 1), a1 + hstep, voffA);
            PG8_WAIT_V(8); PG8_WAIT_L(0); PG8_BAR; PG8_MMA(0, 0, At, B0); PG8_MMA(0, 1, At, B1); PG8_BAR; PG8_SCHED;
            PG8_LDA(At, 0, 1); PG8_STAGE(PG8_SB(0, 0), b2, voffB); PG8_STAGE(PG8_SB(0, 1), b2 + hstep, voffB); PG8_STAGE(PG8_SA(0, 0), a2, voffA);
            PG8_WAIT_V(8); PG8_WAIT_L(0); PG8_BAR; PG8_MMA(1, 0, At, B0); PG8_MMA(1, 1, At, B1); PG8_BAR; PG8_SCHED;
            PG8_LDB(B0, 1, 0); PG8_LDB(B1, 1, 1); PG8_SCHED; PG8_LDA(At, 1, 0); PG8_STAGE(PG8_SA(0, 1), a2 + hstep, voffA);
            PG8_WAIT_V(8); PG8_WAIT_L(0); PG8_BAR; PG8_MMA(0, 0, At, B0); PG8_MMA(0, 1, At, B1); PG8_BAR; PG8_SCHED;
            PG8_LDA(At, 1, 1); PG8_STAGE(PG8_SB(1, 0), b3, voffB); PG8_STAGE(PG8_SB(1, 1), b3 + hstep, voffB); PG8_STAGE(PG8_SA(1, 0), a3, voffA);
            PG8_WAIT_V(8); PG8_WAIT_L(0); PG8_BAR; PG8_MMA(1, 0, At, B0); PG8_MMA(1, 1, At, B1); PG8_BAR; PG8_SCHED;
            } else {
            PG8_LDB(B0, 0, 0); PG8_SCHED; PG8_LDA(At, 0, 0); PG8_STAGE(PG8_SA(1, 1), a1 + hstep, voffA);
            PG8_WAIT_L(8); PG8_BAR; PG8_WAIT_L(0); PG8_MMA(0, 0, At, B0); PG8_BAR; PG8_SCHED;
            PG8_LDB(B1, 0, 1); PG8_STAGE(PG8_SB(0, 0), b2, voffB);
            PG8_BAR; PG8_WAIT_L(0); PG8_MMA(0, 1, At, B1); PG8_BAR;
            PG8_LDA(At, 0, 1); PG8_STAGE(PG8_SA(0, 0), a2, voffA);
            PG8_BAR; PG8_WAIT_L(0); PG8_MMA(1, 0, At, B0); PG8_BAR; PG8_SCHED;
            PG8_STAGE(PG8_SB(0, 1), b2 + hstep, voffB);
            PG8_WAIT_V(6); PG8_BAR; PG8_MMA(1, 1, At, B1); PG8_BAR;
            PG8_LDB(B0, 1, 0); PG8_SCHED; PG8_LDA(At, 1, 0); PG8_STAGE(PG8_SA(0, 1), a2 + hstep, voffA);
            PG8_WAIT_L(8); PG8_BAR; PG8_WAIT_L(0); PG8_MMA(0, 0, At, B0); PG8_BAR; PG8_SCHED;
            PG8_LDB(B1, 1, 1); PG8_STAGE(PG8_SB(1, 0), b3, voffB);
            PG8_BAR; PG8_WAIT_L(0); PG8_MMA(0, 1, At, B1); PG8_BAR;
            PG8_LDA(At, 1, 1); PG8_STAGE(PG8_SA(1, 0), a3, voffA);
            PG8_BAR; PG8_WAIT_L(0); PG8_MMA(1, 0, At, B0); PG8_BAR; PG8_SCHED;
            PG8_STAGE(PG8_SB(1, 1), b3 + hstep, voffB);
            PG8_WAIT_V(6); PG8_BAR; PG8_MMA(1, 1, At, B1); PG8_BAR;
            }
        }
        if constexpr (ALIGN_EPI) { if (wr == 0) PG8_BAR; }
        if constexpr (!Epi::AFTER_DRAIN) { E(acc, cur, wr, wc, fr, fq); S.done(cur); }
        if (!has_next) break;
#pragma unroll
        for (int a = 0; a < 2; ++a)
#pragma unroll
            for (int b = 0; b < 2; ++b)
#pragma unroll
                for (int m = 0; m < 4; ++m)
#pragma unroll
                    for (int n = 0; n < 2; ++n) acc[a][b][m][n] = (f32x4){0.f, 0.f, 0.f, 0.f};
        cur = nxt; cA = nA; cB = nB; ++ui;
        if constexpr (ALIGN_EPI) { if (wr == 1) PG8_BAR; }
    }
    PG8_WAIT_V(0);
    if constexpr (!ALIGN_EPI) { if (wr == 0) PG8_BAR; }
    PG8_BAR;
    if constexpr (Epi::AFTER_DRAIN) { E.fused(acc, cur, wr, wc, fr, fq, lds, wid, lane); S.done(cur); }
#undef PG8_SA
#undef PG8_SB
#undef PG8_STAGE
#undef PG8_LDA
#undef PG8_LDB
#undef PG8_MMA
#undef PG8_WAIT_V
#undef PG8_WAIT_L
#undef PG8_BAR
#undef PG8_SCHED
}
}

#ifndef PG8_SP2
#define PG8_SP2 true
#endif
#ifndef PG8_ALIGN
#define PG8_ALIGN true
#endif

#define GAS __attribute__((address_space(1)))
#define LAS __attribute__((address_space(3)))
typedef unsigned short bf16;
typedef unsigned v4u __attribute__((ext_vector_type(4)));
typedef unsigned v2u __attribute__((ext_vector_type(2)));
typedef float f32x4 __attribute__((ext_vector_type(4)));
typedef float f32x2v __attribute__((ext_vector_type(2)));
typedef GAS unsigned gu32;
#define RLX_AGENT __ATOMIC_RELAXED, __HIP_MEMORY_SCOPE_AGENT
#define LDS_WAIT() asm volatile("s_waitcnt lgkmcnt(0)" ::: "memory")
#define VM_WAIT() asm volatile("s_waitcnt vmcnt(0)" ::: "memory")
__device__ __forceinline__ unsigned f2bf(float f) { unsigned u = __builtin_bit_cast(unsigned, f); return (u + 0x7fffu + ((u >> 16) & 1u)) >> 16; }
__device__ __forceinline__ unsigned pk2(float lo, float hi) { return f2bf(lo) | (f2bf(hi) << 16); }
__device__ __forceinline__ float bf2f(unsigned short b) { return __builtin_bit_cast(float, (unsigned)b << 16); }
__device__ __forceinline__ float bflo(unsigned w) { return __builtin_bit_cast(float, w << 16); }
__device__ __forceinline__ float bfhi(unsigned w) { return __builtin_bit_cast(float, w & 0xffff0000u); }
__device__ __forceinline__ float sigmoid_f(float x) { return 1.f / (1.f + __expf(-x)); }
__device__ __forceinline__ float silu_f(float x) { return x / (1.f + __expf(-x)); }
__device__ __forceinline__ float gelu_f(float x) { return 0.5f * x * (1.f + erff(x * 0.70710678118654752f)); }
__device__ __forceinline__ float wave_sum(float v) {
#pragma unroll
    for (int o = 1; o < 64; o <<= 1) v += __shfl_xor(v, o);
    return v;
}
__device__ __forceinline__ float wave_max(float v) {
#pragma unroll
    for (int o = 1; o < 64; o <<= 1) v = fmaxf(v, __shfl_xor(v, o));
    return v;
}

#define XB_TMO      128
#define XB_XCNT(j)  (256  + 64 * (j))
#define XB_XSUB(j)  (1280 + 64 * (j))
#define XB_XGEN(j)  (2304 + 64 * (j))
#define XB_TOP      3328
#define XB_TOPGEN   3392
#define XCD_BAR_WORDS 3456
#define XB_SPIN_CAP (1u << 18)

__device__ __forceinline__ unsigned xb_ld(unsigned* p)              { return __hip_atomic_load(p, __ATOMIC_RELAXED, __HIP_MEMORY_SCOPE_AGENT); }
__device__ __forceinline__ unsigned xb_add(unsigned* p, unsigned v) { return __hip_atomic_fetch_add(p, v, __ATOMIC_RELAXED, __HIP_MEMORY_SCOPE_AGENT); }
__device__ __forceinline__ unsigned xb_xcc_id() { return (unsigned)__builtin_amdgcn_s_getreg((3 << 11) | 20) & 0xFu; }
#define XB_SPIN(cond, bar) do { unsigned _sp = 0; while (cond) { __builtin_amdgcn_s_sleep(1); \
    if ((++_sp & 255u) == 0u) { if (xb_ld(&(bar)[XB_TMO])) break; if (_sp > XB_SPIN_CAP) { atomicAdd(&(bar)[XB_TMO], 1u); break; } } } } while (0)

struct XcdBarrier {
    unsigned* bar; unsigned x;
    volatile LAS unsigned* st;
};
__device__ __forceinline__ XcdBarrier xcd_barrier_post(unsigned* bar, volatile LAS unsigned* st) {
    XcdBarrier b; b.bar = bar; b.x = xb_xcc_id(); b.st = st;
    if (threadIdx.x == 0) (void)xb_add(&bar[XB_XCNT(b.x)], 1u);
    return b;
}
__device__ __forceinline__ void xcd_barrier_complete(unsigned* bar, unsigned x, unsigned& nloc, unsigned& nx) {
    const unsigned G = gridDim.x * gridDim.y * gridDim.z;
    unsigned sum, cnt, mine, sp = 0u;
    for (;;) {
        sum = 0u; cnt = 0u; mine = 0u;
#pragma unroll
        for (unsigned j = 0; j < 16; ++j) { const unsigned c = xb_ld(&bar[XB_XCNT(j)]); sum += c; cnt += (c > 0u) ? 1u : 0u; mine = (j == x) ? c : mine; }
        if (sum == G) break;
        __builtin_amdgcn_s_sleep(1);
        if ((++sp & 255u) == 0u) { if (xb_ld(&bar[XB_TMO])) break; if (sp > XB_SPIN_CAP) { atomicAdd(&bar[XB_TMO], 1u); break; } }
    }
    nloc = mine > 0u ? mine : 1u; nx = cnt > 0u ? cnt : 1u;
}
__device__ __forceinline__ void xcd_barrier(const XcdBarrier& b) {
    asm volatile("s_waitcnt vmcnt(0)" ::: "memory");
    __syncthreads();
    if (threadIdx.x == 0) {
        unsigned* bar = b.bar;
        __builtin_amdgcn_s_waitcnt(0);
        unsigned nloc = b.st[0], nx = b.st[1];
        if (nloc == 0u) { xcd_barrier_complete(bar, b.x, nloc, nx); b.st[0] = nloc; b.st[1] = nx; }
        const unsigned old = xb_add(&bar[XB_XSUB(b.x)], 1u);
        const unsigned gen = old / nloc;
        if (old + 1u == (gen + 1u) * nloc) {
            __builtin_amdgcn_fence(__ATOMIC_RELEASE, "agent");
            asm volatile("s_waitcnt vmcnt(0)" ::: "memory");
            const unsigned og = xb_add(&bar[XB_TOP], 1u);
            const unsigned tg = og / nx;
            if (og + 1u == (tg + 1u) * nx) xb_add(&bar[XB_TOPGEN], 1u);
            else XB_SPIN(xb_ld(&bar[XB_TOPGEN]) == tg, bar);
            __builtin_amdgcn_fence(__ATOMIC_ACQUIRE, "agent");
            xb_add(&bar[XB_XGEN(b.x)], 1u);
            asm volatile("s_waitcnt vmcnt(0)" ::: "memory");
        } else {
            XB_SPIN(xb_ld(&bar[XB_XGEN(b.x)]) == gen, bar);
            __builtin_amdgcn_fence(__ATOMIC_ACQUIRE, "agent");
            asm volatile("s_waitcnt vmcnt(0)" ::: "memory");
        }
    }
    __syncthreads();
}

constexpr int NWAVES = 8, NTHR = 512;
constexpr int DM = 1024, MP = 16384, MS = 1024, MT = MP + MS, TSEQ = 8192, DIN = 3584, GW = 256;
constexpr int NBP = 2, NBS = 128, NBT = NBP + NBS;
constexpr int NPOOL = 2560, NPAGES = 16, PAGE = 128, PAST = 2048;
constexpr float EPS = 1e-5f;
constexpr float QSCALE = 0.25503486164919736f;
constexpr float ALPHA = 1.4142135623730951f;
constexpr int HG_L = 64, HG_NB = TSEQ / HG_L;
__device__ const double ROPE_INV[16] = {1.0, 0.5623413251903491, 0.31622776601683794, 0.1778279410038923, 0.1, 0.05623413251903491, 0.03162277660168379, 0.01778279410038923,
                                        0.01, 0.005623413251903491, 0.0031622776601683794, 0.0017782794100389228, 0.001, 0.0005623413251903491, 0.00031622776601683794, 0.00017782794100389227};
enum { I_XP = 0, I_XS, I_CK, I_CV, I_SCONV, I_SHGRN, I_PT, I_CP, I_CSM, I_WADA, I_BADA, I_WIN, I_LAMQK, I_ANG, I_SGG, I_SGB, I_WS, I_BS, I_CW, I_CB, I_CNG, I_CNB, I_WPW, I_LB, I_HNG, I_WOUT, I_LNG, I_LNB, N_IN };
constexpr size_t O_YP = 0, O_YS = O_YP + (size_t)MP * DM, O_KP = O_YS + (size_t)MS * DM, O_VP = O_KP + (size_t)2 * MP * GW, O_KS = O_VP + (size_t)2 * MP * GW,
                 O_VS = O_KS + (size_t)2 * MS * GW, O_CH = O_VS + (size_t)2 * MS * GW, O_CP = O_CH + (size_t)2 * MS * GW, O_CS = O_CP + (size_t)2 * NBP * 30 * GW,
                 O_HP = O_CS + (size_t)2 * NBS * 30 * GW, O_HS = O_HP + (size_t)2 * NBP * 4 * 4096, O_END = O_HS + (size_t)2 * NBS * 4 * 4096;
static_assert(O_END == 42432512, "output size");
constexpr size_t MiB = 1u << 20;
constexpr size_t WS_CTL = 0, CTL_ZERO_BYTES = 1 * MiB;
constexpr size_t WS_CS = 1 * MiB;
constexpr size_t WS_MOD = 2 * MiB;
constexpr size_t WS_SC = 6 * MiB;
constexpr size_t WS_SCAL = 7 * MiB;
constexpr size_t WS_WADA = 8 * MiB;
constexpr size_t WS_WIN = 20 * MiB;
constexpr size_t WS_WOUT = 34 * MiB;
constexpr size_t WS_H = 40 * MiB;
constexpr size_t SEG = 9 * MiB;
constexpr size_t WS_Q = 74 * MiB, WS_K = WS_Q + SEG, WS_V = WS_K + SEG, WS_GA = WS_V + SEG, WS_U = WS_GA + SEG, WS_VN = WS_U + SEG, WS_GB = WS_VN + SEG, WS_GC = WS_GB + SEG,
                 WS_QD = WS_GC + SEG, WS_KD = WS_QD + SEG, WS_VD = WS_KD + SEG, WS_GD = WS_VD + SEG;
constexpr size_t WS_GLU = 182 * MiB;
constexpr size_t WS_LF = 199 * MiB;
constexpr size_t WS_MIX = 216 * MiB;
constexpr size_t WS_R = 250 * MiB;
constexpr size_t WS_Y1 = 318 * MiB;
constexpr size_t WS_SLOC = 386 * MiB;
constexpr size_t WS_DTOT = 402 * MiB;
constexpr size_t WS_Z = 404 * MiB;
constexpr size_t WS_END = 644 * MiB;
constexpr int CW_BAR = 4096;
constexpr int RING_BYTES = 131072, MISC_OFF = RING_BYTES + 320, LDS_BYTES = 147456;

struct Args { const float* in[N_IN]; float* out; unsigned char* ws; int ph_lo, ph_hi; };

struct Ctx {
    const Args* a; unsigned char* wsb; LAS unsigned char* lds; int tid, lane, wave, G, bid;
    __device__ __forceinline__ int gw() const { return bid * NWAVES + wave; }
    __device__ __forceinline__ int ngw() const { return G * NWAVES; }
    template <class T> __device__ __forceinline__ T* ws(size_t off) const { return (T*)(wsb + off); }
};

__device__ __forceinline__ Ctx launder(const Ctx& C, Args& shadow) {
    Ctx P = C; int t; asm volatile("v_mbcnt_lo_u32_b32 %0, -1, 0\n\tv_mbcnt_hi_u32_b32 %0, -1, %0" : "=v"(t)); t += C.wave * 64; P.tid = t; P.lane = t & 63; P.wave = __builtin_amdgcn_readfirstlane(t >> 6);
    unsigned char* w = C.wsb; asm volatile("" : "+s"(w)); P.wsb = w;
    return P;
}
__device__ __forceinline__ f32x4 ld4(const float* p) { return *(const f32x4*)p; }
__device__ __forceinline__ void st4(float* p, f32x4 v) { *(f32x4*)p = v; }
__device__ __forceinline__ void st_bf4(bf16* p, f32x4 v) { v2u w; w.x = pk2(v.x, v.y); w.y = pk2(v.z, v.w); *(v2u*)p = w; }
__device__ __forceinline__ f32x4 ld_bf4(const bf16* p) { const v2u w = *(const v2u*)p; return (f32x4){bflo(w.x), bfhi(w.x), bflo(w.y), bfhi(w.y)}; }

template <class F> struct EpiF {
    static constexpr bool PERM = false, AFTER_DRAIN = false; F f;
    __device__ __forceinline__ void operator()(const pg8::f32x4 (&acc)[2][2][4][2], const pg8::Unit& u, int wr, int wc, int fr, int fq) const {
#pragma unroll
        for (int ai = 0; ai < 2; ++ai)
#pragma unroll
            for (int m = 0; m < 4; ++m) { const int row = u.pm * 256 + ai * 128 + wr * 64 + m * 16 + fr;
#pragma unroll
                for (int bj = 0; bj < 2; ++bj)
#pragma unroll
                    for (int n = 0; n < 2; ++n) { const int col = u.pn * 256 + bj * 128 + wc * 32 + n * 16 + 4 * fq; f(row, col, acc[ai][bj][m][n]); } }
    }
};

__device__ __forceinline__ void p0_transpose_item(const float* W, int K, int N, bf16* WT, int row_off, LAS float* scr, int item, int lane) {
    const int nblk = N / 32, kb = item / nblk, nb = item % nblk, k0 = 64 * kb, n0 = 32 * nb;
#pragma unroll 8
    for (int i = 0; i < 32; ++i) { const int kk = 2 * i + (lane >> 5); scr[kk * 33 + (lane & 31)] = W[(size_t)(k0 + kk) * N + n0 + (lane & 31)]; }
    LDS_WAIT(); asm volatile("" ::: "memory");
    const int c = lane & 7;
#pragma unroll
    for (int j = 0; j < 4; ++j) { const int n = (lane >> 3) + 8 * j; const LAS float* s = scr + (8 * c) * 33 + n;
        v4u o; o.x = pk2(s[0 * 33], s[1 * 33]); o.y = pk2(s[2 * 33], s[3 * 33]); o.z = pk2(s[4 * 33], s[5 * 33]); o.w = pk2(s[6 * 33], s[7 * 33]);
        *(GAS v4u*)(WT + (size_t)(row_off + n0 + n) * K + k0 + 8 * c) = o; }
    LDS_WAIT(); asm volatile("" ::: "memory");
}
__device__ __forceinline__ void p0_prologue(const Ctx& C) {
    const Args& A = *C.a;
    LAS float* scr = (LAS float*)(C.lds + C.wave * 16384);
    const int gw = C.gw(), NGW = C.ngw();
    constexpr int I_IN = 16 * (DIN / 32), I_OUT = 16 * 32, I_ADA = 16 * 96;
    constexpr int NITEMS = 2 * (I_IN + I_OUT + I_ADA);
    for (int it = gw; it < NITEMS; it += NGW) {
        int r = it; const int l = r & 1; r >>= 1;
        if (r < I_IN) { p0_transpose_item(A.in[I_WIN] + (size_t)l * DM * DIN, DM, DIN, C.ws<bf16>(WS_WIN) + (size_t)l * DIN * DM, 0, scr, r, C.lane); continue; } r -= I_IN;
        if (r < I_OUT) { p0_transpose_item(A.in[I_WOUT] + (size_t)l * DM * DM, DM, DM, C.ws<bf16>(WS_WOUT) + (size_t)l * DM * DM, 0, scr, r, C.lane); continue; } r -= I_OUT;
        p0_transpose_item(A.in[I_WADA] + (size_t)l * DM * 3072, DM, 3072, C.ws<bf16>(WS_WADA), l * 3072, scr, r, C.lane);
    }
    f32x2v* cs = C.ws<f32x2v>(WS_CS);
    for (int idx = gw * 64 + C.lane; idx < TSEQ * 16; idx += NGW * 64) {
        const int pos = idx >> 4, i = idx & 15;
        const double a = (double)pos * ROPE_INV[i];
        const double n = rint(a * 0.15915494309189535);
        const float r = (float)(a - n * 6.283185307179586);
        cs[idx] = (f32x2v){cosf(r), sinf(r)};
    }
    bf16* sc = C.ws<bf16>(WS_SC);
    for (int row = gw; row < 256; row += NGW) {
        const float* src = row < NBP ? A.in[I_CP] + (size_t)row * DM : A.in[I_CSM] + (size_t)(row - NBP) * DM;
#pragma unroll
        for (int j = 0; j < 4; ++j) { const int col = 4 * C.lane + 256 * j; f32x4 v = (f32x4){0.f, 0.f, 0.f, 0.f};
            if (row < NBT) { v = ld4(src + col); v.x = silu_f(v.x); v.y = silu_f(v.y); v.z = silu_f(v.z); v.w = silu_f(v.w); }
            st_bf4(sc + (size_t)row * DM + col, v); }
    }
    if (C.bid == 0 && C.wave == 0) {
        float* scal = C.ws<float>(WS_SCAL);
        const float* lq = A.in[I_LAMQK];
        for (int l = 0; l < 2; ++l) {
            float a = C.lane < 32 ? lq[(l * 4 + 0) * 32 + C.lane] * lq[(l * 4 + 1) * 32 + C.lane] : 0.f;
            float b = C.lane < 32 ? lq[(l * 4 + 2) * 32 + C.lane] * lq[(l * 4 + 3) * 32 + C.lane] : 0.f;
            a = wave_sum(a); b = wave_sum(b);
            const float lam_init = l == 0 ? 0.2f : 0.35550906759096934f;
            if (C.lane == 0) scal[l] = __expf(a) - __expf(b) + lam_init;
        }
        const float* lb = A.in[I_LB];
        for (int c = C.lane; c < 256; c += 64) { const float e0 = __expf(lb[c]), e1 = __expf(lb[256 + c]); scal[64 + c] = e1 / (e0 + e1); }
    }
}

__device__ __forceinline__ int batch_of(int m) { return m < MP ? (m >> 13) : NBP + ((m - MP) >> 3); }

__device__ __forceinline__ const float* xrow_in(const Ctx& C, int l, int m) {
    if (l == 0) return m < MP ? C.a->in[I_XP] + (size_t)m * DM : C.a->in[I_XS] + (size_t)(m - MP) * DM;
    return C.ws<float>(WS_Y1) + (size_t)m * DM;
}
__device__ __forceinline__ void ph_hbuild(const Ctx& C, int l) {
    const float* mod = C.ws<float>(WS_MOD); bf16* H = C.ws<bf16>(WS_H);
    for (int m = C.gw(); m < MT; m += C.ngw()) {
        const float* xr = xrow_in(C, l, m); const float* md = mod + (size_t)(l * NBT + batch_of(m)) * 3072;
#pragma unroll
        for (int j = 0; j < 4; ++j) { const int col = 4 * C.lane + 256 * j;
            const f32x4 v = ld4(xr + col), sh = ld4(md + col), sc = ld4(md + 1024 + col);
            st_bf4(H + (size_t)m * DM + col, v * (1.f + sc) + sh); }
    }
}

__device__ __forceinline__ void ph_post(const Ctx& C, int l) {
    const Args& A = *C.a; const int lane = C.lane, c4 = 4 * lane;
    const float* Z = C.ws<float>(WS_Z); const f32x2v* CS = C.ws<f32x2v>(WS_CS); const float* scal = C.ws<float>(WS_SCAL);
    bf16 *Qb = C.ws<bf16>(WS_Q), *Kb = C.ws<bf16>(WS_K), *Vb = C.ws<bf16>(WS_V), *GA = C.ws<bf16>(WS_GA), *U = C.ws<bf16>(WS_U), *VN = C.ws<bf16>(WS_VN), *GB = C.ws<bf16>(WS_GB),
         *GC = C.ws<bf16>(WS_GC), *QD = C.ws<bf16>(WS_QD), *KD = C.ws<bf16>(WS_KD), *VD = C.ws<bf16>(WS_VD), *GD = C.ws<bf16>(WS_GD);
    float *GLU = C.ws<float>(WS_GLU), *LF = C.ws<float>(WS_LF); float* out = A.out;
    const f32x4 sg_g = ld4(A.in[I_SGG] + l * 256 + c4), sg_b = ld4(A.in[I_SGB] + l * 256 + c4);
    f32x4 lb = (f32x4){0.f, 0.f, 0.f, 0.f}; if (l == 1) lb = ld4(scal + 64 + c4);
    const float sgn = (lane & 4) ? 1.f : -1.f;
    for (int m = C.gw(); m < MT; m += C.ngw()) {
        const float* z = Z + (size_t)m * DIN; const size_t mo = (size_t)m * 256 + c4;
        const bool samp = m >= MP; const int r = m - MP;
        const int pos = samp ? PAST + (r & 7) : (m & (TSEQ - 1));
        float *ok, *ov;
        if (!samp) { const size_t o = ((size_t)l * MP + m) * 256 + c4; ok = out + O_KP + o; ov = out + O_VP + o; }
        else { const size_t o = ((size_t)l * MS + r) * 256 + c4; ok = out + O_KS + o; ov = out + O_VS + o; }
        const f32x4 cs0 = *(const f32x4*)(CS + pos * 16 + 4 * (lane & 3)), cs1 = *(const f32x4*)(CS + pos * 16 + 4 * (lane & 3) + 2);
        const f32x4 cosv = (f32x4){cs0.x, cs0.z, cs1.x, cs1.z}, sinv = (f32x4){cs0.y, cs0.w, cs1.y, cs1.w};
        {
            const f32x4 v = ld4(z + c4); f32x4 p; p.x = __shfl_xor(v.x, 4); p.y = __shfl_xor(v.y, 4); p.z = __shfl_xor(v.z, 4); p.w = __shfl_xor(v.w, 4);
            const f32x4 o = v * cosv + (p * sinv) * sgn; st_bf4(Qb + mo, o * QSCALE);
        }
        {
            const f32x4 v = ld4(z + 256 + c4); f32x4 p; p.x = __shfl_xor(v.x, 4); p.y = __shfl_xor(v.y, 4); p.z = __shfl_xor(v.z, 4); p.w = __shfl_xor(v.w, 4);
            const f32x4 o = v * cosv + (p * sinv) * sgn; st4(ok, o); st_bf4(Kb + mo, o);
        }
        { const f32x4 v = ld4(z + 512 + c4); st4(ov, v); st_bf4(Vb + mo, v); }
        { const f32x4 v = ld4(z + 768 + c4); st_bf4(GA + mo, (f32x4){silu_f(v.x), silu_f(v.y), silu_f(v.z), silu_f(v.w)}); }
        { const f32x4 v = ld4(z + 1024 + c4); st_bf4(U + mo, (f32x4){gelu_f(v.x), gelu_f(v.y), gelu_f(v.z), gelu_f(v.w)}); }
        {
            f32x4 v = ld4(z + 1280 + c4); v = (f32x4){gelu_f(v.x), gelu_f(v.y), gelu_f(v.z), gelu_f(v.w)};
            const float mean = wave_sum((v.x + v.y) + (v.z + v.w)) * (1.f / 256.f);
            const f32x4 d = v - mean; const float var = wave_sum((d.x * d.x + d.y * d.y) + (d.z * d.z + d.w * d.w)) * (1.f / 256.f);
            const f32x4 vn = d * rsqrtf(var + EPS) * sg_g + sg_b;
            st_bf4(VN + mo, vn);
            if (samp) st4(out + O_CH + ((size_t)l * MS + r) * 256 + c4, vn);
        }
        { const f32x4 v = ld4(z + 1536 + c4); st_bf4(GB + mo, (f32x4){silu_f(v.x), silu_f(v.y), silu_f(v.z), silu_f(v.w)}); }
        {
            const f32x4 a = ld4(z + 1792 + c4), g = ld4(z + 2048 + c4);
            const f32x4 glu = (f32x4){a.x * sigmoid_f(g.x), a.y * sigmoid_f(g.y), a.z * sigmoid_f(g.z), a.w * sigmoid_f(g.w)};
            st4(GLU + mo, glu);
            if (!samp) { const int t = m & (TSEQ - 1), b = m >> 13; if (t >= TSEQ - 30) st4(out + O_CP + ((size_t)(l * NBP + b) * 30 + (t - (TSEQ - 30))) * 256 + c4, glu); }
            else { const int bs = r >> 3, ts = r & 7; float* dst = out + O_CS + (size_t)(l * NBS + bs) * 30 * 256 + c4;
                st4(dst + (22 + ts) * 256, glu);
                if (ts == 0) { const float* sc = A.in[I_SCONV] + (size_t)(l * NBS + bs) * 30 * 256 + c4;
                    for (int j = 0; j < 22; ++j) st4(dst + j * 256, ld4(sc + (8 + j) * 256)); } }
        }
        { const f32x4 v = ld4(z + 2304 + c4); st_bf4(GC + mo, (f32x4){silu_f(v.x), silu_f(v.y), silu_f(v.z), silu_f(v.w)}); }
        { const f32x4 v = ld4(z + 2560 + c4); st_bf4(QD + mo, (f32x4){silu_f(v.x), silu_f(v.y), silu_f(v.z), silu_f(v.w)}); }
        {
            const f32x4 v = ld4(z + 2816 + c4); f32x4 f, lf;
            f.x = lb.x + (1.f - lb.x) * sigmoid_f(v.x); f.y = lb.y + (1.f - lb.y) * sigmoid_f(v.y); f.z = lb.z + (1.f - lb.z) * sigmoid_f(v.z); f.w = lb.w + (1.f - lb.w) * sigmoid_f(v.w);
            lf.x = __logf(fmaxf(f.x, 1e-30f)); lf.y = __logf(fmaxf(f.y, 1e-30f)); lf.z = __logf(fmaxf(f.z, 1e-30f)); lf.w = __logf(fmaxf(f.w, 1e-30f));
            st4(LF + mo, lf); st_bf4(KD + mo, 1.f - f);
        }
        { const f32x4 v = ld4(z + 3072 + c4); st_bf4(VD + mo, v); }
        { const f32x4 v = ld4(z + 3328 + c4); st_bf4(GD + mo, (f32x4){silu_f(v.x), silu_f(v.y), silu_f(v.z), silu_f(v.w)}); }
    }
}

__device__ __forceinline__ void sg_unit(const Ctx& C, int l, int u) {
    const Args& A = *C.a; const bf16 *U = C.ws<bf16>(WS_U), *VN = C.ws<bf16>(WS_VN), *GB = C.ws<bf16>(WS_GB); bf16* MIX = C.ws<bf16>(WS_MIX);
    const int col = C.tid & 255, th = C.tid >> 8, g = col >> 6;
    const float* w = A.in[I_WS] + (size_t)(l * 4 + g) * 128 * 128; const float* bs = A.in[I_BS] + (l * 4 + g) * 128;
    int m0, t0, t1;
    if (u < 128) { m0 = u * 128; t0 = th * 64; t1 = t0 + 64; } else { m0 = MP + (u - 128) * 8; t0 = th * 4; t1 = t0 + 4; }
    for (int t = t0; t < t1; ++t) {
        float acc = 0.f;
        for (int s = 0; s <= t; ++s) acc += w[t * 128 + s] * bf2f(VN[(size_t)(m0 + s) * 256 + col]);
        const size_t mo = (size_t)(m0 + t) * 256 + col;
        const float o = bf2f(U[mo]) * (acc + bs[t]) * bf2f(GB[mo]);
        MIX[(size_t)(m0 + t) * DM + 256 + col] = (bf16)f2bf(o);
    }
}

__device__ __forceinline__ void conv_unit(const Ctx& C, int l, int u) {
    const Args& A = *C.a; const float* GLU = C.ws<float>(WS_GLU); const bf16* GC = C.ws<bf16>(WS_GC); bf16* MIX = C.ws<bf16>(WS_MIX);
    LAS float* Ys = (LAS float*)C.lds;
    const int c = C.tid & 255, rh = C.tid >> 8, r0 = u * 16;
    const float* cw = A.in[I_CW] + (size_t)l * 31 * 256 + c; const float cb = A.in[I_CB][l * 256 + c];
    for (int i = 0; i < 8; ++i) {
        const int rr = rh * 8 + i, m = r0 + rr; float y = cb;
        if (m < MP) { const int t = m & (TSEQ - 1);
            for (int j = 0; j < 31; ++j) { const int tt = t + j - 30; if (tt >= 0) y += cw[j * 256] * GLU[(size_t)(m + j - 30) * 256 + c]; }
        } else { const int r = m - MP, bs = r >> 3, ts = r & 7; const float* sc = A.in[I_SCONV] + (size_t)(l * NBS + bs) * 30 * 256 + c;
            for (int j = 0; j < 31; ++j) { const int tt = ts + j - 30; const float h = tt >= 0 ? GLU[(size_t)(m + j - 30) * 256 + c] : sc[(ts + j) * 256]; y += cw[j * 256] * h; }
        }
        Ys[rr * 256 + c] = y;
    }
    __syncthreads();
    {
        const f32x4 g = ld4(A.in[I_CNG] + l * 256 + 4 * C.lane), b = ld4(A.in[I_CNB] + l * 256 + 4 * C.lane);
        for (int i = 0; i < 2; ++i) { const int rr = C.wave * 2 + i; LAS f32x4* p = (LAS f32x4*)(Ys + rr * 256) + C.lane; f32x4 v = *p;
            const float mean = wave_sum((v.x + v.y) + (v.z + v.w)) * (1.f / 256.f); const f32x4 d = v - mean;
            const float var = wave_sum((d.x * d.x + d.y * d.y) + (d.z * d.z + d.w * d.w)) * (1.f / 256.f);
            f32x4 y = d * rsqrtf(var + EPS) * g + b; y = (f32x4){silu_f(y.x), silu_f(y.y), silu_f(y.z), silu_f(y.w)}; *p = y; }
    }
    __syncthreads();
    {
        float acc[8];
#pragma unroll
        for (int i = 0; i < 8; ++i) acc[i] = 0.f;
        const float* wp = A.in[I_WPW] + (size_t)l * 256 * 256 + c;
        for (int k = 0; k < 256; k += 4) {
            const float w0 = wp[(k + 0) * 256], w1 = wp[(k + 1) * 256], w2 = wp[(k + 2) * 256], w3 = wp[(k + 3) * 256];
#pragma unroll
            for (int i = 0; i < 8; ++i) { const f32x4 y = *(const LAS f32x4*)(Ys + (rh * 8 + i) * 256 + k); acc[i] += y.x * w0 + y.y * w1 + y.z * w2 + y.w * w3; }
        }
#pragma unroll
        for (int i = 0; i < 8; ++i) { const int m = r0 + rh * 8 + i; MIX[(size_t)m * DM + 512 + c] = (bf16)f2bf(acc[i] * bf2f(GC[(size_t)m * 256 + c])); }
    }
    __syncthreads();
}

template <int MODE> __device__ __forceinline__ void hgrn_item(const Ctx& C, int l, int item) {
    const Args& A = *C.a; const int lane = C.lane;
    const float* LF = C.ws<float>(WS_LF); const bf16 *QD = C.ws<bf16>(WS_QD), *KD = C.ws<bf16>(WS_KD), *VD = C.ws<bf16>(WS_VD), *GD = C.ws<bf16>(WS_GD); bf16* MIX = C.ws<bf16>(WS_MIX);
    LAS float* Fs = (LAS float*)(C.lds + C.wave * 12288); LAS float* Ks = Fs + 1024; LAS float* Qs = Fs + 2048;
    int h, m0, ntok; size_t sidx;
    if (MODE == 2) { const int bs = item >> 2; h = item & 3; m0 = MP + bs * 8; ntok = 8; sidx = ((size_t)(l * NBS + bs) * 4 + h) * 4096; }
    else { const int bh = item >> 7, j = item & 127; h = bh & 3; m0 = (bh >> 2) * TSEQ + j * HG_L; ntok = HG_L; sidx = (size_t)item * 4096; }
    float S[64];
    if (MODE == 0) {
#pragma unroll
        for (int k = 0; k < 64; ++k) S[k] = 0.f;
    } else { const float* s0 = MODE == 2 ? A.in[I_SHGRN] + sidx : C.ws<float>(WS_SLOC) + sidx;
#pragma unroll
        for (int k = 0; k < 64; ++k) S[k] = s0[k * 64 + lane]; }
    const float gn = A.in[I_HNG][l * 64 + lane];
    float lfsum = 0.f;
    for (int c0 = 0; c0 < ntok; c0 += 16) {
        const int nt = (ntok - c0) < 16 ? (ntok - c0) : 16;
        for (int tt = 0; tt < nt; ++tt) { const size_t o = (size_t)(m0 + c0 + tt) * 256 + h * 64 + lane; const float lf = LF[o]; lfsum += lf;
            Fs[tt * 64 + lane] = __expf(lf); Ks[tt * 64 + lane] = bf2f(KD[o]); if (MODE != 0) Qs[tt * 64 + lane] = bf2f(QD[o]); }
        LDS_WAIT();
        for (int tt = 0; tt < nt; ++tt) {
            const int m = m0 + c0 + tt; const size_t o = (size_t)m * 256 + h * 64 + lane;
            const float vd = bf2f(VD[o]); float oacc = 0.f;
#pragma unroll
            for (int k4 = 0; k4 < 16; ++k4) {
                const f32x4 f = *(const LAS f32x4*)(Fs + tt * 64 + 4 * k4), kd = *(const LAS f32x4*)(Ks + tt * 64 + 4 * k4);
                S[4 * k4 + 0] = f.x * S[4 * k4 + 0] + kd.x * vd; S[4 * k4 + 1] = f.y * S[4 * k4 + 1] + kd.y * vd;
                S[4 * k4 + 2] = f.z * S[4 * k4 + 2] + kd.z * vd; S[4 * k4 + 3] = f.w * S[4 * k4 + 3] + kd.w * vd;
                if (MODE != 0) { const f32x4 q = *(const LAS f32x4*)(Qs + tt * 64 + 4 * k4);
                    oacc += S[4 * k4 + 0] * q.x + S[4 * k4 + 1] * q.y + S[4 * k4 + 2] * q.z + S[4 * k4 + 3] * q.w; }
            }
            if (MODE != 0) { const float ss = wave_sum(oacc * oacc) * (1.f / 64.f);
                const float on = oacc * rsqrtf(ss + EPS) * gn * bf2f(GD[o]);
                MIX[(size_t)m * DM + 768 + h * 64 + lane] = (bf16)f2bf(on); }
        }
        LDS_WAIT();
    }
    if (MODE == 0) { float* sl = C.ws<float>(WS_SLOC) + sidx;
#pragma unroll
        for (int k = 0; k < 64; ++k) sl[k * 64 + lane] = S[k];
        C.ws<float>(WS_DTOT)[(size_t)item * 64 + lane] = __expf(lfsum); }
    if (MODE == 2) { float* so = A.out + O_HS + sidx;
#pragma unroll
        for (int k = 0; k < 64; ++k) so[k * 64 + lane] = S[k]; }
}
__device__ __forceinline__ void hgrn_scan_unit(const Ctx& C, int l, int u) {
    const int idx = u * NTHR + C.tid, bh = idx >> 12, kv = idx & 4095, k = kv >> 6;
    float* sl = C.ws<float>(WS_SLOC) + (size_t)bh * HG_NB * 4096 + kv; const float* dt = C.ws<float>(WS_DTOT) + (size_t)bh * HG_NB * 64 + k;
    float S = 0.f;
#pragma unroll 8
    for (int j = 0; j < HG_NB; ++j) { const float a = sl[(size_t)j * 4096], d = dt[j * 64]; sl[(size_t)j * 4096] = S; S = d * S + a; }
    C.a->out[O_HP + ((size_t)l * 8 + bh) * 4096 + kv] = S;
}

__device__ __forceinline__ void attn_unit_naive(const Ctx& C, int l, int u) {
    const Args& A = *C.a; const bf16 *Qb = C.ws<bf16>(WS_Q), *Kb = C.ws<bf16>(WS_K), *Vb = C.ws<bf16>(WS_V), *GA = C.ws<bf16>(WS_GA); bf16* MIX = C.ws<bf16>(WS_MIX);
    const int bh = u & 7, qb = 31 - (u >> 3), b = bh >> 2, h = bh & 3;
    const int map = C.tid >> 8, qi = C.tid & 255, t = qb * 256 + qi; const size_t m = (size_t)b * TSEQ + t;
    LAS unsigned* Ksm = (LAS unsigned*)C.lds;
    LAS unsigned* Vsm = (LAS unsigned*)(C.lds + 32768);
    LAS float* O2 = (LAS float*)C.lds;
    float q[32], acc[64];
    { const v4u* qp = (const v4u*)(Qb + m * 256 + h * 64 + map * 32);
#pragma unroll
        for (int i = 0; i < 4; ++i) { const v4u w = qp[i]; q[8 * i] = bflo(w.x); q[8 * i + 1] = bfhi(w.x); q[8 * i + 2] = bflo(w.y); q[8 * i + 3] = bfhi(w.y); q[8 * i + 4] = bflo(w.z); q[8 * i + 5] = bfhi(w.z); q[8 * i + 6] = bflo(w.w); q[8 * i + 7] = bfhi(w.w); } }
#pragma unroll
    for (int d = 0; d < 64; ++d) acc[d] = 0.f;
    float mx = -1e30f, lsum = 0.f;
    for (int kt = 0; kt <= qb; ++kt) {
        __syncthreads();
        for (int p = C.tid; p < 4096; p += NTHR) { const int arr = p >> 11, row = (p >> 3) & 255, pc = p & 7;
            const bf16* src = (arr ? Vb : Kb) + ((size_t)b * TSEQ + kt * 256 + row) * 256 + h * 64 + pc * 8;
            *(LAS v4u*)((arr ? Vsm : Ksm) + row * 32 + pc * 4) = *(const v4u*)src; }
        __syncthreads();
        const int jn = (kt == qb) ? 256 : 256;
#pragma unroll 1
        for (int j = 0; j < jn; ++j) {
            if (kt * 256 + j > t) break;
            const LAS v4u* kp = (const LAS v4u*)(Ksm + j * 32 + map * 16);
            float s = 0.f;
#pragma unroll
            for (int i = 0; i < 4; ++i) { const v4u w = kp[i];
                s += q[8 * i] * bflo(w.x) + q[8 * i + 1] * bfhi(w.x) + q[8 * i + 2] * bflo(w.y) + q[8 * i + 3] * bfhi(w.y) + q[8 * i + 4] * bflo(w.z) + q[8 * i + 5] * bfhi(w.z) + q[8 * i + 6] * bflo(w.w) + q[8 * i + 7] * bfhi(w.w); }
            if (s > mx) { const float sc = exp2f(mx - s); lsum *= sc;
#pragma unroll
                for (int d = 0; d < 64; ++d) acc[d] *= sc;
                mx = s; }
            const float p = exp2f(s - mx); lsum += p;
            const LAS v4u* vp = (const LAS v4u*)(Vsm + j * 32);
#pragma unroll
            for (int i = 0; i < 8; ++i) { const v4u w = vp[i];
                acc[8 * i] += p * bflo(w.x); acc[8 * i + 1] += p * bfhi(w.x); acc[8 * i + 2] += p * bflo(w.y); acc[8 * i + 3] += p * bfhi(w.y);
                acc[8 * i + 4] += p * bflo(w.z); acc[8 * i + 5] += p * bfhi(w.z); acc[8 * i + 6] += p * bflo(w.w); acc[8 * i + 7] += p * bfhi(w.w); }
        }
    }
    __syncthreads();
    const float il = 1.f / lsum;
    if (map == 1) {
#pragma unroll
        for (int d = 0; d < 64; ++d) O2[qi * 65 + d] = acc[d] * il;
    }
    __syncthreads();
    if (map == 0) {
        const float lam = C.ws<float>(WS_SCAL)[l]; const float lam_init = l == 0 ? 0.2f : 0.35550906759096934f;
        float ss = 0.f;
#pragma unroll
        for (int d = 0; d < 64; ++d) { acc[d] = acc[d] * il - lam * O2[qi * 65 + d]; ss += acc[d] * acc[d]; }
        const float rs = rsqrtf(ss * (1.f / 64.f) + EPS) * (1.f - lam_init);
        const float* g = A.in[I_ANG] + l * 64;
#pragma unroll
        for (int d = 0; d < 64; d += 2) { const unsigned ga = *(const unsigned*)(GA + m * 256 + h * 64 + d);
            *(unsigned*)(MIX + m * DM + h * 64 + d) = pk2(acc[d] * rs * g[d] * bflo(ga), acc[d + 1] * rs * g[d + 1] * bfhi(ga)); }
    }
    __syncthreads();
}

__device__ __forceinline__ void attn_sample_item(const Ctx& C, int l, int item) {
    const Args& A = *C.a; const int lane = C.lane;
    const int ts = item & 7, h = (item >> 3) & 3, bs = item >> 5; const size_t m = (size_t)MP + bs * 8 + ts;
    const bf16 *Qb = C.ws<bf16>(WS_Q), *GA = C.ws<bf16>(WS_GA); bf16* MIX = C.ws<bf16>(WS_MIX);
    const int* pt = (const int*)A.in[I_PT] + bs * NPAGES;
    const float* ck = A.in[I_CK] + (size_t)l * NPOOL * PAGE * 256; const float* cv = A.in[I_CV] + (size_t)l * NPOOL * PAGE * 256;
    const float* nk = A.out + O_KS + ((size_t)l * MS + bs * 8) * 256 + h * 64; const float* nv = A.out + O_VS + ((size_t)l * MS + bs * 8) * 256 + h * 64;
    float o1[64];
#pragma unroll
    for (int d = 0; d < 64; ++d) o1[d] = 0.f;
    const float lam = C.ws<float>(WS_SCAL)[l]; const float lam_init = l == 0 ? 0.2f : 0.35550906759096934f;
#pragma unroll 1
    for (int map = 0; map < 2; ++map) {
        float q[32], acc[64];
        { const v4u* qp = (const v4u*)(Qb + m * 256 + h * 64 + map * 32);
#pragma unroll
            for (int i = 0; i < 4; ++i) { const v4u w = qp[i]; q[8 * i] = bflo(w.x); q[8 * i + 1] = bfhi(w.x); q[8 * i + 2] = bflo(w.y); q[8 * i + 3] = bfhi(w.y); q[8 * i + 4] = bflo(w.z); q[8 * i + 5] = bfhi(w.z); q[8 * i + 6] = bflo(w.w); q[8 * i + 7] = bfhi(w.w); } }
#pragma unroll
        for (int d = 0; d < 64; ++d) acc[d] = 0.f;
        float mx = -1e30f, lsum = 0.f;
        for (int kk = lane; kk < PAST + 1 + ts; kk += 64) {
            const float *kr, *vr;
            if (kk < PAST) { const int page = pt[kk >> 7]; const size_t ro = (((size_t)page * PAGE + (kk & 127)) * 4 + h) * 64; kr = ck + ro; vr = cv + ro; }
            else { kr = nk + (size_t)(kk - PAST) * 256; vr = nv + (size_t)(kk - PAST) * 256; }
            float s = 0.f;
#pragma unroll
            for (int i = 0; i < 8; ++i) { const f32x4 w = ld4(kr + map * 32 + 4 * i); s += q[4 * i] * w.x + q[4 * i + 1] * w.y + q[4 * i + 2] * w.z + q[4 * i + 3] * w.w; }
            if (s > mx) { const float sc = exp2f(mx - s); lsum *= sc;
#pragma unroll
                for (int d = 0; d < 64; ++d) acc[d] *= sc;
                mx = s; }
            const float p = exp2f(s - mx); lsum += p;
#pragma unroll
            for (int i = 0; i < 16; ++i) { const f32x4 w = ld4(vr + 4 * i); acc[4 * i] += p * w.x; acc[4 * i + 1] += p * w.y; acc[4 * i + 2] += p * w.z; acc[4 * i + 3] += p * w.w; }
        }
        const float M = wave_max(mx); const float w = exp2f(mx - M); const float L = wave_sum(lsum * w); const float il = 1.f / L;
        const float coef = map == 0 ? il : -lam * il;
#pragma unroll
        for (int d = 0; d < 64; ++d) o1[d] += wave_sum(acc[d] * w) * coef;
    }
    float ss = 0.f;
#pragma unroll
    for (int d = 0; d < 64; ++d) ss += o1[d] * o1[d];
    const float rs = rsqrtf(ss * (1.f / 64.f) + EPS) * (1.f - lam_init);
    float mine = 0.f;
#pragma unroll
    for (int d = 0; d < 64; ++d) mine = (lane == d) ? o1[d] : mine;
    const float o = mine * rs * A.in[I_ANG][l * 64 + lane] * bf2f(GA[m * 256 + h * 64 + lane]);
    MIX[m * DM + h * 64 + lane] = (bf16)f2bf(o);
}

__device__ __forceinline__ void ph_ln(const Ctx& C, int l) {
    const float* R = C.ws<float>(WS_R); float* Y = l == 0 ? C.ws<float>(WS_Y1) : C.a->out;
    const float* g = C.a->in[I_LNG] + l * DM; const float* b = C.a->in[I_LNB] + l * DM;
    for (int m = C.gw(); m < MT; m += C.ngw()) {
        f32x4 v[4]; float s = 0.f;
#pragma unroll
        for (int j = 0; j < 4; ++j) { v[j] = ld4(R + (size_t)m * DM + 4 * C.lane + 256 * j); s += (v[j].x + v[j].y) + (v[j].z + v[j].w); }
        const float mean = wave_sum(s) * (1.f / DM); float s2 = 0.f;
#pragma unroll
        for (int j = 0; j < 4; ++j) { v[j] = v[j] - mean; s2 += (v[j].x * v[j].x + v[j].y * v[j].y) + (v[j].z * v[j].z + v[j].w * v[j].w); }
        const float rstd = rsqrtf(wave_sum(s2) * (1.f / DM) + EPS);
#pragma unroll
        for (int j = 0; j < 4; ++j) { const int col = 4 * C.lane + 256 * j; st4(Y + (size_t)m * DM + col, v[j] * rstd * ld4(g + col) + ld4(b + col)); }
    }
}

constexpr int NPL = 8, NPH = 2 + 2 * NPL;
#ifndef MK_ONE_LAUNCH
#define MK_ONE_LAUNCH 0
#endif
__global__ void __launch_bounds__(NTHR, 2) mk_fwd(Args args) {
    extern __shared__ __attribute__((aligned(16))) unsigned char lds[];
    Ctx C; C.a = &args; C.wsb = args.ws; C.lds = (LAS unsigned char*)lds; C.tid = threadIdx.x; C.lane = C.tid & 63; C.wave = __builtin_amdgcn_readfirstlane(C.tid >> 6); C.G = gridDim.x; C.bid = blockIdx.x;
    volatile LAS unsigned* MISC = (volatile LAS unsigned*)(C.lds + MISC_OFF);
    for (int u = C.tid; u < (LDS_BYTES - RING_BYTES) / 4; u += NTHR) ((LAS unsigned*)(C.lds + RING_BYTES))[u] = 0u;
    __syncthreads();
    XcdBarrier bar; bar.bar = (unsigned*)(args.ws + WS_CTL) + CW_BAR; bar.x = 0; bar.st = nullptr;
    if (MK_ONE_LAUNCH) bar = xcd_barrier_post((unsigned*)(args.ws + WS_CTL) + CW_BAR, MISC + 8);
    const int lo = args.ph_lo, hi = args.ph_hi;
#ifndef MK_MASK
#define MK_MASK 0x3ff
#endif
#define ON(j) ((MK_MASK >> (j)) & 1)
#define IN(k) (lo <= (k) && (k) < hi)
#define SEAM(k) do { if (MK_ONE_LAUNCH && IN(k) && IN((k) + 1)) xcd_barrier(bar); } while (0)

    if (ON(8) && IN(0)) { const Ctx P = launder(C, args); p0_prologue(P); } SEAM(0);
    if (ON(9) && IN(1)) {
        const Ctx P = launder(C, args);
        pg8::Gemm g{P.ws<bf16>(WS_SC), P.ws<bf16>(WS_WADA), 256, 6144, DM}; pg8::StaticOrder S; S.init(256, 6144, P.G, P.bid);
        float* mod = P.ws<float>(WS_MOD); const float* bada = args.in[I_BADA];
        auto f = [=](int row, int col, const pg8::f32x4& v) { if (row < NBT) { const int l = col >= 3072 ? 1 : 0, j = col - l * 3072; st4(mod + (size_t)(l * NBT + row) * 3072 + j, v + ld4(bada + col)); } };
        EpiF<decltype(f)> E{f};
        pg8::gemm_phase<EpiF<decltype(f)>, pg8::StaticOrder, PG8_ALIGN, PG8_SP2>(P.lds, g, S, E, P.tid);
    } SEAM(1);
#pragma unroll 1
    for (int l = 0; l < 2; ++l) {
        const int pb = 2 + l * NPL;
        if (ON(0) && IN(pb + 0)) { const Ctx P = launder(C, args); ph_hbuild(P, l); } SEAM(pb + 0);
        if (ON(1) && IN(pb + 1)) {
            const Ctx P = launder(C, args);
            pg8::Gemm g{P.ws<bf16>(WS_H), P.ws<bf16>(WS_WIN) + (size_t)l * DIN * DM, MT, DIN, DM}; pg8::StaticOrder S; S.init(MT, DIN, P.G, P.bid);
            float* Z = P.ws<float>(WS_Z);
            auto f = [=](int row, int col, const pg8::f32x4& v) { st4(Z + (size_t)row * DIN + col, v); };
            EpiF<decltype(f)> E{f};
            pg8::gemm_phase<EpiF<decltype(f)>, pg8::StaticOrder, PG8_ALIGN, PG8_SP2>(P.lds, g, S, E, P.tid);
        } SEAM(pb + 1);
        if (ON(2) && IN(pb + 2)) { const Ctx P = launder(C, args); ph_post(P, l); } SEAM(pb + 2);
        if (ON(3) && IN(pb + 3)) {
            const Ctx P = launder(C, args);
            for (int u = P.bid; u < 256 + 1088 + 128; u += P.G) {
                if (u < 256) sg_unit(P, l, u);
                else if (u < 256 + 1088) conv_unit(P, l, u - 256);
                else hgrn_item<0>(P, l, (u - 256 - 1088) * NWAVES + P.wave);
            }
        } SEAM(pb + 3);
        if (ON(4) && IN(pb + 4)) {
            const Ctx P = launder(C, args);
            for (int u = P.bid; u < 64 + 256 + 512; u += P.G) {
                if (u < 64) hgrn_scan_unit(P, l, u);
                else if (u < 64 + 256) attn_unit_naive(P, l, u - 64);
                else attn_sample_item(P, l, (u - 64 - 256) * NWAVES + P.wave);
            }
        } SEAM(pb + 4);
        if (ON(5) && IN(pb + 5)) {
            const Ctx P = launder(C, args);
            for (int u = P.bid; u < 128 + 64; u += P.G) {
                if (u < 128) hgrn_item<1>(P, l, u * NWAVES + P.wave);
                else hgrn_item<2>(P, l, (u - 128) * NWAVES + P.wave);
            }
        } SEAM(pb + 5);
        if (ON(6) && IN(pb + 6)) {
            const Ctx P = launder(C, args);
            pg8::Gemm g{P.ws<bf16>(WS_MIX), P.ws<bf16>(WS_WOUT) + (size_t)l * DM * DM, MT, DM, DM}; pg8::StaticOrder S; S.init(MT, DM, P.G, P.bid);
            float* R = P.ws<float>(WS_R); const float* mod = P.ws<float>(WS_MOD); const Ctx* Cp = &P;
            auto f = [=](int row, int col, const pg8::f32x4& v) { const f32x4 x = ld4(xrow_in(*Cp, l, row) + col), gt = ld4(mod + (size_t)(l * NBT + batch_of(row)) * 3072 + 2048 + col);
                st4(R + (size_t)row * DM + col, x * ALPHA + gt * v); };
            EpiF<decltype(f)> E{f};
            pg8::gemm_phase<EpiF<decltype(f)>, pg8::StaticOrder, PG8_ALIGN, PG8_SP2>(P.lds, g, S, E, P.tid);
        } SEAM(pb + 6);
        if (ON(7) && IN(pb + 7)) { const Ctx P = launder(C, args); ph_ln(P, l); } SEAM(pb + 7);
    }
#undef IN
#undef SEAM
}

extern "C" void kernel_launch(void* const* d_in, const int* in_sizes, int n_in, void* d_out, int out_size, void* d_ws, size_t ws_size, hipStream_t stream) {
    static int grid = 0;
    if (grid == 0) {
        if (n_in != N_IN || out_size != (int)O_END || ws_size < WS_END) { fprintf(stderr, "kernel_launch: unexpected shapes (n_in %d out %d ws %zu)\n", n_in, out_size, ws_size); grid = -1; return; }
        int dev = 0, cus = 0, per_cu = 0;
        if (hipGetDevice(&dev) != hipSuccess || hipDeviceGetAttribute(&cus, hipDeviceAttributeMultiprocessorCount, dev) != hipSuccess) { grid = -1; return; }
        if (hipFuncSetAttribute((const void*)mk_fwd, hipFuncAttributeMaxDynamicSharedMemorySize, LDS_BYTES) != hipSuccess) { fprintf(stderr, "kernel_launch: hipFuncSetAttribute failed\n"); grid = -1; return; }
        if (hipOccupancyMaxActiveBlocksPerMultiprocessor(&per_cu, (const void*)mk_fwd, NTHR, LDS_BYTES) != hipSuccess || per_cu < 1) fprintf(stderr, "kernel_launch: occupancy query says %d\n", per_cu);
        (void)hipGetLastError();
        grid = cus;
    }
    if (grid < 0) return;
    if (hipMemsetAsync((char*)d_ws + WS_CTL, 0, CTL_ZERO_BYTES, stream) != hipSuccess) return;
    Args a{};
    for (int i = 0; i < N_IN; ++i) a.in[i] = (const float*)d_in[i];
    a.out = (float*)d_out; a.ws = (unsigned char*)d_ws;
#if MK_ONE_LAUNCH
    a.ph_lo = 0; a.ph_hi = NPH;
    hipLaunchKernelGGL(mk_fwd, dim3(grid), dim3(NTHR), LDS_BYTES, stream, a);
#else
    for (int p = 0; p < NPH; ++p) { a.ph_lo = p; a.ph_hi = p + 1; hipLaunchKernelGGL(mk_fwd, dim3(grid), dim3(NTHR), LDS_BYTES, stream, a); }
#endif
}
```

```cpp
#include <hip/hip_runtime.h>
#include <cstdio>
#include <cstdint>
namespace pg8 {
#define PG8_LAS __attribute__((address_space(3)))
typedef unsigned short bf16_t;
typedef short bf16x8 __attribute__((ext_vector_type(8)));
typedef float f32x4 __attribute__((ext_vector_type(4)));
typedef unsigned u32x4 __attribute__((ext_vector_type(4)));
constexpr int BM = 256, BK = 64, HALF = 128, HTB = HALF * BK * 2  , STAGE_BYTES = 8 * HTB, NXCD = 8, WGM = 8;

__host__ __device__ __forceinline__ int lds_byte(int r, int c) { const int st = (r >> 4) * 2 + (c >> 5), rr = r & 15, cc = c & 31, ob = rr * 64 + cc * 2; return st * 1024 + (ob ^ (((ob >> 9) & 1) << 5)); }
__host__ __device__ __forceinline__ void stage_rc(int b, int& R, int& C) { const int st = b / 1024, sb = b % 1024, swz = sb ^ (((sb >> 9) & 1) << 5); R = (st >> 1) * 16 + swz / 64; C = (st & 1) * 32 + (swz % 64) / 2; }
__host__ __device__ __forceinline__ int perm32(int rho) { const int n = rho >> 4, i = rho & 15; return 8 * (i >> 2) + 4 * n + (i & 3); }

struct Unit { int pm, pn; };
struct Gemm { const bf16_t* A; const bf16_t* Bt; int M, N, K; int ld = 0; };

struct StaticOrder {
    int nM, nN, nwg, G, c;
    __host__ __device__ void init(int M, int N, int G_, int c_) { nM = M / BM; nN = N / BM; nwg = nM * nN; G = G_; c = c_; }
    __host__ __device__ bool next(int i, Unit& u) const {
        const long L = (long)i * G + c; if (L >= nwg) return false;
        int wgid = (int)L; { const int q = nwg / NXCD, r = nwg % NXCD, xcd = wgid % NXCD, off = wgid / NXCD; wgid = (xcd < r ? xcd * (q + 1) : r * (q + 1) + (xcd - r) * q) + off; }
        const int nig = WGM * nN, gid = wgid / nig, fm = gid * WGM, gsz = (nM - fm) < WGM ? (nM - fm) : WGM;
        u.pm = fm + ((wgid % nig) % gsz); u.pn = (wgid % nig) / gsz; return true;
    }
    __device__ __forceinline__ void a_ready(const Unit&) const {}
    __device__ __forceinline__ void done(const Unit&) const {}
};

__device__ __forceinline__ unsigned cvt_pk_bf16(float lo, float hi) { unsigned r; asm volatile("v_cvt_pk_bf16_f32 %0, %1, %2" : "=v"(r) : "v"(lo), "v"(hi)); return r; }
typedef float f32x2 __attribute__((ext_vector_type(2)));
__device__ __forceinline__ f32x2 gelu_pk(f32x2 v) {
    const f32x2 av = __builtin_elementwise_abs(v), d = av * 0.2316418882f + 1.0f;
    f32x2 t; t.x = __builtin_amdgcn_rcpf(d.x); t.y = __builtin_amdgcn_rcpf(d.y);
    f32x2 q = t * 0.5307027145f + (-0.7265760135f); q = q * t + 0.7107068705f; q = q * t + (-0.142248368f); q = q * t + 0.127414796f; q = q * t;
    const f32x2 s = (v * v) * (-0.72134752044f);
    f32x2 e; e.x = __builtin_amdgcn_exp2f(s.x); e.y = __builtin_amdgcn_exp2f(s.y);
    const f32x2 m = v * (q * e), r = v - m;
    f32x2 o; o.x = v.x < 0.f ? m.x : r.x; o.y = v.y < 0.f ? m.y : r.y; return o;
}
template <class Epi, class Sched, bool ALIGN_EPI = false, bool SP2 = false>
__device__ __forceinline__ void gemm_phase(PG8_LAS unsigned char* lds, const Gemm g, const Sched& S, const Epi& E, const int tid) {
    const int wid = __builtin_amdgcn_readfirstlane(tid >> 6), lane = tid & 63, wr = wid >> 2, wc = wid & 3, fr = lane & 15, fq = lane >> 4;
    const int K = g.K, LD = g.ld ? g.ld : g.K, nt = K / BK;
    unsigned voffA[2], voffB[2];
#pragma unroll
    for (int i = 0; i < 2; ++i) { int R, C; stage_rc(tid * 16 + i * 8192, R, C); const int Rb = Epi::PERM ? ((R & ~31) + perm32(R & 31)) : R;
        voffA[i] = (unsigned)(R * LD + C) * 2u; voffB[i] = (unsigned)(Rb * LD + C) * 2u; }
    const size_t kstep = (size_t)(BK * 2);
    const size_t hstep = (size_t)HALF * LD * 2;
    const size_t tstep = 2 * hstep;
    const unsigned ldsw = (unsigned)wid * 1024u;
    const int aoff = lds_byte(wr * 64 + fr, fq * 8), boff = lds_byte(wc * 32 + fr, fq * 8);
#define PG8_SA(b, h) (((b) * 2 + (h)) * HTB)
#define PG8_SB(b, h) ((4 + (b) * 2 + (h)) * HTB)
#define PG8_STAGE(bufoff, gbase, voff) do { _Pragma("unroll") for (int _i = 0; _i < 2; ++_i) \
        __builtin_amdgcn_global_load_lds((const unsigned*)((const char*)(gbase) + (voff)[_i]), (PG8_LAS unsigned*)(lds + (bufoff) + ldsw + _i * 8192), 16, 0, 0); } while (0)
#define PG8_LDA(dst, b, h) do { _Pragma("unroll") for (int m = 0; m < 4; ++m) _Pragma("unroll") for (int k = 0; k < 2; ++k) dst[m][k] = *(const PG8_LAS bf16x8*)(lds + PG8_SA(b, h) + aoff + m * 2048 + k * 1024); } while (0)
#define PG8_LDB(dst, b, h) do { _Pragma("unroll") for (int n = 0; n < 2; ++n) _Pragma("unroll") for (int k = 0; k < 2; ++k) dst[n][k] = *(const PG8_LAS bf16x8*)(lds + PG8_SB(b, h) + boff + n * 2048 + k * 1024); } while (0)
#define PG8_MMA(ai, bj, At, Bt) do { __builtin_amdgcn_s_setprio(1); _Pragma("unroll") for (int m = 0; m < 4; ++m) _Pragma("unroll") for (int n = 0; n < 2; ++n) _Pragma("unroll") for (int k = 0; k < 2; ++k) \
        acc[ai][bj][m][n] = __builtin_amdgcn_mfma_f32_16x16x32_bf16(Bt[n][k], At[m][k], acc[ai][bj][m][n], 0, 0, 0); __builtin_amdgcn_s_setprio(0); } while (0)
#define PG8_WAIT_V(n) asm volatile("s_waitcnt vmcnt(" #n ")" ::: "memory")
#define PG8_WAIT_L(n) asm volatile("s_waitcnt lgkmcnt(" #n ")" ::: "memory")
#define PG8_BAR __builtin_amdgcn_s_barrier()
#define PG8_SCHED __builtin_amdgcn_sched_barrier(0)
    Unit cur, nxt; int ui = 0;
    if (!S.next(0, cur)) return;
    f32x4 acc[2][2][4][2];
#pragma unroll
    for (int a = 0; a < 2; ++a)
#pragma unroll
        for (int b = 0; b < 2; ++b)
#pragma unroll
            for (int m = 0; m < 4; ++m)
#pragma unroll
                for (int n = 0; n < 2; ++n) acc[a][b][m][n] = (f32x4){0.f, 0.f, 0.f, 0.f};
    bf16x8 At[4][2], B0[2][2], B1[2][2];
    const char* cA = (const char*)g.A + (size_t)cur.pm * tstep; const char* cB = (const char*)g.Bt + (size_t)cur.pn * tstep;
    S.a_ready(cur);
    if constexpr (SP2) {
        PG8_STAGE(PG8_SB(0, 0), cB, voffB); PG8_STAGE(PG8_SB(0, 1), cB + hstep, voffB); PG8_STAGE(PG8_SA(0, 0), cA, voffA); PG8_STAGE(PG8_SA(0, 1), cA + hstep, voffA);
        if (wr == 1) PG8_BAR;
        PG8_WAIT_V(2); PG8_BAR;
        PG8_STAGE(PG8_SB(1, 0), cB + kstep, voffB); PG8_STAGE(PG8_SA(1, 0), cA + kstep, voffA); PG8_STAGE(PG8_SB(1, 1), cB + hstep + kstep, voffB);
        PG8_WAIT_V(6); PG8_BAR;
    } else {
        PG8_STAGE(PG8_SB(0, 0), cB, voffB); PG8_STAGE(PG8_SA(0, 0), cA, voffA); PG8_STAGE(PG8_SB(0, 1), cB + hstep, voffB); PG8_STAGE(PG8_SA(0, 1), cA + hstep, voffA);
        if (wr == 1) PG8_BAR;
        PG8_WAIT_V(4); PG8_BAR;
        PG8_STAGE(PG8_SB(1, 0), cB + kstep, voffB); PG8_STAGE(PG8_SA(1, 0), cA + kstep, voffA); PG8_STAGE(PG8_SB(1, 1), cB + hstep + kstep, voffB);
        PG8_WAIT_V(6); PG8_BAR;
    }
    for (;;) {
        const bool has_next = S.next(ui + 1, nxt);
        const char* nA = has_next ? (const char*)g.A + (size_t)nxt.pm * tstep : cA; const char* nB = has_next ? (const char*)g.Bt + (size_t)nxt.pn * tstep : cB;
        for (int t = 0; t < nt; t += 2) {
            const bool last = (t == nt - 2);
            const char* a1 = cA + (size_t)(t + 1) * kstep;
            const char* a2 = last ? nA : cA + (size_t)(t + 2) * kstep; const char* b2 = last ? nB : cB + (size_t)(t + 2) * kstep;
            const char* a3 = a2 + kstep; const char* b3 = b2 + kstep;
            if (last && has_next) S.a_ready(nxt);
            if constexpr (SP2) {
            PG8_LDB(B0, 0, 0); PG8_LDB(B1, 0, 1); PG8_SCHED; PG8_LDA(At, 0, 0); PG8_STAGE(PG8_SA(1, 1), a1 + hstep, voffA);
            PG8_WAIT_V(8); PG8_WAIT_L(0); PG8_BAR; PG8_MMA(0, 0, At, B0); PG8_MMA(0, 1, At, B1); PG8_BAR; PG8_SCHED;
            PG8_LDA(At, 0, 1); PG8_STAGE(PG8_SB(0, 0), b2, voffB); PG8_STAGE(PG8_SB(0, 1), b2 + hstep, voffB); PG8_STAGE(PG8_SA(0, 0), a2, voffA);
            PG8_WAIT_V(8); PG8_WAIT_L(0); PG8_BAR; PG8_MMA(1, 0, At, B0); PG8_MMA(1, 1, At, B1); PG8_BAR; PG8_SCHED;
            PG8_LDB(B0, 1, 0); PG8_LDB(B1, 1, 1); PG8_SCHED; PG8_LDA(At, 1, 0); PG8_STAGE(PG8_SA(0, 1), a2 + hstep, voffA);
            PG8_WAIT_V(8); PG8_WAIT_L(0); PG8_BAR; PG8_MMA(0, 0, At, B0); PG8_MMA(0, 1, At, B1); PG8_BAR; PG8_SCHED;
            PG8_LDA(At, 1, 1); PG8_STAGE(PG8_SB(1, 0), b3, voffB); PG8_STAGE(PG8_SB(1, 1), b3 + hstep, voffB); PG8_STAGE(PG8_SA(1, 0), a3, voffA);
            PG8_WAIT_V(8); PG8_WAIT_L(0); PG8_BAR; PG8_MMA(1, 0, At, B0); PG8_MMA(1, 1, At, B1); PG8_BAR; PG8_SCHED;
            } else {
            PG8_LDB(B0, 0, 0); PG8_SCHED; PG8_LDA(At, 0, 0); PG8_STAGE(PG8_SA(1, 1), a1 + hstep, voffA);
            PG8_WAIT_L(8); PG8_BAR; PG8_WAIT_L(0); PG8_MMA(0, 0, At, B0); PG8_BAR; PG8_SCHED;
            PG8_LDB(B1, 0, 1); PG8_STAGE(PG8_SB(0, 0), b2, voffB);
            PG8_BAR; PG8_WAIT_L(0); PG8_MMA(0, 1, At, B1); PG8_BAR;
            PG8_LDA(At, 0, 1); PG8_STAGE(PG8_SA(0, 0), a2, voffA);
            PG8_BAR; PG8_WAIT_L(0); PG8_MMA(1, 0, At, B0); PG8_BAR; PG8_SCHED;
            PG8_STAGE(PG8_SB(0, 1), b2 + hstep, voffB);
            PG8_WAIT_V(6); PG8_BAR; PG8_MMA(1, 1, At, B1); PG8_BAR;
            PG8_LDB(B0, 1, 0); PG8_SCHED; PG8_LDA(At, 1, 0); PG8_STAGE(PG8_SA(0, 1), a2 + hstep, voffA);
            PG8_WAIT_L(8); PG8_BAR; PG8_WAIT_L(0); PG8_MMA(0, 0, At, B0); PG8_BAR; PG8_SCHED;
            PG8_LDB(B1, 1, 1); PG8_STAGE(PG8_SB(1, 0), b3, voffB);
            PG8_BAR; PG8_WAIT_L(0); PG8_MMA(0, 1, At, B1); PG8_BAR;
            PG8_LDA(At, 1, 1); PG8_STAGE(PG8_SA(1, 0), a3, voffA);
            PG8_BAR; PG8_WAIT_L(0); PG8_MMA(1, 0, At, B0); PG8_BAR; PG8_SCHED;
            PG8_STAGE(PG8_SB(1, 1), b3 + hstep, voffB);
            PG8_WAIT_V(6); PG8_BAR; PG8_MMA(1, 1, At, B1); PG8_BAR;
            }
        }
        if constexpr (ALIGN_EPI) { if (wr == 0) PG8_BAR; }
        if constexpr (!Epi::AFTER_DRAIN) { E(acc, cur, wr, wc, fr, fq); S.done(cur); }
        if (!has_next) break;
#pragma unroll
        for (int a = 0; a < 2; ++a)
#pragma unroll
            for (int b = 0; b < 2; ++b)
#pragma unroll
                for (int m = 0; m < 4; ++m)
#pragma unroll
                    for (int n = 0; n < 2; ++n) acc[a][b][m][n] = (f32x4){0.f, 0.f, 0.f, 0.f};
        cur = nxt; cA = nA; cB = nB; ++ui;
        if constexpr (ALIGN_EPI) { if (wr == 1) PG8_BAR; }
    }
    PG8_WAIT_V(0);
    if constexpr (!ALIGN_EPI) { if (wr == 0) PG8_BAR; }
    PG8_BAR;
    if constexpr (Epi::AFTER_DRAIN) { E.fused(acc, cur, wr, wc, fr, fq, lds, wid, lane); S.done(cur); }
#undef PG8_SA
#undef PG8_SB
#undef PG8_STAGE
#undef PG8_LDA
#undef PG8_LDB
#undef PG8_MMA
#undef PG8_WAIT_V
#undef PG8_WAIT_L
#undef PG8_BAR
#undef PG8_SCHED
}
}

#ifndef PG8_SP2
#define PG8_SP2 true
#endif
#ifndef PG8_ALIGN
#define PG8_ALIGN true
#endif

#ifndef MK_CHECK
#define MK_CHECK 0
#endif
#if MK_CHECK == 8
#define MK_CHECK_ROWS MT
#define MK_CHECK_ROW0 MP
#define MK_CHECK_COL0 0
#endif
#if MK_CHECK == 7
#define MK_CHECK_ROWS MT
#define MK_CHECK_ROW0 0
#define MK_CHECK_COL0 768
#endif
#if MK_CHECK == 5
#define MK_CHECK_ROWS MT
#define MK_CHECK_ROW0 0
#define MK_CHECK_COL0 768
#endif
#if MK_CHECK == 4
#define MK_CHECK_ROWS MT
#define MK_CHECK_ROW0 0
#define MK_CHECK_COL0 512
#endif
#if MK_CHECK == 3
#define MK_CHECK_ROWS MP
#define MK_CHECK_ROW0 0
#define MK_CHECK_COL0 256
#endif
#ifndef MK_CHECK_ROWS
#define MK_CHECK_ROWS MP
#define MK_CHECK_ROW0 0
#define MK_CHECK_COL0 0
#endif
#ifndef MK_CHECK_MODE
#define MK_CHECK_MODE 2
#endif
#ifndef MK_CHECK_SEL
#define MK_CHECK_SEL -1
#endif
#ifndef MK_CHECK_TOL
#define MK_CHECK_TOL 0
#endif
#define GAS __attribute__((address_space(1)))
#define LAS __attribute__((address_space(3)))
typedef unsigned short bf16;
typedef unsigned v4u __attribute__((ext_vector_type(4)));
typedef unsigned v2u __attribute__((ext_vector_type(2)));
typedef float f32x4 __attribute__((ext_vector_type(4)));
typedef float f32x2v __attribute__((ext_vector_type(2)));
typedef GAS unsigned gu32;
#define RLX_AGENT __ATOMIC_RELAXED, __HIP_MEMORY_SCOPE_AGENT
#define LDS_WAIT() asm volatile("s_waitcnt lgkmcnt(0)" ::: "memory")
#define VM_WAIT() asm volatile("s_waitcnt vmcnt(0)" ::: "memory")
__device__ __forceinline__ unsigned f2bf(float f) { unsigned u = __builtin_bit_cast(unsigned, f); return (u + 0x7fffu + ((u >> 16) & 1u)) >> 16; }
typedef float f32x2_hw __attribute__((ext_vector_type(2))); typedef __bf16 bf16x2_hw __attribute__((ext_vector_type(2)));
__device__ __forceinline__ unsigned pk2(float lo, float hi) { f32x2_hw v = {lo, hi}; return __builtin_bit_cast(unsigned, __builtin_convertvector(v, bf16x2_hw)); }
__device__ __forceinline__ float bf2f(unsigned short b) { return __builtin_bit_cast(float, (unsigned)b << 16); }
__device__ __forceinline__ float bflo(unsigned w) { return __builtin_bit_cast(float, w << 16); }
__device__ __forceinline__ float bfhi(unsigned w) { return __builtin_bit_cast(float, w & 0xffff0000u); }
__device__ __forceinline__ float sigmoid_f(float x) { return 1.f / (1.f + __expf(-x)); }
__device__ __forceinline__ float silu_f(float x) { return x / (1.f + __expf(-x)); }
__device__ __forceinline__ float gelu_f(float x) { return 0.5f * x * (1.f + erff(x * 0.70710678118654752f)); }
template <int MASK> __device__ __forceinline__ float sx_sum(float v) {
    if (MASK == 32) { auto rr = __builtin_amdgcn_permlane32_swap(__float_as_uint(v), __float_as_uint(v), false, false); return __uint_as_float(rr[0]) + __uint_as_float(rr[1]); }
    return v + __builtin_bit_cast(float, __builtin_amdgcn_ds_swizzle(__builtin_bit_cast(int, v), (MASK << 10) | 0x1f));
}
template <int MASK> __device__ __forceinline__ float sx_max(float v) {
    if (MASK == 32) { auto rr = __builtin_amdgcn_permlane32_swap(__float_as_uint(v), __float_as_uint(v), false, false); return fmaxf(__uint_as_float(rr[0]), __uint_as_float(rr[1])); }
    return fmaxf(v, __builtin_bit_cast(float, __builtin_amdgcn_ds_swizzle(__builtin_bit_cast(int, v), (MASK << 10) | 0x1f)));
}
__device__ __forceinline__ float wave_sum(float v) { v = sx_sum<1>(v); v = sx_sum<2>(v); v = sx_sum<4>(v); v = sx_sum<8>(v); v = sx_sum<16>(v); return sx_sum<32>(v); }
__device__ __forceinline__ float wave_max(float v) { v = sx_max<1>(v); v = sx_max<2>(v); v = sx_max<4>(v); v = sx_max<8>(v); v = sx_max<16>(v); return sx_max<32>(v); }

#define XB_TMO      128
#define XB_XCNT(j)  (256  + 64 * (j))
#define XB_XSUB(j)  (1280 + 64 * (j))
#define XB_XGEN(j)  (2304 + 64 * (j))
#define XB_TOP      3328
#define XB_TOPGEN   3392
#define XCD_BAR_WORDS 3456
#define XB_SPIN_CAP (1u << 18)

__device__ __forceinline__ unsigned xb_ld(unsigned* p)              { return __hip_atomic_load(p, __ATOMIC_RELAXED, __HIP_MEMORY_SCOPE_AGENT); }
__device__ __forceinline__ unsigned xb_add(unsigned* p, unsigned v) { return __hip_atomic_fetch_add(p, v, __ATOMIC_RELAXED, __HIP_MEMORY_SCOPE_AGENT); }
__device__ __forceinline__ unsigned xb_xcc_id() { return (unsigned)__builtin_amdgcn_s_getreg((3 << 11) | 20) & 0xFu; }
#define XB_SPIN(cond, bar) do { unsigned _sp = 0; while (cond) { __builtin_amdgcn_s_sleep(1); \
    if ((++_sp & 255u) == 0u) { if (xb_ld(&(bar)[XB_TMO])) break; if (_sp > XB_SPIN_CAP) { atomicAdd(&(bar)[XB_TMO], 1u); break; } } } } while (0)

struct XcdBarrier {
    unsigned* bar; unsigned x;
    volatile LAS unsigned* st;
};
__device__ __forceinline__ XcdBarrier xcd_barrier_post(unsigned* bar, volatile LAS unsigned* st) {
    XcdBarrier b; b.bar = bar; b.x = xb_xcc_id(); b.st = st;
    if (threadIdx.x == 0) (void)xb_add(&bar[XB_XCNT(b.x)], 1u);
    return b;
}
__device__ __forceinline__ void xcd_barrier_complete(unsigned* bar, unsigned x, unsigned& nloc, unsigned& nx) {
    const unsigned G = gridDim.x * gridDim.y * gridDim.z;
    unsigned sum, cnt, mine, sp = 0u;
    for (;;) {
        sum = 0u; cnt = 0u; mine = 0u;
#pragma unroll
        for (unsigned j = 0; j < 16; ++j) { const unsigned c = xb_ld(&bar[XB_XCNT(j)]); sum += c; cnt += (c > 0u) ? 1u : 0u; mine = (j == x) ? c : mine; }
        if (sum == G) break;
        __builtin_amdgcn_s_sleep(1);
        if ((++sp & 255u) == 0u) { if (xb_ld(&bar[XB_TMO])) break; if (sp > XB_SPIN_CAP) { atomicAdd(&bar[XB_TMO], 1u); break; } }
    }
    nloc = mine > 0u ? mine : 1u; nx = cnt > 0u ? cnt : 1u;
}
__device__ __forceinline__ void xcd_barrier(const XcdBarrier& b, const int tid) {
    asm volatile("s_waitcnt vmcnt(0)" ::: "memory");
    __syncthreads();
    if (tid == 0) {
        unsigned* bar = b.bar;
        __builtin_amdgcn_s_waitcnt(0);
        unsigned nloc = b.st[0], nx = b.st[1];
        if (nloc == 0u) { xcd_barrier_complete(bar, b.x, nloc, nx); b.st[0] = nloc; b.st[1] = nx; }
        const unsigned old = xb_add(&bar[XB_XSUB(b.x)], 1u);
        const unsigned gen = old / nloc;
        if (old + 1u == (gen + 1u) * nloc) {
            __builtin_amdgcn_fence(__ATOMIC_RELEASE, "agent");
            asm volatile("s_waitcnt vmcnt(0)" ::: "memory");
            const unsigned og = xb_add(&bar[XB_TOP], 1u);
            const unsigned tg = og / nx;
            if (og + 1u == (tg + 1u) * nx) xb_add(&bar[XB_TOPGEN], 1u);
            else XB_SPIN(xb_ld(&bar[XB_TOPGEN]) == tg, bar);
            __builtin_amdgcn_fence(__ATOMIC_ACQUIRE, "agent");
            xb_add(&bar[XB_XGEN(b.x)], 1u);
            asm volatile("s_waitcnt vmcnt(0)" ::: "memory");
        } else {
            XB_SPIN(xb_ld(&bar[XB_XGEN(b.x)]) == gen, bar);
            __builtin_amdgcn_fence(__ATOMIC_ACQUIRE, "agent");
            asm volatile("s_waitcnt vmcnt(0)" ::: "memory");
        }
    }
    __syncthreads();
}

constexpr int NWAVES = 8, NTHR = 512;
constexpr int DM = 1024, MP = 16384, MS = 1024, MT = MP + MS, TSEQ = 8192, DIN = 3584, GW = 256;
constexpr int NBP = 2, NBS = 128, NBT = NBP + NBS;
constexpr int NPOOL = 2560, NPAGES = 16, PAGE = 128, PAST = 2048;
constexpr float EPS = 1e-5f;
constexpr float QSCALE = 0.25503486164919736f;
constexpr float ALPHA = 1.4142135623730951f;
constexpr int HG_L = 64, HG_NB = TSEQ / HG_L;
__device__ const double ROPE_INV[16] = {1.0, 0.5623413251903491, 0.31622776601683794, 0.1778279410038923, 0.1, 0.05623413251903491, 0.03162277660168379, 0.01778279410038923,
                                        0.01, 0.005623413251903491, 0.0031622776601683794, 0.0017782794100389228, 0.001, 0.0005623413251903491, 0.00031622776601683794, 0.00017782794100389227};
enum { I_XP = 0, I_XS, I_CK, I_CV, I_SCONV, I_SHGRN, I_PT, I_CP, I_CSM, I_WADA, I_BADA, I_WIN, I_LAMQK, I_ANG, I_SGG, I_SGB, I_WS, I_BS, I_CW, I_CB, I_CNG, I_CNB, I_WPW, I_LB, I_HNG, I_WOUT, I_LNG, I_LNB, N_IN };
constexpr size_t O_YP = 0, O_YS = O_YP + (size_t)MP * DM, O_KP = O_YS + (size_t)MS * DM, O_VP = O_KP + (size_t)2 * MP * GW, O_KS = O_VP + (size_t)2 * MP * GW,
                 O_VS = O_KS + (size_t)2 * MS * GW, O_CH = O_VS + (size_t)2 * MS * GW, O_CP = O_CH + (size_t)2 * MS * GW, O_CS = O_CP + (size_t)2 * NBP * 30 * GW,
                 O_HP = O_CS + (size_t)2 * NBS * 30 * GW, O_HS = O_HP + (size_t)2 * NBP * 4 * 4096, O_END = O_HS + (size_t)2 * NBS * 4 * 4096;
static_assert(O_END == 42432512, "output size");
constexpr size_t MiB = 1u << 20;
constexpr size_t WS_CTL = 0, CTL_ZERO_BYTES = 1 * MiB;
constexpr size_t WS_CS = 1 * MiB;
constexpr size_t WS_MOD = 2 * MiB;
constexpr size_t WS_SC = 6 * MiB;
constexpr size_t WS_SCAL = 7 * MiB;
constexpr size_t WS_WADA = 8 * MiB;
constexpr size_t WS_WIN = 20 * MiB;
constexpr size_t WS_WOUT = 34 * MiB;
constexpr size_t WS_WPW = 38 * MiB;
constexpr size_t WS_WSB = 39 * MiB;
constexpr size_t WS_H = 40 * MiB;
constexpr size_t SEG = 9 * MiB;
constexpr size_t WS_Q = 74 * MiB, WS_K = WS_Q + SEG, WS_V = WS_K + SEG, WS_GA = WS_V + SEG, WS_U = WS_GA + SEG, WS_VN = WS_U + SEG, WS_GB = WS_VN + SEG, WS_GC = WS_GB + SEG,
                 WS_QD = WS_GC + SEG, WS_KD = WS_QD + SEG, WS_VD = WS_KD + SEG, WS_GD = WS_VD + SEG;
constexpr size_t WS_KT = WS_K, WS_VT = WS_V;
constexpr size_t WS_GLU = 182 * MiB;
constexpr size_t WS_LF = 199 * MiB;
constexpr size_t WS_MIX = 216 * MiB;
constexpr size_t WS_R = 250 * MiB;
constexpr size_t WS_Y1 = 318 * MiB;
constexpr size_t WS_SLOC = 386 * MiB;
constexpr size_t WS_DTOT = 402 * MiB;
constexpr size_t WS_Z = 404 * MiB;
constexpr size_t WS_SST = 644 * MiB;
constexpr size_t WS_MIXCHK = 660 * MiB;
constexpr size_t WS_KR = 696 * MiB, WS_VR = 705 * MiB;
constexpr size_t WS_END = 714 * MiB;
constexpr size_t WS_PART = WS_Q;
constexpr int CW_BAR = 4096;
constexpr int CW_FQ = 16384;
constexpr int CW_GQ = 18432, CW_HQ = 18688, CW_SD = 18944;
constexpr int RING_BYTES = 131072, MISC_OFF = RING_BYTES + 320, LDS_BYTES = 147456;

__device__ __forceinline__ int batch_of(int m) { return m < MP ? (m >> 13) : NBP + ((m - MP) >> 3); }
struct Args { const float* in[N_IN]; float* out; unsigned char* ws; int ph_lo, ph_hi; };

#define CAS __attribute__((address_space(4)))
struct Ctx {
    const CAS Args* a; unsigned char* wsb; LAS unsigned char* lds; int tid, lane, wave, G, bid;
    __device__ __forceinline__ int gw() const { return bid * NWAVES + wave; }
    __device__ __forceinline__ int ngw() const { return G * NWAVES; }
    template <class T> __device__ __forceinline__ T* ws(size_t off) const { return (T*)(wsb + off); }
};

__device__ __forceinline__ Ctx launder(const Ctx& C, Args& shadow) {
    Ctx P = C; int t; asm volatile("v_mbcnt_lo_u32_b32 %0, -1, 0\n\tv_mbcnt_hi_u32_b32 %0, -1, %0" : "=v"(t)); t += C.wave * 64; P.tid = t; P.lane = t & 63; P.wave = __builtin_amdgcn_readfirstlane(t >> 6);
    const CAS Args* ka = (const CAS Args*)__builtin_amdgcn_kernarg_segment_ptr(); asm volatile("" : "+s"(ka)); P.a = ka;
    unsigned char* w = ka->ws; asm volatile("" : "+s"(w)); P.wsb = w;
    return P;
}
__device__ __forceinline__ f32x4 ld4(const float* p) { return *(const f32x4*)p; }
__device__ __forceinline__ void st4(float* p, f32x4 v) { *(f32x4*)p = v; }
__device__ __forceinline__ void st_bf4(bf16* p, f32x4 v) { v2u w; w.x = pk2(v.x, v.y); w.y = pk2(v.z, v.w); *(v2u*)p = w; }
__device__ __forceinline__ f32x4 ld_bf4(const bf16* p) { const v2u w = *(const v2u*)p; return (f32x4){bflo(w.x), bfhi(w.x), bflo(w.y), bfhi(w.y)}; }

template <class F> struct EpiF {
    static constexpr bool PERM = false, AFTER_DRAIN = false; F f;
    __device__ __forceinline__ void operator()(const pg8::f32x4 (&acc)[2][2][4][2], const pg8::Unit& u, int wr, int wc, int fr, int fq) const {
#pragma unroll
        for (int ai = 0; ai < 2; ++ai)
#pragma unroll
            for (int m = 0; m < 4; ++m) { const int row = u.pm * 256 + ai * 128 + wr * 64 + m * 16 + fr;
#pragma unroll
                for (int bj = 0; bj < 2; ++bj)
#pragma unroll
                    for (int n = 0; n < 2; ++n) { const int col = u.pn * 256 + bj * 128 + wc * 32 + n * 16 + 4 * fq; f(row, col, acc[ai][bj][m][n]); } }
    }
};

struct EpiResid {
    static constexpr bool PERM = false, AFTER_DRAIN = false;
    const float* xp; const float* xs; const float* y1; const float* modg; float* R; int l;
    __device__ __forceinline__ void operator()(const pg8::f32x4 (&acc)[2][2][4][2], const pg8::Unit& u, int wr, int wc, int fr, int fq) const {
#pragma unroll
        for (int ai = 0; ai < 2; ++ai)
#pragma unroll
            for (int m = 0; m < 4; ++m) { const int row = u.pm * 256 + ai * 128 + wr * 64 + m * 16 + fr;
                const float* xr = l == 0 ? (row < MP ? xp + (size_t)row * DM : xs + (size_t)(row - MP) * DM) : y1 + (size_t)row * DM;
                const float* gr = modg + (size_t)batch_of(row) * 3072; float* rr = R + (size_t)row * DM;
#pragma unroll
                for (int bj = 0; bj < 2; ++bj)
#pragma unroll
                    for (int n = 0; n < 2; ++n) { const int col = u.pn * 256 + bj * 128 + wc * 32 + n * 16 + 4 * fq;
                        st4(rr + col, ld4(xr + col) * ALPHA + ld4(gr + col) * acc[ai][bj][m][n]); }
                asm volatile("" ::: "memory"); }
    }
};

constexpr int OUT_KS = 4, OUT_PIECES = 16 * OUT_KS;
struct PieceOrder {
    int un;
    __device__ __forceinline__ bool next(int i, pg8::Unit& u) const { if (i > 0) return false; u.pm = MP / 256 + (un >> 2); u.pn = un & 3; return true; }
    __device__ __forceinline__ void a_ready(const pg8::Unit&) const {}
    __device__ __forceinline__ void done(const pg8::Unit&) const {}
};
struct EpiPart {
    static constexpr bool PERM = false, AFTER_DRAIN = false;
    float* P;
    __device__ __forceinline__ void operator()(const pg8::f32x4 (&acc)[2][2][4][2], const pg8::Unit& u, int wr, int wc, int fr, int fq) const {
#pragma unroll
        for (int ai = 0; ai < 2; ++ai)
#pragma unroll
            for (int m = 0; m < 4; ++m) { const int row = (u.pm - MP / 256) * 256 + ai * 128 + wr * 64 + m * 16 + fr; float* rr = P + (size_t)row * DM;
#pragma unroll
                for (int bj = 0; bj < 2; ++bj)
#pragma unroll
                    for (int n = 0; n < 2; ++n) { const int col = u.pn * 256 + bj * 128 + wc * 32 + n * 16 + 4 * fq; st4(rr + col, acc[ai][bj][m][n]); } }
    }
};

#define EPI_PIN(ai, m) asm volatile("" : "+v"(acc[ai][0][m][0]), "+v"(acc[ai][0][m][1]), "+v"(acc[ai][1][m][0]), "+v"(acc[ai][1][m][1]) :: "memory")
struct EpiIn {
    static constexpr bool PERM = false, AFTER_DRAIN = false;
    unsigned char* ws; float* out; const float* sgg; const float* sgb; LAS unsigned char* xl; int l;
    template <int ACT> static __device__ __forceinline__ f32x4 act4(f32x4 v) {
        if (ACT == 1) { return (f32x4){silu_f(v.x), silu_f(v.y), silu_f(v.z), silu_f(v.w)}; }
        if (ACT == 2) { const pg8::f32x2 a = pg8::gelu_pk((pg8::f32x2){v.x, v.y}), b = pg8::gelu_pk((pg8::f32x2){v.z, v.w}); return (f32x4){a.x, a.y, b.x, b.y}; }
        return v;
    }
    template <int ACT> __device__ __forceinline__ void plain(pg8::f32x4 (&acc)[2][2][4][2], int row0, int c0, size_t off) const {
        bf16* B = (bf16*)(ws + off);
#pragma unroll
        for (int ai = 0; ai < 2; ++ai)
#pragma unroll
            for (int m = 0; m < 4; ++m) { EPI_PIN(ai, m); bf16* rp = B + (size_t)(row0 + ai * 128 + m * 16) * 256 + c0;
#pragma unroll
                for (int bj = 0; bj < 2; ++bj)
#pragma unroll
                    for (int n = 0; n < 2; ++n) st_bf4(rp + bj * 128 + n * 16, act4<ACT>(acc[ai][bj][m][n]));
                asm volatile("" ::: "memory"); }
    }
    __device__ __forceinline__ void operator()(pg8::f32x4 (&acc)[2][2][4][2], const pg8::Unit& u, int wr, int wc, int fr, int fq) const {
        asm volatile("" : "+v"(fr), "+v"(fq));
        const int T = u.pn;
#define EPI_IDX int fr_ = fr, fq_ = fq; asm volatile("" : "+v"(fr_), "+v"(fq_)); const int row0 = u.pm * 256 + wr * 64 + fr_, c0 = wc * 32 + 4 * fq_; (void)row0; (void)c0
        const bool samp = u.pm >= MP / 256;
#ifndef EPI_MASK
#define EPI_MASK 0xff
#endif
        if ((EPI_MASK & 1) && (T == 0 || T == 1)) {
            EPI_IDX;
            const f32x2v* CS = (const f32x2v*)(ws + WS_CS);
#pragma unroll
            for (int ai = 0; ai < 2; ++ai)
#pragma unroll
                for (int m = 0; m < 4; ++m) { EPI_PIN(ai, m); const int row = row0 + ai * 128 + m * 16; const int r = row - MP;
                    const int pos = samp ? PAST + (r & 7) : (row & (TSEQ - 1));
                    const f32x4 cs0 = *(const f32x4*)(CS + pos * 16 + 4 * fq_), cs1 = *(const f32x4*)(CS + pos * 16 + 4 * fq_ + 2);
                    const f32x4 cosv = (f32x4){cs0.x, cs0.z, cs1.x, cs1.z}, sinv = (f32x4){cs0.y, cs0.w, cs1.y, cs1.w};
#pragma unroll
                    for (int bj = 0; bj < 2; ++bj) { const f32x4 x1 = acc[ai][bj][m][0], x2 = acc[ai][bj][m][1];
                        const f32x4 o1 = x1 * cosv - x2 * sinv, o2 = x2 * cosv + x1 * sinv; const int col = bj * 128 + c0;
                        if (T == 0) { bf16* q = (bf16*)(ws + WS_Q) + (size_t)row * 256 + col; st_bf4(q, o1 * QSCALE); st_bf4(q + 16, o2 * QSCALE); }
                        else { float* ok = out + (samp ? O_KS + ((size_t)l * MS + r) * 256 : O_KP + ((size_t)l * MP + row) * 256) + col; st4(ok, o1); st4(ok + 16, o2);
#if MK_CHECK == 1
                            { bf16* kr = (bf16*)(ws + WS_KR) + (size_t)row * 256 + col; st_bf4(kr, o1); st_bf4(kr + 16, o2); }
#endif
                            if (!samp) { const int t = row & (TSEQ - 1), bh = (row >> 13) * 4 + 2 * bj + (wc >> 1);
                                unsigned char* kt = ws + WS_KT + ((size_t)(bh * 128 + (t >> 6)) * 8192 + (4 * (wc & 1) + (fq_ >> 1)) * 1024 + (t & 63) * 16 + 8 * (fq_ & 1));
                                st_bf4((bf16*)kt, o1); st_bf4((bf16*)(kt + 2048), o2); } } }
                    asm volatile("" ::: "memory"); }
        } else if ((EPI_MASK & 2) && T == 2) {
            EPI_IDX;
#pragma unroll
            for (int ai = 0; ai < 2; ++ai)
#pragma unroll
                for (int m = 0; m < 4; ++m) { EPI_PIN(ai, m); const int row = row0 + ai * 128 + m * 16; const int r = row - MP;
#pragma unroll
                    for (int bj = 0; bj < 2; ++bj)
#pragma unroll
                        for (int n = 0; n < 2; ++n) { const f32x4 v = acc[ai][bj][m][n]; const int col = bj * 128 + n * 16 + c0;
                            st4(out + (samp ? O_VS + ((size_t)l * MS + r) * 256 : O_VP + ((size_t)l * MP + row) * 256) + col, v);
#if MK_CHECK == 1
                            st_bf4((bf16*)(ws + WS_VR) + (size_t)row * 256 + col, v);
#endif
                            if (!samp) { const int t = row & (TSEQ - 1), bh = (row >> 13) * 4 + 2 * bj + (wc >> 1), rw = t & 63;
                                st_bf4((bf16*)(ws + WS_VT + ((size_t)(bh * 128 + (t >> 6)) * 8192 + ((wc & 1) * 4 + (rw >> 4)) * 1024 + (rw & 15) * 64 + 32 * n + 8 * fq_)), v); } }
                    asm volatile("" ::: "memory"); }
        } else if ((EPI_MASK & 4) && T == 3) { EPI_IDX; plain<1>(acc, row0, c0, WS_GA); }
        else if ((EPI_MASK & 8) && T == 4) { EPI_IDX; plain<2>(acc, row0, c0, WS_U); }
        else if ((EPI_MASK & 4) && T == 6) { EPI_IDX; plain<1>(acc, row0, c0, WS_GB); }
        else if ((EPI_MASK & 4) && T == 9) { EPI_IDX; plain<1>(acc, row0, c0, WS_GC); }
        else if ((EPI_MASK & 4) && T == 10) { EPI_IDX; plain<1>(acc, row0, c0, WS_QD); }
        else if ((EPI_MASK & 4) && T == 12) { EPI_IDX; plain<0>(acc, row0, c0, WS_VD); }
        else if ((EPI_MASK & 4) && T == 13) { EPI_IDX; plain<1>(acc, row0, c0, WS_GD); }
        else if ((EPI_MASK & 16) && T == 5) { EPI_IDX; plain<2>(acc, row0, c0, WS_VN);
        } else if ((EPI_MASK & 32) && (T == 7 || T == 8)) {
            EPI_IDX;
#pragma unroll
            for (int ai = 0; ai < 2; ++ai)
#pragma unroll
                for (int m = 0; m < 4; ++m) { EPI_PIN(ai, m); const int row = row0 + ai * 128 + m * 16; const int r = row - MP;
#pragma unroll
                    for (int n = 0; n < 2; ++n) { const f32x4 a = acc[ai][0][m][n], gt = acc[ai][1][m][n]; const int col = (T - 7) * 128 + n * 16 + c0;
                        const f32x4 glu = (f32x4){a.x * sigmoid_f(gt.x), a.y * sigmoid_f(gt.y), a.z * sigmoid_f(gt.z), a.w * sigmoid_f(gt.w)};
                        st4((float*)(ws + WS_GLU) + (size_t)row * 256 + col, glu);
                        if (!samp) { const int t = row & (TSEQ - 1); if (t >= TSEQ - 30) st4(out + O_CP + ((size_t)(l * NBP + (row >> 13)) * 30 + (t - (TSEQ - 30))) * 256 + col, glu); }
                        else st4(out + O_CS + ((size_t)(l * NBS + (r >> 3)) * 30 + 22 + (r & 7)) * 256 + col, glu); }
                    asm volatile("" ::: "memory"); }
        } else if ((EPI_MASK & 64) && T == 11) {
            EPI_IDX;
            const float* lbp = (const float*)(ws + WS_SCAL) + 64;
#pragma unroll
            for (int ai = 0; ai < 2; ++ai)
#pragma unroll
                for (int m = 0; m < 4; ++m) { EPI_PIN(ai, m); const int row = row0 + ai * 128 + m * 16;
#pragma unroll
                    for (int bj = 0; bj < 2; ++bj)
#pragma unroll
                        for (int n = 0; n < 2; ++n) { const int col = bj * 128 + n * 16 + c0; f32x4 lb = (f32x4){0.f, 0.f, 0.f, 0.f}; if (l == 1) lb = ld4(lbp + col);
                            const f32x4 v = acc[ai][bj][m][n]; f32x4 f, lf;
                            f.x = lb.x + (1.f - lb.x) * sigmoid_f(v.x); f.y = lb.y + (1.f - lb.y) * sigmoid_f(v.y); f.z = lb.z + (1.f - lb.z) * sigmoid_f(v.z); f.w = lb.w + (1.f - lb.w) * sigmoid_f(v.w);
                            lf.x = __logf(fmaxf(f.x, 1e-30f)); lf.y = __logf(fmaxf(f.y, 1e-30f)); lf.z = __logf(fmaxf(f.z, 1e-30f)); lf.w = __logf(fmaxf(f.w, 1e-30f));
                            st4((float*)(ws + WS_LF) + (size_t)row * 256 + col, lf); st_bf4((bf16*)(ws + WS_KD) + (size_t)row * 256 + col, 1.f - f); } }
        }
    }
};

template <bool GLU_PERM = false> __device__ __forceinline__ void p0_transpose_item(const float* W, int K, int N, bf16* WT, int row_off, LAS float* scr, int item, int lane) {
    const int nblk = N / 32, kb = item / nblk, nb = item % nblk, k0 = 64 * kb, n0 = 32 * nb;
    int d0 = n0;
    if (GLU_PERM && n0 >= 1792 && n0 < 2304) { const int c = n0 - 1792, part = c >> 8, idx = c & 255; d0 = 1792 + (idx >> 7) * 256 + part * 128 + (idx & 127); }
    float tv[32];
#pragma unroll
    for (int i = 0; i < 32; ++i) tv[i] = W[(size_t)(k0 + 2 * i + (lane >> 5)) * N + n0 + (lane & 31)];
#pragma unroll
    for (int i = 0; i < 32; ++i) scr[(2 * i + (lane >> 5)) * 33 + (lane & 31)] = tv[i];
    LDS_WAIT(); asm volatile("" ::: "memory");
    const int c = lane & 7;
#pragma unroll
    for (int j = 0; j < 4; ++j) { const int n = (lane >> 3) + 8 * j; const LAS float* s = scr + (8 * c) * 33 + n;
        v4u o; o.x = pk2(s[0 * 33], s[1 * 33]); o.y = pk2(s[2 * 33], s[3 * 33]); o.z = pk2(s[4 * 33], s[5 * 33]); o.w = pk2(s[6 * 33], s[7 * 33]);
        *(GAS v4u*)(WT + (size_t)(row_off + d0 + n) * K + k0 + 8 * c) = o; }
    LDS_WAIT(); asm volatile("" ::: "memory");
}
struct TItem { const float* src; bf16* dst; int N, K; };
template <bool GLU_PERM = false> __device__ __forceinline__ TItem p0_titem(const float* W, int K, int N, bf16* WT, int row_off, int item, int lane) {
    const int nblk = N / 32, kb = item / nblk, nb = item % nblk, k0 = 64 * kb, n0 = 32 * nb;
    int d0 = n0;
    if (GLU_PERM && n0 >= 1792 && n0 < 2304) { const int c = n0 - 1792, part = c >> 8, idx = c & 255; d0 = 1792 + (idx >> 7) * 256 + part * 128 + (idx & 127); }
    TItem t; t.src = W + (size_t)(k0 + (lane >> 5)) * N + n0 + (lane & 31); t.dst = WT + (size_t)(row_off + d0) * K + k0; t.N = N; t.K = K; return t;
}
#define P0_TLOAD(T, tv) { _Pragma("unroll") for (int i_ = 0; i_ < 32; ++i_) tv[i_] = (T).src[(size_t)(2 * i_) * (T).N]; }
#define P0_TSTORE(T, tv, scr, lane) { \
    _Pragma("unroll") for (int i_ = 0; i_ < 32; ++i_) (scr)[(2 * i_ + ((lane) >> 5)) * 33 + ((lane) & 31)] = tv[i_]; \
    LDS_WAIT(); asm volatile("" ::: "memory"); \
    { const int c_ = (lane) & 7; \
      _Pragma("unroll") for (int j_ = 0; j_ < 4; ++j_) { const int n_ = ((lane) >> 3) + 8 * j_; const LAS float* s_ = (scr) + (8 * c_) * 33 + n_; \
        v4u o_; o_.x = pk2(s_[0 * 33], s_[1 * 33]); o_.y = pk2(s_[2 * 33], s_[3 * 33]); o_.z = pk2(s_[4 * 33], s_[5 * 33]); o_.w = pk2(s_[6 * 33], s_[7 * 33]); \
        *(GAS v4u*)((T).dst + (size_t)n_ * (T).K + 8 * c_) = o_; } } \
    LDS_WAIT(); asm volatile("" ::: "memory"); }
__device__ __forceinline__ void p0_layer1_weights(const Ctx& C, int widx, int nw) {
    const CAS Args& A = *C.a; LAS float* scr = (LAS float*)(C.lds + C.wave * 12288);
    constexpr int I_IN = 16 * (DIN / 32), I_OUT = 16 * 32, I_PW = 4 * 8;
    for (int it = widx; it < I_IN + I_OUT + I_PW; it += nw) {
        int r = it;
        if (r < I_IN) { p0_transpose_item<true>(A.in[I_WIN] + (size_t)DM * DIN, DM, DIN, C.ws<bf16>(WS_WIN) + (size_t)DIN * DM, 0, scr, r, C.lane); continue; } r -= I_IN;
        if (r < I_OUT) { p0_transpose_item(A.in[I_WOUT] + (size_t)DM * DM, DM, DM, C.ws<bf16>(WS_WOUT) + (size_t)DM * DM, 0, scr, r, C.lane); continue; } r -= I_OUT;
        p0_transpose_item(A.in[I_WPW] + (size_t)256 * 256, 256, 256, C.ws<bf16>(WS_WPW) + (size_t)256 * 256, 0, scr, r, C.lane);
    }
}
template <int PART, class Mid> __device__ __forceinline__ void p0_prologue(const Ctx& C, int gw, int NGW, Mid mid) {
    const CAS Args& A = *C.a;
    LAS float* scr = (LAS float*)(C.lds + C.wave * 16384);
    constexpr int I_IN = 16 * (DIN / 32), I_OUT = 16 * 32, I_ADA = 16 * 96, I_PW = 4 * 8;
    constexpr int NITEMS = I_IN + I_OUT + I_PW + 2 * I_ADA;
    constexpr int IT_LO = PART == 0 ? NITEMS : 0, IT_HI = PART == 0 ? NITEMS : I_IN + I_OUT + I_PW;
    auto desc = [&](int it) -> TItem {
        int r = it;
        if (r < I_IN) return p0_titem<true>(A.in[I_WIN], DM, DIN, C.ws<bf16>(WS_WIN), 0, r, C.lane); r -= I_IN;
        if (r < I_OUT) return p0_titem(A.in[I_WOUT], DM, DM, C.ws<bf16>(WS_WOUT), 0, r, C.lane); r -= I_OUT;
        if (r < I_PW) return p0_titem(A.in[I_WPW], 256, 256, C.ws<bf16>(WS_WPW), 0, r, C.lane); r -= I_PW;
        const int l = r >= I_ADA ? 1 : 0; r -= l * I_ADA;
        return p0_titem(A.in[I_WADA] + (size_t)l * DM * 3072, DM, 3072, C.ws<bf16>(WS_WADA), l * 3072, r, C.lane);
    };
    {   const int it = IT_LO + gw; const bool has = it < IT_HI, two = it + NGW < IT_HI;
        const TItem T0 = desc(has ? it : 0), T1 = desc(two ? it + NGW : 0);
        float tv0[32], tv1[32];
        if (has) P0_TLOAD(T0, tv0);
        if (two) P0_TLOAD(T1, tv1);
        mid();
        if (has) P0_TSTORE(T0, tv0, scr, C.lane);
        if (two) P0_TSTORE(T1, tv1, scr, C.lane);
    }
    for (int it = IT_LO + gw + 2 * NGW; it < IT_HI; it += 2 * NGW) {
        const bool two = it + NGW < IT_HI;
        const TItem T0 = desc(it), T1 = desc(two ? it + NGW : it);
        float tv0[32], tv1[32];
        P0_TLOAD(T0, tv0);
        if (two) P0_TLOAD(T1, tv1);
        P0_TSTORE(T0, tv0, scr, C.lane);
        if (two) P0_TSTORE(T1, tv1, scr, C.lane);
    }
    if (PART == 1) {
    { bf16* wsb = C.ws<bf16>(WS_WSB); const float* wsrc = A.in[I_WS];
      for (int idx = gw * 64 + C.lane; idx < 2 * 4 * 128 * 32; idx += NGW * 64) { const int t = (idx >> 5) & 127, s4 = (idx & 31) * 4; f32x4 v = ld4(wsrc + (size_t)idx * 4);
          if (s4 + 0 > t) v.x = 0.f; if (s4 + 1 > t) v.y = 0.f; if (s4 + 2 > t) v.z = 0.f; if (s4 + 3 > t) v.w = 0.f; st_bf4(wsb + (size_t)idx * 4, v); } }
    f32x2v* cs = C.ws<f32x2v>(WS_CS);
    for (int idx = gw * 64 + C.lane; idx < TSEQ * 16; idx += NGW * 64) {
        const int pos = idx >> 4, i = idx & 15;
        const double a = (double)pos * ROPE_INV[i];
        const double n = rint(a * 0.15915494309189535);
        const float r = (float)(a - n * 6.283185307179586);
        cs[idx] = (f32x2v){cosf(r), sinf(r)};
    }
    }
    if (PART == 0) {
    bf16* sc = C.ws<bf16>(WS_SC);
    for (int row = gw; row < 256; row += NGW) {
        const float* src = row < NBP ? A.in[I_CP] + (size_t)row * DM : A.in[I_CSM] + (size_t)(row - NBP) * DM;
#pragma unroll
        for (int j = 0; j < 4; ++j) { const int col = 4 * C.lane + 256 * j; f32x4 v = (f32x4){0.f, 0.f, 0.f, 0.f};
            if (row < NBT) { v = ld4(src + col); v.x = silu_f(v.x); v.y = silu_f(v.y); v.z = silu_f(v.z); v.w = silu_f(v.w); }
            st_bf4(sc + (size_t)row * DM + col, v); }
    }
    }
    if (PART == 1) {
    for (int it = gw; it < 2 * NBS * 22; it += NGW) { const int j = it % 22, lb_ = it / 22;
        st4(A.out + O_CS + ((size_t)lb_ * 30 + j) * 256 + 4 * C.lane, ld4(A.in[I_SCONV] + ((size_t)lb_ * 30 + 8 + j) * 256 + 4 * C.lane)); }
    }
    if (PART == 0 && C.bid == 0 && C.wave == 0) {
        float* scal = C.ws<float>(WS_SCAL);
        const float* lq = A.in[I_LAMQK];
        for (int l = 0; l < 2; ++l) {
            float a = C.lane < 32 ? lq[(l * 4 + 0) * 32 + C.lane] * lq[(l * 4 + 1) * 32 + C.lane] : 0.f;
            float b = C.lane < 32 ? lq[(l * 4 + 2) * 32 + C.lane] * lq[(l * 4 + 3) * 32 + C.lane] : 0.f;
            a = wave_sum(a); b = wave_sum(b);
            const float lam_init = l == 0 ? 0.2f : 0.35550906759096934f;
            if (C.lane == 0) scal[l] = __expf(a) - __expf(b) + lam_init;
        }
        const float* lb = A.in[I_LB];
        for (int c = C.lane; c < 256; c += 64) { const float e0 = __expf(lb[c]), e1 = __expf(lb[256 + c]); scal[64 + c] = e1 / (e0 + e1); }
    }
}


__device__ __forceinline__ const float* xrow_in(const Ctx& C, int l, int m) {
    if (l == 0) return m < MP ? C.a->in[I_XP] + (size_t)m * DM : C.a->in[I_XS] + (size_t)(m - MP) * DM;
    return C.ws<float>(WS_Y1) + (size_t)m * DM;
}
__device__ __forceinline__ void ph_hbuild(const Ctx& C, int l) {
    const float* mod = C.ws<float>(WS_MOD); bf16* H = C.ws<bf16>(WS_H);
    f32x4 nx[4];
    if (C.gw() < MT) { const float* xr = xrow_in(C, l, C.gw());
#pragma unroll
        for (int j = 0; j < 4; ++j) nx[j] = ld4(xr + 4 * C.lane + 256 * j); }
    for (int m = C.gw(); m < MT; m += C.ngw()) {
        const float* md = mod + (size_t)(l * NBT + batch_of(m)) * 3072;
        f32x4 v[4];
#pragma unroll
        for (int j = 0; j < 4; ++j) v[j] = nx[j];
        if (m + C.ngw() < MT) { const float* xr = xrow_in(C, l, m + C.ngw());
#pragma unroll
            for (int j = 0; j < 4; ++j) nx[j] = ld4(xr + 4 * C.lane + 256 * j); }
#pragma unroll
        for (int j = 0; j < 4; ++j) { const int col = 4 * C.lane + 256 * j;
            const f32x4 sh = ld4(md + col), sc = ld4(md + 1024 + col);
            st_bf4(H + (size_t)m * DM + col, v[j] * (1.f + sc) + sh); }
    }
}

#if MK_CHECK == 6
constexpr size_t WS_ALT = 768 * MiB;
__device__ __forceinline__ void ph_post_ref(const Ctx& C, int l) {
    const CAS Args& A = *C.a; const int lane = C.lane, c4 = 4 * lane;
    const float* Z = (const float*)(C.wsb - WS_ALT + WS_Z); const f32x2v* CS = (const f32x2v*)(C.wsb - WS_ALT + WS_CS); const float* scal = (const float*)(C.wsb - WS_ALT + WS_SCAL);
    bf16 *Qb = C.ws<bf16>(WS_Q), *Kb = C.ws<bf16>(WS_K), *Vb = C.ws<bf16>(WS_V), *GA = C.ws<bf16>(WS_GA), *U = C.ws<bf16>(WS_U), *VN = C.ws<bf16>(WS_VN), *GB = C.ws<bf16>(WS_GB),
         *GC = C.ws<bf16>(WS_GC), *QD = C.ws<bf16>(WS_QD), *KD = C.ws<bf16>(WS_KD), *VD = C.ws<bf16>(WS_VD), *GD = C.ws<bf16>(WS_GD);
    float *GLU = C.ws<float>(WS_GLU), *LF = C.ws<float>(WS_LF); float* out = A.out;
    const f32x4 sg_g = ld4(A.in[I_SGG] + l * 256 + c4), sg_b = ld4(A.in[I_SGB] + l * 256 + c4);
    f32x4 lb = (f32x4){0.f, 0.f, 0.f, 0.f}; if (l == 1) lb = ld4(scal + 64 + c4);
    const float sgn = (lane & 4) ? 1.f : -1.f;
    for (int m = C.gw(); m < MT; m += C.ngw()) {
        const float* z = Z + (size_t)m * DIN; const size_t mo = (size_t)m * 256 + c4;
        const bool samp = m >= MP; const int r = m - MP;
        const int pos = samp ? PAST + (r & 7) : (m & (TSEQ - 1));
        float *ok, *ov;
        if (!samp) { const size_t o = ((size_t)l * MP + m) * 256 + c4; ok = out + O_KP + o; ov = out + O_VP + o; }
        else { const size_t o = ((size_t)l * MS + r) * 256 + c4; ok = out + O_KS + o; ov = out + O_VS + o; }
        const f32x4 cs0 = *(const f32x4*)(CS + pos * 16 + 4 * (lane & 3)), cs1 = *(const f32x4*)(CS + pos * 16 + 4 * (lane & 3) + 2);
        const f32x4 cosv = (f32x4){cs0.x, cs0.z, cs1.x, cs1.z}, sinv = (f32x4){cs0.y, cs0.w, cs1.y, cs1.w};
        {
            const f32x4 v = ld4(z + c4); f32x4 p; p.x = __builtin_bit_cast(float, __builtin_amdgcn_ds_swizzle(__builtin_bit_cast(int, v.x), (4 << 10) | 0x1f)); p.y = __builtin_bit_cast(float, __builtin_amdgcn_ds_swizzle(__builtin_bit_cast(int, v.y), (4 << 10) | 0x1f)); p.z = __builtin_bit_cast(float, __builtin_amdgcn_ds_swizzle(__builtin_bit_cast(int, v.z), (4 << 10) | 0x1f)); p.w = __builtin_bit_cast(float, __builtin_amdgcn_ds_swizzle(__builtin_bit_cast(int, v.w), (4 << 10) | 0x1f));
            const f32x4 o = v * cosv + (p * sinv) * sgn; st_bf4(Qb + mo, o * QSCALE);
        }
        {
            const f32x4 v = ld4(z + 256 + c4); f32x4 p; p.x = __builtin_bit_cast(float, __builtin_amdgcn_ds_swizzle(__builtin_bit_cast(int, v.x), (4 << 10) | 0x1f)); p.y = __builtin_bit_cast(float, __builtin_amdgcn_ds_swizzle(__builtin_bit_cast(int, v.y), (4 << 10) | 0x1f)); p.z = __builtin_bit_cast(float, __builtin_amdgcn_ds_swizzle(__builtin_bit_cast(int, v.z), (4 << 10) | 0x1f)); p.w = __builtin_bit_cast(float, __builtin_amdgcn_ds_swizzle(__builtin_bit_cast(int, v.w), (4 << 10) | 0x1f));
            const f32x4 o = v * cosv + (p * sinv) * sgn;
            if (!samp) { const int t = m & (TSEQ - 1), bh = (m >> 13) * 4 + (lane >> 4);
                st_bf4((bf16*)(C.ws<unsigned char>(WS_KT) + ((size_t)(bh * 128 + (t >> 6)) * 8192 + ((lane & 15) >> 1) * 1024 + (t & 63) * 16 + (lane & 1) * 8)), o); }
        }
        { const f32x4 v = ld4(z + 512 + c4);
            if (!samp) { const int t = m & (TSEQ - 1), bh = (m >> 13) * 4 + (lane >> 4), row = t & 63;
                st_bf4((bf16*)(C.ws<unsigned char>(WS_VT) + ((size_t)(bh * 128 + (t >> 6)) * 8192 + ((((lane & 15) >> 3) * 4 + (row >> 4)) * 1024) + (row & 15) * 64 + (lane & 7) * 8)), v); } }
        { const f32x4 v = ld4(z + 768 + c4); st_bf4(GA + mo, (f32x4){silu_f(v.x), silu_f(v.y), silu_f(v.z), silu_f(v.w)}); }
        { const f32x4 v = ld4(z + 1024 + c4); st_bf4(U + mo, (f32x4){gelu_f(v.x), gelu_f(v.y), gelu_f(v.z), gelu_f(v.w)}); }
        { const f32x4 v = ld4(z + 1280 + c4); st_bf4(VN + mo, (f32x4){gelu_f(v.x), gelu_f(v.y), gelu_f(v.z), gelu_f(v.w)}); }
        { const f32x4 v = ld4(z + 1536 + c4); st_bf4(GB + mo, (f32x4){silu_f(v.x), silu_f(v.y), silu_f(v.z), silu_f(v.w)}); }
        {
            const f32x4 a = ld4(z + 1792 + (c4 >> 7) * 256 + (c4 & 127)), g = ld4(z + 1792 + (c4 >> 7) * 256 + 128 + (c4 & 127));
            const f32x4 glu = (f32x4){a.x * sigmoid_f(g.x), a.y * sigmoid_f(g.y), a.z * sigmoid_f(g.z), a.w * sigmoid_f(g.w)};
            st4(GLU + mo, glu);
        }
        { const f32x4 v = ld4(z + 2304 + c4); st_bf4(GC + mo, (f32x4){silu_f(v.x), silu_f(v.y), silu_f(v.z), silu_f(v.w)}); }
        { const f32x4 v = ld4(z + 2560 + c4); st_bf4(QD + mo, (f32x4){silu_f(v.x), silu_f(v.y), silu_f(v.z), silu_f(v.w)}); }
        {
            const f32x4 v = ld4(z + 2816 + c4); f32x4 f, lf;
            f.x = lb.x + (1.f - lb.x) * sigmoid_f(v.x); f.y = lb.y + (1.f - lb.y) * sigmoid_f(v.y); f.z = lb.z + (1.f - lb.z) * sigmoid_f(v.z); f.w = lb.w + (1.f - lb.w) * sigmoid_f(v.w);
            lf.x = __logf(fmaxf(f.x, 1e-30f)); lf.y = __logf(fmaxf(f.y, 1e-30f)); lf.z = __logf(fmaxf(f.z, 1e-30f)); lf.w = __logf(fmaxf(f.w, 1e-30f));
            st4(LF + mo, lf); st_bf4(KD + mo, 1.f - f);
        }
        { const f32x4 v = ld4(z + 3072 + c4); st_bf4(VD + mo, v); }
        { const f32x4 v = ld4(z + 3328 + c4); st_bf4(GD + mo, (f32x4){silu_f(v.x), silu_f(v.y), silu_f(v.z), silu_f(v.w)}); }
    }
}

#endif

__device__ __forceinline__ void sg_unit(const Ctx& C, int l, int u) {
    const CAS Args& A = *C.a; const bf16 *U = C.ws<bf16>(WS_U), *VN = C.ws<bf16>(WS_VN), *GB = C.ws<bf16>(WS_GB); bf16* MIX = C.ws<bf16>(WS_MIX);
    LAS float* vn = (LAS float*)C.lds;
    const int r0 = (u - 128) * 8; const size_t m0 = (size_t)MP + r0;
    {   const int i = C.wave; const f32x4 gam = ld4(A.in[I_SGG] + l * 256 + 4 * C.lane), bet = ld4(A.in[I_SGB] + l * 256 + 4 * C.lane);
        const f32x4 v = ld_bf4(VN + (m0 + i) * 256 + 4 * C.lane);
        const float mean = wave_sum((v.x + v.y) + (v.z + v.w)) * (1.f / 256.f); const f32x4 d = v - mean;
        const float var = wave_sum((d.x * d.x + d.y * d.y) + (d.z * d.z + d.w * d.w)) * (1.f / 256.f);
        const f32x4 y = d * rsqrtf(var + EPS) * gam + bet;
        *(LAS f32x4*)(vn + i * 256 + 4 * C.lane) = y; st4(A.out + O_CH + ((size_t)l * MS + r0 + i) * 256 + 4 * C.lane, y); }
    __syncthreads();
    const int col = C.tid & 255, th = C.tid >> 8, g = col >> 6;
    const float* w = A.in[I_WS] + (size_t)(l * 4 + g) * 128 * 128; const float* bs = A.in[I_BS] + (l * 4 + g) * 128;
    f32x4 wv[4][2]; float bsv[4], uu[4], gg[4];
#pragma unroll
    for (int i = 0; i < 4; ++i) { const int t = th * 4 + i; wv[i][0] = ld4(w + t * 128); wv[i][1] = ld4(w + t * 128 + 4); bsv[i] = bs[t];
        const size_t mo = (m0 + t) * 256 + col; uu[i] = bf2f(U[mo]); gg[i] = bf2f(GB[mo]); }
    float vv[8];
#pragma unroll
    for (int s_ = 0; s_ < 8; ++s_) vv[s_] = vn[s_ * 256 + col];
#pragma unroll
    for (int i = 0; i < 4; ++i) { const int t = th * 4 + i; float acc = 0.f;
#pragma unroll
        for (int s_ = 0; s_ < 8; ++s_) { const float wt = s_ < 4 ? wv[i][0][s_] : wv[i][1][s_ - 4]; acc += (s_ <= t) ? wt * vv[s_] : 0.f; }
        MIX[(m0 + t) * DM + 256 + col] = (bf16)f2bf(uu[i] * (acc + bsv[i]) * gg[i]); }
    __syncthreads();
}

__device__ __forceinline__ void conv_unit(const Ctx& C, int l, int u, bf16* MIX) {
    const CAS Args& A = *C.a; const float* GLU = C.ws<float>(WS_GLU); const bf16* GC = C.ws<bf16>(WS_GC);
    LAS float* Ys = (LAS float*)C.lds;
    const int c = C.tid & 255, rh = C.tid >> 8, r0 = u * 16;
    const float* cw = A.in[I_CW] + (size_t)l * 31 * 256 + c; const float cb = A.in[I_CB][l * 256 + c];
    for (int i = 0; i < 8; ++i) {
        const int rr = rh * 8 + i, m = r0 + rr; float y = cb;
        if (m < MP) { const int t = m & (TSEQ - 1);
            for (int j = 0; j < 31; ++j) { const int tt = t + j - 30; if (tt >= 0) y += cw[j * 256] * GLU[(size_t)(m + j - 30) * 256 + c]; }
        } else { const int r = m - MP, bs = r >> 3, ts = r & 7; const float* sc = A.in[I_SCONV] + (size_t)(l * NBS + bs) * 30 * 256 + c;
            for (int j = 0; j < 31; ++j) { const int tt = ts + j - 30; const float h = tt >= 0 ? GLU[(size_t)(m + j - 30) * 256 + c] : sc[(ts + j) * 256]; y += cw[j * 256] * h; }
        }
        Ys[rr * 256 + c] = y;
    }
    __syncthreads();
    {
        const f32x4 g = ld4(A.in[I_CNG] + l * 256 + 4 * C.lane), b = ld4(A.in[I_CNB] + l * 256 + 4 * C.lane);
        for (int i = 0; i < 2; ++i) { const int rr = C.wave * 2 + i; LAS f32x4* p = (LAS f32x4*)(Ys + rr * 256) + C.lane; f32x4 v = *p;
            const float mean = wave_sum((v.x + v.y) + (v.z + v.w)) * (1.f / 256.f); const f32x4 d = v - mean;
            const float var = wave_sum((d.x * d.x + d.y * d.y) + (d.z * d.z + d.w * d.w)) * (1.f / 256.f);
            f32x4 y = d * rsqrtf(var + EPS) * g + b; y = (f32x4){silu_f(y.x), silu_f(y.y), silu_f(y.z), silu_f(y.w)}; *p = y; }
    }
    __syncthreads();
    {
        float acc[8];
#pragma unroll
        for (int i = 0; i < 8; ++i) acc[i] = 0.f;
        const float* wp = A.in[I_WPW] + (size_t)l * 256 * 256 + c;
        for (int k = 0; k < 256; k += 4) {
            const float w0 = wp[(k + 0) * 256], w1 = wp[(k + 1) * 256], w2 = wp[(k + 2) * 256], w3 = wp[(k + 3) * 256];
#pragma unroll
            for (int i = 0; i < 8; ++i) { const f32x4 y = *(const LAS f32x4*)(Ys + (rh * 8 + i) * 256 + k); acc[i] += y.x * w0 + y.y * w1 + y.z * w2 + y.w * w3; }
        }
#pragma unroll
        for (int i = 0; i < 8; ++i) { const int m = r0 + rh * 8 + i; MIX[(size_t)m * DM + 512 + c] = (bf16)f2bf(acc[i] * bf2f(GC[(size_t)m * 256 + c])); }
    }
    __syncthreads();
}

template <int MODE> __device__ __forceinline__ void hgrn_item(const Ctx& C, int l, int item) {
    const CAS Args& A = *C.a; const int lane = C.lane;
    const float* LF = C.ws<float>(WS_LF); const bf16 *QD = C.ws<bf16>(WS_QD), *KD = C.ws<bf16>(WS_KD), *VD = C.ws<bf16>(WS_VD), *GD = C.ws<bf16>(WS_GD); bf16* MIX = C.ws<bf16>(WS_MIX);
    LAS float* Fs = (LAS float*)(C.lds + C.wave * 12288); LAS float* Ks = Fs + 1024; LAS float* Qs = Fs + 2048;
    int h, m0, ntok; size_t sidx;
    if (MODE == 2) { const int bs = item >> 2; h = item & 3; m0 = MP + bs * 8; ntok = 8; sidx = ((size_t)(l * NBS + bs) * 4 + h) * 4096; }
    else { const int bh = item >> 7, j = item & 127; h = bh & 3; m0 = (bh >> 2) * TSEQ + j * HG_L; ntok = HG_L; sidx = (size_t)item * 4096; }
    float S[64];
    if (MODE == 0) {
#pragma unroll
        for (int k = 0; k < 64; ++k) S[k] = 0.f;
    } else { const float* s0 = MODE == 2 ? A.in[I_SHGRN] + sidx : C.ws<float>(WS_SST) + sidx;
#pragma unroll
        for (int k = 0; k < 64; ++k) S[k] = s0[k * 64 + lane]; }
    const float gn = A.in[I_HNG][l * 64 + lane];
    float lfsum = 0.f;
    for (int c0 = 0; c0 < ntok; c0 += 16) {
        const int nt = (ntok - c0) < 16 ? (ntok - c0) : 16;
        for (int tt = 0; tt < nt; ++tt) { const size_t o = (size_t)(m0 + c0 + tt) * 256 + h * 64 + lane; const float lf = LF[o]; lfsum += lf;
            Fs[tt * 64 + lane] = __expf(lf); Ks[tt * 64 + lane] = bf2f(KD[o]); if (MODE != 0) Qs[tt * 64 + lane] = bf2f(QD[o]); }
        LDS_WAIT();
#pragma unroll 1
        for (int tt = 0; tt < nt; ++tt) {
            const int m = m0 + c0 + tt; const size_t o = (size_t)m * 256 + h * 64 + lane;
            const float vd = bf2f(VD[o]); float oacc = 0.f;
#pragma unroll
            for (int k4 = 0; k4 < 16; ++k4) {
                const f32x4 f = *(const LAS f32x4*)(Fs + tt * 64 + 4 * k4), kd = *(const LAS f32x4*)(Ks + tt * 64 + 4 * k4);
                S[4 * k4 + 0] = f.x * S[4 * k4 + 0] + kd.x * vd; S[4 * k4 + 1] = f.y * S[4 * k4 + 1] + kd.y * vd;
                S[4 * k4 + 2] = f.z * S[4 * k4 + 2] + kd.z * vd; S[4 * k4 + 3] = f.w * S[4 * k4 + 3] + kd.w * vd;
                if (MODE != 0) { const f32x4 q = *(const LAS f32x4*)(Qs + tt * 64 + 4 * k4);
                    oacc += S[4 * k4 + 0] * q.x + S[4 * k4 + 1] * q.y + S[4 * k4 + 2] * q.z + S[4 * k4 + 3] * q.w; }
            }
            if (MODE != 0) { const float ss = wave_sum(oacc * oacc) * (1.f / 64.f);
                const float on = oacc * rsqrtf(ss + EPS) * gn * bf2f(GD[o]);
                MIX[(size_t)m * DM + 768 + h * 64 + lane] = (bf16)f2bf(on); }
        }
        LDS_WAIT();
    }
    if (MODE == 0) { float* sl = C.ws<float>(WS_SLOC) + sidx;
#pragma unroll
        for (int k = 0; k < 64; ++k) sl[k * 64 + lane] = S[k];
        C.ws<float>(WS_DTOT)[(size_t)item * 64 + lane] = __expf(lfsum); }
    if (MODE == 2) { float* so = A.out + O_HS + sidx;
#pragma unroll
        for (int k = 0; k < 64; ++k) so[k * 64 + lane] = S[k]; }
}
__device__ __forceinline__ void hgrn_scan_unit(const Ctx& C, int l, int u) {
    const int seg = C.tid >> 6, kvl = C.tid & 63, bh = u >> 6, kv = (u & 63) * 64 + kvl, k = kv >> 6;
    const float* sl = C.ws<float>(WS_SLOC) + ((size_t)bh * HG_NB + seg * 16) * 4096 + kv; float* ss = C.ws<float>(WS_SST) + ((size_t)bh * HG_NB + seg * 16) * 4096 + kv;
    const float* dt = C.ws<float>(WS_DTOT) + ((size_t)bh * HG_NB + seg * 16) * 64 + k;
    LAS f32x2v* X = (LAS f32x2v*)C.lds;
    float a[16], d[16];
#pragma unroll
    for (int j = 0; j < 16; ++j) { a[j] = sl[(size_t)j * 4096]; d[j] = dt[j * 64]; }
    float D = 1.f, Acc = 0.f;
#pragma unroll
    for (int j = 0; j < 16; ++j) { Acc = d[j] * Acc + a[j]; D *= d[j]; }
    X[seg * 64 + kvl] = (f32x2v){D, Acc};
    __syncthreads();
    float S = 0.f;
    for (int q = 0; q < seg; ++q) { const f32x2v x = X[q * 64 + kvl]; S = x.x * S + x.y; }
#pragma unroll
    for (int j = 0; j < 16; ++j) { ss[(size_t)j * 4096] = S; S = d[j] * S + a[j]; }
    if (seg == 7) C.a->out[O_HP + ((size_t)l * 8 + bh) * 4096 + kv] = S;
    __syncthreads();
}

__device__ __forceinline__ void attn_unit_naive(const Ctx& C, int l, int u) {
    const CAS Args& A = *C.a; const bf16 *Qb = C.ws<bf16>(WS_Q), *Kb = C.ws<bf16>(WS_KR), *Vb = C.ws<bf16>(WS_VR), *GA = C.ws<bf16>(WS_GA); bf16* MIX = C.ws<bf16>(WS_MIX);
    const int bh = u & 7, qb = 31 - (u >> 3), b = bh >> 2, h = bh & 3;
    const int map = C.tid >> 8, qi = C.tid & 255, t = qb * 256 + qi; const size_t m = (size_t)b * TSEQ + t;
    LAS unsigned* Ksm = (LAS unsigned*)C.lds;
    LAS unsigned* Vsm = (LAS unsigned*)(C.lds + 32768);
    LAS float* O2 = (LAS float*)C.lds;
    float q[32], acc[64];
    { const v4u* qp = (const v4u*)(Qb + m * 256 + h * 64 + map * 32);
#pragma unroll
        for (int i = 0; i < 4; ++i) { const v4u w = qp[i]; q[8 * i] = bflo(w.x); q[8 * i + 1] = bfhi(w.x); q[8 * i + 2] = bflo(w.y); q[8 * i + 3] = bfhi(w.y); q[8 * i + 4] = bflo(w.z); q[8 * i + 5] = bfhi(w.z); q[8 * i + 6] = bflo(w.w); q[8 * i + 7] = bfhi(w.w); } }
#pragma unroll
    for (int d = 0; d < 64; ++d) acc[d] = 0.f;
    float mx = -1e30f, lsum = 0.f;
    for (int kt = 0; kt <= qb; ++kt) {
        __syncthreads();
        for (int p = C.tid; p < 4096; p += NTHR) { const int arr = p >> 11, row = (p >> 3) & 255, pc = p & 7;
            const bf16* src = (arr ? Vb : Kb) + ((size_t)b * TSEQ + kt * 256 + row) * 256 + h * 64 + pc * 8;
            *(LAS v4u*)((arr ? Vsm : Ksm) + row * 32 + pc * 4) = *(const v4u*)src; }
        __syncthreads();
        const int jn = (kt == qb) ? 256 : 256;
#pragma unroll 1
        for (int j = 0; j < jn; ++j) {
            if (kt * 256 + j > t) break;
            const LAS v4u* kp = (const LAS v4u*)(Ksm + j * 32 + map * 16);
            float s = 0.f;
#pragma unroll
            for (int i = 0; i < 4; ++i) { const v4u w = kp[i];
                s += q[8 * i] * bflo(w.x) + q[8 * i + 1] * bfhi(w.x) + q[8 * i + 2] * bflo(w.y) + q[8 * i + 3] * bfhi(w.y) + q[8 * i + 4] * bflo(w.z) + q[8 * i + 5] * bfhi(w.z) + q[8 * i + 6] * bflo(w.w) + q[8 * i + 7] * bfhi(w.w); }
            if (s > mx) { const float sc = exp2f(mx - s); lsum *= sc;
#pragma unroll
                for (int d = 0; d < 64; ++d) acc[d] *= sc;
                mx = s; }
            const float p = exp2f(s - mx); lsum += p;
            const LAS v4u* vp = (const LAS v4u*)(Vsm + j * 32);
#pragma unroll
            for (int i = 0; i < 8; ++i) { const v4u w = vp[i];
                acc[8 * i] += p * bflo(w.x); acc[8 * i + 1] += p * bfhi(w.x); acc[8 * i + 2] += p * bflo(w.y); acc[8 * i + 3] += p * bfhi(w.y);
                acc[8 * i + 4] += p * bflo(w.z); acc[8 * i + 5] += p * bfhi(w.z); acc[8 * i + 6] += p * bflo(w.w); acc[8 * i + 7] += p * bfhi(w.w); }
        }
    }
    __syncthreads();
    const float il = 1.f / lsum;
    if (map == 1) {
#pragma unroll
        for (int d = 0; d < 64; ++d) O2[qi * 65 + d] = acc[d] * il;
    }
    __syncthreads();
    if (map == 0) {
        const float lam = C.ws<float>(WS_SCAL)[l]; const float lam_init = l == 0 ? 0.2f : 0.35550906759096934f;
        float ss = 0.f;
#pragma unroll
        for (int d = 0; d < 64; ++d) { acc[d] = acc[d] * il - lam * O2[qi * 65 + d]; ss += acc[d] * acc[d]; }
        const float rs = rsqrtf(ss * (1.f / 64.f) + EPS) * (1.f - lam_init);
        const float* g = A.in[I_ANG] + l * 64;
#pragma unroll
        for (int d = 0; d < 64; d += 2) { const unsigned ga = *(const unsigned*)(GA + m * 256 + h * 64 + d);
            *(unsigned*)(MIX + m * DM + h * 64 + d) = pk2(acc[d] * rs * g[d] * bflo(ga), acc[d + 1] * rs * g[d + 1] * bfhi(ga)); }
    }
    __syncthreads();
}

namespace fa {
typedef float f32x16 __attribute__((ext_vector_type(16)));
typedef short bf16x8 __attribute__((ext_vector_type(8)));
typedef short s16x4 __attribute__((ext_vector_type(4)));
typedef short v4i16_t __attribute__((ext_vector_type(4)));
typedef float f32x2_t __attribute__((ext_vector_type(2))); typedef __bf16 bf16x2_t __attribute__((ext_vector_type(2)));
constexpr int SLOT = 16384;
constexpr int LDS_WSF = 65536;
constexpr int LDS_EX = 65536 + 4096;
constexpr float THR = 32.f;
__device__ __forceinline__ float max3f(float a, float b, float c) { return __builtin_fmaxf(__builtin_fmaxf(a, b), c); }
__device__ __forceinline__ unsigned cvtpk(float lo, float hi) { f32x2_t v = {lo, hi}; bf16x2_t b = __builtin_convertvector(v, bf16x2_t); return __builtin_bit_cast(unsigned, b); }
__device__ __forceinline__ float half_swap_max(float m) { auto rr = __builtin_amdgcn_permlane32_swap(__float_as_uint(m), __float_as_uint(m), false, false); return __builtin_fmaxf(__uint_as_float(rr[0]), __uint_as_float(rr[1])); }
__device__ __forceinline__ float half_swap_sum(float m) { auto rr = __builtin_amdgcn_permlane32_swap(__float_as_uint(m), __float_as_uint(m), false, false); return __uint_as_float(rr[0]) + __uint_as_float(rr[1]); }
__device__ __forceinline__ float rowmax(const f32x16& p0, const f32x16& p1) {
    float a = max3f(p0[0], p0[1], p1[0]), b = max3f(p0[2], p0[3], p1[1]); a = max3f(a, p1[2], p1[3]);
#pragma unroll
    for (int r = 4; r < 16; r += 4) { a = max3f(a, p0[r], p0[r + 1]); b = max3f(b, p0[r + 2], p0[r + 3]); a = max3f(a, p1[r], p1[r + 1]); b = max3f(b, p1[r + 2], p1[r + 3]); }
    return half_swap_max(__builtin_fmaxf(a, b));
}
__device__ __forceinline__ s16x4 vtr(const LAS unsigned char* p) { return __builtin_bit_cast(s16x4, __builtin_amdgcn_ds_read_tr16_b64_v4i16((LAS v4i16_t*)p)); }
__device__ __forceinline__ void softmax_step(const bool FIRST, f32x16& S0, f32x16& S1, float& m, float& lsum, f32x16 (&O)[2], LAS float* wsf, int r32, int hi, bf16x8 (&pk)[4]) {
    const float rm = rowmax(S0, S1);
    if (FIRST) m = (rm != -INFINITY && fabsf(rm) > THR) ? rm : 0.f;
    else if (__any(rm - m > THR)) {
        const float mn = __builtin_fmaxf(m, rm); const float f = __builtin_amdgcn_exp2f(m - mn); m = mn; lsum *= f;
        if (hi == 0) wsf[r32] = f;
        LDS_WAIT();
#pragma unroll
        for (int g = 0; g < 4; ++g) { const f32x4 fv = *(const LAS f32x4*)(wsf + 8 * g + 4 * hi);
#pragma unroll
            for (int j = 0; j < 4; ++j) { O[0][4 * g + j] *= fv[j]; O[1][4 * g + j] *= fv[j]; } }
        LDS_WAIT();
    }
    float s = 0.f;
    if (__all(m == 0.f)) {
#pragma unroll
        for (int r = 0; r < 16; ++r) { S0[r] = __builtin_amdgcn_exp2f(S0[r]); S1[r] = __builtin_amdgcn_exp2f(S1[r]); s += S0[r] + S1[r]; }
    } else {
#pragma unroll
        for (int r = 0; r < 16; ++r) { S0[r] = __builtin_amdgcn_exp2f(S0[r] - m); S1[r] = __builtin_amdgcn_exp2f(S1[r] - m); s += S0[r] + S1[r]; }
    }
    lsum += s;
    v4u w;
    w.x = cvtpk(S0[0], S0[1]); w.y = cvtpk(S0[2], S0[3]); w.z = cvtpk(S0[4], S0[5]); w.w = cvtpk(S0[6], S0[7]); pk[0] = __builtin_bit_cast(bf16x8, w);
    w.x = cvtpk(S0[8], S0[9]); w.y = cvtpk(S0[10], S0[11]); w.z = cvtpk(S0[12], S0[13]); w.w = cvtpk(S0[14], S0[15]); pk[1] = __builtin_bit_cast(bf16x8, w);
    w.x = cvtpk(S1[0], S1[1]); w.y = cvtpk(S1[2], S1[3]); w.z = cvtpk(S1[4], S1[5]); w.w = cvtpk(S1[6], S1[7]); pk[2] = __builtin_bit_cast(bf16x8, w);
    w.x = cvtpk(S1[8], S1[9]); w.y = cvtpk(S1[10], S1[11]); w.z = cvtpk(S1[12], S1[13]); w.w = cvtpk(S1[14], S1[15]); pk[3] = __builtin_bit_cast(bf16x8, w);
}
__device__ __forceinline__ void cmask(f32x16& p0, f32x16& p1, int krel0, int qrel, int hi) {
    asm volatile("" : "+v"(hi), "+v"(qrel));
#pragma unroll
    for (int r = 0; r < 16; ++r) { const int kv = krel0 + 4 * hi + (r & 3) + 8 * (r >> 2); if (kv > qrel) p0[r] = -INFINITY; if (kv + 32 > qrel) p1[r] = -INFINITY; }
}
#define FA_MFMA(a, b, c) __builtin_amdgcn_mfma_f32_32x32x16_bf16((a), (b), (c), 0, 0, 0)
__device__ __forceinline__ void tile_step(const bool FIRST, const LAS unsigned char* slot, const bf16x8 (&qr)[4], bool band, int krel0, int qrel, int r32, int hi, int lane,
        float& m_a, float& l_a, f32x16 (&Oa)[2], float& m_b, float& l_b, f32x16 (&Ob)[2], LAS float* wsf, const bf16* Kg, const bf16* Vg) {
#if MK_CHECK == 2
    const bf16* kp = Kg + (size_t)r32 * 256 + hi * 8;
#define KFR(off) (*(const bf16x8*)(kp + ((off) >> 10 >> 1) * 16 + (((off) >> 9) & 1) * 32 * 256))
#else
    const LAS unsigned char* kp = slot + hi * 1024 + r32 * 16;
#define KFR(off) (*(const LAS bf16x8*)(kp + (off)))
#endif
    bf16x8 pa[4], pb[4];
    {   f32x16 S0, S1;
        const bf16x8 k00 = KFR(0), k01 = KFR(512), k10 = KFR(2048), k11 = KFR(2048 + 512);
        S0 = FA_MFMA(k00, qr[0], (f32x16{})); S1 = FA_MFMA(k01, qr[0], (f32x16{})); S0 = FA_MFMA(k10, qr[1], S0); S1 = FA_MFMA(k11, qr[1], S1);
        if (band) cmask(S0, S1, krel0, qrel, hi);
        softmax_step(FIRST, S0, S1, m_a, l_a, Oa, wsf, r32, hi, pa);
    }
    asm volatile("" ::: "memory");
    {   f32x16 S0, S1;
        const bf16x8 k00 = KFR(4096), k01 = KFR(4096 + 512), k10 = KFR(6144), k11 = KFR(6144 + 512);
        S0 = FA_MFMA(k00, qr[2], (f32x16{})); S1 = FA_MFMA(k01, qr[2], (f32x16{})); S0 = FA_MFMA(k10, qr[3], S0); S1 = FA_MFMA(k11, qr[3], S1);
        if (band) cmask(S0, S1, krel0, qrel, hi);
        softmax_step(FIRST, S0, S1, m_b, l_b, Ob, wsf + 64, r32, hi, pb);
    }
    asm volatile("" ::: "memory");
    const LAS unsigned char* vp = slot + 8192 + ((lane >> 4) & 1) * 32 + (lane & 3) * 8 + (4 * hi + ((lane & 15) >> 2)) * 64;
#pragma unroll
    for (int d0 = 0; d0 < 2; ++d0)
#pragma unroll
        for (int ks = 0; ks < 4; ++ks) {
#if MK_CHECK == 2
            bf16x8 vf;
#pragma unroll
            for (int j = 0; j < 8; ++j) vf[j] = (short)Vg[(size_t)(16 * ks + 8 * (j >> 2) + 4 * hi + (j & 3)) * 256 + 32 * d0 + r32];
#else
            const s16x4 lo = vtr(vp + d0 * 4096 + ks * 1024), hh = vtr(vp + d0 * 4096 + ks * 1024 + 512);
            const bf16x8 vf = (bf16x8){lo[0], lo[1], lo[2], lo[3], hh[0], hh[1], hh[2], hh[3]};
#endif
            Oa[d0] = FA_MFMA(pa[ks], vf, Oa[d0]); Ob[d0] = FA_MFMA(pb[ks], vf, Ob[d0]);
            if (ks == 3) asm volatile("" ::: "memory");
        }
#undef KFR
}
#define FA_WAITBAR() do { asm volatile("s_waitcnt vmcnt(0) lgkmcnt(0)" ::: "memory"); __builtin_amdgcn_s_barrier(); asm volatile("" ::: "memory"); } while (0)

__device__ __forceinline__ void unit(const Ctx& C, int l, int bh, int y, bf16* MIX) {
    int lane = C.lane; asm volatile("" : "+v"(lane));
    const int wid = C.wave, r32 = lane & 31, hi = lane >> 5, half = wid >> 2, wq = wid & 3;
    const int b = bh >> 2, h = bh & 3; const int q0 = 128 * y, qrel = 32 * wq + r32;
    const size_t rowbase = (size_t)b * TSEQ;
    const bf16* Qw = C.ws<bf16>(WS_Q) + (rowbase + q0 + qrel) * 256 + h * 64;
    const unsigned char* KT = C.ws<unsigned char>(WS_KT) + (size_t)bh * 128 * 8192 + wid * 1024 + lane * 16;
    const unsigned char* VT = C.ws<unsigned char>(WS_VT) + (size_t)bh * 128 * 8192 + wid * 1024 + lane * 16;
    LAS unsigned char* lds = C.lds; LAS float* wsf = (LAS float*)(lds + LDS_WSF) + wid * 128;
    bf16x8 qr[4];
#pragma unroll
    for (int d0 = 0; d0 < 4; ++d0) qr[d0] = *(const bf16x8*)(Qw + d0 * 16 + hi * 8);
    const int nsteps = y + 1;
#define FA_DMA(i) do { _Pragma("unroll") for (int hf_ = 0; hf_ < 2; ++hf_) { const int t_ = 2 * (i) + hf_; LAS unsigned char* d_ = lds + ((((i) & 1) * 2 + hf_) * SLOT) + wid * 1024; \
        __builtin_amdgcn_global_load_lds((const unsigned*)(KT + (size_t)t_ * 8192), (LAS unsigned*)d_, 16, 0, 0); \
        __builtin_amdgcn_global_load_lds((const unsigned*)(VT + (size_t)t_ * 8192), (LAS unsigned*)(d_ + 8192), 16, 0, 0); } } while (0)
    float m_a = 0.f, l_a = 0.f, m_b = 0.f, l_b = 0.f; f32x16 Oa[2], Ob[2];
    Oa[0] = f32x16{}; Oa[1] = f32x16{}; Ob[0] = f32x16{}; Ob[1] = f32x16{};
    FA_DMA(0);
    FA_WAITBAR();
#pragma unroll 1
    for (int i = 0; i < nsteps; ++i) {
        if (i + 1 < nsteps) FA_DMA(i + 1);
        const int t = 2 * i + half; const bool band = t >= 2 * y;
        tile_step(i == 0, lds + ((i & 1) * 2 + half) * SLOT, qr, band, 64 * (t - 2 * y), qrel, r32, hi, lane, m_a, l_a, Oa, m_b, l_b, Ob, wsf,
                  C.ws<bf16>(WS_KR) + (rowbase + (size_t)t * 64) * 256 + h * 64, C.ws<bf16>(WS_VR) + (rowbase + (size_t)t * 64) * 256 + h * 64);
        FA_WAITBAR();
    }
    l_a = half_swap_sum(l_a); l_b = half_swap_sum(l_b);
    LAS f32x4* EX = (LAS f32x4*)(lds + LDS_EX);
    if (hi == 0) EX[wid * 32 + r32] = (f32x4){m_a, l_a, m_b, l_b};
    FA_WAITBAR();
    {   const f32x4 o = EX[(wid ^ 4) * 32 + r32];
        const float lam = C.ws<float>(WS_SCAL)[l];
        const float Ma = __builtin_fmaxf(m_a, o.x), fa_ = __builtin_amdgcn_exp2f(m_a - Ma), fa2 = __builtin_amdgcn_exp2f(o.x - Ma); const float ca = fa_ / (l_a * fa_ + o.y * fa2);
        const float Mb = __builtin_fmaxf(m_b, o.z), fb_ = __builtin_amdgcn_exp2f(m_b - Mb), fb2 = __builtin_amdgcn_exp2f(o.z - Mb); const float cb = -lam * fb_ / (l_b * fb_ + o.w * fb2);
        if (hi == 0) { wsf[r32] = ca; wsf[64 + r32] = cb; }
        LDS_WAIT();
    }
    f32x16 part[2];
#pragma unroll
    for (int g = 0; g < 4; ++g) { const f32x4 fa4 = *(const LAS f32x4*)(wsf + 8 * g + 4 * hi), fb4 = *(const LAS f32x4*)(wsf + 64 + 8 * g + 4 * hi);
#pragma unroll
        for (int j = 0; j < 4; ++j) { part[0][4 * g + j] = Oa[0][4 * g + j] * fa4[j] + Ob[0][4 * g + j] * fb4[j]; part[1][4 * g + j] = Oa[1][4 * g + j] * fa4[j] + Ob[1][4 * g + j] * fb4[j]; } }
    LAS float* XO = (LAS float*)lds + wq * 2048;
    if (half == 1) {
#pragma unroll
        for (int r = 0; r < 16; ++r) { XO[r * 64 + lane] = part[0][r]; XO[(16 + r) * 64 + lane] = part[1][r]; }
    }
    FA_WAITBAR();
    if (half == 0) {
        const float lam_init = l == 0 ? 0.2f : 0.35550906759096934f;
        float ss[16];
#pragma unroll
        for (int r = 0; r < 16; ++r) { part[0][r] += XO[r * 64 + lane]; part[1][r] += XO[(16 + r) * 64 + lane]; ss[r] = part[0][r] * part[0][r] + part[1][r] * part[1][r]; }
#pragma unroll
        for (int r = 0; r < 16; ++r) { ss[r] = sx_sum<1>(ss[r]); ss[r] = sx_sum<2>(ss[r]); ss[r] = sx_sum<4>(ss[r]); ss[r] = sx_sum<8>(ss[r]); ss[r] = sx_sum<16>(ss[r]); }
        const float* g = C.a->in[I_ANG] + l * 64; const float g0 = g[r32], g1 = g[32 + r32];
        const bf16* GA = C.ws<bf16>(WS_GA);
#pragma unroll
        for (int r = 0; r < 16; ++r) { const size_t row = rowbase + q0 + 32 * wq + (r & 3) + 8 * (r >> 2) + 4 * hi;
            const float rs = rsqrtf(ss[r] * (1.f / 64.f) + EPS) * (1.f - lam_init);
            MIX[row * DM + h * 64 + r32] = (bf16)f2bf(part[0][r] * rs * g0 * bf2f(GA[row * 256 + h * 64 + r32]));
            MIX[row * DM + h * 64 + 32 + r32] = (bf16)f2bf(part[1][r] * rs * g1 * bf2f(GA[row * 256 + h * 64 + 32 + r32])); }
    }
    FA_WAITBAR();
#undef FA_DMA
}
}

namespace sgm {
using fa::f32x16; using fa::bf16x8;
constexpr int VT_STRIDE = 272;
__device__ __forceinline__ void unit(const Ctx& C, int l, int chunk, bf16* MIX) {
    const CAS Args& A = *C.a;
    int lane = C.lane; asm volatile("" : "+v"(lane));
    const int r32 = lane & 31, hi = lane >> 5, wid = C.wave, g = wid >> 1, th = wid & 1, tid = wid * 64 + lane;
    const bf16 *U = C.ws<bf16>(WS_U), *VN = C.ws<bf16>(WS_VN), *GB = C.ws<bf16>(WS_GB);
    const size_t m0 = (size_t)chunk * 128;
    LAS unsigned char* VT = C.lds;
    {
        const f32x4 gam = ld4(A.in[I_SGG] + l * 256 + 4 * lane), bet = ld4(A.in[I_SGB] + l * 256 + 4 * lane);
        v2u raw[16];
#pragma unroll
        for (int i = 0; i < 16; ++i) raw[i] = *(const v2u*)(VN + (m0 + wid * 16 + i) * 256 + 4 * lane);
#pragma unroll
        for (int i = 0; i < 16; ++i) { const int s_ = wid * 16 + i; const f32x4 v = (f32x4){bflo(raw[i].x), bfhi(raw[i].x), bflo(raw[i].y), bfhi(raw[i].y)};
            const float mean = wave_sum((v.x + v.y) + (v.z + v.w)) * (1.f / 256.f); const f32x4 d = v - mean;
            const float var = wave_sum((d.x * d.x + d.y * d.y) + (d.z * d.z + d.w * d.w)) * (1.f / 256.f);
            const f32x4 y = d * rsqrtf(var + EPS) * gam + bet;
            LAS unsigned char* p = VT + (4 * lane) * VT_STRIDE + s_ * 2;
            *(LAS unsigned short*)(p) = (unsigned short)f2bf(y.x); *(LAS unsigned short*)(p + VT_STRIDE) = (unsigned short)f2bf(y.y);
            *(LAS unsigned short*)(p + 2 * VT_STRIDE) = (unsigned short)f2bf(y.z); *(LAS unsigned short*)(p + 3 * VT_STRIDE) = (unsigned short)f2bf(y.w); }
    }
    __syncthreads();
    const bf16* Wm = C.ws<bf16>(WS_WSB) + (size_t)(l * 4 + g) * 128 * 128;
    f32x16 acc[2][2];
#pragma unroll
    for (int a = 0; a < 2; ++a) { acc[a][0] = f32x16{}; acc[a][1] = f32x16{}; }
#pragma unroll
    for (int tbi = 0; tbi < 2; ++tbi) {
        const int tb = 2 * th + tbi; const bf16* wrow = Wm + (size_t)(tb * 32 + r32) * 128 + 8 * hi;
        const LAS unsigned char* vb = VT + (g * 64 + r32) * VT_STRIDE + 16 * hi;
        bf16x8 af[8];
#pragma unroll
        for (int ks = 0; ks < 8; ++ks) af[ks] = *(const bf16x8*)(wrow + 16 * ks);
#pragma unroll
        for (int ks = 0; ks < 8; ++ks) { if (ks < 2 * (tb + 1)) {
            const bf16x8 b0 = *(const LAS bf16x8*)(vb + 32 * ks), b1 = *(const LAS bf16x8*)(vb + 32 * VT_STRIDE + 32 * ks);
            acc[tbi][0] = FA_MFMA(af[ks], b0, acc[tbi][0]); acc[tbi][1] = FA_MFMA(af[ks], b1, acc[tbi][1]); } }
    }
    const float* bsv = A.in[I_BS] + (l * 4 + g) * 128;
#pragma unroll
    for (int tbi = 0; tbi < 2; ++tbi)
#pragma unroll
        for (int r = 0; r < 16; ++r) { const int t = (2 * th + tbi) * 32 + (r & 3) + 8 * (r >> 2) + 4 * hi; const float bias = bsv[t];
#pragma unroll
            for (int d0 = 0; d0 < 2; ++d0) { const int col = g * 64 + 32 * d0 + r32; const size_t mo = (m0 + t) * 256 + col;
                MIX[(m0 + t) * DM + 256 + col] = (bf16)f2bf(bf2f(U[mo]) * (acc[tbi][d0][r] + bias) * bf2f(GB[mo])); } }
    __syncthreads();
}
}

namespace cvm {
using fa::f32x16; using fa::bf16x8;
constexpr int Y_OFF = 0, YN_OFF = 65536, YN_STRIDE = 528;
__device__ __forceinline__ void unit(const Ctx& C, int l, int u, bf16* MIX) {
    const CAS Args& A = *C.a;
    int lane = C.lane; asm volatile("" : "+v"(lane));
    const int wid = C.wave, tid = wid * 64 + lane, r32 = lane & 31, hi = lane >> 5;
    const float* GLU = C.ws<float>(WS_GLU); const bf16* GC = C.ws<bf16>(WS_GC);
    LAS float* Y = (LAS float*)(C.lds + Y_OFF); LAS unsigned char* YN = C.lds + YN_OFF;
    const int r0 = u * 64; const bool samp = r0 >= MP;
    {
        const int c = tid & 255, half = tid >> 8;
        float cw[31];
#pragma unroll
        for (int j = 0; j < 31; ++j) cw[j] = A.in[I_CW][(size_t)(l * 31 + j) * 256 + c];
        const float cb = A.in[I_CB][l * 256 + c];
        if (!samp) {
            const int rg = half * 32, m = r0 + rg, t0 = m & (TSEQ - 1);
            float in[62];
#pragma unroll
            for (int k = 0; k < 62; ++k) { const int tt = t0 - 30 + k; in[k] = tt >= 0 ? GLU[(size_t)(m - 30 + k) * 256 + c] : 0.f; }
#pragma unroll
            for (int i = 0; i < 32; ++i) { float y = cb;
#pragma unroll
                for (int j = 0; j < 31; ++j) y += cw[j] * in[i + j];
                Y[(rg + i) * 256 + c] = y; }
        } else {
#pragma unroll 1
            for (int gq = 0; gq < 4; ++gq) {
                const int rg = half * 32 + gq * 8, m = r0 + rg;
                float in[38];
                const int bs = (m - MP) >> 3; const float* sc = A.in[I_SCONV] + (size_t)(l * NBS + bs) * 30 * 256 + c;
#pragma unroll
                for (int k = 0; k < 30; ++k) in[k] = sc[k * 256];
#pragma unroll
                for (int k = 0; k < 8; ++k) in[30 + k] = GLU[(size_t)(m + k) * 256 + c];
#pragma unroll
                for (int i = 0; i < 8; ++i) { float y = cb;
#pragma unroll
                    for (int j = 0; j < 31; ++j) y += cw[j] * in[i + j];
                    Y[(rg + i) * 256 + c] = y; }
            }
        }
    }
    __syncthreads();
    {
        const f32x4 g = ld4(A.in[I_CNG] + l * 256 + 4 * lane), b = ld4(A.in[I_CNB] + l * 256 + 4 * lane);
#pragma unroll
        for (int i4 = 0; i4 < 2; ++i4) { f32x4 v[4]; float sm[4], sq[4];
#pragma unroll
            for (int i = 0; i < 4; ++i) { v[i] = *(const LAS f32x4*)(Y + (wid * 8 + i4 * 4 + i) * 256 + 4 * lane); sm[i] = (v[i].x + v[i].y) + (v[i].z + v[i].w); }
#pragma unroll
            for (int i = 0; i < 4; ++i) sm[i] = sx_sum<1>(sm[i]);
#pragma unroll
            for (int i = 0; i < 4; ++i) sm[i] = sx_sum<2>(sm[i]);
#pragma unroll
            for (int i = 0; i < 4; ++i) sm[i] = sx_sum<4>(sm[i]);
#pragma unroll
            for (int i = 0; i < 4; ++i) sm[i] = sx_sum<8>(sm[i]);
#pragma unroll
            for (int i = 0; i < 4; ++i) sm[i] = sx_sum<16>(sm[i]);
#pragma unroll
            for (int i = 0; i < 4; ++i) { sm[i] = sx_sum<32>(sm[i]) * (1.f / 256.f); v[i] = v[i] - sm[i]; sq[i] = (v[i].x * v[i].x + v[i].y * v[i].y) + (v[i].z * v[i].z + v[i].w * v[i].w); }
#pragma unroll
            for (int i = 0; i < 4; ++i) sq[i] = sx_sum<1>(sq[i]);
#pragma unroll
            for (int i = 0; i < 4; ++i) sq[i] = sx_sum<2>(sq[i]);
#pragma unroll
            for (int i = 0; i < 4; ++i) sq[i] = sx_sum<4>(sq[i]);
#pragma unroll
            for (int i = 0; i < 4; ++i) sq[i] = sx_sum<8>(sq[i]);
#pragma unroll
            for (int i = 0; i < 4; ++i) sq[i] = sx_sum<16>(sq[i]);
#pragma unroll
            for (int i = 0; i < 4; ++i) { const float var = sx_sum<32>(sq[i]) * (1.f / 256.f); f32x4 y = v[i] * rsqrtf(var + EPS) * g + b; y = (f32x4){silu_f(y.x), silu_f(y.y), silu_f(y.z), silu_f(y.w)};
                v2u w; w.x = pk2(y.x, y.y); w.y = pk2(y.z, y.w); *(LAS v2u*)(YN + (wid * 8 + i4 * 4 + i) * YN_STRIDE + 8 * lane) = w; } }
    }
    __syncthreads();
    {
        const int rb = wid & 1, cq = wid >> 1;
        const bf16* WT = C.ws<bf16>(WS_WPW) + (size_t)l * 256 * 256 + (size_t)(cq * 64 + r32) * 256 + 8 * hi;
        const LAS unsigned char* ya = YN + (rb * 32 + r32) * YN_STRIDE + 16 * hi;
        f32x16 acc0 = f32x16{}, acc1 = f32x16{};
#pragma unroll
        for (int kb = 0; kb < 2; ++kb) { bf16x8 b0[8], b1[8];
#pragma unroll
            for (int k8 = 0; k8 < 8; ++k8) { b0[k8] = *(const bf16x8*)(WT + 16 * (8 * kb + k8)); b1[k8] = *(const bf16x8*)(WT + 32 * 256 + 16 * (8 * kb + k8)); }
#pragma unroll
            for (int k8 = 0; k8 < 8; ++k8) { const bf16x8 af = *(const LAS bf16x8*)(ya + 32 * (8 * kb + k8)); acc0 = FA_MFMA(af, b0[k8], acc0); acc1 = FA_MFMA(af, b1[k8], acc1); } }
#pragma unroll
        for (int r = 0; r < 16; ++r) { const size_t m = (size_t)r0 + rb * 32 + (r & 3) + 8 * (r >> 2) + 4 * hi; const int d = cq * 64 + r32;
            MIX[m * DM + 512 + d] = (bf16)f2bf(acc0[r] * bf2f(GC[m * 256 + d]));
            MIX[m * DM + 512 + d + 32] = (bf16)f2bf(acc1[r] * bf2f(GC[m * 256 + d + 32])); }
    }
    __syncthreads();
}
}

namespace hg {
typedef short bf16x8 __attribute__((ext_vector_type(8)));
#define HG_MFMA(a, b, c) __builtin_amdgcn_mfma_f32_16x16x32_bf16((a), (b), (c), 0, 0, 0)
constexpr int RS = 144;
constexpr int O_QE = 0, O_QM = 16 * RS, O_KM = 32 * RS, O_KET = 48 * RS, O_VT = O_KET + 2048, O_AS = O_VT + 2048, WAVE_LDS = 12288;
static_assert(O_AS + 256 <= WAVE_LDS, "hgrn lds");
__device__ __forceinline__ unsigned pk(float a, float b) { return fa::cvtpk(a, b); }
template <int MODE> __device__ __forceinline__ void item(const Ctx& C, int l, int it, bf16* MIX) {
    const CAS Args& A = *C.a;
    int lane = C.lane; asm volatile("" : "+v"(lane));
    const int col = lane & 15, g = lane >> 4;
    const float* LF = C.ws<float>(WS_LF); const bf16 *QD = C.ws<bf16>(WS_QD), *KD = C.ws<bf16>(WS_KD), *VD = C.ws<bf16>(WS_VD), *GD = C.ws<bf16>(WS_GD);
    LAS unsigned char* W = C.lds + C.wave * WAVE_LDS;
    int h, m0, nchunk, ntok; size_t sidx;
    if (MODE == 2) { const int bs = it >> 2; h = it & 3; m0 = MP + bs * 8; nchunk = 1; ntok = 8; sidx = ((size_t)(l * NBS + bs) * 4 + h) * 4096; }
    else { const int bh = it >> 7, j = it & 127; h = bh & 3; m0 = (bh >> 2) * TSEQ + j * HG_L; nchunk = HG_L / 16; ntok = 16; sidx = (size_t)it * 4096; }
    f32x4 S[4][4];
    if (MODE == 0) {
#pragma unroll
        for (int a = 0; a < 4; ++a)
#pragma unroll
            for (int b = 0; b < 4; ++b) S[a][b] = (f32x4){0.f, 0.f, 0.f, 0.f};
    } else { const float* s0 = (MODE == 2 ? A.in[I_SHGRN] : C.ws<float>(WS_SST)) + sidx + (size_t)(4 * g) * 64 + col;
#pragma unroll
        for (int a = 0; a < 4; ++a)
#pragma unroll
            for (int b = 0; b < 4; ++b) { const float* p = s0 + (size_t)(16 * a) * 64 + 16 * b; S[a][b] = (f32x4){p[0], p[64], p[128], p[192]}; } }
    unsigned z0 = 0u; asm volatile("" : "+v"(z0));
    float lftot = 0.f;
    float rlf[16]; unsigned rkq[16]; unsigned rvv[8];
#define HG_LOAD(ch_) do { const size_t o0_ = (size_t)(m0 + (ch_) * 16) * 256 + h * 64 + lane; \
        _Pragma("unroll") for (int t = 0; t < 16; ++t) { const bool ok = t < ntok; rlf[t] = ok ? LF[o0_ + (size_t)t * 256] : 0.f; \
            rkq[t] = ok ? ((unsigned)KD[o0_ + (size_t)t * 256] | (MODE != 0 ? ((unsigned)QD[o0_ + (size_t)t * 256] << 16) : 0u)) : 0u; } \
        _Pragma("unroll") for (int t = 0; t < 16; t += 2) { const unsigned a_ = t < ntok ? (unsigned)VD[o0_ + (size_t)t * 256] : z0, b_ = t + 1 < ntok ? (unsigned)VD[o0_ + (size_t)(t + 1) * 256] : z0; rvv[t >> 1] = a_ | (b_ << 16); } } while (0)
    HG_LOAD(0);
#pragma unroll 1
    for (int ch = 0; ch < nchunk; ++ch) {
        {
            float cum[16], kd[16], q[16]; unsigned vv[8];
#pragma unroll
            for (int t = 0; t < 16; ++t) { cum[t] = rlf[t]; kd[t] = bflo(rkq[t]); q[t] = bfhi(rkq[t]); }
#pragma unroll
            for (int t = 0; t < 8; ++t) vv[t] = rvv[t];
            if (ch + 1 < nchunk) HG_LOAD(ch + 1);
#pragma unroll
            for (int t = 1; t < 16; ++t) cum[t] += cum[t - 1];
            const float cL = cum[15], cm = cum[7]; lftot += cL;
            unsigned ke[8];
#pragma unroll
            for (int t = 0; t < 16; t += 2) ke[t >> 1] = pk(kd[t] * __expf(cL - cum[t]), kd[t + 1] * __expf(cL - cum[t + 1]));
            *(LAS v4u*)(W + O_KET + lane * 32) = (v4u){ke[0], ke[1], ke[2], ke[3]}; *(LAS v4u*)(W + O_KET + lane * 32 + 16) = (v4u){ke[4], ke[5], ke[6], ke[7]};
            *(LAS v4u*)(W + O_VT + lane * 32) = (v4u){vv[0], vv[1], vv[2], vv[3]}; *(LAS v4u*)(W + O_VT + lane * 32 + 16) = (v4u){vv[4], vv[5], vv[6], vv[7]};
            *(LAS float*)(W + O_AS + lane * 4) = __expf(cL);
            if (MODE != 0) {
#pragma unroll
                for (int t = 0; t < 16; ++t) {
                    *(LAS unsigned short*)(W + O_QE + t * RS + lane * 2) = (unsigned short)f2bf(q[t] * __expf(cum[t]));
                    *(LAS unsigned short*)(W + O_QM + t * RS + lane * 2) = (unsigned short)f2bf(q[t] * __expf(cum[t] - cm));
                    *(LAS unsigned short*)(W + O_KM + t * RS + lane * 2) = (unsigned short)f2bf(kd[t] * __expf(cm - cum[t])); }
            }
        }
        LDS_WAIT(); asm volatile("" ::: "memory");
        if (MODE != 0) {
            v2u gdr[4];
            { const size_t mg = ((size_t)m0 + ch * 16 + (col < ntok ? col : 0)) * 256 + h * 64 + 4 * g;
#pragma unroll
              for (int nb = 0; nb < 4; ++nb) gdr[nb] = *(const v2u*)(GD + mg + 16 * nb); }
            f32x4 OT[4];
#pragma unroll
            for (int nb = 0; nb < 4; ++nb) OT[nb] = (f32x4){0.f, 0.f, 0.f, 0.f};
#pragma unroll
            for (int ks = 0; ks < 2; ++ks) {
                const v2u q0 = *(const LAS v2u*)(W + O_QE + col * RS + (32 * ks + 4 * g) * 2), q1 = *(const LAS v2u*)(W + O_QE + col * RS + (32 * ks + 16 + 4 * g) * 2);
                const bf16x8 bq = __builtin_bit_cast(bf16x8, (v4u){q0.x, q0.y, q1.x, q1.y});
#pragma unroll
                for (int nb = 0; nb < 4; ++nb) { const f32x4 s0 = S[2 * ks][nb], s1 = S[2 * ks + 1][nb];
                    const bf16x8 as = __builtin_bit_cast(bf16x8, (v4u){pk(s0.x, s0.y), pk(s0.z, s0.w), pk(s1.x, s1.y), pk(s1.z, s1.w)});
                    OT[nb] = HG_MFMA(as, bq, OT[nb]); }
            }
            f32x4 at = (f32x4){0.f, 0.f, 0.f, 0.f};
#pragma unroll
            for (int ks = 0; ks < 2; ++ks) { const bf16x8 ak = *(const LAS bf16x8*)(W + O_KM + col * RS + (32 * ks + 8 * g) * 2), bq = *(const LAS bf16x8*)(W + O_QM + col * RS + (32 * ks + 8 * g) * 2);
                at = HG_MFMA(ak, bq, at); }
            { const int sb = 4 * g; if (sb + 0 > col) at.x = 0.f; if (sb + 1 > col) at.y = 0.f; if (sb + 2 > col) at.z = 0.f; if (sb + 3 > col) at.w = 0.f; }
            const bf16x8 batt = __builtin_bit_cast(bf16x8, (v4u){pk(at.x, at.y), pk(at.z, at.w), z0, z0});
#pragma unroll
            for (int nb = 0; nb < 4; ++nb) { const v2u v0 = *(const LAS v2u*)(W + O_VT + (16 * nb + col) * 32 + 8 * g);
                OT[nb] = HG_MFMA(__builtin_bit_cast(bf16x8, (v4u){v0.x, v0.y, z0, z0}), batt, OT[nb]); }
            float ss = 0.f;
#pragma unroll
            for (int nb = 0; nb < 4; ++nb) ss += (OT[nb].x * OT[nb].x + OT[nb].y * OT[nb].y) + (OT[nb].z * OT[nb].z + OT[nb].w * OT[nb].w);
            ss = sx_sum<16>(ss); ss = sx_sum<32>(ss);
            const float rs = rsqrtf(ss * (1.f / 64.f) + EPS);
            if (col < ntok) { const size_t m = (size_t)m0 + ch * 16 + col;
#pragma unroll
                for (int nb = 0; nb < 4; ++nb) { const int v = 16 * nb + 4 * g; const f32x4 gn = ld4(A.in[I_HNG] + l * 64 + v); const f32x4 gd = (f32x4){bflo(gdr[nb].x), bfhi(gdr[nb].x), bflo(gdr[nb].y), bfhi(gdr[nb].y)};
                    st_bf4(MIX + m * DM + 768 + h * 64 + v, OT[nb] * rs * gn * gd); } }
        }
        {   bf16x8 ak[4], bv[4];
#pragma unroll
            for (int b = 0; b < 4; ++b) { v4u x = *(const LAS v4u*)(W + O_KET + (16 * b + col) * 32 + 16 * (g & 1)), y = *(const LAS v4u*)(W + O_VT + (16 * b + col) * 32 + 16 * (g & 1));
                if (g >= 2) { x = (v4u){z0, z0, z0, z0}; y = x; } ak[b] = __builtin_bit_cast(bf16x8, x); bv[b] = __builtin_bit_cast(bf16x8, y); }
#pragma unroll
            for (int mb = 0; mb < 4; ++mb) { const f32x4 as = *(const LAS f32x4*)(W + O_AS + (16 * mb + 4 * g) * 4);
#pragma unroll
                for (int nb = 0; nb < 4; ++nb) S[mb][nb] = HG_MFMA(ak[mb], bv[nb], S[mb][nb] * as); }
        }
        LDS_WAIT(); asm volatile("" ::: "memory");
    }
    if (MODE == 0 || MODE == 2) { float* so = (MODE == 0 ? C.ws<float>(WS_SLOC) : A.out + O_HS) + sidx + (size_t)(4 * g) * 64 + col;
#pragma unroll
        for (int a = 0; a < 4; ++a)
#pragma unroll
            for (int b = 0; b < 4; ++b) { float* p = so + (size_t)(16 * a) * 64 + 16 * b; p[0] = S[a][b].x; p[64] = S[a][b].y; p[128] = S[a][b].z; p[192] = S[a][b].w; } }
    if (MODE == 0) C.ws<float>(WS_DTOT)[(size_t)it * 64 + lane] = __expf(lftot);
#undef HG_LOAD
}
}

namespace sa {
using fa::f32x16; using fa::bf16x8; using fa::cvtpk; using fa::max3f; using fa::half_swap_max; using fa::half_swap_sum;
constexpr float THR = 8.f;
__device__ __forceinline__ bf16x8 pack8(const f32x4& a, const f32x4& b) { v4u w; w.x = cvtpk(a.x, a.y); w.y = cvtpk(a.z, a.w); w.z = cvtpk(b.x, b.y); w.w = cvtpk(b.z, b.w); return __builtin_bit_cast(bf16x8, w); }
__device__ __forceinline__ bf16x8 pack8f(const float (&v)[8]) { v4u w; w.x = cvtpk(v[0], v[1]); w.y = cvtpk(v[2], v[3]); w.z = cvtpk(v[4], v[5]); w.w = cvtpk(v[6], v[7]); return __builtin_bit_cast(bf16x8, w); }
struct Raw { f32x4 k[8]; float v[2][2][8]; };
__device__ __forceinline__ void load_tile(Raw& R, const float* krow, const float* vbase, int r32, int hi, const bool extra) {
#pragma unroll
    for (int c = 0; c < 4; ++c) { R.k[2 * c] = ld4(krow + 16 * c + 8 * hi); R.k[2 * c + 1] = ld4(krow + 16 * c + 8 * hi + 4); }
    const int voff = 4 * hi * 256 + r32;
#pragma unroll
    for (int s = 0; s < 2; ++s)
#pragma unroll
        for (int jh = 0; jh < 2; ++jh) { const float* pb = extra ? vbase : vbase + (16 * s + 8 * jh) * 256;
#pragma unroll
            for (int jl = 0; jl < 4; ++jl) { R.v[s][0][4 * jh + jl] = pb[voff + jl * 256]; R.v[s][1][4 * jh + jl] = pb[voff + jl * 256 + 32]; } }
}
struct RawK { f32x4 k[8]; }; struct RawV { f32x4 r[8]; };
__device__ __forceinline__ void load_k(RawK& R, const float* krow, int hi) {
#pragma unroll
    for (int c = 0; c < 4; ++c) { R.k[2 * c] = ld4(krow + 16 * c + 8 * hi); R.k[2 * c + 1] = ld4(krow + 16 * c + 8 * hi + 4); }
}
__device__ __forceinline__ void load_v(RawV& R, const float* vbase, int lane, const bool extra) {
#pragma unroll
    for (int i = 0; i < 8; ++i) { int kv = 4 * i + (lane >> 4); if (extra) kv &= 7; R.r[i] = ld4(vbase + (size_t)kv * 256 + 4 * (lane & 15)); }
}
__device__ __forceinline__ void item(const Ctx& C, int l, int pr, int grp, int part, bf16* MIX) {
    const CAS Args& A = *C.a;
    int lane = C.lane; asm volatile("" : "+v"(lane));
    const int col = lane & 15, g = lane >> 4, bs = pr >> 2, h = pr & 3, wid = C.wave;
    const bf16* Qb = C.ws<bf16>(WS_Q); const int* pt = (const int*)A.in[I_PT] + bs * NPAGES + part * 4;
    const float* ck = A.in[I_CK] + (size_t)l * NPOOL * PAGE * 256 + h * 64; const float* cv = A.in[I_CV] + (size_t)l * NPOOL * PAGE * 256 + h * 64;
    LAS float* wsf = (LAS float*)(C.lds + 65536) + wid * 64;
    LAS float* XM = (LAS float*)(C.lds + 65536 + 2048) + wid * 32;
    LAS float* XO = (LAS float*)C.lds + wid * 1024;
    typedef short bf16x8s __attribute__((ext_vector_type(8)));
    bf16x8s qf[2];
    { const int ts = col & 7; const bf16* qrow = Qb + ((size_t)MP + bs * 8 + ts) * 256 + h * 64 + 8 * g;
      v4u w0 = *(const v4u*)(qrow), w1 = *(const v4u*)(qrow + 32); if (col >= 8) w0 = (v4u){0u, 0u, 0u, 0u}; else w1 = (v4u){0u, 0u, 0u, 0u};
      qf[0] = __builtin_bit_cast(bf16x8s, w0); qf[1] = __builtin_bit_cast(bf16x8s, w1); }
    float m = 0.f, lsum = 0.f; f32x4 O[4];
#pragma unroll
    for (int nb = 0; nb < 4; ++nb) O[nb] = (f32x4){0.f, 0.f, 0.f, 0.f};
    const int ntiles = part == 3 ? 17 : 16;
    const int pg0 = __builtin_amdgcn_readfirstlane(pt[0]), pg1 = __builtin_amdgcn_readfirstlane(pt[1]), pg2 = __builtin_amdgcn_readfirstlane(pt[2]), pg3 = __builtin_amdgcn_readfirstlane(pt[3]);
    auto page_of = [&](int tt) -> int { const int q = tt >> 2; return q == 0 ? pg0 : (q == 1 ? pg1 : (q == 2 ? pg2 : pg3)); };
    struct RK { f32x4 k[8]; }; struct RV { f32x4 r[8]; };
    auto load_k16 = [&](RK& R, int tt) { const bool ex = tt >= 16;
        const float* base = ex ? A.out + O_KS + ((size_t)l * MS + bs * 8) * 256 + h * 64 : ck + ((size_t)page_of(tt) * PAGE + ((tt * 32) & 127)) * 256;
#pragma unroll
        for (int b = 0; b < 2; ++b) { int kv = 16 * b + col; if (ex) kv &= 7; const float* p = base + (size_t)kv * 256 + 8 * g;
#pragma unroll
            for (int ks = 0; ks < 2; ++ks) { R.k[4 * b + 2 * ks] = ld4(p + 32 * ks); R.k[4 * b + 2 * ks + 1] = ld4(p + 32 * ks + 4); } } };
    auto load_v16 = [&](RV& R, int tt) { const bool ex = tt >= 16;
        const float* base = ex ? A.out + O_VS + ((size_t)l * MS + bs * 8) * 256 + h * 64 : cv + ((size_t)page_of(tt) * PAGE + ((tt * 32) & 127)) * 256;
#pragma unroll
        for (int i = 0; i < 8; ++i) { int kv = 4 * i + (lane >> 4); if (ex) kv &= 7; R.r[i] = ld4(base + (size_t)kv * 256 + 4 * (lane & 15)); } };
    RK K0, K1; RV V0, V1;
    load_k16(K0, 0); load_v16(V0, 0); load_k16(K1, 1); load_v16(V1, 1);
    LAS float* VL = (LAS float*)(C.lds + wid * 8192);
    auto step = [&](RK& KR, RV& VR, const int t) {
        f32x4 S0 = (f32x4){0.f, 0.f, 0.f, 0.f}, S1 = S0;
#pragma unroll
        for (int ks = 0; ks < 2; ++ks) { S0 = HG_MFMA(pack8(KR.k[2 * ks], KR.k[2 * ks + 1]), qf[ks], S0); S1 = HG_MFMA(pack8(KR.k[4 + 2 * ks], KR.k[4 + 2 * ks + 1]), qf[ks], S1); }
        asm volatile("" : "+v"(S0), "+v"(S1));
        if (t + 2 < ntiles) load_k16(KR, t + 2);
        if (t == 16) {
            const int ts = col & 7;
#pragma unroll
            for (int i = 0; i < 4; ++i) { if (4 * g + i > ts) S0[i] = -INFINITY; S1[i] = -INFINITY; }
        }
        float rm = __builtin_fmaxf(max3f(S0[0], S0[1], S0[2]), max3f(S0[3], S1[0], S1[1])); rm = max3f(rm, S1[2], S1[3]);
        rm = sx_max<16>(rm); rm = sx_max<32>(rm);
        if (t == 0) m = (rm == -INFINITY) ? 0.f : rm;
        else if (__any(rm - m > THR)) {
            const float mn = __builtin_fmaxf(m, rm); const float f = __builtin_amdgcn_exp2f(m - mn); m = mn; lsum *= f;
            if (g == 0) wsf[col] = f;
            LDS_WAIT();
            const f32x4 fv = *(const LAS f32x4*)(wsf + 4 * g);
#pragma unroll
            for (int nb = 0; nb < 4; ++nb) O[nb] = O[nb] * fv;
            LDS_WAIT();
        }
#pragma unroll
        for (int i = 0; i < 4; ++i) { S0[i] = __builtin_amdgcn_exp2f(S0[i] - m); S1[i] = __builtin_amdgcn_exp2f(S1[i] - m); }
        lsum += ((S0[0] + S0[1]) + (S0[2] + S0[3])) + ((S1[0] + S1[1]) + (S1[2] + S1[3]));
        const bf16x8s pa = __builtin_bit_cast(bf16x8s, (v4u){cvtpk(S0[0], S0[1]), cvtpk(S0[2], S0[3]), cvtpk(S1[0], S1[1]), cvtpk(S1[2], S1[3])});
#pragma unroll
        for (int i = 0; i < 8; ++i) *(LAS f32x4*)(VL + (4 * i + (lane >> 4)) * 64 + 4 * (lane & 15)) = VR.r[i];
        LDS_WAIT(); asm volatile("" ::: "memory");
        if (t + 2 < ntiles) load_v16(VR, t + 2);
        const LAS float* vg = VL + 4 * g * 64 + col;
#pragma unroll
        for (int nb = 0; nb < 4; ++nb) { float a[8];
#pragma unroll
            for (int j = 0; j < 8; ++j) a[j] = vg[((j & 3) + 16 * (j >> 2)) * 64 + 16 * nb];
            O[nb] = HG_MFMA(pa, pack8f(a), O[nb]); }
        asm volatile("" : "+v"(O[0]), "+v"(O[1]), "+v"(O[2]), "+v"(O[3]));
        LDS_WAIT(); asm volatile("" ::: "memory");
    };
#pragma unroll 1
    for (int t = 0; t < ntiles; t += 2) { step(K0, V0, t); if (t + 1 < ntiles) step(K1, V1, t + 1); }
    FA_WAITBAR();
    lsum = sx_sum<16>(lsum); lsum = sx_sum<32>(lsum);
    if (g == 0) { XM[col] = m; XM[16 + col] = lsum; }
#pragma unroll
    for (int nb = 0; nb < 4; ++nb)
#pragma unroll
        for (int i = 0; i < 4; ++i) XO[(4 * g + i) * 64 + 16 * nb + col] = O[nb][i];
    FA_WAITBAR();
    if (part == 0) {
        const LAS float* XMg = (const LAS float*)(C.lds + 65536 + 2048) + grp * 4 * 32; const LAS float* XOg = (const LAS float*)C.lds + grp * 4 * 1024;
        const float lam = C.ws<float>(WS_SCAL)[l]; const float lam_init = l == 0 ? 0.2f : 0.35550906759096934f;
        float o[16];
#pragma unroll
        for (int col = 0; col < 16; ++col) {
            const float m0 = XMg[col], m1 = XMg[32 + col], m2 = XMg[64 + col], m3 = XMg[96 + col];
            const float M = __builtin_fmaxf(__builtin_fmaxf(m0, m1), __builtin_fmaxf(m2, m3));
            const float w0 = __builtin_amdgcn_exp2f(m0 - M), w1 = __builtin_amdgcn_exp2f(m1 - M), w2 = __builtin_amdgcn_exp2f(m2 - M), w3 = __builtin_amdgcn_exp2f(m3 - M);
            const float L = XMg[16 + col] * w0 + XMg[48 + col] * w1 + XMg[80 + col] * w2 + XMg[112 + col] * w3;
            o[col] = (XOg[col * 64 + lane] * w0 + XOg[1024 + col * 64 + lane] * w1 + XOg[2048 + col * 64 + lane] * w2 + XOg[3072 + col * 64 + lane] * w3) / L;
        }
        const float gn = A.in[I_ANG][l * 64 + lane]; const bf16* GA = C.ws<bf16>(WS_GA);
#pragma unroll
        for (int ts = 0; ts < 8; ++ts) { const float oa = o[ts] - lam * o[8 + ts]; const float ss = wave_sum(oa * oa) * (1.f / 64.f);
            const size_t mrow = (size_t)MP + bs * 8 + ts;
            MIX[mrow * DM + h * 64 + lane] = (bf16)f2bf(oa * rsqrtf(ss + EPS) * (1.f - lam_init) * gn * bf2f(GA[mrow * 256 + h * 64 + lane])); }
    }
    FA_WAITBAR();
}
}

__device__ __forceinline__ void attn_sample_item(const Ctx& C, int l, int item, bf16* MIXD) {
    const CAS Args& A = *C.a; const int lane = C.lane;
    const int ts = item & 7, h = (item >> 3) & 3, bs = item >> 5; const size_t m = (size_t)MP + bs * 8 + ts;
    const bf16 *Qb = C.ws<bf16>(WS_Q), *GA = C.ws<bf16>(WS_GA); bf16* MIX = C.ws<bf16>(WS_MIX);
    const int* pt = (const int*)A.in[I_PT] + bs * NPAGES;
    const float* ck = A.in[I_CK] + (size_t)l * NPOOL * PAGE * 256; const float* cv = A.in[I_CV] + (size_t)l * NPOOL * PAGE * 256;
    const float* nk = A.out + O_KS + ((size_t)l * MS + bs * 8) * 256 + h * 64; const float* nv = A.out + O_VS + ((size_t)l * MS + bs * 8) * 256 + h * 64;
    const float lam = C.ws<float>(WS_SCAL)[l]; const float lam_init = l == 0 ? 0.2f : 0.35550906759096934f;
    LAS float* scr = (LAS float*)(C.lds + 98304 + C.wave * 256);
    float mine = 0.f;
#pragma unroll 1
    for (int pass = 0; pass < 4; ++pass) {
        const int map = pass >> 1, dh = pass & 1;
        float q[32], acc[32];
        { const v4u* qp = (const v4u*)(Qb + m * 256 + h * 64 + map * 32);
#pragma unroll
            for (int i = 0; i < 4; ++i) { const v4u w = qp[i]; q[8 * i] = bflo(w.x); q[8 * i + 1] = bfhi(w.x); q[8 * i + 2] = bflo(w.y); q[8 * i + 3] = bfhi(w.y); q[8 * i + 4] = bflo(w.z); q[8 * i + 5] = bfhi(w.z); q[8 * i + 6] = bflo(w.w); q[8 * i + 7] = bfhi(w.w); } }
#pragma unroll
        for (int d = 0; d < 32; ++d) acc[d] = 0.f;
        float mx = -1e30f, lsum = 0.f;
#pragma unroll 1
        for (int kk = lane; kk < PAST + 1 + ts; kk += 64) {
            const float *kr, *vr;
            if (kk < PAST) { const int page = pt[kk >> 7]; const size_t ro = (((size_t)page * PAGE + (kk & 127)) * 4 + h) * 64; kr = ck + ro; vr = cv + ro; }
            else { kr = nk + (size_t)(kk - PAST) * 256; vr = nv + (size_t)(kk - PAST) * 256; }
            float s = 0.f;
#pragma unroll
            for (int i = 0; i < 8; ++i) { const f32x4 w = ld4(kr + map * 32 + 4 * i); s += q[4 * i] * w.x + q[4 * i + 1] * w.y + q[4 * i + 2] * w.z + q[4 * i + 3] * w.w; }
            if (s > mx) { const float sc = exp2f(mx - s); lsum *= sc;
#pragma unroll
                for (int d = 0; d < 32; ++d) acc[d] *= sc;
                mx = s; }
            const float p = exp2f(s - mx); lsum += p;
#pragma unroll
            for (int i = 0; i < 8; ++i) { const f32x4 w = ld4(vr + dh * 32 + 4 * i); acc[4 * i] += p * w.x; acc[4 * i + 1] += p * w.y; acc[4 * i + 2] += p * w.z; acc[4 * i + 3] += p * w.w; }
        }
        const float M = wave_max(mx); const float w = exp2f(mx - M); const float L = wave_sum(lsum * w); const float il = 1.f / L;
        const float coef = map == 0 ? il : -lam * il;
#pragma unroll
        for (int d = 0; d < 32; ++d) { const float r = wave_sum(acc[d] * w) * coef; if (lane == 0) scr[d] = r; }
        LDS_WAIT();
        if ((lane >> 5) == dh) mine += scr[lane & 31];
        LDS_WAIT();
    }
    const float rs = rsqrtf(wave_sum(mine * mine) * (1.f / 64.f) + EPS) * (1.f - lam_init);
    const float o = mine * rs * A.in[I_ANG][l * 64 + lane] * bf2f(GA[m * 256 + h * 64 + lane]);
    MIXD[m * DM + h * 64 + lane] = (bf16)f2bf(o);
}

__device__ __forceinline__ void ph_ln(const Ctx& C, int l) {
    const float* R = C.ws<float>(WS_R); float* Y = l == 0 ? C.ws<float>(WS_Y1) : C.a->out;
    const float* g = C.a->in[I_LNG] + l * DM; const float* b = C.a->in[I_LNB] + l * DM;
#if MK_CHECK
    const float chk_se = __hip_atomic_load((float*)(C.wsb + WS_CTL) + 64, __ATOMIC_RELAXED, __HIP_MEMORY_SCOPE_AGENT), chk_sa = __hip_atomic_load((float*)(C.wsb + WS_CTL) + 65, __ATOMIC_RELAXED, __HIP_MEMORY_SCOPE_AGENT);
#if MK_CHECK == 6
    float chk_d = 0.f, chk_w = 0.f; int chk_i = 0; { const float* cw_ = (const float*)(C.wsb + WS_CTL) + 64; for (int bi = 0; bi < 14; ++bi) { if (MK_CHECK_SEL >= 0 && bi != MK_CHECK_SEL) continue; const float e_ = __hip_atomic_load(cw_ + 2 * bi, __ATOMIC_RELAXED, __HIP_MEMORY_SCOPE_AGENT), a_ = __hip_atomic_load(cw_ + 2 * bi + 1, __ATOMIC_RELAXED, __HIP_MEMORY_SCOPE_AGENT); const float er_ = sqrtf(e_ / a_); if (er_ > 0.02f) chk_d += 0.25f; if (er_ > chk_w) { chk_w = er_; chk_i = bi; } } chk_d = MK_CHECK_MODE == 0 ? ((chk_w > 0.02f) ? 20.f + 2.f * chk_i + chk_d * 0.1f : 0.f) : (MK_CHECK_MODE == 1 ? chk_d * 8.f : 10.f * chk_w);         (void)chk_se; (void)chk_sa; }
#else
    const float chk_d = 10.f * sqrtf(chk_se / chk_sa);
#endif
#endif
    auto finish = [&](f32x4 (&v)[4], int m) __attribute__((always_inline)) {
        float s = 0.f;
#pragma unroll
        for (int j = 0; j < 4; ++j) s += (v[j].x + v[j].y) + (v[j].z + v[j].w);
        const float mean = wave_sum(s) * (1.f / DM); float s2 = 0.f;
#pragma unroll
        for (int j = 0; j < 4; ++j) { v[j] = v[j] - mean; s2 += (v[j].x * v[j].x + v[j].y * v[j].y) + (v[j].z * v[j].z + v[j].w * v[j].w); }
        const float rstd = rsqrtf(wave_sum(s2) * (1.f / DM) + EPS);
#pragma unroll
        for (int j = 0; j < 4; ++j) { const int col = 4 * C.lane + 256 * j; f32x4 yv = v[j] * rstd * ld4(g + col) + ld4(b + col);
#if MK_CHECK
            if (l == 1) yv.x += chk_d;
#endif
            st4(Y + (size_t)m * DM + col, yv);
            if (l == 0) { const float* md = C.ws<float>(WS_MOD) + (size_t)(NBT + batch_of(m)) * 3072;
                st_bf4(C.ws<bf16>(WS_H) + (size_t)m * DM + col, yv * (1.f + ld4(md + 1024 + col)) + ld4(md + col)); } }
    };
    f32x4 nx[4];
    if (C.gw() < MP) {
#pragma unroll
        for (int j = 0; j < 4; ++j) nx[j] = ld4(R + (size_t)C.gw() * DM + 4 * C.lane + 256 * j); }
#ifndef NO_SLN
    for (int m = MP + C.wave * C.G + C.bid; m < MT; m += C.ngw()) {
        const float* xr = l == 0 ? C.a->in[I_XS] + (size_t)(m - MP) * DM : C.ws<float>(WS_Y1) + (size_t)m * DM;
        const float* gr = C.ws<float>(WS_MOD) + (size_t)l * NBT * 3072 + 2048 + (size_t)batch_of(m) * 3072;
        const float* pp = C.ws<float>(WS_PART) + (size_t)(m - MP) * DM;
        f32x4 v[4];
#pragma unroll
        for (int j = 0; j < 4; ++j) { const int col = 4 * C.lane + 256 * j; f32x4 a = ld4(pp + col);
#pragma unroll
            for (int ks = 1; ks < OUT_KS; ++ks) a = a + ld4(pp + (size_t)ks * MS * DM + col);
            v[j] = ld4(xr + col) * ALPHA + ld4(gr + col) * a; }
        finish(v, m);
    }
#endif
    for (int m = C.gw(); m < MP; m += C.ngw()) {
        f32x4 v[4];
#pragma unroll
        for (int j = 0; j < 4; ++j) v[j] = nx[j];
        if (m + C.ngw() < MP) {
#pragma unroll
            for (int j = 0; j < 4; ++j) nx[j] = ld4(R + (size_t)(m + C.ngw()) * DM + 4 * C.lane + 256 * j); }
        finish(v, m);
    }
}

struct ModB { float t[8][8]; };
__device__ __forceinline__ void mod_strip_load(const Ctx& C, int strip, ModB& B) {
    const int n0 = 32 * strip, l = n0 >= 3072 ? 1 : 0, j0 = n0 - l * 3072;
    const float* W = C.a->in[I_WADA] + (size_t)l * DM * 3072 + (size_t)(128 * C.wave + 8 * (C.lane >> 5)) * 3072 + j0 + (C.lane & 31);
#pragma unroll
    for (int s_ = 0; s_ < 8; ++s_)
#pragma unroll
        for (int j = 0; j < 8; ++j) B.t[s_][j] = W[(size_t)(16 * s_ + j) * 3072];
}
__device__ __forceinline__ void mod_strip_mma(const Ctx& C, int strip, const ModB& B) {
    using fa::f32x16; using fa::bf16x8;
    const int n0 = 32 * strip, l = n0 >= 3072 ? 1 : 0, j0 = n0 - l * 3072;
    const bf16* A = C.ws<bf16>(WS_SC) + (size_t)(C.lane & 31) * DM + 128 * C.wave + 8 * (C.lane >> 5);
    f32x16 acc[5];
#pragma unroll
    for (int t = 0; t < 5; ++t)
#pragma unroll
        for (int r = 0; r < 16; ++r) acc[t][r] = 0.f;
#pragma unroll
    for (int s_ = 0; s_ < 8; ++s_) {
        const bf16x8 bf = sa::pack8f(B.t[s_]);
#pragma unroll
        for (int t = 0; t < 5; ++t) { const bf16x8 af = *(const GAS bf16x8*)(A + (size_t)(32 * t) * DM + 16 * s_); acc[t] = FA_MFMA(af, bf, acc[t]); }
    }
    LAS float* red = (LAS float*)C.lds;
    float* mod = C.ws<float>(WS_MOD) + (size_t)l * NBT * 3072 + j0 + (C.lane & 31);
    const float bias = C.a->in[I_BADA][n0 + (C.lane & 31)];
#pragma unroll
    for (int p = 0; p < 2; ++p) {
        const int T0 = p == 0 ? 0 : 3, NT = p == 0 ? 3 : 2, NS = NT * 16;
        __syncthreads();
#pragma unroll
        for (int t = 0; t < NT; ++t)
#pragma unroll
            for (int r = 0; r < 16; ++r) red[((size_t)C.wave * NS + t * 16 + r) * 64 + C.lane] = acc[T0 + t][r];
        __syncthreads();
        for (int q = 0; q < NS / 8; ++q) { const int slot = C.wave * (NS / 8) + q, t = T0 + (slot >> 4), r = slot & 15;
            float v = bias;
#pragma unroll
            for (int w = 0; w < 8; ++w) v += red[((size_t)w * NS + slot) * 64 + C.lane];
            const int m = 32 * t + (r & 3) + 8 * (r >> 2) + 4 * (C.lane >> 5);
            if (m < NBT) mod[(size_t)m * 3072] = v; }
    }
    __syncthreads();
}

constexpr int NPL = 8, NPH = 2 + 2 * NPL;
#ifndef MK_ONE_LAUNCH
#define MK_ONE_LAUNCH 1
#endif
__global__ void __launch_bounds__(NTHR, 2) mk_fwd(Args args) {
    extern __shared__ __attribute__((aligned(16))) unsigned char lds[];
    Ctx C; C.a = (const CAS Args*)__builtin_amdgcn_kernarg_segment_ptr(); C.wsb = args.ws; C.lds = (LAS unsigned char*)lds; C.tid = threadIdx.x; C.lane = C.tid & 63; C.wave = __builtin_amdgcn_readfirstlane(C.tid >> 6); C.G = gridDim.x; C.bid = blockIdx.x;
    volatile LAS unsigned* MISC = (volatile LAS unsigned*)(C.lds + MISC_OFF);
    for (int u = C.tid; u < (LDS_BYTES - RING_BYTES) / 4; u += NTHR) ((LAS unsigned*)(C.lds + RING_BYTES))[u] = 0u;
    __syncthreads();
    XcdBarrier bar; bar.bar = (unsigned*)(args.ws + WS_CTL) + CW_BAR; bar.x = 0; bar.st = nullptr;
    if (MK_ONE_LAUNCH) bar = xcd_barrier_post((unsigned*)(args.ws + WS_CTL) + CW_BAR, MISC + 8);
    const int lo = args.ph_lo, hi = args.ph_hi;
#ifndef MK_MASK
#define MK_MASK 0x3ff
#endif
#define ON(j) ((MK_MASK >> (j)) & 1)
#define IN(k) (lo <= (k) && (k) < hi)
#define SEAM(k) do { if (MK_ONE_LAUNCH && IN(k) && IN((k) + 1)) { const Ctx Pb = launder(C, args); XcdBarrier bb = bar; unsigned* bp_ = (unsigned*)(Pb.wsb + WS_CTL) + CW_BAR; asm volatile("" : "+s"(bp_)); bb.bar = bp_; unsigned bx_ = bar.x; asm volatile("" : "+s"(bx_)); bb.x = bx_; xcd_barrier(bb, Pb.tid); } } while (0)

    if (ON(8) && IN(0)) {
        const Ctx P = launder(C, args);
        ModB MB;
        const bool strip = P.bid < 192;
        if (strip) mod_strip_load(P, P.bid, MB);
        p0_prologue<0>(P, P.gw(), P.ngw(), [] {});
        if (MK_ONE_LAUNCH) xcd_barrier(bar, P.tid);
        if (strip) mod_strip_mma(P, P.bid, MB);
#pragma unroll 1
        for (int st = P.bid + P.G; st < 192; st += P.G) { mod_strip_load(P, st, MB); mod_strip_mma(P, st, MB); }
    } SEAM(0);
#pragma unroll 1
    for (int l = 0; l < 2; ++l) {
        const int pb = 2 + l * NPL;
        if (l == 0) { if (ON(0) && IN(pb + 0)) { const Ctx P = launder(C, args); p0_prologue<1>(P, P.gw(), P.ngw(), [&] { ph_hbuild(P, 0); }); } SEAM(pb + 0); }
        if (ON(1) && IN(pb + 1)) {
            const Ctx P = launder(C, args);
#if MK_CHECK == 6
            {   pg8::Gemm g0{P.ws<bf16>(WS_H), P.ws<bf16>(WS_WIN) + (size_t)l * DIN * DM, MT, DIN, DM}; pg8::StaticOrder S0; S0.init(MT, DIN, P.G, P.bid);
                float* Z = P.ws<float>(WS_Z);
                auto f = [=](int row, int col, const pg8::f32x4& v) { st4(Z + (size_t)row * DIN + col, v); };
                EpiF<decltype(f)> E0{f};
                pg8::gemm_phase<EpiF<decltype(f)>, pg8::StaticOrder, PG8_ALIGN, PG8_SP2>(P.lds, g0, S0, E0, P.tid);
                xcd_barrier(bar, P.tid);
                Ctx P2 = P; P2.wsb = P.wsb + WS_ALT; ph_post_ref(P2, l);
                xcd_barrier(bar, P.tid);
            }
#endif
            pg8::Gemm g{P.ws<bf16>(WS_H), P.ws<bf16>(WS_WIN) + (size_t)l * DIN * DM, MT, DIN, DM}; pg8::StaticOrder S; S.init(MT, DIN, P.G, P.bid);
            EpiIn E{P.wsb, P.a->out, P.a->in[I_SGG] + l * 256, P.a->in[I_SGB] + l * 256, P.lds + RING_BYTES + 512, l};
            pg8::gemm_phase<EpiIn, pg8::StaticOrder, PG8_ALIGN, PG8_SP2>(P.lds, g, S, E, P.tid);
        } SEAM(pb + 1);
        if (ON(3) && IN(pb + 3)) {
            const Ctx P = launder(C, args);
            if (P.bid < 128) { hg::item<0>(P, l, P.bid * NWAVES + P.wave, nullptr); if (l == 0) p0_layer1_weights(P, P.bid * NWAVES + P.wave, 128 * NWAVES); }
            else cvm::unit(P, l, P.bid - 128, P.ws<bf16>(WS_MIX));
        } SEAM(pb + 3);
        if (ON(4) && IN(pb + 4)) {
            const Ctx P = launder(C, args);
            bf16* fa_dst = P.ws<bf16>(WS_MIX);
            volatile LAS int* qsel = (volatile LAS int*)(P.lds + RING_BYTES + 256);
            unsigned* ctl = (unsigned*)(P.wsb + WS_CTL);
            for (int u = P.bid; u < 512; u += P.G) hgrn_scan_unit(P, l, u);
            asm volatile("s_waitcnt vmcnt(0)" ::: "memory"); __syncthreads();
            if (P.tid == 0) { __builtin_amdgcn_fence(__ATOMIC_RELEASE, "agent"); asm volatile("s_waitcnt vmcnt(0)" ::: "memory"); __hip_atomic_fetch_add(ctl + CW_SD + l * 64, 1u, __ATOMIC_RELAXED, __HIP_MEMORY_SCOPE_AGENT); }
            const bool sample_wg = ((P.bid >> 3) & 3) == 3;
            if (sample_wg) { const int r = (P.bid >> 5) * 8 + (P.bid & 7);
#pragma unroll 1
                for (int p = r; p < 256; p += 64) sa::item(P, l, 2 * p + (P.wave >> 2), P.wave >> 2, P.wave & 3, fa_dst); }
            {   unsigned* fq = ctl + CW_FQ + l * 8 * 64;
#pragma unroll 1
                for (;;) {
                    if (P.tid == 0) { int sel = -1;
                        for (int q = 0; q < 8; ++q) { const int xq = (P.bid + q) & 7; const unsigned idx = __hip_atomic_fetch_add(fq + xq * 64, 1u, __ATOMIC_RELAXED, __HIP_MEMORY_SCOPE_AGENT); if (idx < 64u) { sel = xq * 64 + (63 - (int)idx); break; } }
                        qsel[0] = sel; }
                    __syncthreads();
                    const int sel = qsel[0];
                    __syncthreads();
                    if (sel < 0) break;
                    fa::unit(P, l, sel >> 6, sel & 63, fa_dst);
                }
            }
            {   unsigned* gq = ctl + CW_GQ + l * 64;
#pragma unroll 1
                for (;;) {
                    if (P.tid == 0) { const unsigned idx = __hip_atomic_fetch_add(gq, 1u, __ATOMIC_RELAXED, __HIP_MEMORY_SCOPE_AGENT); qsel[0] = idx < 400u ? (int)idx : -1; }
                    __syncthreads();
                    const int u = qsel[0];
                    __syncthreads();
                    if (u < 0) break;
                    if (u < 144) cvm::unit(P, l, u + 128, fa_dst);
                    else if (u < 272) sgm::unit(P, l, u - 144, fa_dst);
                    else sg_unit(P, l, u - 272 + 128);
                }
            }
            if (P.tid == 0) { unsigned sp = 0; while (__hip_atomic_load(ctl + CW_SD + l * 64, __ATOMIC_RELAXED, __HIP_MEMORY_SCOPE_AGENT) < (unsigned)P.G) { __builtin_amdgcn_s_sleep(2); if (++sp > (1u << 22)) break; }
                __builtin_amdgcn_fence(__ATOMIC_ACQUIRE, "agent"); asm volatile("s_waitcnt vmcnt(0)" ::: "memory"); }
            __syncthreads();
            {   unsigned* hq = ctl + CW_HQ + l * 64;
#pragma unroll 1
                for (;;) {
                    if (P.tid == 0) { const unsigned idx = __hip_atomic_fetch_add(hq, 1u, __ATOMIC_RELAXED, __HIP_MEMORY_SCOPE_AGENT); qsel[0] = idx < 192u ? (int)idx : -1; }
                    __syncthreads();
                    const int u = qsel[0];
                    __syncthreads();
                    if (u < 0) break;
                    if (u < 128) hg::item<1>(P, l, u * NWAVES + P.wave, fa_dst);
                    else hg::item<2>(P, l, (u - 128) * NWAVES + P.wave, fa_dst);
                }
            }
        } SEAM(pb + 4);
        if (ON(6) && IN(pb + 6)) {
            const Ctx P = launder(C, args);
#if MK_CHECK == 8
            {
                for (int u = P.bid; u < 512; u += P.G) attn_sample_item(P, l, u * NWAVES + P.wave, P.ws<bf16>(WS_MIXCHK));
                xcd_barrier(bar, P.tid);
            }
#endif
#if MK_CHECK == 4
            {
                for (int u = P.bid; u < 1088; u += P.G) conv_unit(P, l, u, P.ws<bf16>(WS_MIXCHK));
                xcd_barrier(bar, P.tid);
            }
#endif
#if MK_CHECK == 7
            {
                for (int u = P.bid; u < 128 + 64; u += P.G) { if (u < 128) hg::item<1>(P, l, u * NWAVES + P.wave, P.ws<bf16>(WS_MIXCHK)); else hg::item<2>(P, l, (u - 128) * NWAVES + P.wave, P.ws<bf16>(WS_MIXCHK)); }
                xcd_barrier(bar, P.tid);
            }
#endif
#if MK_CHECK && MK_CHECK != 6
            {   const bf16* A0 = P.ws<bf16>(WS_MIX); const bf16* A1 = P.ws<bf16>(WS_MIXCHK); float se = 0.f, sa = 0.f;
                for (int m = P.gw(); m < MK_CHECK_ROWS; m += P.ngw()) { if (m < MK_CHECK_ROW0) continue; const f32x4 a = ld_bf4(A0 + (size_t)m * DM + MK_CHECK_COL0 + 4 * P.lane), b = ld_bf4(A1 + (size_t)m * DM + MK_CHECK_COL0 + 4 * P.lane);
#pragma unroll
                    for (int j = 0; j < 4; ++j) { const float d = a[j] - b[j]; se += d * d; sa += a[j] * a[j]; } }
                se = wave_sum(se); sa = wave_sum(sa);
                if (P.lane == 0) { atomicAdd((float*)(P.wsb + WS_CTL) + 64, se); atomicAdd((float*)(P.wsb + WS_CTL) + 65, sa); } }
#endif
            pg8::Gemm g{P.ws<bf16>(WS_MIX), P.ws<bf16>(WS_WOUT) + (size_t)l * DM * DM, MP, DM, DM}; pg8::StaticOrder S; S.init(MP, DM, P.G, P.bid);
            EpiResid E{P.a->in[I_XP], P.a->in[I_XS], P.ws<float>(WS_Y1), P.ws<float>(WS_MOD) + (size_t)l * NBT * 3072 + 2048, P.ws<float>(WS_R), l};
            pg8::gemm_phase<EpiResid, pg8::StaticOrder, PG8_ALIGN, PG8_SP2>(P.lds, g, S, E, P.tid);
#ifndef NO_PCS
#pragma unroll 1
            for (int pc = P.bid; pc < OUT_PIECES; pc += P.G) {
                const Ctx P2 = launder(C, args);
                const int ks = pc >> 4; const size_t ko = (size_t)ks * (DM / OUT_KS);
                pg8::Gemm g2{P2.ws<bf16>(WS_MIX) + ko, P2.ws<bf16>(WS_WOUT) + (size_t)l * DM * DM + ko, MT, DM, DM / OUT_KS, DM}; PieceOrder S2{pc & 15};
                EpiPart E2{P2.ws<float>(WS_PART) + (size_t)ks * MS * DM};
                pg8::gemm_phase<EpiPart, PieceOrder, PG8_ALIGN, PG8_SP2>(P2.lds, g2, S2, E2, P2.tid);
            }
#endif
        } SEAM(pb + 6);
        if (ON(7) && IN(pb + 7)) { const Ctx P = launder(C, args); ph_ln(P, l); } SEAM(pb + 7);
    }
#undef IN
#undef SEAM
}

extern "C" void kernel_launch(void* const* d_in, const int* in_sizes, int n_in, void* d_out, int out_size, void* d_ws, size_t ws_size, hipStream_t stream) {
    static int grid = 0;
    if (grid == 0) {
        if (n_in != N_IN || out_size != (int)O_END || ws_size < WS_END) { fprintf(stderr, "kernel_launch: unexpected shapes (n_in %d out %d ws %zu)\n", n_in, out_size, ws_size); grid = -1; return; }
        int dev = 0, cus = 0, per_cu = 0;
        if (hipGetDevice(&dev) != hipSuccess || hipDeviceGetAttribute(&cus, hipDeviceAttributeMultiprocessorCount, dev) != hipSuccess) { grid = -1; return; }
        if (hipFuncSetAttribute((const void*)mk_fwd, hipFuncAttributeMaxDynamicSharedMemorySize, LDS_BYTES) != hipSuccess) { fprintf(stderr, "kernel_launch: hipFuncSetAttribute failed\n"); grid = -1; return; }
        if (hipOccupancyMaxActiveBlocksPerMultiprocessor(&per_cu, (const void*)mk_fwd, NTHR, LDS_BYTES) != hipSuccess || per_cu < 1) fprintf(stderr, "kernel_launch: occupancy query says %d\n", per_cu);
        (void)hipGetLastError();
        grid = cus;
    }
    if (grid < 0) return;
    if (hipMemsetAsync((char*)d_ws + WS_CTL, 0, CTL_ZERO_BYTES, stream) != hipSuccess) return;
    Args a{};
    for (int i = 0; i < N_IN; ++i) a.in[i] = (const float*)d_in[i];
    a.out = (float*)d_out; a.ws = (unsigned char*)d_ws;
#if MK_ONE_LAUNCH
    a.ph_lo = 0; a.ph_hi = NPH;
    hipLaunchKernelGGL(mk_fwd, dim3(grid), dim3(NTHR), LDS_BYTES, stream, a);
#else
    for (int p = 0; p < NPH; ++p) { a.ph_lo = p; a.ph_hi = p + 1; hipLaunchKernelGGL(mk_fwd, dim3(grid), dim3(NTHR), LDS_BYTES, stream, a); }
#endif
}
```

```cpp
#include <hip/hip_runtime.h>
#include <cstdio>
#include <cstdint>
namespace pg8 {
#define PG8_LAS __attribute__((address_space(3)))
typedef unsigned short bf16_t;
typedef short bf16x8 __attribute__((ext_vector_type(8)));
typedef float f32x4 __attribute__((ext_vector_type(4)));
typedef unsigned u32x4 __attribute__((ext_vector_type(4)));
constexpr int BM = 256, BK = 64, HALF = 128, HTB = HALF * BK * 2  , STAGE_BYTES = 8 * HTB, NXCD = 8, WGM = 8;

__host__ __device__ __forceinline__ int lds_byte(int r, int c) { const int st = (r >> 4) * 2 + (c >> 5), rr = r & 15, cc = c & 31, ob = rr * 64 + cc * 2; return st * 1024 + (ob ^ (((ob >> 9) & 1) << 5)); }
__host__ __device__ __forceinline__ void stage_rc(int b, int& R, int& C) { const int st = b / 1024, sb = b % 1024, swz = sb ^ (((sb >> 9) & 1) << 5); R = (st >> 1) * 16 + swz / 64; C = (st & 1) * 32 + (swz % 64) / 2; }
__host__ __device__ __forceinline__ int perm32(int rho) { const int n = rho >> 4, i = rho & 15; return 8 * (i >> 2) + 4 * n + (i & 3); }

struct Unit { int pm, pn; };
struct Gemm { const bf16_t* A; const bf16_t* Bt; int M, N, K; int ld = 0; };

struct StaticOrder {
    int nM, nN, nwg, G, c;
    __host__ __device__ void init(int M, int N, int G_, int c_) { nM = M / BM; nN = N / BM; nwg = nM * nN; G = G_; c = c_; }
    __host__ __device__ bool next(int i, Unit& u) const {
        const long L = (long)i * G + c; if (L >= nwg) return false;
        int wgid = (int)L; { const int q = nwg / NXCD, r = nwg % NXCD, xcd = wgid % NXCD, off = wgid / NXCD; wgid = (xcd < r ? xcd * (q + 1) : r * (q + 1) + (xcd - r) * q) + off; }
        const int nig = WGM * nN, gid = wgid / nig, fm = gid * WGM, gsz = (nM - fm) < WGM ? (nM - fm) : WGM;
        u.pm = fm + ((wgid % nig) % gsz); u.pn = (wgid % nig) / gsz; return true;
    }
    __device__ __forceinline__ void a_ready(const Unit&) const {}
    __device__ __forceinline__ void done(const Unit&) const {}
};

__device__ __forceinline__ unsigned cvt_pk_bf16(float lo, float hi) { unsigned r; asm volatile("v_cvt_pk_bf16_f32 %0, %1, %2" : "=v"(r) : "v"(lo), "v"(hi)); return r; }
typedef float f32x2 __attribute__((ext_vector_type(2)));
__device__ __forceinline__ f32x2 gelu_pk(f32x2 v) {
    const f32x2 av = __builtin_elementwise_abs(v), d = av * 0.2316418882f + 1.0f;
    f32x2 t; t.x = __builtin_amdgcn_rcpf(d.x); t.y = __builtin_amdgcn_rcpf(d.y);
    f32x2 q = t * 0.5307027145f + (-0.7265760135f); q = q * t + 0.7107068705f; q = q * t + (-0.142248368f); q = q * t + 0.127414796f; q = q * t;
    const f32x2 s = (v * v) * (-0.72134752044f);
    f32x2 e; e.x = __builtin_amdgcn_exp2f(s.x); e.y = __builtin_amdgcn_exp2f(s.y);
    const f32x2 m = v * (q * e), r = v - m;
    f32x2 o; o.x = v.x < 0.f ? m.x : r.x; o.y = v.y < 0.f ? m.y : r.y; return o;
}
template <class Epi, class Sched, bool ALIGN_EPI = false, bool SP2 = false>
__device__ __forceinline__ void gemm_phase(PG8_LAS unsigned char* lds, const Gemm g, const Sched& S, const Epi& E, const int tid) {
    const int wid = __builtin_amdgcn_readfirstlane(tid >> 6), lane = tid & 63, wr = wid >> 2, wc = wid & 3, fr = lane & 15, fq = lane >> 4;
    const int K = g.K, LD = g.ld ? g.ld : g.K, nt = K / BK;
    unsigned voffA[2], voffB[2];
#pragma unroll
    for (int i = 0; i < 2; ++i) { int R, C; stage_rc(tid * 16 + i * 8192, R, C); const int Rb = Epi::PERM ? ((R & ~31) + perm32(R & 31)) : R;
        voffA[i] = (unsigned)(R * LD + C) * 2u; voffB[i] = (unsigned)(Rb * LD + C) * 2u; }
    const size_t kstep = (size_t)(BK * 2);
    const size_t hstep = (size_t)HALF * LD * 2;
    const size_t tstep = 2 * hstep;
    const unsigned ldsw = (unsigned)wid * 1024u;
    const int aoff = lds_byte(wr * 64 + fr, fq * 8), boff = lds_byte(wc * 32 + fr, fq * 8);
#define PG8_SA(b, h) (((b) * 2 + (h)) * HTB)
#define PG8_SB(b, h) ((4 + (b) * 2 + (h)) * HTB)
#define PG8_STAGE(bufoff, gbase, voff) do { _Pragma("unroll") for (int _i = 0; _i < 2; ++_i) \
        __builtin_amdgcn_global_load_lds((const unsigned*)((const char*)(gbase) + (voff)[_i]), (PG8_LAS unsigned*)(lds + (bufoff) + ldsw + _i * 8192), 16, 0, 0); } while (0)
#define PG8_LDA(dst, b, h) do { _Pragma("unroll") for (int m = 0; m < 4; ++m) _Pragma("unroll") for (int k = 0; k < 2; ++k) dst[m][k] = *(const PG8_LAS bf16x8*)(lds + PG8_SA(b, h) + aoff + m * 2048 + k * 1024); } while (0)
#define PG8_LDB(dst, b, h) do { _Pragma("unroll") for (int n = 0; n < 2; ++n) _Pragma("unroll") for (int k = 0; k < 2; ++k) dst[n][k] = *(const PG8_LAS bf16x8*)(lds + PG8_SB(b, h) + boff + n * 2048 + k * 1024); } while (0)
#define PG8_MMA(ai, bj, At, Bt) do { __builtin_amdgcn_s_setprio(1); _Pragma("unroll") for (int m = 0; m < 4; ++m) _Pragma("unroll") for (int n = 0; n < 2; ++n) _Pragma("unroll") for (int k = 0; k < 2; ++k) \
        acc[ai][bj][m][n] = __builtin_amdgcn_mfma_f32_16x16x32_bf16(Bt[n][k], At[m][k], acc[ai][bj][m][n], 0, 0, 0); __builtin_amdgcn_s_setprio(0); } while (0)
#define PG8_WAIT_V(n) asm volatile("s_waitcnt vmcnt(" #n ")" ::: "memory")
#define PG8_WAIT_L(n) asm volatile("s_waitcnt lgkmcnt(" #n ")" ::: "memory")
#define PG8_BAR __builtin_amdgcn_s_barrier()
#define PG8_SCHED __builtin_amdgcn_sched_barrier(0)
    Unit cur, nxt; int ui = 0;
    if (!S.next(0, cur)) return;
    f32x4 acc[2][2][4][2];
#pragma unroll
    for (int a = 0; a < 2; ++a)
#pragma unroll
        for (int b = 0; b < 2; ++b)
#pragma unroll
            for (int m = 0; m < 4; ++m)
#pragma unroll
                for (int n = 0; n < 2; ++n) acc[a][b][m][n] = (f32x4){0.f, 0.f, 0.f, 0.f};
    bf16x8 At[4][2], B0[2][2], B1[2][2];
    const char* cA = (const char*)g.A + (size_t)cur.pm * tstep; const char* cB = (const char*)g.Bt + (size_t)cur.pn * tstep;
    S.a_ready(cur);
    if constexpr (SP2) {
        PG8_STAGE(PG8_SB(0, 0), cB, voffB); PG8_STAGE(PG8_SB(0, 1), cB + hstep, voffB); PG8_STAGE(PG8_SA(0, 0), cA, voffA); PG8_STAGE(PG8_SA(0, 1), cA + hstep, voffA);
        if (wr == 1) PG8_BAR;
        PG8_WAIT_V(2); PG8_BAR;
        PG8_STAGE(PG8_SB(1, 0), cB + kstep, voffB); PG8_STAGE(PG8_SA(1, 0), cA + kstep, voffA); PG8_STAGE(PG8_SB(1, 1), cB + hstep + kstep, voffB);
        PG8_WAIT_V(6); PG8_BAR;
    } else {
        PG8_STAGE(PG8_SB(0, 0), cB, voffB); PG8_STAGE(PG8_SA(0, 0), cA, voffA); PG8_STAGE(PG8_SB(0, 1), cB + hstep, voffB); PG8_STAGE(PG8_SA(0, 1), cA + hstep, voffA);
        if (wr == 1) PG8_BAR;
        PG8_WAIT_V(4); PG8_BAR;
        PG8_STAGE(PG8_SB(1, 0), cB + kstep, voffB); PG8_STAGE(PG8_SA(1, 0), cA + kstep, voffA); PG8_STAGE(PG8_SB(1, 1), cB + hstep + kstep, voffB);
        PG8_WAIT_V(6); PG8_BAR;
    }
    for (;;) {
        const bool has_next = S.next(ui + 1, nxt);
        const char* nA = has_next ? (const char*)g.A + (size_t)nxt.pm * tstep : cA; const char* nB = has_next ? (const char*)g.Bt + (size_t)nxt.pn * tstep : cB;
        for (int t = 0; t < nt; t += 2) {
            const bool last = (t == nt - 2);
            const char* a1 = cA + (size_t)(t + 1) * kstep;
            const char* a2 = last ? nA : cA + (size_t)(t + 2) * kstep; const char* b2 = last ? nB : cB + (size_t)(t + 2) * kstep;
            const char* a3 = a2 + kstep; const char* b3 = b2 + kstep;
            if (last && has_next) S.a_ready(nxt);
            if constexpr (SP2) {
            PG8_LDB(B0, 0, 0); PG8_LDB(B1, 0, 1); PG8_SCHED; PG8_LDA(At, 0, 0); PG8_STAGE(PG8_SA(1, 1), a1 + hstep, voffA);
            PG8_WAIT_V(8); PG8_WAIT_L(0); PG8_BAR; PG8_MMA(0, 0, At, B0); PG8_MMA(0, 1, At, B1); PG8_BAR; PG8_SCHED;
            PG8_LDA(At, 0, 1); PG8_STAGE(PG8_SB(0, 0), b2, voffB); PG8_STAGE(PG8_SB(0, 1), b2 + hstep, voffB); PG8_STAGE(PG8_SA(0, 0), a2, voffA);
            PG8_WAIT_V(8); PG8_WAIT_L(0); PG8_BAR; PG8_MMA(1, 0, At, B0); PG8_MMA(1, 1, At, B1); PG8_BAR; PG8_SCHED;
            PG8_LDB(B0, 1, 0); PG8_LDB(B1, 1, 1); PG8_SCHED; PG8_LDA(At, 1, 0); PG8_STAGE(PG8_SA(0, 1), a2 + hstep, voffA);
            PG8_WAIT_V(8); PG8_WAIT_L(0); PG8_BAR; PG8_MMA(0, 0, At, B0); PG8_MMA(0, 1, At, B1); PG8_BAR; PG8_SCHED;
            PG8_LDA(At, 1, 1); PG8_STAGE(PG8_SB(1, 0), b3, voffB); PG8_STAGE(PG8_SB(1, 1), b3 + hstep, voffB); PG8_STAGE(PG8_SA(1, 0), a3, voffA);
            PG8_WAIT_V(8); PG8_WAIT_L(0); PG8_BAR; PG8_MMA(1, 0, At, B0); PG8_MMA(1, 1, At, B1); PG8_BAR; PG8_SCHED;
            } else {
            PG8_LDB(B0, 0, 0); PG8_SCHED; PG8_LDA(At, 0, 0); PG8_STAGE(PG8_SA(1, 1), a1 + hstep, voffA);
            PG8_WAIT_L(8); PG8_BAR; PG8_WAIT_L(0); PG8_MMA(0, 0, At, B0); PG8_BAR; PG8_SCHED;
            PG8_LDB(B1, 0, 1); PG8_STAGE(PG8_SB(0, 0), b2, voffB);
            PG8_BAR; PG8_WAIT_L(0); PG8_MMA(0, 1, At, B1); PG8_BAR;
            PG8_LDA(At, 0, 1); PG8_STAGE(PG8_SA(0, 0), a2, voffA);
            PG8_BAR; PG8_WAIT_L(0); PG8_MMA(1, 0, At, B0); PG8_BAR; PG8_SCHED;
            PG8_STAGE(PG8_SB(0, 1), b2 + hstep, voffB);
            PG8_WAIT_V(6); PG8_BAR; PG8_MMA(1, 1, At, B1); PG8_BAR;
            PG8_LDB(B0, 1, 0); PG8_SCHED; PG8_LDA(At, 1, 0); PG8_STAGE(PG8_SA(0, 1), a2 + hstep, voffA);
            PG8_WAIT_L(8); PG8_BAR; PG8_WAIT_L(0); PG8_MMA(0, 0, At, B0); PG8_BAR; PG8_SCHED;
            PG8_LDB(B1, 1, 1); PG8_STAGE(PG8_SB(1, 0), b3, voffB);
            PG8_BAR; PG8_WAIT_L(0); PG8_MMA(0, 1, At, B1); PG8_BAR;
            PG8_LDA(At, 1, 1); PG8_STAGE(PG8_SA(1, 0), a3, voffA);
            PG8_BAR; PG8_WAIT_L(0); PG8_MMA(1, 0, At, B0); PG8_BAR; PG8_SCHED;
            PG8_STAGE(PG8_SB(1, 1), b3 + hstep, voffB);
            PG8_WAIT_V(6); PG8_BAR; PG8_MMA(1, 1, At, B1); PG8_BAR;
            }
        }
        if constexpr (ALIGN_EPI) { if (wr == 0) PG8_BAR; }
        if constexpr (!Epi::AFTER_DRAIN) { E(acc, cur, wr, wc, fr, fq); S.done(cur); }
        if (!has_next) break;
#pragma unroll
        for (int a = 0; a < 2; ++a)
#pragma unroll
            for (int b = 0; b < 2; ++b)
#pragma unroll
                for (int m = 0; m < 4; ++m)
#pragma unroll
                    for (int n = 0; n < 2; ++n) acc[a][b][m][n] = (f32x4){0.f, 0.f, 0.f, 0.f};
        cur = nxt; cA = nA; cB = nB; ++ui;
        if constexpr (ALIGN_EPI) { if (wr == 1) PG8_BAR; }
    }
    PG8_WAIT_V(0);
    if constexpr (!ALIGN_EPI) { if (wr == 0) PG8_BAR; }
    PG8_BAR;
    if constexpr (Epi::AFTER_DRAIN) { E.fused(acc, cur, wr, wc, fr, fq, lds, wid, lane); S.done(cur); }
#undef PG8_SA
#undef PG8_SB
#undef PG8_STAGE
#undef PG8_LDA
#undef PG8_LDB
#undef PG8_MMA
#undef PG8_WAIT_V
#undef PG8_WAIT_L
#undef PG8_BAR
#undef PG8_SCHED
}
}

#ifndef PG8_SP2
#define PG8_SP2 true
#endif
#ifndef PG8_ALIGN
#define PG8_ALIGN true
#endif

#ifndef MK_CHECK
#define MK_CHECK 0
#endif
#if MK_CHECK == 8
#define MK_CHECK_ROWS MT
#define MK_CHECK_ROW0 MP
#define MK_CHECK_COL0 0
#endif
#if MK_CHECK == 7
#define MK_CHECK_ROWS MT
#define MK_CHECK_ROW0 0
#define MK_CHECK_COL0 768
#endif
#if MK_CHECK == 5
#define MK_CHECK_ROWS MT
#define MK_CHECK_ROW0 0
#define MK_CHECK_COL0 768
#endif
#if MK_CHECK == 4
#define MK_CHECK_ROWS MT
#define MK_CHECK_ROW0 0
#define MK_CHECK_COL0 512
#endif
#if MK_CHECK == 3
#define MK_CHECK_ROWS MP
#define MK_CHECK_ROW0 0
#define MK_CHECK_COL0 256
#endif
#ifndef MK_CHECK_ROWS
#define MK_CHECK_ROWS MP
#define MK_CHECK_ROW0 0
#define MK_CHECK_COL0 0
#endif
#ifndef MK_CHECK_MODE
#define MK_CHECK_MODE 2
#endif
#ifndef MK_CHECK_SEL
#define MK_CHECK_SEL -1
#endif
#ifndef MK_CHECK_TOL
#define MK_CHECK_TOL 0
#endif
#define GAS __attribute__((address_space(1)))
#define LAS __attribute__((address_space(3)))
typedef unsigned short bf16;
typedef unsigned v4u __attribute__((ext_vector_type(4)));
typedef unsigned v2u __attribute__((ext_vector_type(2)));
typedef float f32x4 __attribute__((ext_vector_type(4)));
typedef float f32x2v __attribute__((ext_vector_type(2)));
typedef GAS unsigned gu32;
#define RLX_AGENT __ATOMIC_RELAXED, __HIP_MEMORY_SCOPE_AGENT
#define LDS_WAIT() asm volatile("s_waitcnt lgkmcnt(0)" ::: "memory")
#define VM_WAIT() asm volatile("s_waitcnt vmcnt(0)" ::: "memory")
__device__ __forceinline__ unsigned f2bf(float f) { unsigned u = __builtin_bit_cast(unsigned, f); return (u + 0x7fffu + ((u >> 16) & 1u)) >> 16; }
typedef float f32x2_hw __attribute__((ext_vector_type(2))); typedef __bf16 bf16x2_hw __attribute__((ext_vector_type(2)));
__device__ __forceinline__ unsigned pk2(float lo, float hi) { f32x2_hw v = {lo, hi}; return __builtin_bit_cast(unsigned, __builtin_convertvector(v, bf16x2_hw)); }
__device__ __forceinline__ float bf2f(unsigned short b) { return __builtin_bit_cast(float, (unsigned)b << 16); }
__device__ __forceinline__ float bflo(unsigned w) { return __builtin_bit_cast(float, w << 16); }
__device__ __forceinline__ float bfhi(unsigned w) { return __builtin_bit_cast(float, w & 0xffff0000u); }
__device__ __forceinline__ float sigmoid_f(float x) { return 1.f / (1.f + __expf(-x)); }
__device__ __forceinline__ float silu_f(float x) { return x / (1.f + __expf(-x)); }
__device__ __forceinline__ float gelu_f(float x) { return 0.5f * x * (1.f + erff(x * 0.70710678118654752f)); }
template <int MASK> __device__ __forceinline__ float sx_sum(float v) {
    if (MASK == 32) { auto rr = __builtin_amdgcn_permlane32_swap(__float_as_uint(v), __float_as_uint(v), false, false); return __uint_as_float(rr[0]) + __uint_as_float(rr[1]); }
    return v + __builtin_bit_cast(float, __builtin_amdgcn_ds_swizzle(__builtin_bit_cast(int, v), (MASK << 10) | 0x1f));
}
template <int MASK> __device__ __forceinline__ float sx_max(float v) {
    if (MASK == 32) { auto rr = __builtin_amdgcn_permlane32_swap(__float_as_uint(v), __float_as_uint(v), false, false); return fmaxf(__uint_as_float(rr[0]), __uint_as_float(rr[1])); }
    return fmaxf(v, __builtin_bit_cast(float, __builtin_amdgcn_ds_swizzle(__builtin_bit_cast(int, v), (MASK << 10) | 0x1f)));
}
__device__ __forceinline__ float wave_sum(float v) { v = sx_sum<1>(v); v = sx_sum<2>(v); v = sx_sum<4>(v); v = sx_sum<8>(v); v = sx_sum<16>(v); return sx_sum<32>(v); }
__device__ __forceinline__ float wave_max(float v) { v = sx_max<1>(v); v = sx_max<2>(v); v = sx_max<4>(v); v = sx_max<8>(v); v = sx_max<16>(v); return sx_max<32>(v); }

#define XB_TMO      128
#define XB_XCNT(j)  (256  + 64 * (j))
#define XB_XSUB(j)  (1280 + 64 * (j))
#define XB_XGEN(j)  (2304 + 64 * (j))
#define XB_TOP      3328
#define XB_TOPGEN   3392
#define XCD_BAR_WORDS 3456
#define XB_SPIN_CAP (1u << 18)

__device__ __forceinline__ unsigned xb_ld(unsigned* p)              { return __hip_atomic_load(p, __ATOMIC_RELAXED, __HIP_MEMORY_SCOPE_AGENT); }
__device__ __forceinline__ unsigned xb_add(unsigned* p, unsigned v) { return __hip_atomic_fetch_add(p, v, __ATOMIC_RELAXED, __HIP_MEMORY_SCOPE_AGENT); }
__device__ __forceinline__ unsigned xb_xcc_id() { return (unsigned)__builtin_amdgcn_s_getreg((3 << 11) | 20) & 0xFu; }
#define XB_SPIN(cond, bar) do { unsigned _sp = 0; while (cond) { __builtin_amdgcn_s_sleep(1); \
    if ((++_sp & 255u) == 0u) { if (xb_ld(&(bar)[XB_TMO])) break; if (_sp > XB_SPIN_CAP) { atomicAdd(&(bar)[XB_TMO], 1u); break; } } } } while (0)

struct XcdBarrier {
    unsigned* bar; unsigned x;
    volatile LAS unsigned* st;
};
__device__ __forceinline__ XcdBarrier xcd_barrier_post(unsigned* bar, volatile LAS unsigned* st) {
    XcdBarrier b; b.bar = bar; b.x = xb_xcc_id(); b.st = st;
    if (threadIdx.x == 0) (void)xb_add(&bar[XB_XCNT(b.x)], 1u);
    return b;
}
__device__ __forceinline__ void xcd_barrier_complete(unsigned* bar, unsigned x, unsigned& nloc, unsigned& nx) {
    const unsigned G = gridDim.x * gridDim.y * gridDim.z;
    unsigned sum, cnt, mine, sp = 0u;
    for (;;) {
        sum = 0u; cnt = 0u; mine = 0u;
#pragma unroll
        for (unsigned j = 0; j < 16; ++j) { const unsigned c = xb_ld(&bar[XB_XCNT(j)]); sum += c; cnt += (c > 0u) ? 1u : 0u; mine = (j == x) ? c : mine; }
        if (sum == G) break;
        __builtin_amdgcn_s_sleep(1);
        if ((++sp & 255u) == 0u) { if (xb_ld(&bar[XB_TMO])) break; if (sp > XB_SPIN_CAP) { atomicAdd(&bar[XB_TMO], 1u); break; } }
    }
    nloc = mine > 0u ? mine : 1u; nx = cnt > 0u ? cnt : 1u;
}
__device__ __forceinline__ void xcd_barrier(const XcdBarrier& b, const int tid) {
    asm volatile("s_waitcnt vmcnt(0)" ::: "memory");
    __syncthreads();
    if (tid == 0) {
        unsigned* bar = b.bar;
        __builtin_amdgcn_s_waitcnt(0);
        unsigned nloc = b.st[0], nx = b.st[1];
        if (nloc == 0u) { xcd_barrier_complete(bar, b.x, nloc, nx); b.st[0] = nloc; b.st[1] = nx; }
        const unsigned old = xb_add(&bar[XB_XSUB(b.x)], 1u);
        const unsigned gen = old / nloc;
        if (old + 1u == (gen + 1u) * nloc) {
            __builtin_amdgcn_fence(__ATOMIC_RELEASE, "agent");
            asm volatile("s_waitcnt vmcnt(0)" ::: "memory");
            const unsigned og = xb_add(&bar[XB_TOP], 1u);
            const unsigned tg = og / nx;
            if (og + 1u == (tg + 1u) * nx) xb_add(&bar[XB_TOPGEN], 1u);
            else XB_SPIN(xb_ld(&bar[XB_TOPGEN]) == tg, bar);
            __builtin_amdgcn_fence(__ATOMIC_ACQUIRE, "agent");
            xb_add(&bar[XB_XGEN(b.x)], 1u);
            asm volatile("s_waitcnt vmcnt(0)" ::: "memory");
        } else {
            XB_SPIN(xb_ld(&bar[XB_XGEN(b.x)]) == gen, bar);
            __builtin_amdgcn_fence(__ATOMIC_ACQUIRE, "agent");
            asm volatile("s_waitcnt vmcnt(0)" ::: "memory");
        }
    }
    __syncthreads();
}

constexpr int NWAVES = 8, NTHR = 512;
constexpr int DM = 1024, MP = 16384, MS = 1024, MT = MP + MS, TSEQ = 8192, DIN = 3584, GW = 256;
constexpr int NBP = 2, NBS = 128, NBT = NBP + NBS;
constexpr int NPOOL = 2560, NPAGES = 16, PAGE = 128, PAST = 2048;
constexpr float EPS = 1e-5f;
constexpr float QSCALE = 0.25503486164919736f;
constexpr float ALPHA = 1.4142135623730951f;
constexpr int HG_L = 64, HG_NB = TSEQ / HG_L;
__device__ const double ROPE_INV[16] = {1.0, 0.5623413251903491, 0.31622776601683794, 0.1778279410038923, 0.1, 0.05623413251903491, 0.03162277660168379, 0.01778279410038923,
                                        0.01, 0.005623413251903491, 0.0031622776601683794, 0.0017782794100389228, 0.001, 0.0005623413251903491, 0.00031622776601683794, 0.00017782794100389227};
enum { I_XP = 0, I_XS, I_CK, I_CV, I_SCONV, I_SHGRN, I_PT, I_CP, I_CSM, I_WADA, I_BADA, I_WIN, I_LAMQK, I_ANG, I_SGG, I_SGB, I_WS, I_BS, I_CW, I_CB, I_CNG, I_CNB, I_WPW, I_LB, I_HNG, I_WOUT, I_LNG, I_LNB, N_IN };
constexpr size_t O_YP = 0, O_YS = O_YP + (size_t)MP * DM, O_KP = O_YS + (size_t)MS * DM, O_VP = O_KP + (size_t)2 * MP * GW, O_KS = O_VP + (size_t)2 * MP * GW,
                 O_VS = O_KS + (size_t)2 * MS * GW, O_CH = O_VS + (size_t)2 * MS * GW, O_CP = O_CH + (size_t)2 * MS * GW, O_CS = O_CP + (size_t)2 * NBP * 30 * GW,
                 O_HP = O_CS + (size_t)2 * NBS * 30 * GW, O_HS = O_HP + (size_t)2 * NBP * 4 * 4096, O_END = O_HS + (size_t)2 * NBS * 4 * 4096;
static_assert(O_END == 42432512, "output size");
constexpr size_t MiB = 1u << 20;
constexpr size_t WS_CTL = 0, CTL_ZERO_BYTES = 1 * MiB;
constexpr size_t WS_CS = 1 * MiB;
constexpr size_t WS_MOD = 2 * MiB;
constexpr size_t WS_SC = 6 * MiB;
constexpr size_t WS_SCAL = 7 * MiB;
constexpr size_t WS_WADA = 8 * MiB;
constexpr size_t WS_WIN = 20 * MiB;
constexpr size_t WS_WOUT = 34 * MiB;
constexpr size_t WS_WPW = 38 * MiB;
constexpr size_t WS_WSB = 39 * MiB;
constexpr size_t WS_H = 40 * MiB;
constexpr size_t SEG = 9 * MiB;
constexpr size_t WS_Q = 74 * MiB, WS_K = WS_Q + SEG, WS_V = WS_K + SEG, WS_GA = WS_V + SEG, WS_U = WS_GA + SEG, WS_VN = WS_U + SEG, WS_GB = WS_VN + SEG, WS_GC = WS_GB + SEG,
                 WS_QD = WS_GC + SEG, WS_KD = WS_QD + SEG, WS_VD = WS_KD + SEG, WS_GD = WS_VD + SEG;
constexpr size_t WS_KT = WS_K, WS_VT = WS_V;
constexpr size_t WS_GLU = 182 * MiB;
constexpr size_t WS_LF = 199 * MiB;
constexpr size_t WS_MIX = 216 * MiB;
constexpr size_t WS_R = 250 * MiB;
constexpr size_t WS_Y1 = 318 * MiB;
constexpr size_t WS_SLOC = 386 * MiB;
constexpr size_t WS_DTOT = 402 * MiB;
constexpr size_t WS_Z = 404 * MiB;
constexpr size_t WS_SST = 644 * MiB;
constexpr size_t WS_MIXCHK = 660 * MiB;
constexpr size_t WS_KR = 696 * MiB, WS_VR = 705 * MiB;
constexpr size_t WS_END = 714 * MiB;
constexpr size_t WS_PART = WS_Q;
constexpr int CW_BAR = 4096;
constexpr int CW_FQ = 16384;
constexpr int CW_GQ = 18432, CW_HQ = 18688, CW_SD = 18944;
constexpr int RING_BYTES = 131072, MISC_OFF = RING_BYTES + 320, LDS_BYTES = 147456;

__device__ __forceinline__ int batch_of(int m) { return m < MP ? (m >> 13) : NBP + ((m - MP) >> 3); }
struct Args { const float* in[N_IN]; float* out; unsigned char* ws; int ph_lo, ph_hi; };

#define CAS __attribute__((address_space(4)))
struct Ctx {
    const CAS Args* a; unsigned char* wsb; LAS unsigned char* lds; int tid, lane, wave, G, bid;
    __device__ __forceinline__ int gw() const { return bid * NWAVES + wave; }
    __device__ __forceinline__ int ngw() const { return G * NWAVES; }
    template <class T> __device__ __forceinline__ T* ws(size_t off) const { return (T*)(wsb + off); }
};

__device__ __forceinline__ Ctx launder(const Ctx& C, Args& shadow) {
    Ctx P = C; int t; asm volatile("v_mbcnt_lo_u32_b32 %0, -1, 0\n\tv_mbcnt_hi_u32_b32 %0, -1, %0" : "=v"(t)); t += C.wave * 64; P.tid = t; P.lane = t & 63; P.wave = __builtin_amdgcn_readfirstlane(t >> 6);
    const CAS Args* ka = (const CAS Args*)__builtin_amdgcn_kernarg_segment_ptr(); asm volatile("" : "+s"(ka)); P.a = ka;
    unsigned char* w = ka->ws; asm volatile("" : "+s"(w)); P.wsb = w;
    return P;
}
__device__ __forceinline__ f32x4 ld4(const float* p) { return *(const f32x4*)p; }
__device__ __forceinline__ void st4(float* p, f32x4 v) { *(f32x4*)p = v; }
__device__ __forceinline__ void st_bf4(bf16* p, f32x4 v) { v2u w; w.x = pk2(v.x, v.y); w.y = pk2(v.z, v.w); *(v2u*)p = w; }
__device__ __forceinline__ f32x4 ld_bf4(const bf16* p) { const v2u w = *(const v2u*)p; return (f32x4){bflo(w.x), bfhi(w.x), bflo(w.y), bfhi(w.y)}; }

template <class F> struct EpiF {
    static constexpr bool PERM = false, AFTER_DRAIN = false; F f;
    __device__ __forceinline__ void operator()(const pg8::f32x4 (&acc)[2][2][4][2], const pg8::Unit& u, int wr, int wc, int fr, int fq) const {
#pragma unroll
        for (int ai = 0; ai < 2; ++ai)
#pragma unroll
            for (int m = 0; m < 4; ++m) { const int row = u.pm * 256 + ai * 128 + wr * 64 + m * 16 + fr;
#pragma unroll
                for (int bj = 0; bj < 2; ++bj)
#pragma unroll
                    for (int n = 0; n < 2; ++n) { const int col = u.pn * 256 + bj * 128 + wc * 32 + n * 16 + 4 * fq; f(row, col, acc[ai][bj][m][n]); } }
    }
};

struct EpiResid {
    static constexpr bool PERM = false, AFTER_DRAIN = false;
    const float* xp; const float* xs; const float* y1; const float* modg; float* R; int l;
    __device__ __forceinline__ void operator()(const pg8::f32x4 (&acc)[2][2][4][2], const pg8::Unit& u, int wr, int wc, int fr, int fq) const {
#pragma unroll
        for (int ai = 0; ai < 2; ++ai)
#pragma unroll
            for (int m = 0; m < 4; ++m) { const int row = u.pm * 256 + ai * 128 + wr * 64 + m * 16 + fr;
                const float* xr = l == 0 ? (row < MP ? xp + (size_t)row * DM : xs + (size_t)(row - MP) * DM) : y1 + (size_t)row * DM;
                const float* gr = modg + (size_t)batch_of(row) * 3072; float* rr = R + (size_t)row * DM;
#pragma unroll
                for (int bj = 0; bj < 2; ++bj)
#pragma unroll
                    for (int n = 0; n < 2; ++n) { const int col = u.pn * 256 + bj * 128 + wc * 32 + n * 16 + 4 * fq;
                        st4(rr + col, ld4(xr + col) * ALPHA + ld4(gr + col) * acc[ai][bj][m][n]); }
                asm volatile("" ::: "memory"); }
    }
};

constexpr int OUT_KS = 4, OUT_PIECES = 16 * OUT_KS;
struct PieceOrder {
    int un;
    __device__ __forceinline__ bool next(int i, pg8::Unit& u) const { if (i > 0) return false; u.pm = MP / 256 + (un >> 2); u.pn = un & 3; return true; }
    __device__ __forceinline__ void a_ready(const pg8::Unit&) const {}
    __device__ __forceinline__ void done(const pg8::Unit&) const {}
};
struct EpiPart {
    static constexpr bool PERM = false, AFTER_DRAIN = false;
    float* P;
    __device__ __forceinline__ void operator()(const pg8::f32x4 (&acc)[2][2][4][2], const pg8::Unit& u, int wr, int wc, int fr, int fq) const {
#pragma unroll
        for (int ai = 0; ai < 2; ++ai)
#pragma unroll
            for (int m = 0; m < 4; ++m) { const int row = (u.pm - MP / 256) * 256 + ai * 128 + wr * 64 + m * 16 + fr; float* rr = P + (size_t)row * DM;
#pragma unroll
                for (int bj = 0; bj < 2; ++bj)
#pragma unroll
                    for (int n = 0; n < 2; ++n) { const int col = u.pn * 256 + bj * 128 + wc * 32 + n * 16 + 4 * fq; st4(rr + col, acc[ai][bj][m][n]); } }
    }
};

#define EPI_PIN(ai, m) asm volatile("" : "+v"(acc[ai][0][m][0]), "+v"(acc[ai][0][m][1]), "+v"(acc[ai][1][m][0]), "+v"(acc[ai][1][m][1]) :: "memory")
struct EpiIn {
    static constexpr bool PERM = false, AFTER_DRAIN = false;
    unsigned char* ws; float* out; const float* sgg; const float* sgb; LAS unsigned char* xl; int l;
    template <int ACT> static __device__ __forceinline__ f32x4 act4(f32x4 v) {
        if (ACT == 1) { return (f32x4){silu_f(v.x), silu_f(v.y), silu_f(v.z), silu_f(v.w)}; }
        if (ACT == 2) { const pg8::f32x2 a = pg8::gelu_pk((pg8::f32x2){v.x, v.y}), b = pg8::gelu_pk((pg8::f32x2){v.z, v.w}); return (f32x4){a.x, a.y, b.x, b.y}; }
        return v;
    }
    template <int ACT> __device__ __forceinline__ void plain(pg8::f32x4 (&acc)[2][2][4][2], int row0, int c0, size_t off) const {
        bf16* B = (bf16*)(ws + off);
#pragma unroll
        for (int ai = 0; ai < 2; ++ai)
#pragma unroll
            for (int m = 0; m < 4; ++m) { EPI_PIN(ai, m); bf16* rp = B + (size_t)(row0 + ai * 128 + m * 16) * 256 + c0;
#pragma unroll
                for (int bj = 0; bj < 2; ++bj)
#pragma unroll
                    for (int n = 0; n < 2; ++n) st_bf4(rp + bj * 128 + n * 16, act4<ACT>(acc[ai][bj][m][n]));
                asm volatile("" ::: "memory"); }
    }
    __device__ __forceinline__ void operator()(pg8::f32x4 (&acc)[2][2][4][2], const pg8::Unit& u, int wr, int wc, int fr, int fq) const {
        asm volatile("" : "+v"(fr), "+v"(fq));
        const int T = u.pn;
#define EPI_IDX int fr_ = fr, fq_ = fq; asm volatile("" : "+v"(fr_), "+v"(fq_)); const int row0 = u.pm * 256 + wr * 64 + fr_, c0 = wc * 32 + 4 * fq_; (void)row0; (void)c0
        const bool samp = u.pm >= MP / 256;
#ifndef EPI_MASK
#define EPI_MASK 0xff
#endif
        if ((EPI_MASK & 1) && (T == 0 || T == 1)) {
            EPI_IDX;
            const f32x2v* CS = (const f32x2v*)(ws + WS_CS);
#pragma unroll
            for (int ai = 0; ai < 2; ++ai)
#pragma unroll
                for (int m = 0; m < 4; ++m) { EPI_PIN(ai, m); const int row = row0 + ai * 128 + m * 16; const int r = row - MP;
                    const int pos = samp ? PAST + (r & 7) : (row & (TSEQ - 1));
                    const f32x4 cs0 = *(const f32x4*)(CS + pos * 16 + 4 * fq_), cs1 = *(const f32x4*)(CS + pos * 16 + 4 * fq_ + 2);
                    const f32x4 cosv = (f32x4){cs0.x, cs0.z, cs1.x, cs1.z}, sinv = (f32x4){cs0.y, cs0.w, cs1.y, cs1.w};
#pragma unroll
                    for (int bj = 0; bj < 2; ++bj) { const f32x4 x1 = acc[ai][bj][m][0], x2 = acc[ai][bj][m][1];
                        const f32x4 o1 = x1 * cosv - x2 * sinv, o2 = x2 * cosv + x1 * sinv; const int col = bj * 128 + c0;
                        if (T == 0) { bf16* q = (bf16*)(ws + WS_Q) + (size_t)row * 256 + col; st_bf4(q, o1 * QSCALE); st_bf4(q + 16, o2 * QSCALE); }
                        else { float* ok = out + (samp ? O_KS + ((size_t)l * MS + r) * 256 : O_KP + ((size_t)l * MP + row) * 256) + col; st4(ok, o1); st4(ok + 16, o2);
#if MK_CHECK == 1
                            { bf16* kr = (bf16*)(ws + WS_KR) + (size_t)row * 256 + col; st_bf4(kr, o1); st_bf4(kr + 16, o2); }
#endif
                            if (!samp) { const int t = row & (TSEQ - 1), bh = (row >> 13) * 4 + 2 * bj + (wc >> 1);
                                unsigned char* kt = ws + WS_KT + ((size_t)(bh * 128 + (t >> 6)) * 8192 + (4 * (wc & 1) + (fq_ >> 1)) * 1024 + (t & 63) * 16 + 8 * (fq_ & 1));
                                st_bf4((bf16*)kt, o1); st_bf4((bf16*)(kt + 2048), o2); } } }
                    asm volatile("" ::: "memory"); }
        } else if ((EPI_MASK & 2) && T == 2) {
            EPI_IDX;
#pragma unroll
            for (int ai = 0; ai < 2; ++ai)
#pragma unroll
                for (int m = 0; m < 4; ++m) { EPI_PIN(ai, m); const int row = row0 + ai * 128 + m * 16; const int r = row - MP;
#pragma unroll
                    for (int bj = 0; bj < 2; ++bj)
#pragma unroll
                        for (int n = 0; n < 2; ++n) { const f32x4 v = acc[ai][bj][m][n]; const int col = bj * 128 + n * 16 + c0;
                            st4(out + (samp ? O_VS + ((size_t)l * MS + r) * 256 : O_VP + ((size_t)l * MP + row) * 256) + col, v);
#if MK_CHECK == 1
                            st_bf4((bf16*)(ws + WS_VR) + (size_t)row * 256 + col, v);
#endif
                            if (!samp) { const int t = row & (TSEQ - 1), bh = (row >> 13) * 4 + 2 * bj + (wc >> 1), rw = t & 63;
                                st_bf4((bf16*)(ws + WS_VT + ((size_t)(bh * 128 + (t >> 6)) * 8192 + ((wc & 1) * 4 + (rw >> 4)) * 1024 + (rw & 15) * 64 + 32 * n + 8 * fq_)), v); } }
                    asm volatile("" ::: "memory"); }
        } else if ((EPI_MASK & 4) && T == 3) { EPI_IDX; plain<1>(acc, row0, c0, WS_GA); }
        else if ((EPI_MASK & 8) && T == 4) { EPI_IDX; plain<2>(acc, row0, c0, WS_U); }
        else if ((EPI_MASK & 4) && T == 6) { EPI_IDX; plain<1>(acc, row0, c0, WS_GB); }
        else if ((EPI_MASK & 4) && T == 9) { EPI_IDX; plain<1>(acc, row0, c0, WS_GC); }
        else if ((EPI_MASK & 4) && T == 10) { EPI_IDX; plain<1>(acc, row0, c0, WS_QD); }
        else if ((EPI_MASK & 4) && T == 12) { EPI_IDX; plain<0>(acc, row0, c0, WS_VD); }
        else if ((EPI_MASK & 4) && T == 13) { EPI_IDX; plain<1>(acc, row0, c0, WS_GD); }
        else if ((EPI_MASK & 16) && T == 5) { EPI_IDX; plain<2>(acc, row0, c0, WS_VN);
        } else if ((EPI_MASK & 32) && (T == 7 || T == 8)) {
            EPI_IDX;
#pragma unroll
            for (int ai = 0; ai < 2; ++ai)
#pragma unroll
                for (int m = 0; m < 4; ++m) { EPI_PIN(ai, m); const int row = row0 + ai * 128 + m * 16; const int r = row - MP;
#pragma unroll
                    for (int n = 0; n < 2; ++n) { const f32x4 a = acc[ai][0][m][n], gt = acc[ai][1][m][n]; const int col = (T - 7) * 128 + n * 16 + c0;
                        const f32x4 glu = (f32x4){a.x * sigmoid_f(gt.x), a.y * sigmoid_f(gt.y), a.z * sigmoid_f(gt.z), a.w * sigmoid_f(gt.w)};
                        st4((float*)(ws + WS_GLU) + (size_t)row * 256 + col, glu);
                        if (!samp) { const int t = row & (TSEQ - 1); if (t >= TSEQ - 30) st4(out + O_CP + ((size_t)(l * NBP + (row >> 13)) * 30 + (t - (TSEQ - 30))) * 256 + col, glu); }
                        else st4(out + O_CS + ((size_t)(l * NBS + (r >> 3)) * 30 + 22 + (r & 7)) * 256 + col, glu); }
                    asm volatile("" ::: "memory"); }
        } else if ((EPI_MASK & 64) && T == 11) {
            EPI_IDX;
            const float* lbp = (const float*)(ws + WS_SCAL) + 64;
#pragma unroll
            for (int ai = 0; ai < 2; ++ai)
#pragma unroll
                for (int m = 0; m < 4; ++m) { EPI_PIN(ai, m); const int row = row0 + ai * 128 + m * 16;
#pragma unroll
                    for (int bj = 0; bj < 2; ++bj)
#pragma unroll
                        for (int n = 0; n < 2; ++n) { const int col = bj * 128 + n * 16 + c0; f32x4 lb = (f32x4){0.f, 0.f, 0.f, 0.f}; if (l == 1) lb = ld4(lbp + col);
                            const f32x4 v = acc[ai][bj][m][n]; f32x4 f, lf;
                            f.x = lb.x + (1.f - lb.x) * sigmoid_f(v.x); f.y = lb.y + (1.f - lb.y) * sigmoid_f(v.y); f.z = lb.z + (1.f - lb.z) * sigmoid_f(v.z); f.w = lb.w + (1.f - lb.w) * sigmoid_f(v.w);
                            lf.x = __logf(fmaxf(f.x, 1e-30f)); lf.y = __logf(fmaxf(f.y, 1e-30f)); lf.z = __logf(fmaxf(f.z, 1e-30f)); lf.w = __logf(fmaxf(f.w, 1e-30f));
                            st4((float*)(ws + WS_LF) + (size_t)row * 256 + col, lf); st_bf4((bf16*)(ws + WS_KD) + (size_t)row * 256 + col, 1.f - f); } }
        }
    }
};

template <bool GLU_PERM = false> __device__ __forceinline__ void p0_transpose_item(const float* W, int K, int N, bf16* WT, int row_off, LAS float* scr, int item, int lane) {
    const int nblk = N / 32, kb = item / nblk, nb = item % nblk, k0 = 64 * kb, n0 = 32 * nb;
    int d0 = n0;
    if (GLU_PERM && n0 >= 1792 && n0 < 2304) { const int c = n0 - 1792, part = c >> 8, idx = c & 255; d0 = 1792 + (idx >> 7) * 256 + part * 128 + (idx & 127); }
    float tv[32];
#pragma unroll
    for (int i = 0; i < 32; ++i) tv[i] = W[(size_t)(k0 + 2 * i + (lane >> 5)) * N + n0 + (lane & 31)];
#pragma unroll
    for (int i = 0; i < 32; ++i) scr[(2 * i + (lane >> 5)) * 33 + (lane & 31)] = tv[i];
    LDS_WAIT(); asm volatile("" ::: "memory");
    const int c = lane & 7;
#pragma unroll
    for (int j = 0; j < 4; ++j) { const int n = (lane >> 3) + 8 * j; const LAS float* s = scr + (8 * c) * 33 + n;
        v4u o; o.x = pk2(s[0 * 33], s[1 * 33]); o.y = pk2(s[2 * 33], s[3 * 33]); o.z = pk2(s[4 * 33], s[5 * 33]); o.w = pk2(s[6 * 33], s[7 * 33]);
        *(GAS v4u*)(WT + (size_t)(row_off + d0 + n) * K + k0 + 8 * c) = o; }
    LDS_WAIT(); asm volatile("" ::: "memory");
}
struct TItem { const float* src; bf16* dst; int N, K; };
template <bool GLU_PERM = false> __device__ __forceinline__ TItem p0_titem(const float* W, int K, int N, bf16* WT, int row_off, int item, int lane) {
    const int nblk = N / 32, kb = item / nblk, nb = item % nblk, k0 = 64 * kb, n0 = 32 * nb;
    int d0 = n0;
    if (GLU_PERM && n0 >= 1792 && n0 < 2304) { const int c = n0 - 1792, part = c >> 8, idx = c & 255; d0 = 1792 + (idx >> 7) * 256 + part * 128 + (idx & 127); }
    TItem t; t.src = W + (size_t)(k0 + (lane >> 5)) * N + n0 + (lane & 31); t.dst = WT + (size_t)(row_off + d0) * K + k0; t.N = N; t.K = K; return t;
}
#define P0_TLOAD(T, tv) { _Pragma("unroll") for (int i_ = 0; i_ < 32; ++i_) tv[i_] = (T).src[(size_t)(2 * i_) * (T).N]; }
#define P0_TSTORE(T, tv, scr, lane) { \
    _Pragma("unroll") for (int i_ = 0; i_ < 32; ++i_) (scr)[(2 * i_ + ((lane) >> 5)) * 33 + ((lane) & 31)] = tv[i_]; \
    LDS_WAIT(); asm volatile("" ::: "memory"); \
    { const int c_ = (lane) & 7; \
      _Pragma("unroll") for (int j_ = 0; j_ < 4; ++j_) { const int n_ = ((lane) >> 3) + 8 * j_; const LAS float* s_ = (scr) + (8 * c_) * 33 + n_; \
        v4u o_; o_.x = pk2(s_[0 * 33], s_[1 * 33]); o_.y = pk2(s_[2 * 33], s_[3 * 33]); o_.z = pk2(s_[4 * 33], s_[5 * 33]); o_.w = pk2(s_[6 * 33], s_[7 * 33]); \
        *(GAS v4u*)((T).dst + (size_t)n_ * (T).K + 8 * c_) = o_; } } \
    LDS_WAIT(); asm volatile("" ::: "memory"); }
__device__ __forceinline__ void p0_layer1_weights(const Ctx& C, int widx, int nw) {
    const CAS Args& A = *C.a; LAS float* scr = (LAS float*)(C.lds + C.wave * 12288);
    constexpr int I_IN = 16 * (DIN / 32), I_OUT = 16 * 32, I_PW = 4 * 8;
    for (int it = widx; it < I_IN + I_OUT + I_PW; it += nw) {
        int r = it;
        if (r < I_IN) { p0_transpose_item<true>(A.in[I_WIN] + (size_t)DM * DIN, DM, DIN, C.ws<bf16>(WS_WIN) + (size_t)DIN * DM, 0, scr, r, C.lane); continue; } r -= I_IN;
        if (r < I_OUT) { p0_transpose_item(A.in[I_WOUT] + (size_t)DM * DM, DM, DM, C.ws<bf16>(WS_WOUT) + (size_t)DM * DM, 0, scr, r, C.lane); continue; } r -= I_OUT;
        p0_transpose_item(A.in[I_WPW] + (size_t)256 * 256, 256, 256, C.ws<bf16>(WS_WPW) + (size_t)256 * 256, 0, scr, r, C.lane);
    }
}
template <int PART> __device__ __forceinline__ void p0_prologue(const Ctx& C, int gw, int NGW) {
    const CAS Args& A = *C.a;
    LAS float* scr = (LAS float*)(C.lds + C.wave * 16384);
    constexpr int I_IN = 16 * (DIN / 32), I_OUT = 16 * 32, I_ADA = 16 * 96, I_PW = 4 * 8;
    constexpr int NITEMS = I_IN + I_OUT + I_PW + 2 * I_ADA;
    constexpr int IT_LO = PART == 0 ? I_IN + I_OUT + I_PW : 0, IT_HI = PART == 0 ? NITEMS : I_IN + I_OUT + I_PW;
    auto desc = [&](int it) -> TItem {
        int r = it;
        if (r < I_IN) return p0_titem<true>(A.in[I_WIN], DM, DIN, C.ws<bf16>(WS_WIN), 0, r, C.lane); r -= I_IN;
        if (r < I_OUT) return p0_titem(A.in[I_WOUT], DM, DM, C.ws<bf16>(WS_WOUT), 0, r, C.lane); r -= I_OUT;
        if (r < I_PW) return p0_titem(A.in[I_WPW], 256, 256, C.ws<bf16>(WS_WPW), 0, r, C.lane); r -= I_PW;
        const int l = r >= I_ADA ? 1 : 0; r -= l * I_ADA;
        return p0_titem(A.in[I_WADA] + (size_t)l * DM * 3072, DM, 3072, C.ws<bf16>(WS_WADA), l * 3072, r, C.lane);
    };
    for (int it = IT_LO + gw; it < IT_HI; it += 2 * NGW) {
        const bool two = it + NGW < IT_HI;
        const TItem T0 = desc(it), T1 = desc(two ? it + NGW : it);
        float tv0[32], tv1[32];
        P0_TLOAD(T0, tv0);
        if (two) P0_TLOAD(T1, tv1);
        P0_TSTORE(T0, tv0, scr, C.lane);
        if (two) P0_TSTORE(T1, tv1, scr, C.lane);
    }
    if (PART == 1) {
    { bf16* wsb = C.ws<bf16>(WS_WSB); const float* wsrc = A.in[I_WS];
      for (int idx = gw * 64 + C.lane; idx < 2 * 4 * 128 * 32; idx += NGW * 64) { const int t = (idx >> 5) & 127, s4 = (idx & 31) * 4; f32x4 v = ld4(wsrc + (size_t)idx * 4);
          if (s4 + 0 > t) v.x = 0.f; if (s4 + 1 > t) v.y = 0.f; if (s4 + 2 > t) v.z = 0.f; if (s4 + 3 > t) v.w = 0.f; st_bf4(wsb + (size_t)idx * 4, v); } }
    f32x2v* cs = C.ws<f32x2v>(WS_CS);
    for (int idx = gw * 64 + C.lane; idx < TSEQ * 16; idx += NGW * 64) {
        const int pos = idx >> 4, i = idx & 15;
        const double a = (double)pos * ROPE_INV[i];
        const double n = rint(a * 0.15915494309189535);
        const float r = (float)(a - n * 6.283185307179586);
        cs[idx] = (f32x2v){cosf(r), sinf(r)};
    }
    }
    if (PART == 0) {
    bf16* sc = C.ws<bf16>(WS_SC);
    for (int row = gw; row < 256; row += NGW) {
        const float* src = row < NBP ? A.in[I_CP] + (size_t)row * DM : A.in[I_CSM] + (size_t)(row - NBP) * DM;
#pragma unroll
        for (int j = 0; j < 4; ++j) { const int col = 4 * C.lane + 256 * j; f32x4 v = (f32x4){0.f, 0.f, 0.f, 0.f};
            if (row < NBT) { v = ld4(src + col); v.x = silu_f(v.x); v.y = silu_f(v.y); v.z = silu_f(v.z); v.w = silu_f(v.w); }
            st_bf4(sc + (size_t)row * DM + col, v); }
    }
    }
    if (PART == 1) {
    for (int it = gw; it < 2 * NBS * 22; it += NGW) { const int j = it % 22, lb_ = it / 22;
        st4(A.out + O_CS + ((size_t)lb_ * 30 + j) * 256 + 4 * C.lane, ld4(A.in[I_SCONV] + ((size_t)lb_ * 30 + 8 + j) * 256 + 4 * C.lane)); }
    }
    if (PART == 0 && C.bid == 0 && C.wave == 0) {
        float* scal = C.ws<float>(WS_SCAL);
        const float* lq = A.in[I_LAMQK];
        for (int l = 0; l < 2; ++l) {
            float a = C.lane < 32 ? lq[(l * 4 + 0) * 32 + C.lane] * lq[(l * 4 + 1) * 32 + C.lane] : 0.f;
            float b = C.lane < 32 ? lq[(l * 4 + 2) * 32 + C.lane] * lq[(l * 4 + 3) * 32 + C.lane] : 0.f;
            a = wave_sum(a); b = wave_sum(b);
            const float lam_init = l == 0 ? 0.2f : 0.35550906759096934f;
            if (C.lane == 0) scal[l] = __expf(a) - __expf(b) + lam_init;
        }
        const float* lb = A.in[I_LB];
        for (int c = C.lane; c < 256; c += 64) { const float e0 = __expf(lb[c]), e1 = __expf(lb[256 + c]); scal[64 + c] = e1 / (e0 + e1); }
    }
}


__device__ __forceinline__ const float* xrow_in(const Ctx& C, int l, int m) {
    if (l == 0) return m < MP ? C.a->in[I_XP] + (size_t)m * DM : C.a->in[I_XS] + (size_t)(m - MP) * DM;
    return C.ws<float>(WS_Y1) + (size_t)m * DM;
}
__device__ __forceinline__ void ph_hbuild(const Ctx& C, int l) {
    const float* mod = C.ws<float>(WS_MOD); bf16* H = C.ws<bf16>(WS_H);
    f32x4 nx[4];
    if (C.gw() < MT) { const float* xr = xrow_in(C, l, C.gw());
#pragma unroll
        for (int j = 0; j < 4; ++j) nx[j] = ld4(xr + 4 * C.lane + 256 * j); }
    for (int m = C.gw(); m < MT; m += C.ngw()) {
        const float* md = mod + (size_t)(l * NBT + batch_of(m)) * 3072;
        f32x4 v[4];
#pragma unroll
        for (int j = 0; j < 4; ++j) v[j] = nx[j];
        if (m + C.ngw() < MT) { const float* xr = xrow_in(C, l, m + C.ngw());
#pragma unroll
            for (int j = 0; j < 4; ++j) nx[j] = ld4(xr + 4 * C.lane + 256 * j); }
#pragma unroll
        for (int j = 0; j < 4; ++j) { const int col = 4 * C.lane + 256 * j;
            const f32x4 sh = ld4(md + col), sc = ld4(md + 1024 + col);
            st_bf4(H + (size_t)m * DM + col, v[j] * (1.f + sc) + sh); }
    }
}

#if MK_CHECK == 6
constexpr size_t WS_ALT = 768 * MiB;
__device__ __forceinline__ void ph_post_ref(const Ctx& C, int l) {
    const CAS Args& A = *C.a; const int lane = C.lane, c4 = 4 * lane;
    const float* Z = (const float*)(C.wsb - WS_ALT + WS_Z); const f32x2v* CS = (const f32x2v*)(C.wsb - WS_ALT + WS_CS); const float* scal = (const float*)(C.wsb - WS_ALT + WS_SCAL);
    bf16 *Qb = C.ws<bf16>(WS_Q), *Kb = C.ws<bf16>(WS_K), *Vb = C.ws<bf16>(WS_V), *GA = C.ws<bf16>(WS_GA), *U = C.ws<bf16>(WS_U), *VN = C.ws<bf16>(WS_VN), *GB = C.ws<bf16>(WS_GB),
         *GC = C.ws<bf16>(WS_GC), *QD = C.ws<bf16>(WS_QD), *KD = C.ws<bf16>(WS_KD), *VD = C.ws<bf16>(WS_VD), *GD = C.ws<bf16>(WS_GD);
    float *GLU = C.ws<float>(WS_GLU), *LF = C.ws<float>(WS_LF); float* out = A.out;
    const f32x4 sg_g = ld4(A.in[I_SGG] + l * 256 + c4), sg_b = ld4(A.in[I_SGB] + l * 256 + c4);
    f32x4 lb = (f32x4){0.f, 0.f, 0.f, 0.f}; if (l == 1) lb = ld4(scal + 64 + c4);
    const float sgn = (lane & 4) ? 1.f : -1.f;
    for (int m = C.gw(); m < MT; m += C.ngw()) {
        const float* z = Z + (size_t)m * DIN; const size_t mo = (size_t)m * 256 + c4;
        const bool samp = m >= MP; const int r = m - MP;
        const int pos = samp ? PAST + (r & 7) : (m & (TSEQ - 1));
        float *ok, *ov;
        if (!samp) { const size_t o = ((size_t)l * MP + m) * 256 + c4; ok = out + O_KP + o; ov = out + O_VP + o; }
        else { const size_t o = ((size_t)l * MS + r) * 256 + c4; ok = out + O_KS + o; ov = out + O_VS + o; }
        const f32x4 cs0 = *(const f32x4*)(CS + pos * 16 + 4 * (lane & 3)), cs1 = *(const f32x4*)(CS + pos * 16 + 4 * (lane & 3) + 2);
        const f32x4 cosv = (f32x4){cs0.x, cs0.z, cs1.x, cs1.z}, sinv = (f32x4){cs0.y, cs0.w, cs1.y, cs1.w};
        {
            const f32x4 v = ld4(z + c4); f32x4 p; p.x = __builtin_bit_cast(float, __builtin_amdgcn_ds_swizzle(__builtin_bit_cast(int, v.x), (4 << 10) | 0x1f)); p.y = __builtin_bit_cast(float, __builtin_amdgcn_ds_swizzle(__builtin_bit_cast(int, v.y), (4 << 10) | 0x1f)); p.z = __builtin_bit_cast(float, __builtin_amdgcn_ds_swizzle(__builtin_bit_cast(int, v.z), (4 << 10) | 0x1f)); p.w = __builtin_bit_cast(float, __builtin_amdgcn_ds_swizzle(__builtin_bit_cast(int, v.w), (4 << 10) | 0x1f));
            const f32x4 o = v * cosv + (p * sinv) * sgn; st_bf4(Qb + mo, o * QSCALE);
        }
        {
            const f32x4 v = ld4(z + 256 + c4); f32x4 p; p.x = __builtin_bit_cast(float, __builtin_amdgcn_ds_swizzle(__builtin_bit_cast(int, v.x), (4 << 10) | 0x1f)); p.y = __builtin_bit_cast(float, __builtin_amdgcn_ds_swizzle(__builtin_bit_cast(int, v.y), (4 << 10) | 0x1f)); p.z = __builtin_bit_cast(float, __builtin_amdgcn_ds_swizzle(__builtin_bit_cast(int, v.z), (4 << 10) | 0x1f)); p.w = __builtin_bit_cast(float, __builtin_amdgcn_ds_swizzle(__builtin_bit_cast(int, v.w), (4 << 10) | 0x1f));
            const f32x4 o = v * cosv + (p * sinv) * sgn;
            if (!samp) { const int t = m & (TSEQ - 1), bh = (m >> 13) * 4 + (lane >> 4);
                st_bf4((bf16*)(C.ws<unsigned char>(WS_KT) + ((size_t)(bh * 128 + (t >> 6)) * 8192 + ((lane & 15) >> 1) * 1024 + (t & 63) * 16 + (lane & 1) * 8)), o); }
        }
        { const f32x4 v = ld4(z + 512 + c4);
            if (!samp) { const int t = m & (TSEQ - 1), bh = (m >> 13) * 4 + (lane >> 4), row = t & 63;
                st_bf4((bf16*)(C.ws<unsigned char>(WS_VT) + ((size_t)(bh * 128 + (t >> 6)) * 8192 + ((((lane & 15) >> 3) * 4 + (row >> 4)) * 1024) + (row & 15) * 64 + (lane & 7) * 8)), v); } }
        { const f32x4 v = ld4(z + 768 + c4); st_bf4(GA + mo, (f32x4){silu_f(v.x), silu_f(v.y), silu_f(v.z), silu_f(v.w)}); }
        { const f32x4 v = ld4(z + 1024 + c4); st_bf4(U + mo, (f32x4){gelu_f(v.x), gelu_f(v.y), gelu_f(v.z), gelu_f(v.w)}); }
        { const f32x4 v = ld4(z + 1280 + c4); st_bf4(VN + mo, (f32x4){gelu_f(v.x), gelu_f(v.y), gelu_f(v.z), gelu_f(v.w)}); }
        { const f32x4 v = ld4(z + 1536 + c4); st_bf4(GB + mo, (f32x4){silu_f(v.x), silu_f(v.y), silu_f(v.z), silu_f(v.w)}); }
        {
            const f32x4 a = ld4(z + 1792 + (c4 >> 7) * 256 + (c4 & 127)), g = ld4(z + 1792 + (c4 >> 7) * 256 + 128 + (c4 & 127));
            const f32x4 glu = (f32x4){a.x * sigmoid_f(g.x), a.y * sigmoid_f(g.y), a.z * sigmoid_f(g.z), a.w * sigmoid_f(g.w)};
            st4(GLU + mo, glu);
        }
        { const f32x4 v = ld4(z + 2304 + c4); st_bf4(GC + mo, (f32x4){silu_f(v.x), silu_f(v.y), silu_f(v.z), silu_f(v.w)}); }
        { const f32x4 v = ld4(z + 2560 + c4); st_bf4(QD + mo, (f32x4){silu_f(v.x), silu_f(v.y), silu_f(v.z), silu_f(v.w)}); }
        {
            const f32x4 v = ld4(z + 2816 + c4); f32x4 f, lf;
            f.x = lb.x + (1.f - lb.x) * sigmoid_f(v.x); f.y = lb.y + (1.f - lb.y) * sigmoid_f(v.y); f.z = lb.z + (1.f - lb.z) * sigmoid_f(v.z); f.w = lb.w + (1.f - lb.w) * sigmoid_f(v.w);
            lf.x = __logf(fmaxf(f.x, 1e-30f)); lf.y = __logf(fmaxf(f.y, 1e-30f)); lf.z = __logf(fmaxf(f.z, 1e-30f)); lf.w = __logf(fmaxf(f.w, 1e-30f));
            st4(LF + mo, lf); st_bf4(KD + mo, 1.f - f);
        }
        { const f32x4 v = ld4(z + 3072 + c4); st_bf4(VD + mo, v); }
        { const f32x4 v = ld4(z + 3328 + c4); st_bf4(GD + mo, (f32x4){silu_f(v.x), silu_f(v.y), silu_f(v.z), silu_f(v.w)}); }
    }
}

#endif

__device__ __forceinline__ void sg_unit(const Ctx& C, int l, int u) {
    const CAS Args& A = *C.a; const bf16 *U = C.ws<bf16>(WS_U), *VN = C.ws<bf16>(WS_VN), *GB = C.ws<bf16>(WS_GB); bf16* MIX = C.ws<bf16>(WS_MIX);
    LAS float* vn = (LAS float*)C.lds;
    const int r0 = (u - 128) * 8; const size_t m0 = (size_t)MP + r0;
    {   const int i = C.wave; const f32x4 gam = ld4(A.in[I_SGG] + l * 256 + 4 * C.lane), bet = ld4(A.in[I_SGB] + l * 256 + 4 * C.lane);
        const f32x4 v = ld_bf4(VN + (m0 + i) * 256 + 4 * C.lane);
        const float mean = wave_sum((v.x + v.y) + (v.z + v.w)) * (1.f / 256.f); const f32x4 d = v - mean;
        const float var = wave_sum((d.x * d.x + d.y * d.y) + (d.z * d.z + d.w * d.w)) * (1.f / 256.f);
        const f32x4 y = d * rsqrtf(var + EPS) * gam + bet;
        *(LAS f32x4*)(vn + i * 256 + 4 * C.lane) = y; st4(A.out + O_CH + ((size_t)l * MS + r0 + i) * 256 + 4 * C.lane, y); }
    __syncthreads();
    const int col = C.tid & 255, th = C.tid >> 8, g = col >> 6;
    const float* w = A.in[I_WS] + (size_t)(l * 4 + g) * 128 * 128; const float* bs = A.in[I_BS] + (l * 4 + g) * 128;
    f32x4 wv[4][2]; float bsv[4], uu[4], gg[4];
#pragma unroll
    for (int i = 0; i < 4; ++i) { const int t = th * 4 + i; wv[i][0] = ld4(w + t * 128); wv[i][1] = ld4(w + t * 128 + 4); bsv[i] = bs[t];
        const size_t mo = (m0 + t) * 256 + col; uu[i] = bf2f(U[mo]); gg[i] = bf2f(GB[mo]); }
    float vv[8];
#pragma unroll
    for (int s_ = 0; s_ < 8; ++s_) vv[s_] = vn[s_ * 256 + col];
#pragma unroll
    for (int i = 0; i < 4; ++i) { const int t = th * 4 + i; float acc = 0.f;
#pragma unroll
        for (int s_ = 0; s_ < 8; ++s_) { const float wt = s_ < 4 ? wv[i][0][s_] : wv[i][1][s_ - 4]; acc += (s_ <= t) ? wt * vv[s_] : 0.f; }
        MIX[(m0 + t) * DM + 256 + col] = (bf16)f2bf(uu[i] * (acc + bsv[i]) * gg[i]); }
    __syncthreads();
}

__device__ __forceinline__ void conv_unit(const Ctx& C, int l, int u, bf16* MIX) {
    const CAS Args& A = *C.a; const float* GLU = C.ws<float>(WS_GLU); const bf16* GC = C.ws<bf16>(WS_GC);
    LAS float* Ys = (LAS float*)C.lds;
    const int c = C.tid & 255, rh = C.tid >> 8, r0 = u * 16;
    const float* cw = A.in[I_CW] + (size_t)l * 31 * 256 + c; const float cb = A.in[I_CB][l * 256 + c];
    for (int i = 0; i < 8; ++i) {
        const int rr = rh * 8 + i, m = r0 + rr; float y = cb;
        if (m < MP) { const int t = m & (TSEQ - 1);
            for (int j = 0; j < 31; ++j) { const int tt = t + j - 30; if (tt >= 0) y += cw[j * 256] * GLU[(size_t)(m + j - 30) * 256 + c]; }
        } else { const int r = m - MP, bs = r >> 3, ts = r & 7; const float* sc = A.in[I_SCONV] + (size_t)(l * NBS + bs) * 30 * 256 + c;
            for (int j = 0; j < 31; ++j) { const int tt = ts + j - 30; const float h = tt >= 0 ? GLU[(size_t)(m + j - 30) * 256 + c] : sc[(ts + j) * 256]; y += cw[j * 256] * h; }
        }
        Ys[rr * 256 + c] = y;
    }
    __syncthreads();
    {
        const f32x4 g = ld4(A.in[I_CNG] + l * 256 + 4 * C.lane), b = ld4(A.in[I_CNB] + l * 256 + 4 * C.lane);
        for (int i = 0; i < 2; ++i) { const int rr = C.wave * 2 + i; LAS f32x4* p = (LAS f32x4*)(Ys + rr * 256) + C.lane; f32x4 v = *p;
            const float mean = wave_sum((v.x + v.y) + (v.z + v.w)) * (1.f / 256.f); const f32x4 d = v - mean;
            const float var = wave_sum((d.x * d.x + d.y * d.y) + (d.z * d.z + d.w * d.w)) * (1.f / 256.f);
            f32x4 y = d * rsqrtf(var + EPS) * g + b; y = (f32x4){silu_f(y.x), silu_f(y.y), silu_f(y.z), silu_f(y.w)}; *p = y; }
    }
    __syncthreads();
    {
        float acc[8];
#pragma unroll
        for (int i = 0; i < 8; ++i) acc[i] = 0.f;
        const float* wp = A.in[I_WPW] + (size_t)l * 256 * 256 + c;
        for (int k = 0; k < 256; k += 4) {
            const float w0 = wp[(k + 0) * 256], w1 = wp[(k + 1) * 256], w2 = wp[(k + 2) * 256], w3 = wp[(k + 3) * 256];
#pragma unroll
            for (int i = 0; i < 8; ++i) { const f32x4 y = *(const LAS f32x4*)(Ys + (rh * 8 + i) * 256 + k); acc[i] += y.x * w0 + y.y * w1 + y.z * w2 + y.w * w3; }
        }
#pragma unroll
        for (int i = 0; i < 8; ++i) { const int m = r0 + rh * 8 + i; MIX[(size_t)m * DM + 512 + c] = (bf16)f2bf(acc[i] * bf2f(GC[(size_t)m * 256 + c])); }
    }
    __syncthreads();
}

template <int MODE> __device__ __forceinline__ void hgrn_item(const Ctx& C, int l, int item) {
    const CAS Args& A = *C.a; const int lane = C.lane;
    const float* LF = C.ws<float>(WS_LF); const bf16 *QD = C.ws<bf16>(WS_QD), *KD = C.ws<bf16>(WS_KD), *VD = C.ws<bf16>(WS_VD), *GD = C.ws<bf16>(WS_GD); bf16* MIX = C.ws<bf16>(WS_MIX);
    LAS float* Fs = (LAS float*)(C.lds + C.wave * 12288); LAS float* Ks = Fs + 1024; LAS float* Qs = Fs + 2048;
    int h, m0, ntok; size_t sidx;
    if (MODE == 2) { const int bs = item >> 2; h = item & 3; m0 = MP + bs * 8; ntok = 8; sidx = ((size_t)(l * NBS + bs) * 4 + h) * 4096; }
    else { const int bh = item >> 7, j = item & 127; h = bh & 3; m0 = (bh >> 2) * TSEQ + j * HG_L; ntok = HG_L; sidx = (size_t)item * 4096; }
    float S[64];
    if (MODE == 0) {
#pragma unroll
        for (int k = 0; k < 64; ++k) S[k] = 0.f;
    } else { const float* s0 = MODE == 2 ? A.in[I_SHGRN] + sidx : C.ws<float>(WS_SST) + sidx;
#pragma unroll
        for (int k = 0; k < 64; ++k) S[k] = s0[k * 64 + lane]; }
    const float gn = A.in[I_HNG][l * 64 + lane];
    float lfsum = 0.f;
    for (int c0 = 0; c0 < ntok; c0 += 16) {
        const int nt = (ntok - c0) < 16 ? (ntok - c0) : 16;
        for (int tt = 0; tt < nt; ++tt) { const size_t o = (size_t)(m0 + c0 + tt) * 256 + h * 64 + lane; const float lf = LF[o]; lfsum += lf;
            Fs[tt * 64 + lane] = __expf(lf); Ks[tt * 64 + lane] = bf2f(KD[o]); if (MODE != 0) Qs[tt * 64 + lane] = bf2f(QD[o]); }
        LDS_WAIT();
#pragma unroll 1
        for (int tt = 0; tt < nt; ++tt) {
            const int m = m0 + c0 + tt; const size_t o = (size_t)m * 256 + h * 64 + lane;
            const float vd = bf2f(VD[o]); float oacc = 0.f;
#pragma unroll
            for (int k4 = 0; k4 < 16; ++k4) {
                const f32x4 f = *(const LAS f32x4*)(Fs + tt * 64 + 4 * k4), kd = *(const LAS f32x4*)(Ks + tt * 64 + 4 * k4);
                S[4 * k4 + 0] = f.x * S[4 * k4 + 0] + kd.x * vd; S[4 * k4 + 1] = f.y * S[4 * k4 + 1] + kd.y * vd;
                S[4 * k4 + 2] = f.z * S[4 * k4 + 2] + kd.z * vd; S[4 * k4 + 3] = f.w * S[4 * k4 + 3] + kd.w * vd;
                if (MODE != 0) { const f32x4 q = *(const LAS f32x4*)(Qs + tt * 64 + 4 * k4);
                    oacc += S[4 * k4 + 0] * q.x + S[4 * k4 + 1] * q.y + S[4 * k4 + 2] * q.z + S[4 * k4 + 3] * q.w; }
            }
            if (MODE != 0) { const float ss = wave_sum(oacc * oacc) * (1.f / 64.f);
                const float on = oacc * rsqrtf(ss + EPS) * gn * bf2f(GD[o]);
                MIX[(size_t)m * DM + 768 + h * 64 + lane] = (bf16)f2bf(on); }
        }
        LDS_WAIT();
    }
    if (MODE == 0) { float* sl = C.ws<float>(WS_SLOC) + sidx;
#pragma unroll
        for (int k = 0; k < 64; ++k) sl[k * 64 + lane] = S[k];
        C.ws<float>(WS_DTOT)[(size_t)item * 64 + lane] = __expf(lfsum); }
    if (MODE == 2) { float* so = A.out + O_HS + sidx;
#pragma unroll
        for (int k = 0; k < 64; ++k) so[k * 64 + lane] = S[k]; }
}
__device__ __forceinline__ void hgrn_scan_unit(const Ctx& C, int l, int u) {
    const int seg = C.tid >> 6, kvl = C.tid & 63, bh = u >> 6, kv = (u & 63) * 64 + kvl, k = kv >> 6;
    const float* sl = C.ws<float>(WS_SLOC) + ((size_t)bh * HG_NB + seg * 16) * 4096 + kv; float* ss = C.ws<float>(WS_SST) + ((size_t)bh * HG_NB + seg * 16) * 4096 + kv;
    const float* dt = C.ws<float>(WS_DTOT) + ((size_t)bh * HG_NB + seg * 16) * 64 + k;
    LAS f32x2v* X = (LAS f32x2v*)C.lds;
    float a[16], d[16];
#pragma unroll
    for (int j = 0; j < 16; ++j) { a[j] = sl[(size_t)j * 4096]; d[j] = dt[j * 64]; }
    float D = 1.f, Acc = 0.f;
#pragma unroll
    for (int j = 0; j < 16; ++j) { Acc = d[j] * Acc + a[j]; D *= d[j]; }
    X[seg * 64 + kvl] = (f32x2v){D, Acc};
    __syncthreads();
    float S = 0.f;
    for (int q = 0; q < seg; ++q) { const f32x2v x = X[q * 64 + kvl]; S = x.x * S + x.y; }
#pragma unroll
    for (int j = 0; j < 16; ++j) { ss[(size_t)j * 4096] = S; S = d[j] * S + a[j]; }
    if (seg == 7) C.a->out[O_HP + ((size_t)l * 8 + bh) * 4096 + kv] = S;
    __syncthreads();
}

__device__ __forceinline__ void attn_unit_naive(const Ctx& C, int l, int u) {
    const CAS Args& A = *C.a; const bf16 *Qb = C.ws<bf16>(WS_Q), *Kb = C.ws<bf16>(WS_KR), *Vb = C.ws<bf16>(WS_VR), *GA = C.ws<bf16>(WS_GA); bf16* MIX = C.ws<bf16>(WS_MIX);
    const int bh = u & 7, qb = 31 - (u >> 3), b = bh >> 2, h = bh & 3;
    const int map = C.tid >> 8, qi = C.tid & 255, t = qb * 256 + qi; const size_t m = (size_t)b * TSEQ + t;
    LAS unsigned* Ksm = (LAS unsigned*)C.lds;
    LAS unsigned* Vsm = (LAS unsigned*)(C.lds + 32768);
    LAS float* O2 = (LAS float*)C.lds;
    float q[32], acc[64];
    { const v4u* qp = (const v4u*)(Qb + m * 256 + h * 64 + map * 32);
#pragma unroll
        for (int i = 0; i < 4; ++i) { const v4u w = qp[i]; q[8 * i] = bflo(w.x); q[8 * i + 1] = bfhi(w.x); q[8 * i + 2] = bflo(w.y); q[8 * i + 3] = bfhi(w.y); q[8 * i + 4] = bflo(w.z); q[8 * i + 5] = bfhi(w.z); q[8 * i + 6] = bflo(w.w); q[8 * i + 7] = bfhi(w.w); } }
#pragma unroll
    for (int d = 0; d < 64; ++d) acc[d] = 0.f;
    float mx = -1e30f, lsum = 0.f;
    for (int kt = 0; kt <= qb; ++kt) {
        __syncthreads();
        for (int p = C.tid; p < 4096; p += NTHR) { const int arr = p >> 11, row = (p >> 3) & 255, pc = p & 7;
            const bf16* src = (arr ? Vb : Kb) + ((size_t)b * TSEQ + kt * 256 + row) * 256 + h * 64 + pc * 8;
            *(LAS v4u*)((arr ? Vsm : Ksm) + row * 32 + pc * 4) = *(const v4u*)src; }
        __syncthreads();
        const int jn = (kt == qb) ? 256 : 256;
#pragma unroll 1
        for (int j = 0; j < jn; ++j) {
            if (kt * 256 + j > t) break;
            const LAS v4u* kp = (const LAS v4u*)(Ksm + j * 32 + map * 16);
            float s = 0.f;
#pragma unroll
            for (int i = 0; i < 4; ++i) { const v4u w = kp[i];
                s += q[8 * i] * bflo(w.x) + q[8 * i + 1] * bfhi(w.x) + q[8 * i + 2] * bflo(w.y) + q[8 * i + 3] * bfhi(w.y) + q[8 * i + 4] * bflo(w.z) + q[8 * i + 5] * bfhi(w.z) + q[8 * i + 6] * bflo(w.w) + q[8 * i + 7] * bfhi(w.w); }
            if (s > mx) { const float sc = exp2f(mx - s); lsum *= sc;
#pragma unroll
                for (int d = 0; d < 64; ++d) acc[d] *= sc;
                mx = s; }
            const float p = exp2f(s - mx); lsum += p;
            const LAS v4u* vp = (const LAS v4u*)(Vsm + j * 32);
#pragma unroll
            for (int i = 0; i < 8; ++i) { const v4u w = vp[i];
                acc[8 * i] += p * bflo(w.x); acc[8 * i + 1] += p * bfhi(w.x); acc[8 * i + 2] += p * bflo(w.y); acc[8 * i + 3] += p * bfhi(w.y);
                acc[8 * i + 4] += p * bflo(w.z); acc[8 * i + 5] += p * bfhi(w.z); acc[8 * i + 6] += p * bflo(w.w); acc[8 * i + 7] += p * bfhi(w.w); }
        }
    }
    __syncthreads();
    const float il = 1.f / lsum;
    if (map == 1) {
#pragma unroll
        for (int d = 0; d < 64; ++d) O2[qi * 65 + d] = acc[d] * il;
    }
    __syncthreads();
    if (map == 0) {
        const float lam = C.ws<float>(WS_SCAL)[l]; const float lam_init = l == 0 ? 0.2f : 0.35550906759096934f;
        float ss = 0.f;
#pragma unroll
        for (int d = 0; d < 64; ++d) { acc[d] = acc[d] * il - lam * O2[qi * 65 + d]; ss += acc[d] * acc[d]; }
        const float rs = rsqrtf(ss * (1.f / 64.f) + EPS) * (1.f - lam_init);
        const float* g = A.in[I_ANG] + l * 64;
#pragma unroll
        for (int d = 0; d < 64; d += 2) { const unsigned ga = *(const unsigned*)(GA + m * 256 + h * 64 + d);
            *(unsigned*)(MIX + m * DM + h * 64 + d) = pk2(acc[d] * rs * g[d] * bflo(ga), acc[d + 1] * rs * g[d + 1] * bfhi(ga)); }
    }
    __syncthreads();
}

namespace fa {
typedef float f32x16 __attribute__((ext_vector_type(16)));
typedef short bf16x8 __attribute__((ext_vector_type(8)));
typedef short s16x4 __attribute__((ext_vector_type(4)));
typedef short v4i16_t __attribute__((ext_vector_type(4)));
typedef float f32x2_t __attribute__((ext_vector_type(2))); typedef __bf16 bf16x2_t __attribute__((ext_vector_type(2)));
constexpr int SLOT = 16384;
constexpr int LDS_WSF = 65536;
constexpr int LDS_EX = 65536 + 4096;
constexpr float THR = 32.f;
__device__ __forceinline__ float max3f(float a, float b, float c) { return __builtin_fmaxf(__builtin_fmaxf(a, b), c); }
__device__ __forceinline__ unsigned cvtpk(float lo, float hi) { f32x2_t v = {lo, hi}; bf16x2_t b = __builtin_convertvector(v, bf16x2_t); return __builtin_bit_cast(unsigned, b); }
__device__ __forceinline__ float half_swap_max(float m) { auto rr = __builtin_amdgcn_permlane32_swap(__float_as_uint(m), __float_as_uint(m), false, false); return __builtin_fmaxf(__uint_as_float(rr[0]), __uint_as_float(rr[1])); }
__device__ __forceinline__ float half_swap_sum(float m) { auto rr = __builtin_amdgcn_permlane32_swap(__float_as_uint(m), __float_as_uint(m), false, false); return __uint_as_float(rr[0]) + __uint_as_float(rr[1]); }
__device__ __forceinline__ float rowmax(const f32x16& p0, const f32x16& p1) {
    float a = max3f(p0[0], p0[1], p1[0]), b = max3f(p0[2], p0[3], p1[1]); a = max3f(a, p1[2], p1[3]);
#pragma unroll
    for (int r = 4; r < 16; r += 4) { a = max3f(a, p0[r], p0[r + 1]); b = max3f(b, p0[r + 2], p0[r + 3]); a = max3f(a, p1[r], p1[r + 1]); b = max3f(b, p1[r + 2], p1[r + 3]); }
    return half_swap_max(__builtin_fmaxf(a, b));
}
__device__ __forceinline__ s16x4 vtr(const LAS unsigned char* p) { return __builtin_bit_cast(s16x4, __builtin_amdgcn_ds_read_tr16_b64_v4i16((LAS v4i16_t*)p)); }
__device__ __forceinline__ void softmax_step(const bool FIRST, f32x16& S0, f32x16& S1, float& m, float& lsum, f32x16 (&O)[2], LAS float* wsf, int r32, int hi, bf16x8 (&pk)[4]) {
    const float rm = rowmax(S0, S1);
    if (FIRST) m = (rm != -INFINITY && fabsf(rm) > THR) ? rm : 0.f;
    else if (__any(rm - m > THR)) {
        const float mn = __builtin_fmaxf(m, rm); const float f = __builtin_amdgcn_exp2f(m - mn); m = mn; lsum *= f;
        if (hi == 0) wsf[r32] = f;
        LDS_WAIT();
#pragma unroll
        for (int g = 0; g < 4; ++g) { const f32x4 fv = *(const LAS f32x4*)(wsf + 8 * g + 4 * hi);
#pragma unroll
            for (int j = 0; j < 4; ++j) { O[0][4 * g + j] *= fv[j]; O[1][4 * g + j] *= fv[j]; } }
        LDS_WAIT();
    }
    float s = 0.f;
    if (__all(m == 0.f)) {
#pragma unroll
        for (int r = 0; r < 16; ++r) { S0[r] = __builtin_amdgcn_exp2f(S0[r]); S1[r] = __builtin_amdgcn_exp2f(S1[r]); s += S0[r] + S1[r]; }
    } else {
#pragma unroll
        for (int r = 0; r < 16; ++r) { S0[r] = __builtin_amdgcn_exp2f(S0[r] - m); S1[r] = __builtin_amdgcn_exp2f(S1[r] - m); s += S0[r] + S1[r]; }
    }
    lsum += s;
    v4u w;
    w.x = cvtpk(S0[0], S0[1]); w.y = cvtpk(S0[2], S0[3]); w.z = cvtpk(S0[4], S0[5]); w.w = cvtpk(S0[6], S0[7]); pk[0] = __builtin_bit_cast(bf16x8, w);
    w.x = cvtpk(S0[8], S0[9]); w.y = cvtpk(S0[10], S0[11]); w.z = cvtpk(S0[12], S0[13]); w.w = cvtpk(S0[14], S0[15]); pk[1] = __builtin_bit_cast(bf16x8, w);
    w.x = cvtpk(S1[0], S1[1]); w.y = cvtpk(S1[2], S1[3]); w.z = cvtpk(S1[4], S1[5]); w.w = cvtpk(S1[6], S1[7]); pk[2] = __builtin_bit_cast(bf16x8, w);
    w.x = cvtpk(S1[8], S1[9]); w.y = cvtpk(S1[10], S1[11]); w.z = cvtpk(S1[12], S1[13]); w.w = cvtpk(S1[14], S1[15]); pk[3] = __builtin_bit_cast(bf16x8, w);
}
__device__ __forceinline__ void cmask(f32x16& p0, f32x16& p1, int krel0, int qrel, int hi) {
    asm volatile("" : "+v"(hi), "+v"(qrel));
#pragma unroll
    for (int r = 0; r < 16; ++r) { const int kv = krel0 + 4 * hi + (r & 3) + 8 * (r >> 2); if (kv > qrel) p0[r] = -INFINITY; if (kv + 32 > qrel) p1[r] = -INFINITY; }
}
#define FA_MFMA(a, b, c) __builtin_amdgcn_mfma_f32_32x32x16_bf16((a), (b), (c), 0, 0, 0)
__device__ __forceinline__ void tile_step(const bool FIRST, const LAS unsigned char* slot, const bf16x8 (&qr)[4], bool band, int krel0, int qrel, int r32, int hi, int lane,
        float& m_a, float& l_a, f32x16 (&Oa)[2], float& m_b, float& l_b, f32x16 (&Ob)[2], LAS float* wsf, const bf16* Kg, const bf16* Vg) {
#if MK_CHECK == 2
    const bf16* kp = Kg + (size_t)r32 * 256 + hi * 8;
#define KFR(off) (*(const bf16x8*)(kp + ((off) >> 10 >> 1) * 16 + (((off) >> 9) & 1) * 32 * 256))
#else
    const LAS unsigned char* kp = slot + hi * 1024 + r32 * 16;
#define KFR(off) (*(const LAS bf16x8*)(kp + (off)))
#endif
    bf16x8 pa[4], pb[4];
    {   f32x16 S0, S1;
        const bf16x8 k00 = KFR(0), k01 = KFR(512), k10 = KFR(2048), k11 = KFR(2048 + 512);
        S0 = FA_MFMA(k00, qr[0], (f32x16{})); S1 = FA_MFMA(k01, qr[0], (f32x16{})); S0 = FA_MFMA(k10, qr[1], S0); S1 = FA_MFMA(k11, qr[1], S1);
        if (band) cmask(S0, S1, krel0, qrel, hi);
        softmax_step(FIRST, S0, S1, m_a, l_a, Oa, wsf, r32, hi, pa);
    }
    asm volatile("" ::: "memory");
    {   f32x16 S0, S1;
        const bf16x8 k00 = KFR(4096), k01 = KFR(4096 + 512), k10 = KFR(6144), k11 = KFR(6144 + 512);
        S0 = FA_MFMA(k00, qr[2], (f32x16{})); S1 = FA_MFMA(k01, qr[2], (f32x16{})); S0 = FA_MFMA(k10, qr[3], S0); S1 = FA_MFMA(k11, qr[3], S1);
        if (band) cmask(S0, S1, krel0, qrel, hi);
        softmax_step(FIRST, S0, S1, m_b, l_b, Ob, wsf + 64, r32, hi, pb);
    }
    asm volatile("" ::: "memory");
    const LAS unsigned char* vp = slot + 8192 + ((lane >> 4) & 1) * 32 + (lane & 3) * 8 + (4 * hi + ((lane & 15) >> 2)) * 64;
#pragma unroll
    for (int d0 = 0; d0 < 2; ++d0)
#pragma unroll
        for (int ks = 0; ks < 4; ++ks) {
#if MK_CHECK == 2
            bf16x8 vf;
#pragma unroll
            for (int j = 0; j < 8; ++j) vf[j] = (short)Vg[(size_t)(16 * ks + 8 * (j >> 2) + 4 * hi + (j & 3)) * 256 + 32 * d0 + r32];
#else
            const s16x4 lo = vtr(vp + d0 * 4096 + ks * 1024), hh = vtr(vp + d0 * 4096 + ks * 1024 + 512);
            const bf16x8 vf = (bf16x8){lo[0], lo[1], lo[2], lo[3], hh[0], hh[1], hh[2], hh[3]};
#endif
            Oa[d0] = FA_MFMA(pa[ks], vf, Oa[d0]); Ob[d0] = FA_MFMA(pb[ks], vf, Ob[d0]);
            if (ks == 3) asm volatile("" ::: "memory");
        }
#undef KFR
}
#define FA_WAITBAR() do { asm volatile("s_waitcnt vmcnt(0) lgkmcnt(0)" ::: "memory"); __builtin_amdgcn_s_barrier(); asm volatile("" ::: "memory"); } while (0)

__device__ __forceinline__ void unit(const Ctx& C, int l, int bh, int y, bf16* MIX) {
    int lane = C.lane; asm volatile("" : "+v"(lane));
    const int wid = C.wave, r32 = lane & 31, hi = lane >> 5, half = wid >> 2, wq = wid & 3;
    const int b = bh >> 2, h = bh & 3; const int q0 = 128 * y, qrel = 32 * wq + r32;
    const size_t rowbase = (size_t)b * TSEQ;
    const bf16* Qw = C.ws<bf16>(WS_Q) + (rowbase + q0 + qrel) * 256 + h * 64;
    const unsigned char* KT = C.ws<unsigned char>(WS_KT) + (size_t)bh * 128 * 8192 + wid * 1024 + lane * 16;
    const unsigned char* VT = C.ws<unsigned char>(WS_VT) + (size_t)bh * 128 * 8192 + wid * 1024 + lane * 16;
    LAS unsigned char* lds = C.lds; LAS float* wsf = (LAS float*)(lds + LDS_WSF) + wid * 128;
    bf16x8 qr[4];
#pragma unroll
    for (int d0 = 0; d0 < 4; ++d0) qr[d0] = *(const bf16x8*)(Qw + d0 * 16 + hi * 8);
    const int nsteps = y + 1;
#define FA_DMA(i) do { _Pragma("unroll") for (int hf_ = 0; hf_ < 2; ++hf_) { const int t_ = 2 * (i) + hf_; LAS unsigned char* d_ = lds + ((((i) & 1) * 2 + hf_) * SLOT) + wid * 1024; \
        __builtin_amdgcn_global_load_lds((const unsigned*)(KT + (size_t)t_ * 8192), (LAS unsigned*)d_, 16, 0, 0); \
        __builtin_amdgcn_global_load_lds((const unsigned*)(VT + (size_t)t_ * 8192), (LAS unsigned*)(d_ + 8192), 16, 0, 0); } } while (0)
    float m_a = 0.f, l_a = 0.f, m_b = 0.f, l_b = 0.f; f32x16 Oa[2], Ob[2];
    Oa[0] = f32x16{}; Oa[1] = f32x16{}; Ob[0] = f32x16{}; Ob[1] = f32x16{};
    FA_DMA(0);
    FA_WAITBAR();
#pragma unroll 1
    for (int i = 0; i < nsteps; ++i) {
        if (i + 1 < nsteps) FA_DMA(i + 1);
        const int t = 2 * i + half; const bool band = t >= 2 * y;
        tile_step(i == 0, lds + ((i & 1) * 2 + half) * SLOT, qr, band, 64 * (t - 2 * y), qrel, r32, hi, lane, m_a, l_a, Oa, m_b, l_b, Ob, wsf,
                  C.ws<bf16>(WS_KR) + (rowbase + (size_t)t * 64) * 256 + h * 64, C.ws<bf16>(WS_VR) + (rowbase + (size_t)t * 64) * 256 + h * 64);
        FA_WAITBAR();
    }
    l_a = half_swap_sum(l_a); l_b = half_swap_sum(l_b);
    LAS f32x4* EX = (LAS f32x4*)(lds + LDS_EX);
    if (hi == 0) EX[wid * 32 + r32] = (f32x4){m_a, l_a, m_b, l_b};
    FA_WAITBAR();
    {   const f32x4 o = EX[(wid ^ 4) * 32 + r32];
        const float lam = C.ws<float>(WS_SCAL)[l];
        const float Ma = __builtin_fmaxf(m_a, o.x), fa_ = __builtin_amdgcn_exp2f(m_a - Ma), fa2 = __builtin_amdgcn_exp2f(o.x - Ma); const float ca = fa_ / (l_a * fa_ + o.y * fa2);
        const float Mb = __builtin_fmaxf(m_b, o.z), fb_ = __builtin_amdgcn_exp2f(m_b - Mb), fb2 = __builtin_amdgcn_exp2f(o.z - Mb); const float cb = -lam * fb_ / (l_b * fb_ + o.w * fb2);
        if (hi == 0) { wsf[r32] = ca; wsf[64 + r32] = cb; }
        LDS_WAIT();
    }
    f32x16 part[2];
#pragma unroll
    for (int g = 0; g < 4; ++g) { const f32x4 fa4 = *(const LAS f32x4*)(wsf + 8 * g + 4 * hi), fb4 = *(const LAS f32x4*)(wsf + 64 + 8 * g + 4 * hi);
#pragma unroll
        for (int j = 0; j < 4; ++j) { part[0][4 * g + j] = Oa[0][4 * g + j] * fa4[j] + Ob[0][4 * g + j] * fb4[j]; part[1][4 * g + j] = Oa[1][4 * g + j] * fa4[j] + Ob[1][4 * g + j] * fb4[j]; } }
    LAS float* XO = (LAS float*)lds + wq * 2048;
    if (half == 1) {
#pragma unroll
        for (int r = 0; r < 16; ++r) { XO[r * 64 + lane] = part[0][r]; XO[(16 + r) * 64 + lane] = part[1][r]; }
    }
    FA_WAITBAR();
    if (half == 0) {
        const float lam_init = l == 0 ? 0.2f : 0.35550906759096934f;
        float ss[16];
#pragma unroll
        for (int r = 0; r < 16; ++r) { part[0][r] += XO[r * 64 + lane]; part[1][r] += XO[(16 + r) * 64 + lane]; ss[r] = part[0][r] * part[0][r] + part[1][r] * part[1][r]; }
#pragma unroll
        for (int r = 0; r < 16; ++r) { ss[r] = sx_sum<1>(ss[r]); ss[r] = sx_sum<2>(ss[r]); ss[r] = sx_sum<4>(ss[r]); ss[r] = sx_sum<8>(ss[r]); ss[r] = sx_sum<16>(ss[r]); }
        const float* g = C.a->in[I_ANG] + l * 64; const float g0 = g[r32], g1 = g[32 + r32];
        const bf16* GA = C.ws<bf16>(WS_GA);
#pragma unroll
        for (int r = 0; r < 16; ++r) { const size_t row = rowbase + q0 + 32 * wq + (r & 3) + 8 * (r >> 2) + 4 * hi;
            const float rs = rsqrtf(ss[r] * (1.f / 64.f) + EPS) * (1.f - lam_init);
            MIX[row * DM + h * 64 + r32] = (bf16)f2bf(part[0][r] * rs * g0 * bf2f(GA[row * 256 + h * 64 + r32]));
            MIX[row * DM + h * 64 + 32 + r32] = (bf16)f2bf(part[1][r] * rs * g1 * bf2f(GA[row * 256 + h * 64 + 32 + r32])); }
    }
    FA_WAITBAR();
#undef FA_DMA
}
}

namespace sgm {
using fa::f32x16; using fa::bf16x8;
constexpr int VT_STRIDE = 272;
__device__ __forceinline__ void unit(const Ctx& C, int l, int chunk, bf16* MIX) {
    const CAS Args& A = *C.a;
    int lane = C.lane; asm volatile("" : "+v"(lane));
    const int r32 = lane & 31, hi = lane >> 5, wid = C.wave, g = wid >> 1, th = wid & 1, tid = wid * 64 + lane;
    const bf16 *U = C.ws<bf16>(WS_U), *VN = C.ws<bf16>(WS_VN), *GB = C.ws<bf16>(WS_GB);
    const size_t m0 = (size_t)chunk * 128;
    LAS unsigned char* VT = C.lds;
    {
        const f32x4 gam = ld4(A.in[I_SGG] + l * 256 + 4 * lane), bet = ld4(A.in[I_SGB] + l * 256 + 4 * lane);
        v2u raw[16];
#pragma unroll
        for (int i = 0; i < 16; ++i) raw[i] = *(const v2u*)(VN + (m0 + wid * 16 + i) * 256 + 4 * lane);
#pragma unroll
        for (int i = 0; i < 16; ++i) { const int s_ = wid * 16 + i; const f32x4 v = (f32x4){bflo(raw[i].x), bfhi(raw[i].x), bflo(raw[i].y), bfhi(raw[i].y)};
            const float mean = wave_sum((v.x + v.y) + (v.z + v.w)) * (1.f / 256.f); const f32x4 d = v - mean;
            const float var = wave_sum((d.x * d.x + d.y * d.y) + (d.z * d.z + d.w * d.w)) * (1.f / 256.f);
            const f32x4 y = d * rsqrtf(var + EPS) * gam + bet;
            LAS unsigned char* p = VT + (4 * lane) * VT_STRIDE + s_ * 2;
            *(LAS unsigned short*)(p) = (unsigned short)f2bf(y.x); *(LAS unsigned short*)(p + VT_STRIDE) = (unsigned short)f2bf(y.y);
            *(LAS unsigned short*)(p + 2 * VT_STRIDE) = (unsigned short)f2bf(y.z); *(LAS unsigned short*)(p + 3 * VT_STRIDE) = (unsigned short)f2bf(y.w); }
    }
    __syncthreads();
    const bf16* Wm = C.ws<bf16>(WS_WSB) + (size_t)(l * 4 + g) * 128 * 128;
    f32x16 acc[2][2];
#pragma unroll
    for (int a = 0; a < 2; ++a) { acc[a][0] = f32x16{}; acc[a][1] = f32x16{}; }
#pragma unroll
    for (int tbi = 0; tbi < 2; ++tbi) {
        const int tb = 2 * th + tbi; const bf16* wrow = Wm + (size_t)(tb * 32 + r32) * 128 + 8 * hi;
        const LAS unsigned char* vb = VT + (g * 64 + r32) * VT_STRIDE + 16 * hi;
        bf16x8 af[8];
#pragma unroll
        for (int ks = 0; ks < 8; ++ks) af[ks] = *(const bf16x8*)(wrow + 16 * ks);
#pragma unroll
        for (int ks = 0; ks < 8; ++ks) { if (ks < 2 * (tb + 1)) {
            const bf16x8 b0 = *(const LAS bf16x8*)(vb + 32 * ks), b1 = *(const LAS bf16x8*)(vb + 32 * VT_STRIDE + 32 * ks);
            acc[tbi][0] = FA_MFMA(af[ks], b0, acc[tbi][0]); acc[tbi][1] = FA_MFMA(af[ks], b1, acc[tbi][1]); } }
    }
    const float* bsv = A.in[I_BS] + (l * 4 + g) * 128;
#pragma unroll
    for (int tbi = 0; tbi < 2; ++tbi)
#pragma unroll
        for (int r = 0; r < 16; ++r) { const int t = (2 * th + tbi) * 32 + (r & 3) + 8 * (r >> 2) + 4 * hi; const float bias = bsv[t];
#pragma unroll
            for (int d0 = 0; d0 < 2; ++d0) { const int col = g * 64 + 32 * d0 + r32; const size_t mo = (m0 + t) * 256 + col;
                MIX[(m0 + t) * DM + 256 + col] = (bf16)f2bf(bf2f(U[mo]) * (acc[tbi][d0][r] + bias) * bf2f(GB[mo])); } }
    __syncthreads();
}
}

namespace cvm {
using fa::f32x16; using fa::bf16x8;
constexpr int Y_OFF = 0, YN_OFF = 65536, YN_STRIDE = 528;
__device__ __forceinline__ void unit(const Ctx& C, int l, int u, bf16* MIX) {
    const CAS Args& A = *C.a;
    int lane = C.lane; asm volatile("" : "+v"(lane));
    const int wid = C.wave, tid = wid * 64 + lane, r32 = lane & 31, hi = lane >> 5;
    const float* GLU = C.ws<float>(WS_GLU); const bf16* GC = C.ws<bf16>(WS_GC);
    LAS float* Y = (LAS float*)(C.lds + Y_OFF); LAS unsigned char* YN = C.lds + YN_OFF;
    const int r0 = u * 64; const bool samp = r0 >= MP;
    {
        const int c = tid & 255, half = tid >> 8;
        float cw[31];
#pragma unroll
        for (int j = 0; j < 31; ++j) cw[j] = A.in[I_CW][(size_t)(l * 31 + j) * 256 + c];
        const float cb = A.in[I_CB][l * 256 + c];
        if (!samp) {
            const int rg = half * 32, m = r0 + rg, t0 = m & (TSEQ - 1);
            float in[62];
#pragma unroll
            for (int k = 0; k < 62; ++k) { const int tt = t0 - 30 + k; in[k] = tt >= 0 ? GLU[(size_t)(m - 30 + k) * 256 + c] : 0.f; }
#pragma unroll
            for (int i = 0; i < 32; ++i) { float y = cb;
#pragma unroll
                for (int j = 0; j < 31; ++j) y += cw[j] * in[i + j];
                Y[(rg + i) * 256 + c] = y; }
        } else {
#pragma unroll 1
            for (int gq = 0; gq < 4; ++gq) {
                const int rg = half * 32 + gq * 8, m = r0 + rg;
                float in[38];
                const int bs = (m - MP) >> 3; const float* sc = A.in[I_SCONV] + (size_t)(l * NBS + bs) * 30 * 256 + c;
#pragma unroll
                for (int k = 0; k < 30; ++k) in[k] = sc[k * 256];
#pragma unroll
                for (int k = 0; k < 8; ++k) in[30 + k] = GLU[(size_t)(m + k) * 256 + c];
#pragma unroll
                for (int i = 0; i < 8; ++i) { float y = cb;
#pragma unroll
                    for (int j = 0; j < 31; ++j) y += cw[j] * in[i + j];
                    Y[(rg + i) * 256 + c] = y; }
            }
        }
    }
    __syncthreads();
    {
        const f32x4 g = ld4(A.in[I_CNG] + l * 256 + 4 * lane), b = ld4(A.in[I_CNB] + l * 256 + 4 * lane);
#pragma unroll
        for (int i4 = 0; i4 < 2; ++i4) { f32x4 v[4]; float sm[4], sq[4];
#pragma unroll
            for (int i = 0; i < 4; ++i) { v[i] = *(const LAS f32x4*)(Y + (wid * 8 + i4 * 4 + i) * 256 + 4 * lane); sm[i] = (v[i].x + v[i].y) + (v[i].z + v[i].w); }
#pragma unroll
            for (int i = 0; i < 4; ++i) sm[i] = sx_sum<1>(sm[i]);
#pragma unroll
            for (int i = 0; i < 4; ++i) sm[i] = sx_sum<2>(sm[i]);
#pragma unroll
            for (int i = 0; i < 4; ++i) sm[i] = sx_sum<4>(sm[i]);
#pragma unroll
            for (int i = 0; i < 4; ++i) sm[i] = sx_sum<8>(sm[i]);
#pragma unroll
            for (int i = 0; i < 4; ++i) sm[i] = sx_sum<16>(sm[i]);
#pragma unroll
            for (int i = 0; i < 4; ++i) { sm[i] = sx_sum<32>(sm[i]) * (1.f / 256.f); v[i] = v[i] - sm[i]; sq[i] = (v[i].x * v[i].x + v[i].y * v[i].y) + (v[i].z * v[i].z + v[i].w * v[i].w); }
#pragma unroll
            for (int i = 0; i < 4; ++i) sq[i] = sx_sum<1>(sq[i]);
#pragma unroll
            for (int i = 0; i < 4; ++i) sq[i] = sx_sum<2>(sq[i]);
#pragma unroll
            for (int i = 0; i < 4; ++i) sq[i] = sx_sum<4>(sq[i]);
#pragma unroll
            for (int i = 0; i < 4; ++i) sq[i] = sx_sum<8>(sq[i]);
#pragma unroll
            for (int i = 0; i < 4; ++i) sq[i] = sx_sum<16>(sq[i]);
#pragma unroll
            for (int i = 0; i < 4; ++i) { const float var = sx_sum<32>(sq[i]) * (1.f / 256.f); f32x4 y = v[i] * rsqrtf(var + EPS) * g + b; y = (f32x4){silu_f(y.x), silu_f(y.y), silu_f(y.z), silu_f(y.w)};
                v2u w; w.x = pk2(y.x, y.y); w.y = pk2(y.z, y.w); *(LAS v2u*)(YN + (wid * 8 + i4 * 4 + i) * YN_STRIDE + 8 * lane) = w; } }
    }
    __syncthreads();
    {
        const int rb = wid & 1, cq = wid >> 1;
        const bf16* WT = C.ws<bf16>(WS_WPW) + (size_t)l * 256 * 256 + (size_t)(cq * 64 + r32) * 256 + 8 * hi;
        const LAS unsigned char* ya = YN + (rb * 32 + r32) * YN_STRIDE + 16 * hi;
        f32x16 acc0 = f32x16{}, acc1 = f32x16{};
#pragma unroll
        for (int kb = 0; kb < 2; ++kb) { bf16x8 b0[8], b1[8];
#pragma unroll
            for (int k8 = 0; k8 < 8; ++k8) { b0[k8] = *(const bf16x8*)(WT + 16 * (8 * kb + k8)); b1[k8] = *(const bf16x8*)(WT + 32 * 256 + 16 * (8 * kb + k8)); }
#pragma unroll
            for (int k8 = 0; k8 < 8; ++k8) { const bf16x8 af = *(const LAS bf16x8*)(ya + 32 * (8 * kb + k8)); acc0 = FA_MFMA(af, b0[k8], acc0); acc1 = FA_MFMA(af, b1[k8], acc1); } }
#pragma unroll
        for (int r = 0; r < 16; ++r) { const size_t m = (size_t)r0 + rb * 32 + (r & 3) + 8 * (r >> 2) + 4 * hi; const int d = cq * 64 + r32;
            MIX[m * DM + 512 + d] = (bf16)f2bf(acc0[r] * bf2f(GC[m * 256 + d]));
            MIX[m * DM + 512 + d + 32] = (bf16)f2bf(acc1[r] * bf2f(GC[m * 256 + d + 32])); }
    }
    __syncthreads();
}
}

namespace hg {
typedef short bf16x8 __attribute__((ext_vector_type(8)));
#define HG_MFMA(a, b, c) __builtin_amdgcn_mfma_f32_16x16x32_bf16((a), (b), (c), 0, 0, 0)
constexpr int RS = 144;
constexpr int O_QE = 0, O_QM = 16 * RS, O_KM = 32 * RS, O_KET = 48 * RS, O_VT = O_KET + 2048, O_AS = O_VT + 2048, WAVE_LDS = 12288;
static_assert(O_AS + 256 <= WAVE_LDS, "hgrn lds");
__device__ __forceinline__ unsigned pk(float a, float b) { return fa::cvtpk(a, b); }
template <int MODE> __device__ __forceinline__ void item(const Ctx& C, int l, int it, bf16* MIX) {
    const CAS Args& A = *C.a;
    int lane = C.lane; asm volatile("" : "+v"(lane));
    const int col = lane & 15, g = lane >> 4;
    const float* LF = C.ws<float>(WS_LF); const bf16 *QD = C.ws<bf16>(WS_QD), *KD = C.ws<bf16>(WS_KD), *VD = C.ws<bf16>(WS_VD), *GD = C.ws<bf16>(WS_GD);
    LAS unsigned char* W = C.lds + C.wave * WAVE_LDS;
    int h, m0, nchunk, ntok; size_t sidx;
    if (MODE == 2) { const int bs = it >> 2; h = it & 3; m0 = MP + bs * 8; nchunk = 1; ntok = 8; sidx = ((size_t)(l * NBS + bs) * 4 + h) * 4096; }
    else { const int bh = it >> 7, j = it & 127; h = bh & 3; m0 = (bh >> 2) * TSEQ + j * HG_L; nchunk = HG_L / 16; ntok = 16; sidx = (size_t)it * 4096; }
    f32x4 S[4][4];
    if (MODE == 0) {
#pragma unroll
        for (int a = 0; a < 4; ++a)
#pragma unroll
            for (int b = 0; b < 4; ++b) S[a][b] = (f32x4){0.f, 0.f, 0.f, 0.f};
    } else { const float* s0 = (MODE == 2 ? A.in[I_SHGRN] : C.ws<float>(WS_SST)) + sidx + (size_t)(4 * g) * 64 + col;
#pragma unroll
        for (int a = 0; a < 4; ++a)
#pragma unroll
            for (int b = 0; b < 4; ++b) { const float* p = s0 + (size_t)(16 * a) * 64 + 16 * b; S[a][b] = (f32x4){p[0], p[64], p[128], p[192]}; } }
    unsigned z0 = 0u; asm volatile("" : "+v"(z0));
    float lftot = 0.f;
    float rlf[16]; unsigned rkq[16]; unsigned rvv[8];
#define HG_LOAD(ch_) do { const size_t o0_ = (size_t)(m0 + (ch_) * 16) * 256 + h * 64 + lane; \
        _Pragma("unroll") for (int t = 0; t < 16; ++t) { const bool ok = t < ntok; rlf[t] = ok ? LF[o0_ + (size_t)t * 256] : 0.f; \
            rkq[t] = ok ? ((unsigned)KD[o0_ + (size_t)t * 256] | (MODE != 0 ? ((unsigned)QD[o0_ + (size_t)t * 256] << 16) : 0u)) : 0u; } \
        _Pragma("unroll") for (int t = 0; t < 16; t += 2) { const unsigned a_ = t < ntok ? (unsigned)VD[o0_ + (size_t)t * 256] : z0, b_ = t + 1 < ntok ? (unsigned)VD[o0_ + (size_t)(t + 1) * 256] : z0; rvv[t >> 1] = a_ | (b_ << 16); } } while (0)
    HG_LOAD(0);
#pragma unroll 1
    for (int ch = 0; ch < nchunk; ++ch) {
        {
            float cum[16], kd[16], q[16]; unsigned vv[8];
#pragma unroll
            for (int t = 0; t < 16; ++t) { cum[t] = rlf[t]; kd[t] = bflo(rkq[t]); q[t] = bfhi(rkq[t]); }
#pragma unroll
            for (int t = 0; t < 8; ++t) vv[t] = rvv[t];
            if (ch + 1 < nchunk) HG_LOAD(ch + 1);
#pragma unroll
            for (int t = 1; t < 16; ++t) cum[t] += cum[t - 1];
            const float cL = cum[15], cm = cum[7]; lftot += cL;
            unsigned ke[8];
#pragma unroll
            for (int t = 0; t < 16; t += 2) ke[t >> 1] = pk(kd[t] * __expf(cL - cum[t]), kd[t + 1] * __expf(cL - cum[t + 1]));
            *(LAS v4u*)(W + O_KET + lane * 32) = (v4u){ke[0], ke[1], ke[2], ke[3]}; *(LAS v4u*)(W + O_KET + lane * 32 + 16) = (v4u){ke[4], ke[5], ke[6], ke[7]};
            *(LAS v4u*)(W + O_VT + lane * 32) = (v4u){vv[0], vv[1], vv[2], vv[3]}; *(LAS v4u*)(W + O_VT + lane * 32 + 16) = (v4u){vv[4], vv[5], vv[6], vv[7]};
            *(LAS float*)(W + O_AS + lane * 4) = __expf(cL);
            if (MODE != 0) {
#pragma unroll
                for (int t = 0; t < 16; ++t) {
                    *(LAS unsigned short*)(W + O_QE + t * RS + lane * 2) = (unsigned short)f2bf(q[t] * __expf(cum[t]));
                    *(LAS unsigned short*)(W + O_QM + t * RS + lane * 2) = (unsigned short)f2bf(q[t] * __expf(cum[t] - cm));
                    *(LAS unsigned short*)(W + O_KM + t * RS + lane * 2) = (unsigned short)f2bf(kd[t] * __expf(cm - cum[t])); }
            }
        }
        LDS_WAIT(); asm volatile("" ::: "memory");
        if (MODE != 0) {
            v2u gdr[4];
            { const size_t mg = ((size_t)m0 + ch * 16 + (col < ntok ? col : 0)) * 256 + h * 64 + 4 * g;
#pragma unroll
              for (int nb = 0; nb < 4; ++nb) gdr[nb] = *(const v2u*)(GD + mg + 16 * nb); }
            f32x4 OT[4];
#pragma unroll
            for (int nb = 0; nb < 4; ++nb) OT[nb] = (f32x4){0.f, 0.f, 0.f, 0.f};
#pragma unroll
            for (int ks = 0; ks < 2; ++ks) {
                const v2u q0 = *(const LAS v2u*)(W + O_QE + col * RS + (32 * ks + 4 * g) * 2), q1 = *(const LAS v2u*)(W + O_QE + col * RS + (32 * ks + 16 + 4 * g) * 2);
                const bf16x8 bq = __builtin_bit_cast(bf16x8, (v4u){q0.x, q0.y, q1.x, q1.y});
#pragma unroll
                for (int nb = 0; nb < 4; ++nb) { const f32x4 s0 = S[2 * ks][nb], s1 = S[2 * ks + 1][nb];
                    const bf16x8 as = __builtin_bit_cast(bf16x8, (v4u){pk(s0.x, s0.y), pk(s0.z, s0.w), pk(s1.x, s1.y), pk(s1.z, s1.w)});
                    OT[nb] = HG_MFMA(as, bq, OT[nb]); }
            }
            f32x4 at = (f32x4){0.f, 0.f, 0.f, 0.f};
#pragma unroll
            for (int ks = 0; ks < 2; ++ks) { const bf16x8 ak = *(const LAS bf16x8*)(W + O_KM + col * RS + (32 * ks + 8 * g) * 2), bq = *(const LAS bf16x8*)(W + O_QM + col * RS + (32 * ks + 8 * g) * 2);
                at = HG_MFMA(ak, bq, at); }
            { const int sb = 4 * g; if (sb + 0 > col) at.x = 0.f; if (sb + 1 > col) at.y = 0.f; if (sb + 2 > col) at.z = 0.f; if (sb + 3 > col) at.w = 0.f; }
            const bf16x8 batt = __builtin_bit_cast(bf16x8, (v4u){pk(at.x, at.y), pk(at.z, at.w), z0, z0});
#pragma unroll
            for (int nb = 0; nb < 4; ++nb) { const v2u v0 = *(const LAS v2u*)(W + O_VT + (16 * nb + col) * 32 + 8 * g);
                OT[nb] = HG_MFMA(__builtin_bit_cast(bf16x8, (v4u){v0.x, v0.y, z0, z0}), batt, OT[nb]); }
            float ss = 0.f;
#pragma unroll
            for (int nb = 0; nb < 4; ++nb) ss += (OT[nb].x * OT[nb].x + OT[nb].y * OT[nb].y) + (OT[nb].z * OT[nb].z + OT[nb].w * OT[nb].w);
            ss = sx_sum<16>(ss); ss = sx_sum<32>(ss);
            const float rs = rsqrtf(ss * (1.f / 64.f) + EPS);
            if (col < ntok) { const size_t m = (size_t)m0 + ch * 16 + col;
#pragma unroll
                for (int nb = 0; nb < 4; ++nb) { const int v = 16 * nb + 4 * g; const f32x4 gn = ld4(A.in[I_HNG] + l * 64 + v); const f32x4 gd = (f32x4){bflo(gdr[nb].x), bfhi(gdr[nb].x), bflo(gdr[nb].y), bfhi(gdr[nb].y)};
                    st_bf4(MIX + m * DM + 768 + h * 64 + v, OT[nb] * rs * gn * gd); } }
        }
        {   bf16x8 ak[4], bv[4];
#pragma unroll
            for (int b = 0; b < 4; ++b) { v4u x = *(const LAS v4u*)(W + O_KET + (16 * b + col) * 32 + 16 * (g & 1)), y = *(const LAS v4u*)(W + O_VT + (16 * b + col) * 32 + 16 * (g & 1));
                if (g >= 2) { x = (v4u){z0, z0, z0, z0}; y = x; } ak[b] = __builtin_bit_cast(bf16x8, x); bv[b] = __builtin_bit_cast(bf16x8, y); }
#pragma unroll
            for (int mb = 0; mb < 4; ++mb) { const f32x4 as = *(const LAS f32x4*)(W + O_AS + (16 * mb + 4 * g) * 4);
#pragma unroll
                for (int nb = 0; nb < 4; ++nb) S[mb][nb] = HG_MFMA(ak[mb], bv[nb], S[mb][nb] * as); }
        }
        LDS_WAIT(); asm volatile("" ::: "memory");
    }
    if (MODE == 0 || MODE == 2) { float* so = (MODE == 0 ? C.ws<float>(WS_SLOC) : A.out + O_HS) + sidx + (size_t)(4 * g) * 64 + col;
#pragma unroll
        for (int a = 0; a < 4; ++a)
#pragma unroll
            for (int b = 0; b < 4; ++b) { float* p = so + (size_t)(16 * a) * 64 + 16 * b; p[0] = S[a][b].x; p[64] = S[a][b].y; p[128] = S[a][b].z; p[192] = S[a][b].w; } }
    if (MODE == 0) C.ws<float>(WS_DTOT)[(size_t)it * 64 + lane] = __expf(lftot);
#undef HG_LOAD
}
}

namespace sa {
using fa::f32x16; using fa::bf16x8; using fa::cvtpk; using fa::max3f; using fa::half_swap_max; using fa::half_swap_sum;
constexpr float THR = 8.f;
__device__ __forceinline__ bf16x8 pack8(const f32x4& a, const f32x4& b) { v4u w; w.x = cvtpk(a.x, a.y); w.y = cvtpk(a.z, a.w); w.z = cvtpk(b.x, b.y); w.w = cvtpk(b.z, b.w); return __builtin_bit_cast(bf16x8, w); }
__device__ __forceinline__ bf16x8 pack8f(const float (&v)[8]) { v4u w; w.x = cvtpk(v[0], v[1]); w.y = cvtpk(v[2], v[3]); w.z = cvtpk(v[4], v[5]); w.w = cvtpk(v[6], v[7]); return __builtin_bit_cast(bf16x8, w); }
struct Raw { f32x4 k[8]; float v[2][2][8]; };
__device__ __forceinline__ void load_tile(Raw& R, const float* krow, const float* vbase, int r32, int hi, const bool extra) {
#pragma unroll
    for (int c = 0; c < 4; ++c) { R.k[2 * c] = ld4(krow + 16 * c + 8 * hi); R.k[2 * c + 1] = ld4(krow + 16 * c + 8 * hi + 4); }
    const int voff = 4 * hi * 256 + r32;
#pragma unroll
    for (int s = 0; s < 2; ++s)
#pragma unroll
        for (int jh = 0; jh < 2; ++jh) { const float* pb = extra ? vbase : vbase + (16 * s + 8 * jh) * 256;
#pragma unroll
            for (int jl = 0; jl < 4; ++jl) { R.v[s][0][4 * jh + jl] = pb[voff + jl * 256]; R.v[s][1][4 * jh + jl] = pb[voff + jl * 256 + 32]; } }
}
struct RawK { f32x4 k[8]; }; struct RawV { f32x4 r[8]; };
__device__ __forceinline__ void load_k(RawK& R, const float* krow, int hi) {
#pragma unroll
    for (int c = 0; c < 4; ++c) { R.k[2 * c] = ld4(krow + 16 * c + 8 * hi); R.k[2 * c + 1] = ld4(krow + 16 * c + 8 * hi + 4); }
}
__device__ __forceinline__ void load_v(RawV& R, const float* vbase, int lane, const bool extra) {
#pragma unroll
    for (int i = 0; i < 8; ++i) { int kv = 4 * i + (lane >> 4); if (extra) kv &= 7; R.r[i] = ld4(vbase + (size_t)kv * 256 + 4 * (lane & 15)); }
}
__device__ __forceinline__ void item(const Ctx& C, int l, int pr, int grp, int part, bf16* MIX) {
    const CAS Args& A = *C.a;
    int lane = C.lane; asm volatile("" : "+v"(lane));
    const int col = lane & 15, g = lane >> 4, bs = pr >> 2, h = pr & 3, wid = C.wave;
    const bf16* Qb = C.ws<bf16>(WS_Q); const int* pt = (const int*)A.in[I_PT] + bs * NPAGES + part * 4;
    const float* ck = A.in[I_CK] + (size_t)l * NPOOL * PAGE * 256 + h * 64; const float* cv = A.in[I_CV] + (size_t)l * NPOOL * PAGE * 256 + h * 64;
    LAS float* wsf = (LAS float*)(C.lds + 65536) + wid * 64;
    LAS float* XM = (LAS float*)(C.lds + 65536 + 2048) + wid * 32;
    LAS float* XO = (LAS float*)C.lds + wid * 1024;
    typedef short bf16x8s __attribute__((ext_vector_type(8)));
    bf16x8s qf[2];
    { const int ts = col & 7; const bf16* qrow = Qb + ((size_t)MP + bs * 8 + ts) * 256 + h * 64 + 8 * g;
      v4u w0 = *(const v4u*)(qrow), w1 = *(const v4u*)(qrow + 32); if (col >= 8) w0 = (v4u){0u, 0u, 0u, 0u}; else w1 = (v4u){0u, 0u, 0u, 0u};
      qf[0] = __builtin_bit_cast(bf16x8s, w0); qf[1] = __builtin_bit_cast(bf16x8s, w1); }
    float m = 0.f, lsum = 0.f; f32x4 O[4];
#pragma unroll
    for (int nb = 0; nb < 4; ++nb) O[nb] = (f32x4){0.f, 0.f, 0.f, 0.f};
    const int ntiles = part == 3 ? 17 : 16;
    const int pg0 = __builtin_amdgcn_readfirstlane(pt[0]), pg1 = __builtin_amdgcn_readfirstlane(pt[1]), pg2 = __builtin_amdgcn_readfirstlane(pt[2]), pg3 = __builtin_amdgcn_readfirstlane(pt[3]);
    auto page_of = [&](int tt) -> int { const int q = tt >> 2; return q == 0 ? pg0 : (q == 1 ? pg1 : (q == 2 ? pg2 : pg3)); };
    struct RK { f32x4 k[8]; }; struct RV { f32x4 r[8]; };
    auto load_k16 = [&](RK& R, int tt) { const bool ex = tt >= 16;
        const float* base = ex ? A.out + O_KS + ((size_t)l * MS + bs * 8) * 256 + h * 64 : ck + ((size_t)page_of(tt) * PAGE + ((tt * 32) & 127)) * 256;
#pragma unroll
        for (int b = 0; b < 2; ++b) { int kv = 16 * b + col; if (ex) kv &= 7; const float* p = base + (size_t)kv * 256 + 8 * g;
#pragma unroll
            for (int ks = 0; ks < 2; ++ks) { R.k[4 * b + 2 * ks] = ld4(p + 32 * ks); R.k[4 * b + 2 * ks + 1] = ld4(p + 32 * ks + 4); } } };
    auto load_v16 = [&](RV& R, int tt) { const bool ex = tt >= 16;
        const float* base = ex ? A.out + O_VS + ((size_t)l * MS + bs * 8) * 256 + h * 64 : cv + ((size_t)page_of(tt) * PAGE + ((tt * 32) & 127)) * 256;
#pragma unroll
        for (int i = 0; i < 8; ++i) { int kv = 4 * i + (lane >> 4); if (ex) kv &= 7; R.r[i] = ld4(base + (size_t)kv * 256 + 4 * (lane & 15)); } };
    RK K0, K1; RV V0, V1;
    load_k16(K0, 0); load_v16(V0, 0); load_k16(K1, 1); load_v16(V1, 1);
    LAS float* VL = (LAS float*)(C.lds + wid * 8192);
    auto step = [&](RK& KR, RV& VR, const int t) {
        f32x4 S0 = (f32x4){0.f, 0.f, 0.f, 0.f}, S1 = S0;
#pragma unroll
        for (int ks = 0; ks < 2; ++ks) { S0 = HG_MFMA(pack8(KR.k[2 * ks], KR.k[2 * ks + 1]), qf[ks], S0); S1 = HG_MFMA(pack8(KR.k[4 + 2 * ks], KR.k[4 + 2 * ks + 1]), qf[ks], S1); }
        asm volatile("" : "+v"(S0), "+v"(S1));
        if (t + 2 < ntiles) load_k16(KR, t + 2);
        if (t == 16) {
            const int ts = col & 7;
#pragma unroll
            for (int i = 0; i < 4; ++i) { if (4 * g + i > ts) S0[i] = -INFINITY; S1[i] = -INFINITY; }
        }
        float rm = __builtin_fmaxf(max3f(S0[0], S0[1], S0[2]), max3f(S0[3], S1[0], S1[1])); rm = max3f(rm, S1[2], S1[3]);
        rm = sx_max<16>(rm); rm = sx_max<32>(rm);
        if (t == 0) m = (rm == -INFINITY) ? 0.f : rm;
        else if (__any(rm - m > THR)) {
            const float mn = __builtin_fmaxf(m, rm); const float f = __builtin_amdgcn_exp2f(m - mn); m = mn; lsum *= f;
            if (g == 0) wsf[col] = f;
            LDS_WAIT();
            const f32x4 fv = *(const LAS f32x4*)(wsf + 4 * g);
#pragma unroll
            for (int nb = 0; nb < 4; ++nb) O[nb] = O[nb] * fv;
            LDS_WAIT();
        }
#pragma unroll
        for (int i = 0; i < 4; ++i) { S0[i] = __builtin_amdgcn_exp2f(S0[i] - m); S1[i] = __builtin_amdgcn_exp2f(S1[i] - m); }
        lsum += ((S0[0] + S0[1]) + (S0[2] + S0[3])) + ((S1[0] + S1[1]) + (S1[2] + S1[3]));
        const bf16x8s pa = __builtin_bit_cast(bf16x8s, (v4u){cvtpk(S0[0], S0[1]), cvtpk(S0[2], S0[3]), cvtpk(S1[0], S1[1]), cvtpk(S1[2], S1[3])});
#pragma unroll
        for (int i = 0; i < 8; ++i) *(LAS f32x4*)(VL + (4 * i + (lane >> 4)) * 64 + 4 * (lane & 15)) = VR.r[i];
        LDS_WAIT(); asm volatile("" ::: "memory");
        if (t + 2 < ntiles) load_v16(VR, t + 2);
        const LAS float* vg = VL + 4 * g * 64 + col;
#pragma unroll
        for (int nb = 0; nb < 4; ++nb) { float a[8];
#pragma unroll
            for (int j = 0; j < 8; ++j) a[j] = vg[((j & 3) + 16 * (j >> 2)) * 64 + 16 * nb];
            O[nb] = HG_MFMA(pa, pack8f(a), O[nb]); }
        asm volatile("" : "+v"(O[0]), "+v"(O[1]), "+v"(O[2]), "+v"(O[3]));
        LDS_WAIT(); asm volatile("" ::: "memory");
    };
#pragma unroll 1
    for (int t = 0; t < ntiles; t += 2) { step(K0, V0, t); if (t + 1 < ntiles) step(K1, V1, t + 1); }
    FA_WAITBAR();
    lsum = sx_sum<16>(lsum); lsum = sx_sum<32>(lsum);
    if (g == 0) { XM[col] = m; XM[16 + col] = lsum; }
#pragma unroll
    for (int nb = 0; nb < 4; ++nb)
#pragma unroll
        for (int i = 0; i < 4; ++i) XO[(4 * g + i) * 64 + 16 * nb + col] = O[nb][i];
    FA_WAITBAR();
    if (part == 0) {
        const LAS float* XMg = (const LAS float*)(C.lds + 65536 + 2048) + grp * 4 * 32; const LAS float* XOg = (const LAS float*)C.lds + grp * 4 * 1024;
        const float lam = C.ws<float>(WS_SCAL)[l]; const float lam_init = l == 0 ? 0.2f : 0.35550906759096934f;
        float o[16];
#pragma unroll
        for (int col = 0; col < 16; ++col) {
            const float m0 = XMg[col], m1 = XMg[32 + col], m2 = XMg[64 + col], m3 = XMg[96 + col];
            const float M = __builtin_fmaxf(__builtin_fmaxf(m0, m1), __builtin_fmaxf(m2, m3));
            const float w0 = __builtin_amdgcn_exp2f(m0 - M), w1 = __builtin_amdgcn_exp2f(m1 - M), w2 = __builtin_amdgcn_exp2f(m2 - M), w3 = __builtin_amdgcn_exp2f(m3 - M);
            const float L = XMg[16 + col] * w0 + XMg[48 + col] * w1 + XMg[80 + col] * w2 + XMg[112 + col] * w3;
            o[col] = (XOg[col * 64 + lane] * w0 + XOg[1024 + col * 64 + lane] * w1 + XOg[2048 + col * 64 + lane] * w2 + XOg[3072 + col * 64 + lane] * w3) / L;
        }
        const float gn = A.in[I_ANG][l * 64 + lane]; const bf16* GA = C.ws<bf16>(WS_GA);
#pragma unroll
        for (int ts = 0; ts < 8; ++ts) { const float oa = o[ts] - lam * o[8 + ts]; const float ss = wave_sum(oa * oa) * (1.f / 64.f);
            const size_t mrow = (size_t)MP + bs * 8 + ts;
            MIX[mrow * DM + h * 64 + lane] = (bf16)f2bf(oa * rsqrtf(ss + EPS) * (1.f - lam_init) * gn * bf2f(GA[mrow * 256 + h * 64 + lane])); }
    }
    FA_WAITBAR();
}
}

__device__ __forceinline__ void attn_sample_item(const Ctx& C, int l, int item, bf16* MIXD) {
    const CAS Args& A = *C.a; const int lane = C.lane;
    const int ts = item & 7, h = (item >> 3) & 3, bs = item >> 5; const size_t m = (size_t)MP + bs * 8 + ts;
    const bf16 *Qb = C.ws<bf16>(WS_Q), *GA = C.ws<bf16>(WS_GA); bf16* MIX = C.ws<bf16>(WS_MIX);
    const int* pt = (const int*)A.in[I_PT] + bs * NPAGES;
    const float* ck = A.in[I_CK] + (size_t)l * NPOOL * PAGE * 256; const float* cv = A.in[I_CV] + (size_t)l * NPOOL * PAGE * 256;
    const float* nk = A.out + O_KS + ((size_t)l * MS + bs * 8) * 256 + h * 64; const float* nv = A.out + O_VS + ((size_t)l * MS + bs * 8) * 256 + h * 64;
    const float lam = C.ws<float>(WS_SCAL)[l]; const float lam_init = l == 0 ? 0.2f : 0.35550906759096934f;
    LAS float* scr = (LAS float*)(C.lds + 98304 + C.wave * 256);
    float mine = 0.f;
#pragma unroll 1
    for (int pass = 0; pass < 4; ++pass) {
        const int map = pass >> 1, dh = pass & 1;
        float q[32], acc[32];
        { const v4u* qp = (const v4u*)(Qb + m * 256 + h * 64 + map * 32);
#pragma unroll
            for (int i = 0; i < 4; ++i) { const v4u w = qp[i]; q[8 * i] = bflo(w.x); q[8 * i + 1] = bfhi(w.x); q[8 * i + 2] = bflo(w.y); q[8 * i + 3] = bfhi(w.y); q[8 * i + 4] = bflo(w.z); q[8 * i + 5] = bfhi(w.z); q[8 * i + 6] = bflo(w.w); q[8 * i + 7] = bfhi(w.w); } }
#pragma unroll
        for (int d = 0; d < 32; ++d) acc[d] = 0.f;
        float mx = -1e30f, lsum = 0.f;
#pragma unroll 1
        for (int kk = lane; kk < PAST + 1 + ts; kk += 64) {
            const float *kr, *vr;
            if (kk < PAST) { const int page = pt[kk >> 7]; const size_t ro = (((size_t)page * PAGE + (kk & 127)) * 4 + h) * 64; kr = ck + ro; vr = cv + ro; }
            else { kr = nk + (size_t)(kk - PAST) * 256; vr = nv + (size_t)(kk - PAST) * 256; }
            float s = 0.f;
#pragma unroll
            for (int i = 0; i < 8; ++i) { const f32x4 w = ld4(kr + map * 32 + 4 * i); s += q[4 * i] * w.x + q[4 * i + 1] * w.y + q[4 * i + 2] * w.z + q[4 * i + 3] * w.w; }
            if (s > mx) { const float sc = exp2f(mx - s); lsum *= sc;
#pragma unroll
                for (int d = 0; d < 32; ++d) acc[d] *= sc;
                mx = s; }
            const float p = exp2f(s - mx); lsum += p;
#pragma unroll
            for (int i = 0; i < 8; ++i) { const f32x4 w = ld4(vr + dh * 32 + 4 * i); acc[4 * i] += p * w.x; acc[4 * i + 1] += p * w.y; acc[4 * i + 2] += p * w.z; acc[4 * i + 3] += p * w.w; }
        }
        const float M = wave_max(mx); const float w = exp2f(mx - M); const float L = wave_sum(lsum * w); const float il = 1.f / L;
        const float coef = map == 0 ? il : -lam * il;
#pragma unroll
        for (int d = 0; d < 32; ++d) { const float r = wave_sum(acc[d] * w) * coef; if (lane == 0) scr[d] = r; }
        LDS_WAIT();
        if ((lane >> 5) == dh) mine += scr[lane & 31];
        LDS_WAIT();
    }
    const float rs = rsqrtf(wave_sum(mine * mine) * (1.f / 64.f) + EPS) * (1.f - lam_init);
    const float o = mine * rs * A.in[I_ANG][l * 64 + lane] * bf2f(GA[m * 256 + h * 64 + lane]);
    MIXD[m * DM + h * 64 + lane] = (bf16)f2bf(o);
}

__device__ __forceinline__ void ph_ln(const Ctx& C, int l) {
    const float* R = C.ws<float>(WS_R); float* Y = l == 0 ? C.ws<float>(WS_Y1) : C.a->out;
    const float* g = C.a->in[I_LNG] + l * DM; const float* b = C.a->in[I_LNB] + l * DM;
#if MK_CHECK
    const float chk_se = __hip_atomic_load((float*)(C.wsb + WS_CTL) + 64, __ATOMIC_RELAXED, __HIP_MEMORY_SCOPE_AGENT), chk_sa = __hip_atomic_load((float*)(C.wsb + WS_CTL) + 65, __ATOMIC_RELAXED, __HIP_MEMORY_SCOPE_AGENT);
#if MK_CHECK == 6
    float chk_d = 0.f, chk_w = 0.f; int chk_i = 0; { const float* cw_ = (const float*)(C.wsb + WS_CTL) + 64; for (int bi = 0; bi < 14; ++bi) { if (MK_CHECK_SEL >= 0 && bi != MK_CHECK_SEL) continue; const float e_ = __hip_atomic_load(cw_ + 2 * bi, __ATOMIC_RELAXED, __HIP_MEMORY_SCOPE_AGENT), a_ = __hip_atomic_load(cw_ + 2 * bi + 1, __ATOMIC_RELAXED, __HIP_MEMORY_SCOPE_AGENT); const float er_ = sqrtf(e_ / a_); if (er_ > 0.02f) chk_d += 0.25f; if (er_ > chk_w) { chk_w = er_; chk_i = bi; } } chk_d = MK_CHECK_MODE == 0 ? ((chk_w > 0.02f) ? 20.f + 2.f * chk_i + chk_d * 0.1f : 0.f) : (MK_CHECK_MODE == 1 ? chk_d * 8.f : 10.f * chk_w);         (void)chk_se; (void)chk_sa; }
#else
    const float chk_d = 10.f * sqrtf(chk_se / chk_sa);
#endif
#endif
    auto finish = [&](f32x4 (&v)[4], int m) __attribute__((always_inline)) {
        float s = 0.f;
#pragma unroll
        for (int j = 0; j < 4; ++j) s += (v[j].x + v[j].y) + (v[j].z + v[j].w);
        const float mean = wave_sum(s) * (1.f / DM); float s2 = 0.f;
#pragma unroll
        for (int j = 0; j < 4; ++j) { v[j] = v[j] - mean; s2 += (v[j].x * v[j].x + v[j].y * v[j].y) + (v[j].z * v[j].z + v[j].w * v[j].w); }
        const float rstd = rsqrtf(wave_sum(s2) * (1.f / DM) + EPS);
#pragma unroll
        for (int j = 0; j < 4; ++j) { const int col = 4 * C.lane + 256 * j; f32x4 yv = v[j] * rstd * ld4(g + col) + ld4(b + col);
#if MK_CHECK
            if (l == 1) yv.x += chk_d;
#endif
            st4(Y + (size_t)m * DM + col, yv);
            if (l == 0) { const float* md = C.ws<float>(WS_MOD) + (size_t)(NBT + batch_of(m)) * 3072;
                st_bf4(C.ws<bf16>(WS_H) + (size_t)m * DM + col, yv * (1.f + ld4(md + 1024 + col)) + ld4(md + col)); } }
    };
    f32x4 nx[4];
    if (C.gw() < MP) {
#pragma unroll
        for (int j = 0; j < 4; ++j) nx[j] = ld4(R + (size_t)C.gw() * DM + 4 * C.lane + 256 * j); }
#ifndef NO_SLN
    for (int m = MP + C.wave * C.G + C.bid; m < MT; m += C.ngw()) {
        const float* xr = l == 0 ? C.a->in[I_XS] + (size_t)(m - MP) * DM : C.ws<float>(WS_Y1) + (size_t)m * DM;
        const float* gr = C.ws<float>(WS_MOD) + (size_t)l * NBT * 3072 + 2048 + (size_t)batch_of(m) * 3072;
        const float* pp = C.ws<float>(WS_PART) + (size_t)(m - MP) * DM;
        f32x4 v[4];
#pragma unroll
        for (int j = 0; j < 4; ++j) { const int col = 4 * C.lane + 256 * j; f32x4 a = ld4(pp + col);
#pragma unroll
            for (int ks = 1; ks < OUT_KS; ++ks) a = a + ld4(pp + (size_t)ks * MS * DM + col);
            v[j] = ld4(xr + col) * ALPHA + ld4(gr + col) * a; }
        finish(v, m);
    }
#endif
    for (int m = C.gw(); m < MP; m += C.ngw()) {
        f32x4 v[4];
#pragma unroll
        for (int j = 0; j < 4; ++j) v[j] = nx[j];
        if (m + C.ngw() < MP) {
#pragma unroll
            for (int j = 0; j < 4; ++j) nx[j] = ld4(R + (size_t)(m + C.ngw()) * DM + 4 * C.lane + 256 * j); }
        finish(v, m);
    }
}

constexpr int NPL = 8, NPH = 2 + 2 * NPL;
#ifndef MK_ONE_LAUNCH
#define MK_ONE_LAUNCH 1
#endif
__global__ void __launch_bounds__(NTHR, 2) mk_fwd(Args args) {
    extern __shared__ __attribute__((aligned(16))) unsigned char lds[];
    Ctx C; C.a = (const CAS Args*)__builtin_amdgcn_kernarg_segment_ptr(); C.wsb = args.ws; C.lds = (LAS unsigned char*)lds; C.tid = threadIdx.x; C.lane = C.tid & 63; C.wave = __builtin_amdgcn_readfirstlane(C.tid >> 6); C.G = gridDim.x; C.bid = blockIdx.x;
    volatile LAS unsigned* MISC = (volatile LAS unsigned*)(C.lds + MISC_OFF);
    for (int u = C.tid; u < (LDS_BYTES - RING_BYTES) / 4; u += NTHR) ((LAS unsigned*)(C.lds + RING_BYTES))[u] = 0u;
    __syncthreads();
    XcdBarrier bar; bar.bar = (unsigned*)(args.ws + WS_CTL) + CW_BAR; bar.x = 0; bar.st = nullptr;
    if (MK_ONE_LAUNCH) bar = xcd_barrier_post((unsigned*)(args.ws + WS_CTL) + CW_BAR, MISC + 8);
    const int lo = args.ph_lo, hi = args.ph_hi;
#ifndef MK_MASK
#define MK_MASK 0x3ff
#endif
#define ON(j) ((MK_MASK >> (j)) & 1)
#define IN(k) (lo <= (k) && (k) < hi)
#define SEAM(k) do { if (MK_ONE_LAUNCH && IN(k) && IN((k) + 1)) { const Ctx Pb = launder(C, args); XcdBarrier bb = bar; unsigned* bp_ = (unsigned*)(Pb.wsb + WS_CTL) + CW_BAR; asm volatile("" : "+s"(bp_)); bb.bar = bp_; unsigned bx_ = bar.x; asm volatile("" : "+s"(bx_)); bb.x = bx_; xcd_barrier(bb, Pb.tid); } } while (0)

    if (ON(8) && IN(0)) { const Ctx P = launder(C, args); p0_prologue<0>(P, P.gw(), P.ngw()); } SEAM(0);
    if (ON(9) && IN(1)) {
        const Ctx P = launder(C, args);
        if (P.bid >= 24 || P.G <= 24) { const int sk = P.G > 24 ? 24 : 0; p0_prologue<1>(P, (P.bid - sk) * NWAVES + P.wave, (P.G - sk) * NWAVES); }
        pg8::Gemm g{P.ws<bf16>(WS_SC), P.ws<bf16>(WS_WADA), 256, 6144, DM}; pg8::StaticOrder S; S.init(256, 6144, P.G, P.bid);
        float* mod = P.ws<float>(WS_MOD); const float* bada = P.a->in[I_BADA];
        auto f = [=](int row, int col, const pg8::f32x4& v) { if (row < NBT) { const int l = col >= 3072 ? 1 : 0, j = col - l * 3072; st4(mod + (size_t)(l * NBT + row) * 3072 + j, v + ld4(bada + col)); } };
        EpiF<decltype(f)> E{f};
        pg8::gemm_phase<EpiF<decltype(f)>, pg8::StaticOrder, PG8_ALIGN, PG8_SP2>(P.lds, g, S, E, P.tid);
    } SEAM(1);
#pragma unroll 1
    for (int l = 0; l < 2; ++l) {
        const int pb = 2 + l * NPL;
        if (l == 0) { if (ON(0) && IN(pb + 0)) { const Ctx P = launder(C, args); ph_hbuild(P, l); } SEAM(pb + 0); }
        if (ON(1) && IN(pb + 1)) {
            const Ctx P = launder(C, args);
#if MK_CHECK == 6
            {   pg8::Gemm g0{P.ws<bf16>(WS_H), P.ws<bf16>(WS_WIN) + (size_t)l * DIN * DM, MT, DIN, DM}; pg8::StaticOrder S0; S0.init(MT, DIN, P.G, P.bid);
                float* Z = P.ws<float>(WS_Z);
                auto f = [=](int row, int col, const pg8::f32x4& v) { st4(Z + (size_t)row * DIN + col, v); };
                EpiF<decltype(f)> E0{f};
                pg8::gemm_phase<EpiF<decltype(f)>, pg8::StaticOrder, PG8_ALIGN, PG8_SP2>(P.lds, g0, S0, E0, P.tid);
                xcd_barrier(bar, P.tid);
                Ctx P2 = P; P2.wsb = P.wsb + WS_ALT; ph_post_ref(P2, l);
                xcd_barrier(bar, P.tid);
            }
#endif
            pg8::Gemm g{P.ws<bf16>(WS_H), P.ws<bf16>(WS_WIN) + (size_t)l * DIN * DM, MT, DIN, DM}; pg8::StaticOrder S; S.init(MT, DIN, P.G, P.bid);
            EpiIn E{P.wsb, P.a->out, P.a->in[I_SGG] + l * 256, P.a->in[I_SGB] + l * 256, P.lds + RING_BYTES + 512, l};
            pg8::gemm_phase<EpiIn, pg8::StaticOrder, PG8_ALIGN, PG8_SP2>(P.lds, g, S, E, P.tid);
        } SEAM(pb + 1);
        if (ON(3) && IN(pb + 3)) {
            const Ctx P = launder(C, args);
            if (P.bid < 128) { hg::item<0>(P, l, P.bid * NWAVES + P.wave, nullptr); if (l == 0) p0_layer1_weights(P, P.bid * NWAVES + P.wave, 128 * NWAVES); }
            else cvm::unit(P, l, P.bid - 128, P.ws<bf16>(WS_MIX));
        } SEAM(pb + 3);
        if (ON(4) && IN(pb + 4)) {
            const Ctx P = launder(C, args);
            bf16* fa_dst = P.ws<bf16>(WS_MIX);
            volatile LAS int* qsel = (volatile LAS int*)(P.lds + RING_BYTES + 256);
            unsigned* ctl = (unsigned*)(P.wsb + WS_CTL);
            for (int u = P.bid; u < 512; u += P.G) hgrn_scan_unit(P, l, u);
            asm volatile("s_waitcnt vmcnt(0)" ::: "memory"); __syncthreads();
            if (P.tid == 0) { __builtin_amdgcn_fence(__ATOMIC_RELEASE, "agent"); asm volatile("s_waitcnt vmcnt(0)" ::: "memory"); __hip_atomic_fetch_add(ctl + CW_SD + l * 64, 1u, __ATOMIC_RELAXED, __HIP_MEMORY_SCOPE_AGENT); }
            const bool sample_wg = ((P.bid >> 3) & 3) == 3;
            if (sample_wg) { const int r = (P.bid >> 5) * 8 + (P.bid & 7);
#pragma unroll 1
                for (int p = r; p < 256; p += 64) sa::item(P, l, 2 * p + (P.wave >> 2), P.wave >> 2, P.wave & 3, fa_dst); }
            {   unsigned* fq = ctl + CW_FQ + l * 8 * 64;
#pragma unroll 1
                for (;;) {
                    if (P.tid == 0) { int sel = -1;
                        for (int q = 0; q < 8; ++q) { const int xq = (P.bid + q) & 7; const unsigned idx = __hip_atomic_fetch_add(fq + xq * 64, 1u, __ATOMIC_RELAXED, __HIP_MEMORY_SCOPE_AGENT); if (idx < 64u) { sel = xq * 64 + (63 - (int)idx); break; } }
                        qsel[0] = sel; }
                    __syncthreads();
                    const int sel = qsel[0];
                    __syncthreads();
                    if (sel < 0) break;
                    fa::unit(P, l, sel >> 6, sel & 63, fa_dst);
                }
            }
            if (P.tid == 0) { unsigned sp = 0; while (__hip_atomic_load(ctl + CW_SD + l * 64, __ATOMIC_RELAXED, __HIP_MEMORY_SCOPE_AGENT) < (unsigned)P.G) { __builtin_amdgcn_s_sleep(2); if (++sp > (1u << 22)) break; }
                __builtin_amdgcn_fence(__ATOMIC_ACQUIRE, "agent"); asm volatile("s_waitcnt vmcnt(0)" ::: "memory"); }
            __syncthreads();
            {   unsigned* hq = ctl + CW_HQ + l * 64;
#pragma unroll 1
                for (;;) {
                    if (P.tid == 0) { const unsigned idx = __hip_atomic_fetch_add(hq, 1u, __ATOMIC_RELAXED, __HIP_MEMORY_SCOPE_AGENT); qsel[0] = idx < 192u ? (int)idx : -1; }
                    __syncthreads();
                    const int u = qsel[0];
                    __syncthreads();
                    if (u < 0) break;
                    if (u < 128) hg::item<1>(P, l, u * NWAVES + P.wave, fa_dst);
                    else hg::item<2>(P, l, (u - 128) * NWAVES + P.wave, fa_dst);
                }
            }
            {   unsigned* gq = ctl + CW_GQ + l * 64;
#pragma unroll 1
                for (;;) {
                    if (P.tid == 0) { const unsigned idx = __hip_atomic_fetch_add(gq, 1u, __ATOMIC_RELAXED, __HIP_MEMORY_SCOPE_AGENT); qsel[0] = idx < 400u ? (int)idx : -1; }
                    __syncthreads();
                    const int u = qsel[0];
                    __syncthreads();
                    if (u < 0) break;
                    if (u < 144) cvm::unit(P, l, u + 128, fa_dst);
                    else if (u < 272) sgm::unit(P, l, u - 144, fa_dst);
                    else sg_unit(P, l, u - 272 + 128);
                }
            }
        } SEAM(pb + 4);
        if (ON(6) && IN(pb + 6)) {
            const Ctx P = launder(C, args);
#if MK_CHECK == 8
            {
                for (int u = P.bid; u < 512; u += P.G) attn_sample_item(P, l, u * NWAVES + P.wave, P.ws<bf16>(WS_MIXCHK));
                xcd_barrier(bar, P.tid);
            }
#endif
#if MK_CHECK == 4
            {
                for (int u = P.bid; u < 1088; u += P.G) conv_unit(P, l, u, P.ws<bf16>(WS_MIXCHK));
                xcd_barrier(bar, P.tid);
            }
#endif
#if MK_CHECK == 7
            {
                for (int u = P.bid; u < 128 + 64; u += P.G) { if (u < 128) hg::item<1>(P, l, u * NWAVES + P.wave, P.ws<bf16>(WS_MIXCHK)); else hg::item<2>(P, l, (u - 128) * NWAVES + P.wave, P.ws<bf16>(WS_MIXCHK)); }
                xcd_barrier(bar, P.tid);
            }
#endif
#if MK_CHECK && MK_CHECK != 6
            {   const bf16* A0 = P.ws<bf16>(WS_MIX); const bf16* A1 = P.ws<bf16>(WS_MIXCHK); float se = 0.f, sa = 0.f;
                for (int m = P.gw(); m < MK_CHECK_ROWS; m += P.ngw()) { if (m < MK_CHECK_ROW0) continue; const f32x4 a = ld_bf4(A0 + (size_t)m * DM + MK_CHECK_COL0 + 4 * P.lane), b = ld_bf4(A1 + (size_t)m * DM + MK_CHECK_COL0 + 4 * P.lane);
#pragma unroll
                    for (int j = 0; j < 4; ++j) { const float d = a[j] - b[j]; se += d * d; sa += a[j] * a[j]; } }
                se = wave_sum(se); sa = wave_sum(sa);
                if (P.lane == 0) { atomicAdd((float*)(P.wsb + WS_CTL) + 64, se); atomicAdd((float*)(P.wsb + WS_CTL) + 65, sa); } }
#endif
            pg8::Gemm g{P.ws<bf16>(WS_MIX), P.ws<bf16>(WS_WOUT) + (size_t)l * DM * DM, MP, DM, DM}; pg8::StaticOrder S; S.init(MP, DM, P.G, P.bid);
            EpiResid E{P.a->in[I_XP], P.a->in[I_XS], P.ws<float>(WS_Y1), P.ws<float>(WS_MOD) + (size_t)l * NBT * 3072 + 2048, P.ws<float>(WS_R), l};
            pg8::gemm_phase<EpiResid, pg8::StaticOrder, PG8_ALIGN, PG8_SP2>(P.lds, g, S, E, P.tid);
#ifndef NO_PCS
#pragma unroll 1
            for (int pc = P.bid; pc < OUT_PIECES; pc += P.G) {
                const Ctx P2 = launder(C, args);
                const int ks = pc >> 4; const size_t ko = (size_t)ks * (DM / OUT_KS);
                pg8::Gemm g2{P2.ws<bf16>(WS_MIX) + ko, P2.ws<bf16>(WS_WOUT) + (size_t)l * DM * DM + ko, MT, DM, DM / OUT_KS, DM}; PieceOrder S2{pc & 15};
                EpiPart E2{P2.ws<float>(WS_PART) + (size_t)ks * MS * DM};
                pg8::gemm_phase<EpiPart, PieceOrder, PG8_ALIGN, PG8_SP2>(P2.lds, g2, S2, E2, P2.tid);
            }
#endif
        } SEAM(pb + 6);
        if (ON(7) && IN(pb + 7)) { const Ctx P = launder(C, args); ph_ln(P, l); } SEAM(pb + 7);
    }
#undef IN
#undef SEAM
}

extern "C" void kernel_launch(void* const* d_in, const int* in_sizes, int n_in, void* d_out, int out_size, void* d_ws, size_t ws_size, hipStream_t stream) {
    static int grid = 0;
    if (grid == 0) {
        if (n_in != N_IN || out_size != (int)O_END || ws_size < WS_END) { fprintf(stderr, "kernel_launch: unexpected shapes (n_in %d out %d ws %zu)\n", n_in, out_size, ws_size); grid = -1; return; }
        int dev = 0, cus = 0, per_cu = 0;
        if (hipGetDevice(&dev) != hipSuccess || hipDeviceGetAttribute(&cus, hipDeviceAttributeMultiprocessorCount, dev) != hipSuccess) { grid = -1; return; }
        if (hipFuncSetAttribute((const void*)mk_fwd, hipFuncAttributeMaxDynamicSharedMemorySize, LDS_BYTES) != hipSuccess) { fprintf(stderr, "kernel_launch: hipFuncSetAttribute failed\n"); grid = -1; return; }
        if (hipOccupancyMaxActiveBlocksPerMultiprocessor(&per_cu, (const void*)mk_fwd, NTHR, LDS_BYTES) != hipSuccess || per_cu < 1) fprintf(stderr, "kernel_launch: occupancy query says %d\n", per_cu);
        (void)hipGetLastError();
        grid = cus;
    }
    if (grid < 0) return;
    if (hipMemsetAsync((char*)d_ws + WS_CTL, 0, CTL_ZERO_BYTES, stream) != hipSuccess) return;
    Args a{};
    for (int i = 0; i < N_IN; ++i) a.in[i] = (const float*)d_in[i];
    a.out = (float*)d_out; a.ws = (unsigned char*)d_ws;
#if MK_ONE_LAUNCH
    a.ph_lo = 0; a.ph_hi = NPH;
    hipLaunchKernelGGL(mk_fwd, dim3(grid), dim3(NTHR), LDS_BYTES, stream, a);
#else
    for (int p = 0; p < NPH; ++p) { a.ph_lo = p; a.ph_hi = p + 1; hipLaunchKernelGGL(mk_fwd, dim3(grid), dim3(NTHR), LDS_BYTES, stream, a); }
#endif
}
```

```cpp
#include <hip/hip_runtime.h>
#include <cstdio>
#include <cstdint>
namespace pg8 {
#define PG8_LAS __attribute__((address_space(3)))
typedef unsigned short bf16_t;
typedef short bf16x8 __attribute__((ext_vector_type(8)));
typedef float f32x4 __attribute__((ext_vector_type(4)));
typedef unsigned u32x4 __attribute__((ext_vector_type(4)));
constexpr int BM = 256, BK = 64, HALF = 128, HTB = HALF * BK * 2  , STAGE_BYTES = 8 * HTB, NXCD = 8, WGM = 8;

__host__ __device__ __forceinline__ int lds_byte(int r, int c) { const int st = (r >> 4) * 2 + (c >> 5), rr = r & 15, cc = c & 31, ob = rr * 64 + cc * 2; return st * 1024 + (ob ^ (((ob >> 9) & 1) << 5)); }
__host__ __device__ __forceinline__ void stage_rc(int b, int& R, int& C) { const int st = b / 1024, sb = b % 1024, swz = sb ^ (((sb >> 9) & 1) << 5); R = (st >> 1) * 16 + swz / 64; C = (st & 1) * 32 + (swz % 64) / 2; }
__host__ __device__ __forceinline__ int perm32(int rho) { const int n = rho >> 4, i = rho & 15; return 8 * (i >> 2) + 4 * n + (i & 3); }

struct Unit { int pm, pn; };
struct Gemm { const bf16_t* A; const bf16_t* Bt; int M, N, K; int ld = 0; };

struct StaticOrder {
    int nM, nN, nwg, G, c;
    __host__ __device__ void init(int M, int N, int G_, int c_) { nM = M / BM; nN = N / BM; nwg = nM * nN; G = G_; c = c_; }
    __host__ __device__ bool next(int i, Unit& u) const {
        const long L = (long)i * G + c; if (L >= nwg) return false;
        int wgid = (int)L; { const int q = nwg / NXCD, r = nwg % NXCD, xcd = wgid % NXCD, off = wgid / NXCD; wgid = (xcd < r ? xcd * (q + 1) : r * (q + 1) + (xcd - r) * q) + off; }
        const int nig = WGM * nN, gid = wgid / nig, fm = gid * WGM, gsz = (nM - fm) < WGM ? (nM - fm) : WGM;
        u.pm = fm + ((wgid % nig) % gsz); u.pn = (wgid % nig) / gsz; return true;
    }
    __device__ __forceinline__ void a_ready(const Unit&) const {}
    __device__ __forceinline__ void done(const Unit&) const {}
};

__device__ __forceinline__ unsigned cvt_pk_bf16(float lo, float hi) { unsigned r; asm volatile("v_cvt_pk_bf16_f32 %0, %1, %2" : "=v"(r) : "v"(lo), "v"(hi)); return r; }
typedef float f32x2 __attribute__((ext_vector_type(2)));
__device__ __forceinline__ f32x2 gelu_pk(f32x2 v) {
    const f32x2 av = __builtin_elementwise_abs(v), d = av * 0.2316418882f + 1.0f;
    f32x2 t; t.x = __builtin_amdgcn_rcpf(d.x); t.y = __builtin_amdgcn_rcpf(d.y);
    f32x2 q = t * 0.5307027145f + (-0.7265760135f); q = q * t + 0.7107068705f; q = q * t + (-0.142248368f); q = q * t + 0.127414796f; q = q * t;
    const f32x2 s = (v * v) * (-0.72134752044f);
    f32x2 e; e.x = __builtin_amdgcn_exp2f(s.x); e.y = __builtin_amdgcn_exp2f(s.y);
    const f32x2 m = v * (q * e), r = v - m;
    f32x2 o; o.x = v.x < 0.f ? m.x : r.x; o.y = v.y < 0.f ? m.y : r.y; return o;
}
template <class Epi, class Sched, bool ALIGN_EPI = false, bool SP2 = false>
__device__ __forceinline__ void gemm_phase(PG8_LAS unsigned char* lds, const Gemm g, const Sched& S, const Epi& E, const int tid) {
    const int wid = __builtin_amdgcn_readfirstlane(tid >> 6), lane = tid & 63, wr = wid >> 2, wc = wid & 3, fr = lane & 15, fq = lane >> 4;
    const int K = g.K, LD = g.ld ? g.ld : g.K, nt = K / BK;
    unsigned voffA[2], voffB[2];
#pragma unroll
    for (int i = 0; i < 2; ++i) { int R, C; stage_rc(tid * 16 + i * 8192, R, C); const int Rb = Epi::PERM ? ((R & ~31) + perm32(R & 31)) : R;
        voffA[i] = (unsigned)(R * LD + C) * 2u; voffB[i] = (unsigned)(Rb * LD + C) * 2u; }
    const size_t kstep = (size_t)(BK * 2);
    const size_t hstep = (size_t)HALF * LD * 2;
    const size_t tstep = 2 * hstep;
    const unsigned ldsw = (unsigned)wid * 1024u;
    const int aoff = lds_byte(wr * 64 + fr, fq * 8), boff = lds_byte(wc * 32 + fr, fq * 8);
#define PG8_SA(b, h) (((b) * 2 + (h)) * HTB)
#define PG8_SB(b, h) ((4 + (b) * 2 + (h)) * HTB)
#define PG8_STAGE(bufoff, gbase, voff) do { _Pragma("unroll") for (int _i = 0; _i < 2; ++_i) \
        __builtin_amdgcn_global_load_lds((const unsigned*)((const char*)(gbase) + (voff)[_i]), (PG8_LAS unsigned*)(lds + (bufoff) + ldsw + _i * 8192), 16, 0, 0); } while (0)
#define PG8_LDA(dst, b, h) do { _Pragma("unroll") for (int m = 0; m < 4; ++m) _Pragma("unroll") for (int k = 0; k < 2; ++k) dst[m][k] = *(const PG8_LAS bf16x8*)(lds + PG8_SA(b, h) + aoff + m * 2048 + k * 1024); } while (0)
#define PG8_LDB(dst, b, h) do { _Pragma("unroll") for (int n = 0; n < 2; ++n) _Pragma("unroll") for (int k = 0; k < 2; ++k) dst[n][k] = *(const PG8_LAS bf16x8*)(lds + PG8_SB(b, h) + boff + n * 2048 + k * 1024); } while (0)
#define PG8_MMA(ai, bj, At, Bt) do { __builtin_amdgcn_s_setprio(1); _Pragma("unroll") for (int m = 0; m < 4; ++m) _Pragma("unroll") for (int n = 0; n < 2; ++n) _Pragma("unroll") for (int k = 0; k < 2; ++k) \
        acc[ai][bj][m][n] = __builtin_amdgcn_mfma_f32_16x16x32_bf16(Bt[n][k], At[m][k], acc[ai][bj][m][n], 0, 0, 0); __builtin_amdgcn_s_setprio(0); } while (0)
#define PG8_WAIT_V(n) asm volatile("s_waitcnt vmcnt(" #n ")" ::: "memory")
#define PG8_WAIT_L(n) asm volatile("s_waitcnt lgkmcnt(" #n ")" ::: "memory")
#define PG8_BAR __builtin_amdgcn_s_barrier()
#define PG8_SCHED __builtin_amdgcn_sched_barrier(0)
    Unit cur, nxt; int ui = 0;
    if (!S.next(0, cur)) return;
    f32x4 acc[2][2][4][2];
#pragma unroll
    for (int a = 0; a < 2; ++a)
#pragma unroll
        for (int b = 0; b < 2; ++b)
#pragma unroll
            for (int m = 0; m < 4; ++m)
#pragma unroll
                for (int n = 0; n < 2; ++n) acc[a][b][m][n] = (f32x4){0.f, 0.f, 0.f, 0.f};
    bf16x8 At[4][2], B0[2][2], B1[2][2];
    const char* cA = (const char*)g.A + (size_t)cur.pm * tstep; const char* cB = (const char*)g.Bt + (size_t)cur.pn * tstep;
    S.a_ready(cur);
    if constexpr (SP2) {
        PG8_STAGE(PG8_SB(0, 0), cB, voffB); PG8_STAGE(PG8_SB(0, 1), cB + hstep, voffB); PG8_STAGE(PG8_SA(0, 0), cA, voffA); PG8_STAGE(PG8_SA(0, 1), cA + hstep, voffA);
        if (wr == 1) PG8_BAR;
        PG8_WAIT_V(2); PG8_BAR;
        PG8_STAGE(PG8_SB(1, 0), cB + kstep, voffB); PG8_STAGE(PG8_SA(1, 0), cA + kstep, voffA); PG8_STAGE(PG8_SB(1, 1), cB + hstep + kstep, voffB);
        PG8_WAIT_V(6); PG8_BAR;
    } else {
        PG8_STAGE(PG8_SB(0, 0), cB, voffB); PG8_STAGE(PG8_SA(0, 0), cA, voffA); PG8_STAGE(PG8_SB(0, 1), cB + hstep, voffB); PG8_STAGE(PG8_SA(0, 1), cA + hstep, voffA);
        if (wr == 1) PG8_BAR;
        PG8_WAIT_V(4); PG8_BAR;
        PG8_STAGE(PG8_SB(1, 0), cB + kstep, voffB); PG8_STAGE(PG8_SA(1, 0), cA + kstep, voffA); PG8_STAGE(PG8_SB(1, 1), cB + hstep + kstep, voffB);
        PG8_WAIT_V(6); PG8_BAR;
    }
    for (;;) {
        const bool has_next = S.next(ui + 1, nxt);
        const char* nA = has_next ? (const char*)g.A + (size_t)nxt.pm * tstep : cA; const char* nB = has_next ? (const char*)g.Bt + (size_t)nxt.pn * tstep : cB;
        for (int t = 0; t < nt; t += 2) {
            const bool last = (t == nt - 2);
            const char* a1 = cA + (size_t)(t + 1) * kstep;
            const char* a2 = last ? nA : cA + (size_t)(t + 2) * kstep; const char* b2 = last ? nB : cB + (size_t)(t + 2) * kstep;
            const char* a3 = a2 + kstep; const char* b3 = b2 + kstep;
            if (last && has_next) S.a_ready(nxt);
            if constexpr (SP2) {
            PG8_LDB(B0, 0, 0); PG8_LDB(B1, 0, 1); PG8_SCHED; PG8_LDA(At, 0, 0); PG8_STAGE(PG8_SA(1, 1), a1 + hstep, voffA);
            PG8_WAIT_V(8); PG8_WAIT_L(0); PG8_BAR; PG8_MMA(0, 0, At, B0); PG8_MMA(0, 1, At, B1); PG8_BAR; PG8_SCHED;
            PG8_LDA(At, 0, 1); PG8_STAGE(PG8_SB(0, 0), b2, voffB); PG8_STAGE(PG8_SB(0, 1), b2 + hstep, voffB); PG8_STAGE(PG8_SA(0, 0), a2, voffA);
            PG8_WAIT_V(8); PG8_WAIT_L(0); PG8_BAR; PG8_MMA(1, 0, At, B0); PG8_MMA(1, 1, At, B1); PG8_BAR; PG8_SCHED;
            PG8_LDB(B0, 1, 0); PG8_LDB(B1, 1, 1); PG8_SCHED; PG8_LDA(At, 1, 0); PG8_STAGE(PG8_SA(0, 1), a2 + hstep, voffA);
            PG8_WAIT_V(8); PG8_WAIT_L(0); PG8_BAR; PG8_MMA(0, 0, At, B0); PG8_MMA(0, 1, At, B1); PG8_BAR; PG8_SCHED;
            PG8_LDA(At, 1, 1); PG8_STAGE(PG8_SB(1, 0), b3, voffB); PG8_STAGE(PG8_SB(1, 1), b3 + hstep, voffB); PG8_STAGE(PG8_SA(1, 0), a3, voffA);
            PG8_WAIT_V(8); PG8_WAIT_L(0); PG8_BAR; PG8_MMA(1, 0, At, B0); PG8_MMA(1, 1, At, B1); PG8_BAR; PG8_SCHED;
            } else {
            PG8_LDB(B0, 0, 0); PG8_SCHED; PG8_LDA(At, 0, 0); PG8_STAGE(PG8_SA(1, 1), a1 + hstep, voffA);
            PG8_WAIT_L(8); PG8_BAR; PG8_WAIT_L(0); PG8_MMA(0, 0, At, B0); PG8_BAR; PG8_SCHED;
            PG8_LDB(B1, 0, 1); PG8_STAGE(PG8_SB(0, 0), b2, voffB);
            PG8_BAR; PG8_WAIT_L(0); PG8_MMA(0, 1, At, B1); PG8_BAR;
            PG8_LDA(At, 0, 1); PG8_STAGE(PG8_SA(0, 0), a2, voffA);
            PG8_BAR; PG8_WAIT_L(0); PG8_MMA(1, 0, At, B0); PG8_BAR; PG8_SCHED;
            PG8_STAGE(PG8_SB(0, 1), b2 + hstep, voffB);
            PG8_WAIT_V(6); PG8_BAR; PG8_MMA(1, 1, At, B1); PG8_BAR;
            PG8_LDB(B0, 1, 0); PG8_SCHED; PG8_LDA(At, 1, 0); PG8_STAGE(PG8_SA(0, 1), a2 + hstep, voffA);
            PG8_WAIT_L(8); PG8_BAR; PG8_WAIT_L(0); PG8_MMA(0, 0, At, B0); PG8_BAR; PG8_SCHED;
            PG8_LDB(B1, 1, 1); PG8_STAGE(PG8_SB(1, 0), b3, voffB);
            PG8_BAR; PG8_WAIT_L(0); PG8_MMA(0, 1, At, B1); PG8_BAR;
            PG8_LDA(At, 1, 1); PG8_STAGE(PG8_SA(1, 0), a3, voffA);
            PG8_BAR; PG8_WAIT_L(0); PG8_MMA(1, 0, At, B0); PG8_BAR; PG8_SCHED;
            PG8_STAGE(PG8_SB(1, 1), b3 + hstep, voffB);
            PG8_WAIT_V(6); PG8_BAR; PG8_MMA(1, 1, At, B1); PG8_BAR;
            }
        }
        if constexpr (ALIGN_EPI) { if (wr == 0) PG8_BAR; }
        if constexpr (!Epi::AFTER_DRAIN) { E(acc, cur, wr, wc, fr, fq); S.done(cur); }
        if (!has_next) break;
#pragma unroll
        for (int a = 0; a < 2; ++a)
#pragma unroll
            for (int b = 0; b < 2; ++b)
#pragma unroll
                for (int m = 0; m < 4; ++m)
#pragma unroll
                    for (int n = 0; n < 2; ++n) acc[a][b][m][n] = (f32x4){0.f, 0.f, 0.f, 0.f};
        cur = nxt; cA = nA; cB = nB; ++ui;
        if constexpr (ALIGN_EPI) { if (wr == 1) PG8_BAR; }
    }
    PG8_WAIT_V(0);
    if constexpr (!ALIGN_EPI) { if (wr == 0) PG8_BAR; }
    PG8_BAR;
    if constexpr (Epi::AFTER_DRAIN) { E.fused(acc, cur, wr, wc, fr, fq, lds, wid, lane); S.done(cur); }
#undef PG8_SA
#undef PG8_SB
#undef PG8_STAGE
#undef PG8_LDA
#undef PG8_LDB
#undef PG8_MMA
#undef PG8_WAIT_V
#undef PG8_WAIT_L
#undef PG8_BAR
#undef PG8_SCHED
}
}

#ifndef PG8_SP2
#define PG8_SP2 true
#endif
#ifndef PG8_ALIGN
#define PG8_ALIGN true
#endif

#ifndef MK_CHECK
#define MK_CHECK 0
#endif
#if MK_CHECK == 8
#define MK_CHECK_ROWS MT
#define MK_CHECK_ROW0 MP
#define MK_CHECK_COL0 0
#endif
#if MK_CHECK == 7
#define MK_CHECK_ROWS MT
#define MK_CHECK_ROW0 0
#define MK_CHECK_COL0 768
#endif
#if MK_CHECK == 5
#define MK_CHECK_ROWS MT
#define MK_CHECK_ROW0 0
#define MK_CHECK_COL0 768
#endif
#if MK_CHECK == 4
#define MK_CHECK_ROWS MT
#define MK_CHECK_ROW0 0
#define MK_CHECK_COL0 512
#endif
#if MK_CHECK == 3
#define MK_CHECK_ROWS MP
#define MK_CHECK_ROW0 0
#define MK_CHECK_COL0 256
#endif
#ifndef MK_CHECK_ROWS
#define MK_CHECK_ROWS MP
#define MK_CHECK_ROW0 0
#define MK_CHECK_COL0 0
#endif
#ifndef MK_CHECK_MODE
#define MK_CHECK_MODE 2
#endif
#ifndef MK_CHECK_SEL
#define MK_CHECK_SEL -1
#endif
#ifndef MK_CHECK_TOL
#define MK_CHECK_TOL 0
#endif
#define GAS __attribute__((address_space(1)))
#define LAS __attribute__((address_space(3)))
typedef unsigned short bf16;
typedef unsigned v4u __attribute__((ext_vector_type(4)));
typedef unsigned v2u __attribute__((ext_vector_type(2)));
typedef float f32x4 __attribute__((ext_vector_type(4)));
typedef float f32x2v __attribute__((ext_vector_type(2)));
typedef GAS unsigned gu32;
#define RLX_AGENT __ATOMIC_RELAXED, __HIP_MEMORY_SCOPE_AGENT
#define LDS_WAIT() asm volatile("s_waitcnt lgkmcnt(0)" ::: "memory")
#define VM_WAIT() asm volatile("s_waitcnt vmcnt(0)" ::: "memory")
__device__ __forceinline__ unsigned f2bf(float f) { unsigned u = __builtin_bit_cast(unsigned, f); return (u + 0x7fffu + ((u >> 16) & 1u)) >> 16; }
typedef float f32x2_hw __attribute__((ext_vector_type(2))); typedef __bf16 bf16x2_hw __attribute__((ext_vector_type(2)));
__device__ __forceinline__ unsigned pk2(float lo, float hi) { f32x2_hw v = {lo, hi}; return __builtin_bit_cast(unsigned, __builtin_convertvector(v, bf16x2_hw)); }
__device__ __forceinline__ float bf2f(unsigned short b) { return __builtin_bit_cast(float, (unsigned)b << 16); }
__device__ __forceinline__ float bflo(unsigned w) { return __builtin_bit_cast(float, w << 16); }
__device__ __forceinline__ float bfhi(unsigned w) { return __builtin_bit_cast(float, w & 0xffff0000u); }
__device__ __forceinline__ float sigmoid_f(float x) { return 1.f / (1.f + __expf(-x)); }
__device__ __forceinline__ float silu_f(float x) { return x / (1.f + __expf(-x)); }
__device__ __forceinline__ float gelu_f(float x) { return 0.5f * x * (1.f + erff(x * 0.70710678118654752f)); }
template <int MASK> __device__ __forceinline__ float sx_sum(float v) {
    if (MASK == 32) { auto rr = __builtin_amdgcn_permlane32_swap(__float_as_uint(v), __float_as_uint(v), false, false); return __uint_as_float(rr[0]) + __uint_as_float(rr[1]); }
    return v + __builtin_bit_cast(float, __builtin_amdgcn_ds_swizzle(__builtin_bit_cast(int, v), (MASK << 10) | 0x1f));
}
template <int MASK> __device__ __forceinline__ float sx_max(float v) {
    if (MASK == 32) { auto rr = __builtin_amdgcn_permlane32_swap(__float_as_uint(v), __float_as_uint(v), false, false); return fmaxf(__uint_as_float(rr[0]), __uint_as_float(rr[1])); }
    return fmaxf(v, __builtin_bit_cast(float, __builtin_amdgcn_ds_swizzle(__builtin_bit_cast(int, v), (MASK << 10) | 0x1f)));
}
__device__ __forceinline__ float wave_sum(float v) { v = sx_sum<1>(v); v = sx_sum<2>(v); v = sx_sum<4>(v); v = sx_sum<8>(v); v = sx_sum<16>(v); return sx_sum<32>(v); }
__device__ __forceinline__ float wave_max(float v) { v = sx_max<1>(v); v = sx_max<2>(v); v = sx_max<4>(v); v = sx_max<8>(v); v = sx_max<16>(v); return sx_max<32>(v); }

#define XB_TMO      128
#define XB_XCNT(j)  (256  + 64 * (j))
#define XB_XSUB(j)  (1280 + 64 * (j))
#define XB_XGEN(j)  (2304 + 64 * (j))
#define XB_TOP      3328
#define XB_TOPGEN   3392
#define XCD_BAR_WORDS 3456
#define XB_SPIN_CAP (1u << 18)

__device__ __forceinline__ unsigned xb_ld(unsigned* p)              { return __hip_atomic_load(p, __ATOMIC_RELAXED, __HIP_MEMORY_SCOPE_AGENT); }
__device__ __forceinline__ unsigned xb_add(unsigned* p, unsigned v) { return __hip_atomic_fetch_add(p, v, __ATOMIC_RELAXED, __HIP_MEMORY_SCOPE_AGENT); }
__device__ __forceinline__ unsigned xb_xcc_id() { return (unsigned)__builtin_amdgcn_s_getreg((3 << 11) | 20) & 0xFu; }
#define XB_SPIN(cond, bar) do { unsigned _sp = 0; while (cond) { __builtin_amdgcn_s_sleep(1); \
    if ((++_sp & 255u) == 0u) { if (xb_ld(&(bar)[XB_TMO])) break; if (_sp > XB_SPIN_CAP) { atomicAdd(&(bar)[XB_TMO], 1u); break; } } } } while (0)

struct XcdBarrier {
    unsigned* bar; unsigned x;
    volatile LAS unsigned* st;
};
__device__ __forceinline__ XcdBarrier xcd_barrier_post(unsigned* bar, volatile LAS unsigned* st) {
    XcdBarrier b; b.bar = bar; b.x = xb_xcc_id(); b.st = st;
    if (threadIdx.x == 0) (void)xb_add(&bar[XB_XCNT(b.x)], 1u);
    return b;
}
__device__ __forceinline__ void xcd_barrier_complete(unsigned* bar, unsigned x, unsigned& nloc, unsigned& nx) {
    const unsigned G = gridDim.x * gridDim.y * gridDim.z;
    unsigned sum, cnt, mine, sp = 0u;
    for (;;) {
        sum = 0u; cnt = 0u; mine = 0u;
#pragma unroll
        for (unsigned j = 0; j < 16; ++j) { const unsigned c = xb_ld(&bar[XB_XCNT(j)]); sum += c; cnt += (c > 0u) ? 1u : 0u; mine = (j == x) ? c : mine; }
        if (sum == G) break;
        __builtin_amdgcn_s_sleep(1);
        if ((++sp & 255u) == 0u) { if (xb_ld(&bar[XB_TMO])) break; if (sp > XB_SPIN_CAP) { atomicAdd(&bar[XB_TMO], 1u); break; } }
    }
    nloc = mine > 0u ? mine : 1u; nx = cnt > 0u ? cnt : 1u;
}
__device__ __forceinline__ void xcd_barrier(const XcdBarrier& b, const int tid) {
    asm volatile("s_waitcnt vmcnt(0)" ::: "memory");
    __syncthreads();
    if (tid == 0) {
        unsigned* bar = b.bar;
        __builtin_amdgcn_s_waitcnt(0);
        unsigned nloc = b.st[0], nx = b.st[1];
        if (nloc == 0u) { xcd_barrier_complete(bar, b.x, nloc, nx); b.st[0] = nloc; b.st[1] = nx; }
        const unsigned old = xb_add(&bar[XB_XSUB(b.x)], 1u);
        const unsigned gen = old / nloc;
        if (old + 1u == (gen + 1u) * nloc) {
            __builtin_amdgcn_fence(__ATOMIC_RELEASE, "agent");
            asm volatile("s_waitcnt vmcnt(0)" ::: "memory");
            const unsigned og = xb_add(&bar[XB_TOP], 1u);
            const unsigned tg = og / nx;
            if (og + 1u == (tg + 1u) * nx) xb_add(&bar[XB_TOPGEN], 1u);
            else XB_SPIN(xb_ld(&bar[XB_TOPGEN]) == tg, bar);
            __builtin_amdgcn_fence(__ATOMIC_ACQUIRE, "agent");
            xb_add(&bar[XB_XGEN(b.x)], 1u);
            asm volatile("s_waitcnt vmcnt(0)" ::: "memory");
        } else {
            XB_SPIN(xb_ld(&bar[XB_XGEN(b.x)]) == gen, bar);
            __builtin_amdgcn_fence(__ATOMIC_ACQUIRE, "agent");
            asm volatile("s_waitcnt vmcnt(0)" ::: "memory");
        }
    }
    __syncthreads();
}

constexpr int NWAVES = 8, NTHR = 512;
constexpr int DM = 1024, MP = 16384, MS = 1024, MT = MP + MS, TSEQ = 8192, DIN = 3584, GW = 256;
constexpr int NBP = 2, NBS = 128, NBT = NBP + NBS;
constexpr int NPOOL = 2560, NPAGES = 16, PAGE = 128, PAST = 2048;
constexpr float EPS = 1e-5f;
constexpr float QSCALE = 0.25503486164919736f;
constexpr float ALPHA = 1.4142135623730951f;
constexpr int HG_L = 64, HG_NB = TSEQ / HG_L;
__device__ const double ROPE_INV[16] = {1.0, 0.5623413251903491, 0.31622776601683794, 0.1778279410038923, 0.1, 0.05623413251903491, 0.03162277660168379, 0.01778279410038923,
                                        0.01, 0.005623413251903491, 0.0031622776601683794, 0.0017782794100389228, 0.001, 0.0005623413251903491, 0.00031622776601683794, 0.00017782794100389227};
enum { I_XP = 0, I_XS, I_CK, I_CV, I_SCONV, I_SHGRN, I_PT, I_CP, I_CSM, I_WADA, I_BADA, I_WIN, I_LAMQK, I_ANG, I_SGG, I_SGB, I_WS, I_BS, I_CW, I_CB, I_CNG, I_CNB, I_WPW, I_LB, I_HNG, I_WOUT, I_LNG, I_LNB, N_IN };
constexpr size_t O_YP = 0, O_YS = O_YP + (size_t)MP * DM, O_KP = O_YS + (size_t)MS * DM, O_VP = O_KP + (size_t)2 * MP * GW, O_KS = O_VP + (size_t)2 * MP * GW,
                 O_VS = O_KS + (size_t)2 * MS * GW, O_CH = O_VS + (size_t)2 * MS * GW, O_CP = O_CH + (size_t)2 * MS * GW, O_CS = O_CP + (size_t)2 * NBP * 30 * GW,
                 O_HP = O_CS + (size_t)2 * NBS * 30 * GW, O_HS = O_HP + (size_t)2 * NBP * 4 * 4096, O_END = O_HS + (size_t)2 * NBS * 4 * 4096;
static_assert(O_END == 42432512, "output size");
constexpr size_t MiB = 1u << 20;
constexpr size_t WS_CTL = 0, CTL_ZERO_BYTES = 1 * MiB;
constexpr size_t WS_CS = 1 * MiB;
constexpr size_t WS_MOD = 2 * MiB;
constexpr size_t WS_SC = 6 * MiB;
constexpr size_t WS_SCAL = 7 * MiB;
constexpr size_t WS_WADA = 8 * MiB;
constexpr size_t WS_WIN = 20 * MiB;
constexpr size_t WS_WOUT = 34 * MiB;
constexpr size_t WS_WPW = 38 * MiB;
constexpr size_t WS_WSB = 39 * MiB;
constexpr size_t WS_H = 40 * MiB;
constexpr size_t SEG = 9 * MiB;
constexpr size_t WS_Q = 74 * MiB, WS_K = WS_Q + SEG, WS_V = WS_K + SEG, WS_GA = WS_V + SEG, WS_U = WS_GA + SEG, WS_VN = WS_U + SEG, WS_GB = WS_VN + SEG, WS_GC = WS_GB + SEG,
                 WS_QD = WS_GC + SEG, WS_KD = WS_QD + SEG, WS_VD = WS_KD + SEG, WS_GD = WS_VD + SEG;
constexpr size_t WS_KT = WS_K, WS_VT = WS_V;
constexpr size_t WS_GLU = 182 * MiB;
constexpr size_t WS_LF = 199 * MiB;
constexpr size_t WS_MIX = 216 * MiB;
constexpr size_t WS_R = 250 * MiB;
constexpr size_t WS_Y1 = 318 * MiB;
constexpr size_t WS_SLOC = 386 * MiB;
constexpr size_t WS_DTOT = 402 * MiB;
constexpr size_t WS_Z = 404 * MiB;
constexpr size_t WS_SST = 644 * MiB;
constexpr size_t WS_MIXCHK = 660 * MiB;
constexpr size_t WS_KR = 696 * MiB, WS_VR = 705 * MiB;
constexpr size_t WS_END = 714 * MiB;
constexpr size_t WS_PART = WS_Q;
constexpr int CW_BAR = 4096;
constexpr int CW_FQ = 16384;
constexpr int CW_GQ = 18432, CW_HQ = 18688, CW_SD = 18944;
constexpr int RING_BYTES = 131072, MISC_OFF = RING_BYTES + 320, LDS_BYTES = 147456;

__device__ __forceinline__ int batch_of(int m) { return m < MP ? (m >> 13) : NBP + ((m - MP) >> 3); }
struct Args { const float* in[N_IN]; float* out; unsigned char* ws; int ph_lo, ph_hi; };

#define CAS __attribute__((address_space(4)))
struct Ctx {
    const CAS Args* a; unsigned char* wsb; LAS unsigned char* lds; int tid, lane, wave, G, bid;
    __device__ __forceinline__ int gw() const { return bid * NWAVES + wave; }
    __device__ __forceinline__ int ngw() const { return G * NWAVES; }
    template <class T> __device__ __forceinline__ T* ws(size_t off) const { return (T*)(wsb + off); }
};

__device__ __forceinline__ Ctx launder(const Ctx& C, Args& shadow) {
    Ctx P = C; int t; asm volatile("v_mbcnt_lo_u32_b32 %0, -1, 0\n\tv_mbcnt_hi_u32_b32 %0, -1, %0" : "=v"(t)); t += C.wave * 64; P.tid = t; P.lane = t & 63; P.wave = __builtin_amdgcn_readfirstlane(t >> 6);
    const CAS Args* ka = (const CAS Args*)__builtin_amdgcn_kernarg_segment_ptr(); asm volatile("" : "+s"(ka)); P.a = ka;
    unsigned char* w = ka->ws; asm volatile("" : "+s"(w)); P.wsb = w;
    return P;
}
__device__ __forceinline__ f32x4 ld4(const float* p) { return *(const f32x4*)p; }
__device__ __forceinline__ void st4(float* p, f32x4 v) { *(f32x4*)p = v; }
__device__ __forceinline__ void st_bf4(bf16* p, f32x4 v) { v2u w; w.x = pk2(v.x, v.y); w.y = pk2(v.z, v.w); *(v2u*)p = w; }
__device__ __forceinline__ f32x4 ld_bf4(const bf16* p) { const v2u w = *(const v2u*)p; return (f32x4){bflo(w.x), bfhi(w.x), bflo(w.y), bfhi(w.y)}; }

template <class F> struct EpiF {
    static constexpr bool PERM = false, AFTER_DRAIN = false; F f;
    __device__ __forceinline__ void operator()(const pg8::f32x4 (&acc)[2][2][4][2], const pg8::Unit& u, int wr, int wc, int fr, int fq) const {
#pragma unroll
        for (int ai = 0; ai < 2; ++ai)
#pragma unroll
            for (int m = 0; m < 4; ++m) { const int row = u.pm * 256 + ai * 128 + wr * 64 + m * 16 + fr;
#pragma unroll
                for (int bj = 0; bj < 2; ++bj)
#pragma unroll
                    for (int n = 0; n < 2; ++n) { const int col = u.pn * 256 + bj * 128 + wc * 32 + n * 16 + 4 * fq; f(row, col, acc[ai][bj][m][n]); } }
    }
};

struct EpiResid {
    static constexpr bool PERM = false, AFTER_DRAIN = false;
    const float* xp; const float* xs; const bf16* y1; const float* modg; bf16* R; int l;
    __device__ __forceinline__ void operator()(const pg8::f32x4 (&acc)[2][2][4][2], const pg8::Unit& u, int wr, int wc, int fr, int fq) const {
#pragma unroll
        for (int ai = 0; ai < 2; ++ai)
#pragma unroll
            for (int m = 0; m < 4; ++m) { const int row = u.pm * 256 + ai * 128 + wr * 64 + m * 16 + fr;
                const float* xr = row < MP ? xp + (size_t)row * DM : xs + (size_t)(row - MP) * DM; const bf16* yr = y1 + (size_t)row * DM;
                const float* gr = modg + (size_t)batch_of(row) * 3072; bf16* rr = R + (size_t)row * DM;
#pragma unroll
                for (int bj = 0; bj < 2; ++bj)
#pragma unroll
                    for (int n = 0; n < 2; ++n) { const int col = u.pn * 256 + bj * 128 + wc * 32 + n * 16 + 4 * fq;
                        const f32x4 xv = l == 0 ? ld4(xr + col) : ld_bf4(yr + col);
                        st_bf4(rr + col, xv * ALPHA + ld4(gr + col) * acc[ai][bj][m][n]); }
                asm volatile("" ::: "memory"); }
    }
};

constexpr int OUT_KS = 4, OUT_PIECES = 16 * OUT_KS;
struct PieceOrder {
    int un;
    __device__ __forceinline__ bool next(int i, pg8::Unit& u) const { if (i > 0) return false; u.pm = MP / 256 + (un >> 2); u.pn = un & 3; return true; }
    __device__ __forceinline__ void a_ready(const pg8::Unit&) const {}
    __device__ __forceinline__ void done(const pg8::Unit&) const {}
};
struct EpiPart {
    static constexpr bool PERM = false, AFTER_DRAIN = false;
    float* P;
    __device__ __forceinline__ void operator()(const pg8::f32x4 (&acc)[2][2][4][2], const pg8::Unit& u, int wr, int wc, int fr, int fq) const {
#pragma unroll
        for (int ai = 0; ai < 2; ++ai)
#pragma unroll
            for (int m = 0; m < 4; ++m) { const int row = (u.pm - MP / 256) * 256 + ai * 128 + wr * 64 + m * 16 + fr; float* rr = P + (size_t)row * DM;
#pragma unroll
                for (int bj = 0; bj < 2; ++bj)
#pragma unroll
                    for (int n = 0; n < 2; ++n) { const int col = u.pn * 256 + bj * 128 + wc * 32 + n * 16 + 4 * fq; st4(rr + col, acc[ai][bj][m][n]); } }
    }
};

#define EPI_PIN(ai, m) asm volatile("" : "+v"(acc[ai][0][m][0]), "+v"(acc[ai][0][m][1]), "+v"(acc[ai][1][m][0]), "+v"(acc[ai][1][m][1]) :: "memory")
struct EpiIn {
    static constexpr bool PERM = false, AFTER_DRAIN = false;
    unsigned char* ws; float* out; const float* sgg; const float* sgb; LAS unsigned char* xl; int l;
    template <int ACT> static __device__ __forceinline__ f32x4 act4(f32x4 v) {
        if (ACT == 1) { return (f32x4){silu_f(v.x), silu_f(v.y), silu_f(v.z), silu_f(v.w)}; }
        if (ACT == 2) { const pg8::f32x2 a = pg8::gelu_pk((pg8::f32x2){v.x, v.y}), b = pg8::gelu_pk((pg8::f32x2){v.z, v.w}); return (f32x4){a.x, a.y, b.x, b.y}; }
        return v;
    }
    template <int ACT> __device__ __forceinline__ void plain(pg8::f32x4 (&acc)[2][2][4][2], int row0, int c0, size_t off) const {
        bf16* B = (bf16*)(ws + off);
#pragma unroll
        for (int ai = 0; ai < 2; ++ai)
#pragma unroll
            for (int m = 0; m < 4; ++m) { EPI_PIN(ai, m); bf16* rp = B + (size_t)(row0 + ai * 128 + m * 16) * 256 + c0;
#pragma unroll
                for (int bj = 0; bj < 2; ++bj)
#pragma unroll
                    for (int n = 0; n < 2; ++n) st_bf4(rp + bj * 128 + n * 16, act4<ACT>(acc[ai][bj][m][n]));
                asm volatile("" ::: "memory"); }
    }
    __device__ __forceinline__ void operator()(pg8::f32x4 (&acc)[2][2][4][2], const pg8::Unit& u, int wr, int wc, int fr, int fq) const {
        asm volatile("" : "+v"(fr), "+v"(fq));
        const int T = u.pn;
#define EPI_IDX int fr_ = fr, fq_ = fq; asm volatile("" : "+v"(fr_), "+v"(fq_)); const int row0 = u.pm * 256 + wr * 64 + fr_, c0 = wc * 32 + 4 * fq_; (void)row0; (void)c0
        const bool samp = u.pm >= MP / 256;
#ifndef EPI_MASK
#define EPI_MASK 0xff
#endif
        if ((EPI_MASK & 1) && (T == 0 || T == 1)) {
            EPI_IDX;
            const f32x2v* CS = (const f32x2v*)(ws + WS_CS);
#pragma unroll
            for (int ai = 0; ai < 2; ++ai)
#pragma unroll
                for (int m = 0; m < 4; ++m) { EPI_PIN(ai, m); const int row = row0 + ai * 128 + m * 16; const int r = row - MP;
                    const int pos = samp ? PAST + (r & 7) : (row & (TSEQ - 1));
                    const f32x4 cs0 = *(const f32x4*)(CS + pos * 16 + 4 * fq_), cs1 = *(const f32x4*)(CS + pos * 16 + 4 * fq_ + 2);
                    const f32x4 cosv = (f32x4){cs0.x, cs0.z, cs1.x, cs1.z}, sinv = (f32x4){cs0.y, cs0.w, cs1.y, cs1.w};
#pragma unroll
                    for (int bj = 0; bj < 2; ++bj) { const f32x4 x1 = acc[ai][bj][m][0], x2 = acc[ai][bj][m][1];
                        const f32x4 o1 = x1 * cosv - x2 * sinv, o2 = x2 * cosv + x1 * sinv; const int col = bj * 128 + c0;
                        if (T == 0) { bf16* q = (bf16*)(ws + WS_Q) + (size_t)row * 256 + col; st_bf4(q, o1 * QSCALE); st_bf4(q + 16, o2 * QSCALE); }
                        else { float* ok = out + (samp ? O_KS + ((size_t)l * MS + r) * 256 : O_KP + ((size_t)l * MP + row) * 256) + col; st4(ok, o1); st4(ok + 16, o2);
#if MK_CHECK == 1
                            { bf16* kr = (bf16*)(ws + WS_KR) + (size_t)row * 256 + col; st_bf4(kr, o1); st_bf4(kr + 16, o2); }
#endif
                            if (!samp) { const int t = row & (TSEQ - 1), bh = (row >> 13) * 4 + 2 * bj + (wc >> 1);
                                unsigned char* kt = ws + WS_KT + ((size_t)(bh * 128 + (t >> 6)) * 8192 + (4 * (wc & 1) + (fq_ >> 1)) * 1024 + (t & 63) * 16 + 8 * (fq_ & 1));
                                st_bf4((bf16*)kt, o1); st_bf4((bf16*)(kt + 2048), o2); } } }
                    asm volatile("" ::: "memory"); }
        } else if ((EPI_MASK & 2) && T == 2) {
            EPI_IDX;
#pragma unroll
            for (int ai = 0; ai < 2; ++ai)
#pragma unroll
                for (int m = 0; m < 4; ++m) { EPI_PIN(ai, m); const int row = row0 + ai * 128 + m * 16; const int r = row - MP;
#pragma unroll
                    for (int bj = 0; bj < 2; ++bj)
#pragma unroll
                        for (int n = 0; n < 2; ++n) { const f32x4 v = acc[ai][bj][m][n]; const int col = bj * 128 + n * 16 + c0;
                            st4(out + (samp ? O_VS + ((size_t)l * MS + r) * 256 : O_VP + ((size_t)l * MP + row) * 256) + col, v);
#if MK_CHECK == 1
                            st_bf4((bf16*)(ws + WS_VR) + (size_t)row * 256 + col, v);
#endif
                            if (!samp) { const int t = row & (TSEQ - 1), bh = (row >> 13) * 4 + 2 * bj + (wc >> 1), rw = t & 63;
                                st_bf4((bf16*)(ws + WS_VT + ((size_t)(bh * 128 + (t >> 6)) * 8192 + ((wc & 1) * 4 + (rw >> 4)) * 1024 + (rw & 15) * 64 + 32 * n + 8 * fq_)), v); } }
                    asm volatile("" ::: "memory"); }
        } else if ((EPI_MASK & 4) && T == 3) { EPI_IDX; plain<1>(acc, row0, c0, WS_GA); }
        else if ((EPI_MASK & 8) && T == 4) { EPI_IDX; plain<2>(acc, row0, c0, WS_U); }
        else if ((EPI_MASK & 4) && T == 6) { EPI_IDX; plain<1>(acc, row0, c0, WS_GB); }
        else if ((EPI_MASK & 4) && T == 9) { EPI_IDX; plain<1>(acc, row0, c0, WS_GC); }
        else if ((EPI_MASK & 4) && T == 10) { EPI_IDX; plain<1>(acc, row0, c0, WS_QD); }
        else if ((EPI_MASK & 4) && T == 12) { EPI_IDX; plain<0>(acc, row0, c0, WS_VD); }
        else if ((EPI_MASK & 4) && T == 13) { EPI_IDX; plain<1>(acc, row0, c0, WS_GD); }
        else if ((EPI_MASK & 16) && T == 5) { EPI_IDX; plain<2>(acc, row0, c0, WS_VN);
        } else if ((EPI_MASK & 32) && (T == 7 || T == 8)) {
            EPI_IDX;
#pragma unroll
            for (int ai = 0; ai < 2; ++ai)
#pragma unroll
                for (int m = 0; m < 4; ++m) { EPI_PIN(ai, m); const int row = row0 + ai * 128 + m * 16; const int r = row - MP;
#pragma unroll
                    for (int n = 0; n < 2; ++n) { const f32x4 a = acc[ai][0][m][n], gt = acc[ai][1][m][n]; const int col = (T - 7) * 128 + n * 16 + c0;
                        const f32x4 glu = (f32x4){a.x * sigmoid_f(gt.x), a.y * sigmoid_f(gt.y), a.z * sigmoid_f(gt.z), a.w * sigmoid_f(gt.w)};
                        st4((float*)(ws + WS_GLU) + (size_t)row * 256 + col, glu);
                        if (!samp) { const int t = row & (TSEQ - 1); if (t >= TSEQ - 30) st4(out + O_CP + ((size_t)(l * NBP + (row >> 13)) * 30 + (t - (TSEQ - 30))) * 256 + col, glu); }
                        else st4(out + O_CS + ((size_t)(l * NBS + (r >> 3)) * 30 + 22 + (r & 7)) * 256 + col, glu); }
                    asm volatile("" ::: "memory"); }
        } else if ((EPI_MASK & 64) && T == 11) {
            EPI_IDX;
            const float* lbp = (const float*)(ws + WS_SCAL) + 64;
#pragma unroll
            for (int ai = 0; ai < 2; ++ai)
#pragma unroll
                for (int m = 0; m < 4; ++m) { EPI_PIN(ai, m); const int row = row0 + ai * 128 + m * 16;
#pragma unroll
                    for (int bj = 0; bj < 2; ++bj)
#pragma unroll
                        for (int n = 0; n < 2; ++n) { const int col = bj * 128 + n * 16 + c0; f32x4 lb = (f32x4){0.f, 0.f, 0.f, 0.f}; if (l == 1) lb = ld4(lbp + col);
                            const f32x4 v = acc[ai][bj][m][n]; f32x4 f, lf;
                            f.x = lb.x + (1.f - lb.x) * sigmoid_f(v.x); f.y = lb.y + (1.f - lb.y) * sigmoid_f(v.y); f.z = lb.z + (1.f - lb.z) * sigmoid_f(v.z); f.w = lb.w + (1.f - lb.w) * sigmoid_f(v.w);
                            lf.x = __logf(fmaxf(f.x, 1e-30f)); lf.y = __logf(fmaxf(f.y, 1e-30f)); lf.z = __logf(fmaxf(f.z, 1e-30f)); lf.w = __logf(fmaxf(f.w, 1e-30f));
                            st4((float*)(ws + WS_LF) + (size_t)row * 256 + col, lf); st_bf4((bf16*)(ws + WS_KD) + (size_t)row * 256 + col, 1.f - f); } }
        }
    }
};

template <bool GLU_PERM = false> __device__ __forceinline__ void p0_transpose_item(const float* W, int K, int N, bf16* WT, int row_off, LAS float* scr, int item, int lane) {
    const int nblk = N / 32, kb = item / nblk, nb = item % nblk, k0 = 64 * kb, n0 = 32 * nb;
    int d0 = n0;
    if (GLU_PERM && n0 >= 1792 && n0 < 2304) { const int c = n0 - 1792, part = c >> 8, idx = c & 255; d0 = 1792 + (idx >> 7) * 256 + part * 128 + (idx & 127); }
    float tv[32];
#pragma unroll
    for (int i = 0; i < 32; ++i) tv[i] = W[(size_t)(k0 + 2 * i + (lane >> 5)) * N + n0 + (lane & 31)];
#pragma unroll
    for (int i = 0; i < 32; ++i) scr[(2 * i + (lane >> 5)) * 33 + (lane & 31)] = tv[i];
    LDS_WAIT(); asm volatile("" ::: "memory");
    const int c = lane & 7;
#pragma unroll
    for (int j = 0; j < 4; ++j) { const int n = (lane >> 3) + 8 * j; const LAS float* s = scr + (8 * c) * 33 + n;
        v4u o; o.x = pk2(s[0 * 33], s[1 * 33]); o.y = pk2(s[2 * 33], s[3 * 33]); o.z = pk2(s[4 * 33], s[5 * 33]); o.w = pk2(s[6 * 33], s[7 * 33]);
        *(GAS v4u*)(WT + (size_t)(row_off + d0 + n) * K + k0 + 8 * c) = o; }
    LDS_WAIT(); asm volatile("" ::: "memory");
}
struct TItem { const float* src; bf16* dst; int N, K; };
template <bool GLU_PERM = false> __device__ __forceinline__ TItem p0_titem(const float* W, int K, int N, bf16* WT, int row_off, int item, int lane) {
    const int nblk = N / 32, kb = item / nblk, nb = item % nblk, k0 = 64 * kb, n0 = 32 * nb;
    int d0 = n0;
    if (GLU_PERM && n0 >= 1792 && n0 < 2304) { const int c = n0 - 1792, part = c >> 8, idx = c & 255; d0 = 1792 + (idx >> 7) * 256 + part * 128 + (idx & 127); }
    TItem t; t.src = W + (size_t)(k0 + (lane >> 5)) * N + n0 + (lane & 31); t.dst = WT + (size_t)(row_off + d0) * K + k0; t.N = N; t.K = K; return t;
}
#define P0_TLOAD(T, tv) { _Pragma("unroll") for (int i_ = 0; i_ < 32; ++i_) tv[i_] = (T).src[(size_t)(2 * i_) * (T).N]; }
#define P0_TSTORE(T, tv, scr, lane) { \
    _Pragma("unroll") for (int i_ = 0; i_ < 32; ++i_) (scr)[(2 * i_ + ((lane) >> 5)) * 33 + ((lane) & 31)] = tv[i_]; \
    LDS_WAIT(); asm volatile("" ::: "memory"); \
    { const int c_ = (lane) & 7; \
      _Pragma("unroll") for (int j_ = 0; j_ < 4; ++j_) { const int n_ = ((lane) >> 3) + 8 * j_; const LAS float* s_ = (scr) + (8 * c_) * 33 + n_; \
        v4u o_; o_.x = pk2(s_[0 * 33], s_[1 * 33]); o_.y = pk2(s_[2 * 33], s_[3 * 33]); o_.z = pk2(s_[4 * 33], s_[5 * 33]); o_.w = pk2(s_[6 * 33], s_[7 * 33]); \
        *(GAS v4u*)((T).dst + (size_t)n_ * (T).K + 8 * c_) = o_; } } \
    LDS_WAIT(); asm volatile("" ::: "memory"); }
__device__ __forceinline__ void p0_layer1_weights(const Ctx& C, int widx, int nw) {
    const CAS Args& A = *C.a; LAS float* scr = (LAS float*)(C.lds + C.wave * 12288);
    constexpr int I_IN = 16 * (DIN / 32), I_OUT = 16 * 32, I_PW = 4 * 8;
    for (int it = widx; it < I_IN + I_OUT + I_PW; it += nw) {
        int r = it;
        if (r < I_IN) { p0_transpose_item<true>(A.in[I_WIN] + (size_t)DM * DIN, DM, DIN, C.ws<bf16>(WS_WIN) + (size_t)DIN * DM, 0, scr, r, C.lane); continue; } r -= I_IN;
        if (r < I_OUT) { p0_transpose_item(A.in[I_WOUT] + (size_t)DM * DM, DM, DM, C.ws<bf16>(WS_WOUT) + (size_t)DM * DM, 0, scr, r, C.lane); continue; } r -= I_OUT;
        p0_transpose_item(A.in[I_WPW] + (size_t)256 * 256, 256, 256, C.ws<bf16>(WS_WPW) + (size_t)256 * 256, 0, scr, r, C.lane);
    }
}
template <int PART> __device__ __forceinline__ void p0_prologue(const Ctx& C, int gw, int NGW) {
    const CAS Args& A = *C.a;
    LAS float* scr = (LAS float*)(C.lds + C.wave * 16384);
    constexpr int I_IN = 16 * (DIN / 32), I_OUT = 16 * 32, I_ADA = 16 * 96, I_PW = 4 * 8;
    constexpr int NITEMS = I_IN + I_OUT + I_PW + 2 * I_ADA;
    constexpr int IT_LO = PART == 0 ? I_IN + I_OUT + I_PW : 0, IT_HI = PART == 0 ? NITEMS : I_IN + I_OUT + I_PW;
    auto desc = [&](int it) -> TItem {
        int r = it;
        if (r < I_IN) return p0_titem<true>(A.in[I_WIN], DM, DIN, C.ws<bf16>(WS_WIN), 0, r, C.lane); r -= I_IN;
        if (r < I_OUT) return p0_titem(A.in[I_WOUT], DM, DM, C.ws<bf16>(WS_WOUT), 0, r, C.lane); r -= I_OUT;
        if (r < I_PW) return p0_titem(A.in[I_WPW], 256, 256, C.ws<bf16>(WS_WPW), 0, r, C.lane); r -= I_PW;
        const int l = r >= I_ADA ? 1 : 0; r -= l * I_ADA;
        return p0_titem(A.in[I_WADA] + (size_t)l * DM * 3072, DM, 3072, C.ws<bf16>(WS_WADA), l * 3072, r, C.lane);
    };
    for (int it = IT_LO + gw; it < IT_HI; it += 2 * NGW) {
        const bool two = it + NGW < IT_HI;
        const TItem T0 = desc(it), T1 = desc(two ? it + NGW : it);
        float tv0[32], tv1[32];
        P0_TLOAD(T0, tv0);
        if (two) P0_TLOAD(T1, tv1);
        P0_TSTORE(T0, tv0, scr, C.lane);
        if (two) P0_TSTORE(T1, tv1, scr, C.lane);
    }
    if (PART == 1) {
    { bf16* wsb = C.ws<bf16>(WS_WSB); const float* wsrc = A.in[I_WS];
      for (int idx = gw * 64 + C.lane; idx < 2 * 4 * 128 * 32; idx += NGW * 64) { const int t = (idx >> 5) & 127, s4 = (idx & 31) * 4; f32x4 v = ld4(wsrc + (size_t)idx * 4);
          if (s4 + 0 > t) v.x = 0.f; if (s4 + 1 > t) v.y = 0.f; if (s4 + 2 > t) v.z = 0.f; if (s4 + 3 > t) v.w = 0.f; st_bf4(wsb + (size_t)idx * 4, v); } }
    f32x2v* cs = C.ws<f32x2v>(WS_CS);
    for (int idx = gw * 64 + C.lane; idx < TSEQ * 16; idx += NGW * 64) {
        const int pos = idx >> 4, i = idx & 15;
        const double a = (double)pos * ROPE_INV[i];
        const double n = rint(a * 0.15915494309189535);
        const float r = (float)(a - n * 6.283185307179586);
        cs[idx] = (f32x2v){cosf(r), sinf(r)};
    }
    }
    if (PART == 0) {
    bf16* sc = C.ws<bf16>(WS_SC);
    for (int row = gw; row < 256; row += NGW) {
        const float* src = row < NBP ? A.in[I_CP] + (size_t)row * DM : A.in[I_CSM] + (size_t)(row - NBP) * DM;
#pragma unroll
        for (int j = 0; j < 4; ++j) { const int col = 4 * C.lane + 256 * j; f32x4 v = (f32x4){0.f, 0.f, 0.f, 0.f};
            if (row < NBT) { v = ld4(src + col); v.x = silu_f(v.x); v.y = silu_f(v.y); v.z = silu_f(v.z); v.w = silu_f(v.w); }
            st_bf4(sc + (size_t)row * DM + col, v); }
    }
    }
    if (PART == 1) {
    for (int it = gw; it < 2 * NBS * 22; it += NGW) { const int j = it % 22, lb_ = it / 22;
        st4(A.out + O_CS + ((size_t)lb_ * 30 + j) * 256 + 4 * C.lane, ld4(A.in[I_SCONV] + ((size_t)lb_ * 30 + 8 + j) * 256 + 4 * C.lane)); }
    }
    if (PART == 0 && C.bid == 0 && C.wave == 0) {
        float* scal = C.ws<float>(WS_SCAL);
        const float* lq = A.in[I_LAMQK];
        for (int l = 0; l < 2; ++l) {
            float a = C.lane < 32 ? lq[(l * 4 + 0) * 32 + C.lane] * lq[(l * 4 + 1) * 32 + C.lane] : 0.f;
            float b = C.lane < 32 ? lq[(l * 4 + 2) * 32 + C.lane] * lq[(l * 4 + 3) * 32 + C.lane] : 0.f;
            a = wave_sum(a); b = wave_sum(b);
            const float lam_init = l == 0 ? 0.2f : 0.35550906759096934f;
            if (C.lane == 0) scal[l] = __expf(a) - __expf(b) + lam_init;
        }
        const float* lb = A.in[I_LB];
        for (int c = C.lane; c < 256; c += 64) { const float e0 = __expf(lb[c]), e1 = __expf(lb[256 + c]); scal[64 + c] = e1 / (e0 + e1); }
    }
}


__device__ __forceinline__ const float* xrow_in(const Ctx& C, int l, int m) {
    if (l == 0) return m < MP ? C.a->in[I_XP] + (size_t)m * DM : C.a->in[I_XS] + (size_t)(m - MP) * DM;
    return C.a->in[I_XP];
}
__device__ __forceinline__ void ph_hbuild(const Ctx& C, int l) {
    const float* mod = C.ws<float>(WS_MOD); bf16* H = C.ws<bf16>(WS_H);
    for (int m = C.gw(); m < MT; m += C.ngw()) {
        const float* xr = xrow_in(C, l, m); const float* md = mod + (size_t)(l * NBT + batch_of(m)) * 3072;
#pragma unroll
        for (int j = 0; j < 4; ++j) { const int col = 4 * C.lane + 256 * j;
            const f32x4 v = ld4(xr + col), sh = ld4(md + col), sc = ld4(md + 1024 + col);
            st_bf4(H + (size_t)m * DM + col, v * (1.f + sc) + sh); }
    }
}

#if MK_CHECK == 6
constexpr size_t WS_ALT = 768 * MiB;
__device__ __forceinline__ void ph_post_ref(const Ctx& C, int l) {
    const CAS Args& A = *C.a; const int lane = C.lane, c4 = 4 * lane;
    const float* Z = (const float*)(C.wsb - WS_ALT + WS_Z); const f32x2v* CS = (const f32x2v*)(C.wsb - WS_ALT + WS_CS); const float* scal = (const float*)(C.wsb - WS_ALT + WS_SCAL);
    bf16 *Qb = C.ws<bf16>(WS_Q), *Kb = C.ws<bf16>(WS_K), *Vb = C.ws<bf16>(WS_V), *GA = C.ws<bf16>(WS_GA), *U = C.ws<bf16>(WS_U), *VN = C.ws<bf16>(WS_VN), *GB = C.ws<bf16>(WS_GB),
         *GC = C.ws<bf16>(WS_GC), *QD = C.ws<bf16>(WS_QD), *KD = C.ws<bf16>(WS_KD), *VD = C.ws<bf16>(WS_VD), *GD = C.ws<bf16>(WS_GD);
    float *GLU = C.ws<float>(WS_GLU), *LF = C.ws<float>(WS_LF); float* out = A.out;
    const f32x4 sg_g = ld4(A.in[I_SGG] + l * 256 + c4), sg_b = ld4(A.in[I_SGB] + l * 256 + c4);
    f32x4 lb = (f32x4){0.f, 0.f, 0.f, 0.f}; if (l == 1) lb = ld4(scal + 64 + c4);
    const float sgn = (lane & 4) ? 1.f : -1.f;
    for (int m = C.gw(); m < MT; m += C.ngw()) {
        const float* z = Z + (size_t)m * DIN; const size_t mo = (size_t)m * 256 + c4;
        const bool samp = m >= MP; const int r = m - MP;
        const int pos = samp ? PAST + (r & 7) : (m & (TSEQ - 1));
        float *ok, *ov;
        if (!samp) { const size_t o = ((size_t)l * MP + m) * 256 + c4; ok = out + O_KP + o; ov = out + O_VP + o; }
        else { const size_t o = ((size_t)l * MS + r) * 256 + c4; ok = out + O_KS + o; ov = out + O_VS + o; }
        const f32x4 cs0 = *(const f32x4*)(CS + pos * 16 + 4 * (lane & 3)), cs1 = *(const f32x4*)(CS + pos * 16 + 4 * (lane & 3) + 2);
        const f32x4 cosv = (f32x4){cs0.x, cs0.z, cs1.x, cs1.z}, sinv = (f32x4){cs0.y, cs0.w, cs1.y, cs1.w};
        {
            const f32x4 v = ld4(z + c4); f32x4 p; p.x = __builtin_bit_cast(float, __builtin_amdgcn_ds_swizzle(__builtin_bit_cast(int, v.x), (4 << 10) | 0x1f)); p.y = __builtin_bit_cast(float, __builtin_amdgcn_ds_swizzle(__builtin_bit_cast(int, v.y), (4 << 10) | 0x1f)); p.z = __builtin_bit_cast(float, __builtin_amdgcn_ds_swizzle(__builtin_bit_cast(int, v.z), (4 << 10) | 0x1f)); p.w = __builtin_bit_cast(float, __builtin_amdgcn_ds_swizzle(__builtin_bit_cast(int, v.w), (4 << 10) | 0x1f));
            const f32x4 o = v * cosv + (p * sinv) * sgn; st_bf4(Qb + mo, o * QSCALE);
        }
        {
            const f32x4 v = ld4(z + 256 + c4); f32x4 p; p.x = __builtin_bit_cast(float, __builtin_amdgcn_ds_swizzle(__builtin_bit_cast(int, v.x), (4 << 10) | 0x1f)); p.y = __builtin_bit_cast(float, __builtin_amdgcn_ds_swizzle(__builtin_bit_cast(int, v.y), (4 << 10) | 0x1f)); p.z = __builtin_bit_cast(float, __builtin_amdgcn_ds_swizzle(__builtin_bit_cast(int, v.z), (4 << 10) | 0x1f)); p.w = __builtin_bit_cast(float, __builtin_amdgcn_ds_swizzle(__builtin_bit_cast(int, v.w), (4 << 10) | 0x1f));
            const f32x4 o = v * cosv + (p * sinv) * sgn;
            if (!samp) { const int t = m & (TSEQ - 1), bh = (m >> 13) * 4 + (lane >> 4);
                st_bf4((bf16*)(C.ws<unsigned char>(WS_KT) + ((size_t)(bh * 128 + (t >> 6)) * 8192 + ((lane & 15) >> 1) * 1024 + (t & 63) * 16 + (lane & 1) * 8)), o); }
        }
        { const f32x4 v = ld4(z + 512 + c4);
            if (!samp) { const int t = m & (TSEQ - 1), bh = (m >> 13) * 4 + (lane >> 4), row = t & 63;
                st_bf4((bf16*)(C.ws<unsigned char>(WS_VT) + ((size_t)(bh * 128 + (t >> 6)) * 8192 + ((((lane & 15) >> 3) * 4 + (row >> 4)) * 1024) + (row & 15) * 64 + (lane & 7) * 8)), v); } }
        { const f32x4 v = ld4(z + 768 + c4); st_bf4(GA + mo, (f32x4){silu_f(v.x), silu_f(v.y), silu_f(v.z), silu_f(v.w)}); }
        { const f32x4 v = ld4(z + 1024 + c4); st_bf4(U + mo, (f32x4){gelu_f(v.x), gelu_f(v.y), gelu_f(v.z), gelu_f(v.w)}); }
        { const f32x4 v = ld4(z + 1280 + c4); st_bf4(VN + mo, (f32x4){gelu_f(v.x), gelu_f(v.y), gelu_f(v.z), gelu_f(v.w)}); }
        { const f32x4 v = ld4(z + 1536 + c4); st_bf4(GB + mo, (f32x4){silu_f(v.x), silu_f(v.y), silu_f(v.z), silu_f(v.w)}); }
        {
            const f32x4 a = ld4(z + 1792 + (c4 >> 7) * 256 + (c4 & 127)), g = ld4(z + 1792 + (c4 >> 7) * 256 + 128 + (c4 & 127));
            const f32x4 glu = (f32x4){a.x * sigmoid_f(g.x), a.y * sigmoid_f(g.y), a.z * sigmoid_f(g.z), a.w * sigmoid_f(g.w)};
            st4(GLU + mo, glu);
        }
        { const f32x4 v = ld4(z + 2304 + c4); st_bf4(GC + mo, (f32x4){silu_f(v.x), silu_f(v.y), silu_f(v.z), silu_f(v.w)}); }
        { const f32x4 v = ld4(z + 2560 + c4); st_bf4(QD + mo, (f32x4){silu_f(v.x), silu_f(v.y), silu_f(v.z), silu_f(v.w)}); }
        {
            const f32x4 v = ld4(z + 2816 + c4); f32x4 f, lf;
            f.x = lb.x + (1.f - lb.x) * sigmoid_f(v.x); f.y = lb.y + (1.f - lb.y) * sigmoid_f(v.y); f.z = lb.z + (1.f - lb.z) * sigmoid_f(v.z); f.w = lb.w + (1.f - lb.w) * sigmoid_f(v.w);
            lf.x = __logf(fmaxf(f.x, 1e-30f)); lf.y = __logf(fmaxf(f.y, 1e-30f)); lf.z = __logf(fmaxf(f.z, 1e-30f)); lf.w = __logf(fmaxf(f.w, 1e-30f));
            st4(LF + mo, lf); st_bf4(KD + mo, 1.f - f);
        }
        { const f32x4 v = ld4(z + 3072 + c4); st_bf4(VD + mo, v); }
        { const f32x4 v = ld4(z + 3328 + c4); st_bf4(GD + mo, (f32x4){silu_f(v.x), silu_f(v.y), silu_f(v.z), silu_f(v.w)}); }
    }
}

#endif

__device__ __forceinline__ void sg_unit(const Ctx& C, int l, int u) {
    const CAS Args& A = *C.a; const bf16 *U = C.ws<bf16>(WS_U), *VN = C.ws<bf16>(WS_VN), *GB = C.ws<bf16>(WS_GB); bf16* MIX = C.ws<bf16>(WS_MIX);
    LAS float* vn = (LAS float*)C.lds;
    const int r0 = (u - 128) * 8; const size_t m0 = (size_t)MP + r0;
    {   const int i = C.wave; const f32x4 gam = ld4(A.in[I_SGG] + l * 256 + 4 * C.lane), bet = ld4(A.in[I_SGB] + l * 256 + 4 * C.lane);
        const f32x4 v = ld_bf4(VN + (m0 + i) * 256 + 4 * C.lane);
        const float mean = wave_sum((v.x + v.y) + (v.z + v.w)) * (1.f / 256.f); const f32x4 d = v - mean;
        const float var = wave_sum((d.x * d.x + d.y * d.y) + (d.z * d.z + d.w * d.w)) * (1.f / 256.f);
        const f32x4 y = d * rsqrtf(var + EPS) * gam + bet;
        *(LAS f32x4*)(vn + i * 256 + 4 * C.lane) = y; st4(A.out + O_CH + ((size_t)l * MS + r0 + i) * 256 + 4 * C.lane, y); }
    __syncthreads();
    const int col = C.tid & 255, th = C.tid >> 8, g = col >> 6;
    const float* w = A.in[I_WS] + (size_t)(l * 4 + g) * 128 * 128; const float* bs = A.in[I_BS] + (l * 4 + g) * 128;
    f32x4 wv[4][2]; float bsv[4], uu[4], gg[4];
#pragma unroll
    for (int i = 0; i < 4; ++i) { const int t = th * 4 + i; wv[i][0] = ld4(w + t * 128); wv[i][1] = ld4(w + t * 128 + 4); bsv[i] = bs[t];
        const size_t mo = (m0 + t) * 256 + col; uu[i] = bf2f(U[mo]); gg[i] = bf2f(GB[mo]); }
    float vv[8];
#pragma unroll
    for (int s_ = 0; s_ < 8; ++s_) vv[s_] = vn[s_ * 256 + col];
#pragma unroll
    for (int i = 0; i < 4; ++i) { const int t = th * 4 + i; float acc = 0.f;
#pragma unroll
        for (int s_ = 0; s_ < 8; ++s_) { const float wt = s_ < 4 ? wv[i][0][s_] : wv[i][1][s_ - 4]; acc += (s_ <= t) ? wt * vv[s_] : 0.f; }
        MIX[(m0 + t) * DM + 256 + col] = (bf16)f2bf(uu[i] * (acc + bsv[i]) * gg[i]); }
    __syncthreads();
}

__device__ __forceinline__ void conv_unit(const Ctx& C, int l, int u, bf16* MIX) {
    const CAS Args& A = *C.a; const float* GLU = C.ws<float>(WS_GLU); const bf16* GC = C.ws<bf16>(WS_GC);
    LAS float* Ys = (LAS float*)C.lds;
    const int c = C.tid & 255, rh = C.tid >> 8, r0 = u * 16;
    const float* cw = A.in[I_CW] + (size_t)l * 31 * 256 + c; const float cb = A.in[I_CB][l * 256 + c];
    for (int i = 0; i < 8; ++i) {
        const int rr = rh * 8 + i, m = r0 + rr; float y = cb;
        if (m < MP) { const int t = m & (TSEQ - 1);
            for (int j = 0; j < 31; ++j) { const int tt = t + j - 30; if (tt >= 0) y += cw[j * 256] * GLU[(size_t)(m + j - 30) * 256 + c]; }
        } else { const int r = m - MP, bs = r >> 3, ts = r & 7; const float* sc = A.in[I_SCONV] + (size_t)(l * NBS + bs) * 30 * 256 + c;
            for (int j = 0; j < 31; ++j) { const int tt = ts + j - 30; const float h = tt >= 0 ? GLU[(size_t)(m + j - 30) * 256 + c] : sc[(ts + j) * 256]; y += cw[j * 256] * h; }
        }
        Ys[rr * 256 + c] = y;
    }
    __syncthreads();
    {
        const f32x4 g = ld4(A.in[I_CNG] + l * 256 + 4 * C.lane), b = ld4(A.in[I_CNB] + l * 256 + 4 * C.lane);
        for (int i = 0; i < 2; ++i) { const int rr = C.wave * 2 + i; LAS f32x4* p = (LAS f32x4*)(Ys + rr * 256) + C.lane; f32x4 v = *p;
            const float mean = wave_sum((v.x + v.y) + (v.z + v.w)) * (1.f / 256.f); const f32x4 d = v - mean;
            const float var = wave_sum((d.x * d.x + d.y * d.y) + (d.z * d.z + d.w * d.w)) * (1.f / 256.f);
            f32x4 y = d * rsqrtf(var + EPS) * g + b; y = (f32x4){silu_f(y.x), silu_f(y.y), silu_f(y.z), silu_f(y.w)}; *p = y; }
    }
    __syncthreads();
    {
        float acc[8];
#pragma unroll
        for (int i = 0; i < 8; ++i) acc[i] = 0.f;
        const float* wp = A.in[I_WPW] + (size_t)l * 256 * 256 + c;
        for (int k = 0; k < 256; k += 4) {
            const float w0 = wp[(k + 0) * 256], w1 = wp[(k + 1) * 256], w2 = wp[(k + 2) * 256], w3 = wp[(k + 3) * 256];
#pragma unroll
            for (int i = 0; i < 8; ++i) { const f32x4 y = *(const LAS f32x4*)(Ys + (rh * 8 + i) * 256 + k); acc[i] += y.x * w0 + y.y * w1 + y.z * w2 + y.w * w3; }
        }
#pragma unroll
        for (int i = 0; i < 8; ++i) { const int m = r0 + rh * 8 + i; MIX[(size_t)m * DM + 512 + c] = (bf16)f2bf(acc[i] * bf2f(GC[(size_t)m * 256 + c])); }
    }
    __syncthreads();
}

template <int MODE> __device__ __forceinline__ void hgrn_item(const Ctx& C, int l, int item) {
    const CAS Args& A = *C.a; const int lane = C.lane;
    const float* LF = C.ws<float>(WS_LF); const bf16 *QD = C.ws<bf16>(WS_QD), *KD = C.ws<bf16>(WS_KD), *VD = C.ws<bf16>(WS_VD), *GD = C.ws<bf16>(WS_GD); bf16* MIX = C.ws<bf16>(WS_MIX);
    LAS float* Fs = (LAS float*)(C.lds + C.wave * 12288); LAS float* Ks = Fs + 1024; LAS float* Qs = Fs + 2048;
    int h, m0, ntok; size_t sidx;
    if (MODE == 2) { const int bs = item >> 2; h = item & 3; m0 = MP + bs * 8; ntok = 8; sidx = ((size_t)(l * NBS + bs) * 4 + h) * 4096; }
    else { const int bh = item >> 7, j = item & 127; h = bh & 3; m0 = (bh >> 2) * TSEQ + j * HG_L; ntok = HG_L; sidx = (size_t)item * 4096; }
    float S[64];
    if (MODE == 0) {
#pragma unroll
        for (int k = 0; k < 64; ++k) S[k] = 0.f;
    } else { const float* s0 = MODE == 2 ? A.in[I_SHGRN] + sidx : C.ws<float>(WS_SST) + sidx;
#pragma unroll
        for (int k = 0; k < 64; ++k) S[k] = s0[k * 64 + lane]; }
    const float gn = A.in[I_HNG][l * 64 + lane];
    float lfsum = 0.f;
    for (int c0 = 0; c0 < ntok; c0 += 16) {
        const int nt = (ntok - c0) < 16 ? (ntok - c0) : 16;
        for (int tt = 0; tt < nt; ++tt) { const size_t o = (size_t)(m0 + c0 + tt) * 256 + h * 64 + lane; const float lf = LF[o]; lfsum += lf;
            Fs[tt * 64 + lane] = __expf(lf); Ks[tt * 64 + lane] = bf2f(KD[o]); if (MODE != 0) Qs[tt * 64 + lane] = bf2f(QD[o]); }
        LDS_WAIT();
#pragma unroll 1
        for (int tt = 0; tt < nt; ++tt) {
            const int m = m0 + c0 + tt; const size_t o = (size_t)m * 256 + h * 64 + lane;
            const float vd = bf2f(VD[o]); float oacc = 0.f;
#pragma unroll
            for (int k4 = 0; k4 < 16; ++k4) {
                const f32x4 f = *(const LAS f32x4*)(Fs + tt * 64 + 4 * k4), kd = *(const LAS f32x4*)(Ks + tt * 64 + 4 * k4);
                S[4 * k4 + 0] = f.x * S[4 * k4 + 0] + kd.x * vd; S[4 * k4 + 1] = f.y * S[4 * k4 + 1] + kd.y * vd;
                S[4 * k4 + 2] = f.z * S[4 * k4 + 2] + kd.z * vd; S[4 * k4 + 3] = f.w * S[4 * k4 + 3] + kd.w * vd;
                if (MODE != 0) { const f32x4 q = *(const LAS f32x4*)(Qs + tt * 64 + 4 * k4);
                    oacc += S[4 * k4 + 0] * q.x + S[4 * k4 + 1] * q.y + S[4 * k4 + 2] * q.z + S[4 * k4 + 3] * q.w; }
            }
            if (MODE != 0) { const float ss = wave_sum(oacc * oacc) * (1.f / 64.f);
                const float on = oacc * rsqrtf(ss + EPS) * gn * bf2f(GD[o]);
                MIX[(size_t)m * DM + 768 + h * 64 + lane] = (bf16)f2bf(on); }
        }
        LDS_WAIT();
    }
    if (MODE == 0) { float* sl = C.ws<float>(WS_SLOC) + sidx;
#pragma unroll
        for (int k = 0; k < 64; ++k) sl[k * 64 + lane] = S[k];
        C.ws<float>(WS_DTOT)[(size_t)item * 64 + lane] = __expf(lfsum); }
    if (MODE == 2) { float* so = A.out + O_HS + sidx;
#pragma unroll
        for (int k = 0; k < 64; ++k) so[k * 64 + lane] = S[k]; }
}
__device__ __forceinline__ void hgrn_scan_unit(const Ctx& C, int l, int u) {
    const int seg = C.tid >> 6, kvl = C.tid & 63, bh = u >> 6, kv = (u & 63) * 64 + kvl, k = kv >> 6;
    const float* sl = C.ws<float>(WS_SLOC) + ((size_t)bh * HG_NB + seg * 16) * 4096 + kv; float* ss = C.ws<float>(WS_SST) + ((size_t)bh * HG_NB + seg * 16) * 4096 + kv;
    const float* dt = C.ws<float>(WS_DTOT) + ((size_t)bh * HG_NB + seg * 16) * 64 + k;
    LAS f32x2v* X = (LAS f32x2v*)C.lds;
    float a[16], d[16];
#pragma unroll
    for (int j = 0; j < 16; ++j) { a[j] = sl[(size_t)j * 4096]; d[j] = dt[j * 64]; }
    float D = 1.f, Acc = 0.f;
#pragma unroll
    for (int j = 0; j < 16; ++j) { Acc = d[j] * Acc + a[j]; D *= d[j]; }
    X[seg * 64 + kvl] = (f32x2v){D, Acc};
    __syncthreads();
    float S = 0.f;
    for (int q = 0; q < seg; ++q) { const f32x2v x = X[q * 64 + kvl]; S = x.x * S + x.y; }
#pragma unroll
    for (int j = 0; j < 16; ++j) { ss[(size_t)j * 4096] = S; S = d[j] * S + a[j]; }
    if (seg == 7) C.a->out[O_HP + ((size_t)l * 8 + bh) * 4096 + kv] = S;
    __syncthreads();
}

__device__ __forceinline__ void attn_unit_naive(const Ctx& C, int l, int u) {
    const CAS Args& A = *C.a; const bf16 *Qb = C.ws<bf16>(WS_Q), *Kb = C.ws<bf16>(WS_KR), *Vb = C.ws<bf16>(WS_VR), *GA = C.ws<bf16>(WS_GA); bf16* MIX = C.ws<bf16>(WS_MIX);
    const int bh = u & 7, qb = 31 - (u >> 3), b = bh >> 2, h = bh & 3;
    const int map = C.tid >> 8, qi = C.tid & 255, t = qb * 256 + qi; const size_t m = (size_t)b * TSEQ + t;
    LAS unsigned* Ksm = (LAS unsigned*)C.lds;
    LAS unsigned* Vsm = (LAS unsigned*)(C.lds + 32768);
    LAS float* O2 = (LAS float*)C.lds;
    float q[32], acc[64];
    { const v4u* qp = (const v4u*)(Qb + m * 256 + h * 64 + map * 32);
#pragma unroll
        for (int i = 0; i < 4; ++i) { const v4u w = qp[i]; q[8 * i] = bflo(w.x); q[8 * i + 1] = bfhi(w.x); q[8 * i + 2] = bflo(w.y); q[8 * i + 3] = bfhi(w.y); q[8 * i + 4] = bflo(w.z); q[8 * i + 5] = bfhi(w.z); q[8 * i + 6] = bflo(w.w); q[8 * i + 7] = bfhi(w.w); } }
#pragma unroll
    for (int d = 0; d < 64; ++d) acc[d] = 0.f;
    float mx = -1e30f, lsum = 0.f;
    for (int kt = 0; kt <= qb; ++kt) {
        __syncthreads();
        for (int p = C.tid; p < 4096; p += NTHR) { const int arr = p >> 11, row = (p >> 3) & 255, pc = p & 7;
            const bf16* src = (arr ? Vb : Kb) + ((size_t)b * TSEQ + kt * 256 + row) * 256 + h * 64 + pc * 8;
            *(LAS v4u*)((arr ? Vsm : Ksm) + row * 32 + pc * 4) = *(const v4u*)src; }
        __syncthreads();
        const int jn = (kt == qb) ? 256 : 256;
#pragma unroll 1
        for (int j = 0; j < jn; ++j) {
            if (kt * 256 + j > t) break;
            const LAS v4u* kp = (const LAS v4u*)(Ksm + j * 32 + map * 16);
            float s = 0.f;
#pragma unroll
            for (int i = 0; i < 4; ++i) { const v4u w = kp[i];
                s += q[8 * i] * bflo(w.x) + q[8 * i + 1] * bfhi(w.x) + q[8 * i + 2] * bflo(w.y) + q[8 * i + 3] * bfhi(w.y) + q[8 * i + 4] * bflo(w.z) + q[8 * i + 5] * bfhi(w.z) + q[8 * i + 6] * bflo(w.w) + q[8 * i + 7] * bfhi(w.w); }
            if (s > mx) { const float sc = exp2f(mx - s); lsum *= sc;
#pragma unroll
                for (int d = 0; d < 64; ++d) acc[d] *= sc;
                mx = s; }
            const float p = exp2f(s - mx); lsum += p;
            const LAS v4u* vp = (const LAS v4u*)(Vsm + j * 32);
#pragma unroll
            for (int i = 0; i < 8; ++i) { const v4u w = vp[i];
                acc[8 * i] += p * bflo(w.x); acc[8 * i + 1] += p * bfhi(w.x); acc[8 * i + 2] += p * bflo(w.y); acc[8 * i + 3] += p * bfhi(w.y);
                acc[8 * i + 4] += p * bflo(w.z); acc[8 * i + 5] += p * bfhi(w.z); acc[8 * i + 6] += p * bflo(w.w); acc[8 * i + 7] += p * bfhi(w.w); }
        }
    }
    __syncthreads();
    const float il = 1.f / lsum;
    if (map == 1) {
#pragma unroll
        for (int d = 0; d < 64; ++d) O2[qi * 65 + d] = acc[d] * il;
    }
    __syncthreads();
    if (map == 0) {
        const float lam = C.ws<float>(WS_SCAL)[l]; const float lam_init = l == 0 ? 0.2f : 0.35550906759096934f;
        float ss = 0.f;
#pragma unroll
        for (int d = 0; d < 64; ++d) { acc[d] = acc[d] * il - lam * O2[qi * 65 + d]; ss += acc[d] * acc[d]; }
        const float rs = rsqrtf(ss * (1.f / 64.f) + EPS) * (1.f - lam_init);
        const float* g = A.in[I_ANG] + l * 64;
#pragma unroll
        for (int d = 0; d < 64; d += 2) { const unsigned ga = *(const unsigned*)(GA + m * 256 + h * 64 + d);
            *(unsigned*)(MIX + m * DM + h * 64 + d) = pk2(acc[d] * rs * g[d] * bflo(ga), acc[d + 1] * rs * g[d + 1] * bfhi(ga)); }
    }
    __syncthreads();
}

namespace fa {
typedef float f32x16 __attribute__((ext_vector_type(16)));
typedef short bf16x8 __attribute__((ext_vector_type(8)));
typedef short s16x4 __attribute__((ext_vector_type(4)));
typedef short v4i16_t __attribute__((ext_vector_type(4)));
typedef float f32x2_t __attribute__((ext_vector_type(2))); typedef __bf16 bf16x2_t __attribute__((ext_vector_type(2)));
constexpr int SLOT = 16384;
constexpr int LDS_WSF = 65536;
constexpr int LDS_EX = 65536 + 4096;
constexpr float THR = 32.f;
__device__ __forceinline__ float max3f(float a, float b, float c) { return __builtin_fmaxf(__builtin_fmaxf(a, b), c); }
__device__ __forceinline__ unsigned cvtpk(float lo, float hi) { f32x2_t v = {lo, hi}; bf16x2_t b = __builtin_convertvector(v, bf16x2_t); return __builtin_bit_cast(unsigned, b); }
__device__ __forceinline__ float half_swap_max(float m) { auto rr = __builtin_amdgcn_permlane32_swap(__float_as_uint(m), __float_as_uint(m), false, false); return __builtin_fmaxf(__uint_as_float(rr[0]), __uint_as_float(rr[1])); }
__device__ __forceinline__ float half_swap_sum(float m) { auto rr = __builtin_amdgcn_permlane32_swap(__float_as_uint(m), __float_as_uint(m), false, false); return __uint_as_float(rr[0]) + __uint_as_float(rr[1]); }
__device__ __forceinline__ float rowmax(const f32x16& p0, const f32x16& p1) {
    float a = max3f(p0[0], p0[1], p1[0]), b = max3f(p0[2], p0[3], p1[1]); a = max3f(a, p1[2], p1[3]);
#pragma unroll
    for (int r = 4; r < 16; r += 4) { a = max3f(a, p0[r], p0[r + 1]); b = max3f(b, p0[r + 2], p0[r + 3]); a = max3f(a, p1[r], p1[r + 1]); b = max3f(b, p1[r + 2], p1[r + 3]); }
    return half_swap_max(__builtin_fmaxf(a, b));
}
__device__ __forceinline__ s16x4 vtr(const LAS unsigned char* p) { return __builtin_bit_cast(s16x4, __builtin_amdgcn_ds_read_tr16_b64_v4i16((LAS v4i16_t*)p)); }
__device__ __forceinline__ void softmax_step(const bool FIRST, f32x16& S0, f32x16& S1, float& m, float& lsum, f32x16 (&O)[2], LAS float* wsf, int r32, int hi, bf16x8 (&pk)[4]) {
    const float rm = rowmax(S0, S1);
    if (FIRST) m = (rm != -INFINITY && fabsf(rm) > THR) ? rm : 0.f;
    else if (__any(rm - m > THR)) {
        const float mn = __builtin_fmaxf(m, rm); const float f = __builtin_amdgcn_exp2f(m - mn); m = mn; lsum *= f;
        if (hi == 0) wsf[r32] = f;
        LDS_WAIT();
#pragma unroll
        for (int g = 0; g < 4; ++g) { const f32x4 fv = *(const LAS f32x4*)(wsf + 8 * g + 4 * hi);
#pragma unroll
            for (int j = 0; j < 4; ++j) { O[0][4 * g + j] *= fv[j]; O[1][4 * g + j] *= fv[j]; } }
        LDS_WAIT();
    }
    float s = 0.f;
    if (__all(m == 0.f)) {
#pragma unroll
        for (int r = 0; r < 16; ++r) { S0[r] = __builtin_amdgcn_exp2f(S0[r]); S1[r] = __builtin_amdgcn_exp2f(S1[r]); s += S0[r] + S1[r]; }
    } else {
#pragma unroll
        for (int r = 0; r < 16; ++r) { S0[r] = __builtin_amdgcn_exp2f(S0[r] - m); S1[r] = __builtin_amdgcn_exp2f(S1[r] - m); s += S0[r] + S1[r]; }
    }
    lsum += s;
    v4u w;
    w.x = cvtpk(S0[0], S0[1]); w.y = cvtpk(S0[2], S0[3]); w.z = cvtpk(S0[4], S0[5]); w.w = cvtpk(S0[6], S0[7]); pk[0] = __builtin_bit_cast(bf16x8, w);
    w.x = cvtpk(S0[8], S0[9]); w.y = cvtpk(S0[10], S0[11]); w.z = cvtpk(S0[12], S0[13]); w.w = cvtpk(S0[14], S0[15]); pk[1] = __builtin_bit_cast(bf16x8, w);
    w.x = cvtpk(S1[0], S1[1]); w.y = cvtpk(S1[2], S1[3]); w.z = cvtpk(S1[4], S1[5]); w.w = cvtpk(S1[6], S1[7]); pk[2] = __builtin_bit_cast(bf16x8, w);
    w.x = cvtpk(S1[8], S1[9]); w.y = cvtpk(S1[10], S1[11]); w.z = cvtpk(S1[12], S1[13]); w.w = cvtpk(S1[14], S1[15]); pk[3] = __builtin_bit_cast(bf16x8, w);
}
__device__ __forceinline__ void cmask(f32x16& p0, f32x16& p1, int krel0, int qrel, int hi) {
    asm volatile("" : "+v"(hi), "+v"(qrel));
#pragma unroll
    for (int r = 0; r < 16; ++r) { const int kv = krel0 + 4 * hi + (r & 3) + 8 * (r >> 2); if (kv > qrel) p0[r] = -INFINITY; if (kv + 32 > qrel) p1[r] = -INFINITY; }
}
#define FA_MFMA(a, b, c) __builtin_amdgcn_mfma_f32_32x32x16_bf16((a), (b), (c), 0, 0, 0)
__device__ __forceinline__ void tile_step(const bool FIRST, const LAS unsigned char* slot, const bf16x8 (&qr)[4], bool band, int krel0, int qrel, int r32, int hi, int lane,
        float& m_a, float& l_a, f32x16 (&Oa)[2], float& m_b, float& l_b, f32x16 (&Ob)[2], LAS float* wsf, const bf16* Kg, const bf16* Vg) {
#if MK_CHECK == 2
    const bf16* kp = Kg + (size_t)r32 * 256 + hi * 8;
#define KFR(off) (*(const bf16x8*)(kp + ((off) >> 10 >> 1) * 16 + (((off) >> 9) & 1) * 32 * 256))
#else
    const LAS unsigned char* kp = slot + hi * 1024 + r32 * 16;
#define KFR(off) (*(const LAS bf16x8*)(kp + (off)))
#endif
    bf16x8 pa[4], pb[4];
    {   f32x16 S0, S1;
        const bf16x8 k00 = KFR(0), k01 = KFR(512), k10 = KFR(2048), k11 = KFR(2048 + 512);
        S0 = FA_MFMA(k00, qr[0], (f32x16{})); S1 = FA_MFMA(k01, qr[0], (f32x16{})); S0 = FA_MFMA(k10, qr[1], S0); S1 = FA_MFMA(k11, qr[1], S1);
        if (band) cmask(S0, S1, krel0, qrel, hi);
        softmax_step(FIRST, S0, S1, m_a, l_a, Oa, wsf, r32, hi, pa);
    }
    asm volatile("" ::: "memory");
    {   f32x16 S0, S1;
        const bf16x8 k00 = KFR(4096), k01 = KFR(4096 + 512), k10 = KFR(6144), k11 = KFR(6144 + 512);
        S0 = FA_MFMA(k00, qr[2], (f32x16{})); S1 = FA_MFMA(k01, qr[2], (f32x16{})); S0 = FA_MFMA(k10, qr[3], S0); S1 = FA_MFMA(k11, qr[3], S1);
        if (band) cmask(S0, S1, krel0, qrel, hi);
        softmax_step(FIRST, S0, S1, m_b, l_b, Ob, wsf + 64, r32, hi, pb);
    }
    asm volatile("" ::: "memory");
    const LAS unsigned char* vp = slot + 8192 + ((lane >> 4) & 1) * 32 + (lane & 3) * 8 + (4 * hi + ((lane & 15) >> 2)) * 64;
#pragma unroll
    for (int d0 = 0; d0 < 2; ++d0)
#pragma unroll
        for (int ks = 0; ks < 4; ++ks) {
#if MK_CHECK == 2
            bf16x8 vf;
#pragma unroll
            for (int j = 0; j < 8; ++j) vf[j] = (short)Vg[(size_t)(16 * ks + 8 * (j >> 2) + 4 * hi + (j & 3)) * 256 + 32 * d0 + r32];
#else
            const s16x4 lo = vtr(vp + d0 * 4096 + ks * 1024), hh = vtr(vp + d0 * 4096 + ks * 1024 + 512);
            const bf16x8 vf = (bf16x8){lo[0], lo[1], lo[2], lo[3], hh[0], hh[1], hh[2], hh[3]};
#endif
            Oa[d0] = FA_MFMA(pa[ks], vf, Oa[d0]); Ob[d0] = FA_MFMA(pb[ks], vf, Ob[d0]);
            if (ks == 3) asm volatile("" ::: "memory");
        }
#undef KFR
}
#define FA_WAITBAR() do { asm volatile("s_waitcnt vmcnt(0) lgkmcnt(0)" ::: "memory"); __builtin_amdgcn_s_barrier(); asm volatile("" ::: "memory"); } while (0)

__device__ __forceinline__ void unit(const Ctx& C, int l, int bh, int y, bf16* MIX) {
    int lane = C.lane; asm volatile("" : "+v"(lane));
    const int wid = C.wave, r32 = lane & 31, hi = lane >> 5, half = wid >> 2, wq = wid & 3;
    const int b = bh >> 2, h = bh & 3; const int q0 = 128 * y, qrel = 32 * wq + r32;
    const size_t rowbase = (size_t)b * TSEQ;
    const bf16* Qw = C.ws<bf16>(WS_Q) + (rowbase + q0 + qrel) * 256 + h * 64;
    const unsigned char* KT = C.ws<unsigned char>(WS_KT) + (size_t)bh * 128 * 8192 + wid * 1024 + lane * 16;
    const unsigned char* VT = C.ws<unsigned char>(WS_VT) + (size_t)bh * 128 * 8192 + wid * 1024 + lane * 16;
    LAS unsigned char* lds = C.lds; LAS float* wsf = (LAS float*)(lds + LDS_WSF) + wid * 128;
    bf16x8 qr[4];
#pragma unroll
    for (int d0 = 0; d0 < 4; ++d0) qr[d0] = *(const bf16x8*)(Qw + d0 * 16 + hi * 8);
    const int nsteps = y + 1;
#define FA_DMA(i) do { _Pragma("unroll") for (int hf_ = 0; hf_ < 2; ++hf_) { const int t_ = 2 * (i) + hf_; LAS unsigned char* d_ = lds + ((((i) & 1) * 2 + hf_) * SLOT) + wid * 1024; \
        __builtin_amdgcn_global_load_lds((const unsigned*)(KT + (size_t)t_ * 8192), (LAS unsigned*)d_, 16, 0, 0); \
        __builtin_amdgcn_global_load_lds((const unsigned*)(VT + (size_t)t_ * 8192), (LAS unsigned*)(d_ + 8192), 16, 0, 0); } } while (0)
    float m_a = 0.f, l_a = 0.f, m_b = 0.f, l_b = 0.f; f32x16 Oa[2], Ob[2];
    Oa[0] = f32x16{}; Oa[1] = f32x16{}; Ob[0] = f32x16{}; Ob[1] = f32x16{};
    FA_DMA(0);
    FA_WAITBAR();
#pragma unroll 1
    for (int i = 0; i < nsteps; ++i) {
        if (i + 1 < nsteps) FA_DMA(i + 1);
        const int t = 2 * i + half; const bool band = t >= 2 * y;
        tile_step(i == 0, lds + ((i & 1) * 2 + half) * SLOT, qr, band, 64 * (t - 2 * y), qrel, r32, hi, lane, m_a, l_a, Oa, m_b, l_b, Ob, wsf,
                  C.ws<bf16>(WS_KR) + (rowbase + (size_t)t * 64) * 256 + h * 64, C.ws<bf16>(WS_VR) + (rowbase + (size_t)t * 64) * 256 + h * 64);
        FA_WAITBAR();
    }
    l_a = half_swap_sum(l_a); l_b = half_swap_sum(l_b);
    LAS f32x4* EX = (LAS f32x4*)(lds + LDS_EX);
    if (hi == 0) EX[wid * 32 + r32] = (f32x4){m_a, l_a, m_b, l_b};
    FA_WAITBAR();
    {   const f32x4 o = EX[(wid ^ 4) * 32 + r32];
        const float lam = C.ws<float>(WS_SCAL)[l];
        const float Ma = __builtin_fmaxf(m_a, o.x), fa_ = __builtin_amdgcn_exp2f(m_a - Ma), fa2 = __builtin_amdgcn_exp2f(o.x - Ma); const float ca = fa_ / (l_a * fa_ + o.y * fa2);
        const float Mb = __builtin_fmaxf(m_b, o.z), fb_ = __builtin_amdgcn_exp2f(m_b - Mb), fb2 = __builtin_amdgcn_exp2f(o.z - Mb); const float cb = -lam * fb_ / (l_b * fb_ + o.w * fb2);
        if (hi == 0) { wsf[r32] = ca; wsf[64 + r32] = cb; }
        LDS_WAIT();
    }
    f32x16 part[2];
#pragma unroll
    for (int g = 0; g < 4; ++g) { const f32x4 fa4 = *(const LAS f32x4*)(wsf + 8 * g + 4 * hi), fb4 = *(const LAS f32x4*)(wsf + 64 + 8 * g + 4 * hi);
#pragma unroll
        for (int j = 0; j < 4; ++j) { part[0][4 * g + j] = Oa[0][4 * g + j] * fa4[j] + Ob[0][4 * g + j] * fb4[j]; part[1][4 * g + j] = Oa[1][4 * g + j] * fa4[j] + Ob[1][4 * g + j] * fb4[j]; } }
    LAS float* XO = (LAS float*)lds + wq * 2048;
    if (half == 1) {
#pragma unroll
        for (int r = 0; r < 16; ++r) { XO[r * 64 + lane] = part[0][r]; XO[(16 + r) * 64 + lane] = part[1][r]; }
    }
    FA_WAITBAR();
    if (half == 0) {
        const float lam_init = l == 0 ? 0.2f : 0.35550906759096934f;
        float ss[16];
#pragma unroll
        for (int r = 0; r < 16; ++r) { part[0][r] += XO[r * 64 + lane]; part[1][r] += XO[(16 + r) * 64 + lane]; ss[r] = part[0][r] * part[0][r] + part[1][r] * part[1][r]; }
#pragma unroll
        for (int r = 0; r < 16; ++r) { ss[r] = sx_sum<1>(ss[r]); ss[r] = sx_sum<2>(ss[r]); ss[r] = sx_sum<4>(ss[r]); ss[r] = sx_sum<8>(ss[r]); ss[r] = sx_sum<16>(ss[r]); }
        const float* g = C.a->in[I_ANG] + l * 64; const float g0 = g[r32], g1 = g[32 + r32];
        const bf16* GA = C.ws<bf16>(WS_GA);
#pragma unroll
        for (int r = 0; r < 16; ++r) { const size_t row = rowbase + q0 + 32 * wq + (r & 3) + 8 * (r >> 2) + 4 * hi;
            const float rs = rsqrtf(ss[r] * (1.f / 64.f) + EPS) * (1.f - lam_init);
            MIX[row * DM + h * 64 + r32] = (bf16)f2bf(part[0][r] * rs * g0 * bf2f(GA[row * 256 + h * 64 + r32]));
            MIX[row * DM + h * 64 + 32 + r32] = (bf16)f2bf(part[1][r] * rs * g1 * bf2f(GA[row * 256 + h * 64 + 32 + r32])); }
    }
    FA_WAITBAR();
#undef FA_DMA
}
}

namespace sgm {
using fa::f32x16; using fa::bf16x8;
constexpr int VT_STRIDE = 272;
__device__ __forceinline__ void unit(const Ctx& C, int l, int chunk, bf16* MIX) {
    const CAS Args& A = *C.a;
    int lane = C.lane; asm volatile("" : "+v"(lane));
    const int r32 = lane & 31, hi = lane >> 5, wid = C.wave, g = wid >> 1, th = wid & 1, tid = wid * 64 + lane;
    const bf16 *U = C.ws<bf16>(WS_U), *VN = C.ws<bf16>(WS_VN), *GB = C.ws<bf16>(WS_GB);
    const size_t m0 = (size_t)chunk * 128;
    LAS unsigned char* VT = C.lds;
    {
        const f32x4 gam = ld4(A.in[I_SGG] + l * 256 + 4 * lane), bet = ld4(A.in[I_SGB] + l * 256 + 4 * lane);
        v2u raw[16];
#pragma unroll
        for (int i = 0; i < 16; ++i) raw[i] = *(const v2u*)(VN + (m0 + wid * 16 + i) * 256 + 4 * lane);
#pragma unroll
        for (int i = 0; i < 16; ++i) { const int s_ = wid * 16 + i; const f32x4 v = (f32x4){bflo(raw[i].x), bfhi(raw[i].x), bflo(raw[i].y), bfhi(raw[i].y)};
            const float mean = wave_sum((v.x + v.y) + (v.z + v.w)) * (1.f / 256.f); const f32x4 d = v - mean;
            const float var = wave_sum((d.x * d.x + d.y * d.y) + (d.z * d.z + d.w * d.w)) * (1.f / 256.f);
            const f32x4 y = d * rsqrtf(var + EPS) * gam + bet;
            LAS unsigned char* p = VT + (4 * lane) * VT_STRIDE + s_ * 2;
            *(LAS unsigned short*)(p) = (unsigned short)f2bf(y.x); *(LAS unsigned short*)(p + VT_STRIDE) = (unsigned short)f2bf(y.y);
            *(LAS unsigned short*)(p + 2 * VT_STRIDE) = (unsigned short)f2bf(y.z); *(LAS unsigned short*)(p + 3 * VT_STRIDE) = (unsigned short)f2bf(y.w); }
    }
    __syncthreads();
    const bf16* Wm = C.ws<bf16>(WS_WSB) + (size_t)(l * 4 + g) * 128 * 128;
    f32x16 acc[2][2];
#pragma unroll
    for (int a = 0; a < 2; ++a) { acc[a][0] = f32x16{}; acc[a][1] = f32x16{}; }
#pragma unroll
    for (int tbi = 0; tbi < 2; ++tbi) {
        const int tb = 2 * th + tbi; const bf16* wrow = Wm + (size_t)(tb * 32 + r32) * 128 + 8 * hi;
        const LAS unsigned char* vb = VT + (g * 64 + r32) * VT_STRIDE + 16 * hi;
        bf16x8 af[8];
#pragma unroll
        for (int ks = 0; ks < 8; ++ks) af[ks] = *(const bf16x8*)(wrow + 16 * ks);
#pragma unroll
        for (int ks = 0; ks < 8; ++ks) { if (ks < 2 * (tb + 1)) {
            const bf16x8 b0 = *(const LAS bf16x8*)(vb + 32 * ks), b1 = *(const LAS bf16x8*)(vb + 32 * VT_STRIDE + 32 * ks);
            acc[tbi][0] = FA_MFMA(af[ks], b0, acc[tbi][0]); acc[tbi][1] = FA_MFMA(af[ks], b1, acc[tbi][1]); } }
    }
    const float* bsv = A.in[I_BS] + (l * 4 + g) * 128;
#pragma unroll
    for (int tbi = 0; tbi < 2; ++tbi)
#pragma unroll
        for (int r = 0; r < 16; ++r) { const int t = (2 * th + tbi) * 32 + (r & 3) + 8 * (r >> 2) + 4 * hi; const float bias = bsv[t];
#pragma unroll
            for (int d0 = 0; d0 < 2; ++d0) { const int col = g * 64 + 32 * d0 + r32; const size_t mo = (m0 + t) * 256 + col;
                MIX[(m0 + t) * DM + 256 + col] = (bf16)f2bf(bf2f(U[mo]) * (acc[tbi][d0][r] + bias) * bf2f(GB[mo])); } }
    __syncthreads();
}
}

namespace cvm {
using fa::f32x16; using fa::bf16x8;
constexpr int Y_OFF = 0, YN_OFF = 65536, YN_STRIDE = 528;
__device__ __forceinline__ void unit(const Ctx& C, int l, int u, bf16* MIX) {
    const CAS Args& A = *C.a;
    int lane = C.lane; asm volatile("" : "+v"(lane));
    const int wid = C.wave, tid = wid * 64 + lane, r32 = lane & 31, hi = lane >> 5;
    const float* GLU = C.ws<float>(WS_GLU); const bf16* GC = C.ws<bf16>(WS_GC);
    LAS float* Y = (LAS float*)(C.lds + Y_OFF); LAS unsigned char* YN = C.lds + YN_OFF;
    const int r0 = u * 64; const bool samp = r0 >= MP;
    {
        const int c = tid & 255, half = tid >> 8;
        float cw[31];
#pragma unroll
        for (int j = 0; j < 31; ++j) cw[j] = A.in[I_CW][(size_t)(l * 31 + j) * 256 + c];
        const float cb = A.in[I_CB][l * 256 + c];
        if (!samp) {
            const int rg = half * 32, m = r0 + rg, t0 = m & (TSEQ - 1);
            float in[62];
#pragma unroll
            for (int k = 0; k < 62; ++k) { const int tt = t0 - 30 + k; in[k] = tt >= 0 ? GLU[(size_t)(m - 30 + k) * 256 + c] : 0.f; }
#pragma unroll
            for (int i = 0; i < 32; ++i) { float y = cb;
#pragma unroll
                for (int j = 0; j < 31; ++j) y += cw[j] * in[i + j];
                Y[(rg + i) * 256 + c] = y; }
        } else {
#pragma unroll 1
            for (int gq = 0; gq < 4; ++gq) {
                const int rg = half * 32 + gq * 8, m = r0 + rg;
                float in[38];
                const int bs = (m - MP) >> 3; const float* sc = A.in[I_SCONV] + (size_t)(l * NBS + bs) * 30 * 256 + c;
#pragma unroll
                for (int k = 0; k < 30; ++k) in[k] = sc[k * 256];
#pragma unroll
                for (int k = 0; k < 8; ++k) in[30 + k] = GLU[(size_t)(m + k) * 256 + c];
#pragma unroll
                for (int i = 0; i < 8; ++i) { float y = cb;
#pragma unroll
                    for (int j = 0; j < 31; ++j) y += cw[j] * in[i + j];
                    Y[(rg + i) * 256 + c] = y; }
            }
        }
    }
    __syncthreads();
    {
        const f32x4 g = ld4(A.in[I_CNG] + l * 256 + 4 * lane), b = ld4(A.in[I_CNB] + l * 256 + 4 * lane);
#pragma unroll
        for (int i4 = 0; i4 < 2; ++i4) { f32x4 v[4]; float sm[4], sq[4];
#pragma unroll
            for (int i = 0; i < 4; ++i) { v[i] = *(const LAS f32x4*)(Y + (wid * 8 + i4 * 4 + i) * 256 + 4 * lane); sm[i] = (v[i].x + v[i].y) + (v[i].z + v[i].w); }
#pragma unroll
            for (int i = 0; i < 4; ++i) sm[i] = sx_sum<1>(sm[i]);
#pragma unroll
            for (int i = 0; i < 4; ++i) sm[i] = sx_sum<2>(sm[i]);
#pragma unroll
            for (int i = 0; i < 4; ++i) sm[i] = sx_sum<4>(sm[i]);
#pragma unroll
            for (int i = 0; i < 4; ++i) sm[i] = sx_sum<8>(sm[i]);
#pragma unroll
            for (int i = 0; i < 4; ++i) sm[i] = sx_sum<16>(sm[i]);
#pragma unroll
            for (int i = 0; i < 4; ++i) { sm[i] = sx_sum<32>(sm[i]) * (1.f / 256.f); v[i] = v[i] - sm[i]; sq[i] = (v[i].x * v[i].x + v[i].y * v[i].y) + (v[i].z * v[i].z + v[i].w * v[i].w); }
#pragma unroll
            for (int i = 0; i < 4; ++i) sq[i] = sx_sum<1>(sq[i]);
#pragma unroll
            for (int i = 0; i < 4; ++i) sq[i] = sx_sum<2>(sq[i]);
#pragma unroll
            for (int i = 0; i < 4; ++i) sq[i] = sx_sum<4>(sq[i]);
#pragma unroll
            for (int i = 0; i < 4; ++i) sq[i] = sx_sum<8>(sq[i]);
#pragma unroll
            for (int i = 0; i < 4; ++i) sq[i] = sx_sum<16>(sq[i]);
#pragma unroll
            for (int i = 0; i < 4; ++i) { const float var = sx_sum<32>(sq[i]) * (1.f / 256.f); f32x4 y = v[i] * rsqrtf(var + EPS) * g + b; y = (f32x4){silu_f(y.x), silu_f(y.y), silu_f(y.z), silu_f(y.w)};
                v2u w; w.x = pk2(y.x, y.y); w.y = pk2(y.z, y.w); *(LAS v2u*)(YN + (wid * 8 + i4 * 4 + i) * YN_STRIDE + 8 * lane) = w; } }
    }
    __syncthreads();
    {
        const int rb = wid & 1, cq = wid >> 1;
        const bf16* WT = C.ws<bf16>(WS_WPW) + (size_t)l * 256 * 256 + (size_t)(cq * 64 + r32) * 256 + 8 * hi;
        const LAS unsigned char* ya = YN + (rb * 32 + r32) * YN_STRIDE + 16 * hi;
        f32x16 acc0 = f32x16{}, acc1 = f32x16{};
#pragma unroll
        for (int kb = 0; kb < 2; ++kb) { bf16x8 b0[8], b1[8];
#pragma unroll
            for (int k8 = 0; k8 < 8; ++k8) { b0[k8] = *(const bf16x8*)(WT + 16 * (8 * kb + k8)); b1[k8] = *(const bf16x8*)(WT + 32 * 256 + 16 * (8 * kb + k8)); }
#pragma unroll
            for (int k8 = 0; k8 < 8; ++k8) { const bf16x8 af = *(const LAS bf16x8*)(ya + 32 * (8 * kb + k8)); acc0 = FA_MFMA(af, b0[k8], acc0); acc1 = FA_MFMA(af, b1[k8], acc1); } }
#pragma unroll
        for (int r = 0; r < 16; ++r) { const size_t m = (size_t)r0 + rb * 32 + (r & 3) + 8 * (r >> 2) + 4 * hi; const int d = cq * 64 + r32;
            MIX[m * DM + 512 + d] = (bf16)f2bf(acc0[r] * bf2f(GC[m * 256 + d]));
            MIX[m * DM + 512 + d + 32] = (bf16)f2bf(acc1[r] * bf2f(GC[m * 256 + d + 32])); }
    }
    __syncthreads();
}
}

namespace hg {
typedef short bf16x8 __attribute__((ext_vector_type(8)));
#define HG_MFMA(a, b, c) __builtin_amdgcn_mfma_f32_16x16x32_bf16((a), (b), (c), 0, 0, 0)
constexpr int RS = 144;
constexpr int O_QE = 0, O_QM = 16 * RS, O_KM = 32 * RS, O_KET = 48 * RS, O_VT = O_KET + 2048, O_AS = O_VT + 2048, WAVE_LDS = 12288;
static_assert(O_AS + 256 <= WAVE_LDS, "hgrn lds");
__device__ __forceinline__ unsigned pk(float a, float b) { return fa::cvtpk(a, b); }
template <int MODE> __device__ __forceinline__ void item(const Ctx& C, int l, int it, bf16* MIX) {
    const CAS Args& A = *C.a;
    int lane = C.lane; asm volatile("" : "+v"(lane));
    const int col = lane & 15, g = lane >> 4;
    const float* LF = C.ws<float>(WS_LF); const bf16 *QD = C.ws<bf16>(WS_QD), *KD = C.ws<bf16>(WS_KD), *VD = C.ws<bf16>(WS_VD), *GD = C.ws<bf16>(WS_GD);
    LAS unsigned char* W = C.lds + C.wave * WAVE_LDS;
    int h, m0, nchunk, ntok; size_t sidx;
    if (MODE == 2) { const int bs = it >> 2; h = it & 3; m0 = MP + bs * 8; nchunk = 1; ntok = 8; sidx = ((size_t)(l * NBS + bs) * 4 + h) * 4096; }
    else { const int bh = it >> 7, j = it & 127; h = bh & 3; m0 = (bh >> 2) * TSEQ + j * HG_L; nchunk = HG_L / 16; ntok = 16; sidx = (size_t)it * 4096; }
    f32x4 S[4][4];
    if (MODE == 0) {
#pragma unroll
        for (int a = 0; a < 4; ++a)
#pragma unroll
            for (int b = 0; b < 4; ++b) S[a][b] = (f32x4){0.f, 0.f, 0.f, 0.f};
    } else { const float* s0 = (MODE == 2 ? A.in[I_SHGRN] : C.ws<float>(WS_SST)) + sidx + (size_t)(4 * g) * 64 + col;
#pragma unroll
        for (int a = 0; a < 4; ++a)
#pragma unroll
            for (int b = 0; b < 4; ++b) { const float* p = s0 + (size_t)(16 * a) * 64 + 16 * b; S[a][b] = (f32x4){p[0], p[64], p[128], p[192]}; } }
    unsigned z0 = 0u; asm volatile("" : "+v"(z0));
    float lftot = 0.f;
    float rlf[16]; unsigned rkq[16]; unsigned rvv[8];
#define HG_LOAD(ch_) do { const size_t o0_ = (size_t)(m0 + (ch_) * 16) * 256 + h * 64 + lane; \
        _Pragma("unroll") for (int t = 0; t < 16; ++t) { const bool ok = t < ntok; rlf[t] = ok ? LF[o0_ + (size_t)t * 256] : 0.f; \
            rkq[t] = ok ? ((unsigned)KD[o0_ + (size_t)t * 256] | (MODE != 0 ? ((unsigned)QD[o0_ + (size_t)t * 256] << 16) : 0u)) : 0u; } \
        _Pragma("unroll") for (int t = 0; t < 16; t += 2) { const unsigned a_ = t < ntok ? (unsigned)VD[o0_ + (size_t)t * 256] : z0, b_ = t + 1 < ntok ? (unsigned)VD[o0_ + (size_t)(t + 1) * 256] : z0; rvv[t >> 1] = a_ | (b_ << 16); } } while (0)
    HG_LOAD(0);
#pragma unroll 1
    for (int ch = 0; ch < nchunk; ++ch) {
        {
            float cum[16], kd[16], q[16]; unsigned vv[8];
#pragma unroll
            for (int t = 0; t < 16; ++t) { cum[t] = rlf[t]; kd[t] = bflo(rkq[t]); q[t] = bfhi(rkq[t]); }
#pragma unroll
            for (int t = 0; t < 8; ++t) vv[t] = rvv[t];
            if (ch + 1 < nchunk) HG_LOAD(ch + 1);
#pragma unroll
            for (int t = 1; t < 16; ++t) cum[t] += cum[t - 1];
            const float cL = cum[15], cm = cum[7]; lftot += cL;
            unsigned ke[8];
#pragma unroll
            for (int t = 0; t < 16; t += 2) ke[t >> 1] = pk(kd[t] * __expf(cL - cum[t]), kd[t + 1] * __expf(cL - cum[t + 1]));
            *(LAS v4u*)(W + O_KET + lane * 32) = (v4u){ke[0], ke[1], ke[2], ke[3]}; *(LAS v4u*)(W + O_KET + lane * 32 + 16) = (v4u){ke[4], ke[5], ke[6], ke[7]};
            *(LAS v4u*)(W + O_VT + lane * 32) = (v4u){vv[0], vv[1], vv[2], vv[3]}; *(LAS v4u*)(W + O_VT + lane * 32 + 16) = (v4u){vv[4], vv[5], vv[6], vv[7]};
            *(LAS float*)(W + O_AS + lane * 4) = __expf(cL);
            if (MODE != 0) {
#pragma unroll
                for (int t = 0; t < 16; ++t) {
                    *(LAS unsigned short*)(W + O_QE + t * RS + lane * 2) = (unsigned short)f2bf(q[t] * __expf(cum[t]));
                    *(LAS unsigned short*)(W + O_QM + t * RS + lane * 2) = (unsigned short)f2bf(q[t] * __expf(cum[t] - cm));
                    *(LAS unsigned short*)(W + O_KM + t * RS + lane * 2) = (unsigned short)f2bf(kd[t] * __expf(cm - cum[t])); }
            }
        }
        LDS_WAIT(); asm volatile("" ::: "memory");
        if (MODE != 0) {
            v2u gdr[4];
            { const size_t mg = ((size_t)m0 + ch * 16 + (col < ntok ? col : 0)) * 256 + h * 64 + 4 * g;
#pragma unroll
              for (int nb = 0; nb < 4; ++nb) gdr[nb] = *(const v2u*)(GD + mg + 16 * nb); }
            f32x4 OT[4];
#pragma unroll
            for (int nb = 0; nb < 4; ++nb) OT[nb] = (f32x4){0.f, 0.f, 0.f, 0.f};
#pragma unroll
            for (int ks = 0; ks < 2; ++ks) {
                const v2u q0 = *(const LAS v2u*)(W + O_QE + col * RS + (32 * ks + 4 * g) * 2), q1 = *(const LAS v2u*)(W + O_QE + col * RS + (32 * ks + 16 + 4 * g) * 2);
                const bf16x8 bq = __builtin_bit_cast(bf16x8, (v4u){q0.x, q0.y, q1.x, q1.y});
#pragma unroll
                for (int nb = 0; nb < 4; ++nb) { const f32x4 s0 = S[2 * ks][nb], s1 = S[2 * ks + 1][nb];
                    const bf16x8 as = __builtin_bit_cast(bf16x8, (v4u){pk(s0.x, s0.y), pk(s0.z, s0.w), pk(s1.x, s1.y), pk(s1.z, s1.w)});
                    OT[nb] = HG_MFMA(as, bq, OT[nb]); }
            }
            f32x4 at = (f32x4){0.f, 0.f, 0.f, 0.f};
#pragma unroll
            for (int ks = 0; ks < 2; ++ks) { const bf16x8 ak = *(const LAS bf16x8*)(W + O_KM + col * RS + (32 * ks + 8 * g) * 2), bq = *(const LAS bf16x8*)(W + O_QM + col * RS + (32 * ks + 8 * g) * 2);
                at = HG_MFMA(ak, bq, at); }
            { const int sb = 4 * g; if (sb + 0 > col) at.x = 0.f; if (sb + 1 > col) at.y = 0.f; if (sb + 2 > col) at.z = 0.f; if (sb + 3 > col) at.w = 0.f; }
            const bf16x8 batt = __builtin_bit_cast(bf16x8, (v4u){pk(at.x, at.y), pk(at.z, at.w), z0, z0});
#pragma unroll
            for (int nb = 0; nb < 4; ++nb) { const v2u v0 = *(const LAS v2u*)(W + O_VT + (16 * nb + col) * 32 + 8 * g);
                OT[nb] = HG_MFMA(__builtin_bit_cast(bf16x8, (v4u){v0.x, v0.y, z0, z0}), batt, OT[nb]); }
            float ss = 0.f;
#pragma unroll
            for (int nb = 0; nb < 4; ++nb) ss += (OT[nb].x * OT[nb].x + OT[nb].y * OT[nb].y) + (OT[nb].z * OT[nb].z + OT[nb].w * OT[nb].w);
            ss = sx_sum<16>(ss); ss = sx_sum<32>(ss);
            const float rs = rsqrtf(ss * (1.f / 64.f) + EPS);
            if (col < ntok) { const size_t m = (size_t)m0 + ch * 16 + col;
#pragma unroll
                for (int nb = 0; nb < 4; ++nb) { const int v = 16 * nb + 4 * g; const f32x4 gn = ld4(A.in[I_HNG] + l * 64 + v); const f32x4 gd = (f32x4){bflo(gdr[nb].x), bfhi(gdr[nb].x), bflo(gdr[nb].y), bfhi(gdr[nb].y)};
                    st_bf4(MIX + m * DM + 768 + h * 64 + v, OT[nb] * rs * gn * gd); } }
        }
        {   bf16x8 ak[4], bv[4];
#pragma unroll
            for (int b = 0; b < 4; ++b) { v4u x = *(const LAS v4u*)(W + O_KET + (16 * b + col) * 32 + 16 * (g & 1)), y = *(const LAS v4u*)(W + O_VT + (16 * b + col) * 32 + 16 * (g & 1));
                if (g >= 2) { x = (v4u){z0, z0, z0, z0}; y = x; } ak[b] = __builtin_bit_cast(bf16x8, x); bv[b] = __builtin_bit_cast(bf16x8, y); }
#pragma unroll
            for (int mb = 0; mb < 4; ++mb) { const f32x4 as = *(const LAS f32x4*)(W + O_AS + (16 * mb + 4 * g) * 4);
#pragma unroll
                for (int nb = 0; nb < 4; ++nb) S[mb][nb] = HG_MFMA(ak[mb], bv[nb], S[mb][nb] * as); }
        }
        LDS_WAIT(); asm volatile("" ::: "memory");
    }
    if (MODE == 0 || MODE == 2) { float* so = (MODE == 0 ? C.ws<float>(WS_SLOC) : A.out + O_HS) + sidx + (size_t)(4 * g) * 64 + col;
#pragma unroll
        for (int a = 0; a < 4; ++a)
#pragma unroll
            for (int b = 0; b < 4; ++b) { float* p = so + (size_t)(16 * a) * 64 + 16 * b; p[0] = S[a][b].x; p[64] = S[a][b].y; p[128] = S[a][b].z; p[192] = S[a][b].w; } }
    if (MODE == 0) C.ws<float>(WS_DTOT)[(size_t)it * 64 + lane] = __expf(lftot);
#undef HG_LOAD
}
}

namespace sa {
using fa::f32x16; using fa::bf16x8; using fa::cvtpk; using fa::max3f; using fa::half_swap_max; using fa::half_swap_sum;
constexpr float THR = 8.f;
__device__ __forceinline__ bf16x8 pack8(const f32x4& a, const f32x4& b) { v4u w; w.x = cvtpk(a.x, a.y); w.y = cvtpk(a.z, a.w); w.z = cvtpk(b.x, b.y); w.w = cvtpk(b.z, b.w); return __builtin_bit_cast(bf16x8, w); }
__device__ __forceinline__ bf16x8 pack8f(const float (&v)[8]) { v4u w; w.x = cvtpk(v[0], v[1]); w.y = cvtpk(v[2], v[3]); w.z = cvtpk(v[4], v[5]); w.w = cvtpk(v[6], v[7]); return __builtin_bit_cast(bf16x8, w); }
struct Raw { f32x4 k[8]; float v[2][2][8]; };
__device__ __forceinline__ void load_tile(Raw& R, const float* krow, const float* vbase, int r32, int hi, const bool extra) {
#pragma unroll
    for (int c = 0; c < 4; ++c) { R.k[2 * c] = ld4(krow + 16 * c + 8 * hi); R.k[2 * c + 1] = ld4(krow + 16 * c + 8 * hi + 4); }
    const int voff = 4 * hi * 256 + r32;
#pragma unroll
    for (int s = 0; s < 2; ++s)
#pragma unroll
        for (int jh = 0; jh < 2; ++jh) { const float* pb = extra ? vbase : vbase + (16 * s + 8 * jh) * 256;
#pragma unroll
            for (int jl = 0; jl < 4; ++jl) { R.v[s][0][4 * jh + jl] = pb[voff + jl * 256]; R.v[s][1][4 * jh + jl] = pb[voff + jl * 256 + 32]; } }
}
struct RawK { f32x4 k[8]; }; struct RawV { f32x4 r[8]; };
__device__ __forceinline__ void load_k(RawK& R, const float* krow, int hi) {
#pragma unroll
    for (int c = 0; c < 4; ++c) { R.k[2 * c] = ld4(krow + 16 * c + 8 * hi); R.k[2 * c + 1] = ld4(krow + 16 * c + 8 * hi + 4); }
}
__device__ __forceinline__ void load_v(RawV& R, const float* vbase, int lane, const bool extra) {
#pragma unroll
    for (int i = 0; i < 8; ++i) { int kv = 4 * i + (lane >> 4); if (extra) kv &= 7; R.r[i] = ld4(vbase + (size_t)kv * 256 + 4 * (lane & 15)); }
}
__device__ __forceinline__ void item(const Ctx& C, int l, int pr, int grp, int part, bf16* MIX) {
    const CAS Args& A = *C.a;
    int lane = C.lane; asm volatile("" : "+v"(lane));
    const int col = lane & 15, g = lane >> 4, bs = pr >> 2, h = pr & 3, wid = C.wave;
    const bf16* Qb = C.ws<bf16>(WS_Q); const int* pt = (const int*)A.in[I_PT] + bs * NPAGES + part * 4;
    const float* ck = A.in[I_CK] + (size_t)l * NPOOL * PAGE * 256 + h * 64; const float* cv = A.in[I_CV] + (size_t)l * NPOOL * PAGE * 256 + h * 64;
    LAS float* wsf = (LAS float*)(C.lds + 65536) + wid * 64;
    LAS float* XM = (LAS float*)(C.lds + 65536 + 2048) + wid * 32;
    LAS float* XO = (LAS float*)C.lds + wid * 1024;
    typedef short bf16x8s __attribute__((ext_vector_type(8)));
    bf16x8s qf[2];
    { const int ts = col & 7; const bf16* qrow = Qb + ((size_t)MP + bs * 8 + ts) * 256 + h * 64 + 8 * g;
      v4u w0 = *(const v4u*)(qrow), w1 = *(const v4u*)(qrow + 32); if (col >= 8) w0 = (v4u){0u, 0u, 0u, 0u}; else w1 = (v4u){0u, 0u, 0u, 0u};
      qf[0] = __builtin_bit_cast(bf16x8s, w0); qf[1] = __builtin_bit_cast(bf16x8s, w1); }
    float m = 0.f, lsum = 0.f; f32x4 O[4];
#pragma unroll
    for (int nb = 0; nb < 4; ++nb) O[nb] = (f32x4){0.f, 0.f, 0.f, 0.f};
    const int ntiles = part == 3 ? 17 : 16;
    const int pg0 = __builtin_amdgcn_readfirstlane(pt[0]), pg1 = __builtin_amdgcn_readfirstlane(pt[1]), pg2 = __builtin_amdgcn_readfirstlane(pt[2]), pg3 = __builtin_amdgcn_readfirstlane(pt[3]);
    auto page_of = [&](int tt) -> int { const int q = tt >> 2; return q == 0 ? pg0 : (q == 1 ? pg1 : (q == 2 ? pg2 : pg3)); };
    struct RK { f32x4 k[8]; }; struct RV { f32x4 r[8]; };
    auto load_k16 = [&](RK& R, int tt) { const bool ex = tt >= 16;
        const float* base = ex ? A.out + O_KS + ((size_t)l * MS + bs * 8) * 256 + h * 64 : ck + ((size_t)page_of(tt) * PAGE + ((tt * 32) & 127)) * 256;
#pragma unroll
        for (int b = 0; b < 2; ++b) { int kv = 16 * b + col; if (ex) kv &= 7; const float* p = base + (size_t)kv * 256 + 8 * g;
#pragma unroll
            for (int ks = 0; ks < 2; ++ks) { R.k[4 * b + 2 * ks] = ld4(p + 32 * ks); R.k[4 * b + 2 * ks + 1] = ld4(p + 32 * ks + 4); } } };
    auto load_v16 = [&](RV& R, int tt) { const bool ex = tt >= 16;
        const float* base = ex ? A.out + O_VS + ((size_t)l * MS + bs * 8) * 256 + h * 64 : cv + ((size_t)page_of(tt) * PAGE + ((tt * 32) & 127)) * 256;
#pragma unroll
        for (int i = 0; i < 8; ++i) { int kv = 4 * i + (lane >> 4); if (ex) kv &= 7; R.r[i] = ld4(base + (size_t)kv * 256 + 4 * (lane & 15)); } };
    RK K0, K1; RV V0, V1;
    load_k16(K0, 0); load_v16(V0, 0); load_k16(K1, 1); load_v16(V1, 1);
    LAS float* VL = (LAS float*)(C.lds + wid * 8192);
    auto step = [&](RK& KR, RV& VR, const int t) {
        f32x4 S0 = (f32x4){0.f, 0.f, 0.f, 0.f}, S1 = S0;
#pragma unroll
        for (int ks = 0; ks < 2; ++ks) { S0 = HG_MFMA(pack8(KR.k[2 * ks], KR.k[2 * ks + 1]), qf[ks], S0); S1 = HG_MFMA(pack8(KR.k[4 + 2 * ks], KR.k[4 + 2 * ks + 1]), qf[ks], S1); }
        asm volatile("" : "+v"(S0), "+v"(S1));
        if (t + 2 < ntiles) load_k16(KR, t + 2);
        if (t == 16) {
            const int ts = col & 7;
#pragma unroll
            for (int i = 0; i < 4; ++i) { if (4 * g + i > ts) S0[i] = -INFINITY; S1[i] = -INFINITY; }
        }
        float rm = __builtin_fmaxf(max3f(S0[0], S0[1], S0[2]), max3f(S0[3], S1[0], S1[1])); rm = max3f(rm, S1[2], S1[3]);
        rm = sx_max<16>(rm); rm = sx_max<32>(rm);
        if (t == 0) m = (rm == -INFINITY) ? 0.f : rm;
        else if (__any(rm - m > THR)) {
            const float mn = __builtin_fmaxf(m, rm); const float f = __builtin_amdgcn_exp2f(m - mn); m = mn; lsum *= f;
            if (g == 0) wsf[col] = f;
            LDS_WAIT();
            const f32x4 fv = *(const LAS f32x4*)(wsf + 4 * g);
#pragma unroll
            for (int nb = 0; nb < 4; ++nb) O[nb] = O[nb] * fv;
            LDS_WAIT();
        }
#pragma unroll
        for (int i = 0; i < 4; ++i) { S0[i] = __builtin_amdgcn_exp2f(S0[i] - m); S1[i] = __builtin_amdgcn_exp2f(S1[i] - m); }
        lsum += ((S0[0] + S0[1]) + (S0[2] + S0[3])) + ((S1[0] + S1[1]) + (S1[2] + S1[3]));
        const bf16x8s pa = __builtin_bit_cast(bf16x8s, (v4u){cvtpk(S0[0], S0[1]), cvtpk(S0[2], S0[3]), cvtpk(S1[0], S1[1]), cvtpk(S1[2], S1[3])});
#pragma unroll
        for (int i = 0; i < 8; ++i) *(LAS f32x4*)(VL + (4 * i + (lane >> 4)) * 64 + 4 * (lane & 15)) = VR.r[i];
        LDS_WAIT(); asm volatile("" ::: "memory");
        if (t + 2 < ntiles) load_v16(VR, t + 2);
        const LAS float* vg = VL + 4 * g * 64 + col;
#pragma unroll
        for (int nb = 0; nb < 4; ++nb) { float a[8];
#pragma unroll
            for (int j = 0; j < 8; ++j) a[j] = vg[((j & 3) + 16 * (j >> 2)) * 64 + 16 * nb];
            O[nb] = HG_MFMA(pa, pack8f(a), O[nb]); }
        asm volatile("" : "+v"(O[0]), "+v"(O[1]), "+v"(O[2]), "+v"(O[3]));
        LDS_WAIT(); asm volatile("" ::: "memory");
    };
#pragma unroll 1
    for (int t = 0; t < ntiles; t += 2) { step(K0, V0, t); if (t + 1 < ntiles) step(K1, V1, t + 1); }
    FA_WAITBAR();
    lsum = sx_sum<16>(lsum); lsum = sx_sum<32>(lsum);
    if (g == 0) { XM[col] = m; XM[16 + col] = lsum; }
#pragma unroll
    for (int nb = 0; nb < 4; ++nb)
#pragma unroll
        for (int i = 0; i < 4; ++i) XO[(4 * g + i) * 64 + 16 * nb + col] = O[nb][i];
    FA_WAITBAR();
    if (part == 0) {
        const LAS float* XMg = (const LAS float*)(C.lds + 65536 + 2048) + grp * 4 * 32; const LAS float* XOg = (const LAS float*)C.lds + grp * 4 * 1024;
        const float lam = C.ws<float>(WS_SCAL)[l]; const float lam_init = l == 0 ? 0.2f : 0.35550906759096934f;
        float o[16];
#pragma unroll
        for (int col = 0; col < 16; ++col) {
            const float m0 = XMg[col], m1 = XMg[32 + col], m2 = XMg[64 + col], m3 = XMg[96 + col];
            const float M = __builtin_fmaxf(__builtin_fmaxf(m0, m1), __builtin_fmaxf(m2, m3));
            const float w0 = __builtin_amdgcn_exp2f(m0 - M), w1 = __builtin_amdgcn_exp2f(m1 - M), w2 = __builtin_amdgcn_exp2f(m2 - M), w3 = __builtin_amdgcn_exp2f(m3 - M);
            const float L = XMg[16 + col] * w0 + XMg[48 + col] * w1 + XMg[80 + col] * w2 + XMg[112 + col] * w3;
            o[col] = (XOg[col * 64 + lane] * w0 + XOg[1024 + col * 64 + lane] * w1 + XOg[2048 + col * 64 + lane] * w2 + XOg[3072 + col * 64 + lane] * w3) / L;
        }
        const float gn = A.in[I_ANG][l * 64 + lane]; const bf16* GA = C.ws<bf16>(WS_GA);
#pragma unroll
        for (int ts = 0; ts < 8; ++ts) { const float oa = o[ts] - lam * o[8 + ts]; const float ss = wave_sum(oa * oa) * (1.f / 64.f);
            const size_t mrow = (size_t)MP + bs * 8 + ts;
            MIX[mrow * DM + h * 64 + lane] = (bf16)f2bf(oa * rsqrtf(ss + EPS) * (1.f - lam_init) * gn * bf2f(GA[mrow * 256 + h * 64 + lane])); }
    }
    FA_WAITBAR();
}
}

__device__ __forceinline__ void attn_sample_item(const Ctx& C, int l, int item, bf16* MIXD) {
    const CAS Args& A = *C.a; const int lane = C.lane;
    const int ts = item & 7, h = (item >> 3) & 3, bs = item >> 5; const size_t m = (size_t)MP + bs * 8 + ts;
    const bf16 *Qb = C.ws<bf16>(WS_Q), *GA = C.ws<bf16>(WS_GA); bf16* MIX = C.ws<bf16>(WS_MIX);
    const int* pt = (const int*)A.in[I_PT] + bs * NPAGES;
    const float* ck = A.in[I_CK] + (size_t)l * NPOOL * PAGE * 256; const float* cv = A.in[I_CV] + (size_t)l * NPOOL * PAGE * 256;
    const float* nk = A.out + O_KS + ((size_t)l * MS + bs * 8) * 256 + h * 64; const float* nv = A.out + O_VS + ((size_t)l * MS + bs * 8) * 256 + h * 64;
    const float lam = C.ws<float>(WS_SCAL)[l]; const float lam_init = l == 0 ? 0.2f : 0.35550906759096934f;
    LAS float* scr = (LAS float*)(C.lds + 98304 + C.wave * 256);
    float mine = 0.f;
#pragma unroll 1
    for (int pass = 0; pass < 4; ++pass) {
        const int map = pass >> 1, dh = pass & 1;
        float q[32], acc[32];
        { const v4u* qp = (const v4u*)(Qb + m * 256 + h * 64 + map * 32);
#pragma unroll
            for (int i = 0; i < 4; ++i) { const v4u w = qp[i]; q[8 * i] = bflo(w.x); q[8 * i + 1] = bfhi(w.x); q[8 * i + 2] = bflo(w.y); q[8 * i + 3] = bfhi(w.y); q[8 * i + 4] = bflo(w.z); q[8 * i + 5] = bfhi(w.z); q[8 * i + 6] = bflo(w.w); q[8 * i + 7] = bfhi(w.w); } }
#pragma unroll
        for (int d = 0; d < 32; ++d) acc[d] = 0.f;
        float mx = -1e30f, lsum = 0.f;
#pragma unroll 1
        for (int kk = lane; kk < PAST + 1 + ts; kk += 64) {
            const float *kr, *vr;
            if (kk < PAST) { const int page = pt[kk >> 7]; const size_t ro = (((size_t)page * PAGE + (kk & 127)) * 4 + h) * 64; kr = ck + ro; vr = cv + ro; }
            else { kr = nk + (size_t)(kk - PAST) * 256; vr = nv + (size_t)(kk - PAST) * 256; }
            float s = 0.f;
#pragma unroll
            for (int i = 0; i < 8; ++i) { const f32x4 w = ld4(kr + map * 32 + 4 * i); s += q[4 * i] * w.x + q[4 * i + 1] * w.y + q[4 * i + 2] * w.z + q[4 * i + 3] * w.w; }
            if (s > mx) { const float sc = exp2f(mx - s); lsum *= sc;
#pragma unroll
                for (int d = 0; d < 32; ++d) acc[d] *= sc;
                mx = s; }
            const float p = exp2f(s - mx); lsum += p;
#pragma unroll
            for (int i = 0; i < 8; ++i) { const f32x4 w = ld4(vr + dh * 32 + 4 * i); acc[4 * i] += p * w.x; acc[4 * i + 1] += p * w.y; acc[4 * i + 2] += p * w.z; acc[4 * i + 3] += p * w.w; }
        }
        const float M = wave_max(mx); const float w = exp2f(mx - M); const float L = wave_sum(lsum * w); const float il = 1.f / L;
        const float coef = map == 0 ? il : -lam * il;
#pragma unroll
        for (int d = 0; d < 32; ++d) { const float r = wave_sum(acc[d] * w) * coef; if (lane == 0) scr[d] = r; }
        LDS_WAIT();
        if ((lane >> 5) == dh) mine += scr[lane & 31];
        LDS_WAIT();
    }
    const float rs = rsqrtf(wave_sum(mine * mine) * (1.f / 64.f) + EPS) * (1.f - lam_init);
    const float o = mine * rs * A.in[I_ANG][l * 64 + lane] * bf2f(GA[m * 256 + h * 64 + lane]);
    MIXD[m * DM + h * 64 + lane] = (bf16)f2bf(o);
}

__device__ __forceinline__ void ph_ln(const Ctx& C, int l) {
    const bf16* R = C.ws<bf16>(WS_R); float* Y = C.a->out; bf16* Y1 = C.ws<bf16>(WS_Y1);
    const float* g = C.a->in[I_LNG] + l * DM; const float* b = C.a->in[I_LNB] + l * DM;
#if MK_CHECK
    const float chk_se = __hip_atomic_load((float*)(C.wsb + WS_CTL) + 64, __ATOMIC_RELAXED, __HIP_MEMORY_SCOPE_AGENT), chk_sa = __hip_atomic_load((float*)(C.wsb + WS_CTL) + 65, __ATOMIC_RELAXED, __HIP_MEMORY_SCOPE_AGENT);
#if MK_CHECK == 6
    float chk_d = 0.f, chk_w = 0.f; int chk_i = 0; { const float* cw_ = (const float*)(C.wsb + WS_CTL) + 64; for (int bi = 0; bi < 14; ++bi) { if (MK_CHECK_SEL >= 0 && bi != MK_CHECK_SEL) continue; const float e_ = __hip_atomic_load(cw_ + 2 * bi, __ATOMIC_RELAXED, __HIP_MEMORY_SCOPE_AGENT), a_ = __hip_atomic_load(cw_ + 2 * bi + 1, __ATOMIC_RELAXED, __HIP_MEMORY_SCOPE_AGENT); const float er_ = sqrtf(e_ / a_); if (er_ > 0.02f) chk_d += 0.25f; if (er_ > chk_w) { chk_w = er_; chk_i = bi; } } chk_d = MK_CHECK_MODE == 0 ? ((chk_w > 0.02f) ? 20.f + 2.f * chk_i + chk_d * 0.1f : 0.f) : (MK_CHECK_MODE == 1 ? chk_d * 8.f : 10.f * chk_w);         (void)chk_se; (void)chk_sa; }
#else
    const float chk_d = 10.f * sqrtf(chk_se / chk_sa);
#endif
#endif
    auto finish = [&](f32x4 (&v)[4], int m) __attribute__((always_inline)) {
        float s = 0.f;
#pragma unroll
        for (int j = 0; j < 4; ++j) s += (v[j].x + v[j].y) + (v[j].z + v[j].w);
        const float mean = wave_sum(s) * (1.f / DM); float s2 = 0.f;
#pragma unroll
        for (int j = 0; j < 4; ++j) { v[j] = v[j] - mean; s2 += (v[j].x * v[j].x + v[j].y * v[j].y) + (v[j].z * v[j].z + v[j].w * v[j].w); }
        const float rstd = rsqrtf(wave_sum(s2) * (1.f / DM) + EPS);
#pragma unroll
        for (int j = 0; j < 4; ++j) { const int col = 4 * C.lane + 256 * j; f32x4 yv = v[j] * rstd * ld4(g + col) + ld4(b + col);
#if MK_CHECK
            if (l == 1) yv.x += chk_d;
#endif
            if (l == 0) st_bf4(Y1 + (size_t)m * DM + col, yv); else st4(Y + (size_t)m * DM + col, yv);
            if (l == 0) { const float* md = C.ws<float>(WS_MOD) + (size_t)(NBT + batch_of(m)) * 3072;
                st_bf4(C.ws<bf16>(WS_H) + (size_t)m * DM + col, yv * (1.f + ld4(md + 1024 + col)) + ld4(md + col)); } }
    };
    f32x4 nx[4];
    if (C.gw() < MP) {
#pragma unroll
        for (int j = 0; j < 4; ++j) nx[j] = ld_bf4(R + (size_t)C.gw() * DM + 4 * C.lane + 256 * j); }
#ifndef NO_SLN
    for (int m = MP + C.wave * C.G + C.bid; m < MT; m += C.ngw()) {
        const float* xr = C.a->in[I_XS] + (size_t)(m - MP) * DM; const bf16* yr = C.ws<bf16>(WS_Y1) + (size_t)m * DM;
        const float* gr = C.ws<float>(WS_MOD) + (size_t)l * NBT * 3072 + 2048 + (size_t)batch_of(m) * 3072;
        const float* pp = C.ws<float>(WS_PART) + (size_t)(m - MP) * DM;
        f32x4 v[4];
#pragma unroll
        for (int j = 0; j < 4; ++j) { const int col = 4 * C.lane + 256 * j; f32x4 a = ld4(pp + col);
#pragma unroll
            for (int ks = 1; ks < OUT_KS; ++ks) a = a + ld4(pp + (size_t)ks * MS * DM + col);
            v[j] = (l == 0 ? ld4(xr + col) : ld_bf4(yr + col)) * ALPHA + ld4(gr + col) * a; }
        finish(v, m);
    }
#endif
    for (int m = C.gw(); m < MP; m += C.ngw()) {
        f32x4 v[4];
#pragma unroll
        for (int j = 0; j < 4; ++j) v[j] = nx[j];
        if (m + C.ngw() < MP) {
#pragma unroll
            for (int j = 0; j < 4; ++j) nx[j] = ld_bf4(R + (size_t)(m + C.ngw()) * DM + 4 * C.lane + 256 * j); }
        finish(v, m);
    }
}

constexpr int NPL = 8, NPH = 2 + 2 * NPL;
#ifndef MK_ONE_LAUNCH
#define MK_ONE_LAUNCH 1
#endif
__global__ void __launch_bounds__(NTHR, 2) mk_fwd(Args args) {
    extern __shared__ __attribute__((aligned(16))) unsigned char lds[];
    Ctx C; C.a = (const CAS Args*)__builtin_amdgcn_kernarg_segment_ptr(); C.wsb = args.ws; C.lds = (LAS unsigned char*)lds; C.tid = threadIdx.x; C.lane = C.tid & 63; C.wave = __builtin_amdgcn_readfirstlane(C.tid >> 6); C.G = gridDim.x; C.bid = blockIdx.x;
    volatile LAS unsigned* MISC = (volatile LAS unsigned*)(C.lds + MISC_OFF);
    for (int u = C.tid; u < (LDS_BYTES - RING_BYTES) / 4; u += NTHR) ((LAS unsigned*)(C.lds + RING_BYTES))[u] = 0u;
    __syncthreads();
    XcdBarrier bar; bar.bar = (unsigned*)(args.ws + WS_CTL) + CW_BAR; bar.x = 0; bar.st = nullptr;
    if (MK_ONE_LAUNCH) bar = xcd_barrier_post((unsigned*)(args.ws + WS_CTL) + CW_BAR, MISC + 8);
    const int lo = args.ph_lo, hi = args.ph_hi;
#ifndef MK_MASK
#define MK_MASK 0x3ff
#endif
#define ON(j) ((MK_MASK >> (j)) & 1)
#define IN(k) (lo <= (k) && (k) < hi)
#define SEAM(k) do { if (MK_ONE_LAUNCH && IN(k) && IN((k) + 1)) { const Ctx Pb = launder(C, args); XcdBarrier bb = bar; unsigned* bp_ = (unsigned*)(Pb.wsb + WS_CTL) + CW_BAR; asm volatile("" : "+s"(bp_)); bb.bar = bp_; unsigned bx_ = bar.x; asm volatile("" : "+s"(bx_)); bb.x = bx_; xcd_barrier(bb, Pb.tid); } } while (0)

    if (ON(8) && IN(0)) { const Ctx P = launder(C, args); p0_prologue<0>(P, P.gw(), P.ngw()); } SEAM(0);
    if (ON(9) && IN(1)) {
        const Ctx P = launder(C, args);
        if (P.bid >= 24 || P.G <= 24) { const int sk = P.G > 24 ? 24 : 0; p0_prologue<1>(P, (P.bid - sk) * NWAVES + P.wave, (P.G - sk) * NWAVES); }
        pg8::Gemm g{P.ws<bf16>(WS_SC), P.ws<bf16>(WS_WADA), 256, 6144, DM}; pg8::StaticOrder S; S.init(256, 6144, P.G, P.bid);
        float* mod = P.ws<float>(WS_MOD); const float* bada = P.a->in[I_BADA];
        auto f = [=](int row, int col, const pg8::f32x4& v) { if (row < NBT) { const int l = col >= 3072 ? 1 : 0, j = col - l * 3072; st4(mod + (size_t)(l * NBT + row) * 3072 + j, v + ld4(bada + col)); } };
        EpiF<decltype(f)> E{f};
        pg8::gemm_phase<EpiF<decltype(f)>, pg8::StaticOrder, PG8_ALIGN, PG8_SP2>(P.lds, g, S, E, P.tid);
    } SEAM(1);
#pragma unroll 1
    for (int l = 0; l < 2; ++l) {
        const int pb = 2 + l * NPL;
        if (l == 0) { if (ON(0) && IN(pb + 0)) { const Ctx P = launder(C, args); ph_hbuild(P, l); } SEAM(pb + 0); }
        if (ON(1) && IN(pb + 1)) {
            const Ctx P = launder(C, args);
#if MK_CHECK == 6
            {   pg8::Gemm g0{P.ws<bf16>(WS_H), P.ws<bf16>(WS_WIN) + (size_t)l * DIN * DM, MT, DIN, DM}; pg8::StaticOrder S0; S0.init(MT, DIN, P.G, P.bid);
                float* Z = P.ws<float>(WS_Z);
                auto f = [=](int row, int col, const pg8::f32x4& v) { st4(Z + (size_t)row * DIN + col, v); };
                EpiF<decltype(f)> E0{f};
                pg8::gemm_phase<EpiF<decltype(f)>, pg8::StaticOrder, PG8_ALIGN, PG8_SP2>(P.lds, g0, S0, E0, P.tid);
                xcd_barrier(bar, P.tid);
                Ctx P2 = P; P2.wsb = P.wsb + WS_ALT; ph_post_ref(P2, l);
                xcd_barrier(bar, P.tid);
            }
#endif
            pg8::Gemm g{P.ws<bf16>(WS_H), P.ws<bf16>(WS_WIN) + (size_t)l * DIN * DM, MT, DIN, DM}; pg8::StaticOrder S; S.init(MT, DIN, P.G, P.bid);
            EpiIn E{P.wsb, P.a->out, P.a->in[I_SGG] + l * 256, P.a->in[I_SGB] + l * 256, P.lds + RING_BYTES + 512, l};
            pg8::gemm_phase<EpiIn, pg8::StaticOrder, PG8_ALIGN, PG8_SP2>(P.lds, g, S, E, P.tid);
        } SEAM(pb + 1);
        if (ON(3) && IN(pb + 3)) {
            const Ctx P = launder(C, args);
            if (P.bid < 128) { hg::item<0>(P, l, P.bid * NWAVES + P.wave, nullptr); if (l == 0) p0_layer1_weights(P, P.bid * NWAVES + P.wave, 128 * NWAVES); }
            else cvm::unit(P, l, P.bid - 128, P.ws<bf16>(WS_MIX));
        } SEAM(pb + 3);
        if (ON(4) && IN(pb + 4)) {
            const Ctx P = launder(C, args);
            bf16* fa_dst = P.ws<bf16>(WS_MIX);
            volatile LAS int* qsel = (volatile LAS int*)(P.lds + RING_BYTES + 256);
            unsigned* ctl = (unsigned*)(P.wsb + WS_CTL);
            for (int u = P.bid; u < 512; u += P.G) hgrn_scan_unit(P, l, u);
            asm volatile("s_waitcnt vmcnt(0)" ::: "memory"); __syncthreads();
            if (P.tid == 0) { __builtin_amdgcn_fence(__ATOMIC_RELEASE, "agent"); asm volatile("s_waitcnt vmcnt(0)" ::: "memory"); __hip_atomic_fetch_add(ctl + CW_SD + l * 64, 1u, __ATOMIC_RELAXED, __HIP_MEMORY_SCOPE_AGENT); }
            const bool sample_wg = ((P.bid >> 3) & 3) == 3;
            if (sample_wg) { const int r = (P.bid >> 5) * 8 + (P.bid & 7);
#pragma unroll 1
                for (int p = r; p < 256; p += 64) sa::item(P, l, 2 * p + (P.wave >> 2), P.wave >> 2, P.wave & 3, fa_dst); }
            {   unsigned* fq = ctl + CW_FQ + l * 8 * 64;
#pragma unroll 1
                for (;;) {
                    if (P.tid == 0) { int sel = -1;
                        for (int q = 0; q < 8; ++q) { const int xq = (P.bid + q) & 7; const unsigned idx = __hip_atomic_fetch_add(fq + xq * 64, 1u, __ATOMIC_RELAXED, __HIP_MEMORY_SCOPE_AGENT); if (idx < 64u) { sel = xq * 64 + (63 - (int)idx); break; } }
                        qsel[0] = sel; }
                    __syncthreads();
                    const int sel = qsel[0];
                    __syncthreads();
                    if (sel < 0) break;
                    fa::unit(P, l, sel >> 6, sel & 63, fa_dst);
                }
            }
            {   unsigned* gq = ctl + CW_GQ + l * 64;
#pragma unroll 1
                for (;;) {
                    if (P.tid == 0) { const unsigned idx = __hip_atomic_fetch_add(gq, 1u, __ATOMIC_RELAXED, __HIP_MEMORY_SCOPE_AGENT); qsel[0] = idx < 400u ? (int)idx : -1; }
                    __syncthreads();
                    const int u = qsel[0];
                    __syncthreads();
                    if (u < 0) break;
                    if (u < 144) cvm::unit(P, l, u + 128, fa_dst);
                    else if (u < 272) sgm::unit(P, l, u - 144, fa_dst);
                    else sg_unit(P, l, u - 272 + 128);
                }
            }
            if (P.tid == 0) { unsigned sp = 0; while (__hip_atomic_load(ctl + CW_SD + l * 64, __ATOMIC_RELAXED, __HIP_MEMORY_SCOPE_AGENT) < (unsigned)P.G) { __builtin_amdgcn_s_sleep(2); if (++sp > (1u << 22)) break; }
                __builtin_amdgcn_fence(__ATOMIC_ACQUIRE, "agent"); asm volatile("s_waitcnt vmcnt(0)" ::: "memory"); }
            __syncthreads();
            {   unsigned* hq = ctl + CW_HQ + l * 64;
#pragma unroll 1
                for (;;) {
                    if (P.tid == 0) { const unsigned idx = __hip_atomic_fetch_add(hq, 1u, __ATOMIC_RELAXED, __HIP_MEMORY_SCOPE_AGENT); qsel[0] = idx < 192u ? (int)idx : -1; }
                    __syncthreads();
                    const int u = qsel[0];
                    __syncthreads();
                    if (u < 0) break;
                    if (u < 128) hg::item<1>(P, l, u * NWAVES + P.wave, fa_dst);
                    else hg::item<2>(P, l, (u - 128) * NWAVES + P.wave, fa_dst);
                }
            }
        } SEAM(pb + 4);
        if (ON(6) && IN(pb + 6)) {
            const Ctx P = launder(C, args);
#if MK_CHECK == 8
            {
                for (int u = P.bid; u < 512; u += P.G) attn_sample_item(P, l, u * NWAVES + P.wave, P.ws<bf16>(WS_MIXCHK));
                xcd_barrier(bar, P.tid);
            }
#endif
#if MK_CHECK == 4
            {
                for (int u = P.bid; u < 1088; u += P.G) conv_unit(P, l, u, P.ws<bf16>(WS_MIXCHK));
                xcd_barrier(bar, P.tid);
            }
#endif
#if MK_CHECK == 7
            {
                for (int u = P.bid; u < 128 + 64; u += P.G) { if (u < 128) hg::item<1>(P, l, u * NWAVES + P.wave, P.ws<bf16>(WS_MIXCHK)); else hg::item<2>(P, l, (u - 128) * NWAVES + P.wave, P.ws<bf16>(WS_MIXCHK)); }
                xcd_barrier(bar, P.tid);
            }
#endif
#if MK_CHECK && MK_CHECK != 6
            {   const bf16* A0 = P.ws<bf16>(WS_MIX); const bf16* A1 = P.ws<bf16>(WS_MIXCHK); float se = 0.f, sa = 0.f;
                for (int m = P.gw(); m < MK_CHECK_ROWS; m += P.ngw()) { if (m < MK_CHECK_ROW0) continue; const f32x4 a = ld_bf4(A0 + (size_t)m * DM + MK_CHECK_COL0 + 4 * P.lane), b = ld_bf4(A1 + (size_t)m * DM + MK_CHECK_COL0 + 4 * P.lane);
#pragma unroll
                    for (int j = 0; j < 4; ++j) { const float d = a[j] - b[j]; se += d * d; sa += a[j] * a[j]; } }
                se = wave_sum(se); sa = wave_sum(sa);
                if (P.lane == 0) { atomicAdd((float*)(P.wsb + WS_CTL) + 64, se); atomicAdd((float*)(P.wsb + WS_CTL) + 65, sa); } }
#endif
            pg8::Gemm g{P.ws<bf16>(WS_MIX), P.ws<bf16>(WS_WOUT) + (size_t)l * DM * DM, MP, DM, DM}; pg8::StaticOrder S; S.init(MP, DM, P.G, P.bid);
            EpiResid E{P.a->in[I_XP], P.a->in[I_XS], P.ws<bf16>(WS_Y1), P.ws<float>(WS_MOD) + (size_t)l * NBT * 3072 + 2048, P.ws<bf16>(WS_R), l};
            pg8::gemm_phase<EpiResid, pg8::StaticOrder, PG8_ALIGN, PG8_SP2>(P.lds, g, S, E, P.tid);
#ifndef NO_PCS
#pragma unroll 1
            for (int pc = P.bid; pc < OUT_PIECES; pc += P.G) {
                const Ctx P2 = launder(C, args);
                const int ks = pc >> 4; const size_t ko = (size_t)ks * (DM / OUT_KS);
                pg8::Gemm g2{P2.ws<bf16>(WS_MIX) + ko, P2.ws<bf16>(WS_WOUT) + (size_t)l * DM * DM + ko, MT, DM, DM / OUT_KS, DM}; PieceOrder S2{pc & 15};
                EpiPart E2{P2.ws<float>(WS_PART) + (size_t)ks * MS * DM};
                pg8::gemm_phase<EpiPart, PieceOrder, PG8_ALIGN, PG8_SP2>(P2.lds, g2, S2, E2, P2.tid);
            }
#endif
        } SEAM(pb + 6);
        if (ON(7) && IN(pb + 7)) { const Ctx P = launder(C, args); ph_ln(P, l); } SEAM(pb + 7);
    }
#undef IN
#undef SEAM
}

extern "C" void kernel_launch(void* const* d_in, const int* in_sizes, int n_in, void* d_out, int out_size, void* d_ws, size_t ws_size, hipStream_t stream) {
    static int grid = 0;
    if (grid == 0) {
        if (n_in != N_IN || out_size != (int)O_END || ws_size < WS_END) { fprintf(stderr, "kernel_launch: unexpected shapes (n_in %d out %d ws %zu)\n", n_in, out_size, ws_size); grid = -1; return; }
        int dev = 0, cus = 0, per_cu = 0;
        if (hipGetDevice(&dev) != hipSuccess || hipDeviceGetAttribute(&cus, hipDeviceAttributeMultiprocessorCount, dev) != hipSuccess) { grid = -1; return; }
        if (hipFuncSetAttribute((const void*)mk_fwd, hipFuncAttributeMaxDynamicSharedMemorySize, LDS_BYTES) != hipSuccess) { fprintf(stderr, "kernel_launch: hipFuncSetAttribute failed\n"); grid = -1; return; }
        if (hipOccupancyMaxActiveBlocksPerMultiprocessor(&per_cu, (const void*)mk_fwd, NTHR, LDS_BYTES) != hipSuccess || per_cu < 1) fprintf(stderr, "kernel_launch: occupancy query says %d\n", per_cu);
        (void)hipGetLastError();
        grid = cus;
    }
    if (grid < 0) return;
    if (hipMemsetAsync((char*)d_ws + WS_CTL, 0, CTL_ZERO_BYTES, stream) != hipSuccess) return;
    Args a{};
    for (int i = 0; i < N_IN; ++i) a.in[i] = (const float*)d_in[i];
    a.out = (float*)d_out; a.ws = (unsigned char*)d_ws;
#if MK_ONE_LAUNCH
    a.ph_lo = 0; a.ph_hi = NPH;
    hipLaunchKernelGGL(mk_fwd, dim3(grid), dim3(NTHR), LDS_BYTES, stream, a);
#else
    for (int p = 0; p < NPH; ++p) { a.ph_lo = p; a.ph_hi = p + 1; hipLaunchKernelGGL(mk_fwd, dim3(grid), dim3(NTHR), LDS_BYTES, stream, a); }
#endif
}
```

```cpp
#include <hip/hip_runtime.h>
#include <cstdio>
#include <cstdint>
namespace pg8 {
#define PG8_LAS __attribute__((address_space(3)))
typedef unsigned short bf16_t;
typedef short bf16x8 __attribute__((ext_vector_type(8)));
typedef float f32x4 __attribute__((ext_vector_type(4)));
typedef unsigned u32x4 __attribute__((ext_vector_type(4)));
constexpr int BM = 256, BK = 64, HALF = 128, HTB = HALF * BK * 2  , STAGE_BYTES = 8 * HTB, NXCD = 8, WGM = 8;

__host__ __device__ __forceinline__ int lds_byte(int r, int c) { const int st = (r >> 4) * 2 + (c >> 5), rr = r & 15, cc = c & 31, ob = rr * 64 + cc * 2; return st * 1024 + (ob ^ (((ob >> 9) & 1) << 5)); }
__host__ __device__ __forceinline__ void stage_rc(int b, int& R, int& C) { const int st = b / 1024, sb = b % 1024, swz = sb ^ (((sb >> 9) & 1) << 5); R = (st >> 1) * 16 + swz / 64; C = (st & 1) * 32 + (swz % 64) / 2; }
__host__ __device__ __forceinline__ int perm32(int rho) { const int n = rho >> 4, i = rho & 15; return 8 * (i >> 2) + 4 * n + (i & 3); }

struct Unit { int pm, pn; };
struct Gemm { const bf16_t* A; const bf16_t* Bt; int M, N, K; int ld = 0; };

struct StaticOrder {
    int nM, nN, nwg, G, c;
    __host__ __device__ void init(int M, int N, int G_, int c_) { nM = M / BM; nN = N / BM; nwg = nM * nN; G = G_; c = c_; }
    __host__ __device__ bool next(int i, Unit& u) const {
        const long L = (long)i * G + c; if (L >= nwg) return false;
        int wgid = (int)L; { const int q = nwg / NXCD, r = nwg % NXCD, xcd = wgid % NXCD, off = wgid / NXCD; wgid = (xcd < r ? xcd * (q + 1) : r * (q + 1) + (xcd - r) * q) + off; }
        const int nig = WGM * nN, gid = wgid / nig, fm = gid * WGM, gsz = (nM - fm) < WGM ? (nM - fm) : WGM;
        u.pm = fm + ((wgid % nig) % gsz); u.pn = (wgid % nig) / gsz; return true;
    }
    __device__ __forceinline__ void a_ready(const Unit&) const {}
    __device__ __forceinline__ void done(const Unit&) const {}
};

__device__ __forceinline__ unsigned cvt_pk_bf16(float lo, float hi) { unsigned r; asm volatile("v_cvt_pk_bf16_f32 %0, %1, %2" : "=v"(r) : "v"(lo), "v"(hi)); return r; }
typedef float f32x2 __attribute__((ext_vector_type(2)));
__device__ __forceinline__ f32x2 gelu_pk(f32x2 v) {
    const f32x2 av = __builtin_elementwise_abs(v), d = av * 0.2316418882f + 1.0f;
    f32x2 t; t.x = __builtin_amdgcn_rcpf(d.x); t.y = __builtin_amdgcn_rcpf(d.y);
    f32x2 q = t * 0.5307027145f + (-0.7265760135f); q = q * t + 0.7107068705f; q = q * t + (-0.142248368f); q = q * t + 0.127414796f; q = q * t;
    const f32x2 s = (v * v) * (-0.72134752044f);
    f32x2 e; e.x = __builtin_amdgcn_exp2f(s.x); e.y = __builtin_amdgcn_exp2f(s.y);
    const f32x2 m = v * (q * e), r = v - m;
    f32x2 o; o.x = v.x < 0.f ? m.x : r.x; o.y = v.y < 0.f ? m.y : r.y; return o;
}
template <class Epi, class Sched, bool ALIGN_EPI = false, bool SP2 = false>
__device__ __forceinline__ void gemm_phase(PG8_LAS unsigned char* lds, const Gemm g, const Sched& S, const Epi& E, const int tid) {
    const int wid = __builtin_amdgcn_readfirstlane(tid >> 6), lane = tid & 63, wr = wid >> 2, wc = wid & 3, fr = lane & 15, fq = lane >> 4;
    const int K = g.K, LD = g.ld ? g.ld : g.K, nt = K / BK;
    unsigned voffA[2], voffB[2];
#pragma unroll
    for (int i = 0; i < 2; ++i) { int R, C; stage_rc(tid * 16 + i * 8192, R, C); const int Rb = Epi::PERM ? ((R & ~31) + perm32(R & 31)) : R;
        voffA[i] = (unsigned)(R * LD + C) * 2u; voffB[i] = (unsigned)(Rb * LD + C) * 2u; }
    const size_t kstep = (size_t)(BK * 2);
    const size_t hstep = (size_t)HALF * LD * 2;
    const size_t tstep = 2 * hstep;
    const unsigned ldsw = (unsigned)wid * 1024u;
    const int aoff = lds_byte(wr * 64 + fr, fq * 8), boff = lds_byte(wc * 32 + fr, fq * 8);
#define PG8_SA(b, h) (((b) * 2 + (h)) * HTB)
#define PG8_SB(b, h) ((4 + (b) * 2 + (h)) * HTB)
#define PG8_STAGE(bufoff, gbase, voff) do { _Pragma("unroll") for (int _i = 0; _i < 2; ++_i) \
        __builtin_amdgcn_global_load_lds((const unsigned*)((const char*)(gbase) + (voff)[_i]), (PG8_LAS unsigned*)(lds + (bufoff) + ldsw + _i * 8192), 16, 0, 0); } while (0)
#define PG8_LDA(dst, b, h) do { _Pragma("unroll") for (int m = 0; m < 4; ++m) _Pragma("unroll") for (int k = 0; k < 2; ++k) dst[m][k] = *(const PG8_LAS bf16x8*)(lds + PG8_SA(b, h) + aoff + m * 2048 + k * 1024); } while (0)
#define PG8_LDB(dst, b, h) do { _Pragma("unroll") for (int n = 0; n < 2; ++n) _Pragma("unroll") for (int k = 0; k < 2; ++k) dst[n][k] = *(const PG8_LAS bf16x8*)(lds + PG8_SB(b, h) + boff + n * 2048 + k * 1024); } while (0)
#define PG8_MMA(ai, bj, At, Bt) do { __builtin_amdgcn_s_setprio(1); _Pragma("unroll") for (int m = 0; m < 4; ++m) _Pragma("unroll") for (int n = 0; n < 2; ++n) _Pragma("unroll") for (int k = 0; k < 2; ++k) \
        acc[ai][bj][m][n] = __builtin_amdgcn_mfma_f32_16x16x32_bf16(Bt[n][k], At[m][k], acc[ai][bj][m][n], 0, 0, 0); __builtin_amdgcn_s_setprio(0); } while (0)
#define PG8_WAIT_V(n) asm volatile("s_waitcnt vmcnt(" #n ")" ::: "memory")
#define PG8_WAIT_L(n) asm volatile("s_waitcnt lgkmcnt(" #n ")" ::: "memory")
#define PG8_BAR __builtin_amdgcn_s_barrier()
#define PG8_SCHED __builtin_amdgcn_sched_barrier(0)
    Unit cur, nxt; int ui = 0;
    if (!S.next(0, cur)) return;
    f32x4 acc[2][2][4][2];
#pragma unroll
    for (int a = 0; a < 2; ++a)
#pragma unroll
        for (int b = 0; b < 2; ++b)
#pragma unroll
            for (int m = 0; m < 4; ++m)
#pragma unroll
                for (int n = 0; n < 2; ++n) acc[a][b][m][n] = (f32x4){0.f, 0.f, 0.f, 0.f};
    bf16x8 At[4][2], B0[2][2], B1[2][2];
    const char* cA = (const char*)g.A + (size_t)cur.pm * tstep; const char* cB = (const char*)g.Bt + (size_t)cur.pn * tstep;
    S.a_ready(cur);
    if constexpr (SP2) {
        PG8_STAGE(PG8_SB(0, 0), cB, voffB); PG8_STAGE(PG8_SB(0, 1), cB + hstep, voffB); PG8_STAGE(PG8_SA(0, 0), cA, voffA); PG8_STAGE(PG8_SA(0, 1), cA + hstep, voffA);
        if (wr == 1) PG8_BAR;
        PG8_WAIT_V(2); PG8_BAR;
        PG8_STAGE(PG8_SB(1, 0), cB + kstep, voffB); PG8_STAGE(PG8_SA(1, 0), cA + kstep, voffA); PG8_STAGE(PG8_SB(1, 1), cB + hstep + kstep, voffB);
        PG8_WAIT_V(6); PG8_BAR;
    } else {
        PG8_STAGE(PG8_SB(0, 0), cB, voffB); PG8_STAGE(PG8_SA(0, 0), cA, voffA); PG8_STAGE(PG8_SB(0, 1), cB + hstep, voffB); PG8_STAGE(PG8_SA(0, 1), cA + hstep, voffA);
        if (wr == 1) PG8_BAR;
        PG8_WAIT_V(4); PG8_BAR;
        PG8_STAGE(PG8_SB(1, 0), cB + kstep, voffB); PG8_STAGE(PG8_SA(1, 0), cA + kstep, voffA); PG8_STAGE(PG8_SB(1, 1), cB + hstep + kstep, voffB);
        PG8_WAIT_V(6); PG8_BAR;
    }
    for (;;) {
        const bool has_next = S.next(ui + 1, nxt);
        const char* nA = has_next ? (const char*)g.A + (size_t)nxt.pm * tstep : cA; const char* nB = has_next ? (const char*)g.Bt + (size_t)nxt.pn * tstep : cB;
        for (int t = 0; t < nt; t += 2) {
            const bool last = (t == nt - 2);
            const char* a1 = cA + (size_t)(t + 1) * kstep;
            const char* a2 = last ? nA : cA + (size_t)(t + 2) * kstep; const char* b2 = last ? nB : cB + (size_t)(t + 2) * kstep;
            const char* a3 = a2 + kstep; const char* b3 = b2 + kstep;
            if (last && has_next) S.a_ready(nxt);
            if constexpr (SP2) {
            PG8_LDB(B0, 0, 0); PG8_LDB(B1, 0, 1); PG8_SCHED; PG8_LDA(At, 0, 0); PG8_STAGE(PG8_SA(1, 1), a1 + hstep, voffA);
            PG8_WAIT_V(8); PG8_WAIT_L(0); PG8_BAR; PG8_MMA(0, 0, At, B0); PG8_MMA(0, 1, At, B1); PG8_BAR; PG8_SCHED;
            PG8_LDA(At, 0, 1); PG8_STAGE(PG8_SB(0, 0), b2, voffB); PG8_STAGE(PG8_SB(0, 1), b2 + hstep, voffB); PG8_STAGE(PG8_SA(0, 0), a2, voffA);
            PG8_WAIT_V(8); PG8_WAIT_L(0); PG8_BAR; PG8_MMA(1, 0, At, B0); PG8_MMA(1, 1, At, B1); PG8_BAR; PG8_SCHED;
            PG8_LDB(B0, 1, 0); PG8_LDB(B1, 1, 1); PG8_SCHED; PG8_LDA(At, 1, 0); PG8_STAGE(PG8_SA(0, 1), a2 + hstep, voffA);
            PG8_WAIT_V(8); PG8_WAIT_L(0); PG8_BAR; PG8_MMA(0, 0, At, B0); PG8_MMA(0, 1, At, B1); PG8_BAR; PG8_SCHED;
            PG8_LDA(At, 1, 1); PG8_STAGE(PG8_SB(1, 0), b3, voffB); PG8_STAGE(PG8_SB(1, 1), b3 + hstep, voffB); PG8_STAGE(PG8_SA(1, 0), a3, voffA);
            PG8_WAIT_V(8); PG8_WAIT_L(0); PG8_BAR; PG8_MMA(1, 0, At, B0); PG8_MMA(1, 1, At, B1); PG8_BAR; PG8_SCHED;
            } else {
            PG8_LDB(B0, 0, 0); PG8_SCHED; PG8_LDA(At, 0, 0); PG8_STAGE(PG8_SA(1, 1), a1 + hstep, voffA);
            PG8_WAIT_L(8); PG8_BAR; PG8_WAIT_L(0); PG8_MMA(0, 0, At, B0); PG8_BAR; PG8_SCHED;
            PG8_LDB(B1, 0, 1); PG8_STAGE(PG8_SB(0, 0), b2, voffB);
            PG8_BAR; PG8_WAIT_L(0); PG8_MMA(0, 1, At, B1); PG8_BAR;
            PG8_LDA(At, 0, 1); PG8_STAGE(PG8_SA(0, 0), a2, voffA);
            PG8_BAR; PG8_WAIT_L(0); PG8_MMA(1, 0, At, B0); PG8_BAR; PG8_SCHED;
            PG8_STAGE(PG8_SB(0, 1), b2 + hstep, voffB);
            PG8_WAIT_V(6); PG8_BAR; PG8_MMA(1, 1, At, B1); PG8_BAR;
            PG8_LDB(B0, 1, 0); PG8_SCHED; PG8_LDA(At, 1, 0); PG8_STAGE(PG8_SA(0, 1), a2 + hstep, voffA);
            PG8_WAIT_L(8); PG8_BAR; PG8_WAIT_L(0); PG8_MMA(0, 0, At, B0); PG8_BAR; PG8_SCHED;
            PG8_LDB(B1, 1, 1); PG8_STAGE(PG8_SB(1, 0), b3, voffB);
            PG8_BAR; PG8_WAIT_L(0); PG8_MMA(0, 1, At, B1); PG8_BAR;
            PG8_LDA(At, 1, 1); PG8_STAGE(PG8_SA(1, 0), a3, voffA);
            PG8_BAR; PG8_WAIT_L(0); PG8_MMA(1, 0, At, B0); PG8_BAR; PG8_SCHED;
            PG8_STAGE(PG8_SB(1, 1), b3 + hstep, voffB);
            PG8_WAIT_V(6); PG8_BAR; PG8_MMA(1, 1, At, B1); PG8_BAR;
            }
        }
        if constexpr (ALIGN_EPI) { if (wr == 0) PG8_BAR; }
        if constexpr (!Epi::AFTER_DRAIN) { E(acc, cur, wr, wc, fr, fq); S.done(cur); }
        if (!has_next) break;
#pragma unroll
        for (int a = 0; a < 2; ++a)
#pragma unroll
            for (int b = 0; b < 2; ++b)
#pragma unroll
                for (int m = 0; m < 4; ++m)
#pragma unroll
                    for (int n = 0; n < 2; ++n) acc[a][b][m][n] = (f32x4){0.f, 0.f, 0.f, 0.f};
        cur = nxt; cA = nA; cB = nB; ++ui;
        if constexpr (ALIGN_EPI) { if (wr == 1) PG8_BAR; }
    }
    PG8_WAIT_V(0);
    if constexpr (!ALIGN_EPI) { if (wr == 0) PG8_BAR; }
    PG8_BAR;
    if constexpr (Epi::AFTER_DRAIN) { E.fused(acc, cur, wr, wc, fr, fq, lds, wid, lane); S.done(cur); }
#undef PG8_SA
#undef PG8_SB
#undef PG8_STAGE
#undef PG8_LDA
#undef PG8_LDB
#undef PG8_MMA
#undef PG8_WAIT_V
#undef PG8_WAIT_L
#undef PG8_BAR
#undef PG8_SCHED
}
}

#ifndef PG8_SP2
#define PG8_SP2 true
#endif
#ifndef PG8_ALIGN
#define PG8_ALIGN true
#endif

#ifndef MK_CHECK
#define MK_CHECK 0
#endif
#if MK_CHECK == 8
#define MK_CHECK_ROWS MT
#define MK_CHECK_ROW0 MP
#define MK_CHECK_COL0 0
#endif
#if MK_CHECK == 7
#define MK_CHECK_ROWS MT
#define MK_CHECK_ROW0 0
#define MK_CHECK_COL0 768
#endif
#if MK_CHECK == 5
#define MK_CHECK_ROWS MT
#define MK_CHECK_ROW0 0
#define MK_CHECK_COL0 768
#endif
#if MK_CHECK == 4
#define MK_CHECK_ROWS MT
#define MK_CHECK_ROW0 0
#define MK_CHECK_COL0 512
#endif
#if MK_CHECK == 3
#define MK_CHECK_ROWS MP
#define MK_CHECK_ROW0 0
#define MK_CHECK_COL0 256
#endif
#ifndef MK_CHECK_ROWS
#define MK_CHECK_ROWS MP
#define MK_CHECK_ROW0 0
#define MK_CHECK_COL0 0
#endif
#ifndef MK_CHECK_MODE
#define MK_CHECK_MODE 2
#endif
#ifndef MK_CHECK_SEL
#define MK_CHECK_SEL -1
#endif
#ifndef MK_CHECK_TOL
#define MK_CHECK_TOL 0
#endif
#define GAS __attribute__((address_space(1)))
#define LAS __attribute__((address_space(3)))
typedef unsigned short bf16;
typedef unsigned v4u __attribute__((ext_vector_type(4)));
typedef unsigned v2u __attribute__((ext_vector_type(2)));
typedef float f32x4 __attribute__((ext_vector_type(4)));
typedef float f32x2v __attribute__((ext_vector_type(2)));
typedef GAS unsigned gu32;
#define RLX_AGENT __ATOMIC_RELAXED, __HIP_MEMORY_SCOPE_AGENT
#define LDS_WAIT() asm volatile("s_waitcnt lgkmcnt(0)" ::: "memory")
#define VM_WAIT() asm volatile("s_waitcnt vmcnt(0)" ::: "memory")
__device__ __forceinline__ unsigned f2bf(float f) { unsigned u = __builtin_bit_cast(unsigned, f); return (u + 0x7fffu + ((u >> 16) & 1u)) >> 16; }
typedef float f32x2_hw __attribute__((ext_vector_type(2))); typedef __bf16 bf16x2_hw __attribute__((ext_vector_type(2)));
__device__ __forceinline__ unsigned pk2(float lo, float hi) { f32x2_hw v = {lo, hi}; return __builtin_bit_cast(unsigned, __builtin_convertvector(v, bf16x2_hw)); }
__device__ __forceinline__ float bf2f(unsigned short b) { return __builtin_bit_cast(float, (unsigned)b << 16); }
__device__ __forceinline__ float bflo(unsigned w) { return __builtin_bit_cast(float, w << 16); }
__device__ __forceinline__ float bfhi(unsigned w) { return __builtin_bit_cast(float, w & 0xffff0000u); }
__device__ __forceinline__ float sigmoid_f(float x) { return 1.f / (1.f + __expf(-x)); }
__device__ __forceinline__ float silu_f(float x) { return x / (1.f + __expf(-x)); }
__device__ __forceinline__ float gelu_f(float x) { return 0.5f * x * (1.f + erff(x * 0.70710678118654752f)); }
template <int MASK> __device__ __forceinline__ float sx_sum(float v) {
    if (MASK == 32) { auto rr = __builtin_amdgcn_permlane32_swap(__float_as_uint(v), __float_as_uint(v), false, false); return __uint_as_float(rr[0]) + __uint_as_float(rr[1]); }
    return v + __builtin_bit_cast(float, __builtin_amdgcn_ds_swizzle(__builtin_bit_cast(int, v), (MASK << 10) | 0x1f));
}
template <int MASK> __device__ __forceinline__ float sx_max(float v) {
    if (MASK == 32) { auto rr = __builtin_amdgcn_permlane32_swap(__float_as_uint(v), __float_as_uint(v), false, false); return fmaxf(__uint_as_float(rr[0]), __uint_as_float(rr[1])); }
    return fmaxf(v, __builtin_bit_cast(float, __builtin_amdgcn_ds_swizzle(__builtin_bit_cast(int, v), (MASK << 10) | 0x1f)));
}
__device__ __forceinline__ float wave_sum(float v) { v = sx_sum<1>(v); v = sx_sum<2>(v); v = sx_sum<4>(v); v = sx_sum<8>(v); v = sx_sum<16>(v); return sx_sum<32>(v); }
__device__ __forceinline__ float wave_max(float v) { v = sx_max<1>(v); v = sx_max<2>(v); v = sx_max<4>(v); v = sx_max<8>(v); v = sx_max<16>(v); return sx_max<32>(v); }

#define XB_TMO      128
#define XB_XCNT(j)  (256  + 64 * (j))
#define XB_XSUB(j)  (1280 + 64 * (j))
#define XB_XGEN(j)  (2304 + 64 * (j))
#define XB_TOP      3328
#define XB_TOPGEN   3392
#define XCD_BAR_WORDS 3456
#define XB_SPIN_CAP (1u << 18)

__device__ __forceinline__ unsigned xb_ld(unsigned* p)              { return __hip_atomic_load(p, __ATOMIC_RELAXED, __HIP_MEMORY_SCOPE_AGENT); }
__device__ __forceinline__ unsigned xb_add(unsigned* p, unsigned v) { return __hip_atomic_fetch_add(p, v, __ATOMIC_RELAXED, __HIP_MEMORY_SCOPE_AGENT); }
__device__ __forceinline__ unsigned xb_xcc_id() { return (unsigned)__builtin_amdgcn_s_getreg((3 << 11) | 20) & 0xFu; }
#define XB_SPIN(cond, bar) do { unsigned _sp = 0; while (cond) { __builtin_amdgcn_s_sleep(1); \
    if ((++_sp & 255u) == 0u) { if (xb_ld(&(bar)[XB_TMO])) break; if (_sp > XB_SPIN_CAP) { atomicAdd(&(bar)[XB_TMO], 1u); break; } } } } while (0)

struct XcdBarrier {
    unsigned* bar; unsigned x;
    volatile LAS unsigned* st;
};
__device__ __forceinline__ XcdBarrier xcd_barrier_post(unsigned* bar, volatile LAS unsigned* st) {
    XcdBarrier b; b.bar = bar; b.x = xb_xcc_id(); b.st = st;
    if (threadIdx.x == 0) (void)xb_add(&bar[XB_XCNT(b.x)], 1u);
    return b;
}
__device__ __forceinline__ void xcd_barrier_complete(unsigned* bar, unsigned x, unsigned& nloc, unsigned& nx) {
    const unsigned G = gridDim.x * gridDim.y * gridDim.z;
    unsigned sum, cnt, mine, sp = 0u;
    for (;;) {
        sum = 0u; cnt = 0u; mine = 0u;
#pragma unroll
        for (unsigned j = 0; j < 16; ++j) { const unsigned c = xb_ld(&bar[XB_XCNT(j)]); sum += c; cnt += (c > 0u) ? 1u : 0u; mine = (j == x) ? c : mine; }
        if (sum == G) break;
        __builtin_amdgcn_s_sleep(1);
        if ((++sp & 255u) == 0u) { if (xb_ld(&bar[XB_TMO])) break; if (sp > XB_SPIN_CAP) { atomicAdd(&bar[XB_TMO], 1u); break; } }
    }
    nloc = mine > 0u ? mine : 1u; nx = cnt > 0u ? cnt : 1u;
}
__device__ __forceinline__ void xcd_barrier(const XcdBarrier& b, const int tid) {
    asm volatile("s_waitcnt vmcnt(0)" ::: "memory");
    __syncthreads();
    if (tid == 0) {
        unsigned* bar = b.bar;
        __builtin_amdgcn_s_waitcnt(0);
        unsigned nloc = b.st[0], nx = b.st[1];
        if (nloc == 0u) { xcd_barrier_complete(bar, b.x, nloc, nx); b.st[0] = nloc; b.st[1] = nx; }
        const unsigned old = xb_add(&bar[XB_XSUB(b.x)], 1u);
        const unsigned gen = old / nloc;
        if (old + 1u == (gen + 1u) * nloc) {
            __builtin_amdgcn_fence(__ATOMIC_RELEASE, "agent");
            asm volatile("s_waitcnt vmcnt(0)" ::: "memory");
            const unsigned og = xb_add(&bar[XB_TOP], 1u);
            const unsigned tg = og / nx;
            if (og + 1u == (tg + 1u) * nx) xb_add(&bar[XB_TOPGEN], 1u);
            else XB_SPIN(xb_ld(&bar[XB_TOPGEN]) == tg, bar);
            __builtin_amdgcn_fence(__ATOMIC_ACQUIRE, "agent");
            xb_add(&bar[XB_XGEN(b.x)], 1u);
            asm volatile("s_waitcnt vmcnt(0)" ::: "memory");
        } else {
            XB_SPIN(xb_ld(&bar[XB_XGEN(b.x)]) == gen, bar);
            __builtin_amdgcn_fence(__ATOMIC_ACQUIRE, "agent");
            asm volatile("s_waitcnt vmcnt(0)" ::: "memory");
        }
    }
    __syncthreads();
}

constexpr int NWAVES = 8, NTHR = 512;
constexpr int DM = 1024, MP = 16384, MS = 1024, MT = MP + MS, TSEQ = 8192, DIN = 3584, GW = 256;
constexpr int NBP = 2, NBS = 128, NBT = NBP + NBS;
constexpr int NPOOL = 2560, NPAGES = 16, PAGE = 128, PAST = 2048;
constexpr float EPS = 1e-5f;
constexpr float QSCALE = 0.25503486164919736f;
constexpr float ALPHA = 1.4142135623730951f;
constexpr int HG_L = 64, HG_NB = TSEQ / HG_L;
__device__ const double ROPE_INV[16] = {1.0, 0.5623413251903491, 0.31622776601683794, 0.1778279410038923, 0.1, 0.05623413251903491, 0.03162277660168379, 0.01778279410038923,
                                        0.01, 0.005623413251903491, 0.0031622776601683794, 0.0017782794100389228, 0.001, 0.0005623413251903491, 0.00031622776601683794, 0.00017782794100389227};
enum { I_XP = 0, I_XS, I_CK, I_CV, I_SCONV, I_SHGRN, I_PT, I_CP, I_CSM, I_WADA, I_BADA, I_WIN, I_LAMQK, I_ANG, I_SGG, I_SGB, I_WS, I_BS, I_CW, I_CB, I_CNG, I_CNB, I_WPW, I_LB, I_HNG, I_WOUT, I_LNG, I_LNB, N_IN };
constexpr size_t O_YP = 0, O_YS = O_YP + (size_t)MP * DM, O_KP = O_YS + (size_t)MS * DM, O_VP = O_KP + (size_t)2 * MP * GW, O_KS = O_VP + (size_t)2 * MP * GW,
                 O_VS = O_KS + (size_t)2 * MS * GW, O_CH = O_VS + (size_t)2 * MS * GW, O_CP = O_CH + (size_t)2 * MS * GW, O_CS = O_CP + (size_t)2 * NBP * 30 * GW,
                 O_HP = O_CS + (size_t)2 * NBS * 30 * GW, O_HS = O_HP + (size_t)2 * NBP * 4 * 4096, O_END = O_HS + (size_t)2 * NBS * 4 * 4096;
static_assert(O_END == 42432512, "output size");
constexpr size_t MiB = 1u << 20;
constexpr size_t WS_CTL = 0, CTL_ZERO_BYTES = 1 * MiB;
constexpr size_t WS_CS = 1 * MiB;
constexpr size_t WS_MOD = 2 * MiB;
constexpr size_t WS_SC = 6 * MiB;
constexpr size_t WS_SCAL = 7 * MiB;
constexpr size_t WS_WADA = 8 * MiB;
constexpr size_t WS_WIN = 20 * MiB;
constexpr size_t WS_WOUT = 34 * MiB;
constexpr size_t WS_WPW = 38 * MiB;
constexpr size_t WS_WSB = 39 * MiB;
constexpr size_t WS_H = 40 * MiB;
constexpr size_t SEG = 9 * MiB;
constexpr size_t WS_Q = 74 * MiB, WS_K = WS_Q + SEG, WS_V = WS_K + SEG, WS_GA = WS_V + SEG, WS_U = WS_GA + SEG, WS_VN = WS_U + SEG, WS_GB = WS_VN + SEG, WS_GC = WS_GB + SEG,
                 WS_QD = WS_GC + SEG, WS_KD = WS_QD + SEG, WS_VD = WS_KD + SEG, WS_GD = WS_VD + SEG;
constexpr size_t WS_KT = WS_K, WS_VT = WS_V;
constexpr size_t WS_GLU = 182 * MiB;
constexpr size_t WS_LF = 199 * MiB;
constexpr size_t WS_MIX = 216 * MiB;
constexpr size_t WS_R = 250 * MiB;
constexpr size_t WS_Y1 = 318 * MiB;
constexpr size_t WS_SLOC = 386 * MiB;
constexpr size_t WS_DTOT = 402 * MiB;
constexpr size_t WS_Z = 404 * MiB;
constexpr size_t WS_SST = 644 * MiB;
constexpr size_t WS_MIXCHK = 660 * MiB;
constexpr size_t WS_KR = 696 * MiB, WS_VR = 705 * MiB;
constexpr size_t WS_END = 714 * MiB;
constexpr size_t WS_PART = WS_Q;
constexpr int CW_BAR = 4096;
constexpr int CW_FQ = 16384;
constexpr int CW_GQ = 18432, CW_HQ = 18688, CW_SD = 18944;
constexpr int RING_BYTES = 131072, MISC_OFF = RING_BYTES + 320, LDS_BYTES = 147456;

__device__ __forceinline__ int batch_of(int m) { return m < MP ? (m >> 13) : NBP + ((m - MP) >> 3); }
struct Args { const float* in[N_IN]; float* out; unsigned char* ws; int ph_lo, ph_hi; };

#define CAS __attribute__((address_space(4)))
struct Ctx {
    const CAS Args* a; unsigned char* wsb; LAS unsigned char* lds; int tid, lane, wave, G, bid;
    __device__ __forceinline__ int gw() const { return bid * NWAVES + wave; }
    __device__ __forceinline__ int ngw() const { return G * NWAVES; }
    template <class T> __device__ __forceinline__ T* ws(size_t off) const { return (T*)(wsb + off); }
};

__device__ __forceinline__ Ctx launder(const Ctx& C, Args& shadow) {
    Ctx P = C; int t; asm volatile("v_mbcnt_lo_u32_b32 %0, -1, 0\n\tv_mbcnt_hi_u32_b32 %0, -1, %0" : "=v"(t)); t += C.wave * 64; P.tid = t; P.lane = t & 63; P.wave = __builtin_amdgcn_readfirstlane(t >> 6);
    const CAS Args* ka = (const CAS Args*)__builtin_amdgcn_kernarg_segment_ptr(); asm volatile("" : "+s"(ka)); P.a = ka;
    unsigned char* w = ka->ws; asm volatile("" : "+s"(w)); P.wsb = w;
    return P;
}
__device__ __forceinline__ f32x4 ld4(const float* p) { return *(const f32x4*)p; }
__device__ __forceinline__ void st4(float* p, f32x4 v) { *(f32x4*)p = v; }
__device__ __forceinline__ void st_bf4(bf16* p, f32x4 v) { v2u w; w.x = pk2(v.x, v.y); w.y = pk2(v.z, v.w); *(v2u*)p = w; }
__device__ __forceinline__ f32x4 ld_bf4(const bf16* p) { const v2u w = *(const v2u*)p; return (f32x4){bflo(w.x), bfhi(w.x), bflo(w.y), bfhi(w.y)}; }

template <class F> struct EpiF {
    static constexpr bool PERM = false, AFTER_DRAIN = false; F f;
    __device__ __forceinline__ void operator()(const pg8::f32x4 (&acc)[2][2][4][2], const pg8::Unit& u, int wr, int wc, int fr, int fq) const {
#pragma unroll
        for (int ai = 0; ai < 2; ++ai)
#pragma unroll
            for (int m = 0; m < 4; ++m) { const int row = u.pm * 256 + ai * 128 + wr * 64 + m * 16 + fr;
#pragma unroll
                for (int bj = 0; bj < 2; ++bj)
#pragma unroll
                    for (int n = 0; n < 2; ++n) { const int col = u.pn * 256 + bj * 128 + wc * 32 + n * 16 + 4 * fq; f(row, col, acc[ai][bj][m][n]); } }
    }
};

struct EpiResid {
    static constexpr bool PERM = false, AFTER_DRAIN = false;
    const float* xp; const float* xs; const bf16* y1; const float* modg; bf16* R; int l;
    __device__ __forceinline__ void operator()(const pg8::f32x4 (&acc)[2][2][4][2], const pg8::Unit& u, int wr, int wc, int fr, int fq) const {
#pragma unroll
        for (int ai = 0; ai < 2; ++ai)
#pragma unroll
            for (int m = 0; m < 4; ++m) { const int row = u.pm * 256 + ai * 128 + wr * 64 + m * 16 + fr;
                const float* xr = row < MP ? xp + (size_t)row * DM : xs + (size_t)(row - MP) * DM; const bf16* yr = y1 + (size_t)row * DM;
                const float* gr = modg + (size_t)batch_of(row) * 3072; bf16* rr = R + (size_t)row * DM;
#pragma unroll
                for (int bj = 0; bj < 2; ++bj)
#pragma unroll
                    for (int n = 0; n < 2; ++n) { const int col = u.pn * 256 + bj * 128 + wc * 32 + n * 16 + 4 * fq;
                        const f32x4 xv = l == 0 ? ld4(xr + col) : ld_bf4(yr + col);
                        st_bf4(rr + col, xv * ALPHA + ld4(gr + col) * acc[ai][bj][m][n]); }
                asm volatile("" ::: "memory"); }
    }
};

constexpr int OUT_KS = 4, OUT_PIECES = 16 * OUT_KS;
struct PieceOrder {
    int un;
    __device__ __forceinline__ bool next(int i, pg8::Unit& u) const { if (i > 0) return false; u.pm = MP / 256 + (un >> 2); u.pn = un & 3; return true; }
    __device__ __forceinline__ void a_ready(const pg8::Unit&) const {}
    __device__ __forceinline__ void done(const pg8::Unit&) const {}
};
struct EpiPart {
    static constexpr bool PERM = false, AFTER_DRAIN = false;
    float* P;
    __device__ __forceinline__ void operator()(const pg8::f32x4 (&acc)[2][2][4][2], const pg8::Unit& u, int wr, int wc, int fr, int fq) const {
#pragma unroll
        for (int ai = 0; ai < 2; ++ai)
#pragma unroll
            for (int m = 0; m < 4; ++m) { const int row = (u.pm - MP / 256) * 256 + ai * 128 + wr * 64 + m * 16 + fr; float* rr = P + (size_t)row * DM;
#pragma unroll
                for (int bj = 0; bj < 2; ++bj)
#pragma unroll
                    for (int n = 0; n < 2; ++n) { const int col = u.pn * 256 + bj * 128 + wc * 32 + n * 16 + 4 * fq; st4(rr + col, acc[ai][bj][m][n]); } }
    }
};

#define EPI_PIN(ai, m) asm volatile("" : "+v"(acc[ai][0][m][0]), "+v"(acc[ai][0][m][1]), "+v"(acc[ai][1][m][0]), "+v"(acc[ai][1][m][1]) :: "memory")
struct EpiIn {
    static constexpr bool PERM = false, AFTER_DRAIN = false;
    unsigned char* ws; float* out; const float* sgg; const float* sgb; LAS unsigned char* xl; int l;
    template <int ACT> static __device__ __forceinline__ f32x4 act4(f32x4 v) {
        if (ACT == 1) { return (f32x4){silu_f(v.x), silu_f(v.y), silu_f(v.z), silu_f(v.w)}; }
        if (ACT == 2) { const pg8::f32x2 a = pg8::gelu_pk((pg8::f32x2){v.x, v.y}), b = pg8::gelu_pk((pg8::f32x2){v.z, v.w}); return (f32x4){a.x, a.y, b.x, b.y}; }
        return v;
    }
    template <int ACT> __device__ __forceinline__ void plain(pg8::f32x4 (&acc)[2][2][4][2], int row0, int c0, size_t off) const {
        bf16* B = (bf16*)(ws + off);
#pragma unroll
        for (int ai = 0; ai < 2; ++ai)
#pragma unroll
            for (int m = 0; m < 4; ++m) { EPI_PIN(ai, m); bf16* rp = B + (size_t)(row0 + ai * 128 + m * 16) * 256 + c0;
#pragma unroll
                for (int bj = 0; bj < 2; ++bj)
#pragma unroll
                    for (int n = 0; n < 2; ++n) st_bf4(rp + bj * 128 + n * 16, act4<ACT>(acc[ai][bj][m][n]));
                asm volatile("" ::: "memory"); }
    }
    __device__ __forceinline__ void operator()(pg8::f32x4 (&acc)[2][2][4][2], const pg8::Unit& u, int wr, int wc, int fr, int fq) const {
        asm volatile("" : "+v"(fr), "+v"(fq));
        const int T = u.pn;
#define EPI_IDX int fr_ = fr, fq_ = fq; asm volatile("" : "+v"(fr_), "+v"(fq_)); const int row0 = u.pm * 256 + wr * 64 + fr_, c0 = wc * 32 + 4 * fq_; (void)row0; (void)c0
        const bool samp = u.pm >= MP / 256;
#ifndef EPI_MASK
#define EPI_MASK 0xff
#endif
        if ((EPI_MASK & 1) && (T == 0 || T == 1)) {
            EPI_IDX;
            const f32x2v* CS = (const f32x2v*)(ws + WS_CS);
#pragma unroll
            for (int ai = 0; ai < 2; ++ai)
#pragma unroll
                for (int m = 0; m < 4; ++m) { EPI_PIN(ai, m); const int row = row0 + ai * 128 + m * 16; const int r = row - MP;
                    const int pos = samp ? PAST + (r & 7) : (row & (TSEQ - 1));
                    const f32x4 cs0 = *(const f32x4*)(CS + pos * 16 + 4 * fq_), cs1 = *(const f32x4*)(CS + pos * 16 + 4 * fq_ + 2);
                    const f32x4 cosv = (f32x4){cs0.x, cs0.z, cs1.x, cs1.z}, sinv = (f32x4){cs0.y, cs0.w, cs1.y, cs1.w};
#pragma unroll
                    for (int bj = 0; bj < 2; ++bj) { const f32x4 x1 = acc[ai][bj][m][0], x2 = acc[ai][bj][m][1];
                        const f32x4 o1 = x1 * cosv - x2 * sinv, o2 = x2 * cosv + x1 * sinv; const int col = bj * 128 + c0;
                        if (T == 0) { bf16* q = (bf16*)(ws + WS_Q) + (size_t)row * 256 + col; st_bf4(q, o1 * QSCALE); st_bf4(q + 16, o2 * QSCALE); }
                        else { float* ok = out + (samp ? O_KS + ((size_t)l * MS + r) * 256 : O_KP + ((size_t)l * MP + row) * 256) + col; st4(ok, o1); st4(ok + 16, o2);
#if MK_CHECK == 1
                            { bf16* kr = (bf16*)(ws + WS_KR) + (size_t)row * 256 + col; st_bf4(kr, o1); st_bf4(kr + 16, o2); }
#endif
                            if (!samp) { const int t = row & (TSEQ - 1), bh = (row >> 13) * 4 + 2 * bj + (wc >> 1);
                                unsigned char* kt = ws + WS_KT + ((size_t)(bh * 128 + (t >> 6)) * 8192 + (4 * (wc & 1) + (fq_ >> 1)) * 1024 + (t & 63) * 16 + 8 * (fq_ & 1));
                                st_bf4((bf16*)kt, o1); st_bf4((bf16*)(kt + 2048), o2); } } }
                    asm volatile("" ::: "memory"); }
        } else if ((EPI_MASK & 2) && T == 2) {
            EPI_IDX;
#pragma unroll
            for (int ai = 0; ai < 2; ++ai)
#pragma unroll
                for (int m = 0; m < 4; ++m) { EPI_PIN(ai, m); const int row = row0 + ai * 128 + m * 16; const int r = row - MP;
#pragma unroll
                    for (int bj = 0; bj < 2; ++bj)
#pragma unroll
                        for (int n = 0; n < 2; ++n) { const f32x4 v = acc[ai][bj][m][n]; const int col = bj * 128 + n * 16 + c0;
                            st4(out + (samp ? O_VS + ((size_t)l * MS + r) * 256 : O_VP + ((size_t)l * MP + row) * 256) + col, v);
#if MK_CHECK == 1
                            st_bf4((bf16*)(ws + WS_VR) + (size_t)row * 256 + col, v);
#endif
                            if (!samp) { const int t = row & (TSEQ - 1), bh = (row >> 13) * 4 + 2 * bj + (wc >> 1), rw = t & 63;
                                st_bf4((bf16*)(ws + WS_VT + ((size_t)(bh * 128 + (t >> 6)) * 8192 + ((wc & 1) * 4 + (rw >> 4)) * 1024 + (rw & 15) * 64 + 32 * n + 8 * fq_)), v); } }
                    asm volatile("" ::: "memory"); }
        } else if ((EPI_MASK & 4) && T == 3) { EPI_IDX; plain<1>(acc, row0, c0, WS_GA); }
        else if ((EPI_MASK & 8) && T == 4) { EPI_IDX; plain<2>(acc, row0, c0, WS_U); }
        else if ((EPI_MASK & 4) && T == 6) { EPI_IDX; plain<1>(acc, row0, c0, WS_GB); }
        else if ((EPI_MASK & 4) && T == 9) { EPI_IDX; plain<1>(acc, row0, c0, WS_GC); }
        else if ((EPI_MASK & 4) && T == 10) { EPI_IDX; plain<1>(acc, row0, c0, WS_QD); }
        else if ((EPI_MASK & 4) && T == 12) { EPI_IDX; plain<0>(acc, row0, c0, WS_VD); }
        else if ((EPI_MASK & 4) && T == 13) { EPI_IDX; plain<1>(acc, row0, c0, WS_GD); }
        else if ((EPI_MASK & 16) && T == 5) { EPI_IDX; plain<2>(acc, row0, c0, WS_VN);
        } else if ((EPI_MASK & 32) && (T == 7 || T == 8)) {
            EPI_IDX;
#pragma unroll
            for (int ai = 0; ai < 2; ++ai)
#pragma unroll
                for (int m = 0; m < 4; ++m) { EPI_PIN(ai, m); const int row = row0 + ai * 128 + m * 16; const int r = row - MP;
#pragma unroll
                    for (int n = 0; n < 2; ++n) { const f32x4 a = acc[ai][0][m][n], gt = acc[ai][1][m][n]; const int col = (T - 7) * 128 + n * 16 + c0;
                        const f32x4 glu = (f32x4){a.x * sigmoid_f(gt.x), a.y * sigmoid_f(gt.y), a.z * sigmoid_f(gt.z), a.w * sigmoid_f(gt.w)};
                        st4((float*)(ws + WS_GLU) + (size_t)row * 256 + col, glu);
                        if (!samp) { const int t = row & (TSEQ - 1); if (t >= TSEQ - 30) st4(out + O_CP + ((size_t)(l * NBP + (row >> 13)) * 30 + (t - (TSEQ - 30))) * 256 + col, glu); }
                        else st4(out + O_CS + ((size_t)(l * NBS + (r >> 3)) * 30 + 22 + (r & 7)) * 256 + col, glu); }
                    asm volatile("" ::: "memory"); }
        } else if ((EPI_MASK & 64) && T == 11) {
            EPI_IDX;
            const float* lbp = (const float*)(ws + WS_SCAL) + 64;
#pragma unroll
            for (int ai = 0; ai < 2; ++ai)
#pragma unroll
                for (int m = 0; m < 4; ++m) { EPI_PIN(ai, m); const int row = row0 + ai * 128 + m * 16;
#pragma unroll
                    for (int bj = 0; bj < 2; ++bj)
#pragma unroll
                        for (int n = 0; n < 2; ++n) { const int col = bj * 128 + n * 16 + c0; f32x4 lb = (f32x4){0.f, 0.f, 0.f, 0.f}; if (l == 1) lb = ld4(lbp + col);
                            const f32x4 v = acc[ai][bj][m][n]; f32x4 f, lf;
                            f.x = lb.x + (1.f - lb.x) * sigmoid_f(v.x); f.y = lb.y + (1.f - lb.y) * sigmoid_f(v.y); f.z = lb.z + (1.f - lb.z) * sigmoid_f(v.z); f.w = lb.w + (1.f - lb.w) * sigmoid_f(v.w);
                            lf.x = __logf(fmaxf(f.x, 1e-30f)); lf.y = __logf(fmaxf(f.y, 1e-30f)); lf.z = __logf(fmaxf(f.z, 1e-30f)); lf.w = __logf(fmaxf(f.w, 1e-30f));
                            st4((float*)(ws + WS_LF) + (size_t)row * 256 + col, lf); st_bf4((bf16*)(ws + WS_KD) + (size_t)row * 256 + col, 1.f - f); } }
        }
    }
};

template <bool GLU_PERM = false> __device__ __forceinline__ void p0_transpose_item(const float* W, int K, int N, bf16* WT, int row_off, LAS float* scr, int item, int lane) {
    const int nblk = N / 32, kb = item / nblk, nb = item % nblk, k0 = 64 * kb, n0 = 32 * nb;
    int d0 = n0;
    if (GLU_PERM && n0 >= 1792 && n0 < 2304) { const int c = n0 - 1792, part = c >> 8, idx = c & 255; d0 = 1792 + (idx >> 7) * 256 + part * 128 + (idx & 127); }
    float tv[32];
#pragma unroll
    for (int i = 0; i < 32; ++i) tv[i] = W[(size_t)(k0 + 2 * i + (lane >> 5)) * N + n0 + (lane & 31)];
#pragma unroll
    for (int i = 0; i < 32; ++i) scr[(2 * i + (lane >> 5)) * 33 + (lane & 31)] = tv[i];
    LDS_WAIT(); asm volatile("" ::: "memory");
    const int c = lane & 7;
#pragma unroll
    for (int j = 0; j < 4; ++j) { const int n = (lane >> 3) + 8 * j; const LAS float* s = scr + (8 * c) * 33 + n;
        v4u o; o.x = pk2(s[0 * 33], s[1 * 33]); o.y = pk2(s[2 * 33], s[3 * 33]); o.z = pk2(s[4 * 33], s[5 * 33]); o.w = pk2(s[6 * 33], s[7 * 33]);
        *(GAS v4u*)(WT + (size_t)(row_off + d0 + n) * K + k0 + 8 * c) = o; }
    LDS_WAIT(); asm volatile("" ::: "memory");
}
struct TItem { const float* src; bf16* dst; int N, K; };
template <bool GLU_PERM = false> __device__ __forceinline__ TItem p0_titem(const float* W, int K, int N, bf16* WT, int row_off, int item, int lane) {
    const int nblk = N / 32, kb = item / nblk, nb = item % nblk, k0 = 64 * kb, n0 = 32 * nb;
    int d0 = n0;
    if (GLU_PERM && n0 >= 1792 && n0 < 2304) { const int c = n0 - 1792, part = c >> 8, idx = c & 255; d0 = 1792 + (idx >> 7) * 256 + part * 128 + (idx & 127); }
    TItem t; t.src = W + (size_t)(k0 + (lane >> 5)) * N + n0 + (lane & 31); t.dst = WT + (size_t)(row_off + d0) * K + k0; t.N = N; t.K = K; return t;
}
#define P0_TLOAD(T, tv) { _Pragma("unroll") for (int i_ = 0; i_ < 32; ++i_) tv[i_] = (T).src[(size_t)(2 * i_) * (T).N]; }
#define P0_TSTORE(T, tv, scr, lane) { \
    _Pragma("unroll") for (int i_ = 0; i_ < 32; ++i_) (scr)[(2 * i_ + ((lane) >> 5)) * 33 + ((lane) & 31)] = tv[i_]; \
    LDS_WAIT(); asm volatile("" ::: "memory"); \
    { const int c_ = (lane) & 7; \
      _Pragma("unroll") for (int j_ = 0; j_ < 4; ++j_) { const int n_ = ((lane) >> 3) + 8 * j_; const LAS float* s_ = (scr) + (8 * c_) * 33 + n_; \
        v4u o_; o_.x = pk2(s_[0 * 33], s_[1 * 33]); o_.y = pk2(s_[2 * 33], s_[3 * 33]); o_.z = pk2(s_[4 * 33], s_[5 * 33]); o_.w = pk2(s_[6 * 33], s_[7 * 33]); \
        *(GAS v4u*)((T).dst + (size_t)n_ * (T).K + 8 * c_) = o_; } } \
    LDS_WAIT(); asm volatile("" ::: "memory"); }
__device__ __forceinline__ void p0_layer1_weights(const Ctx& C, int widx, int nw) {
    const CAS Args& A = *C.a; LAS float* scr = (LAS float*)(C.lds + C.wave * 12288);
    constexpr int I_IN = 16 * (DIN / 32), I_OUT = 16 * 32, I_PW = 4 * 8;
    for (int it = widx; it < I_IN + I_OUT + I_PW; it += nw) {
        int r = it;
        if (r < I_IN) { p0_transpose_item<true>(A.in[I_WIN] + (size_t)DM * DIN, DM, DIN, C.ws<bf16>(WS_WIN) + (size_t)DIN * DM, 0, scr, r, C.lane); continue; } r -= I_IN;
        if (r < I_OUT) { p0_transpose_item(A.in[I_WOUT] + (size_t)DM * DM, DM, DM, C.ws<bf16>(WS_WOUT) + (size_t)DM * DM, 0, scr, r, C.lane); continue; } r -= I_OUT;
        p0_transpose_item(A.in[I_WPW] + (size_t)256 * 256, 256, 256, C.ws<bf16>(WS_WPW) + (size_t)256 * 256, 0, scr, r, C.lane);
    }
}
template <int PART> __device__ __forceinline__ void p0_prologue(const Ctx& C, int gw, int NGW) {
    const CAS Args& A = *C.a;
    LAS float* scr = (LAS float*)(C.lds + C.wave * 16384);
    constexpr int I_IN = 16 * (DIN / 32), I_OUT = 16 * 32, I_ADA = 16 * 96, I_PW = 4 * 8;
    constexpr int NITEMS = I_IN + I_OUT + I_PW + 2 * I_ADA;
    constexpr int IT_LO = PART == 0 ? I_IN + I_OUT + I_PW : 0, IT_HI = PART == 0 ? NITEMS : I_IN + I_OUT + I_PW;
    auto desc = [&](int it) -> TItem {
        int r = it;
        if (r < I_IN) return p0_titem<true>(A.in[I_WIN], DM, DIN, C.ws<bf16>(WS_WIN), 0, r, C.lane); r -= I_IN;
        if (r < I_OUT) return p0_titem(A.in[I_WOUT], DM, DM, C.ws<bf16>(WS_WOUT), 0, r, C.lane); r -= I_OUT;
        if (r < I_PW) return p0_titem(A.in[I_WPW], 256, 256, C.ws<bf16>(WS_WPW), 0, r, C.lane); r -= I_PW;
        const int l = r >= I_ADA ? 1 : 0; r -= l * I_ADA;
        return p0_titem(A.in[I_WADA] + (size_t)l * DM * 3072, DM, 3072, C.ws<bf16>(WS_WADA), l * 3072, r, C.lane);
    };
    for (int it = IT_LO + gw; it < IT_HI; it += 2 * NGW) {
        const bool two = it + NGW < IT_HI;
        const TItem T0 = desc(it), T1 = desc(two ? it + NGW : it);
        float tv0[32], tv1[32];
        P0_TLOAD(T0, tv0);
        if (two) P0_TLOAD(T1, tv1);
        P0_TSTORE(T0, tv0, scr, C.lane);
        if (two) P0_TSTORE(T1, tv1, scr, C.lane);
    }
    if (PART == 1) {
    { bf16* wsb = C.ws<bf16>(WS_WSB); const float* wsrc = A.in[I_WS];
      for (int idx = gw * 64 + C.lane; idx < 2 * 4 * 128 * 32; idx += NGW * 64) { const int t = (idx >> 5) & 127, s4 = (idx & 31) * 4; f32x4 v = ld4(wsrc + (size_t)idx * 4);
          if (s4 + 0 > t) v.x = 0.f; if (s4 + 1 > t) v.y = 0.f; if (s4 + 2 > t) v.z = 0.f; if (s4 + 3 > t) v.w = 0.f; st_bf4(wsb + (size_t)idx * 4, v); } }
    f32x2v* cs = C.ws<f32x2v>(WS_CS);
    for (int idx = gw * 64 + C.lane; idx < TSEQ * 16; idx += NGW * 64) {
        const int pos = idx >> 4, i = idx & 15;
        const double a = (double)pos * ROPE_INV[i];
        const double n = rint(a * 0.15915494309189535);
        const float r = (float)(a - n * 6.283185307179586);
        cs[idx] = (f32x2v){cosf(r), sinf(r)};
    }
    }
    if (PART == 0) {
    bf16* sc = C.ws<bf16>(WS_SC);
    for (int row = gw; row < 256; row += NGW) {
        const float* src = row < NBP ? A.in[I_CP] + (size_t)row * DM : A.in[I_CSM] + (size_t)(row - NBP) * DM;
#pragma unroll
        for (int j = 0; j < 4; ++j) { const int col = 4 * C.lane + 256 * j; f32x4 v = (f32x4){0.f, 0.f, 0.f, 0.f};
            if (row < NBT) { v = ld4(src + col); v.x = silu_f(v.x); v.y = silu_f(v.y); v.z = silu_f(v.z); v.w = silu_f(v.w); }
            st_bf4(sc + (size_t)row * DM + col, v); }
    }
    }
    if (PART == 1) {
    for (int it = gw; it < 2 * NBS * 22; it += NGW) { const int j = it % 22, lb_ = it / 22;
        st4(A.out + O_CS + ((size_t)lb_ * 30 + j) * 256 + 4 * C.lane, ld4(A.in[I_SCONV] + ((size_t)lb_ * 30 + 8 + j) * 256 + 4 * C.lane)); }
    }
    if (PART == 0 && C.bid == 0 && C.wave == 0) {
        float* scal = C.ws<float>(WS_SCAL);
        const float* lq = A.in[I_LAMQK];
        for (int l = 0; l < 2; ++l) {
            float a = C.lane < 32 ? lq[(l * 4 + 0) * 32 + C.lane] * lq[(l * 4 + 1) * 32 + C.lane] : 0.f;
            float b = C.lane < 32 ? lq[(l * 4 + 2) * 32 + C.lane] * lq[(l * 4 + 3) * 32 + C.lane] : 0.f;
            a = wave_sum(a); b = wave_sum(b);
            const float lam_init = l == 0 ? 0.2f : 0.35550906759096934f;
            if (C.lane == 0) scal[l] = __expf(a) - __expf(b) + lam_init;
        }
        const float* lb = A.in[I_LB];
        for (int c = C.lane; c < 256; c += 64) { const float e0 = __expf(lb[c]), e1 = __expf(lb[256 + c]); scal[64 + c] = e1 / (e0 + e1); }
    }
}


__device__ __forceinline__ const float* xrow_in(const Ctx& C, int l, int m) {
    if (l == 0) return m < MP ? C.a->in[I_XP] + (size_t)m * DM : C.a->in[I_XS] + (size_t)(m - MP) * DM;
    return C.a->in[I_XP];
}
__device__ __forceinline__ void ph_hbuild(const Ctx& C, int l) {
    const float* mod = C.ws<float>(WS_MOD); bf16* H = C.ws<bf16>(WS_H);
    constexpr int HB = 2;
    f32x4 b0[HB][4], b1[HB][4];
    const int rstep = C.ngw();
#define HB_LOAD(dst, mb) do { _Pragma("unroll") for (int i_ = 0; i_ < HB; ++i_) { const int mi_ = (mb) + i_ * rstep; if (mi_ < MT) { const float* xr_ = xrow_in(C, l, mi_); \
        _Pragma("unroll") for (int j_ = 0; j_ < 4; ++j_) dst[i_][j_] = ld4(xr_ + 4 * C.lane + 256 * j_); } } } while (0)
    HB_LOAD(b0, C.gw());
    if (C.gw() + HB * rstep < MT) { HB_LOAD(b1, C.gw() + HB * rstep); }
    for (int m = C.gw(); m < MT; m += HB * rstep) {
        f32x4 use[HB][4];
#pragma unroll
        for (int i = 0; i < HB; ++i)
#pragma unroll
            for (int j = 0; j < 4; ++j) { use[i][j] = b0[i][j]; b0[i][j] = b1[i][j]; }
        if (m + 2 * HB * rstep < MT) { HB_LOAD(b1, m + 2 * HB * rstep); }
#pragma unroll
        for (int i = 0; i < HB; ++i) { const int mi = m + i * rstep;
            if (mi < MT) { const float* md = mod + (size_t)(l * NBT + batch_of(mi)) * 3072;
#pragma unroll
                for (int j = 0; j < 4; ++j) { const int col = 4 * C.lane + 256 * j;
                    const f32x4 sh = ld4(md + col), sc = ld4(md + 1024 + col);
                    st_bf4(H + (size_t)mi * DM + col, use[i][j] * (1.f + sc) + sh); } } }
    }
#undef HB_LOAD
}

#if MK_CHECK == 6
constexpr size_t WS_ALT = 768 * MiB;
__device__ __forceinline__ void ph_post_ref(const Ctx& C, int l) {
    const CAS Args& A = *C.a; const int lane = C.lane, c4 = 4 * lane;
    const float* Z = (const float*)(C.wsb - WS_ALT + WS_Z); const f32x2v* CS = (const f32x2v*)(C.wsb - WS_ALT + WS_CS); const float* scal = (const float*)(C.wsb - WS_ALT + WS_SCAL);
    bf16 *Qb = C.ws<bf16>(WS_Q), *Kb = C.ws<bf16>(WS_K), *Vb = C.ws<bf16>(WS_V), *GA = C.ws<bf16>(WS_GA), *U = C.ws<bf16>(WS_U), *VN = C.ws<bf16>(WS_VN), *GB = C.ws<bf16>(WS_GB),
         *GC = C.ws<bf16>(WS_GC), *QD = C.ws<bf16>(WS_QD), *KD = C.ws<bf16>(WS_KD), *VD = C.ws<bf16>(WS_VD), *GD = C.ws<bf16>(WS_GD);
    float *GLU = C.ws<float>(WS_GLU), *LF = C.ws<float>(WS_LF); float* out = A.out;
    const f32x4 sg_g = ld4(A.in[I_SGG] + l * 256 + c4), sg_b = ld4(A.in[I_SGB] + l * 256 + c4);
    f32x4 lb = (f32x4){0.f, 0.f, 0.f, 0.f}; if (l == 1) lb = ld4(scal + 64 + c4);
    const float sgn = (lane & 4) ? 1.f : -1.f;
    for (int m = C.gw(); m < MT; m += C.ngw()) {
        const float* z = Z + (size_t)m * DIN; const size_t mo = (size_t)m * 256 + c4;
        const bool samp = m >= MP; const int r = m - MP;
        const int pos = samp ? PAST + (r & 7) : (m & (TSEQ - 1));
        float *ok, *ov;
        if (!samp) { const size_t o = ((size_t)l * MP + m) * 256 + c4; ok = out + O_KP + o; ov = out + O_VP + o; }
        else { const size_t o = ((size_t)l * MS + r) * 256 + c4; ok = out + O_KS + o; ov = out + O_VS + o; }
        const f32x4 cs0 = *(const f32x4*)(CS + pos * 16 + 4 * (lane & 3)), cs1 = *(const f32x4*)(CS + pos * 16 + 4 * (lane & 3) + 2);
        const f32x4 cosv = (f32x4){cs0.x, cs0.z, cs1.x, cs1.z}, sinv = (f32x4){cs0.y, cs0.w, cs1.y, cs1.w};
        {
            const f32x4 v = ld4(z + c4); f32x4 p; p.x = __builtin_bit_cast(float, __builtin_amdgcn_ds_swizzle(__builtin_bit_cast(int, v.x), (4 << 10) | 0x1f)); p.y = __builtin_bit_cast(float, __builtin_amdgcn_ds_swizzle(__builtin_bit_cast(int, v.y), (4 << 10) | 0x1f)); p.z = __builtin_bit_cast(float, __builtin_amdgcn_ds_swizzle(__builtin_bit_cast(int, v.z), (4 << 10) | 0x1f)); p.w = __builtin_bit_cast(float, __builtin_amdgcn_ds_swizzle(__builtin_bit_cast(int, v.w), (4 << 10) | 0x1f));
            const f32x4 o = v * cosv + (p * sinv) * sgn; st_bf4(Qb + mo, o * QSCALE);
        }
        {
            const f32x4 v = ld4(z + 256 + c4); f32x4 p; p.x = __builtin_bit_cast(float, __builtin_amdgcn_ds_swizzle(__builtin_bit_cast(int, v.x), (4 << 10) | 0x1f)); p.y = __builtin_bit_cast(float, __builtin_amdgcn_ds_swizzle(__builtin_bit_cast(int, v.y), (4 << 10) | 0x1f)); p.z = __builtin_bit_cast(float, __builtin_amdgcn_ds_swizzle(__builtin_bit_cast(int, v.z), (4 << 10) | 0x1f)); p.w = __builtin_bit_cast(float, __builtin_amdgcn_ds_swizzle(__builtin_bit_cast(int, v.w), (4 << 10) | 0x1f));
            const f32x4 o = v * cosv + (p * sinv) * sgn;
            if (!samp) { const int t = m & (TSEQ - 1), bh = (m >> 13) * 4 + (lane >> 4);
                st_bf4((bf16*)(C.ws<unsigned char>(WS_KT) + ((size_t)(bh * 128 + (t >> 6)) * 8192 + ((lane & 15) >> 1) * 1024 + (t & 63) * 16 + (lane & 1) * 8)), o); }
        }
        { const f32x4 v = ld4(z + 512 + c4);
            if (!samp) { const int t = m & (TSEQ - 1), bh = (m >> 13) * 4 + (lane >> 4), row = t & 63;
                st_bf4((bf16*)(C.ws<unsigned char>(WS_VT) + ((size_t)(bh * 128 + (t >> 6)) * 8192 + ((((lane & 15) >> 3) * 4 + (row >> 4)) * 1024) + (row & 15) * 64 + (lane & 7) * 8)), v); } }
        { const f32x4 v = ld4(z + 768 + c4); st_bf4(GA + mo, (f32x4){silu_f(v.x), silu_f(v.y), silu_f(v.z), silu_f(v.w)}); }
        { const f32x4 v = ld4(z + 1024 + c4); st_bf4(U + mo, (f32x4){gelu_f(v.x), gelu_f(v.y), gelu_f(v.z), gelu_f(v.w)}); }
        { const f32x4 v = ld4(z + 1280 + c4); st_bf4(VN + mo, (f32x4){gelu_f(v.x), gelu_f(v.y), gelu_f(v.z), gelu_f(v.w)}); }
        { const f32x4 v = ld4(z + 1536 + c4); st_bf4(GB + mo, (f32x4){silu_f(v.x), silu_f(v.y), silu_f(v.z), silu_f(v.w)}); }
        {
            const f32x4 a = ld4(z + 1792 + (c4 >> 7) * 256 + (c4 & 127)), g = ld4(z + 1792 + (c4 >> 7) * 256 + 128 + (c4 & 127));
            const f32x4 glu = (f32x4){a.x * sigmoid_f(g.x), a.y * sigmoid_f(g.y), a.z * sigmoid_f(g.z), a.w * sigmoid_f(g.w)};
            st4(GLU + mo, glu);
        }
        { const f32x4 v = ld4(z + 2304 + c4); st_bf4(GC + mo, (f32x4){silu_f(v.x), silu_f(v.y), silu_f(v.z), silu_f(v.w)}); }
        { const f32x4 v = ld4(z + 2560 + c4); st_bf4(QD + mo, (f32x4){silu_f(v.x), silu_f(v.y), silu_f(v.z), silu_f(v.w)}); }
        {
            const f32x4 v = ld4(z + 2816 + c4); f32x4 f, lf;
            f.x = lb.x + (1.f - lb.x) * sigmoid_f(v.x); f.y = lb.y + (1.f - lb.y) * sigmoid_f(v.y); f.z = lb.z + (1.f - lb.z) * sigmoid_f(v.z); f.w = lb.w + (1.f - lb.w) * sigmoid_f(v.w);
            lf.x = __logf(fmaxf(f.x, 1e-30f)); lf.y = __logf(fmaxf(f.y, 1e-30f)); lf.z = __logf(fmaxf(f.z, 1e-30f)); lf.w = __logf(fmaxf(f.w, 1e-30f));
            st4(LF + mo, lf); st_bf4(KD + mo, 1.f - f);
        }
        { const f32x4 v = ld4(z + 3072 + c4); st_bf4(VD + mo, v); }
        { const f32x4 v = ld4(z + 3328 + c4); st_bf4(GD + mo, (f32x4){silu_f(v.x), silu_f(v.y), silu_f(v.z), silu_f(v.w)}); }
    }
}

#endif

__device__ __forceinline__ void sg_unit(const Ctx& C, int l, int u) {
    const CAS Args& A = *C.a; const bf16 *U = C.ws<bf16>(WS_U), *VN = C.ws<bf16>(WS_VN), *GB = C.ws<bf16>(WS_GB); bf16* MIX = C.ws<bf16>(WS_MIX);
    LAS float* vn = (LAS float*)C.lds;
    const int r0 = (u - 128) * 8; const size_t m0 = (size_t)MP + r0;
    {   const int i = C.wave; const f32x4 gam = ld4(A.in[I_SGG] + l * 256 + 4 * C.lane), bet = ld4(A.in[I_SGB] + l * 256 + 4 * C.lane);
        const f32x4 v = ld_bf4(VN + (m0 + i) * 256 + 4 * C.lane);
        const float mean = wave_sum((v.x + v.y) + (v.z + v.w)) * (1.f / 256.f); const f32x4 d = v - mean;
        const float var = wave_sum((d.x * d.x + d.y * d.y) + (d.z * d.z + d.w * d.w)) * (1.f / 256.f);
        const f32x4 y = d * rsqrtf(var + EPS) * gam + bet;
        *(LAS f32x4*)(vn + i * 256 + 4 * C.lane) = y; st4(A.out + O_CH + ((size_t)l * MS + r0 + i) * 256 + 4 * C.lane, y); }
    __syncthreads();
    const int col = C.tid & 255, th = C.tid >> 8, g = col >> 6;
    const float* w = A.in[I_WS] + (size_t)(l * 4 + g) * 128 * 128; const float* bs = A.in[I_BS] + (l * 4 + g) * 128;
    f32x4 wv[4][2]; float bsv[4], uu[4], gg[4];
#pragma unroll
    for (int i = 0; i < 4; ++i) { const int t = th * 4 + i; wv[i][0] = ld4(w + t * 128); wv[i][1] = ld4(w + t * 128 + 4); bsv[i] = bs[t];
        const size_t mo = (m0 + t) * 256 + col; uu[i] = bf2f(U[mo]); gg[i] = bf2f(GB[mo]); }
    float vv[8];
#pragma unroll
    for (int s_ = 0; s_ < 8; ++s_) vv[s_] = vn[s_ * 256 + col];
#pragma unroll
    for (int i = 0; i < 4; ++i) { const int t = th * 4 + i; float acc = 0.f;
#pragma unroll
        for (int s_ = 0; s_ < 8; ++s_) { const float wt = s_ < 4 ? wv[i][0][s_] : wv[i][1][s_ - 4]; acc += (s_ <= t) ? wt * vv[s_] : 0.f; }
        MIX[(m0 + t) * DM + 256 + col] = (bf16)f2bf(uu[i] * (acc + bsv[i]) * gg[i]); }
    __syncthreads();
}

__device__ __forceinline__ void conv_unit(const Ctx& C, int l, int u, bf16* MIX) {
    const CAS Args& A = *C.a; const float* GLU = C.ws<float>(WS_GLU); const bf16* GC = C.ws<bf16>(WS_GC);
    LAS float* Ys = (LAS float*)C.lds;
    const int c = C.tid & 255, rh = C.tid >> 8, r0 = u * 16;
    const float* cw = A.in[I_CW] + (size_t)l * 31 * 256 + c; const float cb = A.in[I_CB][l * 256 + c];
    for (int i = 0; i < 8; ++i) {
        const int rr = rh * 8 + i, m = r0 + rr; float y = cb;
        if (m < MP) { const int t = m & (TSEQ - 1);
            for (int j = 0; j < 31; ++j) { const int tt = t + j - 30; if (tt >= 0) y += cw[j * 256] * GLU[(size_t)(m + j - 30) * 256 + c]; }
        } else { const int r = m - MP, bs = r >> 3, ts = r & 7; const float* sc = A.in[I_SCONV] + (size_t)(l * NBS + bs) * 30 * 256 + c;
            for (int j = 0; j < 31; ++j) { const int tt = ts + j - 30; const float h = tt >= 0 ? GLU[(size_t)(m + j - 30) * 256 + c] : sc[(ts + j) * 256]; y += cw[j * 256] * h; }
        }
        Ys[rr * 256 + c] = y;
    }
    __syncthreads();
    {
        const f32x4 g = ld4(A.in[I_CNG] + l * 256 + 4 * C.lane), b = ld4(A.in[I_CNB] + l * 256 + 4 * C.lane);
        for (int i = 0; i < 2; ++i) { const int rr = C.wave * 2 + i; LAS f32x4* p = (LAS f32x4*)(Ys + rr * 256) + C.lane; f32x4 v = *p;
            const float mean = wave_sum((v.x + v.y) + (v.z + v.w)) * (1.f / 256.f); const f32x4 d = v - mean;
            const float var = wave_sum((d.x * d.x + d.y * d.y) + (d.z * d.z + d.w * d.w)) * (1.f / 256.f);
            f32x4 y = d * rsqrtf(var + EPS) * g + b; y = (f32x4){silu_f(y.x), silu_f(y.y), silu_f(y.z), silu_f(y.w)}; *p = y; }
    }
    __syncthreads();
    {
        float acc[8];
#pragma unroll
        for (int i = 0; i < 8; ++i) acc[i] = 0.f;
        const float* wp = A.in[I_WPW] + (size_t)l * 256 * 256 + c;
        for (int k = 0; k < 256; k += 4) {
            const float w0 = wp[(k + 0) * 256], w1 = wp[(k + 1) * 256], w2 = wp[(k + 2) * 256], w3 = wp[(k + 3) * 256];
#pragma unroll
            for (int i = 0; i < 8; ++i) { const f32x4 y = *(const LAS f32x4*)(Ys + (rh * 8 + i) * 256 + k); acc[i] += y.x * w0 + y.y * w1 + y.z * w2 + y.w * w3; }
        }
#pragma unroll
        for (int i = 0; i < 8; ++i) { const int m = r0 + rh * 8 + i; MIX[(size_t)m * DM + 512 + c] = (bf16)f2bf(acc[i] * bf2f(GC[(size_t)m * 256 + c])); }
    }
    __syncthreads();
}

template <int MODE> __device__ __forceinline__ void hgrn_item(const Ctx& C, int l, int item) {
    const CAS Args& A = *C.a; const int lane = C.lane;
    const float* LF = C.ws<float>(WS_LF); const bf16 *QD = C.ws<bf16>(WS_QD), *KD = C.ws<bf16>(WS_KD), *VD = C.ws<bf16>(WS_VD), *GD = C.ws<bf16>(WS_GD); bf16* MIX = C.ws<bf16>(WS_MIX);
    LAS float* Fs = (LAS float*)(C.lds + C.wave * 12288); LAS float* Ks = Fs + 1024; LAS float* Qs = Fs + 2048;
    int h, m0, ntok; size_t sidx;
    if (MODE == 2) { const int bs = item >> 2; h = item & 3; m0 = MP + bs * 8; ntok = 8; sidx = ((size_t)(l * NBS + bs) * 4 + h) * 4096; }
    else { const int bh = item >> 7, j = item & 127; h = bh & 3; m0 = (bh >> 2) * TSEQ + j * HG_L; ntok = HG_L; sidx = (size_t)item * 4096; }
    float S[64];
    if (MODE == 0) {
#pragma unroll
        for (int k = 0; k < 64; ++k) S[k] = 0.f;
    } else { const float* s0 = MODE == 2 ? A.in[I_SHGRN] + sidx : C.ws<float>(WS_SST) + sidx;
#pragma unroll
        for (int k = 0; k < 64; ++k) S[k] = s0[k * 64 + lane]; }
    const float gn = A.in[I_HNG][l * 64 + lane];
    float lfsum = 0.f;
    for (int c0 = 0; c0 < ntok; c0 += 16) {
        const int nt = (ntok - c0) < 16 ? (ntok - c0) : 16;
        for (int tt = 0; tt < nt; ++tt) { const size_t o = (size_t)(m0 + c0 + tt) * 256 + h * 64 + lane; const float lf = LF[o]; lfsum += lf;
            Fs[tt * 64 + lane] = __expf(lf); Ks[tt * 64 + lane] = bf2f(KD[o]); if (MODE != 0) Qs[tt * 64 + lane] = bf2f(QD[o]); }
        LDS_WAIT();
#pragma unroll 1
        for (int tt = 0; tt < nt; ++tt) {
            const int m = m0 + c0 + tt; const size_t o = (size_t)m * 256 + h * 64 + lane;
            const float vd = bf2f(VD[o]); float oacc = 0.f;
#pragma unroll
            for (int k4 = 0; k4 < 16; ++k4) {
                const f32x4 f = *(const LAS f32x4*)(Fs + tt * 64 + 4 * k4), kd = *(const LAS f32x4*)(Ks + tt * 64 + 4 * k4);
                S[4 * k4 + 0] = f.x * S[4 * k4 + 0] + kd.x * vd; S[4 * k4 + 1] = f.y * S[4 * k4 + 1] + kd.y * vd;
                S[4 * k4 + 2] = f.z * S[4 * k4 + 2] + kd.z * vd; S[4 * k4 + 3] = f.w * S[4 * k4 + 3] + kd.w * vd;
                if (MODE != 0) { const f32x4 q = *(const LAS f32x4*)(Qs + tt * 64 + 4 * k4);
                    oacc += S[4 * k4 + 0] * q.x + S[4 * k4 + 1] * q.y + S[4 * k4 + 2] * q.z + S[4 * k4 + 3] * q.w; }
            }
            if (MODE != 0) { const float ss = wave_sum(oacc * oacc) * (1.f / 64.f);
                const float on = oacc * rsqrtf(ss + EPS) * gn * bf2f(GD[o]);
                MIX[(size_t)m * DM + 768 + h * 64 + lane] = (bf16)f2bf(on); }
        }
        LDS_WAIT();
    }
    if (MODE == 0) { float* sl = C.ws<float>(WS_SLOC) + sidx;
#pragma unroll
        for (int k = 0; k < 64; ++k) sl[k * 64 + lane] = S[k];
        C.ws<float>(WS_DTOT)[(size_t)item * 64 + lane] = __expf(lfsum); }
    if (MODE == 2) { float* so = A.out + O_HS + sidx;
#pragma unroll
        for (int k = 0; k < 64; ++k) so[k * 64 + lane] = S[k]; }
}
__device__ __forceinline__ void hgrn_scan_unit(const Ctx& C, int l, int u) {
    const int seg = C.tid >> 6, kvl = C.tid & 63, bh = u >> 6, kv = (u & 63) * 64 + kvl, k = kv >> 6;
    const float* sl = C.ws<float>(WS_SLOC) + ((size_t)bh * HG_NB + seg * 16) * 4096 + kv; float* ss = C.ws<float>(WS_SST) + ((size_t)bh * HG_NB + seg * 16) * 4096 + kv;
    const float* dt = C.ws<float>(WS_DTOT) + ((size_t)bh * HG_NB + seg * 16) * 64 + k;
    LAS f32x2v* X = (LAS f32x2v*)C.lds;
    float a[16], d[16];
#pragma unroll
    for (int j = 0; j < 16; ++j) { a[j] = sl[(size_t)j * 4096]; d[j] = dt[j * 64]; }
    float D = 1.f, Acc = 0.f;
#pragma unroll
    for (int j = 0; j < 16; ++j) { Acc = d[j] * Acc + a[j]; D *= d[j]; }
    X[seg * 64 + kvl] = (f32x2v){D, Acc};
    __syncthreads();
    float S = 0.f;
    for (int q = 0; q < seg; ++q) { const f32x2v x = X[q * 64 + kvl]; S = x.x * S + x.y; }
#pragma unroll
    for (int j = 0; j < 16; ++j) { ss[(size_t)j * 4096] = S; S = d[j] * S + a[j]; }
    if (seg == 7) C.a->out[O_HP + ((size_t)l * 8 + bh) * 4096 + kv] = S;
    __syncthreads();
}

__device__ __forceinline__ void attn_unit_naive(const Ctx& C, int l, int u) {
    const CAS Args& A = *C.a; const bf16 *Qb = C.ws<bf16>(WS_Q), *Kb = C.ws<bf16>(WS_KR), *Vb = C.ws<bf16>(WS_VR), *GA = C.ws<bf16>(WS_GA); bf16* MIX = C.ws<bf16>(WS_MIX);
    const int bh = u & 7, qb = 31 - (u >> 3), b = bh >> 2, h = bh & 3;
    const int map = C.tid >> 8, qi = C.tid & 255, t = qb * 256 + qi; const size_t m = (size_t)b * TSEQ + t;
    LAS unsigned* Ksm = (LAS unsigned*)C.lds;
    LAS unsigned* Vsm = (LAS unsigned*)(C.lds + 32768);
    LAS float* O2 = (LAS float*)C.lds;
    float q[32], acc[64];
    { const v4u* qp = (const v4u*)(Qb + m * 256 + h * 64 + map * 32);
#pragma unroll
        for (int i = 0; i < 4; ++i) { const v4u w = qp[i]; q[8 * i] = bflo(w.x); q[8 * i + 1] = bfhi(w.x); q[8 * i + 2] = bflo(w.y); q[8 * i + 3] = bfhi(w.y); q[8 * i + 4] = bflo(w.z); q[8 * i + 5] = bfhi(w.z); q[8 * i + 6] = bflo(w.w); q[8 * i + 7] = bfhi(w.w); } }
#pragma unroll
    for (int d = 0; d < 64; ++d) acc[d] = 0.f;
    float mx = -1e30f, lsum = 0.f;
    for (int kt = 0; kt <= qb; ++kt) {
        __syncthreads();
        for (int p = C.tid; p < 4096; p += NTHR) { const int arr = p >> 11, row = (p >> 3) & 255, pc = p & 7;
            const bf16* src = (arr ? Vb : Kb) + ((size_t)b * TSEQ + kt * 256 + row) * 256 + h * 64 + pc * 8;
            *(LAS v4u*)((arr ? Vsm : Ksm) + row * 32 + pc * 4) = *(const v4u*)src; }
        __syncthreads();
        const int jn = (kt == qb) ? 256 : 256;
#pragma unroll 1
        for (int j = 0; j < jn; ++j) {
            if (kt * 256 + j > t) break;
            const LAS v4u* kp = (const LAS v4u*)(Ksm + j * 32 + map * 16);
            float s = 0.f;
#pragma unroll
            for (int i = 0; i < 4; ++i) { const v4u w = kp[i];
                s += q[8 * i] * bflo(w.x) + q[8 * i + 1] * bfhi(w.x) + q[8 * i + 2] * bflo(w.y) + q[8 * i + 3] * bfhi(w.y) + q[8 * i + 4] * bflo(w.z) + q[8 * i + 5] * bfhi(w.z) + q[8 * i + 6] * bflo(w.w) + q[8 * i + 7] * bfhi(w.w); }
            if (s > mx) { const float sc = exp2f(mx - s); lsum *= sc;
#pragma unroll
                for (int d = 0; d < 64; ++d) acc[d] *= sc;
                mx = s; }
            const float p = exp2f(s - mx); lsum += p;
            const LAS v4u* vp = (const LAS v4u*)(Vsm + j * 32);
#pragma unroll
            for (int i = 0; i < 8; ++i) { const v4u w = vp[i];
                acc[8 * i] += p * bflo(w.x); acc[8 * i + 1] += p * bfhi(w.x); acc[8 * i + 2] += p * bflo(w.y); acc[8 * i + 3] += p * bfhi(w.y);
                acc[8 * i + 4] += p * bflo(w.z); acc[8 * i + 5] += p * bfhi(w.z); acc[8 * i + 6] += p * bflo(w.w); acc[8 * i + 7] += p * bfhi(w.w); }
        }
    }
    __syncthreads();
    const float il = 1.f / lsum;
    if (map == 1) {
#pragma unroll
        for (int d = 0; d < 64; ++d) O2[qi * 65 + d] = acc[d] * il;
    }
    __syncthreads();
    if (map == 0) {
        const float lam = C.ws<float>(WS_SCAL)[l]; const float lam_init = l == 0 ? 0.2f : 0.35550906759096934f;
        float ss = 0.f;
#pragma unroll
        for (int d = 0; d < 64; ++d) { acc[d] = acc[d] * il - lam * O2[qi * 65 + d]; ss += acc[d] * acc[d]; }
        const float rs = rsqrtf(ss * (1.f / 64.f) + EPS) * (1.f - lam_init);
        const float* g = A.in[I_ANG] + l * 64;
#pragma unroll
        for (int d = 0; d < 64; d += 2) { const unsigned ga = *(const unsigned*)(GA + m * 256 + h * 64 + d);
            *(unsigned*)(MIX + m * DM + h * 64 + d) = pk2(acc[d] * rs * g[d] * bflo(ga), acc[d + 1] * rs * g[d + 1] * bfhi(ga)); }
    }
    __syncthreads();
}

namespace fa {
typedef float f32x16 __attribute__((ext_vector_type(16)));
typedef short bf16x8 __attribute__((ext_vector_type(8)));
typedef short s16x4 __attribute__((ext_vector_type(4)));
typedef short v4i16_t __attribute__((ext_vector_type(4)));
typedef float f32x2_t __attribute__((ext_vector_type(2))); typedef __bf16 bf16x2_t __attribute__((ext_vector_type(2)));
constexpr int SLOT = 16384;
constexpr int LDS_WSF = 65536;
constexpr int LDS_EX = 65536 + 4096;
constexpr float THR = 32.f;
__device__ __forceinline__ float max3f(float a, float b, float c) { return __builtin_fmaxf(__builtin_fmaxf(a, b), c); }
__device__ __forceinline__ unsigned cvtpk(float lo, float hi) { f32x2_t v = {lo, hi}; bf16x2_t b = __builtin_convertvector(v, bf16x2_t); return __builtin_bit_cast(unsigned, b); }
__device__ __forceinline__ float half_swap_max(float m) { auto rr = __builtin_amdgcn_permlane32_swap(__float_as_uint(m), __float_as_uint(m), false, false); return __builtin_fmaxf(__uint_as_float(rr[0]), __uint_as_float(rr[1])); }
__device__ __forceinline__ float half_swap_sum(float m) { auto rr = __builtin_amdgcn_permlane32_swap(__float_as_uint(m), __float_as_uint(m), false, false); return __uint_as_float(rr[0]) + __uint_as_float(rr[1]); }
__device__ __forceinline__ float rowmax(const f32x16& p0, const f32x16& p1) {
    float a = max3f(p0[0], p0[1], p1[0]), b = max3f(p0[2], p0[3], p1[1]); a = max3f(a, p1[2], p1[3]);
#pragma unroll
    for (int r = 4; r < 16; r += 4) { a = max3f(a, p0[r], p0[r + 1]); b = max3f(b, p0[r + 2], p0[r + 3]); a = max3f(a, p1[r], p1[r + 1]); b = max3f(b, p1[r + 2], p1[r + 3]); }
    return half_swap_max(__builtin_fmaxf(a, b));
}
__device__ __forceinline__ s16x4 vtr(const LAS unsigned char* p) { return __builtin_bit_cast(s16x4, __builtin_amdgcn_ds_read_tr16_b64_v4i16((LAS v4i16_t*)p)); }
__device__ __forceinline__ void softmax_step(const bool FIRST, f32x16& S0, f32x16& S1, float& m, float& lsum, f32x16 (&O)[2], LAS float* wsf, int r32, int hi, bf16x8 (&pk)[4]) {
    const float rm = rowmax(S0, S1);
    if (FIRST) m = (rm != -INFINITY && fabsf(rm) > THR) ? rm : 0.f;
    else if (__any(rm - m > THR)) {
        const float mn = __builtin_fmaxf(m, rm); const float f = __builtin_amdgcn_exp2f(m - mn); m = mn; lsum *= f;
        if (hi == 0) wsf[r32] = f;
        LDS_WAIT();
#pragma unroll
        for (int g = 0; g < 4; ++g) { const f32x4 fv = *(const LAS f32x4*)(wsf + 8 * g + 4 * hi);
#pragma unroll
            for (int j = 0; j < 4; ++j) { O[0][4 * g + j] *= fv[j]; O[1][4 * g + j] *= fv[j]; } }
        LDS_WAIT();
    }
    float s = 0.f;
    if (__all(m == 0.f)) {
#pragma unroll
        for (int r = 0; r < 16; ++r) { S0[r] = __builtin_amdgcn_exp2f(S0[r]); S1[r] = __builtin_amdgcn_exp2f(S1[r]); s += S0[r] + S1[r]; }
    } else {
#pragma unroll
        for (int r = 0; r < 16; ++r) { S0[r] = __builtin_amdgcn_exp2f(S0[r] - m); S1[r] = __builtin_amdgcn_exp2f(S1[r] - m); s += S0[r] + S1[r]; }
    }
    lsum += s;
    v4u w;
    w.x = cvtpk(S0[0], S0[1]); w.y = cvtpk(S0[2], S0[3]); w.z = cvtpk(S0[4], S0[5]); w.w = cvtpk(S0[6], S0[7]); pk[0] = __builtin_bit_cast(bf16x8, w);
    w.x = cvtpk(S0[8], S0[9]); w.y = cvtpk(S0[10], S0[11]); w.z = cvtpk(S0[12], S0[13]); w.w = cvtpk(S0[14], S0[15]); pk[1] = __builtin_bit_cast(bf16x8, w);
    w.x = cvtpk(S1[0], S1[1]); w.y = cvtpk(S1[2], S1[3]); w.z = cvtpk(S1[4], S1[5]); w.w = cvtpk(S1[6], S1[7]); pk[2] = __builtin_bit_cast(bf16x8, w);
    w.x = cvtpk(S1[8], S1[9]); w.y = cvtpk(S1[10], S1[11]); w.z = cvtpk(S1[12], S1[13]); w.w = cvtpk(S1[14], S1[15]); pk[3] = __builtin_bit_cast(bf16x8, w);
}
__device__ __forceinline__ void cmask(f32x16& p0, f32x16& p1, int krel0, int qrel, int hi) {
    asm volatile("" : "+v"(hi), "+v"(qrel));
#pragma unroll
    for (int r = 0; r < 16; ++r) { const int kv = krel0 + 4 * hi + (r & 3) + 8 * (r >> 2); if (kv > qrel) p0[r] = -INFINITY; if (kv + 32 > qrel) p1[r] = -INFINITY; }
}
#define FA_MFMA(a, b, c) __builtin_amdgcn_mfma_f32_32x32x16_bf16((a), (b), (c), 0, 0, 0)
__device__ __forceinline__ void tile_step(const bool FIRST, const LAS unsigned char* slot, const bf16x8 (&qr)[4], bool band, int krel0, int qrel, int r32, int hi, int lane,
        float& m_a, float& l_a, f32x16 (&Oa)[2], float& m_b, float& l_b, f32x16 (&Ob)[2], LAS float* wsf, const bf16* Kg, const bf16* Vg) {
#if MK_CHECK == 2
    const bf16* kp = Kg + (size_t)r32 * 256 + hi * 8;
#define KFR(off) (*(const bf16x8*)(kp + ((off) >> 10 >> 1) * 16 + (((off) >> 9) & 1) * 32 * 256))
#else
    const LAS unsigned char* kp = slot + hi * 1024 + r32 * 16;
#define KFR(off) (*(const LAS bf16x8*)(kp + (off)))
#endif
    bf16x8 pa[4], pb[4];
    {   f32x16 S0, S1;
        const bf16x8 k00 = KFR(0), k01 = KFR(512), k10 = KFR(2048), k11 = KFR(2048 + 512);
        S0 = FA_MFMA(k00, qr[0], (f32x16{})); S1 = FA_MFMA(k01, qr[0], (f32x16{})); S0 = FA_MFMA(k10, qr[1], S0); S1 = FA_MFMA(k11, qr[1], S1);
        if (band) cmask(S0, S1, krel0, qrel, hi);
        softmax_step(FIRST, S0, S1, m_a, l_a, Oa, wsf, r32, hi, pa);
    }
    asm volatile("" ::: "memory");
    {   f32x16 S0, S1;
        const bf16x8 k00 = KFR(4096), k01 = KFR(4096 + 512), k10 = KFR(6144), k11 = KFR(6144 + 512);
        S0 = FA_MFMA(k00, qr[2], (f32x16{})); S1 = FA_MFMA(k01, qr[2], (f32x16{})); S0 = FA_MFMA(k10, qr[3], S0); S1 = FA_MFMA(k11, qr[3], S1);
        if (band) cmask(S0, S1, krel0, qrel, hi);
        softmax_step(FIRST, S0, S1, m_b, l_b, Ob, wsf + 64, r32, hi, pb);
    }
    asm volatile("" ::: "memory");
    const LAS unsigned char* vp = slot + 8192 + ((lane >> 4) & 1) * 32 + (lane & 3) * 8 + (4 * hi + ((lane & 15) >> 2)) * 64;
#pragma unroll
    for (int d0 = 0; d0 < 2; ++d0)
#pragma unroll
        for (int ks = 0; ks < 4; ++ks) {
#if MK_CHECK == 2
            bf16x8 vf;
#pragma unroll
            for (int j = 0; j < 8; ++j) vf[j] = (short)Vg[(size_t)(16 * ks + 8 * (j >> 2) + 4 * hi + (j & 3)) * 256 + 32 * d0 + r32];
#else
            const s16x4 lo = vtr(vp + d0 * 4096 + ks * 1024), hh = vtr(vp + d0 * 4096 + ks * 1024 + 512);
            const bf16x8 vf = (bf16x8){lo[0], lo[1], lo[2], lo[3], hh[0], hh[1], hh[2], hh[3]};
#endif
            Oa[d0] = FA_MFMA(pa[ks], vf, Oa[d0]); Ob[d0] = FA_MFMA(pb[ks], vf, Ob[d0]);
            if (ks == 3) asm volatile("" ::: "memory");
        }
#undef KFR
}
#define FA_WAITBAR() do { asm volatile("s_waitcnt vmcnt(0) lgkmcnt(0)" ::: "memory"); __builtin_amdgcn_s_barrier(); asm volatile("" ::: "memory"); } while (0)

__device__ __forceinline__ void unit(const Ctx& C, int l, int bh, int y, bf16* MIX) {
    int lane = C.lane; asm volatile("" : "+v"(lane));
    const int wid = C.wave, r32 = lane & 31, hi = lane >> 5, half = wid >> 2, wq = wid & 3;
    const int b = bh >> 2, h = bh & 3; const int q0 = 128 * y, qrel = 32 * wq + r32;
    const size_t rowbase = (size_t)b * TSEQ;
    const bf16* Qw = C.ws<bf16>(WS_Q) + (rowbase + q0 + qrel) * 256 + h * 64;
    const unsigned char* KT = C.ws<unsigned char>(WS_KT) + (size_t)bh * 128 * 8192 + wid * 1024 + lane * 16;
    const unsigned char* VT = C.ws<unsigned char>(WS_VT) + (size_t)bh * 128 * 8192 + wid * 1024 + lane * 16;
    LAS unsigned char* lds = C.lds; LAS float* wsf = (LAS float*)(lds + LDS_WSF) + wid * 128;
    bf16x8 qr[4];
#pragma unroll
    for (int d0 = 0; d0 < 4; ++d0) qr[d0] = *(const bf16x8*)(Qw + d0 * 16 + hi * 8);
    const int nsteps = y + 1;
#define FA_DMA(i) do { _Pragma("unroll") for (int hf_ = 0; hf_ < 2; ++hf_) { const int t_ = 2 * (i) + hf_; LAS unsigned char* d_ = lds + ((((i) & 1) * 2 + hf_) * SLOT) + wid * 1024; \
        __builtin_amdgcn_global_load_lds((const unsigned*)(KT + (size_t)t_ * 8192), (LAS unsigned*)d_, 16, 0, 0); \
        __builtin_amdgcn_global_load_lds((const unsigned*)(VT + (size_t)t_ * 8192), (LAS unsigned*)(d_ + 8192), 16, 0, 0); } } while (0)
    float m_a = 0.f, l_a = 0.f, m_b = 0.f, l_b = 0.f; f32x16 Oa[2], Ob[2];
    Oa[0] = f32x16{}; Oa[1] = f32x16{}; Ob[0] = f32x16{}; Ob[1] = f32x16{};
    FA_DMA(0);
    FA_WAITBAR();
#pragma unroll 1
    for (int i = 0; i < nsteps; ++i) {
        if (i + 1 < nsteps) FA_DMA(i + 1);
        const int t = 2 * i + half; const bool band = t >= 2 * y;
        tile_step(i == 0, lds + ((i & 1) * 2 + half) * SLOT, qr, band, 64 * (t - 2 * y), qrel, r32, hi, lane, m_a, l_a, Oa, m_b, l_b, Ob, wsf,
                  C.ws<bf16>(WS_KR) + (rowbase + (size_t)t * 64) * 256 + h * 64, C.ws<bf16>(WS_VR) + (rowbase + (size_t)t * 64) * 256 + h * 64);
        FA_WAITBAR();
    }
    l_a = half_swap_sum(l_a); l_b = half_swap_sum(l_b);
    LAS f32x4* EX = (LAS f32x4*)(lds + LDS_EX);
    if (hi == 0) EX[wid * 32 + r32] = (f32x4){m_a, l_a, m_b, l_b};
    FA_WAITBAR();
    {   const f32x4 o = EX[(wid ^ 4) * 32 + r32];
        const float lam = C.ws<float>(WS_SCAL)[l];
        const float Ma = __builtin_fmaxf(m_a, o.x), fa_ = __builtin_amdgcn_exp2f(m_a - Ma), fa2 = __builtin_amdgcn_exp2f(o.x - Ma); const float ca = fa_ / (l_a * fa_ + o.y * fa2);
        const float Mb = __builtin_fmaxf(m_b, o.z), fb_ = __builtin_amdgcn_exp2f(m_b - Mb), fb2 = __builtin_amdgcn_exp2f(o.z - Mb); const float cb = -lam * fb_ / (l_b * fb_ + o.w * fb2);
        if (hi == 0) { wsf[r32] = ca; wsf[64 + r32] = cb; }
        LDS_WAIT();
    }
    f32x16 part[2];
#pragma unroll
    for (int g = 0; g < 4; ++g) { const f32x4 fa4 = *(const LAS f32x4*)(wsf + 8 * g + 4 * hi), fb4 = *(const LAS f32x4*)(wsf + 64 + 8 * g + 4 * hi);
#pragma unroll
        for (int j = 0; j < 4; ++j) { part[0][4 * g + j] = Oa[0][4 * g + j] * fa4[j] + Ob[0][4 * g + j] * fb4[j]; part[1][4 * g + j] = Oa[1][4 * g + j] * fa4[j] + Ob[1][4 * g + j] * fb4[j]; } }
    LAS float* XO = (LAS float*)lds + wq * 2048;
    if (half == 1) {
#pragma unroll
        for (int r = 0; r < 16; ++r) { XO[r * 64 + lane] = part[0][r]; XO[(16 + r) * 64 + lane] = part[1][r]; }
    }
    FA_WAITBAR();
    if (half == 0) {
        const float lam_init = l == 0 ? 0.2f : 0.35550906759096934f;
        float ss[16];
#pragma unroll
        for (int r = 0; r < 16; ++r) { part[0][r] += XO[r * 64 + lane]; part[1][r] += XO[(16 + r) * 64 + lane]; ss[r] = part[0][r] * part[0][r] + part[1][r] * part[1][r]; }
#pragma unroll
        for (int r = 0; r < 16; ++r) { ss[r] = sx_sum<1>(ss[r]); ss[r] = sx_sum<2>(ss[r]); ss[r] = sx_sum<4>(ss[r]); ss[r] = sx_sum<8>(ss[r]); ss[r] = sx_sum<16>(ss[r]); }
        const float* g = C.a->in[I_ANG] + l * 64; const float g0 = g[r32], g1 = g[32 + r32];
        const bf16* GA = C.ws<bf16>(WS_GA);
#pragma unroll
        for (int r = 0; r < 16; ++r) { const size_t row = rowbase + q0 + 32 * wq + (r & 3) + 8 * (r >> 2) + 4 * hi;
            const float rs = rsqrtf(ss[r] * (1.f / 64.f) + EPS) * (1.f - lam_init);
            MIX[row * DM + h * 64 + r32] = (bf16)f2bf(part[0][r] * rs * g0 * bf2f(GA[row * 256 + h * 64 + r32]));
            MIX[row * DM + h * 64 + 32 + r32] = (bf16)f2bf(part[1][r] * rs * g1 * bf2f(GA[row * 256 + h * 64 + 32 + r32])); }
    }
    FA_WAITBAR();
#undef FA_DMA
}
}

namespace sgm {
using fa::f32x16; using fa::bf16x8;
constexpr int VT_STRIDE = 272;
__device__ __forceinline__ void unit(const Ctx& C, int l, int chunk, bf16* MIX) {
    const CAS Args& A = *C.a;
    int lane = C.lane; asm volatile("" : "+v"(lane));
    const int r32 = lane & 31, hi = lane >> 5, wid = C.wave, g = wid >> 1, th = wid & 1, tid = wid * 64 + lane;
    const bf16 *U = C.ws<bf16>(WS_U), *VN = C.ws<bf16>(WS_VN), *GB = C.ws<bf16>(WS_GB);
    const size_t m0 = (size_t)chunk * 128;
    LAS unsigned char* VT = C.lds;
    {
        const f32x4 gam = ld4(A.in[I_SGG] + l * 256 + 4 * lane), bet = ld4(A.in[I_SGB] + l * 256 + 4 * lane);
        v2u raw[16];
#pragma unroll
        for (int i = 0; i < 16; ++i) raw[i] = *(const v2u*)(VN + (m0 + wid * 16 + i) * 256 + 4 * lane);
#pragma unroll
        for (int i = 0; i < 16; ++i) { const int s_ = wid * 16 + i; const f32x4 v = (f32x4){bflo(raw[i].x), bfhi(raw[i].x), bflo(raw[i].y), bfhi(raw[i].y)};
            const float mean = wave_sum((v.x + v.y) + (v.z + v.w)) * (1.f / 256.f); const f32x4 d = v - mean;
            const float var = wave_sum((d.x * d.x + d.y * d.y) + (d.z * d.z + d.w * d.w)) * (1.f / 256.f);
            const f32x4 y = d * rsqrtf(var + EPS) * gam + bet;
            LAS unsigned char* p = VT + (4 * lane) * VT_STRIDE + s_ * 2;
            *(LAS unsigned short*)(p) = (unsigned short)f2bf(y.x); *(LAS unsigned short*)(p + VT_STRIDE) = (unsigned short)f2bf(y.y);
            *(LAS unsigned short*)(p + 2 * VT_STRIDE) = (unsigned short)f2bf(y.z); *(LAS unsigned short*)(p + 3 * VT_STRIDE) = (unsigned short)f2bf(y.w); }
    }
    __syncthreads();
    const bf16* Wm = C.ws<bf16>(WS_WSB) + (size_t)(l * 4 + g) * 128 * 128;
    f32x16 acc[2][2];
#pragma unroll
    for (int a = 0; a < 2; ++a) { acc[a][0] = f32x16{}; acc[a][1] = f32x16{}; }
#pragma unroll
    for (int tbi = 0; tbi < 2; ++tbi) {
        const int tb = 2 * th + tbi; const bf16* wrow = Wm + (size_t)(tb * 32 + r32) * 128 + 8 * hi;
        const LAS unsigned char* vb = VT + (g * 64 + r32) * VT_STRIDE + 16 * hi;
        bf16x8 af[8];
#pragma unroll
        for (int ks = 0; ks < 8; ++ks) af[ks] = *(const bf16x8*)(wrow + 16 * ks);
#pragma unroll
        for (int ks = 0; ks < 8; ++ks) { if (ks < 2 * (tb + 1)) {
            const bf16x8 b0 = *(const LAS bf16x8*)(vb + 32 * ks), b1 = *(const LAS bf16x8*)(vb + 32 * VT_STRIDE + 32 * ks);
            acc[tbi][0] = FA_MFMA(af[ks], b0, acc[tbi][0]); acc[tbi][1] = FA_MFMA(af[ks], b1, acc[tbi][1]); } }
    }
    const float* bsv = A.in[I_BS] + (l * 4 + g) * 128;
#pragma unroll
    for (int tbi = 0; tbi < 2; ++tbi)
#pragma unroll
        for (int r = 0; r < 16; ++r) { const int t = (2 * th + tbi) * 32 + (r & 3) + 8 * (r >> 2) + 4 * hi; const float bias = bsv[t];
#pragma unroll
            for (int d0 = 0; d0 < 2; ++d0) { const int col = g * 64 + 32 * d0 + r32; const size_t mo = (m0 + t) * 256 + col;
                MIX[(m0 + t) * DM + 256 + col] = (bf16)f2bf(bf2f(U[mo]) * (acc[tbi][d0][r] + bias) * bf2f(GB[mo])); } }
    __syncthreads();
}
}

namespace cvm {
using fa::f32x16; using fa::bf16x8;
constexpr int Y_OFF = 0, YN_OFF = 65536, YN_STRIDE = 528;
__device__ __forceinline__ void unit(const Ctx& C, int l, int u, bf16* MIX) {
    const CAS Args& A = *C.a;
    int lane = C.lane; asm volatile("" : "+v"(lane));
    const int wid = C.wave, tid = wid * 64 + lane, r32 = lane & 31, hi = lane >> 5;
    const float* GLU = C.ws<float>(WS_GLU); const bf16* GC = C.ws<bf16>(WS_GC);
    LAS float* Y = (LAS float*)(C.lds + Y_OFF); LAS unsigned char* YN = C.lds + YN_OFF;
    const int r0 = u * 64; const bool samp = r0 >= MP;
    {
        const int c = tid & 255, half = tid >> 8;
        float cw[31];
#pragma unroll
        for (int j = 0; j < 31; ++j) cw[j] = A.in[I_CW][(size_t)(l * 31 + j) * 256 + c];
        const float cb = A.in[I_CB][l * 256 + c];
        if (!samp) {
            const int rg = half * 32, m = r0 + rg, t0 = m & (TSEQ - 1);
            float in[62];
#pragma unroll
            for (int k = 0; k < 62; ++k) { const int tt = t0 - 30 + k; in[k] = tt >= 0 ? GLU[(size_t)(m - 30 + k) * 256 + c] : 0.f; }
#pragma unroll
            for (int i = 0; i < 32; ++i) { float y = cb;
#pragma unroll
                for (int j = 0; j < 31; ++j) y += cw[j] * in[i + j];
                Y[(rg + i) * 256 + c] = y; }
        } else {
#pragma unroll 1
            for (int gq = 0; gq < 4; ++gq) {
                const int rg = half * 32 + gq * 8, m = r0 + rg;
                float in[38];
                const int bs = (m - MP) >> 3; const float* sc = A.in[I_SCONV] + (size_t)(l * NBS + bs) * 30 * 256 + c;
#pragma unroll
                for (int k = 0; k < 30; ++k) in[k] = sc[k * 256];
#pragma unroll
                for (int k = 0; k < 8; ++k) in[30 + k] = GLU[(size_t)(m + k) * 256 + c];
#pragma unroll
                for (int i = 0; i < 8; ++i) { float y = cb;
#pragma unroll
                    for (int j = 0; j < 31; ++j) y += cw[j] * in[i + j];
                    Y[(rg + i) * 256 + c] = y; }
            }
        }
    }
    __syncthreads();
    {
        const f32x4 g = ld4(A.in[I_CNG] + l * 256 + 4 * lane), b = ld4(A.in[I_CNB] + l * 256 + 4 * lane);
#pragma unroll
        for (int i4 = 0; i4 < 2; ++i4) { f32x4 v[4]; float sm[4], sq[4];
#pragma unroll
            for (int i = 0; i < 4; ++i) { v[i] = *(const LAS f32x4*)(Y + (wid * 8 + i4 * 4 + i) * 256 + 4 * lane); sm[i] = (v[i].x + v[i].y) + (v[i].z + v[i].w); }
#pragma unroll
            for (int i = 0; i < 4; ++i) sm[i] = sx_sum<1>(sm[i]);
#pragma unroll
            for (int i = 0; i < 4; ++i) sm[i] = sx_sum<2>(sm[i]);
#pragma unroll
            for (int i = 0; i < 4; ++i) sm[i] = sx_sum<4>(sm[i]);
#pragma unroll
            for (int i = 0; i < 4; ++i) sm[i] = sx_sum<8>(sm[i]);
#pragma unroll
            for (int i = 0; i < 4; ++i) sm[i] = sx_sum<16>(sm[i]);
#pragma unroll
            for (int i = 0; i < 4; ++i) { sm[i] = sx_sum<32>(sm[i]) * (1.f / 256.f); v[i] = v[i] - sm[i]; sq[i] = (v[i].x * v[i].x + v[i].y * v[i].y) + (v[i].z * v[i].z + v[i].w * v[i].w); }
#pragma unroll
            for (int i = 0; i < 4; ++i) sq[i] = sx_sum<1>(sq[i]);
#pragma unroll
            for (int i = 0; i < 4; ++i) sq[i] = sx_sum<2>(sq[i]);
#pragma unroll
            for (int i = 0; i < 4; ++i) sq[i] = sx_sum<4>(sq[i]);
#pragma unroll
            for (int i = 0; i < 4; ++i) sq[i] = sx_sum<8>(sq[i]);
#pragma unroll
            for (int i = 0; i < 4; ++i) sq[i] = sx_sum<16>(sq[i]);
#pragma unroll
            for (int i = 0; i < 4; ++i) { const float var = sx_sum<32>(sq[i]) * (1.f / 256.f); f32x4 y = v[i] * rsqrtf(var + EPS) * g + b; y = (f32x4){silu_f(y.x), silu_f(y.y), silu_f(y.z), silu_f(y.w)};
                v2u w; w.x = pk2(y.x, y.y); w.y = pk2(y.z, y.w); *(LAS v2u*)(YN + (wid * 8 + i4 * 4 + i) * YN_STRIDE + 8 * lane) = w; } }
    }
    __syncthreads();
    {
        const int rb = wid & 1, cq = wid >> 1;
        const bf16* WT = C.ws<bf16>(WS_WPW) + (size_t)l * 256 * 256 + (size_t)(cq * 64 + r32) * 256 + 8 * hi;
        const LAS unsigned char* ya = YN + (rb * 32 + r32) * YN_STRIDE + 16 * hi;
        f32x16 acc0 = f32x16{}, acc1 = f32x16{};
#pragma unroll
        for (int kb = 0; kb < 2; ++kb) { bf16x8 b0[8], b1[8];
#pragma unroll
            for (int k8 = 0; k8 < 8; ++k8) { b0[k8] = *(const bf16x8*)(WT + 16 * (8 * kb + k8)); b1[k8] = *(const bf16x8*)(WT + 32 * 256 + 16 * (8 * kb + k8)); }
#pragma unroll
            for (int k8 = 0; k8 < 8; ++k8) { const bf16x8 af = *(const LAS bf16x8*)(ya + 32 * (8 * kb + k8)); acc0 = FA_MFMA(af, b0[k8], acc0); acc1 = FA_MFMA(af, b1[k8], acc1); } }
#pragma unroll
        for (int r = 0; r < 16; ++r) { const size_t m = (size_t)r0 + rb * 32 + (r & 3) + 8 * (r >> 2) + 4 * hi; const int d = cq * 64 + r32;
            MIX[m * DM + 512 + d] = (bf16)f2bf(acc0[r] * bf2f(GC[m * 256 + d]));
            MIX[m * DM + 512 + d + 32] = (bf16)f2bf(acc1[r] * bf2f(GC[m * 256 + d + 32])); }
    }
    __syncthreads();
}
}

namespace hg {
typedef short bf16x8 __attribute__((ext_vector_type(8)));
#define HG_MFMA(a, b, c) __builtin_amdgcn_mfma_f32_16x16x32_bf16((a), (b), (c), 0, 0, 0)
constexpr int RS = 144;
constexpr int O_QE = 0, O_QM = 16 * RS, O_KM = 32 * RS, O_KET = 48 * RS, O_VT = O_KET + 2048, O_AS = O_VT + 2048, WAVE_LDS = 12288;
static_assert(O_AS + 256 <= WAVE_LDS, "hgrn lds");
__device__ __forceinline__ unsigned pk(float a, float b) { return fa::cvtpk(a, b); }
template <int MODE> __device__ __forceinline__ void item(const Ctx& C, int l, int it, bf16* MIX) {
    const CAS Args& A = *C.a;
    int lane = C.lane; asm volatile("" : "+v"(lane));
    const int col = lane & 15, g = lane >> 4;
    const float* LF = C.ws<float>(WS_LF); const bf16 *QD = C.ws<bf16>(WS_QD), *KD = C.ws<bf16>(WS_KD), *VD = C.ws<bf16>(WS_VD), *GD = C.ws<bf16>(WS_GD);
    LAS unsigned char* W = C.lds + C.wave * WAVE_LDS;
    int h, m0, nchunk, ntok; size_t sidx;
    if (MODE == 2) { const int bs = it >> 2; h = it & 3; m0 = MP + bs * 8; nchunk = 1; ntok = 8; sidx = ((size_t)(l * NBS + bs) * 4 + h) * 4096; }
    else { const int bh = it >> 7, j = it & 127; h = bh & 3; m0 = (bh >> 2) * TSEQ + j * HG_L; nchunk = HG_L / 16; ntok = 16; sidx = (size_t)it * 4096; }
    f32x4 S[4][4];
    if (MODE == 0) {
#pragma unroll
        for (int a = 0; a < 4; ++a)
#pragma unroll
            for (int b = 0; b < 4; ++b) S[a][b] = (f32x4){0.f, 0.f, 0.f, 0.f};
    } else { const float* s0 = (MODE == 2 ? A.in[I_SHGRN] : C.ws<float>(WS_SST)) + sidx + (size_t)(4 * g) * 64 + col;
#pragma unroll
        for (int a = 0; a < 4; ++a)
#pragma unroll
            for (int b = 0; b < 4; ++b) { const float* p = s0 + (size_t)(16 * a) * 64 + 16 * b; S[a][b] = (f32x4){p[0], p[64], p[128], p[192]}; } }
    unsigned z0 = 0u; asm volatile("" : "+v"(z0));
    float lftot = 0.f;
    float rlf[16]; unsigned rkq[16]; unsigned rvv[8];
#define HG_LOAD(ch_) do { const size_t o0_ = (size_t)(m0 + (ch_) * 16) * 256 + h * 64 + lane; \
        _Pragma("unroll") for (int t = 0; t < 16; ++t) { const bool ok = t < ntok; rlf[t] = ok ? LF[o0_ + (size_t)t * 256] : 0.f; \
            rkq[t] = ok ? ((unsigned)KD[o0_ + (size_t)t * 256] | (MODE != 0 ? ((unsigned)QD[o0_ + (size_t)t * 256] << 16) : 0u)) : 0u; } \
        _Pragma("unroll") for (int t = 0; t < 16; t += 2) { const unsigned a_ = t < ntok ? (unsigned)VD[o0_ + (size_t)t * 256] : z0, b_ = t + 1 < ntok ? (unsigned)VD[o0_ + (size_t)(t + 1) * 256] : z0; rvv[t >> 1] = a_ | (b_ << 16); } } while (0)
    HG_LOAD(0);
#pragma unroll 1
    for (int ch = 0; ch < nchunk; ++ch) {
        {
            float cum[16], kd[16], q[16]; unsigned vv[8];
#pragma unroll
            for (int t = 0; t < 16; ++t) { cum[t] = rlf[t]; kd[t] = bflo(rkq[t]); q[t] = bfhi(rkq[t]); }
#pragma unroll
            for (int t = 0; t < 8; ++t) vv[t] = rvv[t];
            if (ch + 1 < nchunk) HG_LOAD(ch + 1);
#pragma unroll
            for (int t = 1; t < 16; ++t) cum[t] += cum[t - 1];
            const float cL = cum[15], cm = cum[7]; lftot += cL;
            unsigned ke[8];
#pragma unroll
            for (int t = 0; t < 16; t += 2) ke[t >> 1] = pk(kd[t] * __expf(cL - cum[t]), kd[t + 1] * __expf(cL - cum[t + 1]));
            *(LAS v4u*)(W + O_KET + lane * 32) = (v4u){ke[0], ke[1], ke[2], ke[3]}; *(LAS v4u*)(W + O_KET + lane * 32 + 16) = (v4u){ke[4], ke[5], ke[6], ke[7]};
            *(LAS v4u*)(W + O_VT + lane * 32) = (v4u){vv[0], vv[1], vv[2], vv[3]}; *(LAS v4u*)(W + O_VT + lane * 32 + 16) = (v4u){vv[4], vv[5], vv[6], vv[7]};
            *(LAS float*)(W + O_AS + lane * 4) = __expf(cL);
            if (MODE != 0) {
#pragma unroll
                for (int t = 0; t < 16; ++t) {
                    *(LAS unsigned short*)(W + O_QE + t * RS + lane * 2) = (unsigned short)f2bf(q[t] * __expf(cum[t]));
                    *(LAS unsigned short*)(W + O_QM + t * RS + lane * 2) = (unsigned short)f2bf(q[t] * __expf(cum[t] - cm));
                    *(LAS unsigned short*)(W + O_KM + t * RS + lane * 2) = (unsigned short)f2bf(kd[t] * __expf(cm - cum[t])); }
            }
        }
        LDS_WAIT(); asm volatile("" ::: "memory");
        if (MODE != 0) {
            v2u gdr[4];
            { const size_t mg = ((size_t)m0 + ch * 16 + (col < ntok ? col : 0)) * 256 + h * 64 + 4 * g;
#pragma unroll
              for (int nb = 0; nb < 4; ++nb) gdr[nb] = *(const v2u*)(GD + mg + 16 * nb); }
            f32x4 OT[4];
#pragma unroll
            for (int nb = 0; nb < 4; ++nb) OT[nb] = (f32x4){0.f, 0.f, 0.f, 0.f};
#pragma unroll
            for (int ks = 0; ks < 2; ++ks) {
                const v2u q0 = *(const LAS v2u*)(W + O_QE + col * RS + (32 * ks + 4 * g) * 2), q1 = *(const LAS v2u*)(W + O_QE + col * RS + (32 * ks + 16 + 4 * g) * 2);
                const bf16x8 bq = __builtin_bit_cast(bf16x8, (v4u){q0.x, q0.y, q1.x, q1.y});
#pragma unroll
                for (int nb = 0; nb < 4; ++nb) { const f32x4 s0 = S[2 * ks][nb], s1 = S[2 * ks + 1][nb];
                    const bf16x8 as = __builtin_bit_cast(bf16x8, (v4u){pk(s0.x, s0.y), pk(s0.z, s0.w), pk(s1.x, s1.y), pk(s1.z, s1.w)});
                    OT[nb] = HG_MFMA(as, bq, OT[nb]); }
            }
            f32x4 at = (f32x4){0.f, 0.f, 0.f, 0.f};
#pragma unroll
            for (int ks = 0; ks < 2; ++ks) { const bf16x8 ak = *(const LAS bf16x8*)(W + O_KM + col * RS + (32 * ks + 8 * g) * 2), bq = *(const LAS bf16x8*)(W + O_QM + col * RS + (32 * ks + 8 * g) * 2);
                at = HG_MFMA(ak, bq, at); }
            { const int sb = 4 * g; if (sb + 0 > col) at.x = 0.f; if (sb + 1 > col) at.y = 0.f; if (sb + 2 > col) at.z = 0.f; if (sb + 3 > col) at.w = 0.f; }
            const bf16x8 batt = __builtin_bit_cast(bf16x8, (v4u){pk(at.x, at.y), pk(at.z, at.w), z0, z0});
#pragma unroll
            for (int nb = 0; nb < 4; ++nb) { const v2u v0 = *(const LAS v2u*)(W + O_VT + (16 * nb + col) * 32 + 8 * g);
                OT[nb] = HG_MFMA(__builtin_bit_cast(bf16x8, (v4u){v0.x, v0.y, z0, z0}), batt, OT[nb]); }
            float ss = 0.f;
#pragma unroll
            for (int nb = 0; nb < 4; ++nb) ss += (OT[nb].x * OT[nb].x + OT[nb].y * OT[nb].y) + (OT[nb].z * OT[nb].z + OT[nb].w * OT[nb].w);
            ss = sx_sum<16>(ss); ss = sx_sum<32>(ss);
            const float rs = rsqrtf(ss * (1.f / 64.f) + EPS);
            if (col < ntok) { const size_t m = (size_t)m0 + ch * 16 + col;
#pragma unroll
                for (int nb = 0; nb < 4; ++nb) { const int v = 16 * nb + 4 * g; const f32x4 gn = ld4(A.in[I_HNG] + l * 64 + v); const f32x4 gd = (f32x4){bflo(gdr[nb].x), bfhi(gdr[nb].x), bflo(gdr[nb].y), bfhi(gdr[nb].y)};
                    st_bf4(MIX + m * DM + 768 + h * 64 + v, OT[nb] * rs * gn * gd); } }
        }
        {   bf16x8 ak[4], bv[4];
#pragma unroll
            for (int b = 0; b < 4; ++b) { v4u x = *(const LAS v4u*)(W + O_KET + (16 * b + col) * 32 + 16 * (g & 1)), y = *(const LAS v4u*)(W + O_VT + (16 * b + col) * 32 + 16 * (g & 1));
                if (g >= 2) { x = (v4u){z0, z0, z0, z0}; y = x; } ak[b] = __builtin_bit_cast(bf16x8, x); bv[b] = __builtin_bit_cast(bf16x8, y); }
#pragma unroll
            for (int mb = 0; mb < 4; ++mb) { const f32x4 as = *(const LAS f32x4*)(W + O_AS + (16 * mb + 4 * g) * 4);
#pragma unroll
                for (int nb = 0; nb < 4; ++nb) S[mb][nb] = HG_MFMA(ak[mb], bv[nb], S[mb][nb] * as); }
        }
        LDS_WAIT(); asm volatile("" ::: "memory");
    }
    if (MODE == 0 || MODE == 2) { float* so = (MODE == 0 ? C.ws<float>(WS_SLOC) : A.out + O_HS) + sidx + (size_t)(4 * g) * 64 + col;
#pragma unroll
        for (int a = 0; a < 4; ++a)
#pragma unroll
            for (int b = 0; b < 4; ++b) { float* p = so + (size_t)(16 * a) * 64 + 16 * b; p[0] = S[a][b].x; p[64] = S[a][b].y; p[128] = S[a][b].z; p[192] = S[a][b].w; } }
    if (MODE == 0) C.ws<float>(WS_DTOT)[(size_t)it * 64 + lane] = __expf(lftot);
#undef HG_LOAD
}
}

namespace sa {
using fa::f32x16; using fa::bf16x8; using fa::cvtpk; using fa::max3f; using fa::half_swap_max; using fa::half_swap_sum;
constexpr float THR = 8.f;
__device__ __forceinline__ bf16x8 pack8(const f32x4& a, const f32x4& b) { v4u w; w.x = cvtpk(a.x, a.y); w.y = cvtpk(a.z, a.w); w.z = cvtpk(b.x, b.y); w.w = cvtpk(b.z, b.w); return __builtin_bit_cast(bf16x8, w); }
__device__ __forceinline__ bf16x8 pack8f(const float (&v)[8]) { v4u w; w.x = cvtpk(v[0], v[1]); w.y = cvtpk(v[2], v[3]); w.z = cvtpk(v[4], v[5]); w.w = cvtpk(v[6], v[7]); return __builtin_bit_cast(bf16x8, w); }
struct Raw { f32x4 k[8]; float v[2][2][8]; };
__device__ __forceinline__ void load_tile(Raw& R, const float* krow, const float* vbase, int r32, int hi, const bool extra) {
#pragma unroll
    for (int c = 0; c < 4; ++c) { R.k[2 * c] = ld4(krow + 16 * c + 8 * hi); R.k[2 * c + 1] = ld4(krow + 16 * c + 8 * hi + 4); }
    const int voff = 4 * hi * 256 + r32;
#pragma unroll
    for (int s = 0; s < 2; ++s)
#pragma unroll
        for (int jh = 0; jh < 2; ++jh) { const float* pb = extra ? vbase : vbase + (16 * s + 8 * jh) * 256;
#pragma unroll
            for (int jl = 0; jl < 4; ++jl) { R.v[s][0][4 * jh + jl] = pb[voff + jl * 256]; R.v[s][1][4 * jh + jl] = pb[voff + jl * 256 + 32]; } }
}
struct RawK { f32x4 k[8]; }; struct RawV { f32x4 r[8]; };
__device__ __forceinline__ void load_k(RawK& R, const float* krow, int hi) {
#pragma unroll
    for (int c = 0; c < 4; ++c) { R.k[2 * c] = ld4(krow + 16 * c + 8 * hi); R.k[2 * c + 1] = ld4(krow + 16 * c + 8 * hi + 4); }
}
__device__ __forceinline__ void load_v(RawV& R, const float* vbase, int lane, const bool extra) {
#pragma unroll
    for (int i = 0; i < 8; ++i) { int kv = 4 * i + (lane >> 4); if (extra) kv &= 7; R.r[i] = ld4(vbase + (size_t)kv * 256 + 4 * (lane & 15)); }
}
__device__ __forceinline__ void item(const Ctx& C, int l, int pr, int grp, int part, bf16* MIX) {
    const CAS Args& A = *C.a;
    int lane = C.lane; asm volatile("" : "+v"(lane));
    const int col = lane & 15, g = lane >> 4, bs = pr >> 2, h = pr & 3, wid = C.wave;
    const bf16* Qb = C.ws<bf16>(WS_Q); const int* pt = (const int*)A.in[I_PT] + bs * NPAGES + part * 4;
    const float* ck = A.in[I_CK] + (size_t)l * NPOOL * PAGE * 256 + h * 64; const float* cv = A.in[I_CV] + (size_t)l * NPOOL * PAGE * 256 + h * 64;
    LAS float* wsf = (LAS float*)(C.lds + 65536) + wid * 64;
    LAS float* XM = (LAS float*)(C.lds + 65536 + 2048) + wid * 32;
    LAS float* XO = (LAS float*)C.lds + wid * 1024;
    typedef short bf16x8s __attribute__((ext_vector_type(8)));
    bf16x8s qf[2];
    { const int ts = col & 7; const bf16* qrow = Qb + ((size_t)MP + bs * 8 + ts) * 256 + h * 64 + 8 * g;
      v4u w0 = *(const v4u*)(qrow), w1 = *(const v4u*)(qrow + 32); if (col >= 8) w0 = (v4u){0u, 0u, 0u, 0u}; else w1 = (v4u){0u, 0u, 0u, 0u};
      qf[0] = __builtin_bit_cast(bf16x8s, w0); qf[1] = __builtin_bit_cast(bf16x8s, w1); }
    float m = 0.f, lsum = 0.f; f32x4 O[4];
#pragma unroll
    for (int nb = 0; nb < 4; ++nb) O[nb] = (f32x4){0.f, 0.f, 0.f, 0.f};
    const int ntiles = part == 3 ? 17 : 16;
    const int pg0 = __builtin_amdgcn_readfirstlane(pt[0]), pg1 = __builtin_amdgcn_readfirstlane(pt[1]), pg2 = __builtin_amdgcn_readfirstlane(pt[2]), pg3 = __builtin_amdgcn_readfirstlane(pt[3]);
    auto page_of = [&](int tt) -> int { const int q = tt >> 2; return q == 0 ? pg0 : (q == 1 ? pg1 : (q == 2 ? pg2 : pg3)); };
    struct RK { f32x4 k[8]; }; struct RV { f32x4 r[8]; };
    auto load_k16 = [&](RK& R, int tt) { const bool ex = tt >= 16;
        const float* base = ex ? A.out + O_KS + ((size_t)l * MS + bs * 8) * 256 + h * 64 : ck + ((size_t)page_of(tt) * PAGE + ((tt * 32) & 127)) * 256;
#pragma unroll
        for (int b = 0; b < 2; ++b) { int kv = 16 * b + col; if (ex) kv &= 7; const float* p = base + (size_t)kv * 256 + 8 * g;
#pragma unroll
            for (int ks = 0; ks < 2; ++ks) { R.k[4 * b + 2 * ks] = ld4(p + 32 * ks); R.k[4 * b + 2 * ks + 1] = ld4(p + 32 * ks + 4); } } };
    auto load_v16 = [&](RV& R, int tt) { const bool ex = tt >= 16;
        const float* base = ex ? A.out + O_VS + ((size_t)l * MS + bs * 8) * 256 + h * 64 : cv + ((size_t)page_of(tt) * PAGE + ((tt * 32) & 127)) * 256;
#pragma unroll
        for (int i = 0; i < 8; ++i) { int kv = 4 * i + (lane >> 4); if (ex) kv &= 7; R.r[i] = ld4(base + (size_t)kv * 256 + 4 * (lane & 15)); } };
    RK K0, K1; RV V0, V1;
    load_k16(K0, 0); load_v16(V0, 0); load_k16(K1, 1); load_v16(V1, 1);
    LAS float* VL = (LAS float*)(C.lds + wid * 8192);
    auto step = [&](RK& KR, RV& VR, const int t) {
        f32x4 S0 = (f32x4){0.f, 0.f, 0.f, 0.f}, S1 = S0;
#pragma unroll
        for (int ks = 0; ks < 2; ++ks) { S0 = HG_MFMA(pack8(KR.k[2 * ks], KR.k[2 * ks + 1]), qf[ks], S0); S1 = HG_MFMA(pack8(KR.k[4 + 2 * ks], KR.k[4 + 2 * ks + 1]), qf[ks], S1); }
        asm volatile("" : "+v"(S0), "+v"(S1));
        if (t + 2 < ntiles) load_k16(KR, t + 2);
        if (t == 16) {
            const int ts = col & 7;
#pragma unroll
            for (int i = 0; i < 4; ++i) { if (4 * g + i > ts) S0[i] = -INFINITY; S1[i] = -INFINITY; }
        }
        float rm = __builtin_fmaxf(max3f(S0[0], S0[1], S0[2]), max3f(S0[3], S1[0], S1[1])); rm = max3f(rm, S1[2], S1[3]);
        rm = sx_max<16>(rm); rm = sx_max<32>(rm);
        if (t == 0) m = (rm == -INFINITY) ? 0.f : rm;
        else if (__any(rm - m > THR)) {
            const float mn = __builtin_fmaxf(m, rm); const float f = __builtin_amdgcn_exp2f(m - mn); m = mn; lsum *= f;
            if (g == 0) wsf[col] = f;
            LDS_WAIT();
            const f32x4 fv = *(const LAS f32x4*)(wsf + 4 * g);
#pragma unroll
            for (int nb = 0; nb < 4; ++nb) O[nb] = O[nb] * fv;
            LDS_WAIT();
        }
#pragma unroll
        for (int i = 0; i < 4; ++i) { S0[i] = __builtin_amdgcn_exp2f(S0[i] - m); S1[i] = __builtin_amdgcn_exp2f(S1[i] - m); }
        lsum += ((S0[0] + S0[1]) + (S0[2] + S0[3])) + ((S1[0] + S1[1]) + (S1[2] + S1[3]));
        const bf16x8s pa = __builtin_bit_cast(bf16x8s, (v4u){cvtpk(S0[0], S0[1]), cvtpk(S0[2], S0[3]), cvtpk(S1[0], S1[1]), cvtpk(S1[2], S1[3])});
#pragma unroll
        for (int i = 0; i < 8; ++i) *(LAS f32x4*)(VL + (4 * i + (lane >> 4)) * 64 + 4 * (lane & 15)) = VR.r[i];
        LDS_WAIT(); asm volatile("" ::: "memory");
        if (t + 2 < ntiles) load_v16(VR, t + 2);
        const LAS float* vg = VL + 4 * g * 64 + col;
#pragma unroll
        for (int nb = 0; nb < 4; ++nb) { float a[8];
#pragma unroll
            for (int j = 0; j < 8; ++j) a[j] = vg[((j & 3) + 16 * (j >> 2)) * 64 + 16 * nb];
            O[nb] = HG_MFMA(pa, pack8f(a), O[nb]); }
        asm volatile("" : "+v"(O[0]), "+v"(O[1]), "+v"(O[2]), "+v"(O[3]));
        LDS_WAIT(); asm volatile("" ::: "memory");
    };
#pragma unroll 1
    for (int t = 0; t < ntiles; t += 2) { step(K0, V0, t); if (t + 1 < ntiles) step(K1, V1, t + 1); }
    FA_WAITBAR();
    lsum = sx_sum<16>(lsum); lsum = sx_sum<32>(lsum);
    if (g == 0) { XM[col] = m; XM[16 + col] = lsum; }
#pragma unroll
    for (int nb = 0; nb < 4; ++nb)
#pragma unroll
        for (int i = 0; i < 4; ++i) XO[(4 * g + i) * 64 + 16 * nb + col] = O[nb][i];
    FA_WAITBAR();
    if (part == 0) {
        const LAS float* XMg = (const LAS float*)(C.lds + 65536 + 2048) + grp * 4 * 32; const LAS float* XOg = (const LAS float*)C.lds + grp * 4 * 1024;
        const float lam = C.ws<float>(WS_SCAL)[l]; const float lam_init = l == 0 ? 0.2f : 0.35550906759096934f;
        float o[16];
#pragma unroll
        for (int col = 0; col < 16; ++col) {
            const float m0 = XMg[col], m1 = XMg[32 + col], m2 = XMg[64 + col], m3 = XMg[96 + col];
            const float M = __builtin_fmaxf(__builtin_fmaxf(m0, m1), __builtin_fmaxf(m2, m3));
            const float w0 = __builtin_amdgcn_exp2f(m0 - M), w1 = __builtin_amdgcn_exp2f(m1 - M), w2 = __builtin_amdgcn_exp2f(m2 - M), w3 = __builtin_amdgcn_exp2f(m3 - M);
            const float L = XMg[16 + col] * w0 + XMg[48 + col] * w1 + XMg[80 + col] * w2 + XMg[112 + col] * w3;
            o[col] = (XOg[col * 64 + lane] * w0 + XOg[1024 + col * 64 + lane] * w1 + XOg[2048 + col * 64 + lane] * w2 + XOg[3072 + col * 64 + lane] * w3) / L;
        }
        const float gn = A.in[I_ANG][l * 64 + lane]; const bf16* GA = C.ws<bf16>(WS_GA);
#pragma unroll
        for (int ts = 0; ts < 8; ++ts) { const float oa = o[ts] - lam * o[8 + ts]; const float ss = wave_sum(oa * oa) * (1.f / 64.f);
            const size_t mrow = (size_t)MP + bs * 8 + ts;
            MIX[mrow * DM + h * 64 + lane] = (bf16)f2bf(oa * rsqrtf(ss + EPS) * (1.f - lam_init) * gn * bf2f(GA[mrow * 256 + h * 64 + lane])); }
    }
    FA_WAITBAR();
}
}

__device__ __forceinline__ void attn_sample_item(const Ctx& C, int l, int item, bf16* MIXD) {
    const CAS Args& A = *C.a; const int lane = C.lane;
    const int ts = item & 7, h = (item >> 3) & 3, bs = item >> 5; const size_t m = (size_t)MP + bs * 8 + ts;
    const bf16 *Qb = C.ws<bf16>(WS_Q), *GA = C.ws<bf16>(WS_GA); bf16* MIX = C.ws<bf16>(WS_MIX);
    const int* pt = (const int*)A.in[I_PT] + bs * NPAGES;
    const float* ck = A.in[I_CK] + (size_t)l * NPOOL * PAGE * 256; const float* cv = A.in[I_CV] + (size_t)l * NPOOL * PAGE * 256;
    const float* nk = A.out + O_KS + ((size_t)l * MS + bs * 8) * 256 + h * 64; const float* nv = A.out + O_VS + ((size_t)l * MS + bs * 8) * 256 + h * 64;
    const float lam = C.ws<float>(WS_SCAL)[l]; const float lam_init = l == 0 ? 0.2f : 0.35550906759096934f;
    LAS float* scr = (LAS float*)(C.lds + 98304 + C.wave * 256);
    float mine = 0.f;
#pragma unroll 1
    for (int pass = 0; pass < 4; ++pass) {
        const int map = pass >> 1, dh = pass & 1;
        float q[32], acc[32];
        { const v4u* qp = (const v4u*)(Qb + m * 256 + h * 64 + map * 32);
#pragma unroll
            for (int i = 0; i < 4; ++i) { const v4u w = qp[i]; q[8 * i] = bflo(w.x); q[8 * i + 1] = bfhi(w.x); q[8 * i + 2] = bflo(w.y); q[8 * i + 3] = bfhi(w.y); q[8 * i + 4] = bflo(w.z); q[8 * i + 5] = bfhi(w.z); q[8 * i + 6] = bflo(w.w); q[8 * i + 7] = bfhi(w.w); } }
#pragma unroll
        for (int d = 0; d < 32; ++d) acc[d] = 0.f;
        float mx = -1e30f, lsum = 0.f;
#pragma unroll 1
        for (int kk = lane; kk < PAST + 1 + ts; kk += 64) {
            const float *kr, *vr;
            if (kk < PAST) { const int page = pt[kk >> 7]; const size_t ro = (((size_t)page * PAGE + (kk & 127)) * 4 + h) * 64; kr = ck + ro; vr = cv + ro; }
            else { kr = nk + (size_t)(kk - PAST) * 256; vr = nv + (size_t)(kk - PAST) * 256; }
            float s = 0.f;
#pragma unroll
            for (int i = 0; i < 8; ++i) { const f32x4 w = ld4(kr + map * 32 + 4 * i); s += q[4 * i] * w.x + q[4 * i + 1] * w.y + q[4 * i + 2] * w.z + q[4 * i + 3] * w.w; }
            if (s > mx) { const float sc = exp2f(mx - s); lsum *= sc;
#pragma unroll
                for (int d = 0; d < 32; ++d) acc[d] *= sc;
                mx = s; }
            const float p = exp2f(s - mx); lsum += p;
#pragma unroll
            for (int i = 0; i < 8; ++i) { const f32x4 w = ld4(vr + dh * 32 + 4 * i); acc[4 * i] += p * w.x; acc[4 * i + 1] += p * w.y; acc[4 * i + 2] += p * w.z; acc[4 * i + 3] += p * w.w; }
        }
        const float M = wave_max(mx); const float w = exp2f(mx - M); const float L = wave_sum(lsum * w); const float il = 1.f / L;
        const float coef = map == 0 ? il : -lam * il;
#pragma unroll
        for (int d = 0; d < 32; ++d) { const float r = wave_sum(acc[d] * w) * coef; if (lane == 0) scr[d] = r; }
        LDS_WAIT();
        if ((lane >> 5) == dh) mine += scr[lane & 31];
        LDS_WAIT();
    }
    const float rs = rsqrtf(wave_sum(mine * mine) * (1.f / 64.f) + EPS) * (1.f - lam_init);
    const float o = mine * rs * A.in[I_ANG][l * 64 + lane] * bf2f(GA[m * 256 + h * 64 + lane]);
    MIXD[m * DM + h * 64 + lane] = (bf16)f2bf(o);
}

__device__ __forceinline__ void ph_ln(const Ctx& C, int l) {
    const bf16* R = C.ws<bf16>(WS_R); float* Y = C.a->out; bf16* Y1 = C.ws<bf16>(WS_Y1);
    const float* g = C.a->in[I_LNG] + l * DM; const float* b = C.a->in[I_LNB] + l * DM;
#if MK_CHECK
    const float chk_se = __hip_atomic_load((float*)(C.wsb + WS_CTL) + 64, __ATOMIC_RELAXED, __HIP_MEMORY_SCOPE_AGENT), chk_sa = __hip_atomic_load((float*)(C.wsb + WS_CTL) + 65, __ATOMIC_RELAXED, __HIP_MEMORY_SCOPE_AGENT);
#if MK_CHECK == 6
    float chk_d = 0.f, chk_w = 0.f; int chk_i = 0; { const float* cw_ = (const float*)(C.wsb + WS_CTL) + 64; for (int bi = 0; bi < 14; ++bi) { if (MK_CHECK_SEL >= 0 && bi != MK_CHECK_SEL) continue; const float e_ = __hip_atomic_load(cw_ + 2 * bi, __ATOMIC_RELAXED, __HIP_MEMORY_SCOPE_AGENT), a_ = __hip_atomic_load(cw_ + 2 * bi + 1, __ATOMIC_RELAXED, __HIP_MEMORY_SCOPE_AGENT); const float er_ = sqrtf(e_ / a_); if (er_ > 0.02f) chk_d += 0.25f; if (er_ > chk_w) { chk_w = er_; chk_i = bi; } } chk_d = MK_CHECK_MODE == 0 ? ((chk_w > 0.02f) ? 20.f + 2.f * chk_i + chk_d * 0.1f : 0.f) : (MK_CHECK_MODE == 1 ? chk_d * 8.f : 10.f * chk_w);         (void)chk_se; (void)chk_sa; }
#else
    const float chk_d = 10.f * sqrtf(chk_se / chk_sa);
#endif
#endif
    auto finish = [&](f32x4 (&v)[4], int m) __attribute__((always_inline)) {
        float s = 0.f;
#pragma unroll
        for (int j = 0; j < 4; ++j) s += (v[j].x + v[j].y) + (v[j].z + v[j].w);
        const float mean = wave_sum(s) * (1.f / DM); float s2 = 0.f;
#pragma unroll
        for (int j = 0; j < 4; ++j) { v[j] = v[j] - mean; s2 += (v[j].x * v[j].x + v[j].y * v[j].y) + (v[j].z * v[j].z + v[j].w * v[j].w); }
        const float rstd = rsqrtf(wave_sum(s2) * (1.f / DM) + EPS);
#pragma unroll
        for (int j = 0; j < 4; ++j) { const int col = 4 * C.lane + 256 * j; f32x4 yv = v[j] * rstd * ld4(g + col) + ld4(b + col);
#if MK_CHECK
            if (l == 1) yv.x += chk_d;
#endif
            if (l == 0) st_bf4(Y1 + (size_t)m * DM + col, yv); else st4(Y + (size_t)m * DM + col, yv);
            if (l == 0) { const float* md = C.ws<float>(WS_MOD) + (size_t)(NBT + batch_of(m)) * 3072;
                st_bf4(C.ws<bf16>(WS_H) + (size_t)m * DM + col, yv * (1.f + ld4(md + 1024 + col)) + ld4(md + col)); } }
    };
    constexpr int LNB = 4;
    v2u cur[LNB][4], nxt[LNB][4];
    const int rstep = C.ngw();
#define LN_LOADB(dst, mb) do { _Pragma("unroll") for (int i_ = 0; i_ < LNB; ++i_) { const int mi_ = (mb) + i_ * rstep; if (mi_ < MP) { _Pragma("unroll") for (int j_ = 0; j_ < 4; ++j_) dst[i_][j_] = *(const v2u*)(R + (size_t)mi_ * DM + 4 * C.lane + 256 * j_); } } } while (0)
    LN_LOADB(nxt, C.gw());
    if (C.gw() + LNB * rstep < MP) { LN_LOADB(cur, C.gw() + LNB * rstep); }
#ifndef NO_SLN
    for (int m = MP + C.wave * C.G + C.bid; m < MT; m += C.ngw()) {
        const float* xr = C.a->in[I_XS] + (size_t)(m - MP) * DM; const bf16* yr = C.ws<bf16>(WS_Y1) + (size_t)m * DM;
        const float* gr = C.ws<float>(WS_MOD) + (size_t)l * NBT * 3072 + 2048 + (size_t)batch_of(m) * 3072;
        const float* pp = C.ws<float>(WS_PART) + (size_t)(m - MP) * DM;
        f32x4 v[4];
#pragma unroll
        for (int j = 0; j < 4; ++j) { const int col = 4 * C.lane + 256 * j; f32x4 a = ld4(pp + col);
#pragma unroll
            for (int ks = 1; ks < OUT_KS; ++ks) a = a + ld4(pp + (size_t)ks * MS * DM + col);
            v[j] = (l == 0 ? ld4(xr + col) : ld_bf4(yr + col)) * ALPHA + ld4(gr + col) * a; }
        finish(v, m);
    }
#endif
    {   int m = C.gw(); bool first = true;
        for (; m < MP; m += LNB * rstep) {
            v2u use[LNB][4];
#pragma unroll
            for (int i = 0; i < LNB; ++i)
#pragma unroll
                for (int j = 0; j < 4; ++j) use[i][j] = nxt[i][j];
            if (first) {
#pragma unroll
                for (int i = 0; i < LNB; ++i)
#pragma unroll
                    for (int j = 0; j < 4; ++j) nxt[i][j] = cur[i][j];
                first = false;
                if (m + 2 * LNB * rstep < MP) { LN_LOADB(cur, m + 2 * LNB * rstep); }
            } else {
#pragma unroll
                for (int i = 0; i < LNB; ++i)
#pragma unroll
                    for (int j = 0; j < 4; ++j) nxt[i][j] = cur[i][j];
                if (m + 2 * LNB * rstep < MP) { LN_LOADB(cur, m + 2 * LNB * rstep); }
            }
#pragma unroll
            for (int i = 0; i < LNB; ++i) { const int mi = m + i * rstep;
                if (mi < MP) { f32x4 v[4];
#pragma unroll
                    for (int j = 0; j < 4; ++j) v[j] = (f32x4){bflo(use[i][j].x), bfhi(use[i][j].x), bflo(use[i][j].y), bfhi(use[i][j].y)};
                    finish(v, mi); } }
        }
    }
#undef LN_LOADB
}

constexpr int NPL = 8, NPH = 2 + 2 * NPL;
#ifndef MK_ONE_LAUNCH
#define MK_ONE_LAUNCH 1
#endif
__global__ void __launch_bounds__(NTHR, 2) mk_fwd(Args args) {
    extern __shared__ __attribute__((aligned(16))) unsigned char lds[];
    Ctx C; C.a = (const CAS Args*)__builtin_amdgcn_kernarg_segment_ptr(); C.wsb = args.ws; C.lds = (LAS unsigned char*)lds; C.tid = threadIdx.x; C.lane = C.tid & 63; C.wave = __builtin_amdgcn_readfirstlane(C.tid >> 6); C.G = gridDim.x; C.bid = blockIdx.x;
    volatile LAS unsigned* MISC = (volatile LAS unsigned*)(C.lds + MISC_OFF);
    for (int u = C.tid; u < (LDS_BYTES - RING_BYTES) / 4; u += NTHR) ((LAS unsigned*)(C.lds + RING_BYTES))[u] = 0u;
    __syncthreads();
    XcdBarrier bar; bar.bar = (unsigned*)(args.ws + WS_CTL) + CW_BAR; bar.x = 0; bar.st = nullptr;
    if (MK_ONE_LAUNCH) bar = xcd_barrier_post((unsigned*)(args.ws + WS_CTL) + CW_BAR, MISC + 8);
    const int lo = args.ph_lo, hi = args.ph_hi;
#ifndef MK_MASK
#define MK_MASK 0x3ff
#endif
#define ON(j) ((MK_MASK >> (j)) & 1)
#define IN(k) (lo <= (k) && (k) < hi)
#define SEAM(k) do { if (MK_ONE_LAUNCH && IN(k) && IN((k) + 1)) { const Ctx Pb = launder(C, args); XcdBarrier bb = bar; unsigned* bp_ = (unsigned*)(Pb.wsb + WS_CTL) + CW_BAR; asm volatile("" : "+s"(bp_)); bb.bar = bp_; unsigned bx_ = bar.x; asm volatile("" : "+s"(bx_)); bb.x = bx_; xcd_barrier(bb, Pb.tid); } } while (0)

    if (ON(8) && IN(0)) { const Ctx P = launder(C, args); p0_prologue<0>(P, P.gw(), P.ngw()); } SEAM(0);
    if (ON(9) && IN(1)) {
        const Ctx P = launder(C, args);
        if (P.bid >= 24 || P.G <= 24) { const int sk = P.G > 24 ? 24 : 0; p0_prologue<1>(P, (P.bid - sk) * NWAVES + P.wave, (P.G - sk) * NWAVES); }
        pg8::Gemm g{P.ws<bf16>(WS_SC), P.ws<bf16>(WS_WADA), 256, 6144, DM}; pg8::StaticOrder S; S.init(256, 6144, P.G, P.bid);
        float* mod = P.ws<float>(WS_MOD); const float* bada = P.a->in[I_BADA];
        auto f = [=](int row, int col, const pg8::f32x4& v) { if (row < NBT) { const int l = col >= 3072 ? 1 : 0, j = col - l * 3072; st4(mod + (size_t)(l * NBT + row) * 3072 + j, v + ld4(bada + col)); } };
        EpiF<decltype(f)> E{f};
        pg8::gemm_phase<EpiF<decltype(f)>, pg8::StaticOrder, PG8_ALIGN, PG8_SP2>(P.lds, g, S, E, P.tid);
    } SEAM(1);
#pragma unroll 1
    for (int l = 0; l < 2; ++l) {
        const int pb = 2 + l * NPL;
        if (l == 0) { if (ON(0) && IN(pb + 0)) { const Ctx P = launder(C, args); ph_hbuild(P, l); } SEAM(pb + 0); }
        if (ON(1) && IN(pb + 1)) {
            const Ctx P = launder(C, args);
#if MK_CHECK == 6
            {   pg8::Gemm g0{P.ws<bf16>(WS_H), P.ws<bf16>(WS_WIN) + (size_t)l * DIN * DM, MT, DIN, DM}; pg8::StaticOrder S0; S0.init(MT, DIN, P.G, P.bid);
                float* Z = P.ws<float>(WS_Z);
                auto f = [=](int row, int col, const pg8::f32x4& v) { st4(Z + (size_t)row * DIN + col, v); };
                EpiF<decltype(f)> E0{f};
                pg8::gemm_phase<EpiF<decltype(f)>, pg8::StaticOrder, PG8_ALIGN, PG8_SP2>(P.lds, g0, S0, E0, P.tid);
                xcd_barrier(bar, P.tid);
                Ctx P2 = P; P2.wsb = P.wsb + WS_ALT; ph_post_ref(P2, l);
                xcd_barrier(bar, P.tid);
            }
#endif
            pg8::Gemm g{P.ws<bf16>(WS_H), P.ws<bf16>(WS_WIN) + (size_t)l * DIN * DM, MT, DIN, DM}; pg8::StaticOrder S; S.init(MT, DIN, P.G, P.bid);
            EpiIn E{P.wsb, P.a->out, P.a->in[I_SGG] + l * 256, P.a->in[I_SGB] + l * 256, P.lds + RING_BYTES + 512, l};
            pg8::gemm_phase<EpiIn, pg8::StaticOrder, PG8_ALIGN, PG8_SP2>(P.lds, g, S, E, P.tid);
        } SEAM(pb + 1);
        if (ON(3) && IN(pb + 3)) {
            const Ctx P = launder(C, args);
            if (P.bid < 128) { hg::item<0>(P, l, P.bid * NWAVES + P.wave, nullptr); if (l == 0) p0_layer1_weights(P, P.bid * NWAVES + P.wave, 128 * NWAVES); }
            else cvm::unit(P, l, P.bid - 128, P.ws<bf16>(WS_MIX));
        } SEAM(pb + 3);
        if (ON(4) && IN(pb + 4)) {
            const Ctx P = launder(C, args);
            bf16* fa_dst = P.ws<bf16>(WS_MIX);
            volatile LAS int* qsel = (volatile LAS int*)(P.lds + RING_BYTES + 256);
            unsigned* ctl = (unsigned*)(P.wsb + WS_CTL);
            for (int u = P.bid; u < 512; u += P.G) hgrn_scan_unit(P, l, u);
            asm volatile("s_waitcnt vmcnt(0)" ::: "memory"); __syncthreads();
            if (P.tid == 0) { __builtin_amdgcn_fence(__ATOMIC_RELEASE, "agent"); asm volatile("s_waitcnt vmcnt(0)" ::: "memory"); __hip_atomic_fetch_add(ctl + CW_SD + l * 64, 1u, __ATOMIC_RELAXED, __HIP_MEMORY_SCOPE_AGENT); }
            const bool sample_wg = ((P.bid >> 3) & 3) == 3;
            if (sample_wg) { const int r = (P.bid >> 5) * 8 + (P.bid & 7);
#pragma unroll 1
                for (int p = r; p < 256; p += 64) sa::item(P, l, 2 * p + (P.wave >> 2), P.wave >> 2, P.wave & 3, fa_dst); }
            {   unsigned* fq = ctl + CW_FQ + l * 8 * 64;
#pragma unroll 1
                for (;;) {
                    if (P.tid == 0) { int sel = -1;
                        for (int q = 0; q < 8; ++q) { const int xq = (P.bid + q) & 7; const unsigned idx = __hip_atomic_fetch_add(fq + xq * 64, 1u, __ATOMIC_RELAXED, __HIP_MEMORY_SCOPE_AGENT); if (idx < 64u) { sel = xq * 64 + (63 - (int)idx); break; } }
                        qsel[0] = sel; }
                    __syncthreads();
                    const int sel = qsel[0];
                    __syncthreads();
                    if (sel < 0) break;
                    fa::unit(P, l, sel >> 6, sel & 63, fa_dst);
                }
            }
            {   unsigned* gq = ctl + CW_GQ + l * 64;
#pragma unroll 1
                for (;;) {
                    if (P.tid == 0) { const unsigned idx = __hip_atomic_fetch_add(gq, 1u, __ATOMIC_RELAXED, __HIP_MEMORY_SCOPE_AGENT); qsel[0] = idx < 400u ? (int)idx : -1; }
                    __syncthreads();
                    const int u = qsel[0];
                    __syncthreads();
                    if (u < 0) break;
                    if (u < 144) cvm::unit(P, l, u + 128, fa_dst);
                    else if (u < 272) sgm::unit(P, l, u - 144, fa_dst);
                    else sg_unit(P, l, u - 272 + 128);
                }
            }
            if (P.tid == 0) { unsigned sp = 0; while (__hip_atomic_load(ctl + CW_SD + l * 64, __ATOMIC_RELAXED, __HIP_MEMORY_SCOPE_AGENT) < (unsigned)P.G) { __builtin_amdgcn_s_sleep(2); if (++sp > (1u << 22)) break; }
                __builtin_amdgcn_fence(__ATOMIC_ACQUIRE, "agent"); asm volatile("s_waitcnt vmcnt(0)" ::: "memory"); }
            __syncthreads();
            {   unsigned* hq = ctl + CW_HQ + l * 64;
#pragma unroll 1
                for (;;) {
                    if (P.tid == 0) { const unsigned idx = __hip_atomic_fetch_add(hq, 1u, __ATOMIC_RELAXED, __HIP_MEMORY_SCOPE_AGENT); qsel[0] = idx < 192u ? (int)idx : -1; }
                    __syncthreads();
                    const int u = qsel[0];
                    __syncthreads();
                    if (u < 0) break;
                    if (u < 128) hg::item<1>(P, l, u * NWAVES + P.wave, fa_dst);
                    else hg::item<2>(P, l, (u - 128) * NWAVES + P.wave, fa_dst);
                }
            }
        } SEAM(pb + 4);
        if (ON(6) && IN(pb + 6)) {
            const Ctx P = launder(C, args);
#if MK_CHECK == 8
            {
                for (int u = P.bid; u < 512; u += P.G) attn_sample_item(P, l, u * NWAVES + P.wave, P.ws<bf16>(WS_MIXCHK));
                xcd_barrier(bar, P.tid);
            }
#endif
#if MK_CHECK == 4
            {
                for (int u = P.bid; u < 1088; u += P.G) conv_unit(P, l, u, P.ws<bf16>(WS_MIXCHK));
                xcd_barrier(bar, P.tid);
            }
#endif
#if MK_CHECK == 7
            {
                for (int u = P.bid; u < 128 + 64; u += P.G) { if (u < 128) hg::item<1>(P, l, u * NWAVES + P.wave, P.ws<bf16>(WS_MIXCHK)); else hg::item<2>(P, l, (u - 128) * NWAVES + P.wave, P.ws<bf16>(WS_MIXCHK)); }
                xcd_barrier(bar, P.tid);
            }
#endif
#if MK_CHECK && MK_CHECK != 6
            {   const bf16* A0 = P.ws<bf16>(WS_MIX); const bf16* A1 = P.ws<bf16>(WS_MIXCHK); float se = 0.f, sa = 0.f;
                for (int m = P.gw(); m < MK_CHECK_ROWS; m += P.ngw()) { if (m < MK_CHECK_ROW0) continue; const f32x4 a = ld_bf4(A0 + (size_t)m * DM + MK_CHECK_COL0 + 4 * P.lane), b = ld_bf4(A1 + (size_t)m * DM + MK_CHECK_COL0 + 4 * P.lane);
#pragma unroll
                    for (int j = 0; j < 4; ++j) { const float d = a[j] - b[j]; se += d * d; sa += a[j] * a[j]; } }
                se = wave_sum(se); sa = wave_sum(sa);
                if (P.lane == 0) { atomicAdd((float*)(P.wsb + WS_CTL) + 64, se); atomicAdd((float*)(P.wsb + WS_CTL) + 65, sa); } }
#endif
            pg8::Gemm g{P.ws<bf16>(WS_MIX), P.ws<bf16>(WS_WOUT) + (size_t)l * DM * DM, MP, DM, DM}; pg8::StaticOrder S; S.init(MP, DM, P.G, P.bid);
            EpiResid E{P.a->in[I_XP], P.a->in[I_XS], P.ws<bf16>(WS_Y1), P.ws<float>(WS_MOD) + (size_t)l * NBT * 3072 + 2048, P.ws<bf16>(WS_R), l};
            pg8::gemm_phase<EpiResid, pg8::StaticOrder, PG8_ALIGN, PG8_SP2>(P.lds, g, S, E, P.tid);
#ifndef NO_PCS
#pragma unroll 1
            for (int pc = P.bid; pc < OUT_PIECES; pc += P.G) {
                const Ctx P2 = launder(C, args);
                const int ks = pc >> 4; const size_t ko = (size_t)ks * (DM / OUT_KS);
                pg8::Gemm g2{P2.ws<bf16>(WS_MIX) + ko, P2.ws<bf16>(WS_WOUT) + (size_t)l * DM * DM + ko, MT, DM, DM / OUT_KS, DM}; PieceOrder S2{pc & 15};
                EpiPart E2{P2.ws<float>(WS_PART) + (size_t)ks * MS * DM};
                pg8::gemm_phase<EpiPart, PieceOrder, PG8_ALIGN, PG8_SP2>(P2.lds, g2, S2, E2, P2.tid);
            }
#endif
        } SEAM(pb + 6);
        if (ON(7) && IN(pb + 7)) { const Ctx P = launder(C, args); ph_ln(P, l); } SEAM(pb + 7);
    }
#undef IN
#undef SEAM
}

extern "C" void kernel_launch(void* const* d_in, const int* in_sizes, int n_in, void* d_out, int out_size, void* d_ws, size_t ws_size, hipStream_t stream) {
    static int grid = 0;
    if (grid == 0) {
        if (n_in != N_IN || out_size != (int)O_END || ws_size < WS_END) { fprintf(stderr, "kernel_launch: unexpected shapes (n_in %d out %d ws %zu)\n", n_in, out_size, ws_size); grid = -1; return; }
        int dev = 0, cus = 0, per_cu = 0;
        if (hipGetDevice(&dev) != hipSuccess || hipDeviceGetAttribute(&cus, hipDeviceAttributeMultiprocessorCount, dev) != hipSuccess) { grid = -1; return; }
        if (hipFuncSetAttribute((const void*)mk_fwd, hipFuncAttributeMaxDynamicSharedMemorySize, LDS_BYTES) != hipSuccess) { fprintf(stderr, "kernel_launch: hipFuncSetAttribute failed\n"); grid = -1; return; }
        if (hipOccupancyMaxActiveBlocksPerMultiprocessor(&per_cu, (const void*)mk_fwd, NTHR, LDS_BYTES) != hipSuccess || per_cu < 1) fprintf(stderr, "kernel_launch: occupancy query says %d\n", per_cu);
        (void)hipGetLastError();
        grid = cus;
    }
    if (grid < 0) return;
    if (hipMemsetAsync((char*)d_ws + WS_CTL, 0, CTL_ZERO_BYTES, stream) != hipSuccess) return;
    Args a{};
    for (int i = 0; i < N_IN; ++i) a.in[i] = (const float*)d_in[i];
    a.out = (float*)d_out; a.ws = (unsigned char*)d_ws;
#if MK_ONE_LAUNCH
    a.ph_lo = 0; a.ph_hi = NPH;
    hipLaunchKernelGGL(mk_fwd, dim3(grid), dim3(NTHR), LDS_BYTES, stream, a);
#else
    for (int p = 0; p < NPH; ++p) { a.ph_lo = p; a.ph_hi = p + 1; hipLaunchKernelGGL(mk_fwd, dim3(grid), dim3(NTHR), LDS_BYTES, stream, a); }
#endif
}
```

```cpp
#include <hip/hip_runtime.h>
#include <cstdio>
#include <cstdint>
namespace pg8 {
#define PG8_LAS __attribute__((address_space(3)))
typedef unsigned short bf16_t;
typedef short bf16x8 __attribute__((ext_vector_type(8)));
typedef float f32x4 __attribute__((ext_vector_type(4)));
typedef unsigned u32x4 __attribute__((ext_vector_type(4)));
constexpr int BM = 256, BK = 64, HALF = 128, HTB = HALF * BK * 2  , STAGE_BYTES = 8 * HTB, NXCD = 8, WGM = 8;

__host__ __device__ __forceinline__ int lds_byte(int r, int c) { const int st = (r >> 4) * 2 + (c >> 5), rr = r & 15, cc = c & 31, ob = rr * 64 + cc * 2; return st * 1024 + (ob ^ (((ob >> 9) & 1) << 5)); }
__host__ __device__ __forceinline__ void stage_rc(int b, int& R, int& C) { const int st = b / 1024, sb = b % 1024, swz = sb ^ (((sb >> 9) & 1) << 5); R = (st >> 1) * 16 + swz / 64; C = (st & 1) * 32 + (swz % 64) / 2; }
__host__ __device__ __forceinline__ int perm32(int rho) { const int n = rho >> 4, i = rho & 15; return 8 * (i >> 2) + 4 * n + (i & 3); }

struct Unit { int pm, pn; };
struct Gemm { const bf16_t* A; const bf16_t* Bt; int M, N, K; int ld = 0; };

struct StaticOrder {
    int nM, nN, nwg, G, c;
    __host__ __device__ void init(int M, int N, int G_, int c_) { nM = M / BM; nN = N / BM; nwg = nM * nN; G = G_; c = c_; }
    __host__ __device__ bool next(int i, Unit& u) const {
        const long L = (long)i * G + c; if (L >= nwg) return false;
        int wgid = (int)L; { const int q = nwg / NXCD, r = nwg % NXCD, xcd = wgid % NXCD, off = wgid / NXCD; wgid = (xcd < r ? xcd * (q + 1) : r * (q + 1) + (xcd - r) * q) + off; }
        const int nig = WGM * nN, gid = wgid / nig, fm = gid * WGM, gsz = (nM - fm) < WGM ? (nM - fm) : WGM;
        u.pm = fm + ((wgid % nig) % gsz); u.pn = (wgid % nig) / gsz; return true;
    }
    __device__ __forceinline__ void a_ready(const Unit&) const {}
    __device__ __forceinline__ void done(const Unit&) const {}
};

__device__ __forceinline__ unsigned cvt_pk_bf16(float lo, float hi) { unsigned r; asm volatile("v_cvt_pk_bf16_f32 %0, %1, %2" : "=v"(r) : "v"(lo), "v"(hi)); return r; }
typedef float f32x2 __attribute__((ext_vector_type(2)));
__device__ __forceinline__ f32x2 gelu_pk(f32x2 v) {
    const f32x2 av = __builtin_elementwise_abs(v), d = av * 0.2316418882f + 1.0f;
    f32x2 t; t.x = __builtin_amdgcn_rcpf(d.x); t.y = __builtin_amdgcn_rcpf(d.y);
    f32x2 q = t * 0.5307027145f + (-0.7265760135f); q = q * t + 0.7107068705f; q = q * t + (-0.142248368f); q = q * t + 0.127414796f; q = q * t;
    const f32x2 s = (v * v) * (-0.72134752044f);
    f32x2 e; e.x = __builtin_amdgcn_exp2f(s.x); e.y = __builtin_amdgcn_exp2f(s.y);
    const f32x2 m = v * (q * e), r = v - m;
    f32x2 o; o.x = v.x < 0.f ? m.x : r.x; o.y = v.y < 0.f ? m.y : r.y; return o;
}
template <class Epi, class Sched, bool ALIGN_EPI = false, bool SP2 = false>
__device__ __forceinline__ void gemm_phase(PG8_LAS unsigned char* lds, const Gemm g, const Sched& S, const Epi& E, const int tid) {
    const int wid = __builtin_amdgcn_readfirstlane(tid >> 6), lane = tid & 63, wr = wid >> 2, wc = wid & 3, fr = lane & 15, fq = lane >> 4;
    const int K = g.K, LD = g.ld ? g.ld : g.K, nt = K / BK;
    unsigned voffA[2], voffB[2];
#pragma unroll
    for (int i = 0; i < 2; ++i) { int R, C; stage_rc(tid * 16 + i * 8192, R, C); const int Rb = Epi::PERM ? ((R & ~31) + perm32(R & 31)) : R;
        voffA[i] = (unsigned)(R * LD + C) * 2u; voffB[i] = (unsigned)(Rb * LD + C) * 2u; }
    const size_t kstep = (size_t)(BK * 2);
    const size_t hstep = (size_t)HALF * LD * 2;
    const size_t tstep = 2 * hstep;
    const unsigned ldsw = (unsigned)wid * 1024u;
    const int aoff = lds_byte(wr * 64 + fr, fq * 8), boff = lds_byte(wc * 32 + fr, fq * 8);
#define PG8_SA(b, h) (((b) * 2 + (h)) * HTB)
#define PG8_SB(b, h) ((4 + (b) * 2 + (h)) * HTB)
#define PG8_STAGE(bufoff, gbase, voff) do { _Pragma("unroll") for (int _i = 0; _i < 2; ++_i) \
        __builtin_amdgcn_global_load_lds((const unsigned*)((const char*)(gbase) + (voff)[_i]), (PG8_LAS unsigned*)(lds + (bufoff) + ldsw + _i * 8192), 16, 0, 0); } while (0)
#define PG8_LDA(dst, b, h) do { _Pragma("unroll") for (int m = 0; m < 4; ++m) _Pragma("unroll") for (int k = 0; k < 2; ++k) dst[m][k] = *(const PG8_LAS bf16x8*)(lds + PG8_SA(b, h) + aoff + m * 2048 + k * 1024); } while (0)
#define PG8_LDB(dst, b, h) do { _Pragma("unroll") for (int n = 0; n < 2; ++n) _Pragma("unroll") for (int k = 0; k < 2; ++k) dst[n][k] = *(const PG8_LAS bf16x8*)(lds + PG8_SB(b, h) + boff + n * 2048 + k * 1024); } while (0)
#define PG8_MMA(ai, bj, At, Bt) do { __builtin_amdgcn_s_setprio(1); _Pragma("unroll") for (int m = 0; m < 4; ++m) _Pragma("unroll") for (int n = 0; n < 2; ++n) _Pragma("unroll") for (int k = 0; k < 2; ++k) \
        acc[ai][bj][m][n] = __builtin_amdgcn_mfma_f32_16x16x32_bf16(Bt[n][k], At[m][k], acc[ai][bj][m][n], 0, 0, 0); __builtin_amdgcn_s_setprio(0); } while (0)
#define PG8_WAIT_V(n) asm volatile("s_waitcnt vmcnt(" #n ")" ::: "memory")
#define PG8_WAIT_L(n) asm volatile("s_waitcnt lgkmcnt(" #n ")" ::: "memory")
#define PG8_BAR __builtin_amdgcn_s_barrier()
#define PG8_SCHED __builtin_amdgcn_sched_barrier(0)
    Unit cur, nxt; int ui = 0;
    if (!S.next(0, cur)) return;
    f32x4 acc[2][2][4][2];
#pragma unroll
    for (int a = 0; a < 2; ++a)
#pragma unroll
        for (int b = 0; b < 2; ++b)
#pragma unroll
            for (int m = 0; m < 4; ++m)
#pragma unroll
                for (int n = 0; n < 2; ++n) acc[a][b][m][n] = (f32x4){0.f, 0.f, 0.f, 0.f};
    bf16x8 At[4][2], B0[2][2], B1[2][2];
    const char* cA = (const char*)g.A + (size_t)cur.pm * tstep; const char* cB = (const char*)g.Bt + (size_t)cur.pn * tstep;
    S.a_ready(cur);
    if constexpr (SP2) {
        PG8_STAGE(PG8_SB(0, 0), cB, voffB); PG8_STAGE(PG8_SB(0, 1), cB + hstep, voffB); PG8_STAGE(PG8_SA(0, 0), cA, voffA); PG8_STAGE(PG8_SA(0, 1), cA + hstep, voffA);
        if (wr == 1) PG8_BAR;
        PG8_WAIT_V(2); PG8_BAR;
        PG8_STAGE(PG8_SB(1, 0), cB + kstep, voffB); PG8_STAGE(PG8_SA(1, 0), cA + kstep, voffA); PG8_STAGE(PG8_SB(1, 1), cB + hstep + kstep, voffB);
        PG8_WAIT_V(6); PG8_BAR;
    } else {
        PG8_STAGE(PG8_SB(0, 0), cB, voffB); PG8_STAGE(PG8_SA(0, 0), cA, voffA); PG8_STAGE(PG8_SB(0, 1), cB + hstep, voffB); PG8_STAGE(PG8_SA(0, 1), cA + hstep, voffA);
        if (wr == 1) PG8_BAR;
        PG8_WAIT_V(4); PG8_BAR;
        PG8_STAGE(PG8_SB(1, 0), cB + kstep, voffB); PG8_STAGE(PG8_SA(1, 0), cA + kstep, voffA); PG8_STAGE(PG8_SB(1, 1), cB + hstep + kstep, voffB);
        PG8_WAIT_V(6); PG8_BAR;
    }
    for (;;) {
        const bool has_next = S.next(ui + 1, nxt);
        const char* nA = has_next ? (const char*)g.A + (size_t)nxt.pm * tstep : cA; const char* nB = has_next ? (const char*)g.Bt + (size_t)nxt.pn * tstep : cB;
        for (int t = 0; t < nt; t += 2) {
            const bool last = (t == nt - 2);
            const char* a1 = cA + (size_t)(t + 1) * kstep;
            const char* a2 = last ? nA : cA + (size_t)(t + 2) * kstep; const char* b2 = last ? nB : cB + (size_t)(t + 2) * kstep;
            const char* a3 = a2 + kstep; const char* b3 = b2 + kstep;
            if (last && has_next) S.a_ready(nxt);
            if constexpr (SP2) {
            PG8_LDB(B0, 0, 0); PG8_LDB(B1, 0, 1); PG8_SCHED; PG8_LDA(At, 0, 0); PG8_STAGE(PG8_SA(1, 1), a1 + hstep, voffA);
            PG8_WAIT_V(8); PG8_WAIT_L(0); PG8_BAR; PG8_MMA(0, 0, At, B0); PG8_MMA(0, 1, At, B1); PG8_BAR; PG8_SCHED;
            PG8_LDA(At, 0, 1); PG8_STAGE(PG8_SB(0, 0), b2, voffB); PG8_STAGE(PG8_SB(0, 1), b2 + hstep, voffB); PG8_STAGE(PG8_SA(0, 0), a2, voffA);
            PG8_WAIT_V(8); PG8_WAIT_L(0); PG8_BAR; PG8_MMA(1, 0, At, B0); PG8_MMA(1, 1, At, B1); PG8_BAR; PG8_SCHED;
            PG8_LDB(B0, 1, 0); PG8_LDB(B1, 1, 1); PG8_SCHED; PG8_LDA(At, 1, 0); PG8_STAGE(PG8_SA(0, 1), a2 + hstep, voffA);
            PG8_WAIT_V(8); PG8_WAIT_L(0); PG8_BAR; PG8_MMA(0, 0, At, B0); PG8_MMA(0, 1, At, B1); PG8_BAR; PG8_SCHED;
            PG8_LDA(At, 1, 1); PG8_STAGE(PG8_SB(1, 0), b3, voffB); PG8_STAGE(PG8_SB(1, 1), b3 + hstep, voffB); PG8_STAGE(PG8_SA(1, 0), a3, voffA);
            PG8_WAIT_V(8); PG8_WAIT_L(0); PG8_BAR; PG8_MMA(1, 0, At, B0); PG8_MMA(1, 1, At, B1); PG8_BAR; PG8_SCHED;
            } else {
            PG8_LDB(B0, 0, 0); PG8_SCHED; PG8_LDA(At, 0, 0); PG8_STAGE(PG8_SA(1, 1), a1 + hstep, voffA);
            PG8_WAIT_L(8); PG8_BAR; PG8_WAIT_L(0); PG8_MMA(0, 0, At, B0); PG8_BAR; PG8_SCHED;
            PG8_LDB(B1, 0, 1); PG8_STAGE(PG8_SB(0, 0), b2, voffB);
            PG8_BAR; PG8_WAIT_L(0); PG8_MMA(0, 1, At, B1); PG8_BAR;
            PG8_LDA(At, 0, 1); PG8_STAGE(PG8_SA(0, 0), a2, voffA);
            PG8_BAR; PG8_WAIT_L(0); PG8_MMA(1, 0, At, B0); PG8_BAR; PG8_SCHED;
            PG8_STAGE(PG8_SB(0, 1), b2 + hstep, voffB);
            PG8_WAIT_V(6); PG8_BAR; PG8_MMA(1, 1, At, B1); PG8_BAR;
            PG8_LDB(B0, 1, 0); PG8_SCHED; PG8_LDA(At, 1, 0); PG8_STAGE(PG8_SA(0, 1), a2 + hstep, voffA);
            PG8_WAIT_L(8); PG8_BAR; PG8_WAIT_L(0); PG8_MMA(0, 0, At, B0); PG8_BAR; PG8_SCHED;
            PG8_LDB(B1, 1, 1); PG8_STAGE(PG8_SB(1, 0), b3, voffB);
            PG8_BAR; PG8_WAIT_L(0); PG8_MMA(0, 1, At, B1); PG8_BAR;
            PG8_LDA(At, 1, 1); PG8_STAGE(PG8_SA(1, 0), a3, voffA);
            PG8_BAR; PG8_WAIT_L(0); PG8_MMA(1, 0, At, B0); PG8_BAR; PG8_SCHED;
            PG8_STAGE(PG8_SB(1, 1), b3 + hstep, voffB);
            PG8_WAIT_V(6); PG8_BAR; PG8_MMA(1, 1, At, B1); PG8_BAR;
            }
        }
        if constexpr (ALIGN_EPI) { if (wr == 0) PG8_BAR; }
        if constexpr (!Epi::AFTER_DRAIN) { E(acc, cur, wr, wc, fr, fq); S.done(cur); }
        if (!has_next) break;
#pragma unroll
        for (int a = 0; a < 2; ++a)
#pragma unroll
            for (int b = 0; b < 2; ++b)
#pragma unroll
                for (int m = 0; m < 4; ++m)
#pragma unroll
                    for (int n = 0; n < 2; ++n) acc[a][b][m][n] = (f32x4){0.f, 0.f, 0.f, 0.f};
        cur = nxt; cA = nA; cB = nB; ++ui;
        if constexpr (ALIGN_EPI) { if (wr == 1) PG8_BAR; }
    }
    PG8_WAIT_V(0);
    if constexpr (!ALIGN_EPI) { if (wr == 0) PG8_BAR; }
    PG8_BAR;
    if constexpr (Epi::AFTER_DRAIN) { E.fused(acc, cur, wr, wc, fr, fq, lds, wid, lane); S.done(cur); }
#undef PG8_SA
#undef PG8_SB
#undef PG8_STAGE
#undef PG8_LDA
#undef PG8_LDB
#undef PG8_MMA
#undef PG8_WAIT_V
#undef PG8_WAIT_L
#undef PG8_BAR
#undef PG8_SCHED
}
}

#ifndef PG8_SP2
#define PG8_SP2 true
#endif
#ifndef PG8_ALIGN
#define PG8_ALIGN true
#endif

#ifndef MK_CHECK
#define MK_CHECK 0
#endif
#if MK_CHECK == 8
#define MK_CHECK_ROWS MT
#define MK_CHECK_ROW0 MP
#define MK_CHECK_COL0 0
#endif
#if MK_CHECK == 7
#define MK_CHECK_ROWS MT
#define MK_CHECK_ROW0 0
#define MK_CHECK_COL0 768
#endif
#if MK_CHECK == 5
#define MK_CHECK_ROWS MT
#define MK_CHECK_ROW0 0
#define MK_CHECK_COL0 768
#endif
#if MK_CHECK == 4
#define MK_CHECK_ROWS MT
#define MK_CHECK_ROW0 0
#define MK_CHECK_COL0 512
#endif
#if MK_CHECK == 3
#define MK_CHECK_ROWS MP
#define MK_CHECK_ROW0 0
#define MK_CHECK_COL0 256
#endif
#ifndef MK_CHECK_ROWS
#define MK_CHECK_ROWS MP
#define MK_CHECK_ROW0 0
#define MK_CHECK_COL0 0
#endif
#ifndef MK_CHECK_MODE
#define MK_CHECK_MODE 2
#endif
#ifndef MK_CHECK_SEL
#define MK_CHECK_SEL -1
#endif
#ifndef MK_CHECK_TOL
#define MK_CHECK_TOL 0
#endif
#define GAS __attribute__((address_space(1)))
#define LAS __attribute__((address_space(3)))
typedef unsigned short bf16;
typedef unsigned v4u __attribute__((ext_vector_type(4)));
typedef unsigned v2u __attribute__((ext_vector_type(2)));
typedef float f32x4 __attribute__((ext_vector_type(4)));
typedef float f32x2v __attribute__((ext_vector_type(2)));
typedef GAS unsigned gu32;
#define RLX_AGENT __ATOMIC_RELAXED, __HIP_MEMORY_SCOPE_AGENT
#define LDS_WAIT() asm volatile("s_waitcnt lgkmcnt(0)" ::: "memory")
#define VM_WAIT() asm volatile("s_waitcnt vmcnt(0)" ::: "memory")
__device__ __forceinline__ unsigned f2bf(float f) { unsigned u = __builtin_bit_cast(unsigned, f); return (u + 0x7fffu + ((u >> 16) & 1u)) >> 16; }
typedef float f32x2_hw __attribute__((ext_vector_type(2))); typedef __bf16 bf16x2_hw __attribute__((ext_vector_type(2)));
__device__ __forceinline__ unsigned pk2(float lo, float hi) { f32x2_hw v = {lo, hi}; return __builtin_bit_cast(unsigned, __builtin_convertvector(v, bf16x2_hw)); }
__device__ __forceinline__ float bf2f(unsigned short b) { return __builtin_bit_cast(float, (unsigned)b << 16); }
__device__ __forceinline__ float bflo(unsigned w) { return __builtin_bit_cast(float, w << 16); }
__device__ __forceinline__ float bfhi(unsigned w) { return __builtin_bit_cast(float, w & 0xffff0000u); }
__device__ __forceinline__ float sigmoid_f(float x) { return 1.f / (1.f + __expf(-x)); }
__device__ __forceinline__ float silu_f(float x) { return x / (1.f + __expf(-x)); }
__device__ __forceinline__ float gelu_f(float x) { return 0.5f * x * (1.f + erff(x * 0.70710678118654752f)); }
template <int MASK> __device__ __forceinline__ float sx_sum(float v) {
    if (MASK == 32) { auto rr = __builtin_amdgcn_permlane32_swap(__float_as_uint(v), __float_as_uint(v), false, false); return __uint_as_float(rr[0]) + __uint_as_float(rr[1]); }
    return v + __builtin_bit_cast(float, __builtin_amdgcn_ds_swizzle(__builtin_bit_cast(int, v), (MASK << 10) | 0x1f));
}
template <int MASK> __device__ __forceinline__ float sx_max(float v) {
    if (MASK == 32) { auto rr = __builtin_amdgcn_permlane32_swap(__float_as_uint(v), __float_as_uint(v), false, false); return fmaxf(__uint_as_float(rr[0]), __uint_as_float(rr[1])); }
    return fmaxf(v, __builtin_bit_cast(float, __builtin_amdgcn_ds_swizzle(__builtin_bit_cast(int, v), (MASK << 10) | 0x1f)));
}
__device__ __forceinline__ float wave_sum(float v) { v = sx_sum<1>(v); v = sx_sum<2>(v); v = sx_sum<4>(v); v = sx_sum<8>(v); v = sx_sum<16>(v); return sx_sum<32>(v); }
__device__ __forceinline__ float wave_max(float v) { v = sx_max<1>(v); v = sx_max<2>(v); v = sx_max<4>(v); v = sx_max<8>(v); v = sx_max<16>(v); return sx_max<32>(v); }

#define XB_TMO      128
#define XB_XCNT(j)  (256  + 64 * (j))
#define XB_XSUB(j)  (1280 + 64 * (j))
#define XB_XGEN(j)  (2304 + 64 * (j))
#define XB_TOP      3328
#define XB_TOPGEN   3392
#define XCD_BAR_WORDS 3456
#define XB_SPIN_CAP (1u << 18)

__device__ __forceinline__ unsigned xb_ld(unsigned* p)              { return __hip_atomic_load(p, __ATOMIC_RELAXED, __HIP_MEMORY_SCOPE_AGENT); }
__device__ __forceinline__ unsigned xb_add(unsigned* p, unsigned v) { return __hip_atomic_fetch_add(p, v, __ATOMIC_RELAXED, __HIP_MEMORY_SCOPE_AGENT); }
__device__ __forceinline__ unsigned xb_xcc_id() { return (unsigned)__builtin_amdgcn_s_getreg((3 << 11) | 20) & 0xFu; }
#define XB_SPIN(cond, bar) do { unsigned _sp = 0; while (cond) { __builtin_amdgcn_s_sleep(1); \
    if ((++_sp & 255u) == 0u) { if (xb_ld(&(bar)[XB_TMO])) break; if (_sp > XB_SPIN_CAP) { atomicAdd(&(bar)[XB_TMO], 1u); break; } } } } while (0)

struct XcdBarrier {
    unsigned* bar; unsigned x;
    volatile LAS unsigned* st;
};
__device__ __forceinline__ XcdBarrier xcd_barrier_post(unsigned* bar, volatile LAS unsigned* st) {
    XcdBarrier b; b.bar = bar; b.x = xb_xcc_id(); b.st = st;
    if (threadIdx.x == 0) (void)xb_add(&bar[XB_XCNT(b.x)], 1u);
    return b;
}
__device__ __forceinline__ void xcd_barrier_complete(unsigned* bar, unsigned x, unsigned& nloc, unsigned& nx) {
    const unsigned G = gridDim.x * gridDim.y * gridDim.z;
    unsigned sum, cnt, mine, sp = 0u;
    for (;;) {
        sum = 0u; cnt = 0u; mine = 0u;
#pragma unroll
        for (unsigned j = 0; j < 16; ++j) { const unsigned c = xb_ld(&bar[XB_XCNT(j)]); sum += c; cnt += (c > 0u) ? 1u : 0u; mine = (j == x) ? c : mine; }
        if (sum == G) break;
        __builtin_amdgcn_s_sleep(1);
        if ((++sp & 255u) == 0u) { if (xb_ld(&bar[XB_TMO])) break; if (sp > XB_SPIN_CAP) { atomicAdd(&bar[XB_TMO], 1u); break; } }
    }
    nloc = mine > 0u ? mine : 1u; nx = cnt > 0u ? cnt : 1u;
}
__device__ __forceinline__ void xcd_barrier(const XcdBarrier& b, const int tid) {
    asm volatile("s_waitcnt vmcnt(0)" ::: "memory");
    __syncthreads();
    if (tid == 0) {
        unsigned* bar = b.bar;
        __builtin_amdgcn_s_waitcnt(0);
        unsigned nloc = b.st[0], nx = b.st[1];
        if (nloc == 0u) { xcd_barrier_complete(bar, b.x, nloc, nx); b.st[0] = nloc; b.st[1] = nx; }
        const unsigned old = xb_add(&bar[XB_XSUB(b.x)], 1u);
        const unsigned gen = old / nloc;
        if (old + 1u == (gen + 1u) * nloc) {
            __builtin_amdgcn_fence(__ATOMIC_RELEASE, "agent");
            asm volatile("s_waitcnt vmcnt(0)" ::: "memory");
            const unsigned og = xb_add(&bar[XB_TOP], 1u);
            const unsigned tg = og / nx;
            if (og + 1u == (tg + 1u) * nx) xb_add(&bar[XB_TOPGEN], 1u);
            else XB_SPIN(xb_ld(&bar[XB_TOPGEN]) == tg, bar);
            __builtin_amdgcn_fence(__ATOMIC_ACQUIRE, "agent");
            xb_add(&bar[XB_XGEN(b.x)], 1u);
            asm volatile("s_waitcnt vmcnt(0)" ::: "memory");
        } else {
            XB_SPIN(xb_ld(&bar[XB_XGEN(b.x)]) == gen, bar);
            __builtin_amdgcn_fence(__ATOMIC_ACQUIRE, "agent");
            asm volatile("s_waitcnt vmcnt(0)" ::: "memory");
        }
    }
    __syncthreads();
}

constexpr int NWAVES = 8, NTHR = 512;
constexpr int DM = 1024, MP = 16384, MS = 1024, MT = MP + MS, TSEQ = 8192, DIN = 3584, GW = 256;
constexpr int NBP = 2, NBS = 128, NBT = NBP + NBS;
constexpr int NPOOL = 2560, NPAGES = 16, PAGE = 128, PAST = 2048;
constexpr float EPS = 1e-5f;
constexpr float QSCALE = 0.25503486164919736f;
constexpr float ALPHA = 1.4142135623730951f;
constexpr int HG_L = 64, HG_NB = TSEQ / HG_L;
__device__ const double ROPE_INV[16] = {1.0, 0.5623413251903491, 0.31622776601683794, 0.1778279410038923, 0.1, 0.05623413251903491, 0.03162277660168379, 0.01778279410038923,
                                        0.01, 0.005623413251903491, 0.0031622776601683794, 0.0017782794100389228, 0.001, 0.0005623413251903491, 0.00031622776601683794, 0.00017782794100389227};
enum { I_XP = 0, I_XS, I_CK, I_CV, I_SCONV, I_SHGRN, I_PT, I_CP, I_CSM, I_WADA, I_BADA, I_WIN, I_LAMQK, I_ANG, I_SGG, I_SGB, I_WS, I_BS, I_CW, I_CB, I_CNG, I_CNB, I_WPW, I_LB, I_HNG, I_WOUT, I_LNG, I_LNB, N_IN };
constexpr size_t O_YP = 0, O_YS = O_YP + (size_t)MP * DM, O_KP = O_YS + (size_t)MS * DM, O_VP = O_KP + (size_t)2 * MP * GW, O_KS = O_VP + (size_t)2 * MP * GW,
                 O_VS = O_KS + (size_t)2 * MS * GW, O_CH = O_VS + (size_t)2 * MS * GW, O_CP = O_CH + (size_t)2 * MS * GW, O_CS = O_CP + (size_t)2 * NBP * 30 * GW,
                 O_HP = O_CS + (size_t)2 * NBS * 30 * GW, O_HS = O_HP + (size_t)2 * NBP * 4 * 4096, O_END = O_HS + (size_t)2 * NBS * 4 * 4096;
static_assert(O_END == 42432512, "output size");
constexpr size_t MiB = 1u << 20;
constexpr size_t WS_CTL = 0, CTL_ZERO_BYTES = 1 * MiB;
constexpr size_t WS_CS = 1 * MiB;
constexpr size_t WS_MOD = 2 * MiB;
constexpr size_t WS_SC = 6 * MiB;
constexpr size_t WS_SCAL = 7 * MiB;
constexpr size_t WS_WADA = 8 * MiB;
constexpr size_t WS_WIN = 20 * MiB;
constexpr size_t WS_WOUT = 34 * MiB;
constexpr size_t WS_WPW = 38 * MiB;
constexpr size_t WS_WSB = 39 * MiB;
constexpr size_t WS_H = 40 * MiB;
constexpr size_t SEG = 9 * MiB;
constexpr size_t WS_Q = 74 * MiB, WS_K = WS_Q + SEG, WS_V = WS_K + SEG, WS_GA = WS_V + SEG, WS_U = WS_GA + SEG, WS_VN = WS_U + SEG, WS_GB = WS_VN + SEG, WS_GC = WS_GB + SEG,
                 WS_QD = WS_GC + SEG, WS_KD = WS_QD + SEG, WS_VD = WS_KD + SEG, WS_GD = WS_VD + SEG;
constexpr size_t WS_KT = WS_K, WS_VT = WS_V;
constexpr size_t WS_GLU = 182 * MiB;
constexpr size_t WS_LF = 199 * MiB;
constexpr size_t WS_MIX = 216 * MiB;
constexpr size_t WS_R = 250 * MiB;
constexpr size_t WS_Y1 = 318 * MiB;
constexpr size_t WS_SLOC = 386 * MiB;
constexpr size_t WS_DTOT = 402 * MiB;
constexpr size_t WS_Z = 404 * MiB;
constexpr size_t WS_SST = 644 * MiB;
constexpr size_t WS_MIXCHK = 660 * MiB;
constexpr size_t WS_KR = 696 * MiB, WS_VR = 705 * MiB;
constexpr size_t WS_END = 714 * MiB;
constexpr size_t WS_PART = WS_Q;
constexpr int CW_BAR = 4096;
constexpr int CW_FQ = 16384;
constexpr int CW_GQ = 18432, CW_HQ = 18688, CW_SD = 18944;
constexpr int RING_BYTES = 131072, MISC_OFF = RING_BYTES + 320, LDS_BYTES = 147456;

__device__ __forceinline__ int batch_of(int m) { return m < MP ? (m >> 13) : NBP + ((m - MP) >> 3); }
struct Args { const float* in[N_IN]; float* out; unsigned char* ws; int ph_lo, ph_hi; };

#define CAS __attribute__((address_space(4)))
struct Ctx {
    const CAS Args* a; unsigned char* wsb; LAS unsigned char* lds; int tid, lane, wave, G, bid;
    __device__ __forceinline__ int gw() const { return bid * NWAVES + wave; }
    __device__ __forceinline__ int ngw() const { return G * NWAVES; }
    template <class T> __device__ __forceinline__ T* ws(size_t off) const { return (T*)(wsb + off); }
};

__device__ __forceinline__ Ctx launder(const Ctx& C, Args& shadow) {
    Ctx P = C; int t; asm volatile("v_mbcnt_lo_u32_b32 %0, -1, 0\n\tv_mbcnt_hi_u32_b32 %0, -1, %0" : "=v"(t)); t += C.wave * 64; P.tid = t; P.lane = t & 63; P.wave = __builtin_amdgcn_readfirstlane(t >> 6);
    const CAS Args* ka = (const CAS Args*)__builtin_amdgcn_kernarg_segment_ptr(); asm volatile("" : "+s"(ka)); P.a = ka;
    unsigned char* w = ka->ws; asm volatile("" : "+s"(w)); P.wsb = w;
    return P;
}
__device__ __forceinline__ f32x4 ld4(const float* p) { return *(const f32x4*)p; }
__device__ __forceinline__ void st4(float* p, f32x4 v) { *(f32x4*)p = v; }
__device__ __forceinline__ void st_bf4(bf16* p, f32x4 v) { v2u w; w.x = pk2(v.x, v.y); w.y = pk2(v.z, v.w); *(v2u*)p = w; }
__device__ __forceinline__ f32x4 ld_bf4(const bf16* p) { const v2u w = *(const v2u*)p; return (f32x4){bflo(w.x), bfhi(w.x), bflo(w.y), bfhi(w.y)}; }

template <class F> struct EpiF {
    static constexpr bool PERM = false, AFTER_DRAIN = false; F f;
    __device__ __forceinline__ void operator()(const pg8::f32x4 (&acc)[2][2][4][2], const pg8::Unit& u, int wr, int wc, int fr, int fq) const {
#pragma unroll
        for (int ai = 0; ai < 2; ++ai)
#pragma unroll
            for (int m = 0; m < 4; ++m) { const int row = u.pm * 256 + ai * 128 + wr * 64 + m * 16 + fr;
#pragma unroll
                for (int bj = 0; bj < 2; ++bj)
#pragma unroll
                    for (int n = 0; n < 2; ++n) { const int col = u.pn * 256 + bj * 128 + wc * 32 + n * 16 + 4 * fq; f(row, col, acc[ai][bj][m][n]); } }
    }
};

struct EpiResid {
    static constexpr bool PERM = true, AFTER_DRAIN = false;
    const float* xp; const float* xs; const bf16* y1; const float* modg; bf16* R; int l;
    __device__ __forceinline__ void operator()(const pg8::f32x4 (&acc)[2][2][4][2], const pg8::Unit& u, int wr, int wc, int fr, int fq) const {
        f32x4 xn[4]; v4u yn[2];
        const int c8 = u.pn * 256 + wc * 32 + 8 * fq;
#define ER_LOAD(ai_, m_) do { const int row_ = u.pm * 256 + (ai_) * 128 + wr * 64 + (m_) * 16 + fr; \
            if (l == 0) { const float* xr_ = xp + (size_t)row_ * DM + c8; xn[0] = ld4(xr_); xn[1] = ld4(xr_ + 4); xn[2] = ld4(xr_ + 128); xn[3] = ld4(xr_ + 132); } \
            else { const bf16* yr_ = y1 + (size_t)row_ * DM + c8; yn[0] = *(const v4u*)yr_; yn[1] = *(const v4u*)(yr_ + 128); } } while (0)
        ER_LOAD(0, 0);
#pragma unroll
        for (int g = 0; g < 8; ++g) { const int ai = g >> 2, m = g & 3, row = u.pm * 256 + ai * 128 + wr * 64 + m * 16 + fr;
            f32x4 xc[4];
            if (l == 0) { xc[0] = xn[0]; xc[1] = xn[1]; xc[2] = xn[2]; xc[3] = xn[3]; }
            else { xc[0] = (f32x4){bflo(yn[0].x), bfhi(yn[0].x), bflo(yn[0].y), bfhi(yn[0].y)}; xc[1] = (f32x4){bflo(yn[0].z), bfhi(yn[0].z), bflo(yn[0].w), bfhi(yn[0].w)};
                   xc[2] = (f32x4){bflo(yn[1].x), bfhi(yn[1].x), bflo(yn[1].y), bfhi(yn[1].y)}; xc[3] = (f32x4){bflo(yn[1].z), bfhi(yn[1].z), bflo(yn[1].w), bfhi(yn[1].w)}; }
            if (g < 7) ER_LOAD((g + 1) >> 2, (g + 1) & 3);
            const float* gr = modg + (size_t)batch_of(row) * 3072 + c8; bf16* rr = R + (size_t)row * DM + c8;
#pragma unroll
            for (int bj = 0; bj < 2; ++bj) {
                const f32x4 r0 = xc[2 * bj] * ALPHA + ld4(gr + bj * 128) * acc[ai][bj][m][0], r1 = xc[2 * bj + 1] * ALPHA + ld4(gr + bj * 128 + 4) * acc[ai][bj][m][1];
                *(v4u*)(rr + bj * 128) = (v4u){pk2(r0.x, r0.y), pk2(r0.z, r0.w), pk2(r1.x, r1.y), pk2(r1.z, r1.w)}; }
            asm volatile("" ::: "memory"); }
#undef ER_LOAD
    }
};

constexpr int OUT_KS = 4, OUT_PIECES = 16 * OUT_KS;
struct PieceOrder {
    int un;
    __device__ __forceinline__ bool next(int i, pg8::Unit& u) const { if (i > 0) return false; u.pm = MP / 256 + (un >> 2); u.pn = un & 3; return true; }
    __device__ __forceinline__ void a_ready(const pg8::Unit&) const {}
    __device__ __forceinline__ void done(const pg8::Unit&) const {}
};
struct EpiPart {
    static constexpr bool PERM = false, AFTER_DRAIN = false;
    float* P;
    __device__ __forceinline__ void operator()(const pg8::f32x4 (&acc)[2][2][4][2], const pg8::Unit& u, int wr, int wc, int fr, int fq) const {
#pragma unroll
        for (int ai = 0; ai < 2; ++ai)
#pragma unroll
            for (int m = 0; m < 4; ++m) { const int row = (u.pm - MP / 256) * 256 + ai * 128 + wr * 64 + m * 16 + fr; float* rr = P + (size_t)row * DM;
#pragma unroll
                for (int bj = 0; bj < 2; ++bj)
#pragma unroll
                    for (int n = 0; n < 2; ++n) { const int col = u.pn * 256 + bj * 128 + wc * 32 + n * 16 + 4 * fq; st4(rr + col, acc[ai][bj][m][n]); } }
    }
};

#define EPI_PIN(ai, m) asm volatile("" : "+v"(acc[ai][0][m][0]), "+v"(acc[ai][0][m][1]), "+v"(acc[ai][1][m][0]), "+v"(acc[ai][1][m][1]) :: "memory")
struct EpiIn {
    static constexpr bool PERM = false, AFTER_DRAIN = false;
    unsigned char* ws; float* out; const float* sgg; const float* sgb; LAS unsigned char* xl; int l;
    template <int ACT> static __device__ __forceinline__ f32x4 act4(f32x4 v) {
        if (ACT == 1) { return (f32x4){silu_f(v.x), silu_f(v.y), silu_f(v.z), silu_f(v.w)}; }
        if (ACT == 2) { const pg8::f32x2 a = pg8::gelu_pk((pg8::f32x2){v.x, v.y}), b = pg8::gelu_pk((pg8::f32x2){v.z, v.w}); return (f32x4){a.x, a.y, b.x, b.y}; }
        return v;
    }
    template <int ACT> __device__ __forceinline__ void plain(pg8::f32x4 (&acc)[2][2][4][2], int row0, int c0, size_t off) const {
        bf16* B = (bf16*)(ws + off);
#pragma unroll
        for (int ai = 0; ai < 2; ++ai)
#pragma unroll
            for (int m = 0; m < 4; ++m) { EPI_PIN(ai, m); bf16* rp = B + (size_t)(row0 + ai * 128 + m * 16) * 256 + c0;
#pragma unroll
                for (int bj = 0; bj < 2; ++bj)
#pragma unroll
                    for (int n = 0; n < 2; ++n) st_bf4(rp + bj * 128 + n * 16, act4<ACT>(acc[ai][bj][m][n]));
                asm volatile("" ::: "memory"); }
    }
    __device__ __forceinline__ void operator()(pg8::f32x4 (&acc)[2][2][4][2], const pg8::Unit& u, int wr, int wc, int fr, int fq) const {
        asm volatile("" : "+v"(fr), "+v"(fq));
        const int T = u.pn;
#define EPI_IDX int fr_ = fr, fq_ = fq; asm volatile("" : "+v"(fr_), "+v"(fq_)); const int row0 = u.pm * 256 + wr * 64 + fr_, c0 = wc * 32 + 4 * fq_; (void)row0; (void)c0
        const bool samp = u.pm >= MP / 256;
#ifndef EPI_MASK
#define EPI_MASK 0xff
#endif
        if ((EPI_MASK & 1) && (T == 0 || T == 1)) {
            EPI_IDX;
            const f32x2v* CS = (const f32x2v*)(ws + WS_CS);
#pragma unroll
            for (int ai = 0; ai < 2; ++ai)
#pragma unroll
                for (int m = 0; m < 4; ++m) { EPI_PIN(ai, m); const int row = row0 + ai * 128 + m * 16; const int r = row - MP;
                    const int pos = samp ? PAST + (r & 7) : (row & (TSEQ - 1));
                    const f32x4 cs0 = *(const f32x4*)(CS + pos * 16 + 4 * fq_), cs1 = *(const f32x4*)(CS + pos * 16 + 4 * fq_ + 2);
                    const f32x4 cosv = (f32x4){cs0.x, cs0.z, cs1.x, cs1.z}, sinv = (f32x4){cs0.y, cs0.w, cs1.y, cs1.w};
#pragma unroll
                    for (int bj = 0; bj < 2; ++bj) { const f32x4 x1 = acc[ai][bj][m][0], x2 = acc[ai][bj][m][1];
                        const f32x4 o1 = x1 * cosv - x2 * sinv, o2 = x2 * cosv + x1 * sinv; const int col = bj * 128 + c0;
                        if (T == 0) { bf16* q = (bf16*)(ws + WS_Q) + (size_t)row * 256 + col; st_bf4(q, o1 * QSCALE); st_bf4(q + 16, o2 * QSCALE); }
                        else { float* ok = out + (samp ? O_KS + ((size_t)l * MS + r) * 256 : O_KP + ((size_t)l * MP + row) * 256) + col; st4(ok, o1); st4(ok + 16, o2);
#if MK_CHECK == 1
                            { bf16* kr = (bf16*)(ws + WS_KR) + (size_t)row * 256 + col; st_bf4(kr, o1); st_bf4(kr + 16, o2); }
#endif
                            if (!samp) { const int t = row & (TSEQ - 1), bh = (row >> 13) * 4 + 2 * bj + (wc >> 1);
                                unsigned char* kt = ws + WS_KT + ((size_t)(bh * 128 + (t >> 6)) * 8192 + (4 * (wc & 1) + (fq_ >> 1)) * 1024 + (t & 63) * 16 + 8 * (fq_ & 1));
                                st_bf4((bf16*)kt, o1); st_bf4((bf16*)(kt + 2048), o2); } } }
                    asm volatile("" ::: "memory"); }
        } else if ((EPI_MASK & 2) && T == 2) {
            EPI_IDX;
#pragma unroll
            for (int ai = 0; ai < 2; ++ai)
#pragma unroll
                for (int m = 0; m < 4; ++m) { EPI_PIN(ai, m); const int row = row0 + ai * 128 + m * 16; const int r = row - MP;
#pragma unroll
                    for (int bj = 0; bj < 2; ++bj)
#pragma unroll
                        for (int n = 0; n < 2; ++n) { const f32x4 v = acc[ai][bj][m][n]; const int col = bj * 128 + n * 16 + c0;
                            st4(out + (samp ? O_VS + ((size_t)l * MS + r) * 256 : O_VP + ((size_t)l * MP + row) * 256) + col, v);
#if MK_CHECK == 1
                            st_bf4((bf16*)(ws + WS_VR) + (size_t)row * 256 + col, v);
#endif
                            if (!samp) { const int t = row & (TSEQ - 1), bh = (row >> 13) * 4 + 2 * bj + (wc >> 1), rw = t & 63;
                                st_bf4((bf16*)(ws + WS_VT + ((size_t)(bh * 128 + (t >> 6)) * 8192 + ((wc & 1) * 4 + (rw >> 4)) * 1024 + (rw & 15) * 64 + 32 * n + 8 * fq_)), v); } }
                    asm volatile("" ::: "memory"); }
        } else if ((EPI_MASK & 4) && T == 3) { EPI_IDX; plain<1>(acc, row0, c0, WS_GA); }
        else if ((EPI_MASK & 8) && T == 4) { EPI_IDX; plain<2>(acc, row0, c0, WS_U); }
        else if ((EPI_MASK & 4) && T == 6) { EPI_IDX; plain<1>(acc, row0, c0, WS_GB); }
        else if ((EPI_MASK & 4) && T == 9) { EPI_IDX; plain<1>(acc, row0, c0, WS_GC); }
        else if ((EPI_MASK & 4) && T == 10) { EPI_IDX; plain<1>(acc, row0, c0, WS_QD); }
        else if ((EPI_MASK & 4) && T == 12) { EPI_IDX; plain<0>(acc, row0, c0, WS_VD); }
        else if ((EPI_MASK & 4) && T == 13) { EPI_IDX; plain<1>(acc, row0, c0, WS_GD); }
        else if ((EPI_MASK & 16) && T == 5) { EPI_IDX; plain<2>(acc, row0, c0, WS_VN);
        } else if ((EPI_MASK & 32) && (T == 7 || T == 8)) {
            EPI_IDX;
#pragma unroll
            for (int ai = 0; ai < 2; ++ai)
#pragma unroll
                for (int m = 0; m < 4; ++m) { EPI_PIN(ai, m); const int row = row0 + ai * 128 + m * 16; const int r = row - MP;
#pragma unroll
                    for (int n = 0; n < 2; ++n) { const f32x4 a = acc[ai][0][m][n], gt = acc[ai][1][m][n]; const int col = (T - 7) * 128 + n * 16 + c0;
                        const f32x4 glu = (f32x4){a.x * sigmoid_f(gt.x), a.y * sigmoid_f(gt.y), a.z * sigmoid_f(gt.z), a.w * sigmoid_f(gt.w)};
                        st4((float*)(ws + WS_GLU) + (size_t)row * 256 + col, glu);
                        if (!samp) { const int t = row & (TSEQ - 1); if (t >= TSEQ - 30) st4(out + O_CP + ((size_t)(l * NBP + (row >> 13)) * 30 + (t - (TSEQ - 30))) * 256 + col, glu); }
                        else st4(out + O_CS + ((size_t)(l * NBS + (r >> 3)) * 30 + 22 + (r & 7)) * 256 + col, glu); }
                    asm volatile("" ::: "memory"); }
        } else if ((EPI_MASK & 64) && T == 11) {
            EPI_IDX;
            const float* lbp = (const float*)(ws + WS_SCAL) + 64;
#pragma unroll
            for (int ai = 0; ai < 2; ++ai)
#pragma unroll
                for (int m = 0; m < 4; ++m) { EPI_PIN(ai, m); const int row = row0 + ai * 128 + m * 16;
#pragma unroll
                    for (int bj = 0; bj < 2; ++bj)
#pragma unroll
                        for (int n = 0; n < 2; ++n) { const int col = bj * 128 + n * 16 + c0; f32x4 lb = (f32x4){0.f, 0.f, 0.f, 0.f}; if (l == 1) lb = ld4(lbp + col);
                            const f32x4 v = acc[ai][bj][m][n]; f32x4 f, lf;
                            f.x = lb.x + (1.f - lb.x) * sigmoid_f(v.x); f.y = lb.y + (1.f - lb.y) * sigmoid_f(v.y); f.z = lb.z + (1.f - lb.z) * sigmoid_f(v.z); f.w = lb.w + (1.f - lb.w) * sigmoid_f(v.w);
                            lf.x = __logf(fmaxf(f.x, 1e-30f)); lf.y = __logf(fmaxf(f.y, 1e-30f)); lf.z = __logf(fmaxf(f.z, 1e-30f)); lf.w = __logf(fmaxf(f.w, 1e-30f));
                            st4((float*)(ws + WS_LF) + (size_t)row * 256 + col, lf); st_bf4((bf16*)(ws + WS_KD) + (size_t)row * 256 + col, 1.f - f); } }
        }
    }
};

template <bool GLU_PERM = false> __device__ __forceinline__ void p0_transpose_item(const float* W, int K, int N, bf16* WT, int row_off, LAS float* scr, int item, int lane) {
    const int nblk = N / 32, kb = item / nblk, nb = item % nblk, k0 = 64 * kb, n0 = 32 * nb;
    int d0 = n0;
    if (GLU_PERM && n0 >= 1792 && n0 < 2304) { const int c = n0 - 1792, part = c >> 8, idx = c & 255; d0 = 1792 + (idx >> 7) * 256 + part * 128 + (idx & 127); }
    float tv[32];
#pragma unroll
    for (int i = 0; i < 32; ++i) tv[i] = W[(size_t)(k0 + 2 * i + (lane >> 5)) * N + n0 + (lane & 31)];
#pragma unroll
    for (int i = 0; i < 32; ++i) scr[(2 * i + (lane >> 5)) * 33 + (lane & 31)] = tv[i];
    LDS_WAIT(); asm volatile("" ::: "memory");
    const int c = lane & 7;
#pragma unroll
    for (int j = 0; j < 4; ++j) { const int n = (lane >> 3) + 8 * j; const LAS float* s = scr + (8 * c) * 33 + n;
        v4u o; o.x = pk2(s[0 * 33], s[1 * 33]); o.y = pk2(s[2 * 33], s[3 * 33]); o.z = pk2(s[4 * 33], s[5 * 33]); o.w = pk2(s[6 * 33], s[7 * 33]);
        *(GAS v4u*)(WT + (size_t)(row_off + d0 + n) * K + k0 + 8 * c) = o; }
    LDS_WAIT(); asm volatile("" ::: "memory");
}
struct TItem { const float* src; bf16* dst; int N, K; };
template <bool GLU_PERM = false> __device__ __forceinline__ TItem p0_titem(const float* W, int K, int N, bf16* WT, int row_off, int item, int lane) {
    const int nblk = N / 32, kb = item / nblk, nb = item % nblk, k0 = 64 * kb, n0 = 32 * nb;
    int d0 = n0;
    if (GLU_PERM && n0 >= 1792 && n0 < 2304) { const int c = n0 - 1792, part = c >> 8, idx = c & 255; d0 = 1792 + (idx >> 7) * 256 + part * 128 + (idx & 127); }
    TItem t; t.src = W + (size_t)(k0 + (lane >> 5)) * N + n0 + (lane & 31); t.dst = WT + (size_t)(row_off + d0) * K + k0; t.N = N; t.K = K; return t;
}
#define P0_TLOAD(T, tv) { _Pragma("unroll") for (int i_ = 0; i_ < 32; ++i_) tv[i_] = (T).src[(size_t)(2 * i_) * (T).N]; }
#define P0_TSTORE(T, tv, scr, lane) { \
    _Pragma("unroll") for (int i_ = 0; i_ < 32; ++i_) (scr)[(2 * i_ + ((lane) >> 5)) * 33 + ((lane) & 31)] = tv[i_]; \
    LDS_WAIT(); asm volatile("" ::: "memory"); \
    { const int c_ = (lane) & 7; \
      _Pragma("unroll") for (int j_ = 0; j_ < 4; ++j_) { const int n_ = ((lane) >> 3) + 8 * j_; const LAS float* s_ = (scr) + (8 * c_) * 33 + n_; \
        v4u o_; o_.x = pk2(s_[0 * 33], s_[1 * 33]); o_.y = pk2(s_[2 * 33], s_[3 * 33]); o_.z = pk2(s_[4 * 33], s_[5 * 33]); o_.w = pk2(s_[6 * 33], s_[7 * 33]); \
        *(GAS v4u*)((T).dst + (size_t)n_ * (T).K + 8 * c_) = o_; } } \
    LDS_WAIT(); asm volatile("" ::: "memory"); }
__device__ __forceinline__ void p0_layer1_weights(const Ctx& C, int widx, int nw) {
    const CAS Args& A = *C.a; LAS float* scr = (LAS float*)(C.lds + C.wave * 12288);
    constexpr int I_IN = 16 * (DIN / 32), I_OUT = 16 * 32, I_PW = 4 * 8;
    for (int it = widx; it < I_IN + I_OUT + I_PW; it += nw) {
        int r = it;
        if (r < I_IN) { p0_transpose_item<true>(A.in[I_WIN] + (size_t)DM * DIN, DM, DIN, C.ws<bf16>(WS_WIN) + (size_t)DIN * DM, 0, scr, r, C.lane); continue; } r -= I_IN;
        if (r < I_OUT) { p0_transpose_item(A.in[I_WOUT] + (size_t)DM * DM, DM, DM, C.ws<bf16>(WS_WOUT) + (size_t)DM * DM, 0, scr, r, C.lane); continue; } r -= I_OUT;
        p0_transpose_item(A.in[I_WPW] + (size_t)256 * 256, 256, 256, C.ws<bf16>(WS_WPW) + (size_t)256 * 256, 0, scr, r, C.lane);
    }
}
template <int PART> __device__ __forceinline__ void p0_prologue(const Ctx& C, int gw, int NGW) {
    const CAS Args& A = *C.a;
    LAS float* scr = (LAS float*)(C.lds + C.wave * 16384);
    constexpr int I_IN = 16 * (DIN / 32), I_OUT = 16 * 32, I_ADA = 16 * 96, I_PW = 4 * 8;
    constexpr int NITEMS = I_IN + I_OUT + I_PW + 2 * I_ADA;
    constexpr int IT_LO = PART == 0 ? I_IN + I_OUT + I_PW : 0, IT_HI = PART == 0 ? NITEMS : I_IN + I_OUT + I_PW;
    auto desc = [&](int it) -> TItem {
        int r = it;
        if (r < I_IN) return p0_titem<true>(A.in[I_WIN], DM, DIN, C.ws<bf16>(WS_WIN), 0, r, C.lane); r -= I_IN;
        if (r < I_OUT) return p0_titem(A.in[I_WOUT], DM, DM, C.ws<bf16>(WS_WOUT), 0, r, C.lane); r -= I_OUT;
        if (r < I_PW) return p0_titem(A.in[I_WPW], 256, 256, C.ws<bf16>(WS_WPW), 0, r, C.lane); r -= I_PW;
        const int l = r >= I_ADA ? 1 : 0; r -= l * I_ADA;
        return p0_titem(A.in[I_WADA] + (size_t)l * DM * 3072, DM, 3072, C.ws<bf16>(WS_WADA), l * 3072, r, C.lane);
    };
    for (int it = IT_LO + gw; it < IT_HI; it += 2 * NGW) {
        const bool two = it + NGW < IT_HI;
        const TItem T0 = desc(it), T1 = desc(two ? it + NGW : it);
        float tv0[32], tv1[32];
        P0_TLOAD(T0, tv0);
        if (two) P0_TLOAD(T1, tv1);
        P0_TSTORE(T0, tv0, scr, C.lane);
        if (two) P0_TSTORE(T1, tv1, scr, C.lane);
    }
    if (PART == 1) {
    { bf16* wsb = C.ws<bf16>(WS_WSB); const float* wsrc = A.in[I_WS];
      for (int idx = gw * 64 + C.lane; idx < 2 * 4 * 128 * 32; idx += NGW * 64) { const int t = (idx >> 5) & 127, s4 = (idx & 31) * 4; f32x4 v = ld4(wsrc + (size_t)idx * 4);
          if (s4 + 0 > t) v.x = 0.f; if (s4 + 1 > t) v.y = 0.f; if (s4 + 2 > t) v.z = 0.f; if (s4 + 3 > t) v.w = 0.f; st_bf4(wsb + (size_t)idx * 4, v); } }
    f32x2v* cs = C.ws<f32x2v>(WS_CS);
    for (int idx = gw * 64 + C.lane; idx < TSEQ * 16; idx += NGW * 64) {
        const int pos = idx >> 4, i = idx & 15;
        const double a = (double)pos * ROPE_INV[i];
        const double n = rint(a * 0.15915494309189535);
        const float r = (float)(a - n * 6.283185307179586);
        cs[idx] = (f32x2v){cosf(r), sinf(r)};
    }
    }
    if (PART == 0) {
    bf16* sc = C.ws<bf16>(WS_SC);
    for (int row = gw; row < 256; row += NGW) {
        const float* src = row < NBP ? A.in[I_CP] + (size_t)row * DM : A.in[I_CSM] + (size_t)(row - NBP) * DM;
#pragma unroll
        for (int j = 0; j < 4; ++j) { const int col = 4 * C.lane + 256 * j; f32x4 v = (f32x4){0.f, 0.f, 0.f, 0.f};
            if (row < NBT) { v = ld4(src + col); v.x = silu_f(v.x); v.y = silu_f(v.y); v.z = silu_f(v.z); v.w = silu_f(v.w); }
            st_bf4(sc + (size_t)row * DM + col, v); }
    }
    }
    if (PART == 1) {
    for (int it = gw; it < 2 * NBS * 22; it += NGW) { const int j = it % 22, lb_ = it / 22;
        st4(A.out + O_CS + ((size_t)lb_ * 30 + j) * 256 + 4 * C.lane, ld4(A.in[I_SCONV] + ((size_t)lb_ * 30 + 8 + j) * 256 + 4 * C.lane)); }
    }
    if (PART == 0 && C.bid == 0 && C.wave == 0) {
        float* scal = C.ws<float>(WS_SCAL);
        const float* lq = A.in[I_LAMQK];
        for (int l = 0; l < 2; ++l) {
            float a = C.lane < 32 ? lq[(l * 4 + 0) * 32 + C.lane] * lq[(l * 4 + 1) * 32 + C.lane] : 0.f;
            float b = C.lane < 32 ? lq[(l * 4 + 2) * 32 + C.lane] * lq[(l * 4 + 3) * 32 + C.lane] : 0.f;
            a = wave_sum(a); b = wave_sum(b);
            const float lam_init = l == 0 ? 0.2f : 0.35550906759096934f;
            if (C.lane == 0) scal[l] = __expf(a) - __expf(b) + lam_init;
        }
        const float* lb = A.in[I_LB];
        for (int c = C.lane; c < 256; c += 64) { const float e0 = __expf(lb[c]), e1 = __expf(lb[256 + c]); scal[64 + c] = e1 / (e0 + e1); }
    }
}


__device__ __forceinline__ const float* xrow_in(const Ctx& C, int l, int m) {
    if (l == 0) return m < MP ? C.a->in[I_XP] + (size_t)m * DM : C.a->in[I_XS] + (size_t)(m - MP) * DM;
    return C.a->in[I_XP];
}
__device__ __forceinline__ void ph_hbuild(const Ctx& C, int l) {
    const float* mod = C.ws<float>(WS_MOD); bf16* H = C.ws<bf16>(WS_H);
    constexpr int HB = 2;
    f32x4 b0[HB][4], b1[HB][4];
    const int rstep = C.ngw();
#define HB_LOAD(dst, mb) do { _Pragma("unroll") for (int i_ = 0; i_ < HB; ++i_) { const int mi_ = (mb) + i_ * rstep; if (mi_ < MT) { const float* xr_ = xrow_in(C, l, mi_); \
        _Pragma("unroll") for (int j_ = 0; j_ < 4; ++j_) dst[i_][j_] = ld4(xr_ + 4 * C.lane + 256 * j_); } } } while (0)
    HB_LOAD(b0, C.gw());
    if (C.gw() + HB * rstep < MT) { HB_LOAD(b1, C.gw() + HB * rstep); }
    for (int m = C.gw(); m < MT; m += HB * rstep) {
        f32x4 use[HB][4];
#pragma unroll
        for (int i = 0; i < HB; ++i)
#pragma unroll
            for (int j = 0; j < 4; ++j) { use[i][j] = b0[i][j]; b0[i][j] = b1[i][j]; }
        if (m + 2 * HB * rstep < MT) { HB_LOAD(b1, m + 2 * HB * rstep); }
#pragma unroll
        for (int i = 0; i < HB; ++i) { const int mi = m + i * rstep;
            if (mi < MT) { const float* md = mod + (size_t)(l * NBT + batch_of(mi)) * 3072;
#pragma unroll
                for (int j = 0; j < 4; ++j) { const int col = 4 * C.lane + 256 * j;
                    const f32x4 sh = ld4(md + col), sc = ld4(md + 1024 + col);
                    st_bf4(H + (size_t)mi * DM + col, use[i][j] * (1.f + sc) + sh); } } }
    }
#undef HB_LOAD
}

#if MK_CHECK == 6
constexpr size_t WS_ALT = 768 * MiB;
__device__ __forceinline__ void ph_post_ref(const Ctx& C, int l) {
    const CAS Args& A = *C.a; const int lane = C.lane, c4 = 4 * lane;
    const float* Z = (const float*)(C.wsb - WS_ALT + WS_Z); const f32x2v* CS = (const f32x2v*)(C.wsb - WS_ALT + WS_CS); const float* scal = (const float*)(C.wsb - WS_ALT + WS_SCAL);
    bf16 *Qb = C.ws<bf16>(WS_Q), *Kb = C.ws<bf16>(WS_K), *Vb = C.ws<bf16>(WS_V), *GA = C.ws<bf16>(WS_GA), *U = C.ws<bf16>(WS_U), *VN = C.ws<bf16>(WS_VN), *GB = C.ws<bf16>(WS_GB),
         *GC = C.ws<bf16>(WS_GC), *QD = C.ws<bf16>(WS_QD), *KD = C.ws<bf16>(WS_KD), *VD = C.ws<bf16>(WS_VD), *GD = C.ws<bf16>(WS_GD);
    float *GLU = C.ws<float>(WS_GLU), *LF = C.ws<float>(WS_LF); float* out = A.out;
    const f32x4 sg_g = ld4(A.in[I_SGG] + l * 256 + c4), sg_b = ld4(A.in[I_SGB] + l * 256 + c4);
    f32x4 lb = (f32x4){0.f, 0.f, 0.f, 0.f}; if (l == 1) lb = ld4(scal + 64 + c4);
    const float sgn = (lane & 4) ? 1.f : -1.f;
    for (int m = C.gw(); m < MT; m += C.ngw()) {
        const float* z = Z + (size_t)m * DIN; const size_t mo = (size_t)m * 256 + c4;
        const bool samp = m >= MP; const int r = m - MP;
        const int pos = samp ? PAST + (r & 7) : (m & (TSEQ - 1));
        float *ok, *ov;
        if (!samp) { const size_t o = ((size_t)l * MP + m) * 256 + c4; ok = out + O_KP + o; ov = out + O_VP + o; }
        else { const size_t o = ((size_t)l * MS + r) * 256 + c4; ok = out + O_KS + o; ov = out + O_VS + o; }
        const f32x4 cs0 = *(const f32x4*)(CS + pos * 16 + 4 * (lane & 3)), cs1 = *(const f32x4*)(CS + pos * 16 + 4 * (lane & 3) + 2);
        const f32x4 cosv = (f32x4){cs0.x, cs0.z, cs1.x, cs1.z}, sinv = (f32x4){cs0.y, cs0.w, cs1.y, cs1.w};
        {
            const f32x4 v = ld4(z + c4); f32x4 p; p.x = __builtin_bit_cast(float, __builtin_amdgcn_ds_swizzle(__builtin_bit_cast(int, v.x), (4 << 10) | 0x1f)); p.y = __builtin_bit_cast(float, __builtin_amdgcn_ds_swizzle(__builtin_bit_cast(int, v.y), (4 << 10) | 0x1f)); p.z = __builtin_bit_cast(float, __builtin_amdgcn_ds_swizzle(__builtin_bit_cast(int, v.z), (4 << 10) | 0x1f)); p.w = __builtin_bit_cast(float, __builtin_amdgcn_ds_swizzle(__builtin_bit_cast(int, v.w), (4 << 10) | 0x1f));
            const f32x4 o = v * cosv + (p * sinv) * sgn; st_bf4(Qb + mo, o * QSCALE);
        }
        {
            const f32x4 v = ld4(z + 256 + c4); f32x4 p; p.x = __builtin_bit_cast(float, __builtin_amdgcn_ds_swizzle(__builtin_bit_cast(int, v.x), (4 << 10) | 0x1f)); p.y = __builtin_bit_cast(float, __builtin_amdgcn_ds_swizzle(__builtin_bit_cast(int, v.y), (4 << 10) | 0x1f)); p.z = __builtin_bit_cast(float, __builtin_amdgcn_ds_swizzle(__builtin_bit_cast(int, v.z), (4 << 10) | 0x1f)); p.w = __builtin_bit_cast(float, __builtin_amdgcn_ds_swizzle(__builtin_bit_cast(int, v.w), (4 << 10) | 0x1f));
            const f32x4 o = v * cosv + (p * sinv) * sgn;
            if (!samp) { const int t = m & (TSEQ - 1), bh = (m >> 13) * 4 + (lane >> 4);
                st_bf4((bf16*)(C.ws<unsigned char>(WS_KT) + ((size_t)(bh * 128 + (t >> 6)) * 8192 + ((lane & 15) >> 1) * 1024 + (t & 63) * 16 + (lane & 1) * 8)), o); }
        }
        { const f32x4 v = ld4(z + 512 + c4);
            if (!samp) { const int t = m & (TSEQ - 1), bh = (m >> 13) * 4 + (lane >> 4), row = t & 63;
                st_bf4((bf16*)(C.ws<unsigned char>(WS_VT) + ((size_t)(bh * 128 + (t >> 6)) * 8192 + ((((lane & 15) >> 3) * 4 + (row >> 4)) * 1024) + (row & 15) * 64 + (lane & 7) * 8)), v); } }
        { const f32x4 v = ld4(z + 768 + c4); st_bf4(GA + mo, (f32x4){silu_f(v.x), silu_f(v.y), silu_f(v.z), silu_f(v.w)}); }
        { const f32x4 v = ld4(z + 1024 + c4); st_bf4(U + mo, (f32x4){gelu_f(v.x), gelu_f(v.y), gelu_f(v.z), gelu_f(v.w)}); }
        { const f32x4 v = ld4(z + 1280 + c4); st_bf4(VN + mo, (f32x4){gelu_f(v.x), gelu_f(v.y), gelu_f(v.z), gelu_f(v.w)}); }
        { const f32x4 v = ld4(z + 1536 + c4); st_bf4(GB + mo, (f32x4){silu_f(v.x), silu_f(v.y), silu_f(v.z), silu_f(v.w)}); }
        {
            const f32x4 a = ld4(z + 1792 + (c4 >> 7) * 256 + (c4 & 127)), g = ld4(z + 1792 + (c4 >> 7) * 256 + 128 + (c4 & 127));
            const f32x4 glu = (f32x4){a.x * sigmoid_f(g.x), a.y * sigmoid_f(g.y), a.z * sigmoid_f(g.z), a.w * sigmoid_f(g.w)};
            st4(GLU + mo, glu);
        }
        { const f32x4 v = ld4(z + 2304 + c4); st_bf4(GC + mo, (f32x4){silu_f(v.x), silu_f(v.y), silu_f(v.z), silu_f(v.w)}); }
        { const f32x4 v = ld4(z + 2560 + c4); st_bf4(QD + mo, (f32x4){silu_f(v.x), silu_f(v.y), silu_f(v.z), silu_f(v.w)}); }
        {
            const f32x4 v = ld4(z + 2816 + c4); f32x4 f, lf;
            f.x = lb.x + (1.f - lb.x) * sigmoid_f(v.x); f.y = lb.y + (1.f - lb.y) * sigmoid_f(v.y); f.z = lb.z + (1.f - lb.z) * sigmoid_f(v.z); f.w = lb.w + (1.f - lb.w) * sigmoid_f(v.w);
            lf.x = __logf(fmaxf(f.x, 1e-30f)); lf.y = __logf(fmaxf(f.y, 1e-30f)); lf.z = __logf(fmaxf(f.z, 1e-30f)); lf.w = __logf(fmaxf(f.w, 1e-30f));
            st4(LF + mo, lf); st_bf4(KD + mo, 1.f - f);
        }
        { const f32x4 v = ld4(z + 3072 + c4); st_bf4(VD + mo, v); }
        { const f32x4 v = ld4(z + 3328 + c4); st_bf4(GD + mo, (f32x4){silu_f(v.x), silu_f(v.y), silu_f(v.z), silu_f(v.w)}); }
    }
}

#endif

__device__ __forceinline__ void sg_unit(const Ctx& C, int l, int u) {
    const CAS Args& A = *C.a; const bf16 *U = C.ws<bf16>(WS_U), *VN = C.ws<bf16>(WS_VN), *GB = C.ws<bf16>(WS_GB); bf16* MIX = C.ws<bf16>(WS_MIX);
    LAS float* vn = (LAS float*)C.lds;
    const int r0 = (u - 128) * 8; const size_t m0 = (size_t)MP + r0;
    {   const int i = C.wave; const f32x4 gam = ld4(A.in[I_SGG] + l * 256 + 4 * C.lane), bet = ld4(A.in[I_SGB] + l * 256 + 4 * C.lane);
        const f32x4 v = ld_bf4(VN + (m0 + i) * 256 + 4 * C.lane);
        const float mean = wave_sum((v.x + v.y) + (v.z + v.w)) * (1.f / 256.f); const f32x4 d = v - mean;
        const float var = wave_sum((d.x * d.x + d.y * d.y) + (d.z * d.z + d.w * d.w)) * (1.f / 256.f);
        const f32x4 y = d * rsqrtf(var + EPS) * gam + bet;
        *(LAS f32x4*)(vn + i * 256 + 4 * C.lane) = y; st4(A.out + O_CH + ((size_t)l * MS + r0 + i) * 256 + 4 * C.lane, y); }
    __syncthreads();
    const int col = C.tid & 255, th = C.tid >> 8, g = col >> 6;
    const float* w = A.in[I_WS] + (size_t)(l * 4 + g) * 128 * 128; const float* bs = A.in[I_BS] + (l * 4 + g) * 128;
    f32x4 wv[4][2]; float bsv[4], uu[4], gg[4];
#pragma unroll
    for (int i = 0; i < 4; ++i) { const int t = th * 4 + i; wv[i][0] = ld4(w + t * 128); wv[i][1] = ld4(w + t * 128 + 4); bsv[i] = bs[t];
        const size_t mo = (m0 + t) * 256 + col; uu[i] = bf2f(U[mo]); gg[i] = bf2f(GB[mo]); }
    float vv[8];
#pragma unroll
    for (int s_ = 0; s_ < 8; ++s_) vv[s_] = vn[s_ * 256 + col];
#pragma unroll
    for (int i = 0; i < 4; ++i) { const int t = th * 4 + i; float acc = 0.f;
#pragma unroll
        for (int s_ = 0; s_ < 8; ++s_) { const float wt = s_ < 4 ? wv[i][0][s_] : wv[i][1][s_ - 4]; acc += (s_ <= t) ? wt * vv[s_] : 0.f; }
        MIX[(m0 + t) * DM + 256 + col] = (bf16)f2bf(uu[i] * (acc + bsv[i]) * gg[i]); }
    __syncthreads();
}

__device__ __forceinline__ void conv_unit(const Ctx& C, int l, int u, bf16* MIX) {
    const CAS Args& A = *C.a; const float* GLU = C.ws<float>(WS_GLU); const bf16* GC = C.ws<bf16>(WS_GC);
    LAS float* Ys = (LAS float*)C.lds;
    const int c = C.tid & 255, rh = C.tid >> 8, r0 = u * 16;
    const float* cw = A.in[I_CW] + (size_t)l * 31 * 256 + c; const float cb = A.in[I_CB][l * 256 + c];
    for (int i = 0; i < 8; ++i) {
        const int rr = rh * 8 + i, m = r0 + rr; float y = cb;
        if (m < MP) { const int t = m & (TSEQ - 1);
            for (int j = 0; j < 31; ++j) { const int tt = t + j - 30; if (tt >= 0) y += cw[j * 256] * GLU[(size_t)(m + j - 30) * 256 + c]; }
        } else { const int r = m - MP, bs = r >> 3, ts = r & 7; const float* sc = A.in[I_SCONV] + (size_t)(l * NBS + bs) * 30 * 256 + c;
            for (int j = 0; j < 31; ++j) { const int tt = ts + j - 30; const float h = tt >= 0 ? GLU[(size_t)(m + j - 30) * 256 + c] : sc[(ts + j) * 256]; y += cw[j * 256] * h; }
        }
        Ys[rr * 256 + c] = y;
    }
    __syncthreads();
    {
        const f32x4 g = ld4(A.in[I_CNG] + l * 256 + 4 * C.lane), b = ld4(A.in[I_CNB] + l * 256 + 4 * C.lane);
        for (int i = 0; i < 2; ++i) { const int rr = C.wave * 2 + i; LAS f32x4* p = (LAS f32x4*)(Ys + rr * 256) + C.lane; f32x4 v = *p;
            const float mean = wave_sum((v.x + v.y) + (v.z + v.w)) * (1.f / 256.f); const f32x4 d = v - mean;
            const float var = wave_sum((d.x * d.x + d.y * d.y) + (d.z * d.z + d.w * d.w)) * (1.f / 256.f);
            f32x4 y = d * rsqrtf(var + EPS) * g + b; y = (f32x4){silu_f(y.x), silu_f(y.y), silu_f(y.z), silu_f(y.w)}; *p = y; }
    }
    __syncthreads();
    {
        float acc[8];
#pragma unroll
        for (int i = 0; i < 8; ++i) acc[i] = 0.f;
        const float* wp = A.in[I_WPW] + (size_t)l * 256 * 256 + c;
        for (int k = 0; k < 256; k += 4) {
            const float w0 = wp[(k + 0) * 256], w1 = wp[(k + 1) * 256], w2 = wp[(k + 2) * 256], w3 = wp[(k + 3) * 256];
#pragma unroll
            for (int i = 0; i < 8; ++i) { const f32x4 y = *(const LAS f32x4*)(Ys + (rh * 8 + i) * 256 + k); acc[i] += y.x * w0 + y.y * w1 + y.z * w2 + y.w * w3; }
        }
#pragma unroll
        for (int i = 0; i < 8; ++i) { const int m = r0 + rh * 8 + i; MIX[(size_t)m * DM + 512 + c] = (bf16)f2bf(acc[i] * bf2f(GC[(size_t)m * 256 + c])); }
    }
    __syncthreads();
}

template <int MODE> __device__ __forceinline__ void hgrn_item(const Ctx& C, int l, int item) {
    const CAS Args& A = *C.a; const int lane = C.lane;
    const float* LF = C.ws<float>(WS_LF); const bf16 *QD = C.ws<bf16>(WS_QD), *KD = C.ws<bf16>(WS_KD), *VD = C.ws<bf16>(WS_VD), *GD = C.ws<bf16>(WS_GD); bf16* MIX = C.ws<bf16>(WS_MIX);
    LAS float* Fs = (LAS float*)(C.lds + C.wave * 12288); LAS float* Ks = Fs + 1024; LAS float* Qs = Fs + 2048;
    int h, m0, ntok; size_t sidx;
    if (MODE == 2) { const int bs = item >> 2; h = item & 3; m0 = MP + bs * 8; ntok = 8; sidx = ((size_t)(l * NBS + bs) * 4 + h) * 4096; }
    else { const int bh = item >> 7, j = item & 127; h = bh & 3; m0 = (bh >> 2) * TSEQ + j * HG_L; ntok = HG_L; sidx = (size_t)item * 4096; }
    float S[64];
    if (MODE == 0) {
#pragma unroll
        for (int k = 0; k < 64; ++k) S[k] = 0.f;
    } else { const float* s0 = MODE == 2 ? A.in[I_SHGRN] + sidx : C.ws<float>(WS_SST) + sidx;
#pragma unroll
        for (int k = 0; k < 64; ++k) S[k] = s0[k * 64 + lane]; }
    const float gn = A.in[I_HNG][l * 64 + lane];
    float lfsum = 0.f;
    for (int c0 = 0; c0 < ntok; c0 += 16) {
        const int nt = (ntok - c0) < 16 ? (ntok - c0) : 16;
        for (int tt = 0; tt < nt; ++tt) { const size_t o = (size_t)(m0 + c0 + tt) * 256 + h * 64 + lane; const float lf = LF[o]; lfsum += lf;
            Fs[tt * 64 + lane] = __expf(lf); Ks[tt * 64 + lane] = bf2f(KD[o]); if (MODE != 0) Qs[tt * 64 + lane] = bf2f(QD[o]); }
        LDS_WAIT();
#pragma unroll 1
        for (int tt = 0; tt < nt; ++tt) {
            const int m = m0 + c0 + tt; const size_t o = (size_t)m * 256 + h * 64 + lane;
            const float vd = bf2f(VD[o]); float oacc = 0.f;
#pragma unroll
            for (int k4 = 0; k4 < 16; ++k4) {
                const f32x4 f = *(const LAS f32x4*)(Fs + tt * 64 + 4 * k4), kd = *(const LAS f32x4*)(Ks + tt * 64 + 4 * k4);
                S[4 * k4 + 0] = f.x * S[4 * k4 + 0] + kd.x * vd; S[4 * k4 + 1] = f.y * S[4 * k4 + 1] + kd.y * vd;
                S[4 * k4 + 2] = f.z * S[4 * k4 + 2] + kd.z * vd; S[4 * k4 + 3] = f.w * S[4 * k4 + 3] + kd.w * vd;
                if (MODE != 0) { const f32x4 q = *(const LAS f32x4*)(Qs + tt * 64 + 4 * k4);
                    oacc += S[4 * k4 + 0] * q.x + S[4 * k4 + 1] * q.y + S[4 * k4 + 2] * q.z + S[4 * k4 + 3] * q.w; }
            }
            if (MODE != 0) { const float ss = wave_sum(oacc * oacc) * (1.f / 64.f);
                const float on = oacc * rsqrtf(ss + EPS) * gn * bf2f(GD[o]);
                MIX[(size_t)m * DM + 768 + h * 64 + lane] = (bf16)f2bf(on); }
        }
        LDS_WAIT();
    }
    if (MODE == 0) { float* sl = C.ws<float>(WS_SLOC) + sidx;
#pragma unroll
        for (int k = 0; k < 64; ++k) sl[k * 64 + lane] = S[k];
        C.ws<float>(WS_DTOT)[(size_t)item * 64 + lane] = __expf(lfsum); }
    if (MODE == 2) { float* so = A.out + O_HS + sidx;
#pragma unroll
        for (int k = 0; k < 64; ++k) so[k * 64 + lane] = S[k]; }
}
__device__ __forceinline__ void hgrn_scan_unit(const Ctx& C, int l, int u) {
    const int seg = C.tid >> 6, kvl = C.tid & 63, bh = u >> 6, kv = (u & 63) * 64 + kvl, k = kv >> 6;
    const float* sl = C.ws<float>(WS_SLOC) + ((size_t)bh * HG_NB + seg * 16) * 4096 + kv; float* ss = C.ws<float>(WS_SST) + ((size_t)bh * HG_NB + seg * 16) * 4096 + kv;
    const float* dt = C.ws<float>(WS_DTOT) + ((size_t)bh * HG_NB + seg * 16) * 64 + k;
    LAS f32x2v* X = (LAS f32x2v*)C.lds;
    float a[16], d[16];
#pragma unroll
    for (int j = 0; j < 16; ++j) { a[j] = sl[(size_t)j * 4096]; d[j] = dt[j * 64]; }
    float D = 1.f, Acc = 0.f;
#pragma unroll
    for (int j = 0; j < 16; ++j) { Acc = d[j] * Acc + a[j]; D *= d[j]; }
    X[seg * 64 + kvl] = (f32x2v){D, Acc};
    __syncthreads();
    float S = 0.f;
    for (int q = 0; q < seg; ++q) { const f32x2v x = X[q * 64 + kvl]; S = x.x * S + x.y; }
#pragma unroll
    for (int j = 0; j < 16; ++j) { ss[(size_t)j * 4096] = S; S = d[j] * S + a[j]; }
    if (seg == 7) C.a->out[O_HP + ((size_t)l * 8 + bh) * 4096 + kv] = S;
    __syncthreads();
}

__device__ __forceinline__ void attn_unit_naive(const Ctx& C, int l, int u) {
    const CAS Args& A = *C.a; const bf16 *Qb = C.ws<bf16>(WS_Q), *Kb = C.ws<bf16>(WS_KR), *Vb = C.ws<bf16>(WS_VR), *GA = C.ws<bf16>(WS_GA); bf16* MIX = C.ws<bf16>(WS_MIX);
    const int bh = u & 7, qb = 31 - (u >> 3), b = bh >> 2, h = bh & 3;
    const int map = C.tid >> 8, qi = C.tid & 255, t = qb * 256 + qi; const size_t m = (size_t)b * TSEQ + t;
    LAS unsigned* Ksm = (LAS unsigned*)C.lds;
    LAS unsigned* Vsm = (LAS unsigned*)(C.lds + 32768);
    LAS float* O2 = (LAS float*)C.lds;
    float q[32], acc[64];
    { const v4u* qp = (const v4u*)(Qb + m * 256 + h * 64 + map * 32);
#pragma unroll
        for (int i = 0; i < 4; ++i) { const v4u w = qp[i]; q[8 * i] = bflo(w.x); q[8 * i + 1] = bfhi(w.x); q[8 * i + 2] = bflo(w.y); q[8 * i + 3] = bfhi(w.y); q[8 * i + 4] = bflo(w.z); q[8 * i + 5] = bfhi(w.z); q[8 * i + 6] = bflo(w.w); q[8 * i + 7] = bfhi(w.w); } }
#pragma unroll
    for (int d = 0; d < 64; ++d) acc[d] = 0.f;
    float mx = -1e30f, lsum = 0.f;
    for (int kt = 0; kt <= qb; ++kt) {
        __syncthreads();
        for (int p = C.tid; p < 4096; p += NTHR) { const int arr = p >> 11, row = (p >> 3) & 255, pc = p & 7;
            const bf16* src = (arr ? Vb : Kb) + ((size_t)b * TSEQ + kt * 256 + row) * 256 + h * 64 + pc * 8;
            *(LAS v4u*)((arr ? Vsm : Ksm) + row * 32 + pc * 4) = *(const v4u*)src; }
        __syncthreads();
        const int jn = (kt == qb) ? 256 : 256;
#pragma unroll 1
        for (int j = 0; j < jn; ++j) {
            if (kt * 256 + j > t) break;
            const LAS v4u* kp = (const LAS v4u*)(Ksm + j * 32 + map * 16);
            float s = 0.f;
#pragma unroll
            for (int i = 0; i < 4; ++i) { const v4u w = kp[i];
                s += q[8 * i] * bflo(w.x) + q[8 * i + 1] * bfhi(w.x) + q[8 * i + 2] * bflo(w.y) + q[8 * i + 3] * bfhi(w.y) + q[8 * i + 4] * bflo(w.z) + q[8 * i + 5] * bfhi(w.z) + q[8 * i + 6] * bflo(w.w) + q[8 * i + 7] * bfhi(w.w); }
            if (s > mx) { const float sc = exp2f(mx - s); lsum *= sc;
#pragma unroll
                for (int d = 0; d < 64; ++d) acc[d] *= sc;
                mx = s; }
            const float p = exp2f(s - mx); lsum += p;
            const LAS v4u* vp = (const LAS v4u*)(Vsm + j * 32);
#pragma unroll
            for (int i = 0; i < 8; ++i) { const v4u w = vp[i];
                acc[8 * i] += p * bflo(w.x); acc[8 * i + 1] += p * bfhi(w.x); acc[8 * i + 2] += p * bflo(w.y); acc[8 * i + 3] += p * bfhi(w.y);
                acc[8 * i + 4] += p * bflo(w.z); acc[8 * i + 5] += p * bfhi(w.z); acc[8 * i + 6] += p * bflo(w.w); acc[8 * i + 7] += p * bfhi(w.w); }
        }
    }
    __syncthreads();
    const float il = 1.f / lsum;
    if (map == 1) {
#pragma unroll
        for (int d = 0; d < 64; ++d) O2[qi * 65 + d] = acc[d] * il;
    }
    __syncthreads();
    if (map == 0) {
        const float lam = C.ws<float>(WS_SCAL)[l]; const float lam_init = l == 0 ? 0.2f : 0.35550906759096934f;
        float ss = 0.f;
#pragma unroll
        for (int d = 0; d < 64; ++d) { acc[d] = acc[d] * il - lam * O2[qi * 65 + d]; ss += acc[d] * acc[d]; }
        const float rs = rsqrtf(ss * (1.f / 64.f) + EPS) * (1.f - lam_init);
        const float* g = A.in[I_ANG] + l * 64;
#pragma unroll
        for (int d = 0; d < 64; d += 2) { const unsigned ga = *(const unsigned*)(GA + m * 256 + h * 64 + d);
            *(unsigned*)(MIX + m * DM + h * 64 + d) = pk2(acc[d] * rs * g[d] * bflo(ga), acc[d + 1] * rs * g[d + 1] * bfhi(ga)); }
    }
    __syncthreads();
}

namespace fa {
typedef float f32x16 __attribute__((ext_vector_type(16)));
typedef short bf16x8 __attribute__((ext_vector_type(8)));
typedef short s16x4 __attribute__((ext_vector_type(4)));
typedef short v4i16_t __attribute__((ext_vector_type(4)));
typedef float f32x2_t __attribute__((ext_vector_type(2))); typedef __bf16 bf16x2_t __attribute__((ext_vector_type(2)));
constexpr int SLOT = 16384;
constexpr int LDS_WSF = 65536;
constexpr int LDS_EX = 65536 + 4096;
constexpr float THR = 32.f;
__device__ __forceinline__ float max3f(float a, float b, float c) { return __builtin_fmaxf(__builtin_fmaxf(a, b), c); }
__device__ __forceinline__ unsigned cvtpk(float lo, float hi) { f32x2_t v = {lo, hi}; bf16x2_t b = __builtin_convertvector(v, bf16x2_t); return __builtin_bit_cast(unsigned, b); }
__device__ __forceinline__ float half_swap_max(float m) { auto rr = __builtin_amdgcn_permlane32_swap(__float_as_uint(m), __float_as_uint(m), false, false); return __builtin_fmaxf(__uint_as_float(rr[0]), __uint_as_float(rr[1])); }
__device__ __forceinline__ float half_swap_sum(float m) { auto rr = __builtin_amdgcn_permlane32_swap(__float_as_uint(m), __float_as_uint(m), false, false); return __uint_as_float(rr[0]) + __uint_as_float(rr[1]); }
__device__ __forceinline__ float rowmax(const f32x16& p0, const f32x16& p1) {
    float a = max3f(p0[0], p0[1], p1[0]), b = max3f(p0[2], p0[3], p1[1]); a = max3f(a, p1[2], p1[3]);
#pragma unroll
    for (int r = 4; r < 16; r += 4) { a = max3f(a, p0[r], p0[r + 1]); b = max3f(b, p0[r + 2], p0[r + 3]); a = max3f(a, p1[r], p1[r + 1]); b = max3f(b, p1[r + 2], p1[r + 3]); }
    return half_swap_max(__builtin_fmaxf(a, b));
}
__device__ __forceinline__ s16x4 vtr(const LAS unsigned char* p) { return __builtin_bit_cast(s16x4, __builtin_amdgcn_ds_read_tr16_b64_v4i16((LAS v4i16_t*)p)); }
__device__ __forceinline__ void softmax_step(const bool FIRST, f32x16& S0, f32x16& S1, float& m, float& lsum, f32x16 (&O)[2], LAS float* wsf, int r32, int hi, bf16x8 (&pk)[4]) {
    const float rm = rowmax(S0, S1);
    if (FIRST) m = (rm != -INFINITY && fabsf(rm) > THR) ? rm : 0.f;
    else if (__any(rm - m > THR)) {
        const float mn = __builtin_fmaxf(m, rm); const float f = __builtin_amdgcn_exp2f(m - mn); m = mn; lsum *= f;
        if (hi == 0) wsf[r32] = f;
        LDS_WAIT();
#pragma unroll
        for (int g = 0; g < 4; ++g) { const f32x4 fv = *(const LAS f32x4*)(wsf + 8 * g + 4 * hi);
#pragma unroll
            for (int j = 0; j < 4; ++j) { O[0][4 * g + j] *= fv[j]; O[1][4 * g + j] *= fv[j]; } }
        LDS_WAIT();
    }
    float s = 0.f;
    if (__all(m == 0.f)) {
#pragma unroll
        for (int r = 0; r < 16; ++r) { S0[r] = __builtin_amdgcn_exp2f(S0[r]); S1[r] = __builtin_amdgcn_exp2f(S1[r]); s += S0[r] + S1[r]; }
    } else {
#pragma unroll
        for (int r = 0; r < 16; ++r) { S0[r] = __builtin_amdgcn_exp2f(S0[r] - m); S1[r] = __builtin_amdgcn_exp2f(S1[r] - m); s += S0[r] + S1[r]; }
    }
    lsum += s;
    v4u w;
    w.x = cvtpk(S0[0], S0[1]); w.y = cvtpk(S0[2], S0[3]); w.z = cvtpk(S0[4], S0[5]); w.w = cvtpk(S0[6], S0[7]); pk[0] = __builtin_bit_cast(bf16x8, w);
    w.x = cvtpk(S0[8], S0[9]); w.y = cvtpk(S0[10], S0[11]); w.z = cvtpk(S0[12], S0[13]); w.w = cvtpk(S0[14], S0[15]); pk[1] = __builtin_bit_cast(bf16x8, w);
    w.x = cvtpk(S1[0], S1[1]); w.y = cvtpk(S1[2], S1[3]); w.z = cvtpk(S1[4], S1[5]); w.w = cvtpk(S1[6], S1[7]); pk[2] = __builtin_bit_cast(bf16x8, w);
    w.x = cvtpk(S1[8], S1[9]); w.y = cvtpk(S1[10], S1[11]); w.z = cvtpk(S1[12], S1[13]); w.w = cvtpk(S1[14], S1[15]); pk[3] = __builtin_bit_cast(bf16x8, w);
}
__device__ __forceinline__ void cmask(f32x16& p0, f32x16& p1, int krel0, int qrel, int hi) {
    asm volatile("" : "+v"(hi), "+v"(qrel));
#pragma unroll
    for (int r = 0; r < 16; ++r) { const int kv = krel0 + 4 * hi + (r & 3) + 8 * (r >> 2); if (kv > qrel) p0[r] = -INFINITY; if (kv + 32 > qrel) p1[r] = -INFINITY; }
}
#define FA_MFMA(a, b, c) __builtin_amdgcn_mfma_f32_32x32x16_bf16((a), (b), (c), 0, 0, 0)
__device__ __forceinline__ void tile_step(const bool FIRST, const LAS unsigned char* slot, const bf16x8 (&qr)[4], bool band, int krel0, int qrel, int r32, int hi, int lane,
        float& m_a, float& l_a, f32x16 (&Oa)[2], float& m_b, float& l_b, f32x16 (&Ob)[2], LAS float* wsf, const bf16* Kg, const bf16* Vg) {
#if MK_CHECK == 2
    const bf16* kp = Kg + (size_t)r32 * 256 + hi * 8;
#define KFR(off) (*(const bf16x8*)(kp + ((off) >> 10 >> 1) * 16 + (((off) >> 9) & 1) * 32 * 256))
#else
    const LAS unsigned char* kp = slot + hi * 1024 + r32 * 16;
#define KFR(off) (*(const LAS bf16x8*)(kp + (off)))
#endif
    bf16x8 pa[4], pb[4];
    {   f32x16 S0, S1;
        const bf16x8 k00 = KFR(0), k01 = KFR(512), k10 = KFR(2048), k11 = KFR(2048 + 512);
        S0 = FA_MFMA(k00, qr[0], (f32x16{})); S1 = FA_MFMA(k01, qr[0], (f32x16{})); S0 = FA_MFMA(k10, qr[1], S0); S1 = FA_MFMA(k11, qr[1], S1);
        if (band) cmask(S0, S1, krel0, qrel, hi);
        softmax_step(FIRST, S0, S1, m_a, l_a, Oa, wsf, r32, hi, pa);
    }
    asm volatile("" ::: "memory");
    {   f32x16 S0, S1;
        const bf16x8 k00 = KFR(4096), k01 = KFR(4096 + 512), k10 = KFR(6144), k11 = KFR(6144 + 512);
        S0 = FA_MFMA(k00, qr[2], (f32x16{})); S1 = FA_MFMA(k01, qr[2], (f32x16{})); S0 = FA_MFMA(k10, qr[3], S0); S1 = FA_MFMA(k11, qr[3], S1);
        if (band) cmask(S0, S1, krel0, qrel, hi);
        softmax_step(FIRST, S0, S1, m_b, l_b, Ob, wsf + 64, r32, hi, pb);
    }
    asm volatile("" ::: "memory");
    const LAS unsigned char* vp = slot + 8192 + ((lane >> 4) & 1) * 32 + (lane & 3) * 8 + (4 * hi + ((lane & 15) >> 2)) * 64;
#pragma unroll
    for (int d0 = 0; d0 < 2; ++d0)
#pragma unroll
        for (int ks = 0; ks < 4; ++ks) {
#if MK_CHECK == 2
            bf16x8 vf;
#pragma unroll
            for (int j = 0; j < 8; ++j) vf[j] = (short)Vg[(size_t)(16 * ks + 8 * (j >> 2) + 4 * hi + (j & 3)) * 256 + 32 * d0 + r32];
#else
            const s16x4 lo = vtr(vp + d0 * 4096 + ks * 1024), hh = vtr(vp + d0 * 4096 + ks * 1024 + 512);
            const bf16x8 vf = (bf16x8){lo[0], lo[1], lo[2], lo[3], hh[0], hh[1], hh[2], hh[3]};
#endif
            Oa[d0] = FA_MFMA(pa[ks], vf, Oa[d0]); Ob[d0] = FA_MFMA(pb[ks], vf, Ob[d0]);
            if (ks == 3) asm volatile("" ::: "memory");
        }
#undef KFR
}
#define FA_WAITBAR() do { asm volatile("s_waitcnt vmcnt(0) lgkmcnt(0)" ::: "memory"); __builtin_amdgcn_s_barrier(); asm volatile("" ::: "memory"); } while (0)

__device__ __forceinline__ void unit(const Ctx& C, int l, int bh, int y, bf16* MIX) {
    int lane = C.lane; asm volatile("" : "+v"(lane));
    const int wid = C.wave, r32 = lane & 31, hi = lane >> 5, half = wid >> 2, wq = wid & 3;
    const int b = bh >> 2, h = bh & 3; const int q0 = 128 * y, qrel = 32 * wq + r32;
    const size_t rowbase = (size_t)b * TSEQ;
    const bf16* Qw = C.ws<bf16>(WS_Q) + (rowbase + q0 + qrel) * 256 + h * 64;
    const unsigned char* KT = C.ws<unsigned char>(WS_KT) + (size_t)bh * 128 * 8192 + wid * 1024 + lane * 16;
    const unsigned char* VT = C.ws<unsigned char>(WS_VT) + (size_t)bh * 128 * 8192 + wid * 1024 + lane * 16;
    LAS unsigned char* lds = C.lds; LAS float* wsf = (LAS float*)(lds + LDS_WSF) + wid * 128;
    bf16x8 qr[4];
#pragma unroll
    for (int d0 = 0; d0 < 4; ++d0) qr[d0] = *(const bf16x8*)(Qw + d0 * 16 + hi * 8);
    const int nsteps = y + 1;
#define FA_DMA(i) do { _Pragma("unroll") for (int hf_ = 0; hf_ < 2; ++hf_) { const int t_ = 2 * (i) + hf_; LAS unsigned char* d_ = lds + ((((i) & 1) * 2 + hf_) * SLOT) + wid * 1024; \
        __builtin_amdgcn_global_load_lds((const unsigned*)(KT + (size_t)t_ * 8192), (LAS unsigned*)d_, 16, 0, 0); \
        __builtin_amdgcn_global_load_lds((const unsigned*)(VT + (size_t)t_ * 8192), (LAS unsigned*)(d_ + 8192), 16, 0, 0); } } while (0)
    float m_a = 0.f, l_a = 0.f, m_b = 0.f, l_b = 0.f; f32x16 Oa[2], Ob[2];
    Oa[0] = f32x16{}; Oa[1] = f32x16{}; Ob[0] = f32x16{}; Ob[1] = f32x16{};
    FA_DMA(0);
    FA_WAITBAR();
#pragma unroll 1
    for (int i = 0; i < nsteps; ++i) {
        if (i + 1 < nsteps) FA_DMA(i + 1);
        const int t = 2 * i + half; const bool band = t >= 2 * y;
        tile_step(i == 0, lds + ((i & 1) * 2 + half) * SLOT, qr, band, 64 * (t - 2 * y), qrel, r32, hi, lane, m_a, l_a, Oa, m_b, l_b, Ob, wsf,
                  C.ws<bf16>(WS_KR) + (rowbase + (size_t)t * 64) * 256 + h * 64, C.ws<bf16>(WS_VR) + (rowbase + (size_t)t * 64) * 256 + h * 64);
        FA_WAITBAR();
    }
    l_a = half_swap_sum(l_a); l_b = half_swap_sum(l_b);
    LAS f32x4* EX = (LAS f32x4*)(lds + LDS_EX);
    if (hi == 0) EX[wid * 32 + r32] = (f32x4){m_a, l_a, m_b, l_b};
    FA_WAITBAR();
    {   const f32x4 o = EX[(wid ^ 4) * 32 + r32];
        const float lam = C.ws<float>(WS_SCAL)[l];
        const float Ma = __builtin_fmaxf(m_a, o.x), fa_ = __builtin_amdgcn_exp2f(m_a - Ma), fa2 = __builtin_amdgcn_exp2f(o.x - Ma); const float ca = fa_ / (l_a * fa_ + o.y * fa2);
        const float Mb = __builtin_fmaxf(m_b, o.z), fb_ = __builtin_amdgcn_exp2f(m_b - Mb), fb2 = __builtin_amdgcn_exp2f(o.z - Mb); const float cb = -lam * fb_ / (l_b * fb_ + o.w * fb2);
        if (hi == 0) { wsf[r32] = ca; wsf[64 + r32] = cb; }
        LDS_WAIT();
    }
    f32x16 part[2];
#pragma unroll
    for (int g = 0; g < 4; ++g) { const f32x4 fa4 = *(const LAS f32x4*)(wsf + 8 * g + 4 * hi), fb4 = *(const LAS f32x4*)(wsf + 64 + 8 * g + 4 * hi);
#pragma unroll
        for (int j = 0; j < 4; ++j) { part[0][4 * g + j] = Oa[0][4 * g + j] * fa4[j] + Ob[0][4 * g + j] * fb4[j]; part[1][4 * g + j] = Oa[1][4 * g + j] * fa4[j] + Ob[1][4 * g + j] * fb4[j]; } }
    LAS float* XO = (LAS float*)lds + wq * 2048;
    if (half == 1) {
#pragma unroll
        for (int r = 0; r < 16; ++r) { XO[r * 64 + lane] = part[0][r]; XO[(16 + r) * 64 + lane] = part[1][r]; }
    }
    FA_WAITBAR();
    if (half == 0) {
        const float lam_init = l == 0 ? 0.2f : 0.35550906759096934f;
        float ss[16];
#pragma unroll
        for (int r = 0; r < 16; ++r) { part[0][r] += XO[r * 64 + lane]; part[1][r] += XO[(16 + r) * 64 + lane]; ss[r] = part[0][r] * part[0][r] + part[1][r] * part[1][r]; }
#pragma unroll
        for (int r = 0; r < 16; ++r) { ss[r] = sx_sum<1>(ss[r]); ss[r] = sx_sum<2>(ss[r]); ss[r] = sx_sum<4>(ss[r]); ss[r] = sx_sum<8>(ss[r]); ss[r] = sx_sum<16>(ss[r]); }
        const float* g = C.a->in[I_ANG] + l * 64; const float g0 = g[r32], g1 = g[32 + r32];
        const bf16* GA = C.ws<bf16>(WS_GA);
#pragma unroll
        for (int r = 0; r < 16; ++r) { const size_t row = rowbase + q0 + 32 * wq + (r & 3) + 8 * (r >> 2) + 4 * hi;
            const float rs = rsqrtf(ss[r] * (1.f / 64.f) + EPS) * (1.f - lam_init);
            MIX[row * DM + h * 64 + r32] = (bf16)f2bf(part[0][r] * rs * g0 * bf2f(GA[row * 256 + h * 64 + r32]));
            MIX[row * DM + h * 64 + 32 + r32] = (bf16)f2bf(part[1][r] * rs * g1 * bf2f(GA[row * 256 + h * 64 + 32 + r32])); }
    }
    FA_WAITBAR();
#undef FA_DMA
}
}

namespace sgm {
using fa::f32x16; using fa::bf16x8;
constexpr int VT_STRIDE = 272;
__device__ __forceinline__ void unit(const Ctx& C, int l, int chunk, bf16* MIX) {
    const CAS Args& A = *C.a;
    int lane = C.lane; asm volatile("" : "+v"(lane));
    const int r32 = lane & 31, hi = lane >> 5, wid = C.wave, g = wid >> 1, th = wid & 1, tid = wid * 64 + lane;
    const bf16 *U = C.ws<bf16>(WS_U), *VN = C.ws<bf16>(WS_VN), *GB = C.ws<bf16>(WS_GB);
    const size_t m0 = (size_t)chunk * 128;
    LAS unsigned char* VT = C.lds;
    {
        const f32x4 gam = ld4(A.in[I_SGG] + l * 256 + 4 * lane), bet = ld4(A.in[I_SGB] + l * 256 + 4 * lane);
        v2u raw[16];
#pragma unroll
        for (int i = 0; i < 16; ++i) raw[i] = *(const v2u*)(VN + (m0 + wid * 16 + i) * 256 + 4 * lane);
#pragma unroll
        for (int i = 0; i < 16; ++i) { const int s_ = wid * 16 + i; const f32x4 v = (f32x4){bflo(raw[i].x), bfhi(raw[i].x), bflo(raw[i].y), bfhi(raw[i].y)};
            const float mean = wave_sum((v.x + v.y) + (v.z + v.w)) * (1.f / 256.f); const f32x4 d = v - mean;
            const float var = wave_sum((d.x * d.x + d.y * d.y) + (d.z * d.z + d.w * d.w)) * (1.f / 256.f);
            const f32x4 y = d * rsqrtf(var + EPS) * gam + bet;
            LAS unsigned char* p = VT + (4 * lane) * VT_STRIDE + s_ * 2;
            *(LAS unsigned short*)(p) = (unsigned short)f2bf(y.x); *(LAS unsigned short*)(p + VT_STRIDE) = (unsigned short)f2bf(y.y);
            *(LAS unsigned short*)(p + 2 * VT_STRIDE) = (unsigned short)f2bf(y.z); *(LAS unsigned short*)(p + 3 * VT_STRIDE) = (unsigned short)f2bf(y.w); }
    }
    __syncthreads();
    const bf16* Wm = C.ws<bf16>(WS_WSB) + (size_t)(l * 4 + g) * 128 * 128;
    f32x16 acc[2][2];
#pragma unroll
    for (int a = 0; a < 2; ++a) { acc[a][0] = f32x16{}; acc[a][1] = f32x16{}; }
#pragma unroll
    for (int tbi = 0; tbi < 2; ++tbi) {
        const int tb = 2 * th + tbi; const bf16* wrow = Wm + (size_t)(tb * 32 + r32) * 128 + 8 * hi;
        const LAS unsigned char* vb = VT + (g * 64 + r32) * VT_STRIDE + 16 * hi;
        bf16x8 af[8];
#pragma unroll
        for (int ks = 0; ks < 8; ++ks) af[ks] = *(const bf16x8*)(wrow + 16 * ks);
#pragma unroll
        for (int ks = 0; ks < 8; ++ks) { if (ks < 2 * (tb + 1)) {
            const bf16x8 b0 = *(const LAS bf16x8*)(vb + 32 * ks), b1 = *(const LAS bf16x8*)(vb + 32 * VT_STRIDE + 32 * ks);
            acc[tbi][0] = FA_MFMA(af[ks], b0, acc[tbi][0]); acc[tbi][1] = FA_MFMA(af[ks], b1, acc[tbi][1]); } }
    }
    const float* bsv = A.in[I_BS] + (l * 4 + g) * 128;
#pragma unroll
    for (int tbi = 0; tbi < 2; ++tbi)
#pragma unroll
        for (int r = 0; r < 16; ++r) { const int t = (2 * th + tbi) * 32 + (r & 3) + 8 * (r >> 2) + 4 * hi; const float bias = bsv[t];
#pragma unroll
            for (int d0 = 0; d0 < 2; ++d0) { const int col = g * 64 + 32 * d0 + r32; const size_t mo = (m0 + t) * 256 + col;
                MIX[(m0 + t) * DM + 256 + col] = (bf16)f2bf(bf2f(U[mo]) * (acc[tbi][d0][r] + bias) * bf2f(GB[mo])); } }
    __syncthreads();
}
}

namespace cvm {
using fa::f32x16; using fa::bf16x8;
constexpr int Y_OFF = 0, YN_OFF = 65536, YN_STRIDE = 528;
__device__ __forceinline__ void unit(const Ctx& C, int l, int u, bf16* MIX) {
    const CAS Args& A = *C.a;
    int lane = C.lane; asm volatile("" : "+v"(lane));
    const int wid = C.wave, tid = wid * 64 + lane, r32 = lane & 31, hi = lane >> 5;
    const float* GLU = C.ws<float>(WS_GLU); const bf16* GC = C.ws<bf16>(WS_GC);
    LAS float* Y = (LAS float*)(C.lds + Y_OFF); LAS unsigned char* YN = C.lds + YN_OFF;
    const int r0 = u * 64; const bool samp = r0 >= MP;
    {
        const int c = tid & 255, half = tid >> 8;
        float cw[31];
#pragma unroll
        for (int j = 0; j < 31; ++j) cw[j] = A.in[I_CW][(size_t)(l * 31 + j) * 256 + c];
        const float cb = A.in[I_CB][l * 256 + c];
        if (!samp) {
            const int rg = half * 32, m = r0 + rg, t0 = m & (TSEQ - 1);
            float in[62];
#pragma unroll
            for (int k = 0; k < 62; ++k) { const int tt = t0 - 30 + k; in[k] = tt >= 0 ? GLU[(size_t)(m - 30 + k) * 256 + c] : 0.f; }
#pragma unroll
            for (int i = 0; i < 32; ++i) { float y = cb;
#pragma unroll
                for (int j = 0; j < 31; ++j) y += cw[j] * in[i + j];
                Y[(rg + i) * 256 + c] = y; }
        } else {
#pragma unroll 1
            for (int gq = 0; gq < 4; ++gq) {
                const int rg = half * 32 + gq * 8, m = r0 + rg;
                float in[38];
                const int bs = (m - MP) >> 3; const float* sc = A.in[I_SCONV] + (size_t)(l * NBS + bs) * 30 * 256 + c;
#pragma unroll
                for (int k = 0; k < 30; ++k) in[k] = sc[k * 256];
#pragma unroll
                for (int k = 0; k < 8; ++k) in[30 + k] = GLU[(size_t)(m + k) * 256 + c];
#pragma unroll
                for (int i = 0; i < 8; ++i) { float y = cb;
#pragma unroll
                    for (int j = 0; j < 31; ++j) y += cw[j] * in[i + j];
                    Y[(rg + i) * 256 + c] = y; }
            }
        }
    }
    __syncthreads();
    {
        const f32x4 g = ld4(A.in[I_CNG] + l * 256 + 4 * lane), b = ld4(A.in[I_CNB] + l * 256 + 4 * lane);
#pragma unroll
        for (int i4 = 0; i4 < 2; ++i4) { f32x4 v[4]; float sm[4], sq[4];
#pragma unroll
            for (int i = 0; i < 4; ++i) { v[i] = *(const LAS f32x4*)(Y + (wid * 8 + i4 * 4 + i) * 256 + 4 * lane); sm[i] = (v[i].x + v[i].y) + (v[i].z + v[i].w); }
#pragma unroll
            for (int i = 0; i < 4; ++i) sm[i] = sx_sum<1>(sm[i]);
#pragma unroll
            for (int i = 0; i < 4; ++i) sm[i] = sx_sum<2>(sm[i]);
#pragma unroll
            for (int i = 0; i < 4; ++i) sm[i] = sx_sum<4>(sm[i]);
#pragma unroll
            for (int i = 0; i < 4; ++i) sm[i] = sx_sum<8>(sm[i]);
#pragma unroll
            for (int i = 0; i < 4; ++i) sm[i] = sx_sum<16>(sm[i]);
#pragma unroll
            for (int i = 0; i < 4; ++i) { sm[i] = sx_sum<32>(sm[i]) * (1.f / 256.f); v[i] = v[i] - sm[i]; sq[i] = (v[i].x * v[i].x + v[i].y * v[i].y) + (v[i].z * v[i].z + v[i].w * v[i].w); }
#pragma unroll
            for (int i = 0; i < 4; ++i) sq[i] = sx_sum<1>(sq[i]);
#pragma unroll
            for (int i = 0; i < 4; ++i) sq[i] = sx_sum<2>(sq[i]);
#pragma unroll
            for (int i = 0; i < 4; ++i) sq[i] = sx_sum<4>(sq[i]);
#pragma unroll
            for (int i = 0; i < 4; ++i) sq[i] = sx_sum<8>(sq[i]);
#pragma unroll
            for (int i = 0; i < 4; ++i) sq[i] = sx_sum<16>(sq[i]);
#pragma unroll
            for (int i = 0; i < 4; ++i) { const float var = sx_sum<32>(sq[i]) * (1.f / 256.f); f32x4 y = v[i] * rsqrtf(var + EPS) * g + b; y = (f32x4){silu_f(y.x), silu_f(y.y), silu_f(y.z), silu_f(y.w)};
                v2u w; w.x = pk2(y.x, y.y); w.y = pk2(y.z, y.w); *(LAS v2u*)(YN + (wid * 8 + i4 * 4 + i) * YN_STRIDE + 8 * lane) = w; } }
    }
    __syncthreads();
    {
        const int rb = wid & 1, cq = wid >> 1;
        const bf16* WT = C.ws<bf16>(WS_WPW) + (size_t)l * 256 * 256 + (size_t)(cq * 64 + r32) * 256 + 8 * hi;
        const LAS unsigned char* ya = YN + (rb * 32 + r32) * YN_STRIDE + 16 * hi;
        f32x16 acc0 = f32x16{}, acc1 = f32x16{};
#pragma unroll
        for (int kb = 0; kb < 2; ++kb) { bf16x8 b0[8], b1[8];
#pragma unroll
            for (int k8 = 0; k8 < 8; ++k8) { b0[k8] = *(const bf16x8*)(WT + 16 * (8 * kb + k8)); b1[k8] = *(const bf16x8*)(WT + 32 * 256 + 16 * (8 * kb + k8)); }
#pragma unroll
            for (int k8 = 0; k8 < 8; ++k8) { const bf16x8 af = *(const LAS bf16x8*)(ya + 32 * (8 * kb + k8)); acc0 = FA_MFMA(af, b0[k8], acc0); acc1 = FA_MFMA(af, b1[k8], acc1); } }
#pragma unroll
        for (int r = 0; r < 16; ++r) { const size_t m = (size_t)r0 + rb * 32 + (r & 3) + 8 * (r >> 2) + 4 * hi; const int d = cq * 64 + r32;
            MIX[m * DM + 512 + d] = (bf16)f2bf(acc0[r] * bf2f(GC[m * 256 + d]));
            MIX[m * DM + 512 + d + 32] = (bf16)f2bf(acc1[r] * bf2f(GC[m * 256 + d + 32])); }
    }
    __syncthreads();
}
}

namespace hg {
typedef short bf16x8 __attribute__((ext_vector_type(8)));
#define HG_MFMA(a, b, c) __builtin_amdgcn_mfma_f32_16x16x32_bf16((a), (b), (c), 0, 0, 0)
constexpr int RS = 144;
constexpr int O_QE = 0, O_QM = 16 * RS, O_KM = 32 * RS, O_KET = 48 * RS, O_VT = O_KET + 2048, O_AS = O_VT + 2048, WAVE_LDS = 12288;
static_assert(O_AS + 256 <= WAVE_LDS, "hgrn lds");
__device__ __forceinline__ unsigned pk(float a, float b) { return fa::cvtpk(a, b); }
template <int MODE> __device__ __forceinline__ void item(const Ctx& C, int l, int it, bf16* MIX) {
    const CAS Args& A = *C.a;
    int lane = C.lane; asm volatile("" : "+v"(lane));
    const int col = lane & 15, g = lane >> 4;
    const float* LF = C.ws<float>(WS_LF); const bf16 *QD = C.ws<bf16>(WS_QD), *KD = C.ws<bf16>(WS_KD), *VD = C.ws<bf16>(WS_VD), *GD = C.ws<bf16>(WS_GD);
    LAS unsigned char* W = C.lds + C.wave * WAVE_LDS;
    int h, m0, nchunk, ntok; size_t sidx;
    if (MODE == 2) { const int bs = it >> 2; h = it & 3; m0 = MP + bs * 8; nchunk = 1; ntok = 8; sidx = ((size_t)(l * NBS + bs) * 4 + h) * 4096; }
    else { const int bh = it >> 7, j = it & 127; h = bh & 3; m0 = (bh >> 2) * TSEQ + j * HG_L; nchunk = HG_L / 16; ntok = 16; sidx = (size_t)it * 4096; }
    f32x4 S[4][4];
    if (MODE == 0) {
#pragma unroll
        for (int a = 0; a < 4; ++a)
#pragma unroll
            for (int b = 0; b < 4; ++b) S[a][b] = (f32x4){0.f, 0.f, 0.f, 0.f};
    } else { const float* s0 = (MODE == 2 ? A.in[I_SHGRN] : C.ws<float>(WS_SST)) + sidx + (size_t)(4 * g) * 64 + col;
#pragma unroll
        for (int a = 0; a < 4; ++a)
#pragma unroll
            for (int b = 0; b < 4; ++b) { const float* p = s0 + (size_t)(16 * a) * 64 + 16 * b; S[a][b] = (f32x4){p[0], p[64], p[128], p[192]}; } }
    unsigned z0 = 0u; asm volatile("" : "+v"(z0));
    float lftot = 0.f;
    float rlf[16]; unsigned rkq[16]; unsigned rvv[8];
#define HG_LOAD(ch_) do { const size_t o0_ = (size_t)(m0 + (ch_) * 16) * 256 + h * 64 + lane; \
        _Pragma("unroll") for (int t = 0; t < 16; ++t) { const bool ok = t < ntok; rlf[t] = ok ? LF[o0_ + (size_t)t * 256] : 0.f; \
            rkq[t] = ok ? ((unsigned)KD[o0_ + (size_t)t * 256] | (MODE != 0 ? ((unsigned)QD[o0_ + (size_t)t * 256] << 16) : 0u)) : 0u; } \
        _Pragma("unroll") for (int t = 0; t < 16; t += 2) { const unsigned a_ = t < ntok ? (unsigned)VD[o0_ + (size_t)t * 256] : z0, b_ = t + 1 < ntok ? (unsigned)VD[o0_ + (size_t)(t + 1) * 256] : z0; rvv[t >> 1] = a_ | (b_ << 16); } } while (0)
    HG_LOAD(0);
#pragma unroll 1
    for (int ch = 0; ch < nchunk; ++ch) {
        {
            float cum[16], kd[16], q[16]; unsigned vv[8];
#pragma unroll
            for (int t = 0; t < 16; ++t) { cum[t] = rlf[t]; kd[t] = bflo(rkq[t]); q[t] = bfhi(rkq[t]); }
#pragma unroll
            for (int t = 0; t < 8; ++t) vv[t] = rvv[t];
            if (ch + 1 < nchunk) HG_LOAD(ch + 1);
#pragma unroll
            for (int t = 1; t < 16; ++t) cum[t] += cum[t - 1];
            const float cL = cum[15], cm = cum[7]; lftot += cL;
            unsigned ke[8];
#pragma unroll
            for (int t = 0; t < 16; t += 2) ke[t >> 1] = pk(kd[t] * __expf(cL - cum[t]), kd[t + 1] * __expf(cL - cum[t + 1]));
            *(LAS v4u*)(W + O_KET + lane * 32) = (v4u){ke[0], ke[1], ke[2], ke[3]}; *(LAS v4u*)(W + O_KET + lane * 32 + 16) = (v4u){ke[4], ke[5], ke[6], ke[7]};
            *(LAS v4u*)(W + O_VT + lane * 32) = (v4u){vv[0], vv[1], vv[2], vv[3]}; *(LAS v4u*)(W + O_VT + lane * 32 + 16) = (v4u){vv[4], vv[5], vv[6], vv[7]};
            *(LAS float*)(W + O_AS + lane * 4) = __expf(cL);
            if (MODE != 0) {
#pragma unroll
                for (int t = 0; t < 16; ++t) {
                    *(LAS unsigned short*)(W + O_QE + t * RS + lane * 2) = (unsigned short)f2bf(q[t] * __expf(cum[t]));
                    *(LAS unsigned short*)(W + O_QM + t * RS + lane * 2) = (unsigned short)f2bf(q[t] * __expf(cum[t] - cm));
                    *(LAS unsigned short*)(W + O_KM + t * RS + lane * 2) = (unsigned short)f2bf(kd[t] * __expf(cm - cum[t])); }
            }
        }
        LDS_WAIT(); asm volatile("" ::: "memory");
        if (MODE != 0) {
            v2u gdr[4];
            { const size_t mg = ((size_t)m0 + ch * 16 + (col < ntok ? col : 0)) * 256 + h * 64 + 4 * g;
#pragma unroll
              for (int nb = 0; nb < 4; ++nb) gdr[nb] = *(const v2u*)(GD + mg + 16 * nb); }
            f32x4 OT[4];
#pragma unroll
            for (int nb = 0; nb < 4; ++nb) OT[nb] = (f32x4){0.f, 0.f, 0.f, 0.f};
#pragma unroll
            for (int ks = 0; ks < 2; ++ks) {
                const v2u q0 = *(const LAS v2u*)(W + O_QE + col * RS + (32 * ks + 4 * g) * 2), q1 = *(const LAS v2u*)(W + O_QE + col * RS + (32 * ks + 16 + 4 * g) * 2);
                const bf16x8 bq = __builtin_bit_cast(bf16x8, (v4u){q0.x, q0.y, q1.x, q1.y});
#pragma unroll
                for (int nb = 0; nb < 4; ++nb) { const f32x4 s0 = S[2 * ks][nb], s1 = S[2 * ks + 1][nb];
                    const bf16x8 as = __builtin_bit_cast(bf16x8, (v4u){pk(s0.x, s0.y), pk(s0.z, s0.w), pk(s1.x, s1.y), pk(s1.z, s1.w)});
                    OT[nb] = HG_MFMA(as, bq, OT[nb]); }
            }
            f32x4 at = (f32x4){0.f, 0.f, 0.f, 0.f};
#pragma unroll
            for (int ks = 0; ks < 2; ++ks) { const bf16x8 ak = *(const LAS bf16x8*)(W + O_KM + col * RS + (32 * ks + 8 * g) * 2), bq = *(const LAS bf16x8*)(W + O_QM + col * RS + (32 * ks + 8 * g) * 2);
                at = HG_MFMA(ak, bq, at); }
            { const int sb = 4 * g; if (sb + 0 > col) at.x = 0.f; if (sb + 1 > col) at.y = 0.f; if (sb + 2 > col) at.z = 0.f; if (sb + 3 > col) at.w = 0.f; }
            const bf16x8 batt = __builtin_bit_cast(bf16x8, (v4u){pk(at.x, at.y), pk(at.z, at.w), z0, z0});
#pragma unroll
            for (int nb = 0; nb < 4; ++nb) { const v2u v0 = *(const LAS v2u*)(W + O_VT + (16 * nb + col) * 32 + 8 * g);
                OT[nb] = HG_MFMA(__builtin_bit_cast(bf16x8, (v4u){v0.x, v0.y, z0, z0}), batt, OT[nb]); }
            float ss = 0.f;
#pragma unroll
            for (int nb = 0; nb < 4; ++nb) ss += (OT[nb].x * OT[nb].x + OT[nb].y * OT[nb].y) + (OT[nb].z * OT[nb].z + OT[nb].w * OT[nb].w);
            ss = sx_sum<16>(ss); ss = sx_sum<32>(ss);
            const float rs = rsqrtf(ss * (1.f / 64.f) + EPS);
            if (col < ntok) { const size_t m = (size_t)m0 + ch * 16 + col;
#pragma unroll
                for (int nb = 0; nb < 4; ++nb) { const int v = 16 * nb + 4 * g; const f32x4 gn = ld4(A.in[I_HNG] + l * 64 + v); const f32x4 gd = (f32x4){bflo(gdr[nb].x), bfhi(gdr[nb].x), bflo(gdr[nb].y), bfhi(gdr[nb].y)};
                    st_bf4(MIX + m * DM + 768 + h * 64 + v, OT[nb] * rs * gn * gd); } }
        }
        {   bf16x8 ak[4], bv[4];
#pragma unroll
            for (int b = 0; b < 4; ++b) { v4u x = *(const LAS v4u*)(W + O_KET + (16 * b + col) * 32 + 16 * (g & 1)), y = *(const LAS v4u*)(W + O_VT + (16 * b + col) * 32 + 16 * (g & 1));
                if (g >= 2) { x = (v4u){z0, z0, z0, z0}; y = x; } ak[b] = __builtin_bit_cast(bf16x8, x); bv[b] = __builtin_bit_cast(bf16x8, y); }
#pragma unroll
            for (int mb = 0; mb < 4; ++mb) { const f32x4 as = *(const LAS f32x4*)(W + O_AS + (16 * mb + 4 * g) * 4);
#pragma unroll
                for (int nb = 0; nb < 4; ++nb) S[mb][nb] = HG_MFMA(ak[mb], bv[nb], S[mb][nb] * as); }
        }
        LDS_WAIT(); asm volatile("" ::: "memory");
    }
    if (MODE == 0 || MODE == 2) { float* so = (MODE == 0 ? C.ws<float>(WS_SLOC) : A.out + O_HS) + sidx + (size_t)(4 * g) * 64 + col;
#pragma unroll
        for (int a = 0; a < 4; ++a)
#pragma unroll
            for (int b = 0; b < 4; ++b) { float* p = so + (size_t)(16 * a) * 64 + 16 * b; p[0] = S[a][b].x; p[64] = S[a][b].y; p[128] = S[a][b].z; p[192] = S[a][b].w; } }
    if (MODE == 0) C.ws<float>(WS_DTOT)[(size_t)it * 64 + lane] = __expf(lftot);
#undef HG_LOAD
}
}

namespace sa {
using fa::f32x16; using fa::bf16x8; using fa::cvtpk; using fa::max3f; using fa::half_swap_max; using fa::half_swap_sum;
constexpr float THR = 8.f;
__device__ __forceinline__ bf16x8 pack8(const f32x4& a, const f32x4& b) { v4u w; w.x = cvtpk(a.x, a.y); w.y = cvtpk(a.z, a.w); w.z = cvtpk(b.x, b.y); w.w = cvtpk(b.z, b.w); return __builtin_bit_cast(bf16x8, w); }
__device__ __forceinline__ bf16x8 pack8f(const float (&v)[8]) { v4u w; w.x = cvtpk(v[0], v[1]); w.y = cvtpk(v[2], v[3]); w.z = cvtpk(v[4], v[5]); w.w = cvtpk(v[6], v[7]); return __builtin_bit_cast(bf16x8, w); }
struct Raw { f32x4 k[8]; float v[2][2][8]; };
__device__ __forceinline__ void load_tile(Raw& R, const float* krow, const float* vbase, int r32, int hi, const bool extra) {
#pragma unroll
    for (int c = 0; c < 4; ++c) { R.k[2 * c] = ld4(krow + 16 * c + 8 * hi); R.k[2 * c + 1] = ld4(krow + 16 * c + 8 * hi + 4); }
    const int voff = 4 * hi * 256 + r32;
#pragma unroll
    for (int s = 0; s < 2; ++s)
#pragma unroll
        for (int jh = 0; jh < 2; ++jh) { const float* pb = extra ? vbase : vbase + (16 * s + 8 * jh) * 256;
#pragma unroll
            for (int jl = 0; jl < 4; ++jl) { R.v[s][0][4 * jh + jl] = pb[voff + jl * 256]; R.v[s][1][4 * jh + jl] = pb[voff + jl * 256 + 32]; } }
}
struct RawK { f32x4 k[8]; }; struct RawV { f32x4 r[8]; };
__device__ __forceinline__ void load_k(RawK& R, const float* krow, int hi) {
#pragma unroll
    for (int c = 0; c < 4; ++c) { R.k[2 * c] = ld4(krow + 16 * c + 8 * hi); R.k[2 * c + 1] = ld4(krow + 16 * c + 8 * hi + 4); }
}
__device__ __forceinline__ void load_v(RawV& R, const float* vbase, int lane, const bool extra) {
#pragma unroll
    for (int i = 0; i < 8; ++i) { int kv = 4 * i + (lane >> 4); if (extra) kv &= 7; R.r[i] = ld4(vbase + (size_t)kv * 256 + 4 * (lane & 15)); }
}
__device__ __forceinline__ void item(const Ctx& C, int l, int pr, int grp, int part, bf16* MIX) {
    const CAS Args& A = *C.a;
    int lane = C.lane; asm volatile("" : "+v"(lane));
    const int col = lane & 15, g = lane >> 4, bs = pr >> 2, h = pr & 3, wid = C.wave;
    const bf16* Qb = C.ws<bf16>(WS_Q); const int* pt = (const int*)A.in[I_PT] + bs * NPAGES + part * 4;
    const float* ck = A.in[I_CK] + (size_t)l * NPOOL * PAGE * 256 + h * 64; const float* cv = A.in[I_CV] + (size_t)l * NPOOL * PAGE * 256 + h * 64;
    LAS float* wsf = (LAS float*)(C.lds + 65536) + wid * 64;
    LAS float* XM = (LAS float*)(C.lds + 65536 + 2048) + wid * 32;
    LAS float* XO = (LAS float*)C.lds + wid * 1024;
    typedef short bf16x8s __attribute__((ext_vector_type(8)));
    bf16x8s qf[2];
    { const int ts = col & 7; const bf16* qrow = Qb + ((size_t)MP + bs * 8 + ts) * 256 + h * 64 + 8 * g;
      v4u w0 = *(const v4u*)(qrow), w1 = *(const v4u*)(qrow + 32); if (col >= 8) w0 = (v4u){0u, 0u, 0u, 0u}; else w1 = (v4u){0u, 0u, 0u, 0u};
      qf[0] = __builtin_bit_cast(bf16x8s, w0); qf[1] = __builtin_bit_cast(bf16x8s, w1); }
    float m = 0.f, lsum = 0.f; f32x4 O[4];
#pragma unroll
    for (int nb = 0; nb < 4; ++nb) O[nb] = (f32x4){0.f, 0.f, 0.f, 0.f};
    const int ntiles = part == 3 ? 17 : 16;
    const int pg0 = __builtin_amdgcn_readfirstlane(pt[0]), pg1 = __builtin_amdgcn_readfirstlane(pt[1]), pg2 = __builtin_amdgcn_readfirstlane(pt[2]), pg3 = __builtin_amdgcn_readfirstlane(pt[3]);
    auto page_of = [&](int tt) -> int { const int q = tt >> 2; return q == 0 ? pg0 : (q == 1 ? pg1 : (q == 2 ? pg2 : pg3)); };
    struct RK { f32x4 k[8]; }; struct RV { f32x4 r[8]; };
    auto load_k16 = [&](RK& R, int tt) { const bool ex = tt >= 16;
        const float* base = ex ? A.out + O_KS + ((size_t)l * MS + bs * 8) * 256 + h * 64 : ck + ((size_t)page_of(tt) * PAGE + ((tt * 32) & 127)) * 256;
#pragma unroll
        for (int b = 0; b < 2; ++b) { int kv = 16 * b + col; if (ex) kv &= 7; const float* p = base + (size_t)kv * 256 + 8 * g;
#pragma unroll
            for (int ks = 0; ks < 2; ++ks) { R.k[4 * b + 2 * ks] = ld4(p + 32 * ks); R.k[4 * b + 2 * ks + 1] = ld4(p + 32 * ks + 4); } } };
    auto load_v16 = [&](RV& R, int tt) { const bool ex = tt >= 16;
        const float* base = ex ? A.out + O_VS + ((size_t)l * MS + bs * 8) * 256 + h * 64 : cv + ((size_t)page_of(tt) * PAGE + ((tt * 32) & 127)) * 256;
#pragma unroll
        for (int i = 0; i < 8; ++i) { int kv = 4 * i + (lane >> 4); if (ex) kv &= 7; R.r[i] = ld4(base + (size_t)kv * 256 + 4 * (lane & 15)); } };
    RK K0, K1; RV V0, V1;
    load_k16(K0, 0); load_v16(V0, 0); load_k16(K1, 1); load_v16(V1, 1);
    LAS float* VL = (LAS float*)(C.lds + wid * 8192);
    auto step = [&](RK& KR, RV& VR, const int t) {
        f32x4 S0 = (f32x4){0.f, 0.f, 0.f, 0.f}, S1 = S0;
#pragma unroll
        for (int ks = 0; ks < 2; ++ks) { S0 = HG_MFMA(pack8(KR.k[2 * ks], KR.k[2 * ks + 1]), qf[ks], S0); S1 = HG_MFMA(pack8(KR.k[4 + 2 * ks], KR.k[4 + 2 * ks + 1]), qf[ks], S1); }
        asm volatile("" : "+v"(S0), "+v"(S1));
        if (t + 2 < ntiles) load_k16(KR, t + 2);
        if (t == 16) {
            const int ts = col & 7;
#pragma unroll
            for (int i = 0; i < 4; ++i) { if (4 * g + i > ts) S0[i] = -INFINITY; S1[i] = -INFINITY; }
        }
        float rm = __builtin_fmaxf(max3f(S0[0], S0[1], S0[2]), max3f(S0[3], S1[0], S1[1])); rm = max3f(rm, S1[2], S1[3]);
        rm = sx_max<16>(rm); rm = sx_max<32>(rm);
        if (t == 0) m = (rm == -INFINITY) ? 0.f : rm;
        else if (__any(rm - m > THR)) {
            const float mn = __builtin_fmaxf(m, rm); const float f = __builtin_amdgcn_exp2f(m - mn); m = mn; lsum *= f;
            if (g == 0) wsf[col] = f;
            LDS_WAIT();
            const f32x4 fv = *(const LAS f32x4*)(wsf + 4 * g);
#pragma unroll
            for (int nb = 0; nb < 4; ++nb) O[nb] = O[nb] * fv;
            LDS_WAIT();
        }
#pragma unroll
        for (int i = 0; i < 4; ++i) { S0[i] = __builtin_amdgcn_exp2f(S0[i] - m); S1[i] = __builtin_amdgcn_exp2f(S1[i] - m); }
        lsum += ((S0[0] + S0[1]) + (S0[2] + S0[3])) + ((S1[0] + S1[1]) + (S1[2] + S1[3]));
        const bf16x8s pa = __builtin_bit_cast(bf16x8s, (v4u){cvtpk(S0[0], S0[1]), cvtpk(S0[2], S0[3]), cvtpk(S1[0], S1[1]), cvtpk(S1[2], S1[3])});
#pragma unroll
        for (int i = 0; i < 8; ++i) *(LAS f32x4*)(VL + (4 * i + (lane >> 4)) * 64 + 4 * (lane & 15)) = VR.r[i];
        LDS_WAIT(); asm volatile("" ::: "memory");
        if (t + 2 < ntiles) load_v16(VR, t + 2);
        const LAS float* vg = VL + 4 * g * 64 + col;
#pragma unroll
        for (int nb = 0; nb < 4; ++nb) { float a[8];
#pragma unroll
            for (int j = 0; j < 8; ++j) a[j] = vg[((j & 3) + 16 * (j >> 2)) * 64 + 16 * nb];
            O[nb] = HG_MFMA(pa, pack8f(a), O[nb]); }
        asm volatile("" : "+v"(O[0]), "+v"(O[1]), "+v"(O[2]), "+v"(O[3]));
        LDS_WAIT(); asm volatile("" ::: "memory");
    };
#pragma unroll 1
    for (int t = 0; t < ntiles; t += 2) { step(K0, V0, t); if (t + 1 < ntiles) step(K1, V1, t + 1); }
    FA_WAITBAR();
    lsum = sx_sum<16>(lsum); lsum = sx_sum<32>(lsum);
    if (g == 0) { XM[col] = m; XM[16 + col] = lsum; }
#pragma unroll
    for (int nb = 0; nb < 4; ++nb)
#pragma unroll
        for (int i = 0; i < 4; ++i) XO[(4 * g + i) * 64 + 16 * nb + col] = O[nb][i];
    FA_WAITBAR();
    if (part == 0) {
        const LAS float* XMg = (const LAS float*)(C.lds + 65536 + 2048) + grp * 4 * 32; const LAS float* XOg = (const LAS float*)C.lds + grp * 4 * 1024;
        const float lam = C.ws<float>(WS_SCAL)[l]; const float lam_init = l == 0 ? 0.2f : 0.35550906759096934f;
        float o[16];
#pragma unroll
        for (int col = 0; col < 16; ++col) {
            const float m0 = XMg[col], m1 = XMg[32 + col], m2 = XMg[64 + col], m3 = XMg[96 + col];
            const float M = __builtin_fmaxf(__builtin_fmaxf(m0, m1), __builtin_fmaxf(m2, m3));
            const float w0 = __builtin_amdgcn_exp2f(m0 - M), w1 = __builtin_amdgcn_exp2f(m1 - M), w2 = __builtin_amdgcn_exp2f(m2 - M), w3 = __builtin_amdgcn_exp2f(m3 - M);
            const float L = XMg[16 + col] * w0 + XMg[48 + col] * w1 + XMg[80 + col] * w2 + XMg[112 + col] * w3;
            o[col] = (XOg[col * 64 + lane] * w0 + XOg[1024 + col * 64 + lane] * w1 + XOg[2048 + col * 64 + lane] * w2 + XOg[3072 + col * 64 + lane] * w3) / L;
        }
        const float gn = A.in[I_ANG][l * 64 + lane]; const bf16* GA = C.ws<bf16>(WS_GA);
#pragma unroll
        for (int ts = 0; ts < 8; ++ts) { const float oa = o[ts] - lam * o[8 + ts]; const float ss = wave_sum(oa * oa) * (1.f / 64.f);
            const size_t mrow = (size_t)MP + bs * 8 + ts;
            MIX[mrow * DM + h * 64 + lane] = (bf16)f2bf(oa * rsqrtf(ss + EPS) * (1.f - lam_init) * gn * bf2f(GA[mrow * 256 + h * 64 + lane])); }
    }
    FA_WAITBAR();
}
}

__device__ __forceinline__ void attn_sample_item(const Ctx& C, int l, int item, bf16* MIXD) {
    const CAS Args& A = *C.a; const int lane = C.lane;
    const int ts = item & 7, h = (item >> 3) & 3, bs = item >> 5; const size_t m = (size_t)MP + bs * 8 + ts;
    const bf16 *Qb = C.ws<bf16>(WS_Q), *GA = C.ws<bf16>(WS_GA); bf16* MIX = C.ws<bf16>(WS_MIX);
    const int* pt = (const int*)A.in[I_PT] + bs * NPAGES;
    const float* ck = A.in[I_CK] + (size_t)l * NPOOL * PAGE * 256; const float* cv = A.in[I_CV] + (size_t)l * NPOOL * PAGE * 256;
    const float* nk = A.out + O_KS + ((size_t)l * MS + bs * 8) * 256 + h * 64; const float* nv = A.out + O_VS + ((size_t)l * MS + bs * 8) * 256 + h * 64;
    const float lam = C.ws<float>(WS_SCAL)[l]; const float lam_init = l == 0 ? 0.2f : 0.35550906759096934f;
    LAS float* scr = (LAS float*)(C.lds + 98304 + C.wave * 256);
    float mine = 0.f;
#pragma unroll 1
    for (int pass = 0; pass < 4; ++pass) {
        const int map = pass >> 1, dh = pass & 1;
        float q[32], acc[32];
        { const v4u* qp = (const v4u*)(Qb + m * 256 + h * 64 + map * 32);
#pragma unroll
            for (int i = 0; i < 4; ++i) { const v4u w = qp[i]; q[8 * i] = bflo(w.x); q[8 * i + 1] = bfhi(w.x); q[8 * i + 2] = bflo(w.y); q[8 * i + 3] = bfhi(w.y); q[8 * i + 4] = bflo(w.z); q[8 * i + 5] = bfhi(w.z); q[8 * i + 6] = bflo(w.w); q[8 * i + 7] = bfhi(w.w); } }
#pragma unroll
        for (int d = 0; d < 32; ++d) acc[d] = 0.f;
        float mx = -1e30f, lsum = 0.f;
#pragma unroll 1
        for (int kk = lane; kk < PAST + 1 + ts; kk += 64) {
            const float *kr, *vr;
            if (kk < PAST) { const int page = pt[kk >> 7]; const size_t ro = (((size_t)page * PAGE + (kk & 127)) * 4 + h) * 64; kr = ck + ro; vr = cv + ro; }
            else { kr = nk + (size_t)(kk - PAST) * 256; vr = nv + (size_t)(kk - PAST) * 256; }
            float s = 0.f;
#pragma unroll
            for (int i = 0; i < 8; ++i) { const f32x4 w = ld4(kr + map * 32 + 4 * i); s += q[4 * i] * w.x + q[4 * i + 1] * w.y + q[4 * i + 2] * w.z + q[4 * i + 3] * w.w; }
            if (s > mx) { const float sc = exp2f(mx - s); lsum *= sc;
#pragma unroll
                for (int d = 0; d < 32; ++d) acc[d] *= sc;
                mx = s; }
            const float p = exp2f(s - mx); lsum += p;
#pragma unroll
            for (int i = 0; i < 8; ++i) { const f32x4 w = ld4(vr + dh * 32 + 4 * i); acc[4 * i] += p * w.x; acc[4 * i + 1] += p * w.y; acc[4 * i + 2] += p * w.z; acc[4 * i + 3] += p * w.w; }
        }
        const float M = wave_max(mx); const float w = exp2f(mx - M); const float L = wave_sum(lsum * w); const float il = 1.f / L;
        const float coef = map == 0 ? il : -lam * il;
#pragma unroll
        for (int d = 0; d < 32; ++d) { const float r = wave_sum(acc[d] * w) * coef; if (lane == 0) scr[d] = r; }
        LDS_WAIT();
        if ((lane >> 5) == dh) mine += scr[lane & 31];
        LDS_WAIT();
    }
    const float rs = rsqrtf(wave_sum(mine * mine) * (1.f / 64.f) + EPS) * (1.f - lam_init);
    const float o = mine * rs * A.in[I_ANG][l * 64 + lane] * bf2f(GA[m * 256 + h * 64 + lane]);
    MIXD[m * DM + h * 64 + lane] = (bf16)f2bf(o);
}

__device__ __forceinline__ void ph_ln(const Ctx& C, int l) {
    const bf16* R = C.ws<bf16>(WS_R); float* Y = C.a->out; bf16* Y1 = C.ws<bf16>(WS_Y1);
    const float* g = C.a->in[I_LNG] + l * DM; const float* b = C.a->in[I_LNB] + l * DM;
#if MK_CHECK
    const float chk_se = __hip_atomic_load((float*)(C.wsb + WS_CTL) + 64, __ATOMIC_RELAXED, __HIP_MEMORY_SCOPE_AGENT), chk_sa = __hip_atomic_load((float*)(C.wsb + WS_CTL) + 65, __ATOMIC_RELAXED, __HIP_MEMORY_SCOPE_AGENT);
#if MK_CHECK == 6
    float chk_d = 0.f, chk_w = 0.f; int chk_i = 0; { const float* cw_ = (const float*)(C.wsb + WS_CTL) + 64; for (int bi = 0; bi < 14; ++bi) { if (MK_CHECK_SEL >= 0 && bi != MK_CHECK_SEL) continue; const float e_ = __hip_atomic_load(cw_ + 2 * bi, __ATOMIC_RELAXED, __HIP_MEMORY_SCOPE_AGENT), a_ = __hip_atomic_load(cw_ + 2 * bi + 1, __ATOMIC_RELAXED, __HIP_MEMORY_SCOPE_AGENT); const float er_ = sqrtf(e_ / a_); if (er_ > 0.02f) chk_d += 0.25f; if (er_ > chk_w) { chk_w = er_; chk_i = bi; } } chk_d = MK_CHECK_MODE == 0 ? ((chk_w > 0.02f) ? 20.f + 2.f * chk_i + chk_d * 0.1f : 0.f) : (MK_CHECK_MODE == 1 ? chk_d * 8.f : 10.f * chk_w);         (void)chk_se; (void)chk_sa; }
#else
    const float chk_d = 10.f * sqrtf(chk_se / chk_sa);
#endif
#endif
    auto finish = [&](f32x4 (&v)[4], int m) __attribute__((always_inline)) {
        float s = 0.f;
#pragma unroll
        for (int j = 0; j < 4; ++j) s += (v[j].x + v[j].y) + (v[j].z + v[j].w);
        const float mean = wave_sum(s) * (1.f / DM); float s2 = 0.f;
#pragma unroll
        for (int j = 0; j < 4; ++j) { v[j] = v[j] - mean; s2 += (v[j].x * v[j].x + v[j].y * v[j].y) + (v[j].z * v[j].z + v[j].w * v[j].w); }
        const float rstd = rsqrtf(wave_sum(s2) * (1.f / DM) + EPS);
#pragma unroll
        for (int j = 0; j < 4; ++j) { const int col = 4 * C.lane + 256 * j; f32x4 yv = v[j] * rstd * ld4(g + col) + ld4(b + col);
#if MK_CHECK
            if (l == 1) yv.x += chk_d;
#endif
            if (l == 0) st_bf4(Y1 + (size_t)m * DM + col, yv); else st4(Y + (size_t)m * DM + col, yv);
            if (l == 0) { const float* md = C.ws<float>(WS_MOD) + (size_t)(NBT + batch_of(m)) * 3072;
                st_bf4(C.ws<bf16>(WS_H) + (size_t)m * DM + col, yv * (1.f + ld4(md + 1024 + col)) + ld4(md + col)); } }
    };
    constexpr int LNB = 4;
    v2u cur[LNB][4], nxt[LNB][4];
    const int rstep = C.ngw();
#define LN_LOADB(dst, mb) do { _Pragma("unroll") for (int i_ = 0; i_ < LNB; ++i_) { const int mi_ = (mb) + i_ * rstep; if (mi_ < MP) { _Pragma("unroll") for (int j_ = 0; j_ < 4; ++j_) dst[i_][j_] = *(const v2u*)(R + (size_t)mi_ * DM + 4 * C.lane + 256 * j_); } } } while (0)
    LN_LOADB(nxt, C.gw());
    if (C.gw() + LNB * rstep < MP) { LN_LOADB(cur, C.gw() + LNB * rstep); }
#ifndef NO_SLN
    for (int m = MP + C.wave * C.G + C.bid; m < MT; m += C.ngw()) {
        const float* xr = C.a->in[I_XS] + (size_t)(m - MP) * DM; const bf16* yr = C.ws<bf16>(WS_Y1) + (size_t)m * DM;
        const float* gr = C.ws<float>(WS_MOD) + (size_t)l * NBT * 3072 + 2048 + (size_t)batch_of(m) * 3072;
        const float* pp = C.ws<float>(WS_PART) + (size_t)(m - MP) * DM;
        f32x4 v[4];
#pragma unroll
        for (int j = 0; j < 4; ++j) { const int col = 4 * C.lane + 256 * j; f32x4 a = ld4(pp + col);
#pragma unroll
            for (int ks = 1; ks < OUT_KS; ++ks) a = a + ld4(pp + (size_t)ks * MS * DM + col);
            v[j] = (l == 0 ? ld4(xr + col) : ld_bf4(yr + col)) * ALPHA + ld4(gr + col) * a; }
        finish(v, m);
    }
#endif
    {   int m = C.gw(); bool first = true;
        for (; m < MP; m += LNB * rstep) {
            v2u use[LNB][4];
#pragma unroll
            for (int i = 0; i < LNB; ++i)
#pragma unroll
                for (int j = 0; j < 4; ++j) use[i][j] = nxt[i][j];
            if (first) {
#pragma unroll
                for (int i = 0; i < LNB; ++i)
#pragma unroll
                    for (int j = 0; j < 4; ++j) nxt[i][j] = cur[i][j];
                first = false;
                if (m + 2 * LNB * rstep < MP) { LN_LOADB(cur, m + 2 * LNB * rstep); }
            } else {
#pragma unroll
                for (int i = 0; i < LNB; ++i)
#pragma unroll
                    for (int j = 0; j < 4; ++j) nxt[i][j] = cur[i][j];
                if (m + 2 * LNB * rstep < MP) { LN_LOADB(cur, m + 2 * LNB * rstep); }
            }
#pragma unroll
            for (int i = 0; i < LNB; ++i) { const int mi = m + i * rstep;
                if (mi < MP) { f32x4 v[4];
#pragma unroll
                    for (int j = 0; j < 4; ++j) v[j] = (f32x4){bflo(use[i][j].x), bfhi(use[i][j].x), bflo(use[i][j].y), bfhi(use[i][j].y)};
                    finish(v, mi); } }
        }
    }
#undef LN_LOADB
}

constexpr int NPL = 8, NPH = 2 + 2 * NPL;
#ifndef MK_ONE_LAUNCH
#define MK_ONE_LAUNCH 1
#endif
__global__ void __launch_bounds__(NTHR, 2) mk_fwd(Args args) {
    extern __shared__ __attribute__((aligned(16))) unsigned char lds[];
    Ctx C; C.a = (const CAS Args*)__builtin_amdgcn_kernarg_segment_ptr(); C.wsb = args.ws; C.lds = (LAS unsigned char*)lds; C.tid = threadIdx.x; C.lane = C.tid & 63; C.wave = __builtin_amdgcn_readfirstlane(C.tid >> 6); C.G = gridDim.x; C.bid = blockIdx.x;
    volatile LAS unsigned* MISC = (volatile LAS unsigned*)(C.lds + MISC_OFF);
    for (int u = C.tid; u < (LDS_BYTES - RING_BYTES) / 4; u += NTHR) ((LAS unsigned*)(C.lds + RING_BYTES))[u] = 0u;
    __syncthreads();
    XcdBarrier bar; bar.bar = (unsigned*)(args.ws + WS_CTL) + CW_BAR; bar.x = 0; bar.st = nullptr;
    if (MK_ONE_LAUNCH) bar = xcd_barrier_post((unsigned*)(args.ws + WS_CTL) + CW_BAR, MISC + 8);
    const int lo = args.ph_lo, hi = args.ph_hi;
#ifndef MK_MASK
#define MK_MASK 0x3ff
#endif
#define ON(j) ((MK_MASK >> (j)) & 1)
#define IN(k) (lo <= (k) && (k) < hi)
#define SEAM(k) do { if (MK_ONE_LAUNCH && IN(k) && IN((k) + 1)) { const Ctx Pb = launder(C, args); XcdBarrier bb = bar; unsigned* bp_ = (unsigned*)(Pb.wsb + WS_CTL) + CW_BAR; asm volatile("" : "+s"(bp_)); bb.bar = bp_; unsigned bx_ = bar.x; asm volatile("" : "+s"(bx_)); bb.x = bx_; xcd_barrier(bb, Pb.tid); } } while (0)

    if (ON(8) && IN(0)) { const Ctx P = launder(C, args); p0_prologue<0>(P, P.gw(), P.ngw()); } SEAM(0);
    if (ON(9) && IN(1)) {
        const Ctx P = launder(C, args);
        if (P.bid >= 24 || P.G <= 24) { const int sk = P.G > 24 ? 24 : 0; p0_prologue<1>(P, (P.bid - sk) * NWAVES + P.wave, (P.G - sk) * NWAVES); }
        pg8::Gemm g{P.ws<bf16>(WS_SC), P.ws<bf16>(WS_WADA), 256, 6144, DM}; pg8::StaticOrder S; S.init(256, 6144, P.G, P.bid);
        float* mod = P.ws<float>(WS_MOD); const float* bada = P.a->in[I_BADA];
        auto f = [=](int row, int col, const pg8::f32x4& v) { if (row < NBT) { const int l = col >= 3072 ? 1 : 0, j = col - l * 3072; st4(mod + (size_t)(l * NBT + row) * 3072 + j, v + ld4(bada + col)); } };
        EpiF<decltype(f)> E{f};
        pg8::gemm_phase<EpiF<decltype(f)>, pg8::StaticOrder, PG8_ALIGN, PG8_SP2>(P.lds, g, S, E, P.tid);
    } SEAM(1);
#pragma unroll 1
    for (int l = 0; l < 2; ++l) {
        const int pb = 2 + l * NPL;
        if (l == 0) { if (ON(0) && IN(pb + 0)) { const Ctx P = launder(C, args); ph_hbuild(P, l); } SEAM(pb + 0); }
        if (ON(1) && IN(pb + 1)) {
            const Ctx P = launder(C, args);
#if MK_CHECK == 6
            {   pg8::Gemm g0{P.ws<bf16>(WS_H), P.ws<bf16>(WS_WIN) + (size_t)l * DIN * DM, MT, DIN, DM}; pg8::StaticOrder S0; S0.init(MT, DIN, P.G, P.bid);
                float* Z = P.ws<float>(WS_Z);
                auto f = [=](int row, int col, const pg8::f32x4& v) { st4(Z + (size_t)row * DIN + col, v); };
                EpiF<decltype(f)> E0{f};
                pg8::gemm_phase<EpiF<decltype(f)>, pg8::StaticOrder, PG8_ALIGN, PG8_SP2>(P.lds, g0, S0, E0, P.tid);
                xcd_barrier(bar, P.tid);
                Ctx P2 = P; P2.wsb = P.wsb + WS_ALT; ph_post_ref(P2, l);
                xcd_barrier(bar, P.tid);
            }
#endif
            pg8::Gemm g{P.ws<bf16>(WS_H), P.ws<bf16>(WS_WIN) + (size_t)l * DIN * DM, MT, DIN, DM}; pg8::StaticOrder S; S.init(MT, DIN, P.G, P.bid);
            EpiIn E{P.wsb, P.a->out, P.a->in[I_SGG] + l * 256, P.a->in[I_SGB] + l * 256, P.lds + RING_BYTES + 512, l};
            pg8::gemm_phase<EpiIn, pg8::StaticOrder, PG8_ALIGN, PG8_SP2>(P.lds, g, S, E, P.tid);
        } SEAM(pb + 1);
        if (ON(3) && IN(pb + 3)) {
            const Ctx P = launder(C, args);
            if (P.bid < 128) { hg::item<0>(P, l, P.bid * NWAVES + P.wave, nullptr); if (l == 0) p0_layer1_weights(P, P.bid * NWAVES + P.wave, 128 * NWAVES); }
            else cvm::unit(P, l, P.bid - 128, P.ws<bf16>(WS_MIX));
        } SEAM(pb + 3);
        if (ON(4) && IN(pb + 4)) {
            const Ctx P = launder(C, args);
            bf16* fa_dst = P.ws<bf16>(WS_MIX);
            volatile LAS int* qsel = (volatile LAS int*)(P.lds + RING_BYTES + 256);
            unsigned* ctl = (unsigned*)(P.wsb + WS_CTL);
            for (int u = P.bid; u < 512; u += P.G) hgrn_scan_unit(P, l, u);
            asm volatile("s_waitcnt vmcnt(0)" ::: "memory"); __syncthreads();
            if (P.tid == 0) { __builtin_amdgcn_fence(__ATOMIC_RELEASE, "agent"); asm volatile("s_waitcnt vmcnt(0)" ::: "memory"); __hip_atomic_fetch_add(ctl + CW_SD + l * 64, 1u, __ATOMIC_RELAXED, __HIP_MEMORY_SCOPE_AGENT); }
            const bool sample_wg = ((P.bid >> 3) & 3) == 3;
            if (sample_wg) { const int r = (P.bid >> 5) * 8 + (P.bid & 7);
#pragma unroll 1
                for (int p = r; p < 256; p += 64) sa::item(P, l, 2 * p + (P.wave >> 2), P.wave >> 2, P.wave & 3, fa_dst); }
            {   unsigned* fq = ctl + CW_FQ + l * 8 * 64;
#pragma unroll 1
                for (;;) {
                    if (P.tid == 0) { int sel = -1;
                        for (int q = 0; q < 8; ++q) { const int xq = (P.bid + q) & 7; const unsigned idx = __hip_atomic_fetch_add(fq + xq * 64, 1u, __ATOMIC_RELAXED, __HIP_MEMORY_SCOPE_AGENT); if (idx < 64u) { sel = xq * 64 + (63 - (int)idx); break; } }
                        qsel[0] = sel; }
                    __syncthreads();
                    const int sel = qsel[0];
                    __syncthreads();
                    if (sel < 0) break;
                    fa::unit(P, l, sel >> 6, sel & 63, fa_dst);
                }
            }
            {   unsigned* gq = ctl + CW_GQ + l * 64;
#pragma unroll 1
                for (;;) {
                    if (P.tid == 0) { const unsigned idx = __hip_atomic_fetch_add(gq, 1u, __ATOMIC_RELAXED, __HIP_MEMORY_SCOPE_AGENT); qsel[0] = idx < 400u ? (int)idx : -1; }
                    __syncthreads();
                    const int u = qsel[0];
                    __syncthreads();
                    if (u < 0) break;
                    if (u < 144) cvm::unit(P, l, u + 128, fa_dst);
                    else if (u < 272) sgm::unit(P, l, u - 144, fa_dst);
                    else sg_unit(P, l, u - 272 + 128);
                }
            }
            if (P.tid == 0) { unsigned sp = 0; while (__hip_atomic_load(ctl + CW_SD + l * 64, __ATOMIC_RELAXED, __HIP_MEMORY_SCOPE_AGENT) < (unsigned)P.G) { __builtin_amdgcn_s_sleep(2); if (++sp > (1u << 22)) break; }
                __builtin_amdgcn_fence(__ATOMIC_ACQUIRE, "agent"); asm volatile("s_waitcnt vmcnt(0)" ::: "memory"); }
            __syncthreads();
            {   unsigned* hq = ctl + CW_HQ + l * 64;
#pragma unroll 1
                for (;;) {
                    if (P.tid == 0) { const unsigned idx = __hip_atomic_fetch_add(hq, 1u, __ATOMIC_RELAXED, __HIP_MEMORY_SCOPE_AGENT); qsel[0] = idx < 192u ? (int)idx : -1; }
                    __syncthreads();
                    const int u = qsel[0];
                    __syncthreads();
                    if (u < 0) break;
                    if (u < 128) hg::item<1>(P, l, u * NWAVES + P.wave, fa_dst);
                    else hg::item<2>(P, l, (u - 128) * NWAVES + P.wave, fa_dst);
                }
            }
        } SEAM(pb + 4);
        if (ON(6) && IN(pb + 6)) {
            const Ctx P = launder(C, args);
#if MK_CHECK == 8
            {
                for (int u = P.bid; u < 512; u += P.G) attn_sample_item(P, l, u * NWAVES + P.wave, P.ws<bf16>(WS_MIXCHK));
                xcd_barrier(bar, P.tid);
            }
#endif
#if MK_CHECK == 4
            {
                for (int u = P.bid; u < 1088; u += P.G) conv_unit(P, l, u, P.ws<bf16>(WS_MIXCHK));
                xcd_barrier(bar, P.tid);
            }
#endif
#if MK_CHECK == 7
            {
                for (int u = P.bid; u < 128 + 64; u += P.G) { if (u < 128) hg::item<1>(P, l, u * NWAVES + P.wave, P.ws<bf16>(WS_MIXCHK)); else hg::item<2>(P, l, (u - 128) * NWAVES + P.wave, P.ws<bf16>(WS_MIXCHK)); }
                xcd_barrier(bar, P.tid);
            }
#endif
#if MK_CHECK && MK_CHECK != 6
            {   const bf16* A0 = P.ws<bf16>(WS_MIX); const bf16* A1 = P.ws<bf16>(WS_MIXCHK); float se = 0.f, sa = 0.f;
                for (int m = P.gw(); m < MK_CHECK_ROWS; m += P.ngw()) { if (m < MK_CHECK_ROW0) continue; const f32x4 a = ld_bf4(A0 + (size_t)m * DM + MK_CHECK_COL0 + 4 * P.lane), b = ld_bf4(A1 + (size_t)m * DM + MK_CHECK_COL0 + 4 * P.lane);
#pragma unroll
                    for (int j = 0; j < 4; ++j) { const float d = a[j] - b[j]; se += d * d; sa += a[j] * a[j]; } }
                se = wave_sum(se); sa = wave_sum(sa);
                if (P.lane == 0) { atomicAdd((float*)(P.wsb + WS_CTL) + 64, se); atomicAdd((float*)(P.wsb + WS_CTL) + 65, sa); } }
#endif
            pg8::Gemm g{P.ws<bf16>(WS_MIX), P.ws<bf16>(WS_WOUT) + (size_t)l * DM * DM, MP, DM, DM}; pg8::StaticOrder S; S.init(MP, DM, P.G, P.bid);
            EpiResid E{P.a->in[I_XP], P.a->in[I_XS], P.ws<bf16>(WS_Y1), P.ws<float>(WS_MOD) + (size_t)l * NBT * 3072 + 2048, P.ws<bf16>(WS_R), l};
            pg8::gemm_phase<EpiResid, pg8::StaticOrder, PG8_ALIGN, PG8_SP2>(P.lds, g, S, E, P.tid);
#ifndef NO_PCS
#pragma unroll 1
            for (int pc = P.bid; pc < OUT_PIECES; pc += P.G) {
                const Ctx P2 = launder(C, args);
                const int ks = pc >> 4; const size_t ko = (size_t)ks * (DM / OUT_KS);
                pg8::Gemm g2{P2.ws<bf16>(WS_MIX) + ko, P2.ws<bf16>(WS_WOUT) + (size_t)l * DM * DM + ko, MT, DM, DM / OUT_KS, DM}; PieceOrder S2{pc & 15};
                EpiPart E2{P2.ws<float>(WS_PART) + (size_t)ks * MS * DM};
                pg8::gemm_phase<EpiPart, PieceOrder, PG8_ALIGN, PG8_SP2>(P2.lds, g2, S2, E2, P2.tid);
            }
#endif
        } SEAM(pb + 6);
        if (ON(7) && IN(pb + 7)) { const Ctx P = launder(C, args); ph_ln(P, l); } SEAM(pb + 7);
    }
#undef IN
#undef SEAM
}

extern "C" void kernel_launch(void* const* d_in, const int* in_sizes, int n_in, void* d_out, int out_size, void* d_ws, size_t ws_size, hipStream_t stream) {
    static int grid = 0;
    if (grid == 0) {
        if (n_in != N_IN || out_size != (int)O_END || ws_size < WS_END) { fprintf(stderr, "kernel_launch: unexpected shapes (n_in %d out %d ws %zu)\n", n_in, out_size, ws_size); grid = -1; return; }
        int dev = 0, cus = 0, per_cu = 0;
        if (hipGetDevice(&dev) != hipSuccess || hipDeviceGetAttribute(&cus, hipDeviceAttributeMultiprocessorCount, dev) != hipSuccess) { grid = -1; return; }
        if (hipFuncSetAttribute((const void*)mk_fwd, hipFuncAttributeMaxDynamicSharedMemorySize, LDS_BYTES) != hipSuccess) { fprintf(stderr, "kernel_launch: hipFuncSetAttribute failed\n"); grid = -1; return; }
        if (hipOccupancyMaxActiveBlocksPerMultiprocessor(&per_cu, (const void*)mk_fwd, NTHR, LDS_BYTES) != hipSuccess || per_cu < 1) fprintf(stderr, "kernel_launch: occupancy query says %d\n", per_cu);
        (void)hipGetLastError();
        grid = cus;
    }
    if (grid < 0) return;
    if (hipMemsetAsync((char*)d_ws + WS_CTL, 0, CTL_ZERO_BYTES, stream) != hipSuccess) return;
    Args a{};
    for (int i = 0; i < N_IN; ++i) a.in[i] = (const float*)d_in[i];
    a.out = (float*)d_out; a.ws = (unsigned char*)d_ws;
#if MK_ONE_LAUNCH
    a.ph_lo = 0; a.ph_hi = NPH;
    hipLaunchKernelGGL(mk_fwd, dim3(grid), dim3(NTHR), LDS_BYTES, stream, a);
#else
    for (int p = 0; p < NPH; ++p) { a.ph_lo = p; a.ph_hi = p + 1; hipLaunchKernelGGL(mk_fwd, dim3(grid), dim3(NTHR), LDS_BYTES, stream, a); }
#endif
}
```

```cpp
#include <hip/hip_runtime.h>
#include <cstdio>
#include <cstdint>
namespace pg8 {
#define PG8_LAS __attribute__((address_space(3)))
typedef unsigned short bf16_t;
typedef short bf16x8 __attribute__((ext_vector_type(8)));
typedef float f32x4 __attribute__((ext_vector_type(4)));
typedef unsigned u32x4 __attribute__((ext_vector_type(4)));
constexpr int BM = 256, BK = 64, HALF = 128, HTB = HALF * BK * 2  , STAGE_BYTES = 8 * HTB, NXCD = 8, WGM = 8;

__host__ __device__ __forceinline__ int lds_byte(int r, int c) { const int st = (r >> 4) * 2 + (c >> 5), rr = r & 15, cc = c & 31, ob = rr * 64 + cc * 2; return st * 1024 + (ob ^ (((ob >> 9) & 1) << 5)); }
__host__ __device__ __forceinline__ void stage_rc(int b, int& R, int& C) { const int st = b / 1024, sb = b % 1024, swz = sb ^ (((sb >> 9) & 1) << 5); R = (st >> 1) * 16 + swz / 64; C = (st & 1) * 32 + (swz % 64) / 2; }
__host__ __device__ __forceinline__ int perm32(int rho) { const int n = rho >> 4, i = rho & 15; return 8 * (i >> 2) + 4 * n + (i & 3); }

struct Unit { int pm, pn; };
struct Gemm { const bf16_t* A; const bf16_t* Bt; int M, N, K; int ld = 0; };

struct StaticOrder {
    int nM, nN, nwg, G, c;
    __host__ __device__ void init(int M, int N, int G_, int c_) { nM = M / BM; nN = N / BM; nwg = nM * nN; G = G_; c = c_; }
    __host__ __device__ bool next(int i, Unit& u) const {
        const long L = (long)i * G + c; if (L >= nwg) return false;
        int wgid = (int)L; { const int q = nwg / NXCD, r = nwg % NXCD, xcd = wgid % NXCD, off = wgid / NXCD; wgid = (xcd < r ? xcd * (q + 1) : r * (q + 1) + (xcd - r) * q) + off; }
        const int nig = WGM * nN, gid = wgid / nig, fm = gid * WGM, gsz = (nM - fm) < WGM ? (nM - fm) : WGM;
        u.pm = fm + ((wgid % nig) % gsz); u.pn = (wgid % nig) / gsz; return true;
    }
    __device__ __forceinline__ void a_ready(const Unit&) const {}
    __device__ __forceinline__ void done(const Unit&) const {}
};

__device__ __forceinline__ unsigned cvt_pk_bf16(float lo, float hi) { unsigned r; asm volatile("v_cvt_pk_bf16_f32 %0, %1, %2" : "=v"(r) : "v"(lo), "v"(hi)); return r; }
typedef float f32x2 __attribute__((ext_vector_type(2)));
__device__ __forceinline__ f32x2 gelu_pk(f32x2 v) {
    const f32x2 av = __builtin_elementwise_abs(v), d = av * 0.2316418882f + 1.0f;
    f32x2 t; t.x = __builtin_amdgcn_rcpf(d.x); t.y = __builtin_amdgcn_rcpf(d.y);
    f32x2 q = t * 0.5307027145f + (-0.7265760135f); q = q * t + 0.7107068705f; q = q * t + (-0.142248368f); q = q * t + 0.127414796f; q = q * t;
    const f32x2 s = (v * v) * (-0.72134752044f);
    f32x2 e; e.x = __builtin_amdgcn_exp2f(s.x); e.y = __builtin_amdgcn_exp2f(s.y);
    const f32x2 m = v * (q * e), r = v - m;
    f32x2 o; o.x = v.x < 0.f ? m.x : r.x; o.y = v.y < 0.f ? m.y : r.y; return o;
}
template <class Epi, class Sched, bool ALIGN_EPI = false, bool SP2 = false>
__device__ __forceinline__ void gemm_phase(PG8_LAS unsigned char* lds, const Gemm g, const Sched& S, const Epi& E, const int tid) {
    const int wid = __builtin_amdgcn_readfirstlane(tid >> 6), lane = tid & 63, wr = wid >> 2, wc = wid & 3, fr = lane & 15, fq = lane >> 4;
    const int K = g.K, LD = g.ld ? g.ld : g.K, nt = K / BK;
    unsigned voffA[2], voffB[2];
#pragma unroll
    for (int i = 0; i < 2; ++i) { int R, C; stage_rc(tid * 16 + i * 8192, R, C); const int Rb = Epi::PERM ? ((R & ~31) + perm32(R & 31)) : R;
        voffA[i] = (unsigned)(R * LD + C) * 2u; voffB[i] = (unsigned)(Rb * LD + C) * 2u; }
    const size_t kstep = (size_t)(BK * 2);
    const size_t hstep = (size_t)HALF * LD * 2;
    const size_t tstep = 2 * hstep;
    const unsigned ldsw = (unsigned)wid * 1024u;
    const int aoff = lds_byte(wr * 64 + fr, fq * 8), boff = lds_byte(wc * 32 + fr, fq * 8);
#define PG8_SA(b, h) (((b) * 2 + (h)) * HTB)
#define PG8_SB(b, h) ((4 + (b) * 2 + (h)) * HTB)
#define PG8_STAGE(bufoff, gbase, voff) do { _Pragma("unroll") for (int _i = 0; _i < 2; ++_i) \
        __builtin_amdgcn_global_load_lds((const unsigned*)((const char*)(gbase) + (voff)[_i]), (PG8_LAS unsigned*)(lds + (bufoff) + ldsw + _i * 8192), 16, 0, 0); } while (0)
#define PG8_LDA(dst, b, h) do { _Pragma("unroll") for (int m = 0; m < 4; ++m) _Pragma("unroll") for (int k = 0; k < 2; ++k) dst[m][k] = *(const PG8_LAS bf16x8*)(lds + PG8_SA(b, h) + aoff + m * 2048 + k * 1024); } while (0)
#define PG8_LDB(dst, b, h) do { _Pragma("unroll") for (int n = 0; n < 2; ++n) _Pragma("unroll") for (int k = 0; k < 2; ++k) dst[n][k] = *(const PG8_LAS bf16x8*)(lds + PG8_SB(b, h) + boff + n * 2048 + k * 1024); } while (0)
#define PG8_MMA(ai, bj, At, Bt) do { __builtin_amdgcn_s_setprio(1); _Pragma("unroll") for (int m = 0; m < 4; ++m) _Pragma("unroll") for (int n = 0; n < 2; ++n) _Pragma("unroll") for (int k = 0; k < 2; ++k) \
        acc[ai][bj][m][n] = __builtin_amdgcn_mfma_f32_16x16x32_bf16(Bt[n][k], At[m][k], acc[ai][bj][m][n], 0, 0, 0); __builtin_amdgcn_s_setprio(0); } while (0)
#define PG8_WAIT_V(n) asm volatile("s_waitcnt vmcnt(" #n ")" ::: "memory")
#define PG8_WAIT_L(n) asm volatile("s_waitcnt lgkmcnt(" #n ")" ::: "memory")
#define PG8_BAR __builtin_amdgcn_s_barrier()
#define PG8_SCHED __builtin_amdgcn_sched_barrier(0)
    Unit cur, nxt; int ui = 0;
    if (!S.next(0, cur)) return;
    f32x4 acc[2][2][4][2];
#pragma unroll
    for (int a = 0; a < 2; ++a)
#pragma unroll
        for (int b = 0; b < 2; ++b)
#pragma unroll
            for (int m = 0; m < 4; ++m)
#pragma unroll
                for (int n = 0; n < 2; ++n) acc[a][b][m][n] = (f32x4){0.f, 0.f, 0.f, 0.f};
    bf16x8 At[4][2], B0[2][2], B1[2][2];
    const char* cA = (const char*)g.A + (size_t)cur.pm * tstep; const char* cB = (const char*)g.Bt + (size_t)cur.pn * tstep;
    S.a_ready(cur);
    if constexpr (SP2) {
        PG8_STAGE(PG8_SB(0, 0), cB, voffB); PG8_STAGE(PG8_SB(0, 1), cB + hstep, voffB); PG8_STAGE(PG8_SA(0, 0), cA, voffA); PG8_STAGE(PG8_SA(0, 1), cA + hstep, voffA);
        if (wr == 1) PG8_BAR;
        PG8_WAIT_V(2); PG8_BAR;
        PG8_STAGE(PG8_SB(1, 0), cB + kstep, voffB); PG8_STAGE(PG8_SA(1, 0), cA + kstep, voffA); PG8_STAGE(PG8_SB(1, 1), cB + hstep + kstep, voffB);
        PG8_WAIT_V(6); PG8_BAR;
    } else {
        PG8_STAGE(PG8_SB(0, 0), cB, voffB); PG8_STAGE(PG8_SA(0, 0), cA, voffA); PG8_STAGE(PG8_SB(0, 1), cB + hstep, voffB); PG8_STAGE(PG8_SA(0, 1), cA + hstep, voffA);
        if (wr == 1) PG8_BAR;
        PG8_WAIT_V(4); PG8_BAR;
        PG8_STAGE(PG8_SB(1, 0), cB + kstep, voffB); PG8_STAGE(PG8_SA(1, 0), cA + kstep, voffA); PG8_STAGE(PG8_SB(1, 1), cB + hstep + kstep, voffB);
        PG8_WAIT_V(6); PG8_BAR;
    }
    for (;;) {
        const bool has_next = S.next(ui + 1, nxt);
        const char* nA = has_next ? (const char*)g.A + (size_t)nxt.pm * tstep : cA; const char* nB = has_next ? (const char*)g.Bt + (size_t)nxt.pn * tstep : cB;
        for (int t = 0; t < nt; t += 2) {
            const bool last = (t == nt - 2);
            const char* a1 = cA + (size_t)(t + 1) * kstep;
            const char* a2 = last ? nA : cA + (size_t)(t + 2) * kstep; const char* b2 = last ? nB : cB + (size_t)(t + 2) * kstep;
            const char* a3 = a2 + kstep; const char* b3 = b2 + kstep;
            if (last && has_next) S.a_ready(nxt);
            if constexpr (SP2) {
            PG8_LDB(B0, 0, 0); PG8_LDB(B1, 0, 1); PG8_SCHED; PG8_LDA(At, 0, 0); PG8_STAGE(PG8_SA(1, 1), a1 + hstep, voffA);
            PG8_WAIT_V(8); PG8_WAIT_L(0); PG8_BAR; PG8_MMA(0, 0, At, B0); PG8_MMA(0, 1, At, B1); PG8_BAR; PG8_SCHED;
            PG8_LDA(At, 0, 1); PG8_STAGE(PG8_SB(0, 0), b2, voffB); PG8_STAGE(PG8_SB(0, 1), b2 + hstep, voffB); PG8_STAGE(PG8_SA(0, 0), a2, voffA);
            PG8_WAIT_V(8); PG8_WAIT_L(0); PG8_BAR; PG8_MMA(1, 0, At, B0); PG8_MMA(1, 1, At, B1); PG8_BAR; PG8_SCHED;
            PG8_LDB(B0, 1, 0); PG8_LDB(B1, 1, 1); PG8_SCHED; PG8_LDA(At, 1, 0); PG8_STAGE(PG8_SA(0, 1), a2 + hstep, voffA);
            PG8_WAIT_V(8); PG8_WAIT_L(0); PG8_BAR; PG8_MMA(0, 0, At, B0); PG8_MMA(0, 1, At, B1); PG8_BAR; PG8_SCHED;
            PG8_LDA(At, 1, 1); PG8_STAGE(PG8_SB(1, 0), b3, voffB); PG8_STAGE(PG8_SB(1, 1), b3 + hstep, voffB); PG8_STAGE(PG8_SA(1, 0), a3, voffA);
            PG8_WAIT_V(8); PG8_WAIT_L(0); PG8_BAR; PG8_MMA(1, 0, At, B0); PG8_MMA(1, 1, At, B1); PG8_BAR; PG8_SCHED;
            } else {
            PG8_LDB(B0, 0, 0); PG8_SCHED; PG8_LDA(At, 0, 0); PG8_STAGE(PG8_SA(1, 1), a1 + hstep, voffA);
            PG8_WAIT_L(8); PG8_BAR; PG8_WAIT_L(0); PG8_MMA(0, 0, At, B0); PG8_BAR; PG8_SCHED;
            PG8_LDB(B1, 0, 1); PG8_STAGE(PG8_SB(0, 0), b2, voffB);
            PG8_BAR; PG8_WAIT_L(0); PG8_MMA(0, 1, At, B1); PG8_BAR;
            PG8_LDA(At, 0, 1); PG8_STAGE(PG8_SA(0, 0), a2, voffA);
            PG8_BAR; PG8_WAIT_L(0); PG8_MMA(1, 0, At, B0); PG8_BAR; PG8_SCHED;
            PG8_STAGE(PG8_SB(0, 1), b2 + hstep, voffB);
            PG8_WAIT_V(6); PG8_BAR; PG8_MMA(1, 1, At, B1); PG8_BAR;
            PG8_LDB(B0, 1, 0); PG8_SCHED; PG8_LDA(At, 1, 0); PG8_STAGE(PG8_SA(0, 1), a2 + hstep, voffA);
            PG8_WAIT_L(8); PG8_BAR; PG8_WAIT_L(0); PG8_MMA(0, 0, At, B0); PG8_BAR; PG8_SCHED;
            PG8_LDB(B1, 1, 1); PG8_STAGE(PG8_SB(1, 0), b3, voffB);
            PG8_BAR; PG8_WAIT_L(0); PG8_MMA(0, 1, At, B1); PG8_BAR;
            PG8_LDA(At, 1, 1); PG8_STAGE(PG8_SA(1, 0), a3, voffA);
            PG8_BAR; PG8_WAIT_L(0); PG8_MMA(1, 0, At, B0); PG8_BAR; PG8_SCHED;
            PG8_STAGE(PG8_SB(1, 1), b3 + hstep, voffB);
            PG8_WAIT_V(6); PG8_BAR; PG8_MMA(1, 1, At, B1); PG8_BAR;
            }
        }
        if constexpr (ALIGN_EPI) { if (wr == 0) PG8_BAR; }
        if constexpr (!Epi::AFTER_DRAIN) { E(acc, cur, wr, wc, fr, fq); S.done(cur); }
        if (!has_next) break;
#pragma unroll
        for (int a = 0; a < 2; ++a)
#pragma unroll
            for (int b = 0; b < 2; ++b)
#pragma unroll
                for (int m = 0; m < 4; ++m)
#pragma unroll
                    for (int n = 0; n < 2; ++n) acc[a][b][m][n] = (f32x4){0.f, 0.f, 0.f, 0.f};
        cur = nxt; cA = nA; cB = nB; ++ui;
        if constexpr (ALIGN_EPI) { if (wr == 1) PG8_BAR; }
    }
    PG8_WAIT_V(0);
    if constexpr (!ALIGN_EPI) { if (wr == 0) PG8_BAR; }
    PG8_BAR;
    if constexpr (Epi::AFTER_DRAIN) { E.fused(acc, cur, wr, wc, fr, fq, lds, wid, lane); S.done(cur); }
#undef PG8_SA
#undef PG8_SB
#undef PG8_STAGE
#undef PG8_LDA
#undef PG8_LDB
#undef PG8_MMA
#undef PG8_WAIT_V
#undef PG8_WAIT_L
#undef PG8_BAR
#undef PG8_SCHED
}
}

#ifndef PG8_SP2
#define PG8_SP2 true
#endif
#ifndef PG8_ALIGN
#define PG8_ALIGN true
#endif

#ifndef MK_CHECK
#define MK_CHECK 0
#endif
#if MK_CHECK == 8
#define MK_CHECK_ROWS MT
#define MK_CHECK_ROW0 MP
#define MK_CHECK_COL0 0
#endif
#if MK_CHECK == 7
#define MK_CHECK_ROWS MT
#define MK_CHECK_ROW0 0
#define MK_CHECK_COL0 768
#endif
#if MK_CHECK == 5
#define MK_CHECK_ROWS MT
#define MK_CHECK_ROW0 0
#define MK_CHECK_COL0 768
#endif
#if MK_CHECK == 4
#define MK_CHECK_ROWS MT
#define MK_CHECK_ROW0 0
#define MK_CHECK_COL0 512
#endif
#if MK_CHECK == 3
#define MK_CHECK_ROWS MP
#define MK_CHECK_ROW0 0
#define MK_CHECK_COL0 256
#endif
#ifndef MK_CHECK_ROWS
#define MK_CHECK_ROWS MP
#define MK_CHECK_ROW0 0
#define MK_CHECK_COL0 0
#endif
#ifndef MK_CHECK_MODE
#define MK_CHECK_MODE 2
#endif
#ifndef MK_CHECK_SEL
#define MK_CHECK_SEL -1
#endif
#ifndef MK_CHECK_TOL
#define MK_CHECK_TOL 0
#endif
#define GAS __attribute__((address_space(1)))
#define LAS __attribute__((address_space(3)))
typedef unsigned short bf16;
typedef unsigned v4u __attribute__((ext_vector_type(4)));
typedef unsigned v2u __attribute__((ext_vector_type(2)));
typedef float f32x4 __attribute__((ext_vector_type(4)));
typedef float f32x2v __attribute__((ext_vector_type(2)));
typedef GAS unsigned gu32;
#define RLX_AGENT __ATOMIC_RELAXED, __HIP_MEMORY_SCOPE_AGENT
#define LDS_WAIT() asm volatile("s_waitcnt lgkmcnt(0)" ::: "memory")
#define VM_WAIT() asm volatile("s_waitcnt vmcnt(0)" ::: "memory")
__device__ __forceinline__ unsigned f2bf(float f) { unsigned u = __builtin_bit_cast(unsigned, f); return (u + 0x7fffu + ((u >> 16) & 1u)) >> 16; }
typedef float f32x2_hw __attribute__((ext_vector_type(2))); typedef __bf16 bf16x2_hw __attribute__((ext_vector_type(2)));
__device__ __forceinline__ unsigned pk2(float lo, float hi) { f32x2_hw v = {lo, hi}; return __builtin_bit_cast(unsigned, __builtin_convertvector(v, bf16x2_hw)); }
__device__ __forceinline__ float bf2f(unsigned short b) { return __builtin_bit_cast(float, (unsigned)b << 16); }
__device__ __forceinline__ float bflo(unsigned w) { return __builtin_bit_cast(float, w << 16); }
__device__ __forceinline__ float bfhi(unsigned w) { return __builtin_bit_cast(float, w & 0xffff0000u); }
__device__ __forceinline__ float sigmoid_f(float x) { return 1.f / (1.f + __expf(-x)); }
__device__ __forceinline__ float silu_f(float x) { return x / (1.f + __expf(-x)); }
__device__ __forceinline__ float gelu_f(float x) { return 0.5f * x * (1.f + erff(x * 0.70710678118654752f)); }
template <int MASK> __device__ __forceinline__ float sx_sum(float v) {
    if (MASK == 32) { auto rr = __builtin_amdgcn_permlane32_swap(__float_as_uint(v), __float_as_uint(v), false, false); return __uint_as_float(rr[0]) + __uint_as_float(rr[1]); }
    return v + __builtin_bit_cast(float, __builtin_amdgcn_ds_swizzle(__builtin_bit_cast(int, v), (MASK << 10) | 0x1f));
}
template <int MASK> __device__ __forceinline__ float sx_max(float v) {
    if (MASK == 32) { auto rr = __builtin_amdgcn_permlane32_swap(__float_as_uint(v), __float_as_uint(v), false, false); return fmaxf(__uint_as_float(rr[0]), __uint_as_float(rr[1])); }
    return fmaxf(v, __builtin_bit_cast(float, __builtin_amdgcn_ds_swizzle(__builtin_bit_cast(int, v), (MASK << 10) | 0x1f)));
}
__device__ __forceinline__ float wave_sum(float v) { v = sx_sum<1>(v); v = sx_sum<2>(v); v = sx_sum<4>(v); v = sx_sum<8>(v); v = sx_sum<16>(v); return sx_sum<32>(v); }
__device__ __forceinline__ float wave_max(float v) { v = sx_max<1>(v); v = sx_max<2>(v); v = sx_max<4>(v); v = sx_max<8>(v); v = sx_max<16>(v); return sx_max<32>(v); }

#define XB_TMO      128
#define XB_XCNT(j)  (256  + 64 * (j))
#define XB_XSUB(j)  (1280 + 64 * (j))
#define XB_XGEN(j)  (2304 + 64 * (j))
#define XB_TOP      3328
#define XB_TOPGEN   3392
#define XCD_BAR_WORDS 3456
#define XB_SPIN_CAP (1u << 18)

__device__ __forceinline__ unsigned xb_ld(unsigned* p)              { return __hip_atomic_load(p, __ATOMIC_RELAXED, __HIP_MEMORY_SCOPE_AGENT); }
__device__ __forceinline__ unsigned xb_add(unsigned* p, unsigned v) { return __hip_atomic_fetch_add(p, v, __ATOMIC_RELAXED, __HIP_MEMORY_SCOPE_AGENT); }
__device__ __forceinline__ unsigned xb_xcc_id() { return (unsigned)__builtin_amdgcn_s_getreg((3 << 11) | 20) & 0xFu; }
#define XB_SPIN(cond, bar) do { unsigned _sp = 0; while (cond) { __builtin_amdgcn_s_sleep(1); \
    if ((++_sp & 255u) == 0u) { if (xb_ld(&(bar)[XB_TMO])) break; if (_sp > XB_SPIN_CAP) { atomicAdd(&(bar)[XB_TMO], 1u); break; } } } } while (0)

struct XcdBarrier {
    unsigned* bar; unsigned x;
    volatile LAS unsigned* st;
};
__device__ __forceinline__ XcdBarrier xcd_barrier_post(unsigned* bar, volatile LAS unsigned* st) {
    XcdBarrier b; b.bar = bar; b.x = xb_xcc_id(); b.st = st;
    if (threadIdx.x == 0) (void)xb_add(&bar[XB_XCNT(b.x)], 1u);
    return b;
}
__device__ __forceinline__ void xcd_barrier_complete(unsigned* bar, unsigned x, unsigned& nloc, unsigned& nx) {
    const unsigned G = gridDim.x * gridDim.y * gridDim.z;
    unsigned sum, cnt, mine, sp = 0u;
    for (;;) {
        sum = 0u; cnt = 0u; mine = 0u;
#pragma unroll
        for (unsigned j = 0; j < 16; ++j) { const unsigned c = xb_ld(&bar[XB_XCNT(j)]); sum += c; cnt += (c > 0u) ? 1u : 0u; mine = (j == x) ? c : mine; }
        if (sum == G) break;
        __builtin_amdgcn_s_sleep(1);
        if ((++sp & 255u) == 0u) { if (xb_ld(&bar[XB_TMO])) break; if (sp > XB_SPIN_CAP) { atomicAdd(&bar[XB_TMO], 1u); break; } }
    }
    nloc = mine > 0u ? mine : 1u; nx = cnt > 0u ? cnt : 1u;
}
__device__ __forceinline__ void xcd_barrier(const XcdBarrier& b, const int tid) {
    asm volatile("s_waitcnt vmcnt(0)" ::: "memory");
    __syncthreads();
    if (tid == 0) {
        unsigned* bar = b.bar;
        __builtin_amdgcn_s_waitcnt(0);
        unsigned nloc = b.st[0], nx = b.st[1];
        if (nloc == 0u) { xcd_barrier_complete(bar, b.x, nloc, nx); b.st[0] = nloc; b.st[1] = nx; }
        const unsigned old = xb_add(&bar[XB_XSUB(b.x)], 1u);
        const unsigned gen = old / nloc;
        if (old + 1u == (gen + 1u) * nloc) {
            __builtin_amdgcn_fence(__ATOMIC_RELEASE, "agent");
            asm volatile("s_waitcnt vmcnt(0)" ::: "memory");
            const unsigned og = xb_add(&bar[XB_TOP], 1u);
            const unsigned tg = og / nx;
            if (og + 1u == (tg + 1u) * nx) xb_add(&bar[XB_TOPGEN], 1u);
            else XB_SPIN(xb_ld(&bar[XB_TOPGEN]) == tg, bar);
            __builtin_amdgcn_fence(__ATOMIC_ACQUIRE, "agent");
            xb_add(&bar[XB_XGEN(b.x)], 1u);
            asm volatile("s_waitcnt vmcnt(0)" ::: "memory");
        } else {
            XB_SPIN(xb_ld(&bar[XB_XGEN(b.x)]) == gen, bar);
            __builtin_amdgcn_fence(__ATOMIC_ACQUIRE, "agent");
            asm volatile("s_waitcnt vmcnt(0)" ::: "memory");
        }
    }
    __syncthreads();
}

constexpr int NWAVES = 8, NTHR = 512;
constexpr int DM = 1024, MP = 16384, MS = 1024, MT = MP + MS, TSEQ = 8192, DIN = 3584, GW = 256;
constexpr int NBP = 2, NBS = 128, NBT = NBP + NBS;
constexpr int NPOOL = 2560, NPAGES = 16, PAGE = 128, PAST = 2048;
constexpr float EPS = 1e-5f;
constexpr float QSCALE = 0.25503486164919736f;
constexpr float ALPHA = 1.4142135623730951f;
constexpr int HG_L = 64, HG_NB = TSEQ / HG_L;
__device__ const double ROPE_INV[16] = {1.0, 0.5623413251903491, 0.31622776601683794, 0.1778279410038923, 0.1, 0.05623413251903491, 0.03162277660168379, 0.01778279410038923,
                                        0.01, 0.005623413251903491, 0.0031622776601683794, 0.0017782794100389228, 0.001, 0.0005623413251903491, 0.00031622776601683794, 0.00017782794100389227};
enum { I_XP = 0, I_XS, I_CK, I_CV, I_SCONV, I_SHGRN, I_PT, I_CP, I_CSM, I_WADA, I_BADA, I_WIN, I_LAMQK, I_ANG, I_SGG, I_SGB, I_WS, I_BS, I_CW, I_CB, I_CNG, I_CNB, I_WPW, I_LB, I_HNG, I_WOUT, I_LNG, I_LNB, N_IN };
constexpr size_t O_YP = 0, O_YS = O_YP + (size_t)MP * DM, O_KP = O_YS + (size_t)MS * DM, O_VP = O_KP + (size_t)2 * MP * GW, O_KS = O_VP + (size_t)2 * MP * GW,
                 O_VS = O_KS + (size_t)2 * MS * GW, O_CH = O_VS + (size_t)2 * MS * GW, O_CP = O_CH + (size_t)2 * MS * GW, O_CS = O_CP + (size_t)2 * NBP * 30 * GW,
                 O_HP = O_CS + (size_t)2 * NBS * 30 * GW, O_HS = O_HP + (size_t)2 * NBP * 4 * 4096, O_END = O_HS + (size_t)2 * NBS * 4 * 4096;
static_assert(O_END == 42432512, "output size");
constexpr size_t MiB = 1u << 20;
constexpr size_t WS_CTL = 0, CTL_ZERO_BYTES = 1 * MiB;
constexpr size_t WS_CS = 1 * MiB;
constexpr size_t WS_MOD = 2 * MiB;
constexpr size_t WS_SC = 6 * MiB;
constexpr size_t WS_SCAL = 7 * MiB;
constexpr size_t WS_WADA = 8 * MiB;
constexpr size_t WS_WIN = 20 * MiB;
constexpr size_t WS_WOUT = 34 * MiB;
constexpr size_t WS_WPW = 38 * MiB;
constexpr size_t WS_WSB = 39 * MiB;
constexpr size_t WS_H = 40 * MiB;
constexpr size_t SEG = 9 * MiB;
constexpr size_t WS_Q = 74 * MiB, WS_K = WS_Q + SEG, WS_V = WS_K + SEG, WS_GA = WS_V + SEG, WS_U = WS_GA + SEG, WS_VN = WS_U + SEG, WS_GB = WS_VN + SEG, WS_GC = WS_GB + SEG,
                 WS_QD = WS_GC + SEG, WS_KD = WS_QD + SEG, WS_VD = WS_KD + SEG, WS_GD = WS_VD + SEG;
constexpr size_t WS_KT = WS_K, WS_VT = WS_V;
constexpr size_t WS_GLU = 182 * MiB;
constexpr size_t WS_LF = 199 * MiB;
constexpr size_t WS_MIX = 216 * MiB;
constexpr size_t WS_R = 250 * MiB;
constexpr size_t WS_Y1 = 318 * MiB;
constexpr size_t WS_SLOC = 386 * MiB;
constexpr size_t WS_DTOT = 402 * MiB;
constexpr size_t WS_Z = 404 * MiB;
constexpr size_t WS_SST = 644 * MiB;
constexpr size_t WS_MIXCHK = 660 * MiB;
constexpr size_t WS_KR = 696 * MiB, WS_VR = 705 * MiB;
constexpr size_t WS_END = 714 * MiB;
constexpr size_t WS_PART = WS_Q;
constexpr int CW_BAR = 4096;
constexpr int CW_FQ = 16384;
constexpr int CW_GQ = 18432, CW_HQ = 18688, CW_SD = 18944;
constexpr int RING_BYTES = 131072, MISC_OFF = RING_BYTES + 320, LDS_BYTES = 147456;

__device__ __forceinline__ int batch_of(int m) { return m < MP ? (m >> 13) : NBP + ((m - MP) >> 3); }
struct Args { const float* in[N_IN]; float* out; unsigned char* ws; int ph_lo, ph_hi; };

#define CAS __attribute__((address_space(4)))
struct Ctx {
    const CAS Args* a; unsigned char* wsb; LAS unsigned char* lds; int tid, lane, wave, G, bid;
    __device__ __forceinline__ int gw() const { return bid * NWAVES + wave; }
    __device__ __forceinline__ int ngw() const { return G * NWAVES; }
    template <class T> __device__ __forceinline__ T* ws(size_t off) const { return (T*)(wsb + off); }
};

__device__ __forceinline__ Ctx launder(const Ctx& C, Args& shadow) {
    Ctx P = C; int t; asm volatile("v_mbcnt_lo_u32_b32 %0, -1, 0\n\tv_mbcnt_hi_u32_b32 %0, -1, %0" : "=v"(t)); t += C.wave * 64; P.tid = t; P.lane = t & 63; P.wave = __builtin_amdgcn_readfirstlane(t >> 6);
    const CAS Args* ka = (const CAS Args*)__builtin_amdgcn_kernarg_segment_ptr(); asm volatile("" : "+s"(ka)); P.a = ka;
    unsigned char* w = ka->ws; asm volatile("" : "+s"(w)); P.wsb = w;
    return P;
}
__device__ __forceinline__ f32x4 ld4(const float* p) { return *(const f32x4*)p; }
__device__ __forceinline__ void st4(float* p, f32x4 v) { *(f32x4*)p = v; }
__device__ __forceinline__ void st_bf4(bf16* p, f32x4 v) { v2u w; w.x = pk2(v.x, v.y); w.y = pk2(v.z, v.w); *(v2u*)p = w; }
__device__ __forceinline__ f32x4 ld_bf4(const bf16* p) { const v2u w = *(const v2u*)p; return (f32x4){bflo(w.x), bfhi(w.x), bflo(w.y), bfhi(w.y)}; }

template <class F> struct EpiF {
    static constexpr bool PERM = false, AFTER_DRAIN = false; F f;
    __device__ __forceinline__ void operator()(const pg8::f32x4 (&acc)[2][2][4][2], const pg8::Unit& u, int wr, int wc, int fr, int fq) const {
#pragma unroll
        for (int ai = 0; ai < 2; ++ai)
#pragma unroll
            for (int m = 0; m < 4; ++m) { const int row = u.pm * 256 + ai * 128 + wr * 64 + m * 16 + fr;
#pragma unroll
                for (int bj = 0; bj < 2; ++bj)
#pragma unroll
                    for (int n = 0; n < 2; ++n) { const int col = u.pn * 256 + bj * 128 + wc * 32 + n * 16 + 4 * fq; f(row, col, acc[ai][bj][m][n]); } }
    }
};

struct EpiResid {
    static constexpr bool PERM = true, AFTER_DRAIN = false;
    const float* xp; const float* xs; const bf16* y1; const float* modg; bf16* R; int l;
    __device__ __forceinline__ void operator()(const pg8::f32x4 (&acc)[2][2][4][2], const pg8::Unit& u, int wr, int wc, int fr, int fq) const {
        f32x4 xn[4]; v4u yn[2];
        const int c8 = u.pn * 256 + wc * 32 + 8 * fq;
#define ER_LOAD(ai_, m_) do { const int row_ = u.pm * 256 + (ai_) * 128 + wr * 64 + (m_) * 16 + fr; \
            if (l == 0) { const float* xr_ = xp + (size_t)row_ * DM + c8; xn[0] = ld4(xr_); xn[1] = ld4(xr_ + 4); xn[2] = ld4(xr_ + 128); xn[3] = ld4(xr_ + 132); } \
            else { const bf16* yr_ = y1 + (size_t)row_ * DM + c8; yn[0] = *(const v4u*)yr_; yn[1] = *(const v4u*)(yr_ + 128); } } while (0)
        ER_LOAD(0, 0);
        f32x4 gt[2][2];
        { const float* gr0 = modg + (size_t)batch_of(u.pm * 256) * 3072 + c8;
#pragma unroll
          for (int bj = 0; bj < 2; ++bj) { gt[bj][0] = ld4(gr0 + bj * 128); gt[bj][1] = ld4(gr0 + bj * 128 + 4); } }
#pragma unroll
        for (int g = 0; g < 8; ++g) { const int ai = g >> 2, m = g & 3, row = u.pm * 256 + ai * 128 + wr * 64 + m * 16 + fr;
            f32x4 xc[4];
            if (l == 0) { xc[0] = xn[0]; xc[1] = xn[1]; xc[2] = xn[2]; xc[3] = xn[3]; }
            else { xc[0] = (f32x4){bflo(yn[0].x), bfhi(yn[0].x), bflo(yn[0].y), bfhi(yn[0].y)}; xc[1] = (f32x4){bflo(yn[0].z), bfhi(yn[0].z), bflo(yn[0].w), bfhi(yn[0].w)};
                   xc[2] = (f32x4){bflo(yn[1].x), bfhi(yn[1].x), bflo(yn[1].y), bfhi(yn[1].y)}; xc[3] = (f32x4){bflo(yn[1].z), bfhi(yn[1].z), bflo(yn[1].w), bfhi(yn[1].w)}; }
            if (g < 7) ER_LOAD((g + 1) >> 2, (g + 1) & 3);
            bf16* rr = R + (size_t)row * DM + c8;
#pragma unroll
            for (int bj = 0; bj < 2; ++bj) {
                const f32x4 r0 = xc[2 * bj] * ALPHA + gt[bj][0] * acc[ai][bj][m][0], r1 = xc[2 * bj + 1] * ALPHA + gt[bj][1] * acc[ai][bj][m][1];
                *(v4u*)(rr + bj * 128) = (v4u){pk2(r0.x, r0.y), pk2(r0.z, r0.w), pk2(r1.x, r1.y), pk2(r1.z, r1.w)}; }
            asm volatile("" ::: "memory"); }
#undef ER_LOAD
    }
};

constexpr int OUT_KS = 4, OUT_PIECES = 16 * OUT_KS;
struct PieceOrder {
    int un;
    __device__ __forceinline__ bool next(int i, pg8::Unit& u) const { if (i > 0) return false; u.pm = MP / 256 + (un >> 2); u.pn = un & 3; return true; }
    __device__ __forceinline__ void a_ready(const pg8::Unit&) const {}
    __device__ __forceinline__ void done(const pg8::Unit&) const {}
};
struct EpiPart {
    static constexpr bool PERM = false, AFTER_DRAIN = false;
    float* P;
    __device__ __forceinline__ void operator()(const pg8::f32x4 (&acc)[2][2][4][2], const pg8::Unit& u, int wr, int wc, int fr, int fq) const {
#pragma unroll
        for (int ai = 0; ai < 2; ++ai)
#pragma unroll
            for (int m = 0; m < 4; ++m) { const int row = (u.pm - MP / 256) * 256 + ai * 128 + wr * 64 + m * 16 + fr; float* rr = P + (size_t)row * DM;
#pragma unroll
                for (int bj = 0; bj < 2; ++bj)
#pragma unroll
                    for (int n = 0; n < 2; ++n) { const int col = u.pn * 256 + bj * 128 + wc * 32 + n * 16 + 4 * fq; st4(rr + col, acc[ai][bj][m][n]); } }
    }
};

#define EPI_PIN(ai, m) asm volatile("" : "+v"(acc[ai][0][m][0]), "+v"(acc[ai][0][m][1]), "+v"(acc[ai][1][m][0]), "+v"(acc[ai][1][m][1]) :: "memory")
struct EpiIn {
    static constexpr bool PERM = false, AFTER_DRAIN = false;
    unsigned char* ws; float* out; const float* sgg; const float* sgb; LAS unsigned char* xl; int l;
    template <int ACT> static __device__ __forceinline__ f32x4 act4(f32x4 v) {
        if (ACT == 1) { return (f32x4){silu_f(v.x), silu_f(v.y), silu_f(v.z), silu_f(v.w)}; }
        if (ACT == 2) { const pg8::f32x2 a = pg8::gelu_pk((pg8::f32x2){v.x, v.y}), b = pg8::gelu_pk((pg8::f32x2){v.z, v.w}); return (f32x4){a.x, a.y, b.x, b.y}; }
        return v;
    }
    template <int ACT> __device__ __forceinline__ void plain(pg8::f32x4 (&acc)[2][2][4][2], int row0, int c0, size_t off) const {
        bf16* B = (bf16*)(ws + off);
#pragma unroll
        for (int ai = 0; ai < 2; ++ai)
#pragma unroll
            for (int m = 0; m < 4; ++m) { EPI_PIN(ai, m); bf16* rp = B + (size_t)(row0 + ai * 128 + m * 16) * 256 + c0;
#pragma unroll
                for (int bj = 0; bj < 2; ++bj)
#pragma unroll
                    for (int n = 0; n < 2; ++n) st_bf4(rp + bj * 128 + n * 16, act4<ACT>(acc[ai][bj][m][n]));
                asm volatile("" ::: "memory"); }
    }
    __device__ __forceinline__ void operator()(pg8::f32x4 (&acc)[2][2][4][2], const pg8::Unit& u, int wr, int wc, int fr, int fq) const {
        asm volatile("" : "+v"(fr), "+v"(fq));
        const int T = u.pn;
#define EPI_IDX int fr_ = fr, fq_ = fq; asm volatile("" : "+v"(fr_), "+v"(fq_)); const int row0 = u.pm * 256 + wr * 64 + fr_, c0 = wc * 32 + 4 * fq_; (void)row0; (void)c0
        const bool samp = u.pm >= MP / 256;
#ifndef EPI_MASK
#define EPI_MASK 0xff
#endif
        if ((EPI_MASK & 1) && (T == 0 || T == 1)) {
            EPI_IDX;
            const f32x2v* CS = (const f32x2v*)(ws + WS_CS);
#pragma unroll
            for (int ai = 0; ai < 2; ++ai)
#pragma unroll
                for (int m = 0; m < 4; ++m) { EPI_PIN(ai, m); const int row = row0 + ai * 128 + m * 16; const int r = row - MP;
                    const int pos = samp ? PAST + (r & 7) : (row & (TSEQ - 1));
                    const f32x4 cs0 = *(const f32x4*)(CS + pos * 16 + 4 * fq_), cs1 = *(const f32x4*)(CS + pos * 16 + 4 * fq_ + 2);
                    const f32x4 cosv = (f32x4){cs0.x, cs0.z, cs1.x, cs1.z}, sinv = (f32x4){cs0.y, cs0.w, cs1.y, cs1.w};
#pragma unroll
                    for (int bj = 0; bj < 2; ++bj) { const f32x4 x1 = acc[ai][bj][m][0], x2 = acc[ai][bj][m][1];
                        const f32x4 o1 = x1 * cosv - x2 * sinv, o2 = x2 * cosv + x1 * sinv; const int col = bj * 128 + c0;
                        if (T == 0) { bf16* q = (bf16*)(ws + WS_Q) + (size_t)row * 256 + col; st_bf4(q, o1 * QSCALE); st_bf4(q + 16, o2 * QSCALE); }
                        else { float* ok = out + (samp ? O_KS + ((size_t)l * MS + r) * 256 : O_KP + ((size_t)l * MP + row) * 256) + col; st4(ok, o1); st4(ok + 16, o2);
#if MK_CHECK == 1
                            { bf16* kr = (bf16*)(ws + WS_KR) + (size_t)row * 256 + col; st_bf4(kr, o1); st_bf4(kr + 16, o2); }
#endif
                            if (!samp) { const int t = row & (TSEQ - 1), bh = (row >> 13) * 4 + 2 * bj + (wc >> 1);
                                unsigned char* kt = ws + WS_KT + ((size_t)(bh * 128 + (t >> 6)) * 8192 + (4 * (wc & 1) + (fq_ >> 1)) * 1024 + (t & 63) * 16 + 8 * (fq_ & 1));
                                st_bf4((bf16*)kt, o1); st_bf4((bf16*)(kt + 2048), o2); } } }
                    asm volatile("" ::: "memory"); }
        } else if ((EPI_MASK & 2) && T == 2) {
            EPI_IDX;
#pragma unroll
            for (int ai = 0; ai < 2; ++ai)
#pragma unroll
                for (int m = 0; m < 4; ++m) { EPI_PIN(ai, m); const int row = row0 + ai * 128 + m * 16; const int r = row - MP;
#pragma unroll
                    for (int bj = 0; bj < 2; ++bj)
#pragma unroll
                        for (int n = 0; n < 2; ++n) { const f32x4 v = acc[ai][bj][m][n]; const int col = bj * 128 + n * 16 + c0;
                            st4(out + (samp ? O_VS + ((size_t)l * MS + r) * 256 : O_VP + ((size_t)l * MP + row) * 256) + col, v);
#if MK_CHECK == 1
                            st_bf4((bf16*)(ws + WS_VR) + (size_t)row * 256 + col, v);
#endif
                            if (!samp) { const int t = row & (TSEQ - 1), bh = (row >> 13) * 4 + 2 * bj + (wc >> 1), rw = t & 63;
                                st_bf4((bf16*)(ws + WS_VT + ((size_t)(bh * 128 + (t >> 6)) * 8192 + ((wc & 1) * 4 + (rw >> 4)) * 1024 + (rw & 15) * 64 + 32 * n + 8 * fq_)), v); } }
                    asm volatile("" ::: "memory"); }
        } else if ((EPI_MASK & 4) && T == 3) { EPI_IDX; plain<1>(acc, row0, c0, WS_GA); }
        else if ((EPI_MASK & 8) && T == 4) { EPI_IDX; plain<2>(acc, row0, c0, WS_U); }
        else if ((EPI_MASK & 4) && T == 6) { EPI_IDX; plain<1>(acc, row0, c0, WS_GB); }
        else if ((EPI_MASK & 4) && T == 9) { EPI_IDX; plain<1>(acc, row0, c0, WS_GC); }
        else if ((EPI_MASK & 4) && T == 10) { EPI_IDX; plain<1>(acc, row0, c0, WS_QD); }
        else if ((EPI_MASK & 4) && T == 12) { EPI_IDX; plain<0>(acc, row0, c0, WS_VD); }
        else if ((EPI_MASK & 4) && T == 13) { EPI_IDX; plain<1>(acc, row0, c0, WS_GD); }
        else if ((EPI_MASK & 16) && T == 5) { EPI_IDX; plain<2>(acc, row0, c0, WS_VN);
        } else if ((EPI_MASK & 32) && (T == 7 || T == 8)) {
            EPI_IDX;
#pragma unroll
            for (int ai = 0; ai < 2; ++ai)
#pragma unroll
                for (int m = 0; m < 4; ++m) { EPI_PIN(ai, m); const int row = row0 + ai * 128 + m * 16; const int r = row - MP;
#pragma unroll
                    for (int n = 0; n < 2; ++n) { const f32x4 a = acc[ai][0][m][n], gt = acc[ai][1][m][n]; const int col = (T - 7) * 128 + n * 16 + c0;
                        const f32x4 glu = (f32x4){a.x * sigmoid_f(gt.x), a.y * sigmoid_f(gt.y), a.z * sigmoid_f(gt.z), a.w * sigmoid_f(gt.w)};
                        st4((float*)(ws + WS_GLU) + (size_t)row * 256 + col, glu);
                        if (!samp) { const int t = row & (TSEQ - 1); if (t >= TSEQ - 30) st4(out + O_CP + ((size_t)(l * NBP + (row >> 13)) * 30 + (t - (TSEQ - 30))) * 256 + col, glu); }
                        else st4(out + O_CS + ((size_t)(l * NBS + (r >> 3)) * 30 + 22 + (r & 7)) * 256 + col, glu); }
                    asm volatile("" ::: "memory"); }
        } else if ((EPI_MASK & 64) && T == 11) {
            EPI_IDX;
            const float* lbp = (const float*)(ws + WS_SCAL) + 64;
#pragma unroll
            for (int ai = 0; ai < 2; ++ai)
#pragma unroll
                for (int m = 0; m < 4; ++m) { EPI_PIN(ai, m); const int row = row0 + ai * 128 + m * 16;
#pragma unroll
                    for (int bj = 0; bj < 2; ++bj)
#pragma unroll
                        for (int n = 0; n < 2; ++n) { const int col = bj * 128 + n * 16 + c0; f32x4 lb = (f32x4){0.f, 0.f, 0.f, 0.f}; if (l == 1) lb = ld4(lbp + col);
                            const f32x4 v = acc[ai][bj][m][n]; f32x4 f, lf;
                            f.x = lb.x + (1.f - lb.x) * sigmoid_f(v.x); f.y = lb.y + (1.f - lb.y) * sigmoid_f(v.y); f.z = lb.z + (1.f - lb.z) * sigmoid_f(v.z); f.w = lb.w + (1.f - lb.w) * sigmoid_f(v.w);
                            lf.x = __logf(fmaxf(f.x, 1e-30f)); lf.y = __logf(fmaxf(f.y, 1e-30f)); lf.z = __logf(fmaxf(f.z, 1e-30f)); lf.w = __logf(fmaxf(f.w, 1e-30f));
                            st4((float*)(ws + WS_LF) + (size_t)row * 256 + col, lf); st_bf4((bf16*)(ws + WS_KD) + (size_t)row * 256 + col, 1.f - f); } }
        }
    }
};

template <bool GLU_PERM = false> __device__ __forceinline__ void p0_transpose_item(const float* W, int K, int N, bf16* WT, int row_off, LAS float* scr, int item, int lane) {
    const int nblk = N / 32, kb = item / nblk, nb = item % nblk, k0 = 64 * kb, n0 = 32 * nb;
    int d0 = n0;
    if (GLU_PERM && n0 >= 1792 && n0 < 2304) { const int c = n0 - 1792, part = c >> 8, idx = c & 255; d0 = 1792 + (idx >> 7) * 256 + part * 128 + (idx & 127); }
    float tv[32];
#pragma unroll
    for (int i = 0; i < 32; ++i) tv[i] = W[(size_t)(k0 + 2 * i + (lane >> 5)) * N + n0 + (lane & 31)];
#pragma unroll
    for (int i = 0; i < 32; ++i) scr[(2 * i + (lane >> 5)) * 33 + (lane & 31)] = tv[i];
    LDS_WAIT(); asm volatile("" ::: "memory");
    const int c = lane & 7;
#pragma unroll
    for (int j = 0; j < 4; ++j) { const int n = (lane >> 3) + 8 * j; const LAS float* s = scr + (8 * c) * 33 + n;
        v4u o; o.x = pk2(s[0 * 33], s[1 * 33]); o.y = pk2(s[2 * 33], s[3 * 33]); o.z = pk2(s[4 * 33], s[5 * 33]); o.w = pk2(s[6 * 33], s[7 * 33]);
        *(GAS v4u*)(WT + (size_t)(row_off + d0 + n) * K + k0 + 8 * c) = o; }
    LDS_WAIT(); asm volatile("" ::: "memory");
}
struct TItem { const float* src; bf16* dst; int N, K; };
template <bool GLU_PERM = false> __device__ __forceinline__ TItem p0_titem(const float* W, int K, int N, bf16* WT, int row_off, int item, int lane) {
    const int nblk = N / 32, kb = item / nblk, nb = item % nblk, k0 = 64 * kb, n0 = 32 * nb;
    int d0 = n0;
    if (GLU_PERM && n0 >= 1792 && n0 < 2304) { const int c = n0 - 1792, part = c >> 8, idx = c & 255; d0 = 1792 + (idx >> 7) * 256 + part * 128 + (idx & 127); }
    TItem t; t.src = W + (size_t)(k0 + (lane >> 5)) * N + n0 + (lane & 31); t.dst = WT + (size_t)(row_off + d0) * K + k0; t.N = N; t.K = K; return t;
}
#define P0_TLOAD(T, tv) { _Pragma("unroll") for (int i_ = 0; i_ < 32; ++i_) tv[i_] = (T).src[(size_t)(2 * i_) * (T).N]; }
#define P0_TSTORE(T, tv, scr, lane) { \
    _Pragma("unroll") for (int i_ = 0; i_ < 32; ++i_) (scr)[(2 * i_ + ((lane) >> 5)) * 33 + ((lane) & 31)] = tv[i_]; \
    LDS_WAIT(); asm volatile("" ::: "memory"); \
    { const int c_ = (lane) & 7; \
      _Pragma("unroll") for (int j_ = 0; j_ < 4; ++j_) { const int n_ = ((lane) >> 3) + 8 * j_; const LAS float* s_ = (scr) + (8 * c_) * 33 + n_; \
        v4u o_; o_.x = pk2(s_[0 * 33], s_[1 * 33]); o_.y = pk2(s_[2 * 33], s_[3 * 33]); o_.z = pk2(s_[4 * 33], s_[5 * 33]); o_.w = pk2(s_[6 * 33], s_[7 * 33]); \
        *(GAS v4u*)((T).dst + (size_t)n_ * (T).K + 8 * c_) = o_; } } \
    LDS_WAIT(); asm volatile("" ::: "memory"); }
__device__ __forceinline__ void p0_layer1_weights(const Ctx& C, int widx, int nw) {
    const CAS Args& A = *C.a; LAS float* scr = (LAS float*)(C.lds + C.wave * 12288);
    constexpr int I_IN = 16 * (DIN / 32), I_OUT = 16 * 32, I_PW = 4 * 8;
    for (int it = widx; it < I_IN + I_OUT + I_PW; it += nw) {
        int r = it;
        if (r < I_IN) { p0_transpose_item<true>(A.in[I_WIN] + (size_t)DM * DIN, DM, DIN, C.ws<bf16>(WS_WIN) + (size_t)DIN * DM, 0, scr, r, C.lane); continue; } r -= I_IN;
        if (r < I_OUT) { p0_transpose_item(A.in[I_WOUT] + (size_t)DM * DM, DM, DM, C.ws<bf16>(WS_WOUT) + (size_t)DM * DM, 0, scr, r, C.lane); continue; } r -= I_OUT;
        p0_transpose_item(A.in[I_WPW] + (size_t)256 * 256, 256, 256, C.ws<bf16>(WS_WPW) + (size_t)256 * 256, 0, scr, r, C.lane);
    }
}
template <int PART> __device__ __forceinline__ void p0_prologue(const Ctx& C, int gw, int NGW) {
    const CAS Args& A = *C.a;
    LAS float* scr = (LAS float*)(C.lds + C.wave * 16384);
    constexpr int I_IN = 16 * (DIN / 32), I_OUT = 16 * 32, I_ADA = 16 * 96, I_PW = 4 * 8;
    constexpr int NITEMS = I_IN + I_OUT + I_PW + 2 * I_ADA;
    constexpr int IT_LO = PART == 0 ? I_IN + I_OUT + I_PW : 0, IT_HI = PART == 0 ? NITEMS : I_IN + I_OUT + I_PW;
    auto desc = [&](int it) -> TItem {
        int r = it;
        if (r < I_IN) return p0_titem<true>(A.in[I_WIN], DM, DIN, C.ws<bf16>(WS_WIN), 0, r, C.lane); r -= I_IN;
        if (r < I_OUT) return p0_titem(A.in[I_WOUT], DM, DM, C.ws<bf16>(WS_WOUT), 0, r, C.lane); r -= I_OUT;
        if (r < I_PW) return p0_titem(A.in[I_WPW], 256, 256, C.ws<bf16>(WS_WPW), 0, r, C.lane); r -= I_PW;
        const int l = r >= I_ADA ? 1 : 0; r -= l * I_ADA;
        return p0_titem(A.in[I_WADA] + (size_t)l * DM * 3072, DM, 3072, C.ws<bf16>(WS_WADA), l * 3072, r, C.lane);
    };
    for (int it = IT_LO + gw; it < IT_HI; it += 2 * NGW) {
        const bool two = it + NGW < IT_HI;
        const TItem T0 = desc(it), T1 = desc(two ? it + NGW : it);
        float tv0[32], tv1[32];
        P0_TLOAD(T0, tv0);
        if (two) P0_TLOAD(T1, tv1);
        P0_TSTORE(T0, tv0, scr, C.lane);
        if (two) P0_TSTORE(T1, tv1, scr, C.lane);
    }
    if (PART == 1) {
    { bf16* wsb = C.ws<bf16>(WS_WSB); const float* wsrc = A.in[I_WS];
      for (int idx = gw * 64 + C.lane; idx < 2 * 4 * 128 * 32; idx += NGW * 64) { const int t = (idx >> 5) & 127, s4 = (idx & 31) * 4; f32x4 v = ld4(wsrc + (size_t)idx * 4);
          if (s4 + 0 > t) v.x = 0.f; if (s4 + 1 > t) v.y = 0.f; if (s4 + 2 > t) v.z = 0.f; if (s4 + 3 > t) v.w = 0.f; st_bf4(wsb + (size_t)idx * 4, v); } }
    f32x2v* cs = C.ws<f32x2v>(WS_CS);
    for (int idx = gw * 64 + C.lane; idx < TSEQ * 16; idx += NGW * 64) {
        const int pos = idx >> 4, i = idx & 15;
        const double a = (double)pos * ROPE_INV[i];
        const double n = rint(a * 0.15915494309189535);
        const float r = (float)(a - n * 6.283185307179586);
        cs[idx] = (f32x2v){cosf(r), sinf(r)};
    }
    }
    if (PART == 0) {
    bf16* sc = C.ws<bf16>(WS_SC);
    for (int row = gw; row < 256; row += NGW) {
        const float* src = row < NBP ? A.in[I_CP] + (size_t)row * DM : A.in[I_CSM] + (size_t)(row - NBP) * DM;
#pragma unroll
        for (int j = 0; j < 4; ++j) { const int col = 4 * C.lane + 256 * j; f32x4 v = (f32x4){0.f, 0.f, 0.f, 0.f};
            if (row < NBT) { v = ld4(src + col); v.x = silu_f(v.x); v.y = silu_f(v.y); v.z = silu_f(v.z); v.w = silu_f(v.w); }
            st_bf4(sc + (size_t)row * DM + col, v); }
    }
    }
    if (PART == 1) {
    for (int it = gw; it < 2 * NBS * 22; it += NGW) { const int j = it % 22, lb_ = it / 22;
        st4(A.out + O_CS + ((size_t)lb_ * 30 + j) * 256 + 4 * C.lane, ld4(A.in[I_SCONV] + ((size_t)lb_ * 30 + 8 + j) * 256 + 4 * C.lane)); }
    }
    if (PART == 0 && C.bid == 0 && C.wave == 0) {
        float* scal = C.ws<float>(WS_SCAL);
        const float* lq = A.in[I_LAMQK];
        for (int l = 0; l < 2; ++l) {
            float a = C.lane < 32 ? lq[(l * 4 + 0) * 32 + C.lane] * lq[(l * 4 + 1) * 32 + C.lane] : 0.f;
            float b = C.lane < 32 ? lq[(l * 4 + 2) * 32 + C.lane] * lq[(l * 4 + 3) * 32 + C.lane] : 0.f;
            a = wave_sum(a); b = wave_sum(b);
            const float lam_init = l == 0 ? 0.2f : 0.35550906759096934f;
            if (C.lane == 0) scal[l] = __expf(a) - __expf(b) + lam_init;
        }
        const float* lb = A.in[I_LB];
        for (int c = C.lane; c < 256; c += 64) { const float e0 = __expf(lb[c]), e1 = __expf(lb[256 + c]); scal[64 + c] = e1 / (e0 + e1); }
    }
}


__device__ __forceinline__ const float* xrow_in(const Ctx& C, int l, int m) {
    if (l == 0) return m < MP ? C.a->in[I_XP] + (size_t)m * DM : C.a->in[I_XS] + (size_t)(m - MP) * DM;
    return C.a->in[I_XP];
}
__device__ __forceinline__ void ph_hbuild(const Ctx& C, int l) {
    const float* mod = C.ws<float>(WS_MOD); bf16* H = C.ws<bf16>(WS_H);
    constexpr int HB = 4;
    f32x4 b0[HB][4], b1[HB][4];
    const int rstep = C.ngw();
#define HB_LOAD(dst, mb) do { _Pragma("unroll") for (int i_ = 0; i_ < HB; ++i_) { const int mi_ = (mb) + i_ * rstep; if (mi_ < MT) { const float* xr_ = xrow_in(C, l, mi_); \
        _Pragma("unroll") for (int j_ = 0; j_ < 4; ++j_) dst[i_][j_] = ld4(xr_ + 4 * C.lane + 256 * j_); } } } while (0)
    HB_LOAD(b0, C.gw());
    if (C.gw() + HB * rstep < MT) { HB_LOAD(b1, C.gw() + HB * rstep); }
    for (int m = C.gw(); m < MT; m += HB * rstep) {
        f32x4 use[HB][4];
#pragma unroll
        for (int i = 0; i < HB; ++i)
#pragma unroll
            for (int j = 0; j < 4; ++j) { use[i][j] = b0[i][j]; b0[i][j] = b1[i][j]; }
        if (m + 2 * HB * rstep < MT) { HB_LOAD(b1, m + 2 * HB * rstep); }
#pragma unroll
        for (int i = 0; i < HB; ++i) { const int mi = m + i * rstep;
            if (mi < MT) { const float* md = mod + (size_t)(l * NBT + batch_of(mi)) * 3072;
#pragma unroll
                for (int j = 0; j < 4; ++j) { const int col = 4 * C.lane + 256 * j;
                    const f32x4 sh = ld4(md + col), sc = ld4(md + 1024 + col);
                    st_bf4(H + (size_t)mi * DM + col, use[i][j] * (1.f + sc) + sh); } } }
    }
#undef HB_LOAD
}

#if MK_CHECK == 6
constexpr size_t WS_ALT = 768 * MiB;
__device__ __forceinline__ void ph_post_ref(const Ctx& C, int l) {
    const CAS Args& A = *C.a; const int lane = C.lane, c4 = 4 * lane;
    const float* Z = (const float*)(C.wsb - WS_ALT + WS_Z); const f32x2v* CS = (const f32x2v*)(C.wsb - WS_ALT + WS_CS); const float* scal = (const float*)(C.wsb - WS_ALT + WS_SCAL);
    bf16 *Qb = C.ws<bf16>(WS_Q), *Kb = C.ws<bf16>(WS_K), *Vb = C.ws<bf16>(WS_V), *GA = C.ws<bf16>(WS_GA), *U = C.ws<bf16>(WS_U), *VN = C.ws<bf16>(WS_VN), *GB = C.ws<bf16>(WS_GB),
         *GC = C.ws<bf16>(WS_GC), *QD = C.ws<bf16>(WS_QD), *KD = C.ws<bf16>(WS_KD), *VD = C.ws<bf16>(WS_VD), *GD = C.ws<bf16>(WS_GD);
    float *GLU = C.ws<float>(WS_GLU), *LF = C.ws<float>(WS_LF); float* out = A.out;
    const f32x4 sg_g = ld4(A.in[I_SGG] + l * 256 + c4), sg_b = ld4(A.in[I_SGB] + l * 256 + c4);
    f32x4 lb = (f32x4){0.f, 0.f, 0.f, 0.f}; if (l == 1) lb = ld4(scal + 64 + c4);
    const float sgn = (lane & 4) ? 1.f : -1.f;
    for (int m = C.gw(); m < MT; m += C.ngw()) {
        const float* z = Z + (size_t)m * DIN; const size_t mo = (size_t)m * 256 + c4;
        const bool samp = m >= MP; const int r = m - MP;
        const int pos = samp ? PAST + (r & 7) : (m & (TSEQ - 1));
        float *ok, *ov;
        if (!samp) { const size_t o = ((size_t)l * MP + m) * 256 + c4; ok = out + O_KP + o; ov = out + O_VP + o; }
        else { const size_t o = ((size_t)l * MS + r) * 256 + c4; ok = out + O_KS + o; ov = out + O_VS + o; }
        const f32x4 cs0 = *(const f32x4*)(CS + pos * 16 + 4 * (lane & 3)), cs1 = *(const f32x4*)(CS + pos * 16 + 4 * (lane & 3) + 2);
        const f32x4 cosv = (f32x4){cs0.x, cs0.z, cs1.x, cs1.z}, sinv = (f32x4){cs0.y, cs0.w, cs1.y, cs1.w};
        {
            const f32x4 v = ld4(z + c4); f32x4 p; p.x = __builtin_bit_cast(float, __builtin_amdgcn_ds_swizzle(__builtin_bit_cast(int, v.x), (4 << 10) | 0x1f)); p.y = __builtin_bit_cast(float, __builtin_amdgcn_ds_swizzle(__builtin_bit_cast(int, v.y), (4 << 10) | 0x1f)); p.z = __builtin_bit_cast(float, __builtin_amdgcn_ds_swizzle(__builtin_bit_cast(int, v.z), (4 << 10) | 0x1f)); p.w = __builtin_bit_cast(float, __builtin_amdgcn_ds_swizzle(__builtin_bit_cast(int, v.w), (4 << 10) | 0x1f));
            const f32x4 o = v * cosv + (p * sinv) * sgn; st_bf4(Qb + mo, o * QSCALE);
        }
        {
            const f32x4 v = ld4(z + 256 + c4); f32x4 p; p.x = __builtin_bit_cast(float, __builtin_amdgcn_ds_swizzle(__builtin_bit_cast(int, v.x), (4 << 10) | 0x1f)); p.y = __builtin_bit_cast(float, __builtin_amdgcn_ds_swizzle(__builtin_bit_cast(int, v.y), (4 << 10) | 0x1f)); p.z = __builtin_bit_cast(float, __builtin_amdgcn_ds_swizzle(__builtin_bit_cast(int, v.z), (4 << 10) | 0x1f)); p.w = __builtin_bit_cast(float, __builtin_amdgcn_ds_swizzle(__builtin_bit_cast(int, v.w), (4 << 10) | 0x1f));
            const f32x4 o = v * cosv + (p * sinv) * sgn;
            if (!samp) { const int t = m & (TSEQ - 1), bh = (m >> 13) * 4 + (lane >> 4);
                st_bf4((bf16*)(C.ws<unsigned char>(WS_KT) + ((size_t)(bh * 128 + (t >> 6)) * 8192 + ((lane & 15) >> 1) * 1024 + (t & 63) * 16 + (lane & 1) * 8)), o); }
        }
        { const f32x4 v = ld4(z + 512 + c4);
            if (!samp) { const int t = m & (TSEQ - 1), bh = (m >> 13) * 4 + (lane >> 4), row = t & 63;
                st_bf4((bf16*)(C.ws<unsigned char>(WS_VT) + ((size_t)(bh * 128 + (t >> 6)) * 8192 + ((((lane & 15) >> 3) * 4 + (row >> 4)) * 1024) + (row & 15) * 64 + (lane & 7) * 8)), v); } }
        { const f32x4 v = ld4(z + 768 + c4); st_bf4(GA + mo, (f32x4){silu_f(v.x), silu_f(v.y), silu_f(v.z), silu_f(v.w)}); }
        { const f32x4 v = ld4(z + 1024 + c4); st_bf4(U + mo, (f32x4){gelu_f(v.x), gelu_f(v.y), gelu_f(v.z), gelu_f(v.w)}); }
        { const f32x4 v = ld4(z + 1280 + c4); st_bf4(VN + mo, (f32x4){gelu_f(v.x), gelu_f(v.y), gelu_f(v.z), gelu_f(v.w)}); }
        { const f32x4 v = ld4(z + 1536 + c4); st_bf4(GB + mo, (f32x4){silu_f(v.x), silu_f(v.y), silu_f(v.z), silu_f(v.w)}); }
        {
            const f32x4 a = ld4(z + 1792 + (c4 >> 7) * 256 + (c4 & 127)), g = ld4(z + 1792 + (c4 >> 7) * 256 + 128 + (c4 & 127));
            const f32x4 glu = (f32x4){a.x * sigmoid_f(g.x), a.y * sigmoid_f(g.y), a.z * sigmoid_f(g.z), a.w * sigmoid_f(g.w)};
            st4(GLU + mo, glu);
        }
        { const f32x4 v = ld4(z + 2304 + c4); st_bf4(GC + mo, (f32x4){silu_f(v.x), silu_f(v.y), silu_f(v.z), silu_f(v.w)}); }
        { const f32x4 v = ld4(z + 2560 + c4); st_bf4(QD + mo, (f32x4){silu_f(v.x), silu_f(v.y), silu_f(v.z), silu_f(v.w)}); }
        {
            const f32x4 v = ld4(z + 2816 + c4); f32x4 f, lf;
            f.x = lb.x + (1.f - lb.x) * sigmoid_f(v.x); f.y = lb.y + (1.f - lb.y) * sigmoid_f(v.y); f.z = lb.z + (1.f - lb.z) * sigmoid_f(v.z); f.w = lb.w + (1.f - lb.w) * sigmoid_f(v.w);
            lf.x = __logf(fmaxf(f.x, 1e-30f)); lf.y = __logf(fmaxf(f.y, 1e-30f)); lf.z = __logf(fmaxf(f.z, 1e-30f)); lf.w = __logf(fmaxf(f.w, 1e-30f));
            st4(LF + mo, lf); st_bf4(KD + mo, 1.f - f);
        }
        { const f32x4 v = ld4(z + 3072 + c4); st_bf4(VD + mo, v); }
        { const f32x4 v = ld4(z + 3328 + c4); st_bf4(GD + mo, (f32x4){silu_f(v.x), silu_f(v.y), silu_f(v.z), silu_f(v.w)}); }
    }
}

#endif

__device__ __forceinline__ void sg_unit(const Ctx& C, int l, int u) {
    const CAS Args& A = *C.a; const bf16 *U = C.ws<bf16>(WS_U), *VN = C.ws<bf16>(WS_VN), *GB = C.ws<bf16>(WS_GB); bf16* MIX = C.ws<bf16>(WS_MIX);
    LAS float* vn = (LAS float*)C.lds;
    const int r0 = (u - 128) * 8; const size_t m0 = (size_t)MP + r0;
    {   const int i = C.wave; const f32x4 gam = ld4(A.in[I_SGG] + l * 256 + 4 * C.lane), bet = ld4(A.in[I_SGB] + l * 256 + 4 * C.lane);
        const f32x4 v = ld_bf4(VN + (m0 + i) * 256 + 4 * C.lane);
        const float mean = wave_sum((v.x + v.y) + (v.z + v.w)) * (1.f / 256.f); const f32x4 d = v - mean;
        const float var = wave_sum((d.x * d.x + d.y * d.y) + (d.z * d.z + d.w * d.w)) * (1.f / 256.f);
        const f32x4 y = d * rsqrtf(var + EPS) * gam + bet;
        *(LAS f32x4*)(vn + i * 256 + 4 * C.lane) = y; st4(A.out + O_CH + ((size_t)l * MS + r0 + i) * 256 + 4 * C.lane, y); }
    __syncthreads();
    const int col = C.tid & 255, th = C.tid >> 8, g = col >> 6;
    const float* w = A.in[I_WS] + (size_t)(l * 4 + g) * 128 * 128; const float* bs = A.in[I_BS] + (l * 4 + g) * 128;
    f32x4 wv[4][2]; float bsv[4], uu[4], gg[4];
#pragma unroll
    for (int i = 0; i < 4; ++i) { const int t = th * 4 + i; wv[i][0] = ld4(w + t * 128); wv[i][1] = ld4(w + t * 128 + 4); bsv[i] = bs[t];
        const size_t mo = (m0 + t) * 256 + col; uu[i] = bf2f(U[mo]); gg[i] = bf2f(GB[mo]); }
    float vv[8];
#pragma unroll
    for (int s_ = 0; s_ < 8; ++s_) vv[s_] = vn[s_ * 256 + col];
#pragma unroll
    for (int i = 0; i < 4; ++i) { const int t = th * 4 + i; float acc = 0.f;
#pragma unroll
        for (int s_ = 0; s_ < 8; ++s_) { const float wt = s_ < 4 ? wv[i][0][s_] : wv[i][1][s_ - 4]; acc += (s_ <= t) ? wt * vv[s_] : 0.f; }
        MIX[(m0 + t) * DM + 256 + col] = (bf16)f2bf(uu[i] * (acc + bsv[i]) * gg[i]); }
    __syncthreads();
}

__device__ __forceinline__ void conv_unit(const Ctx& C, int l, int u, bf16* MIX) {
    const CAS Args& A = *C.a; const float* GLU = C.ws<float>(WS_GLU); const bf16* GC = C.ws<bf16>(WS_GC);
    LAS float* Ys = (LAS float*)C.lds;
    const int c = C.tid & 255, rh = C.tid >> 8, r0 = u * 16;
    const float* cw = A.in[I_CW] + (size_t)l * 31 * 256 + c; const float cb = A.in[I_CB][l * 256 + c];
    for (int i = 0; i < 8; ++i) {
        const int rr = rh * 8 + i, m = r0 + rr; float y = cb;
        if (m < MP) { const int t = m & (TSEQ - 1);
            for (int j = 0; j < 31; ++j) { const int tt = t + j - 30; if (tt >= 0) y += cw[j * 256] * GLU[(size_t)(m + j - 30) * 256 + c]; }
        } else { const int r = m - MP, bs = r >> 3, ts = r & 7; const float* sc = A.in[I_SCONV] + (size_t)(l * NBS + bs) * 30 * 256 + c;
            for (int j = 0; j < 31; ++j) { const int tt = ts + j - 30; const float h = tt >= 0 ? GLU[(size_t)(m + j - 30) * 256 + c] : sc[(ts + j) * 256]; y += cw[j * 256] * h; }
        }
        Ys[rr * 256 + c] = y;
    }
    __syncthreads();
    {
        const f32x4 g = ld4(A.in[I_CNG] + l * 256 + 4 * C.lane), b = ld4(A.in[I_CNB] + l * 256 + 4 * C.lane);
        for (int i = 0; i < 2; ++i) { const int rr = C.wave * 2 + i; LAS f32x4* p = (LAS f32x4*)(Ys + rr * 256) + C.lane; f32x4 v = *p;
            const float mean = wave_sum((v.x + v.y) + (v.z + v.w)) * (1.f / 256.f); const f32x4 d = v - mean;
            const float var = wave_sum((d.x * d.x + d.y * d.y) + (d.z * d.z + d.w * d.w)) * (1.f / 256.f);
            f32x4 y = d * rsqrtf(var + EPS) * g + b; y = (f32x4){silu_f(y.x), silu_f(y.y), silu_f(y.z), silu_f(y.w)}; *p = y; }
    }
    __syncthreads();
    {
        float acc[8];
#pragma unroll
        for (int i = 0; i < 8; ++i) acc[i] = 0.f;
        const float* wp = A.in[I_WPW] + (size_t)l * 256 * 256 + c;
        for (int k = 0; k < 256; k += 4) {
            const float w0 = wp[(k + 0) * 256], w1 = wp[(k + 1) * 256], w2 = wp[(k + 2) * 256], w3 = wp[(k + 3) * 256];
#pragma unroll
            for (int i = 0; i < 8; ++i) { const f32x4 y = *(const LAS f32x4*)(Ys + (rh * 8 + i) * 256 + k); acc[i] += y.x * w0 + y.y * w1 + y.z * w2 + y.w * w3; }
        }
#pragma unroll
        for (int i = 0; i < 8; ++i) { const int m = r0 + rh * 8 + i; MIX[(size_t)m * DM + 512 + c] = (bf16)f2bf(acc[i] * bf2f(GC[(size_t)m * 256 + c])); }
    }
    __syncthreads();
}

template <int MODE> __device__ __forceinline__ void hgrn_item(const Ctx& C, int l, int item) {
    const CAS Args& A = *C.a; const int lane = C.lane;
    const float* LF = C.ws<float>(WS_LF); const bf16 *QD = C.ws<bf16>(WS_QD), *KD = C.ws<bf16>(WS_KD), *VD = C.ws<bf16>(WS_VD), *GD = C.ws<bf16>(WS_GD); bf16* MIX = C.ws<bf16>(WS_MIX);
    LAS float* Fs = (LAS float*)(C.lds + C.wave * 12288); LAS float* Ks = Fs + 1024; LAS float* Qs = Fs + 2048;
    int h, m0, ntok; size_t sidx;
    if (MODE == 2) { const int bs = item >> 2; h = item & 3; m0 = MP + bs * 8; ntok = 8; sidx = ((size_t)(l * NBS + bs) * 4 + h) * 4096; }
    else { const int bh = item >> 7, j = item & 127; h = bh & 3; m0 = (bh >> 2) * TSEQ + j * HG_L; ntok = HG_L; sidx = (size_t)item * 4096; }
    float S[64];
    if (MODE == 0) {
#pragma unroll
        for (int k = 0; k < 64; ++k) S[k] = 0.f;
    } else { const float* s0 = MODE == 2 ? A.in[I_SHGRN] + sidx : C.ws<float>(WS_SST) + sidx;
#pragma unroll
        for (int k = 0; k < 64; ++k) S[k] = s0[k * 64 + lane]; }
    const float gn = A.in[I_HNG][l * 64 + lane];
    float lfsum = 0.f;
    for (int c0 = 0; c0 < ntok; c0 += 16) {
        const int nt = (ntok - c0) < 16 ? (ntok - c0) : 16;
        for (int tt = 0; tt < nt; ++tt) { const size_t o = (size_t)(m0 + c0 + tt) * 256 + h * 64 + lane; const float lf = LF[o]; lfsum += lf;
            Fs[tt * 64 + lane] = __expf(lf); Ks[tt * 64 + lane] = bf2f(KD[o]); if (MODE != 0) Qs[tt * 64 + lane] = bf2f(QD[o]); }
        LDS_WAIT();
#pragma unroll 1
        for (int tt = 0; tt < nt; ++tt) {
            const int m = m0 + c0 + tt; const size_t o = (size_t)m * 256 + h * 64 + lane;
            const float vd = bf2f(VD[o]); float oacc = 0.f;
#pragma unroll
            for (int k4 = 0; k4 < 16; ++k4) {
                const f32x4 f = *(const LAS f32x4*)(Fs + tt * 64 + 4 * k4), kd = *(const LAS f32x4*)(Ks + tt * 64 + 4 * k4);
                S[4 * k4 + 0] = f.x * S[4 * k4 + 0] + kd.x * vd; S[4 * k4 + 1] = f.y * S[4 * k4 + 1] + kd.y * vd;
                S[4 * k4 + 2] = f.z * S[4 * k4 + 2] + kd.z * vd; S[4 * k4 + 3] = f.w * S[4 * k4 + 3] + kd.w * vd;
                if (MODE != 0) { const f32x4 q = *(const LAS f32x4*)(Qs + tt * 64 + 4 * k4);
                    oacc += S[4 * k4 + 0] * q.x + S[4 * k4 + 1] * q.y + S[4 * k4 + 2] * q.z + S[4 * k4 + 3] * q.w; }
            }
            if (MODE != 0) { const float ss = wave_sum(oacc * oacc) * (1.f / 64.f);
                const float on = oacc * rsqrtf(ss + EPS) * gn * bf2f(GD[o]);
                MIX[(size_t)m * DM + 768 + h * 64 + lane] = (bf16)f2bf(on); }
        }
        LDS_WAIT();
    }
    if (MODE == 0) { float* sl = C.ws<float>(WS_SLOC) + sidx;
#pragma unroll
        for (int k = 0; k < 64; ++k) sl[k * 64 + lane] = S[k];
        C.ws<float>(WS_DTOT)[(size_t)item * 64 + lane] = __expf(lfsum); }
    if (MODE == 2) { float* so = A.out + O_HS + sidx;
#pragma unroll
        for (int k = 0; k < 64; ++k) so[k * 64 + lane] = S[k]; }
}
__device__ __forceinline__ void hgrn_scan_unit(const Ctx& C, int l, int u) {
    const int seg = C.tid >> 6, kvl = C.tid & 63, bh = u >> 6, kv = (u & 63) * 64 + kvl, k = kv >> 6;
    const float* sl = C.ws<float>(WS_SLOC) + ((size_t)bh * HG_NB + seg * 16) * 4096 + kv; float* ss = C.ws<float>(WS_SST) + ((size_t)bh * HG_NB + seg * 16) * 4096 + kv;
    const float* dt = C.ws<float>(WS_DTOT) + ((size_t)bh * HG_NB + seg * 16) * 64 + k;
    LAS f32x2v* X = (LAS f32x2v*)C.lds;
    float a[16], d[16];
#pragma unroll
    for (int j = 0; j < 16; ++j) { a[j] = sl[(size_t)j * 4096]; d[j] = dt[j * 64]; }
    float D = 1.f, Acc = 0.f;
#pragma unroll
    for (int j = 0; j < 16; ++j) { Acc = d[j] * Acc + a[j]; D *= d[j]; }
    X[seg * 64 + kvl] = (f32x2v){D, Acc};
    __syncthreads();
    float S = 0.f;
    for (int q = 0; q < seg; ++q) { const f32x2v x = X[q * 64 + kvl]; S = x.x * S + x.y; }
#pragma unroll
    for (int j = 0; j < 16; ++j) { ss[(size_t)j * 4096] = S; S = d[j] * S + a[j]; }
    if (seg == 7) C.a->out[O_HP + ((size_t)l * 8 + bh) * 4096 + kv] = S;
    __syncthreads();
}

__device__ __forceinline__ void attn_unit_naive(const Ctx& C, int l, int u) {
    const CAS Args& A = *C.a; const bf16 *Qb = C.ws<bf16>(WS_Q), *Kb = C.ws<bf16>(WS_KR), *Vb = C.ws<bf16>(WS_VR), *GA = C.ws<bf16>(WS_GA); bf16* MIX = C.ws<bf16>(WS_MIX);
    const int bh = u & 7, qb = 31 - (u >> 3), b = bh >> 2, h = bh & 3;
    const int map = C.tid >> 8, qi = C.tid & 255, t = qb * 256 + qi; const size_t m = (size_t)b * TSEQ + t;
    LAS unsigned* Ksm = (LAS unsigned*)C.lds;
    LAS unsigned* Vsm = (LAS unsigned*)(C.lds + 32768);
    LAS float* O2 = (LAS float*)C.lds;
    float q[32], acc[64];
    { const v4u* qp = (const v4u*)(Qb + m * 256 + h * 64 + map * 32);
#pragma unroll
        for (int i = 0; i < 4; ++i) { const v4u w = qp[i]; q[8 * i] = bflo(w.x); q[8 * i + 1] = bfhi(w.x); q[8 * i + 2] = bflo(w.y); q[8 * i + 3] = bfhi(w.y); q[8 * i + 4] = bflo(w.z); q[8 * i + 5] = bfhi(w.z); q[8 * i + 6] = bflo(w.w); q[8 * i + 7] = bfhi(w.w); } }
#pragma unroll
    for (int d = 0; d < 64; ++d) acc[d] = 0.f;
    float mx = -1e30f, lsum = 0.f;
    for (int kt = 0; kt <= qb; ++kt) {
        __syncthreads();
        for (int p = C.tid; p < 4096; p += NTHR) { const int arr = p >> 11, row = (p >> 3) & 255, pc = p & 7;
            const bf16* src = (arr ? Vb : Kb) + ((size_t)b * TSEQ + kt * 256 + row) * 256 + h * 64 + pc * 8;
            *(LAS v4u*)((arr ? Vsm : Ksm) + row * 32 + pc * 4) = *(const v4u*)src; }
        __syncthreads();
        const int jn = (kt == qb) ? 256 : 256;
#pragma unroll 1
        for (int j = 0; j < jn; ++j) {
            if (kt * 256 + j > t) break;
            const LAS v4u* kp = (const LAS v4u*)(Ksm + j * 32 + map * 16);
            float s = 0.f;
#pragma unroll
            for (int i = 0; i < 4; ++i) { const v4u w = kp[i];
                s += q[8 * i] * bflo(w.x) + q[8 * i + 1] * bfhi(w.x) + q[8 * i + 2] * bflo(w.y) + q[8 * i + 3] * bfhi(w.y) + q[8 * i + 4] * bflo(w.z) + q[8 * i + 5] * bfhi(w.z) + q[8 * i + 6] * bflo(w.w) + q[8 * i + 7] * bfhi(w.w); }
            if (s > mx) { const float sc = exp2f(mx - s); lsum *= sc;
#pragma unroll
                for (int d = 0; d < 64; ++d) acc[d] *= sc;
                mx = s; }
            const float p = exp2f(s - mx); lsum += p;
            const LAS v4u* vp = (const LAS v4u*)(Vsm + j * 32);
#pragma unroll
            for (int i = 0; i < 8; ++i) { const v4u w = vp[i];
                acc[8 * i] += p * bflo(w.x); acc[8 * i + 1] += p * bfhi(w.x); acc[8 * i + 2] += p * bflo(w.y); acc[8 * i + 3] += p * bfhi(w.y);
                acc[8 * i + 4] += p * bflo(w.z); acc[8 * i + 5] += p * bfhi(w.z); acc[8 * i + 6] += p * bflo(w.w); acc[8 * i + 7] += p * bfhi(w.w); }
        }
    }
    __syncthreads();
    const float il = 1.f / lsum;
    if (map == 1) {
#pragma unroll
        for (int d = 0; d < 64; ++d) O2[qi * 65 + d] = acc[d] * il;
    }
    __syncthreads();
    if (map == 0) {
        const float lam = C.ws<float>(WS_SCAL)[l]; const float lam_init = l == 0 ? 0.2f : 0.35550906759096934f;
        float ss = 0.f;
#pragma unroll
        for (int d = 0; d < 64; ++d) { acc[d] = acc[d] * il - lam * O2[qi * 65 + d]; ss += acc[d] * acc[d]; }
        const float rs = rsqrtf(ss * (1.f / 64.f) + EPS) * (1.f - lam_init);
        const float* g = A.in[I_ANG] + l * 64;
#pragma unroll
        for (int d = 0; d < 64; d += 2) { const unsigned ga = *(const unsigned*)(GA + m * 256 + h * 64 + d);
            *(unsigned*)(MIX + m * DM + h * 64 + d) = pk2(acc[d] * rs * g[d] * bflo(ga), acc[d + 1] * rs * g[d + 1] * bfhi(ga)); }
    }
    __syncthreads();
}

namespace fa {
typedef float f32x16 __attribute__((ext_vector_type(16)));
typedef short bf16x8 __attribute__((ext_vector_type(8)));
typedef short s16x4 __attribute__((ext_vector_type(4)));
typedef short v4i16_t __attribute__((ext_vector_type(4)));
typedef float f32x2_t __attribute__((ext_vector_type(2))); typedef __bf16 bf16x2_t __attribute__((ext_vector_type(2)));
constexpr int SLOT = 16384;
constexpr int LDS_WSF = 65536;
constexpr int LDS_EX = 65536 + 4096;
constexpr float THR = 32.f;
__device__ __forceinline__ float max3f(float a, float b, float c) { return __builtin_fmaxf(__builtin_fmaxf(a, b), c); }
__device__ __forceinline__ unsigned cvtpk(float lo, float hi) { f32x2_t v = {lo, hi}; bf16x2_t b = __builtin_convertvector(v, bf16x2_t); return __builtin_bit_cast(unsigned, b); }
__device__ __forceinline__ float half_swap_max(float m) { auto rr = __builtin_amdgcn_permlane32_swap(__float_as_uint(m), __float_as_uint(m), false, false); return __builtin_fmaxf(__uint_as_float(rr[0]), __uint_as_float(rr[1])); }
__device__ __forceinline__ float half_swap_sum(float m) { auto rr = __builtin_amdgcn_permlane32_swap(__float_as_uint(m), __float_as_uint(m), false, false); return __uint_as_float(rr[0]) + __uint_as_float(rr[1]); }
__device__ __forceinline__ float rowmax(const f32x16& p0, const f32x16& p1) {
    float a = max3f(p0[0], p0[1], p1[0]), b = max3f(p0[2], p0[3], p1[1]); a = max3f(a, p1[2], p1[3]);
#pragma unroll
    for (int r = 4; r < 16; r += 4) { a = max3f(a, p0[r], p0[r + 1]); b = max3f(b, p0[r + 2], p0[r + 3]); a = max3f(a, p1[r], p1[r + 1]); b = max3f(b, p1[r + 2], p1[r + 3]); }
    return half_swap_max(__builtin_fmaxf(a, b));
}
__device__ __forceinline__ s16x4 vtr(const LAS unsigned char* p) { return __builtin_bit_cast(s16x4, __builtin_amdgcn_ds_read_tr16_b64_v4i16((LAS v4i16_t*)p)); }
__device__ __forceinline__ void softmax_step(const bool FIRST, f32x16& S0, f32x16& S1, float& m, float& lsum, f32x16 (&O)[2], LAS float* wsf, int r32, int hi, bf16x8 (&pk)[4]) {
    const float rm = rowmax(S0, S1);
    if (FIRST) m = (rm != -INFINITY && fabsf(rm) > THR) ? rm : 0.f;
    else if (__any(rm - m > THR)) {
        const float mn = __builtin_fmaxf(m, rm); const float f = __builtin_amdgcn_exp2f(m - mn); m = mn; lsum *= f;
        if (hi == 0) wsf[r32] = f;
        LDS_WAIT();
#pragma unroll
        for (int g = 0; g < 4; ++g) { const f32x4 fv = *(const LAS f32x4*)(wsf + 8 * g + 4 * hi);
#pragma unroll
            for (int j = 0; j < 4; ++j) { O[0][4 * g + j] *= fv[j]; O[1][4 * g + j] *= fv[j]; } }
        LDS_WAIT();
    }
    float s = 0.f;
    if (__all(m == 0.f)) {
#pragma unroll
        for (int r = 0; r < 16; ++r) { S0[r] = __builtin_amdgcn_exp2f(S0[r]); S1[r] = __builtin_amdgcn_exp2f(S1[r]); s += S0[r] + S1[r]; }
    } else {
#pragma unroll
        for (int r = 0; r < 16; ++r) { S0[r] = __builtin_amdgcn_exp2f(S0[r] - m); S1[r] = __builtin_amdgcn_exp2f(S1[r] - m); s += S0[r] + S1[r]; }
    }
    lsum += s;
    v4u w;
    w.x = cvtpk(S0[0], S0[1]); w.y = cvtpk(S0[2], S0[3]); w.z = cvtpk(S0[4], S0[5]); w.w = cvtpk(S0[6], S0[7]); pk[0] = __builtin_bit_cast(bf16x8, w);
    w.x = cvtpk(S0[8], S0[9]); w.y = cvtpk(S0[10], S0[11]); w.z = cvtpk(S0[12], S0[13]); w.w = cvtpk(S0[14], S0[15]); pk[1] = __builtin_bit_cast(bf16x8, w);
    w.x = cvtpk(S1[0], S1[1]); w.y = cvtpk(S1[2], S1[3]); w.z = cvtpk(S1[4], S1[5]); w.w = cvtpk(S1[6], S1[7]); pk[2] = __builtin_bit_cast(bf16x8, w);
    w.x = cvtpk(S1[8], S1[9]); w.y = cvtpk(S1[10], S1[11]); w.z = cvtpk(S1[12], S1[13]); w.w = cvtpk(S1[14], S1[15]); pk[3] = __builtin_bit_cast(bf16x8, w);
}
__device__ __forceinline__ void cmask(f32x16& p0, f32x16& p1, int krel0, int qrel, int hi) {
    asm volatile("" : "+v"(hi), "+v"(qrel));
#pragma unroll
    for (int r = 0; r < 16; ++r) { const int kv = krel0 + 4 * hi + (r & 3) + 8 * (r >> 2); if (kv > qrel) p0[r] = -INFINITY; if (kv + 32 > qrel) p1[r] = -INFINITY; }
}
#define FA_MFMA(a, b, c) __builtin_amdgcn_mfma_f32_32x32x16_bf16((a), (b), (c), 0, 0, 0)
__device__ __forceinline__ void tile_step(const bool FIRST, const LAS unsigned char* slot, const bf16x8 (&qr)[4], bool band, int krel0, int qrel, int r32, int hi, int lane,
        float& m_a, float& l_a, f32x16 (&Oa)[2], float& m_b, float& l_b, f32x16 (&Ob)[2], LAS float* wsf, const bf16* Kg, const bf16* Vg) {
#if MK_CHECK == 2
    const bf16* kp = Kg + (size_t)r32 * 256 + hi * 8;
#define KFR(off) (*(const bf16x8*)(kp + ((off) >> 10 >> 1) * 16 + (((off) >> 9) & 1) * 32 * 256))
#else
    const LAS unsigned char* kp = slot + hi * 1024 + r32 * 16;
#define KFR(off) (*(const LAS bf16x8*)(kp + (off)))
#endif
    bf16x8 pa[4], pb[4];
    {   f32x16 S0, S1;
        const bf16x8 k00 = KFR(0), k01 = KFR(512), k10 = KFR(2048), k11 = KFR(2048 + 512);
        S0 = FA_MFMA(k00, qr[0], (f32x16{})); S1 = FA_MFMA(k01, qr[0], (f32x16{})); S0 = FA_MFMA(k10, qr[1], S0); S1 = FA_MFMA(k11, qr[1], S1);
        if (band) cmask(S0, S1, krel0, qrel, hi);
        softmax_step(FIRST, S0, S1, m_a, l_a, Oa, wsf, r32, hi, pa);
    }
    asm volatile("" ::: "memory");
    {   f32x16 S0, S1;
        const bf16x8 k00 = KFR(4096), k01 = KFR(4096 + 512), k10 = KFR(6144), k11 = KFR(6144 + 512);
        S0 = FA_MFMA(k00, qr[2], (f32x16{})); S1 = FA_MFMA(k01, qr[2], (f32x16{})); S0 = FA_MFMA(k10, qr[3], S0); S1 = FA_MFMA(k11, qr[3], S1);
        if (band) cmask(S0, S1, krel0, qrel, hi);
        softmax_step(FIRST, S0, S1, m_b, l_b, Ob, wsf + 64, r32, hi, pb);
    }
    asm volatile("" ::: "memory");
    const LAS unsigned char* vp = slot + 8192 + ((lane >> 4) & 1) * 32 + (lane & 3) * 8 + (4 * hi + ((lane & 15) >> 2)) * 64;
#pragma unroll
    for (int d0 = 0; d0 < 2; ++d0)
#pragma unroll
        for (int ks = 0; ks < 4; ++ks) {
#if MK_CHECK == 2
            bf16x8 vf;
#pragma unroll
            for (int j = 0; j < 8; ++j) vf[j] = (short)Vg[(size_t)(16 * ks + 8 * (j >> 2) + 4 * hi + (j & 3)) * 256 + 32 * d0 + r32];
#else
            const s16x4 lo = vtr(vp + d0 * 4096 + ks * 1024), hh = vtr(vp + d0 * 4096 + ks * 1024 + 512);
            const bf16x8 vf = (bf16x8){lo[0], lo[1], lo[2], lo[3], hh[0], hh[1], hh[2], hh[3]};
#endif
            Oa[d0] = FA_MFMA(pa[ks], vf, Oa[d0]); Ob[d0] = FA_MFMA(pb[ks], vf, Ob[d0]);
            if (ks == 3) asm volatile("" ::: "memory");
        }
#undef KFR
}
#define FA_WAITBAR() do { asm volatile("s_waitcnt vmcnt(0) lgkmcnt(0)" ::: "memory"); __builtin_amdgcn_s_barrier(); asm volatile("" ::: "memory"); } while (0)

__device__ __forceinline__ void unit(const Ctx& C, int l, int bh, int y, bf16* MIX) {
    int lane = C.lane; asm volatile("" : "+v"(lane));
    const int wid = C.wave, r32 = lane & 31, hi = lane >> 5, half = wid >> 2, wq = wid & 3;
    const int b = bh >> 2, h = bh & 3; const int q0 = 128 * y, qrel = 32 * wq + r32;
    const size_t rowbase = (size_t)b * TSEQ;
    const bf16* Qw = C.ws<bf16>(WS_Q) + (rowbase + q0 + qrel) * 256 + h * 64;
    const unsigned char* KT = C.ws<unsigned char>(WS_KT) + (size_t)bh * 128 * 8192 + wid * 1024 + lane * 16;
    const unsigned char* VT = C.ws<unsigned char>(WS_VT) + (size_t)bh * 128 * 8192 + wid * 1024 + lane * 16;
    LAS unsigned char* lds = C.lds; LAS float* wsf = (LAS float*)(lds + LDS_WSF) + wid * 128;
    bf16x8 qr[4];
#pragma unroll
    for (int d0 = 0; d0 < 4; ++d0) qr[d0] = *(const bf16x8*)(Qw + d0 * 16 + hi * 8);
    const int nsteps = y + 1;
#define FA_DMA(i) do { _Pragma("unroll") for (int hf_ = 0; hf_ < 2; ++hf_) { const int t_ = 2 * (i) + hf_; LAS unsigned char* d_ = lds + ((((i) & 1) * 2 + hf_) * SLOT) + wid * 1024; \
        __builtin_amdgcn_global_load_lds((const unsigned*)(KT + (size_t)t_ * 8192), (LAS unsigned*)d_, 16, 0, 0); \
        __builtin_amdgcn_global_load_lds((const unsigned*)(VT + (size_t)t_ * 8192), (LAS unsigned*)(d_ + 8192), 16, 0, 0); } } while (0)
    float m_a = 0.f, l_a = 0.f, m_b = 0.f, l_b = 0.f; f32x16 Oa[2], Ob[2];
    Oa[0] = f32x16{}; Oa[1] = f32x16{}; Ob[0] = f32x16{}; Ob[1] = f32x16{};
    FA_DMA(0);
    FA_WAITBAR();
#pragma unroll 1
    for (int i = 0; i < nsteps; ++i) {
        if (i + 1 < nsteps) FA_DMA(i + 1);
        const int t = 2 * i + half; const bool band = t >= 2 * y;
        tile_step(i == 0, lds + ((i & 1) * 2 + half) * SLOT, qr, band, 64 * (t - 2 * y), qrel, r32, hi, lane, m_a, l_a, Oa, m_b, l_b, Ob, wsf,
                  C.ws<bf16>(WS_KR) + (rowbase + (size_t)t * 64) * 256 + h * 64, C.ws<bf16>(WS_VR) + (rowbase + (size_t)t * 64) * 256 + h * 64);
        FA_WAITBAR();
    }
    l_a = half_swap_sum(l_a); l_b = half_swap_sum(l_b);
    LAS f32x4* EX = (LAS f32x4*)(lds + LDS_EX);
    if (hi == 0) EX[wid * 32 + r32] = (f32x4){m_a, l_a, m_b, l_b};
    FA_WAITBAR();
    {   const f32x4 o = EX[(wid ^ 4) * 32 + r32];
        const float lam = C.ws<float>(WS_SCAL)[l];
        const float Ma = __builtin_fmaxf(m_a, o.x), fa_ = __builtin_amdgcn_exp2f(m_a - Ma), fa2 = __builtin_amdgcn_exp2f(o.x - Ma); const float ca = fa_ / (l_a * fa_ + o.y * fa2);
        const float Mb = __builtin_fmaxf(m_b, o.z), fb_ = __builtin_amdgcn_exp2f(m_b - Mb), fb2 = __builtin_amdgcn_exp2f(o.z - Mb); const float cb = -lam * fb_ / (l_b * fb_ + o.w * fb2);
        if (hi == 0) { wsf[r32] = ca; wsf[64 + r32] = cb; }
        LDS_WAIT();
    }
    f32x16 part[2];
#pragma unroll
    for (int g = 0; g < 4; ++g) { const f32x4 fa4 = *(const LAS f32x4*)(wsf + 8 * g + 4 * hi), fb4 = *(const LAS f32x4*)(wsf + 64 + 8 * g + 4 * hi);
#pragma unroll
        for (int j = 0; j < 4; ++j) { part[0][4 * g + j] = Oa[0][4 * g + j] * fa4[j] + Ob[0][4 * g + j] * fb4[j]; part[1][4 * g + j] = Oa[1][4 * g + j] * fa4[j] + Ob[1][4 * g + j] * fb4[j]; } }
    LAS float* XO = (LAS float*)lds + wq * 2048;
    if (half == 1) {
#pragma unroll
        for (int r = 0; r < 16; ++r) { XO[r * 64 + lane] = part[0][r]; XO[(16 + r) * 64 + lane] = part[1][r]; }
    }
    FA_WAITBAR();
    if (half == 0) {
        const float lam_init = l == 0 ? 0.2f : 0.35550906759096934f;
        float ss[16];
#pragma unroll
        for (int r = 0; r < 16; ++r) { part[0][r] += XO[r * 64 + lane]; part[1][r] += XO[(16 + r) * 64 + lane]; ss[r] = part[0][r] * part[0][r] + part[1][r] * part[1][r]; }
#pragma unroll
        for (int r = 0; r < 16; ++r) { ss[r] = sx_sum<1>(ss[r]); ss[r] = sx_sum<2>(ss[r]); ss[r] = sx_sum<4>(ss[r]); ss[r] = sx_sum<8>(ss[r]); ss[r] = sx_sum<16>(ss[r]); }
        const float* g = C.a->in[I_ANG] + l * 64; const float g0 = g[r32], g1 = g[32 + r32];
        const bf16* GA = C.ws<bf16>(WS_GA);
#pragma unroll
        for (int r = 0; r < 16; ++r) { const size_t row = rowbase + q0 + 32 * wq + (r & 3) + 8 * (r >> 2) + 4 * hi;
            const float rs = rsqrtf(ss[r] * (1.f / 64.f) + EPS) * (1.f - lam_init);
            MIX[row * DM + h * 64 + r32] = (bf16)f2bf(part[0][r] * rs * g0 * bf2f(GA[row * 256 + h * 64 + r32]));
            MIX[row * DM + h * 64 + 32 + r32] = (bf16)f2bf(part[1][r] * rs * g1 * bf2f(GA[row * 256 + h * 64 + 32 + r32])); }
    }
    FA_WAITBAR();
#undef FA_DMA
}
}

namespace sgm {
using fa::f32x16; using fa::bf16x8;
constexpr int VT_STRIDE = 272;
__device__ __forceinline__ void unit(const Ctx& C, int l, int chunk, bf16* MIX) {
    const CAS Args& A = *C.a;
    int lane = C.lane; asm volatile("" : "+v"(lane));
    const int r32 = lane & 31, hi = lane >> 5, wid = C.wave, g = wid >> 1, th = wid & 1, tid = wid * 64 + lane;
    const bf16 *U = C.ws<bf16>(WS_U), *VN = C.ws<bf16>(WS_VN), *GB = C.ws<bf16>(WS_GB);
    const size_t m0 = (size_t)chunk * 128;
    LAS unsigned char* VT = C.lds;
    {
        const f32x4 gam = ld4(A.in[I_SGG] + l * 256 + 4 * lane), bet = ld4(A.in[I_SGB] + l * 256 + 4 * lane);
        v2u raw[16];
#pragma unroll
        for (int i = 0; i < 16; ++i) raw[i] = *(const v2u*)(VN + (m0 + wid * 16 + i) * 256 + 4 * lane);
#pragma unroll
        for (int i = 0; i < 16; ++i) { const int s_ = wid * 16 + i; const f32x4 v = (f32x4){bflo(raw[i].x), bfhi(raw[i].x), bflo(raw[i].y), bfhi(raw[i].y)};
            const float mean = wave_sum((v.x + v.y) + (v.z + v.w)) * (1.f / 256.f); const f32x4 d = v - mean;
            const float var = wave_sum((d.x * d.x + d.y * d.y) + (d.z * d.z + d.w * d.w)) * (1.f / 256.f);
            const f32x4 y = d * rsqrtf(var + EPS) * gam + bet;
            LAS unsigned char* p = VT + (4 * lane) * VT_STRIDE + s_ * 2;
            *(LAS unsigned short*)(p) = (unsigned short)f2bf(y.x); *(LAS unsigned short*)(p + VT_STRIDE) = (unsigned short)f2bf(y.y);
            *(LAS unsigned short*)(p + 2 * VT_STRIDE) = (unsigned short)f2bf(y.z); *(LAS unsigned short*)(p + 3 * VT_STRIDE) = (unsigned short)f2bf(y.w); }
    }
    __syncthreads();
    const bf16* Wm = C.ws<bf16>(WS_WSB) + (size_t)(l * 4 + g) * 128 * 128;
    f32x16 acc[2][2];
#pragma unroll
    for (int a = 0; a < 2; ++a) { acc[a][0] = f32x16{}; acc[a][1] = f32x16{}; }
#pragma unroll
    for (int tbi = 0; tbi < 2; ++tbi) {
        const int tb = 2 * th + tbi; const bf16* wrow = Wm + (size_t)(tb * 32 + r32) * 128 + 8 * hi;
        const LAS unsigned char* vb = VT + (g * 64 + r32) * VT_STRIDE + 16 * hi;
        bf16x8 af[8];
#pragma unroll
        for (int ks = 0; ks < 8; ++ks) af[ks] = *(const bf16x8*)(wrow + 16 * ks);
#pragma unroll
        for (int ks = 0; ks < 8; ++ks) { if (ks < 2 * (tb + 1)) {
            const bf16x8 b0 = *(const LAS bf16x8*)(vb + 32 * ks), b1 = *(const LAS bf16x8*)(vb + 32 * VT_STRIDE + 32 * ks);
            acc[tbi][0] = FA_MFMA(af[ks], b0, acc[tbi][0]); acc[tbi][1] = FA_MFMA(af[ks], b1, acc[tbi][1]); } }
    }
    const float* bsv = A.in[I_BS] + (l * 4 + g) * 128;
#pragma unroll
    for (int tbi = 0; tbi < 2; ++tbi)
#pragma unroll
        for (int r = 0; r < 16; ++r) { const int t = (2 * th + tbi) * 32 + (r & 3) + 8 * (r >> 2) + 4 * hi; const float bias = bsv[t];
#pragma unroll
            for (int d0 = 0; d0 < 2; ++d0) { const int col = g * 64 + 32 * d0 + r32; const size_t mo = (m0 + t) * 256 + col;
                MIX[(m0 + t) * DM + 256 + col] = (bf16)f2bf(bf2f(U[mo]) * (acc[tbi][d0][r] + bias) * bf2f(GB[mo])); } }
    __syncthreads();
}
}

namespace cvm {
using fa::f32x16; using fa::bf16x8;
constexpr int Y_OFF = 0, YN_OFF = 65536, YN_STRIDE = 528;
__device__ __forceinline__ void unit(const Ctx& C, int l, int u, bf16* MIX) {
    const CAS Args& A = *C.a;
    int lane = C.lane; asm volatile("" : "+v"(lane));
    const int wid = C.wave, tid = wid * 64 + lane, r32 = lane & 31, hi = lane >> 5;
    const float* GLU = C.ws<float>(WS_GLU); const bf16* GC = C.ws<bf16>(WS_GC);
    LAS float* Y = (LAS float*)(C.lds + Y_OFF); LAS unsigned char* YN = C.lds + YN_OFF;
    const int r0 = u * 64; const bool samp = r0 >= MP;
    {
        const int c = tid & 255, half = tid >> 8;
        float cw[31];
#pragma unroll
        for (int j = 0; j < 31; ++j) cw[j] = A.in[I_CW][(size_t)(l * 31 + j) * 256 + c];
        const float cb = A.in[I_CB][l * 256 + c];
        if (!samp) {
            const int rg = half * 32, m = r0 + rg, t0 = m & (TSEQ - 1);
            float in[62];
#pragma unroll
            for (int k = 0; k < 62; ++k) { const int tt = t0 - 30 + k; in[k] = tt >= 0 ? GLU[(size_t)(m - 30 + k) * 256 + c] : 0.f; }
#pragma unroll
            for (int i = 0; i < 32; ++i) { float y = cb;
#pragma unroll
                for (int j = 0; j < 31; ++j) y += cw[j] * in[i + j];
                Y[(rg + i) * 256 + c] = y; }
        } else {
#pragma unroll 1
            for (int gq = 0; gq < 4; ++gq) {
                const int rg = half * 32 + gq * 8, m = r0 + rg;
                float in[38];
                const int bs = (m - MP) >> 3; const float* sc = A.in[I_SCONV] + (size_t)(l * NBS + bs) * 30 * 256 + c;
#pragma unroll
                for (int k = 0; k < 30; ++k) in[k] = sc[k * 256];
#pragma unroll
                for (int k = 0; k < 8; ++k) in[30 + k] = GLU[(size_t)(m + k) * 256 + c];
#pragma unroll
                for (int i = 0; i < 8; ++i) { float y = cb;
#pragma unroll
                    for (int j = 0; j < 31; ++j) y += cw[j] * in[i + j];
                    Y[(rg + i) * 256 + c] = y; }
            }
        }
    }
    __syncthreads();
    {
        const f32x4 g = ld4(A.in[I_CNG] + l * 256 + 4 * lane), b = ld4(A.in[I_CNB] + l * 256 + 4 * lane);
#pragma unroll
        for (int i4 = 0; i4 < 2; ++i4) { f32x4 v[4]; float sm[4], sq[4];
#pragma unroll
            for (int i = 0; i < 4; ++i) { v[i] = *(const LAS f32x4*)(Y + (wid * 8 + i4 * 4 + i) * 256 + 4 * lane); sm[i] = (v[i].x + v[i].y) + (v[i].z + v[i].w); }
#pragma unroll
            for (int i = 0; i < 4; ++i) sm[i] = sx_sum<1>(sm[i]);
#pragma unroll
            for (int i = 0; i < 4; ++i) sm[i] = sx_sum<2>(sm[i]);
#pragma unroll
            for (int i = 0; i < 4; ++i) sm[i] = sx_sum<4>(sm[i]);
#pragma unroll
            for (int i = 0; i < 4; ++i) sm[i] = sx_sum<8>(sm[i]);
#pragma unroll
            for (int i = 0; i < 4; ++i) sm[i] = sx_sum<16>(sm[i]);
#pragma unroll
            for (int i = 0; i < 4; ++i) { sm[i] = sx_sum<32>(sm[i]) * (1.f / 256.f); v[i] = v[i] - sm[i]; sq[i] = (v[i].x * v[i].x + v[i].y * v[i].y) + (v[i].z * v[i].z + v[i].w * v[i].w); }
#pragma unroll
            for (int i = 0; i < 4; ++i) sq[i] = sx_sum<1>(sq[i]);
#pragma unroll
            for (int i = 0; i < 4; ++i) sq[i] = sx_sum<2>(sq[i]);
#pragma unroll
            for (int i = 0; i < 4; ++i) sq[i] = sx_sum<4>(sq[i]);
#pragma unroll
            for (int i = 0; i < 4; ++i) sq[i] = sx_sum<8>(sq[i]);
#pragma unroll
            for (int i = 0; i < 4; ++i) sq[i] = sx_sum<16>(sq[i]);
#pragma unroll
            for (int i = 0; i < 4; ++i) { const float var = sx_sum<32>(sq[i]) * (1.f / 256.f); f32x4 y = v[i] * rsqrtf(var + EPS) * g + b; y = (f32x4){silu_f(y.x), silu_f(y.y), silu_f(y.z), silu_f(y.w)};
                v2u w; w.x = pk2(y.x, y.y); w.y = pk2(y.z, y.w); *(LAS v2u*)(YN + (wid * 8 + i4 * 4 + i) * YN_STRIDE + 8 * lane) = w; } }
    }
    __syncthreads();
    {
        const int rb = wid & 1, cq = wid >> 1;
        const bf16* WT = C.ws<bf16>(WS_WPW) + (size_t)l * 256 * 256 + (size_t)(cq * 64 + r32) * 256 + 8 * hi;
        const LAS unsigned char* ya = YN + (rb * 32 + r32) * YN_STRIDE + 16 * hi;
        f32x16 acc0 = f32x16{}, acc1 = f32x16{};
#pragma unroll
        for (int kb = 0; kb < 2; ++kb) { bf16x8 b0[8], b1[8];
#pragma unroll
            for (int k8 = 0; k8 < 8; ++k8) { b0[k8] = *(const bf16x8*)(WT + 16 * (8 * kb + k8)); b1[k8] = *(const bf16x8*)(WT + 32 * 256 + 16 * (8 * kb + k8)); }
#pragma unroll
            for (int k8 = 0; k8 < 8; ++k8) { const bf16x8 af = *(const LAS bf16x8*)(ya + 32 * (8 * kb + k8)); acc0 = FA_MFMA(af, b0[k8], acc0); acc1 = FA_MFMA(af, b1[k8], acc1); } }
#pragma unroll
        for (int r = 0; r < 16; ++r) { const size_t m = (size_t)r0 + rb * 32 + (r & 3) + 8 * (r >> 2) + 4 * hi; const int d = cq * 64 + r32;
            MIX[m * DM + 512 + d] = (bf16)f2bf(acc0[r] * bf2f(GC[m * 256 + d]));
            MIX[m * DM + 512 + d + 32] = (bf16)f2bf(acc1[r] * bf2f(GC[m * 256 + d + 32])); }
    }
    __syncthreads();
}
}

namespace hg {
typedef short bf16x8 __attribute__((ext_vector_type(8)));
#define HG_MFMA(a, b, c) __builtin_amdgcn_mfma_f32_16x16x32_bf16((a), (b), (c), 0, 0, 0)
constexpr int RS = 144;
constexpr int O_QE = 0, O_QM = 16 * RS, O_KM = 32 * RS, O_KET = 48 * RS, O_VT = O_KET + 2048, O_AS = O_VT + 2048, WAVE_LDS = 12288;
static_assert(O_AS + 256 <= WAVE_LDS, "hgrn lds");
__device__ __forceinline__ unsigned pk(float a, float b) { return fa::cvtpk(a, b); }
template <int MODE> __device__ __forceinline__ void item(const Ctx& C, int l, int it, bf16* MIX) {
    const CAS Args& A = *C.a;
    int lane = C.lane; asm volatile("" : "+v"(lane));
    const int col = lane & 15, g = lane >> 4;
    const float* LF = C.ws<float>(WS_LF); const bf16 *QD = C.ws<bf16>(WS_QD), *KD = C.ws<bf16>(WS_KD), *VD = C.ws<bf16>(WS_VD), *GD = C.ws<bf16>(WS_GD);
    LAS unsigned char* W = C.lds + C.wave * WAVE_LDS;
    int h, m0, nchunk, ntok; size_t sidx;
    if (MODE == 2) { const int bs = it >> 2; h = it & 3; m0 = MP + bs * 8; nchunk = 1; ntok = 8; sidx = ((size_t)(l * NBS + bs) * 4 + h) * 4096; }
    else { const int bh = it >> 7, j = it & 127; h = bh & 3; m0 = (bh >> 2) * TSEQ + j * HG_L; nchunk = HG_L / 16; ntok = 16; sidx = (size_t)it * 4096; }
    f32x4 S[4][4];
    if (MODE == 0) {
#pragma unroll
        for (int a = 0; a < 4; ++a)
#pragma unroll
            for (int b = 0; b < 4; ++b) S[a][b] = (f32x4){0.f, 0.f, 0.f, 0.f};
    } else { const float* s0 = (MODE == 2 ? A.in[I_SHGRN] : C.ws<float>(WS_SST)) + sidx + (size_t)(4 * g) * 64 + col;
#pragma unroll
        for (int a = 0; a < 4; ++a)
#pragma unroll
            for (int b = 0; b < 4; ++b) { const float* p = s0 + (size_t)(16 * a) * 64 + 16 * b; S[a][b] = (f32x4){p[0], p[64], p[128], p[192]}; } }
    unsigned z0 = 0u; asm volatile("" : "+v"(z0));
    float lftot = 0.f;
    float rlf[16]; unsigned rkq[16]; unsigned rvv[8];
#define HG_LOAD(ch_) do { const size_t o0_ = (size_t)(m0 + (ch_) * 16) * 256 + h * 64 + lane; \
        _Pragma("unroll") for (int t = 0; t < 16; ++t) { const bool ok = t < ntok; rlf[t] = ok ? LF[o0_ + (size_t)t * 256] : 0.f; \
            rkq[t] = ok ? ((unsigned)KD[o0_ + (size_t)t * 256] | (MODE != 0 ? ((unsigned)QD[o0_ + (size_t)t * 256] << 16) : 0u)) : 0u; } \
        _Pragma("unroll") for (int t = 0; t < 16; t += 2) { const unsigned a_ = t < ntok ? (unsigned)VD[o0_ + (size_t)t * 256] : z0, b_ = t + 1 < ntok ? (unsigned)VD[o0_ + (size_t)(t + 1) * 256] : z0; rvv[t >> 1] = a_ | (b_ << 16); } } while (0)
    HG_LOAD(0);
#pragma unroll 1
    for (int ch = 0; ch < nchunk; ++ch) {
        {
            float cum[16], kd[16], q[16]; unsigned vv[8];
#pragma unroll
            for (int t = 0; t < 16; ++t) { cum[t] = rlf[t]; kd[t] = bflo(rkq[t]); q[t] = bfhi(rkq[t]); }
#pragma unroll
            for (int t = 0; t < 8; ++t) vv[t] = rvv[t];
            if (ch + 1 < nchunk) HG_LOAD(ch + 1);
#pragma unroll
            for (int t = 1; t < 16; ++t) cum[t] += cum[t - 1];
            const float cL = cum[15], cm = cum[7]; lftot += cL;
            unsigned ke[8];
#pragma unroll
            for (int t = 0; t < 16; t += 2) ke[t >> 1] = pk(kd[t] * __expf(cL - cum[t]), kd[t + 1] * __expf(cL - cum[t + 1]));
            *(LAS v4u*)(W + O_KET + lane * 32) = (v4u){ke[0], ke[1], ke[2], ke[3]}; *(LAS v4u*)(W + O_KET + lane * 32 + 16) = (v4u){ke[4], ke[5], ke[6], ke[7]};
            *(LAS v4u*)(W + O_VT + lane * 32) = (v4u){vv[0], vv[1], vv[2], vv[3]}; *(LAS v4u*)(W + O_VT + lane * 32 + 16) = (v4u){vv[4], vv[5], vv[6], vv[7]};
            *(LAS float*)(W + O_AS + lane * 4) = __expf(cL);
            if (MODE != 0) {
#pragma unroll
                for (int t = 0; t < 16; ++t) {
                    *(LAS unsigned short*)(W + O_QE + t * RS + lane * 2) = (unsigned short)f2bf(q[t] * __expf(cum[t]));
                    *(LAS unsigned short*)(W + O_QM + t * RS + lane * 2) = (unsigned short)f2bf(q[t] * __expf(cum[t] - cm));
                    *(LAS unsigned short*)(W + O_KM + t * RS + lane * 2) = (unsigned short)f2bf(kd[t] * __expf(cm - cum[t])); }
            }
        }
        LDS_WAIT(); asm volatile("" ::: "memory");
        if (MODE != 0) {
            v2u gdr[4];
            { const size_t mg = ((size_t)m0 + ch * 16 + (col < ntok ? col : 0)) * 256 + h * 64 + 4 * g;
#pragma unroll
              for (int nb = 0; nb < 4; ++nb) gdr[nb] = *(const v2u*)(GD + mg + 16 * nb); }
            f32x4 OT[4];
#pragma unroll
            for (int nb = 0; nb < 4; ++nb) OT[nb] = (f32x4){0.f, 0.f, 0.f, 0.f};
#pragma unroll
            for (int ks = 0; ks < 2; ++ks) {
                const v2u q0 = *(const LAS v2u*)(W + O_QE + col * RS + (32 * ks + 4 * g) * 2), q1 = *(const LAS v2u*)(W + O_QE + col * RS + (32 * ks + 16 + 4 * g) * 2);
                const bf16x8 bq = __builtin_bit_cast(bf16x8, (v4u){q0.x, q0.y, q1.x, q1.y});
#pragma unroll
                for (int nb = 0; nb < 4; ++nb) { const f32x4 s0 = S[2 * ks][nb], s1 = S[2 * ks + 1][nb];
                    const bf16x8 as = __builtin_bit_cast(bf16x8, (v4u){pk(s0.x, s0.y), pk(s0.z, s0.w), pk(s1.x, s1.y), pk(s1.z, s1.w)});
                    OT[nb] = HG_MFMA(as, bq, OT[nb]); }
            }
            f32x4 at = (f32x4){0.f, 0.f, 0.f, 0.f};
#pragma unroll
            for (int ks = 0; ks < 2; ++ks) { const bf16x8 ak = *(const LAS bf16x8*)(W + O_KM + col * RS + (32 * ks + 8 * g) * 2), bq = *(const LAS bf16x8*)(W + O_QM + col * RS + (32 * ks + 8 * g) * 2);
                at = HG_MFMA(ak, bq, at); }
            { const int sb = 4 * g; if (sb + 0 > col) at.x = 0.f; if (sb + 1 > col) at.y = 0.f; if (sb + 2 > col) at.z = 0.f; if (sb + 3 > col) at.w = 0.f; }
            const bf16x8 batt = __builtin_bit_cast(bf16x8, (v4u){pk(at.x, at.y), pk(at.z, at.w), z0, z0});
#pragma unroll
            for (int nb = 0; nb < 4; ++nb) { const v2u v0 = *(const LAS v2u*)(W + O_VT + (16 * nb + col) * 32 + 8 * g);
                OT[nb] = HG_MFMA(__builtin_bit_cast(bf16x8, (v4u){v0.x, v0.y, z0, z0}), batt, OT[nb]); }
            float ss = 0.f;
#pragma unroll
            for (int nb = 0; nb < 4; ++nb) ss += (OT[nb].x * OT[nb].x + OT[nb].y * OT[nb].y) + (OT[nb].z * OT[nb].z + OT[nb].w * OT[nb].w);
            ss = sx_sum<16>(ss); ss = sx_sum<32>(ss);
            const float rs = rsqrtf(ss * (1.f / 64.f) + EPS);
            if (col < ntok) { const size_t m = (size_t)m0 + ch * 16 + col;
#pragma unroll
                for (int nb = 0; nb < 4; ++nb) { const int v = 16 * nb + 4 * g; const f32x4 gn = ld4(A.in[I_HNG] + l * 64 + v); const f32x4 gd = (f32x4){bflo(gdr[nb].x), bfhi(gdr[nb].x), bflo(gdr[nb].y), bfhi(gdr[nb].y)};
                    st_bf4(MIX + m * DM + 768 + h * 64 + v, OT[nb] * rs * gn * gd); } }
        }
        {   bf16x8 ak[4], bv[4];
#pragma unroll
            for (int b = 0; b < 4; ++b) { v4u x = *(const LAS v4u*)(W + O_KET + (16 * b + col) * 32 + 16 * (g & 1)), y = *(const LAS v4u*)(W + O_VT + (16 * b + col) * 32 + 16 * (g & 1));
                if (g >= 2) { x = (v4u){z0, z0, z0, z0}; y = x; } ak[b] = __builtin_bit_cast(bf16x8, x); bv[b] = __builtin_bit_cast(bf16x8, y); }
#pragma unroll
            for (int mb = 0; mb < 4; ++mb) { const f32x4 as = *(const LAS f32x4*)(W + O_AS + (16 * mb + 4 * g) * 4);
#pragma unroll
                for (int nb = 0; nb < 4; ++nb) S[mb][nb] = HG_MFMA(ak[mb], bv[nb], S[mb][nb] * as); }
        }
        LDS_WAIT(); asm volatile("" ::: "memory");
    }
    if (MODE == 0 || MODE == 2) { float* so = (MODE == 0 ? C.ws<float>(WS_SLOC) : A.out + O_HS) + sidx + (size_t)(4 * g) * 64 + col;
#pragma unroll
        for (int a = 0; a < 4; ++a)
#pragma unroll
            for (int b = 0; b < 4; ++b) { float* p = so + (size_t)(16 * a) * 64 + 16 * b; p[0] = S[a][b].x; p[64] = S[a][b].y; p[128] = S[a][b].z; p[192] = S[a][b].w; } }
    if (MODE == 0) C.ws<float>(WS_DTOT)[(size_t)it * 64 + lane] = __expf(lftot);
#undef HG_LOAD
}
}

namespace sa {
using fa::f32x16; using fa::bf16x8; using fa::cvtpk; using fa::max3f; using fa::half_swap_max; using fa::half_swap_sum;
constexpr float THR = 8.f;
__device__ __forceinline__ bf16x8 pack8(const f32x4& a, const f32x4& b) { v4u w; w.x = cvtpk(a.x, a.y); w.y = cvtpk(a.z, a.w); w.z = cvtpk(b.x, b.y); w.w = cvtpk(b.z, b.w); return __builtin_bit_cast(bf16x8, w); }
__device__ __forceinline__ bf16x8 pack8f(const float (&v)[8]) { v4u w; w.x = cvtpk(v[0], v[1]); w.y = cvtpk(v[2], v[3]); w.z = cvtpk(v[4], v[5]); w.w = cvtpk(v[6], v[7]); return __builtin_bit_cast(bf16x8, w); }
struct Raw { f32x4 k[8]; float v[2][2][8]; };
__device__ __forceinline__ void load_tile(Raw& R, const float* krow, const float* vbase, int r32, int hi, const bool extra) {
#pragma unroll
    for (int c = 0; c < 4; ++c) { R.k[2 * c] = ld4(krow + 16 * c + 8 * hi); R.k[2 * c + 1] = ld4(krow + 16 * c + 8 * hi + 4); }
    const int voff = 4 * hi * 256 + r32;
#pragma unroll
    for (int s = 0; s < 2; ++s)
#pragma unroll
        for (int jh = 0; jh < 2; ++jh) { const float* pb = extra ? vbase : vbase + (16 * s + 8 * jh) * 256;
#pragma unroll
            for (int jl = 0; jl < 4; ++jl) { R.v[s][0][4 * jh + jl] = pb[voff + jl * 256]; R.v[s][1][4 * jh + jl] = pb[voff + jl * 256 + 32]; } }
}
struct RawK { f32x4 k[8]; }; struct RawV { f32x4 r[8]; };
__device__ __forceinline__ void load_k(RawK& R, const float* krow, int hi) {
#pragma unroll
    for (int c = 0; c < 4; ++c) { R.k[2 * c] = ld4(krow + 16 * c + 8 * hi); R.k[2 * c + 1] = ld4(krow + 16 * c + 8 * hi + 4); }
}
__device__ __forceinline__ void load_v(RawV& R, const float* vbase, int lane, const bool extra) {
#pragma unroll
    for (int i = 0; i < 8; ++i) { int kv = 4 * i + (lane >> 4); if (extra) kv &= 7; R.r[i] = ld4(vbase + (size_t)kv * 256 + 4 * (lane & 15)); }
}
__device__ __forceinline__ void item(const Ctx& C, int l, int pr, int grp, int part, bf16* MIX) {
    const CAS Args& A = *C.a;
    int lane = C.lane; asm volatile("" : "+v"(lane));
    const int col = lane & 15, g = lane >> 4, bs = pr >> 2, h = pr & 3, wid = C.wave;
    const bf16* Qb = C.ws<bf16>(WS_Q); const int* pt = (const int*)A.in[I_PT] + bs * NPAGES + part * 4;
    const float* ck = A.in[I_CK] + (size_t)l * NPOOL * PAGE * 256 + h * 64; const float* cv = A.in[I_CV] + (size_t)l * NPOOL * PAGE * 256 + h * 64;
    LAS float* wsf = (LAS float*)(C.lds + 65536) + wid * 64;
    LAS float* XM = (LAS float*)(C.lds + 65536 + 2048) + wid * 32;
    LAS float* XO = (LAS float*)C.lds + wid * 1024;
    typedef short bf16x8s __attribute__((ext_vector_type(8)));
    bf16x8s qf[2];
    { const int ts = col & 7; const bf16* qrow = Qb + ((size_t)MP + bs * 8 + ts) * 256 + h * 64 + 8 * g;
      v4u w0 = *(const v4u*)(qrow), w1 = *(const v4u*)(qrow + 32); if (col >= 8) w0 = (v4u){0u, 0u, 0u, 0u}; else w1 = (v4u){0u, 0u, 0u, 0u};
      qf[0] = __builtin_bit_cast(bf16x8s, w0); qf[1] = __builtin_bit_cast(bf16x8s, w1); }
    float m = 0.f, lsum = 0.f; f32x4 O[4];
#pragma unroll
    for (int nb = 0; nb < 4; ++nb) O[nb] = (f32x4){0.f, 0.f, 0.f, 0.f};
    const int ntiles = part == 3 ? 17 : 16;
    const int pg0 = __builtin_amdgcn_readfirstlane(pt[0]), pg1 = __builtin_amdgcn_readfirstlane(pt[1]), pg2 = __builtin_amdgcn_readfirstlane(pt[2]), pg3 = __builtin_amdgcn_readfirstlane(pt[3]);
    auto page_of = [&](int tt) -> int { const int q = tt >> 2; return q == 0 ? pg0 : (q == 1 ? pg1 : (q == 2 ? pg2 : pg3)); };
    struct RK { f32x4 k[8]; }; struct RV { f32x4 r[8]; };
    auto load_k16 = [&](RK& R, int tt) { const bool ex = tt >= 16;
        const float* base = ex ? A.out + O_KS + ((size_t)l * MS + bs * 8) * 256 + h * 64 : ck + ((size_t)page_of(tt) * PAGE + ((tt * 32) & 127)) * 256;
#pragma unroll
        for (int b = 0; b < 2; ++b) { int kv = 16 * b + col; if (ex) kv &= 7; const float* p = base + (size_t)kv * 256 + 8 * g;
#pragma unroll
            for (int ks = 0; ks < 2; ++ks) { R.k[4 * b + 2 * ks] = ld4(p + 32 * ks); R.k[4 * b + 2 * ks + 1] = ld4(p + 32 * ks + 4); } } };
    auto load_v16 = [&](RV& R, int tt) { const bool ex = tt >= 16;
        const float* base = ex ? A.out + O_VS + ((size_t)l * MS + bs * 8) * 256 + h * 64 : cv + ((size_t)page_of(tt) * PAGE + ((tt * 32) & 127)) * 256;
#pragma unroll
        for (int i = 0; i < 8; ++i) { int kv = 4 * i + (lane >> 4); if (ex) kv &= 7; R.r[i] = ld4(base + (size_t)kv * 256 + 4 * (lane & 15)); } };
    RK K0, K1; RV V0, V1;
    load_k16(K0, 0); load_v16(V0, 0); load_k16(K1, 1); load_v16(V1, 1);
    LAS float* VL = (LAS float*)(C.lds + wid * 8192);
    auto step = [&](RK& KR, RV& VR, const int t) {
        f32x4 S0 = (f32x4){0.f, 0.f, 0.f, 0.f}, S1 = S0;
#pragma unroll
        for (int ks = 0; ks < 2; ++ks) { S0 = HG_MFMA(pack8(KR.k[2 * ks], KR.k[2 * ks + 1]), qf[ks], S0); S1 = HG_MFMA(pack8(KR.k[4 + 2 * ks], KR.k[4 + 2 * ks + 1]), qf[ks], S1); }
        asm volatile("" : "+v"(S0), "+v"(S1));
        if (t + 2 < ntiles) load_k16(KR, t + 2);
        if (t == 16) {
            const int ts = col & 7;
#pragma unroll
            for (int i = 0; i < 4; ++i) { if (4 * g + i > ts) S0[i] = -INFINITY; S1[i] = -INFINITY; }
        }
        float rm = __builtin_fmaxf(max3f(S0[0], S0[1], S0[2]), max3f(S0[3], S1[0], S1[1])); rm = max3f(rm, S1[2], S1[3]);
        rm = sx_max<16>(rm); rm = sx_max<32>(rm);
        if (t == 0) m = (rm == -INFINITY) ? 0.f : rm;
        else if (__any(rm - m > THR)) {
            const float mn = __builtin_fmaxf(m, rm); const float f = __builtin_amdgcn_exp2f(m - mn); m = mn; lsum *= f;
            if (g == 0) wsf[col] = f;
            LDS_WAIT();
            const f32x4 fv = *(const LAS f32x4*)(wsf + 4 * g);
#pragma unroll
            for (int nb = 0; nb < 4; ++nb) O[nb] = O[nb] * fv;
            LDS_WAIT();
        }
#pragma unroll
        for (int i = 0; i < 4; ++i) { S0[i] = __builtin_amdgcn_exp2f(S0[i] - m); S1[i] = __builtin_amdgcn_exp2f(S1[i] - m); }
        lsum += ((S0[0] + S0[1]) + (S0[2] + S0[3])) + ((S1[0] + S1[1]) + (S1[2] + S1[3]));
        const bf16x8s pa = __builtin_bit_cast(bf16x8s, (v4u){cvtpk(S0[0], S0[1]), cvtpk(S0[2], S0[3]), cvtpk(S1[0], S1[1]), cvtpk(S1[2], S1[3])});
#pragma unroll
        for (int i = 0; i < 8; ++i) *(LAS f32x4*)(VL + (4 * i + (lane >> 4)) * 64 + 4 * (lane & 15)) = VR.r[i];
        LDS_WAIT(); asm volatile("" ::: "memory");
        if (t + 2 < ntiles) load_v16(VR, t + 2);
        const LAS float* vg = VL + 4 * g * 64 + col;
#pragma unroll
        for (int nb = 0; nb < 4; ++nb) { float a[8];
#pragma unroll
            for (int j = 0; j < 8; ++j) a[j] = vg[((j & 3) + 16 * (j >> 2)) * 64 + 16 * nb];
            O[nb] = HG_MFMA(pa, pack8f(a), O[nb]); }
        asm volatile("" : "+v"(O[0]), "+v"(O[1]), "+v"(O[2]), "+v"(O[3]));
        LDS_WAIT(); asm volatile("" ::: "memory");
    };
#pragma unroll 1
    for (int t = 0; t < ntiles; t += 2) { step(K0, V0, t); if (t + 1 < ntiles) step(K1, V1, t + 1); }
    FA_WAITBAR();
    lsum = sx_sum<16>(lsum); lsum = sx_sum<32>(lsum);
    if (g == 0) { XM[col] = m; XM[16 + col] = lsum; }
#pragma unroll
    for (int nb = 0; nb < 4; ++nb)
#pragma unroll
        for (int i = 0; i < 4; ++i) XO[(4 * g + i) * 64 + 16 * nb + col] = O[nb][i];
    FA_WAITBAR();
    if (part == 0) {
        const LAS float* XMg = (const LAS float*)(C.lds + 65536 + 2048) + grp * 4 * 32; const LAS float* XOg = (const LAS float*)C.lds + grp * 4 * 1024;
        const float lam = C.ws<float>(WS_SCAL)[l]; const float lam_init = l == 0 ? 0.2f : 0.35550906759096934f;
        float o[16];
#pragma unroll
        for (int col = 0; col < 16; ++col) {
            const float m0 = XMg[col], m1 = XMg[32 + col], m2 = XMg[64 + col], m3 = XMg[96 + col];
            const float M = __builtin_fmaxf(__builtin_fmaxf(m0, m1), __builtin_fmaxf(m2, m3));
            const float w0 = __builtin_amdgcn_exp2f(m0 - M), w1 = __builtin_amdgcn_exp2f(m1 - M), w2 = __builtin_amdgcn_exp2f(m2 - M), w3 = __builtin_amdgcn_exp2f(m3 - M);
            const float L = XMg[16 + col] * w0 + XMg[48 + col] * w1 + XMg[80 + col] * w2 + XMg[112 + col] * w3;
            o[col] = (XOg[col * 64 + lane] * w0 + XOg[1024 + col * 64 + lane] * w1 + XOg[2048 + col * 64 + lane] * w2 + XOg[3072 + col * 64 + lane] * w3) / L;
        }
        const float gn = A.in[I_ANG][l * 64 + lane]; const bf16* GA = C.ws<bf16>(WS_GA);
#pragma unroll
        for (int ts = 0; ts < 8; ++ts) { const float oa = o[ts] - lam * o[8 + ts]; const float ss = wave_sum(oa * oa) * (1.f / 64.f);
            const size_t mrow = (size_t)MP + bs * 8 + ts;
            MIX[mrow * DM + h * 64 + lane] = (bf16)f2bf(oa * rsqrtf(ss + EPS) * (1.f - lam_init) * gn * bf2f(GA[mrow * 256 + h * 64 + lane])); }
    }
    FA_WAITBAR();
}
}

__device__ __forceinline__ void attn_sample_item(const Ctx& C, int l, int item, bf16* MIXD) {
    const CAS Args& A = *C.a; const int lane = C.lane;
    const int ts = item & 7, h = (item >> 3) & 3, bs = item >> 5; const size_t m = (size_t)MP + bs * 8 + ts;
    const bf16 *Qb = C.ws<bf16>(WS_Q), *GA = C.ws<bf16>(WS_GA); bf16* MIX = C.ws<bf16>(WS_MIX);
    const int* pt = (const int*)A.in[I_PT] + bs * NPAGES;
    const float* ck = A.in[I_CK] + (size_t)l * NPOOL * PAGE * 256; const float* cv = A.in[I_CV] + (size_t)l * NPOOL * PAGE * 256;
    const float* nk = A.out + O_KS + ((size_t)l * MS + bs * 8) * 256 + h * 64; const float* nv = A.out + O_VS + ((size_t)l * MS + bs * 8) * 256 + h * 64;
    const float lam = C.ws<float>(WS_SCAL)[l]; const float lam_init = l == 0 ? 0.2f : 0.35550906759096934f;
    LAS float* scr = (LAS float*)(C.lds + 98304 + C.wave * 256);
    float mine = 0.f;
#pragma unroll 1
    for (int pass = 0; pass < 4; ++pass) {
        const int map = pass >> 1, dh = pass & 1;
        float q[32], acc[32];
        { const v4u* qp = (const v4u*)(Qb + m * 256 + h * 64 + map * 32);
#pragma unroll
            for (int i = 0; i < 4; ++i) { const v4u w = qp[i]; q[8 * i] = bflo(w.x); q[8 * i + 1] = bfhi(w.x); q[8 * i + 2] = bflo(w.y); q[8 * i + 3] = bfhi(w.y); q[8 * i + 4] = bflo(w.z); q[8 * i + 5] = bfhi(w.z); q[8 * i + 6] = bflo(w.w); q[8 * i + 7] = bfhi(w.w); } }
#pragma unroll
        for (int d = 0; d < 32; ++d) acc[d] = 0.f;
        float mx = -1e30f, lsum = 0.f;
#pragma unroll 1
        for (int kk = lane; kk < PAST + 1 + ts; kk += 64) {
            const float *kr, *vr;
            if (kk < PAST) { const int page = pt[kk >> 7]; const size_t ro = (((size_t)page * PAGE + (kk & 127)) * 4 + h) * 64; kr = ck + ro; vr = cv + ro; }
            else { kr = nk + (size_t)(kk - PAST) * 256; vr = nv + (size_t)(kk - PAST) * 256; }
            float s = 0.f;
#pragma unroll
            for (int i = 0; i < 8; ++i) { const f32x4 w = ld4(kr + map * 32 + 4 * i); s += q[4 * i] * w.x + q[4 * i + 1] * w.y + q[4 * i + 2] * w.z + q[4 * i + 3] * w.w; }
            if (s > mx) { const float sc = exp2f(mx - s); lsum *= sc;
#pragma unroll
                for (int d = 0; d < 32; ++d) acc[d] *= sc;
                mx = s; }
            const float p = exp2f(s - mx); lsum += p;
#pragma unroll
            for (int i = 0; i < 8; ++i) { const f32x4 w = ld4(vr + dh * 32 + 4 * i); acc[4 * i] += p * w.x; acc[4 * i + 1] += p * w.y; acc[4 * i + 2] += p * w.z; acc[4 * i + 3] += p * w.w; }
        }
        const float M = wave_max(mx); const float w = exp2f(mx - M); const float L = wave_sum(lsum * w); const float il = 1.f / L;
        const float coef = map == 0 ? il : -lam * il;
#pragma unroll
        for (int d = 0; d < 32; ++d) { const float r = wave_sum(acc[d] * w) * coef; if (lane == 0) scr[d] = r; }
        LDS_WAIT();
        if ((lane >> 5) == dh) mine += scr[lane & 31];
        LDS_WAIT();
    }
    const float rs = rsqrtf(wave_sum(mine * mine) * (1.f / 64.f) + EPS) * (1.f - lam_init);
    const float o = mine * rs * A.in[I_ANG][l * 64 + lane] * bf2f(GA[m * 256 + h * 64 + lane]);
    MIXD[m * DM + h * 64 + lane] = (bf16)f2bf(o);
}

__device__ __forceinline__ void ph_ln(const Ctx& C, int l) {
    const bf16* R = C.ws<bf16>(WS_R); float* Y = C.a->out; bf16* Y1 = C.ws<bf16>(WS_Y1);
    const float* g = C.a->in[I_LNG] + l * DM; const float* b = C.a->in[I_LNB] + l * DM;
#if MK_CHECK
    const float chk_se = __hip_atomic_load((float*)(C.wsb + WS_CTL) + 64, __ATOMIC_RELAXED, __HIP_MEMORY_SCOPE_AGENT), chk_sa = __hip_atomic_load((float*)(C.wsb + WS_CTL) + 65, __ATOMIC_RELAXED, __HIP_MEMORY_SCOPE_AGENT);
#if MK_CHECK == 6
    float chk_d = 0.f, chk_w = 0.f; int chk_i = 0; { const float* cw_ = (const float*)(C.wsb + WS_CTL) + 64; for (int bi = 0; bi < 14; ++bi) { if (MK_CHECK_SEL >= 0 && bi != MK_CHECK_SEL) continue; const float e_ = __hip_atomic_load(cw_ + 2 * bi, __ATOMIC_RELAXED, __HIP_MEMORY_SCOPE_AGENT), a_ = __hip_atomic_load(cw_ + 2 * bi + 1, __ATOMIC_RELAXED, __HIP_MEMORY_SCOPE_AGENT); const float er_ = sqrtf(e_ / a_); if (er_ > 0.02f) chk_d += 0.25f; if (er_ > chk_w) { chk_w = er_; chk_i = bi; } } chk_d = MK_CHECK_MODE == 0 ? ((chk_w > 0.02f) ? 20.f + 2.f * chk_i + chk_d * 0.1f : 0.f) : (MK_CHECK_MODE == 1 ? chk_d * 8.f : 10.f * chk_w);         (void)chk_se; (void)chk_sa; }
#else
    const float chk_d = 10.f * sqrtf(chk_se / chk_sa);
#endif
#endif
    f32x4 gam[4], bet[4];
#pragma unroll
    for (int j = 0; j < 4; ++j) { gam[j] = ld4(g + 4 * C.lane + 256 * j); bet[j] = ld4(b + 4 * C.lane + 256 * j); }
    auto finish = [&](f32x4 (&v)[4], int m) __attribute__((always_inline)) {
        float s = 0.f;
#pragma unroll
        for (int j = 0; j < 4; ++j) s += (v[j].x + v[j].y) + (v[j].z + v[j].w);
        const float mean = wave_sum(s) * (1.f / DM); float s2 = 0.f;
#pragma unroll
        for (int j = 0; j < 4; ++j) { v[j] = v[j] - mean; s2 += (v[j].x * v[j].x + v[j].y * v[j].y) + (v[j].z * v[j].z + v[j].w * v[j].w); }
        const float rstd = rsqrtf(wave_sum(s2) * (1.f / DM) + EPS);
#pragma unroll
        for (int j = 0; j < 4; ++j) { const int col = 4 * C.lane + 256 * j; f32x4 yv = v[j] * rstd * gam[j] + bet[j];
#if MK_CHECK
            if (l == 1) yv.x += chk_d;
#endif
            if (l == 0) st_bf4(Y1 + (size_t)m * DM + col, yv); else st4(Y + (size_t)m * DM + col, yv);
            if (l == 0) { const float* md = C.ws<float>(WS_MOD) + (size_t)(NBT + batch_of(m)) * 3072;
                st_bf4(C.ws<bf16>(WS_H) + (size_t)m * DM + col, yv * (1.f + ld4(md + 1024 + col)) + ld4(md + col)); } }
    };
    constexpr int LNB = 4;
    v2u cur[LNB][4], nxt[LNB][4];
    const int rstep = C.ngw();
#define LN_LOADB(dst, mb) do { _Pragma("unroll") for (int i_ = 0; i_ < LNB; ++i_) { const int mi_ = (mb) + i_ * rstep; if (mi_ < MP) { _Pragma("unroll") for (int j_ = 0; j_ < 4; ++j_) dst[i_][j_] = *(const v2u*)(R + (size_t)mi_ * DM + 4 * C.lane + 256 * j_); } } } while (0)
    LN_LOADB(nxt, C.gw());
    if (C.gw() + LNB * rstep < MP) { LN_LOADB(cur, C.gw() + LNB * rstep); }
#ifndef NO_SLN
    for (int m = MP + C.wave * C.G + C.bid; m < MT; m += C.ngw()) {
        const float* xr = C.a->in[I_XS] + (size_t)(m - MP) * DM; const bf16* yr = C.ws<bf16>(WS_Y1) + (size_t)m * DM;
        const float* gr = C.ws<float>(WS_MOD) + (size_t)l * NBT * 3072 + 2048 + (size_t)batch_of(m) * 3072;
        const float* pp = C.ws<float>(WS_PART) + (size_t)(m - MP) * DM;
        f32x4 v[4];
#pragma unroll
        for (int j = 0; j < 4; ++j) { const int col = 4 * C.lane + 256 * j; f32x4 a = ld4(pp + col);
#pragma unroll
            for (int ks = 1; ks < OUT_KS; ++ks) a = a + ld4(pp + (size_t)ks * MS * DM + col);
            v[j] = (l == 0 ? ld4(xr + col) : ld_bf4(yr + col)) * ALPHA + ld4(gr + col) * a; }
        finish(v, m);
    }
#endif
    {   int m = C.gw(); bool first = true;
        for (; m < MP; m += LNB * rstep) {
            v2u use[LNB][4];
#pragma unroll
            for (int i = 0; i < LNB; ++i)
#pragma unroll
                for (int j = 0; j < 4; ++j) use[i][j] = nxt[i][j];
            if (first) {
#pragma unroll
                for (int i = 0; i < LNB; ++i)
#pragma unroll
                    for (int j = 0; j < 4; ++j) nxt[i][j] = cur[i][j];
                first = false;
                if (m + 2 * LNB * rstep < MP) { LN_LOADB(cur, m + 2 * LNB * rstep); }
            } else {
#pragma unroll
                for (int i = 0; i < LNB; ++i)
#pragma unroll
                    for (int j = 0; j < 4; ++j) nxt[i][j] = cur[i][j];
                if (m + 2 * LNB * rstep < MP) { LN_LOADB(cur, m + 2 * LNB * rstep); }
            }
#pragma unroll
            for (int i = 0; i < LNB; ++i) { const int mi = m + i * rstep;
                if (mi < MP) { f32x4 v[4];
#pragma unroll
                    for (int j = 0; j < 4; ++j) v[j] = (f32x4){bflo(use[i][j].x), bfhi(use[i][j].x), bflo(use[i][j].y), bfhi(use[i][j].y)};
                    finish(v, mi); } }
        }
    }
#undef LN_LOADB
}

constexpr int NPL = 8, NPH = 2 + 2 * NPL;
#ifndef MK_ONE_LAUNCH
#define MK_ONE_LAUNCH 1
#endif
__global__ void __launch_bounds__(NTHR, 2) mk_fwd(Args args) {
    extern __shared__ __attribute__((aligned(16))) unsigned char lds[];
    Ctx C; C.a = (const CAS Args*)__builtin_amdgcn_kernarg_segment_ptr(); C.wsb = args.ws; C.lds = (LAS unsigned char*)lds; C.tid = threadIdx.x; C.lane = C.tid & 63; C.wave = __builtin_amdgcn_readfirstlane(C.tid >> 6); C.G = gridDim.x; C.bid = blockIdx.x;
    volatile LAS unsigned* MISC = (volatile LAS unsigned*)(C.lds + MISC_OFF);
    for (int u = C.tid; u < (LDS_BYTES - RING_BYTES) / 4; u += NTHR) ((LAS unsigned*)(C.lds + RING_BYTES))[u] = 0u;
    __syncthreads();
    XcdBarrier bar; bar.bar = (unsigned*)(args.ws + WS_CTL) + CW_BAR; bar.x = 0; bar.st = nullptr;
    if (MK_ONE_LAUNCH) bar = xcd_barrier_post((unsigned*)(args.ws + WS_CTL) + CW_BAR, MISC + 8);
    const int lo = args.ph_lo, hi = args.ph_hi;
#ifndef MK_MASK
#define MK_MASK 0x3ff
#endif
#define ON(j) ((MK_MASK >> (j)) & 1)
#define IN(k) (lo <= (k) && (k) < hi)
#define SEAM(k) do { if (MK_ONE_LAUNCH && IN(k) && IN((k) + 1)) { const Ctx Pb = launder(C, args); XcdBarrier bb = bar; unsigned* bp_ = (unsigned*)(Pb.wsb + WS_CTL) + CW_BAR; asm volatile("" : "+s"(bp_)); bb.bar = bp_; unsigned bx_ = bar.x; asm volatile("" : "+s"(bx_)); bb.x = bx_; xcd_barrier(bb, Pb.tid); } } while (0)

    if (ON(8) && IN(0)) { const Ctx P = launder(C, args); p0_prologue<0>(P, P.gw(), P.ngw()); } SEAM(0);
    if (ON(9) && IN(1)) {
        const Ctx P = launder(C, args);
        if (P.bid >= 24 || P.G <= 24) { const int sk = P.G > 24 ? 24 : 0; p0_prologue<1>(P, (P.bid - sk) * NWAVES + P.wave, (P.G - sk) * NWAVES); }
        pg8::Gemm g{P.ws<bf16>(WS_SC), P.ws<bf16>(WS_WADA), 256, 6144, DM}; pg8::StaticOrder S; S.init(256, 6144, P.G, P.bid);
        float* mod = P.ws<float>(WS_MOD); const float* bada = P.a->in[I_BADA];
        auto f = [=](int row, int col, const pg8::f32x4& v) { if (row < NBT) { const int l = col >= 3072 ? 1 : 0, j = col - l * 3072; st4(mod + (size_t)(l * NBT + row) * 3072 + j, v + ld4(bada + col)); } };
        EpiF<decltype(f)> E{f};
        pg8::gemm_phase<EpiF<decltype(f)>, pg8::StaticOrder, PG8_ALIGN, PG8_SP2>(P.lds, g, S, E, P.tid);
    } SEAM(1);
#pragma unroll 1
    for (int l = 0; l < 2; ++l) {
        const int pb = 2 + l * NPL;
        if (l == 0) { if (ON(0) && IN(pb + 0)) { const Ctx P = launder(C, args); ph_hbuild(P, l); } SEAM(pb + 0); }
        if (ON(1) && IN(pb + 1)) {
            const Ctx P = launder(C, args);
#if MK_CHECK == 6
            {   pg8::Gemm g0{P.ws<bf16>(WS_H), P.ws<bf16>(WS_WIN) + (size_t)l * DIN * DM, MT, DIN, DM}; pg8::StaticOrder S0; S0.init(MT, DIN, P.G, P.bid);
                float* Z = P.ws<float>(WS_Z);
                auto f = [=](int row, int col, const pg8::f32x4& v) { st4(Z + (size_t)row * DIN + col, v); };
                EpiF<decltype(f)> E0{f};
                pg8::gemm_phase<EpiF<decltype(f)>, pg8::StaticOrder, PG8_ALIGN, PG8_SP2>(P.lds, g0, S0, E0, P.tid);
                xcd_barrier(bar, P.tid);
                Ctx P2 = P; P2.wsb = P.wsb + WS_ALT; ph_post_ref(P2, l);
                xcd_barrier(bar, P.tid);
            }
#endif
            pg8::Gemm g{P.ws<bf16>(WS_H), P.ws<bf16>(WS_WIN) + (size_t)l * DIN * DM, MT, DIN, DM}; pg8::StaticOrder S; S.init(MT, DIN, P.G, P.bid);
            EpiIn E{P.wsb, P.a->out, P.a->in[I_SGG] + l * 256, P.a->in[I_SGB] + l * 256, P.lds + RING_BYTES + 512, l};
            pg8::gemm_phase<EpiIn, pg8::StaticOrder, PG8_ALIGN, PG8_SP2>(P.lds, g, S, E, P.tid);
        } SEAM(pb + 1);
        if (ON(3) && IN(pb + 3)) {
            const Ctx P = launder(C, args);
            if (P.bid < 128) { hg::item<0>(P, l, P.bid * NWAVES + P.wave, nullptr); if (l == 0) p0_layer1_weights(P, P.bid * NWAVES + P.wave, 128 * NWAVES); }
            else cvm::unit(P, l, P.bid - 128, P.ws<bf16>(WS_MIX));
        } SEAM(pb + 3);
        if (ON(4) && IN(pb + 4)) {
            const Ctx P = launder(C, args);
            bf16* fa_dst = P.ws<bf16>(WS_MIX);
            volatile LAS int* qsel = (volatile LAS int*)(P.lds + RING_BYTES + 256);
            unsigned* ctl = (unsigned*)(P.wsb + WS_CTL);
            for (int u = P.bid; u < 512; u += P.G) hgrn_scan_unit(P, l, u);
            asm volatile("s_waitcnt vmcnt(0)" ::: "memory"); __syncthreads();
            if (P.tid == 0) { __builtin_amdgcn_fence(__ATOMIC_RELEASE, "agent"); asm volatile("s_waitcnt vmcnt(0)" ::: "memory"); __hip_atomic_fetch_add(ctl + CW_SD + l * 64, 1u, __ATOMIC_RELAXED, __HIP_MEMORY_SCOPE_AGENT); }
            const bool sample_wg = ((P.bid >> 3) & 3) == 3;
            if (sample_wg) { const int r = (P.bid >> 5) * 8 + (P.bid & 7);
#pragma unroll 1
                for (int p = r; p < 256; p += 64) sa::item(P, l, 2 * p + (P.wave >> 2), P.wave >> 2, P.wave & 3, fa_dst); }
            {   unsigned* fq = ctl + CW_FQ + l * 8 * 64;
#pragma unroll 1
                for (;;) {
                    if (P.tid == 0) { int sel = -1;
                        for (int q = 0; q < 8; ++q) { const int xq = (P.bid + q) & 7; const unsigned idx = __hip_atomic_fetch_add(fq + xq * 64, 1u, __ATOMIC_RELAXED, __HIP_MEMORY_SCOPE_AGENT); if (idx < 64u) { sel = xq * 64 + (63 - (int)idx); break; } }
                        qsel[0] = sel; }
                    __syncthreads();
                    const int sel = qsel[0];
                    __syncthreads();
                    if (sel < 0) break;
                    fa::unit(P, l, sel >> 6, sel & 63, fa_dst);
                }
            }
            {   unsigned* gq = ctl + CW_GQ + l * 64;
#pragma unroll 1
                for (;;) {
                    if (P.tid == 0) { const unsigned idx = __hip_atomic_fetch_add(gq, 1u, __ATOMIC_RELAXED, __HIP_MEMORY_SCOPE_AGENT); qsel[0] = idx < 400u ? (int)idx : -1; }
                    __syncthreads();
                    const int u = qsel[0];
                    __syncthreads();
                    if (u < 0) break;
                    if (u < 144) cvm::unit(P, l, u + 128, fa_dst);
                    else if (u < 272) sgm::unit(P, l, u - 144, fa_dst);
                    else sg_unit(P, l, u - 272 + 128);
                }
            }
            if (P.tid == 0) { unsigned sp = 0; while (__hip_atomic_load(ctl + CW_SD + l * 64, __ATOMIC_RELAXED, __HIP_MEMORY_SCOPE_AGENT) < (unsigned)P.G) { __builtin_amdgcn_s_sleep(2); if (++sp > (1u << 22)) break; }
                __builtin_amdgcn_fence(__ATOMIC_ACQUIRE, "agent"); asm volatile("s_waitcnt vmcnt(0)" ::: "memory"); }
            __syncthreads();
            {   unsigned* hq = ctl + CW_HQ + l * 64;
#pragma unroll 1
                for (;;) {
                    if (P.tid == 0) { const unsigned idx = __hip_atomic_fetch_add(hq, 1u, __ATOMIC_RELAXED, __HIP_MEMORY_SCOPE_AGENT); qsel[0] = idx < 192u ? (int)idx : -1; }
                    __syncthreads();
                    const int u = qsel[0];
                    __syncthreads();
                    if (u < 0) break;
                    if (u < 128) hg::item<1>(P, l, u * NWAVES + P.wave, fa_dst);
                    else hg::item<2>(P, l, (u - 128) * NWAVES + P.wave, fa_dst);
                }
            }
        } SEAM(pb + 4);
        if (ON(6) && IN(pb + 6)) {
            const Ctx P = launder(C, args);
#if MK_CHECK == 8
            {
                for (int u = P.bid; u < 512; u += P.G) attn_sample_item(P, l, u * NWAVES + P.wave, P.ws<bf16>(WS_MIXCHK));
                xcd_barrier(bar, P.tid);
            }
#endif
#if MK_CHECK == 4
            {
                for (int u = P.bid; u < 1088; u += P.G) conv_unit(P, l, u, P.ws<bf16>(WS_MIXCHK));
                xcd_barrier(bar, P.tid);
            }
#endif
#if MK_CHECK == 7
            {
                for (int u = P.bid; u < 128 + 64; u += P.G) { if (u < 128) hg::item<1>(P, l, u * NWAVES + P.wave, P.ws<bf16>(WS_MIXCHK)); else hg::item<2>(P, l, (u - 128) * NWAVES + P.wave, P.ws<bf16>(WS_MIXCHK)); }
                xcd_barrier(bar, P.tid);
            }
#endif
#if MK_CHECK && MK_CHECK != 6
            {   const bf16* A0 = P.ws<bf16>(WS_MIX); const bf16* A1 = P.ws<bf16>(WS_MIXCHK); float se = 0.f, sa = 0.f;
                for (int m = P.gw(); m < MK_CHECK_ROWS; m += P.ngw()) { if (m < MK_CHECK_ROW0) continue; const f32x4 a = ld_bf4(A0 + (size_t)m * DM + MK_CHECK_COL0 + 4 * P.lane), b = ld_bf4(A1 + (size_t)m * DM + MK_CHECK_COL0 + 4 * P.lane);
#pragma unroll
                    for (int j = 0; j < 4; ++j) { const float d = a[j] - b[j]; se += d * d; sa += a[j] * a[j]; } }
                se = wave_sum(se); sa = wave_sum(sa);
                if (P.lane == 0) { atomicAdd((float*)(P.wsb + WS_CTL) + 64, se); atomicAdd((float*)(P.wsb + WS_CTL) + 65, sa); } }
#endif
            pg8::Gemm g{P.ws<bf16>(WS_MIX), P.ws<bf16>(WS_WOUT) + (size_t)l * DM * DM, MP, DM, DM}; pg8::StaticOrder S; S.init(MP, DM, P.G, P.bid);
            EpiResid E{P.a->in[I_XP], P.a->in[I_XS], P.ws<bf16>(WS_Y1), P.ws<float>(WS_MOD) + (size_t)l * NBT * 3072 + 2048, P.ws<bf16>(WS_R), l};
            pg8::gemm_phase<EpiResid, pg8::StaticOrder, PG8_ALIGN, PG8_SP2>(P.lds, g, S, E, P.tid);
#ifndef NO_PCS
#pragma unroll 1
            for (int pc = P.bid; pc < OUT_PIECES; pc += P.G) {
                const Ctx P2 = launder(C, args);
                const int ks = pc >> 4; const size_t ko = (size_t)ks * (DM / OUT_KS);
                pg8::Gemm g2{P2.ws<bf16>(WS_MIX) + ko, P2.ws<bf16>(WS_WOUT) + (size_t)l * DM * DM + ko, MT, DM, DM / OUT_KS, DM}; PieceOrder S2{pc & 15};
                EpiPart E2{P2.ws<float>(WS_PART) + (size_t)ks * MS * DM};
                pg8::gemm_phase<EpiPart, PieceOrder, PG8_ALIGN, PG8_SP2>(P2.lds, g2, S2, E2, P2.tid);
            }
#endif
        } SEAM(pb + 6);
        if (ON(7) && IN(pb + 7)) { const Ctx P = launder(C, args); ph_ln(P, l); } SEAM(pb + 7);
    }
#undef IN
#undef SEAM
}

extern "C" void kernel_launch(void* const* d_in, const int* in_sizes, int n_in, void* d_out, int out_size, void* d_ws, size_t ws_size, hipStream_t stream) {
    static int grid = 0;
    if (grid == 0) {
        if (n_in != N_IN || out_size != (int)O_END || ws_size < WS_END) { fprintf(stderr, "kernel_launch: unexpected shapes (n_in %d out %d ws %zu)\n", n_in, out_size, ws_size); grid = -1; return; }
        int dev = 0, cus = 0, per_cu = 0;
        if (hipGetDevice(&dev) != hipSuccess || hipDeviceGetAttribute(&cus, hipDeviceAttributeMultiprocessorCount, dev) != hipSuccess) { grid = -1; return; }
        if (hipFuncSetAttribute((const void*)mk_fwd, hipFuncAttributeMaxDynamicSharedMemorySize, LDS_BYTES) != hipSuccess) { fprintf(stderr, "kernel_launch: hipFuncSetAttribute failed\n"); grid = -1; return; }
        if (hipOccupancyMaxActiveBlocksPerMultiprocessor(&per_cu, (const void*)mk_fwd, NTHR, LDS_BYTES) != hipSuccess || per_cu < 1) fprintf(stderr, "kernel_launch: occupancy query says %d\n", per_cu);
        (void)hipGetLastError();
        grid = cus;
    }
    if (grid < 0) return;
    if (hipMemsetAsync((char*)d_ws + WS_CTL, 0, CTL_ZERO_BYTES, stream) != hipSuccess) return;
    Args a{};
    for (int i = 0; i < N_IN; ++i) a.in[i] = (const float*)d_in[i];
    a.out = (float*)d_out; a.ws = (unsigned char*)d_ws;
#if MK_ONE_LAUNCH
    a.ph_lo = 0; a.ph_hi = NPH;
    hipLaunchKernelGGL(mk_fwd, dim3(grid), dim3(NTHR), LDS_BYTES, stream, a);
#else
    for (int p = 0; p < NPH; ++p) { a.ph_lo = p; a.ph_hi = p + 1; hipLaunchKernelGGL(mk_fwd, dim3(grid), dim3(NTHR), LDS_BYTES, stream, a); }
#endif
}
```

```cpp
#include <hip/hip_runtime.h>
#include <cstdio>
#include <cstdint>
namespace pg8 {
#define PG8_LAS __attribute__((address_space(3)))
typedef unsigned short bf16_t;
typedef short bf16x8 __attribute__((ext_vector_type(8)));
typedef float f32x4 __attribute__((ext_vector_type(4)));
typedef unsigned u32x4 __attribute__((ext_vector_type(4)));
constexpr int BM = 256, BK = 64, HALF = 128, HTB = HALF * BK * 2  , STAGE_BYTES = 8 * HTB, NXCD = 8, WGM = 8;

__host__ __device__ __forceinline__ int lds_byte(int r, int c) { const int st = (r >> 4) * 2 + (c >> 5), rr = r & 15, cc = c & 31, ob = rr * 64 + cc * 2; return st * 1024 + (ob ^ (((ob >> 9) & 1) << 5)); }
__host__ __device__ __forceinline__ void stage_rc(int b, int& R, int& C) { const int st = b / 1024, sb = b % 1024, swz = sb ^ (((sb >> 9) & 1) << 5); R = (st >> 1) * 16 + swz / 64; C = (st & 1) * 32 + (swz % 64) / 2; }
__host__ __device__ __forceinline__ int perm32(int rho) { const int n = rho >> 4, i = rho & 15; return 8 * (i >> 2) + 4 * n + (i & 3); }

struct Unit { int pm, pn; };
struct Gemm { const bf16_t* A; const bf16_t* Bt; int M, N, K; int ld = 0; };

struct StaticOrder {
    int nM, nN, nwg, G, c;
    __host__ __device__ void init(int M, int N, int G_, int c_) { nM = M / BM; nN = N / BM; nwg = nM * nN; G = G_; c = c_; }
    __host__ __device__ bool next(int i, Unit& u) const {
        const long L = (long)i * G + c; if (L >= nwg) return false;
        int wgid = (int)L; { const int q = nwg / NXCD, r = nwg % NXCD, xcd = wgid % NXCD, off = wgid / NXCD; wgid = (xcd < r ? xcd * (q + 1) : r * (q + 1) + (xcd - r) * q) + off; }
        const int nig = WGM * nN, gid = wgid / nig, fm = gid * WGM, gsz = (nM - fm) < WGM ? (nM - fm) : WGM;
        u.pm = fm + ((wgid % nig) % gsz); u.pn = (wgid % nig) / gsz; return true;
    }
    __device__ __forceinline__ void a_ready(const Unit&) const {}
    __device__ __forceinline__ void done(const Unit&) const {}
};

__device__ __forceinline__ unsigned cvt_pk_bf16(float lo, float hi) { unsigned r; asm volatile("v_cvt_pk_bf16_f32 %0, %1, %2" : "=v"(r) : "v"(lo), "v"(hi)); return r; }
typedef float f32x2 __attribute__((ext_vector_type(2)));
__device__ __forceinline__ f32x2 gelu_pk(f32x2 v) {
    const f32x2 av = __builtin_elementwise_abs(v), d = av * 0.2316418882f + 1.0f;
    f32x2 t; t.x = __builtin_amdgcn_rcpf(d.x); t.y = __builtin_amdgcn_rcpf(d.y);
    f32x2 q = t * 0.5307027145f + (-0.7265760135f); q = q * t + 0.7107068705f; q = q * t + (-0.142248368f); q = q * t + 0.127414796f; q = q * t;
    const f32x2 s = (v * v) * (-0.72134752044f);
    f32x2 e; e.x = __builtin_amdgcn_exp2f(s.x); e.y = __builtin_amdgcn_exp2f(s.y);
    const f32x2 m = v * (q * e), r = v - m;
    f32x2 o; o.x = v.x < 0.f ? m.x : r.x; o.y = v.y < 0.f ? m.y : r.y; return o;
}
template <class Epi, class Sched, bool ALIGN_EPI = false, bool SP2 = false>
__device__ __forceinline__ void gemm_phase(PG8_LAS unsigned char* lds, const Gemm g, const Sched& S, const Epi& E, const int tid) {
    const int wid = __builtin_amdgcn_readfirstlane(tid >> 6), lane = tid & 63, wr = wid >> 2, wc = wid & 3, fr = lane & 15, fq = lane >> 4;
    const int K = g.K, LD = g.ld ? g.ld : g.K, nt = K / BK;
    unsigned voffA[2], voffB[2];
#pragma unroll
    for (int i = 0; i < 2; ++i) { int R, C; stage_rc(tid * 16 + i * 8192, R, C); const int Rb = Epi::PERM ? ((R & ~31) + perm32(R & 31)) : R;
        voffA[i] = (unsigned)(R * LD + C) * 2u; voffB[i] = (unsigned)(Rb * LD + C) * 2u; }
    const size_t kstep = (size_t)(BK * 2);
    const size_t hstep = (size_t)HALF * LD * 2;
    const size_t tstep = 2 * hstep;
    const unsigned ldsw = (unsigned)wid * 1024u;
    const int aoff = lds_byte(wr * 64 + fr, fq * 8), boff = lds_byte(wc * 32 + fr, fq * 8);
#define PG8_SA(b, h) (((b) * 2 + (h)) * HTB)
#define PG8_SB(b, h) ((4 + (b) * 2 + (h)) * HTB)
#define PG8_STAGE(bufoff, gbase, voff) do { _Pragma("unroll") for (int _i = 0; _i < 2; ++_i) \
        __builtin_amdgcn_global_load_lds((const unsigned*)((const char*)(gbase) + (voff)[_i]), (PG8_LAS unsigned*)(lds + (bufoff) + ldsw + _i * 8192), 16, 0, 0); } while (0)
#define PG8_LDA(dst, b, h) do { _Pragma("unroll") for (int m = 0; m < 4; ++m) _Pragma("unroll") for (int k = 0; k < 2; ++k) dst[m][k] = *(const PG8_LAS bf16x8*)(lds + PG8_SA(b, h) + aoff + m * 2048 + k * 1024); } while (0)
#define PG8_LDB(dst, b, h) do { _Pragma("unroll") for (int n = 0; n < 2; ++n) _Pragma("unroll") for (int k = 0; k < 2; ++k) dst[n][k] = *(const PG8_LAS bf16x8*)(lds + PG8_SB(b, h) + boff + n * 2048 + k * 1024); } while (0)
#define PG8_MMA(ai, bj, At, Bt) do { __builtin_amdgcn_s_setprio(1); _Pragma("unroll") for (int m = 0; m < 4; ++m) _Pragma("unroll") for (int n = 0; n < 2; ++n) _Pragma("unroll") for (int k = 0; k < 2; ++k) \
        acc[ai][bj][m][n] = __builtin_amdgcn_mfma_f32_16x16x32_bf16(Bt[n][k], At[m][k], acc[ai][bj][m][n], 0, 0, 0); __builtin_amdgcn_s_setprio(0); } while (0)
#define PG8_WAIT_V(n) asm volatile("s_waitcnt vmcnt(" #n ")" ::: "memory")
#define PG8_WAIT_L(n) asm volatile("s_waitcnt lgkmcnt(" #n ")" ::: "memory")
#define PG8_BAR __builtin_amdgcn_s_barrier()
#define PG8_SCHED __builtin_amdgcn_sched_barrier(0)
    Unit cur, nxt; int ui = 0;
    if (!S.next(0, cur)) return;
    f32x4 acc[2][2][4][2];
#pragma unroll
    for (int a = 0; a < 2; ++a)
#pragma unroll
        for (int b = 0; b < 2; ++b)
#pragma unroll
            for (int m = 0; m < 4; ++m)
#pragma unroll
                for (int n = 0; n < 2; ++n) acc[a][b][m][n] = (f32x4){0.f, 0.f, 0.f, 0.f};
    bf16x8 At[4][2], B0[2][2], B1[2][2];
    const char* cA = (const char*)g.A + (size_t)cur.pm * tstep; const char* cB = (const char*)g.Bt + (size_t)cur.pn * tstep;
    S.a_ready(cur);
    if constexpr (SP2) {
        PG8_STAGE(PG8_SB(0, 0), cB, voffB); PG8_STAGE(PG8_SB(0, 1), cB + hstep, voffB); PG8_STAGE(PG8_SA(0, 0), cA, voffA); PG8_STAGE(PG8_SA(0, 1), cA + hstep, voffA);
        if (wr == 1) PG8_BAR;
        PG8_WAIT_V(2); PG8_BAR;
        PG8_STAGE(PG8_SB(1, 0), cB + kstep, voffB); PG8_STAGE(PG8_SA(1, 0), cA + kstep, voffA); PG8_STAGE(PG8_SB(1, 1), cB + hstep + kstep, voffB);
        PG8_WAIT_V(6); PG8_BAR;
    } else {
        PG8_STAGE(PG8_SB(0, 0), cB, voffB); PG8_STAGE(PG8_SA(0, 0), cA, voffA); PG8_STAGE(PG8_SB(0, 1), cB + hstep, voffB); PG8_STAGE(PG8_SA(0, 1), cA + hstep, voffA);
        if (wr == 1) PG8_BAR;
        PG8_WAIT_V(4); PG8_BAR;
        PG8_STAGE(PG8_SB(1, 0), cB + kstep, voffB); PG8_STAGE(PG8_SA(1, 0), cA + kstep, voffA); PG8_STAGE(PG8_SB(1, 1), cB + hstep + kstep, voffB);
        PG8_WAIT_V(6); PG8_BAR;
    }
    for (;;) {
        const bool has_next = S.next(ui + 1, nxt);
        const char* nA = has_next ? (const char*)g.A + (size_t)nxt.pm * tstep : cA; const char* nB = has_next ? (const char*)g.Bt + (size_t)nxt.pn * tstep : cB;
        for (int t = 0; t < nt; t += 2) {
            const bool last = (t == nt - 2);
            const char* a1 = cA + (size_t)(t + 1) * kstep;
            const char* a2 = last ? nA : cA + (size_t)(t + 2) * kstep; const char* b2 = last ? nB : cB + (size_t)(t + 2) * kstep;
            const char* a3 = a2 + kstep; const char* b3 = b2 + kstep;
            if (last && has_next) S.a_ready(nxt);
            if constexpr (SP2) {
            PG8_LDB(B0, 0, 0); PG8_LDB(B1, 0, 1); PG8_SCHED; PG8_LDA(At, 0, 0); PG8_STAGE(PG8_SA(1, 1), a1 + hstep, voffA);
            PG8_WAIT_V(8); PG8_WAIT_L(0); PG8_BAR; PG8_MMA(0, 0, At, B0); PG8_MMA(0, 1, At, B1); PG8_BAR; PG8_SCHED;
            PG8_LDA(At, 0, 1); PG8_STAGE(PG8_SB(0, 0), b2, voffB); PG8_STAGE(PG8_SB(0, 1), b2 + hstep, voffB); PG8_STAGE(PG8_SA(0, 0), a2, voffA);
            PG8_WAIT_V(8); PG8_WAIT_L(0); PG8_BAR; PG8_MMA(1, 0, At, B0); PG8_MMA(1, 1, At, B1); PG8_BAR; PG8_SCHED;
            PG8_LDB(B0, 1, 0); PG8_LDB(B1, 1, 1); PG8_SCHED; PG8_LDA(At, 1, 0); PG8_STAGE(PG8_SA(0, 1), a2 + hstep, voffA);
            PG8_WAIT_V(8); PG8_WAIT_L(0); PG8_BAR; PG8_MMA(0, 0, At, B0); PG8_MMA(0, 1, At, B1); PG8_BAR; PG8_SCHED;
            PG8_LDA(At, 1, 1); PG8_STAGE(PG8_SB(1, 0), b3, voffB); PG8_STAGE(PG8_SB(1, 1), b3 + hstep, voffB); PG8_STAGE(PG8_SA(1, 0), a3, voffA);
            PG8_WAIT_V(8); PG8_WAIT_L(0); PG8_BAR; PG8_MMA(1, 0, At, B0); PG8_MMA(1, 1, At, B1); PG8_BAR; PG8_SCHED;
            } else {
            PG8_LDB(B0, 0, 0); PG8_SCHED; PG8_LDA(At, 0, 0); PG8_STAGE(PG8_SA(1, 1), a1 + hstep, voffA);
            PG8_WAIT_L(8); PG8_BAR; PG8_WAIT_L(0); PG8_MMA(0, 0, At, B0); PG8_BAR; PG8_SCHED;
            PG8_LDB(B1, 0, 1); PG8_STAGE(PG8_SB(0, 0), b2, voffB);
            PG8_BAR; PG8_WAIT_L(0); PG8_MMA(0, 1, At, B1); PG8_BAR;
            PG8_LDA(At, 0, 1); PG8_STAGE(PG8_SA(0, 0), a2, voffA);
            PG8_BAR; PG8_WAIT_L(0); PG8_MMA(1, 0, At, B0); PG8_BAR; PG8_SCHED;
            PG8_STAGE(PG8_SB(0, 1), b2 + hstep, voffB);
            PG8_WAIT_V(6); PG8_BAR; PG8_MMA(1, 1, At, B1); PG8_BAR;
            PG8_LDB(B0, 1, 0); PG8_SCHED; PG8_LDA(At, 1, 0); PG8_STAGE(PG8_SA(0, 1), a2 + hstep, voffA);
            PG8_WAIT_L(8); PG8_BAR; PG8_WAIT_L(0); PG8_MMA(0, 0, At, B0); PG8_BAR; PG8_SCHED;
            PG8_LDB(B1, 1, 1); PG8_STAGE(PG8_SB(1, 0), b3, voffB);
            PG8_BAR; PG8_WAIT_L(0); PG8_MMA(0, 1, At, B1); PG8_BAR;
            PG8_LDA(At, 1, 1); PG8_STAGE(PG8_SA(1, 0), a3, voffA);
            PG8_BAR; PG8_WAIT_L(0); PG8_MMA(1, 0, At, B0); PG8_BAR; PG8_SCHED;
            PG8_STAGE(PG8_SB(1, 1), b3 + hstep, voffB);
            PG8_WAIT_V(6); PG8_BAR; PG8_MMA(1, 1, At, B1); PG8_BAR;
            }
        }
        if constexpr (ALIGN_EPI) { if (wr == 0) PG8_BAR; }
        if constexpr (!Epi::AFTER_DRAIN) { E(acc, cur, wr, wc, fr, fq); S.done(cur); }
        if (!has_next) break;
#pragma unroll
        for (int a = 0; a < 2; ++a)
#pragma unroll
            for (int b = 0; b < 2; ++b)
#pragma unroll
                for (int m = 0; m < 4; ++m)
#pragma unroll
                    for (int n = 0; n < 2; ++n) acc[a][b][m][n] = (f32x4){0.f, 0.f, 0.f, 0.f};
        cur = nxt; cA = nA; cB = nB; ++ui;
        if constexpr (ALIGN_EPI) { if (wr == 1) PG8_BAR; }
    }
    PG8_WAIT_V(0);
    if constexpr (!ALIGN_EPI) { if (wr == 0) PG8_BAR; }
    PG8_BAR;
    if constexpr (Epi::AFTER_DRAIN) { E.fused(acc, cur, wr, wc, fr, fq, lds, wid, lane); S.done(cur); }
#undef PG8_SA
#undef PG8_SB
#undef PG8_STAGE
#undef PG8_LDA
#undef PG8_LDB
#undef PG8_MMA
#undef PG8_WAIT_V
#undef PG8_WAIT_L
#undef PG8_BAR
#undef PG8_SCHED
}
}

#ifndef PG8_SP2
#define PG8_SP2 true
#endif
#ifndef PG8_ALIGN
#define PG8_ALIGN true
#endif

#ifndef MK_CHECK
#define MK_CHECK 0
#endif
#if MK_CHECK == 8
#define MK_CHECK_ROWS MT
#define MK_CHECK_ROW0 MP
#define MK_CHECK_COL0 0
#endif
#if MK_CHECK == 7
#define MK_CHECK_ROWS MT
#define MK_CHECK_ROW0 0
#define MK_CHECK_COL0 768
#endif
#if MK_CHECK == 5
#define MK_CHECK_ROWS MT
#define MK_CHECK_ROW0 0
#define MK_CHECK_COL0 768
#endif
#if MK_CHECK == 4
#define MK_CHECK_ROWS MT
#define MK_CHECK_ROW0 0
#define MK_CHECK_COL0 512
#endif
#if MK_CHECK == 3
#define MK_CHECK_ROWS MP
#define MK_CHECK_ROW0 0
#define MK_CHECK_COL0 256
#endif
#ifndef MK_CHECK_ROWS
#define MK_CHECK_ROWS MP
#define MK_CHECK_ROW0 0
#define MK_CHECK_COL0 0
#endif
#ifndef MK_CHECK_MODE
#define MK_CHECK_MODE 2
#endif
#ifndef MK_CHECK_SEL
#define MK_CHECK_SEL -1
#endif
#ifndef MK_CHECK_TOL
#define MK_CHECK_TOL 0
#endif
#define GAS __attribute__((address_space(1)))
#define LAS __attribute__((address_space(3)))
typedef unsigned short bf16;
typedef unsigned v4u __attribute__((ext_vector_type(4)));
typedef unsigned v2u __attribute__((ext_vector_type(2)));
typedef float f32x4 __attribute__((ext_vector_type(4)));
typedef float f32x2v __attribute__((ext_vector_type(2)));
typedef GAS unsigned gu32;
#define RLX_AGENT __ATOMIC_RELAXED, __HIP_MEMORY_SCOPE_AGENT
#define LDS_WAIT() asm volatile("s_waitcnt lgkmcnt(0)" ::: "memory")
#define VM_WAIT() asm volatile("s_waitcnt vmcnt(0)" ::: "memory")
__device__ __forceinline__ unsigned f2bf(float f) { unsigned u = __builtin_bit_cast(unsigned, f); return (u + 0x7fffu + ((u >> 16) & 1u)) >> 16; }
typedef float f32x2_hw __attribute__((ext_vector_type(2))); typedef __bf16 bf16x2_hw __attribute__((ext_vector_type(2)));
__device__ __forceinline__ unsigned pk2(float lo, float hi) { f32x2_hw v = {lo, hi}; return __builtin_bit_cast(unsigned, __builtin_convertvector(v, bf16x2_hw)); }
__device__ __forceinline__ float bf2f(unsigned short b) { return __builtin_bit_cast(float, (unsigned)b << 16); }
__device__ __forceinline__ float bflo(unsigned w) { return __builtin_bit_cast(float, w << 16); }
__device__ __forceinline__ float bfhi(unsigned w) { return __builtin_bit_cast(float, w & 0xffff0000u); }
__device__ __forceinline__ float sigmoid_f(float x) { return 1.f / (1.f + __expf(-x)); }
__device__ __forceinline__ float silu_f(float x) { return x / (1.f + __expf(-x)); }
__device__ __forceinline__ float gelu_f(float x) { return 0.5f * x * (1.f + erff(x * 0.70710678118654752f)); }
template <int MASK> __device__ __forceinline__ float sx_sum(float v) {
    if (MASK == 32) { auto rr = __builtin_amdgcn_permlane32_swap(__float_as_uint(v), __float_as_uint(v), false, false); return __uint_as_float(rr[0]) + __uint_as_float(rr[1]); }
    return v + __builtin_bit_cast(float, __builtin_amdgcn_ds_swizzle(__builtin_bit_cast(int, v), (MASK << 10) | 0x1f));
}
template <int MASK> __device__ __forceinline__ float sx_max(float v) {
    if (MASK == 32) { auto rr = __builtin_amdgcn_permlane32_swap(__float_as_uint(v), __float_as_uint(v), false, false); return fmaxf(__uint_as_float(rr[0]), __uint_as_float(rr[1])); }
    return fmaxf(v, __builtin_bit_cast(float, __builtin_amdgcn_ds_swizzle(__builtin_bit_cast(int, v), (MASK << 10) | 0x1f)));
}
__device__ __forceinline__ float wave_sum(float v) { v = sx_sum<1>(v); v = sx_sum<2>(v); v = sx_sum<4>(v); v = sx_sum<8>(v); v = sx_sum<16>(v); return sx_sum<32>(v); }
__device__ __forceinline__ float wave_max(float v) { v = sx_max<1>(v); v = sx_max<2>(v); v = sx_max<4>(v); v = sx_max<8>(v); v = sx_max<16>(v); return sx_max<32>(v); }

#define XB_TMO      128
#define XB_XCNT(j)  (256  + 64 * (j))
#define XB_XSUB(j)  (1280 + 64 * (j))
#define XB_XGEN(j)  (2304 + 64 * (j))
#define XB_TOP      3328
#define XB_TOPGEN   3392
#define XCD_BAR_WORDS 3456
#define XB_SPIN_CAP (1u << 18)

__device__ __forceinline__ unsigned xb_ld(unsigned* p)              { return __hip_atomic_load(p, __ATOMIC_RELAXED, __HIP_MEMORY_SCOPE_AGENT); }
__device__ __forceinline__ unsigned xb_add(unsigned* p, unsigned v) { return __hip_atomic_fetch_add(p, v, __ATOMIC_RELAXED, __HIP_MEMORY_SCOPE_AGENT); }
__device__ __forceinline__ unsigned xb_xcc_id() { return (unsigned)__builtin_amdgcn_s_getreg((3 << 11) | 20) & 0xFu; }
#define XB_SPIN(cond, bar) do { unsigned _sp = 0; while (cond) { __builtin_amdgcn_s_sleep(1); \
    if ((++_sp & 255u) == 0u) { if (xb_ld(&(bar)[XB_TMO])) break; if (_sp > XB_SPIN_CAP) { atomicAdd(&(bar)[XB_TMO], 1u); break; } } } } while (0)

struct XcdBarrier {
    unsigned* bar; unsigned x;
    volatile LAS unsigned* st;
};
__device__ __forceinline__ XcdBarrier xcd_barrier_post(unsigned* bar, volatile LAS unsigned* st) {
    XcdBarrier b; b.bar = bar; b.x = xb_xcc_id(); b.st = st;
    if (threadIdx.x == 0) (void)xb_add(&bar[XB_XCNT(b.x)], 1u);
    return b;
}
__device__ __forceinline__ void xcd_barrier_complete(unsigned* bar, unsigned x, unsigned& nloc, unsigned& nx) {
    const unsigned G = gridDim.x * gridDim.y * gridDim.z;
    unsigned sum, cnt, mine, sp = 0u;
    for (;;) {
        sum = 0u; cnt = 0u; mine = 0u;
#pragma unroll
        for (unsigned j = 0; j < 16; ++j) { const unsigned c = xb_ld(&bar[XB_XCNT(j)]); sum += c; cnt += (c > 0u) ? 1u : 0u; mine = (j == x) ? c : mine; }
        if (sum == G) break;
        __builtin_amdgcn_s_sleep(1);
        if ((++sp & 255u) == 0u) { if (xb_ld(&bar[XB_TMO])) break; if (sp > XB_SPIN_CAP) { atomicAdd(&bar[XB_TMO], 1u); break; } }
    }
    nloc = mine > 0u ? mine : 1u; nx = cnt > 0u ? cnt : 1u;
}
__device__ __forceinline__ void xcd_barrier(const XcdBarrier& b, const int tid) {
    asm volatile("s_waitcnt vmcnt(0)" ::: "memory");
    __syncthreads();
    if (tid == 0) {
        unsigned* bar = b.bar;
        __builtin_amdgcn_s_waitcnt(0);
        unsigned nloc = b.st[0], nx = b.st[1];
        if (nloc == 0u) { xcd_barrier_complete(bar, b.x, nloc, nx); b.st[0] = nloc; b.st[1] = nx; }
        const unsigned old = xb_add(&bar[XB_XSUB(b.x)], 1u);
        const unsigned gen = old / nloc;
        if (old + 1u == (gen + 1u) * nloc) {
            __builtin_amdgcn_fence(__ATOMIC_RELEASE, "agent");
            asm volatile("s_waitcnt vmcnt(0)" ::: "memory");
            const unsigned og = xb_add(&bar[XB_TOP], 1u);
            const unsigned tg = og / nx;
            if (og + 1u == (tg + 1u) * nx) xb_add(&bar[XB_TOPGEN], 1u);
            else XB_SPIN(xb_ld(&bar[XB_TOPGEN]) == tg, bar);
            __builtin_amdgcn_fence(__ATOMIC_ACQUIRE, "agent");
            xb_add(&bar[XB_XGEN(b.x)], 1u);
            asm volatile("s_waitcnt vmcnt(0)" ::: "memory");
        } else {
            XB_SPIN(xb_ld(&bar[XB_XGEN(b.x)]) == gen, bar);
            __builtin_amdgcn_fence(__ATOMIC_ACQUIRE, "agent");
            asm volatile("s_waitcnt vmcnt(0)" ::: "memory");
        }
    }
    __syncthreads();
}

constexpr int NWAVES = 8, NTHR = 512;
constexpr int DM = 1024, MP = 16384, MS = 1024, MT = MP + MS, TSEQ = 8192, DIN = 3584, GW = 256;
constexpr int NBP = 2, NBS = 128, NBT = NBP + NBS;
constexpr int NPOOL = 2560, NPAGES = 16, PAGE = 128, PAST = 2048;
constexpr float EPS = 1e-5f;
constexpr float QSCALE = 0.25503486164919736f;
constexpr float ALPHA = 1.4142135623730951f;
constexpr int HG_L = 64, HG_NB = TSEQ / HG_L;
__device__ const double ROPE_INV[16] = {1.0, 0.5623413251903491, 0.31622776601683794, 0.1778279410038923, 0.1, 0.05623413251903491, 0.03162277660168379, 0.01778279410038923,
                                        0.01, 0.005623413251903491, 0.0031622776601683794, 0.0017782794100389228, 0.001, 0.0005623413251903491, 0.00031622776601683794, 0.00017782794100389227};
enum { I_XP = 0, I_XS, I_CK, I_CV, I_SCONV, I_SHGRN, I_PT, I_CP, I_CSM, I_WADA, I_BADA, I_WIN, I_LAMQK, I_ANG, I_SGG, I_SGB, I_WS, I_BS, I_CW, I_CB, I_CNG, I_CNB, I_WPW, I_LB, I_HNG, I_WOUT, I_LNG, I_LNB, N_IN };
constexpr size_t O_YP = 0, O_YS = O_YP + (size_t)MP * DM, O_KP = O_YS + (size_t)MS * DM, O_VP = O_KP + (size_t)2 * MP * GW, O_KS = O_VP + (size_t)2 * MP * GW,
                 O_VS = O_KS + (size_t)2 * MS * GW, O_CH = O_VS + (size_t)2 * MS * GW, O_CP = O_CH + (size_t)2 * MS * GW, O_CS = O_CP + (size_t)2 * NBP * 30 * GW,
                 O_HP = O_CS + (size_t)2 * NBS * 30 * GW, O_HS = O_HP + (size_t)2 * NBP * 4 * 4096, O_END = O_HS + (size_t)2 * NBS * 4 * 4096;
static_assert(O_END == 42432512, "output size");
constexpr size_t MiB = 1u << 20;
constexpr size_t WS_CTL = 0, CTL_ZERO_BYTES = 1 * MiB;
constexpr size_t WS_CS = 1 * MiB;
constexpr size_t WS_MOD = 2 * MiB;
constexpr size_t WS_SC = 6 * MiB;
constexpr size_t WS_SCAL = 7 * MiB;
constexpr size_t WS_WADA = 8 * MiB;
constexpr size_t WS_WIN = 20 * MiB;
constexpr size_t WS_WOUT = 34 * MiB;
constexpr size_t WS_WPW = 38 * MiB;
constexpr size_t WS_WSB = 39 * MiB;
constexpr size_t WS_H = 40 * MiB;
constexpr size_t SEG = 9 * MiB;
constexpr size_t WS_Q = 74 * MiB, WS_K = WS_Q + SEG, WS_V = WS_K + SEG, WS_GA = WS_V + SEG, WS_U = WS_GA + SEG, WS_VN = WS_U + SEG, WS_GB = WS_VN + SEG, WS_GC = WS_GB + SEG,
                 WS_QD = WS_GC + SEG, WS_KD = WS_QD + SEG, WS_VD = WS_KD + SEG, WS_GD = WS_VD + SEG;
constexpr size_t WS_KT = WS_K, WS_VT = WS_V;
constexpr size_t WS_GLU = 182 * MiB;
constexpr size_t WS_LF = 199 * MiB;
constexpr size_t WS_MIX = 216 * MiB;
constexpr size_t WS_R = 250 * MiB;
constexpr size_t WS_Y1 = 318 * MiB;
constexpr size_t WS_SLOC = 386 * MiB;
constexpr size_t WS_DTOT = 402 * MiB;
constexpr size_t WS_Z = 404 * MiB;
constexpr size_t WS_SST = 644 * MiB;
constexpr size_t WS_MIXCHK = 660 * MiB;
constexpr size_t WS_KR = 696 * MiB, WS_VR = 705 * MiB;
constexpr size_t WS_END = 714 * MiB;
constexpr size_t WS_PART = WS_Q;
constexpr int CW_BAR = 4096;
constexpr int CW_FQ = 16384;
constexpr int CW_GQ = 18432, CW_HQ = 18688, CW_SD = 18944, CW_SL = 19200;
constexpr int RING_BYTES = 131072, MISC_OFF = RING_BYTES + 320, LDS_BYTES = 147456;

__device__ __forceinline__ int batch_of(int m) { return m < MP ? (m >> 13) : NBP + ((m - MP) >> 3); }
struct Args { const float* in[N_IN]; float* out; unsigned char* ws; int ph_lo, ph_hi; };

#define CAS __attribute__((address_space(4)))
struct Ctx {
    const CAS Args* a; unsigned char* wsb; LAS unsigned char* lds; int tid, lane, wave, G, bid;
    __device__ __forceinline__ int gw() const { return bid * NWAVES + wave; }
    __device__ __forceinline__ int ngw() const { return G * NWAVES; }
    template <class T> __device__ __forceinline__ T* ws(size_t off) const { return (T*)(wsb + off); }
};

__device__ __forceinline__ Ctx launder(const Ctx& C, Args& shadow) {
    Ctx P = C; int t; asm volatile("v_mbcnt_lo_u32_b32 %0, -1, 0\n\tv_mbcnt_hi_u32_b32 %0, -1, %0" : "=v"(t)); t += C.wave * 64; P.tid = t; P.lane = t & 63; P.wave = __builtin_amdgcn_readfirstlane(t >> 6);
    const CAS Args* ka = (const CAS Args*)__builtin_amdgcn_kernarg_segment_ptr(); asm volatile("" : "+s"(ka)); P.a = ka;
    unsigned char* w = ka->ws; asm volatile("" : "+s"(w)); P.wsb = w;
    return P;
}
__device__ __forceinline__ f32x4 ld4(const float* p) { return *(const f32x4*)p; }
__device__ __forceinline__ void st4(float* p, f32x4 v) { *(f32x4*)p = v; }
__device__ __forceinline__ void st_bf4(bf16* p, f32x4 v) { v2u w; w.x = pk2(v.x, v.y); w.y = pk2(v.z, v.w); *(v2u*)p = w; }
__device__ __forceinline__ f32x4 ld_bf4(const bf16* p) { const v2u w = *(const v2u*)p; return (f32x4){bflo(w.x), bfhi(w.x), bflo(w.y), bfhi(w.y)}; }

template <class F> struct EpiF {
    static constexpr bool PERM = false, AFTER_DRAIN = false; F f;
    __device__ __forceinline__ void operator()(const pg8::f32x4 (&acc)[2][2][4][2], const pg8::Unit& u, int wr, int wc, int fr, int fq) const {
#pragma unroll
        for (int ai = 0; ai < 2; ++ai)
#pragma unroll
            for (int m = 0; m < 4; ++m) { const int row = u.pm * 256 + ai * 128 + wr * 64 + m * 16 + fr;
#pragma unroll
                for (int bj = 0; bj < 2; ++bj)
#pragma unroll
                    for (int n = 0; n < 2; ++n) { const int col = u.pn * 256 + bj * 128 + wc * 32 + n * 16 + 4 * fq; f(row, col, acc[ai][bj][m][n]); } }
    }
};

struct EpiMod {
    static constexpr bool PERM = false, AFTER_DRAIN = false; float* mod; const float* bada;
    __device__ __forceinline__ void operator()(const pg8::f32x4 (&acc)[2][2][4][2], const pg8::Unit& u, int wr, int wc, int fr, int fq) const {
        f32x4 bv[2][2];
#pragma unroll
        for (int bj = 0; bj < 2; ++bj)
#pragma unroll
            for (int n = 0; n < 2; ++n) bv[bj][n] = ld4(bada + u.pn * 256 + bj * 128 + wc * 32 + n * 16 + 4 * fq);
#pragma unroll
        for (int ai = 0; ai < 2; ++ai)
#pragma unroll
            for (int m = 0; m < 4; ++m) { const int row = u.pm * 256 + ai * 128 + wr * 64 + m * 16 + fr;
                if (row < NBT) {
#pragma unroll
                    for (int bj = 0; bj < 2; ++bj)
#pragma unroll
                        for (int n = 0; n < 2; ++n) { const int col = u.pn * 256 + bj * 128 + wc * 32 + n * 16 + 4 * fq, l = col >= 3072 ? 1 : 0, j = col - l * 3072;
                            st4(mod + (size_t)(l * NBT + row) * 3072 + j, acc[ai][bj][m][n] + bv[bj][n]); } } }
    }
};

struct EpiResid {
    static constexpr bool PERM = true, AFTER_DRAIN = false;
    const float* xp; const float* xs; const bf16* y1; const float* modg; bf16* R; int l;
    __device__ __forceinline__ void operator()(const pg8::f32x4 (&acc)[2][2][4][2], const pg8::Unit& u, int wr, int wc, int fr, int fq) const {
        f32x4 xn[4]; v4u yn[2];
        const int c8 = u.pn * 256 + wc * 32 + 8 * fq;
#define ER_LOAD(ai_, m_) do { const int row_ = u.pm * 256 + (ai_) * 128 + wr * 64 + (m_) * 16 + fr; \
            if (l == 0) { const float* xr_ = xp + (size_t)row_ * DM + c8; xn[0] = ld4(xr_); xn[1] = ld4(xr_ + 4); xn[2] = ld4(xr_ + 128); xn[3] = ld4(xr_ + 132); } \
            else { const bf16* yr_ = y1 + (size_t)row_ * DM + c8; yn[0] = *(const v4u*)yr_; yn[1] = *(const v4u*)(yr_ + 128); } } while (0)
        ER_LOAD(0, 0);
        f32x4 gt[2][2];
        { const float* gr0 = modg + (size_t)batch_of(u.pm * 256) * 3072 + c8;
#pragma unroll
          for (int bj = 0; bj < 2; ++bj) { gt[bj][0] = ld4(gr0 + bj * 128); gt[bj][1] = ld4(gr0 + bj * 128 + 4); } }
#pragma unroll
        for (int g = 0; g < 8; ++g) { const int ai = g >> 2, m = g & 3, row = u.pm * 256 + ai * 128 + wr * 64 + m * 16 + fr;
            f32x4 xc[4];
            if (l == 0) { xc[0] = xn[0]; xc[1] = xn[1]; xc[2] = xn[2]; xc[3] = xn[3]; }
            else { xc[0] = (f32x4){bflo(yn[0].x), bfhi(yn[0].x), bflo(yn[0].y), bfhi(yn[0].y)}; xc[1] = (f32x4){bflo(yn[0].z), bfhi(yn[0].z), bflo(yn[0].w), bfhi(yn[0].w)};
                   xc[2] = (f32x4){bflo(yn[1].x), bfhi(yn[1].x), bflo(yn[1].y), bfhi(yn[1].y)}; xc[3] = (f32x4){bflo(yn[1].z), bfhi(yn[1].z), bflo(yn[1].w), bfhi(yn[1].w)}; }
            if (g < 7) ER_LOAD((g + 1) >> 2, (g + 1) & 3);
            bf16* rr = R + (size_t)row * DM + c8;
#pragma unroll
            for (int bj = 0; bj < 2; ++bj) {
                const f32x4 r0 = xc[2 * bj] * ALPHA + gt[bj][0] * acc[ai][bj][m][0], r1 = xc[2 * bj + 1] * ALPHA + gt[bj][1] * acc[ai][bj][m][1];
                *(v4u*)(rr + bj * 128) = (v4u){pk2(r0.x, r0.y), pk2(r0.z, r0.w), pk2(r1.x, r1.y), pk2(r1.z, r1.w)}; }
            asm volatile("" ::: "memory"); }
#undef ER_LOAD
    }
};

constexpr int OUT_KS = 4, OUT_PIECES = 16 * OUT_KS;
struct PieceOrder {
    int un;
    __device__ __forceinline__ bool next(int i, pg8::Unit& u) const { if (i > 0) return false; u.pm = MP / 256 + (un >> 2); u.pn = un & 3; return true; }
    __device__ __forceinline__ void a_ready(const pg8::Unit&) const {}
    __device__ __forceinline__ void done(const pg8::Unit&) const {}
};
struct EpiPart {
    static constexpr bool PERM = false, AFTER_DRAIN = false;
    float* P;
    __device__ __forceinline__ void operator()(const pg8::f32x4 (&acc)[2][2][4][2], const pg8::Unit& u, int wr, int wc, int fr, int fq) const {
#pragma unroll
        for (int ai = 0; ai < 2; ++ai)
#pragma unroll
            for (int m = 0; m < 4; ++m) { const int row = (u.pm - MP / 256) * 256 + ai * 128 + wr * 64 + m * 16 + fr; float* rr = P + (size_t)row * DM;
#pragma unroll
                for (int bj = 0; bj < 2; ++bj)
#pragma unroll
                    for (int n = 0; n < 2; ++n) { const int col = u.pn * 256 + bj * 128 + wc * 32 + n * 16 + 4 * fq; st4(rr + col, acc[ai][bj][m][n]); } }
    }
};

#define EPI_PIN(ai, m) asm volatile("" : "+v"(acc[ai][0][m][0]), "+v"(acc[ai][0][m][1]), "+v"(acc[ai][1][m][0]), "+v"(acc[ai][1][m][1]) :: "memory")
struct EpiIn {
    static constexpr bool PERM = false, AFTER_DRAIN = false;
    unsigned char* ws; float* out; const float* sgg; const float* sgb; LAS unsigned char* xl; int l;
    template <int ACT> static __device__ __forceinline__ f32x4 act4(f32x4 v) {
        if (ACT == 1) { return (f32x4){silu_f(v.x), silu_f(v.y), silu_f(v.z), silu_f(v.w)}; }
        if (ACT == 2) { const pg8::f32x2 a = pg8::gelu_pk((pg8::f32x2){v.x, v.y}), b = pg8::gelu_pk((pg8::f32x2){v.z, v.w}); return (f32x4){a.x, a.y, b.x, b.y}; }
        return v;
    }
    template <int ACT> __device__ __forceinline__ void plain(pg8::f32x4 (&acc)[2][2][4][2], int row0, int c0, size_t off) const {
        bf16* B = (bf16*)(ws + off);
#pragma unroll
        for (int ai = 0; ai < 2; ++ai)
#pragma unroll
            for (int m = 0; m < 4; ++m) { EPI_PIN(ai, m); bf16* rp = B + (size_t)(row0 + ai * 128 + m * 16) * 256 + c0;
#pragma unroll
                for (int bj = 0; bj < 2; ++bj)
#pragma unroll
                    for (int n = 0; n < 2; ++n) st_bf4(rp + bj * 128 + n * 16, act4<ACT>(acc[ai][bj][m][n]));
                asm volatile("" ::: "memory"); }
    }
    __device__ __forceinline__ void operator()(pg8::f32x4 (&acc)[2][2][4][2], const pg8::Unit& u, int wr, int wc, int fr, int fq) const {
        asm volatile("" : "+v"(fr), "+v"(fq));
        const int T = u.pn;
#define EPI_IDX int fr_ = fr, fq_ = fq; asm volatile("" : "+v"(fr_), "+v"(fq_)); const int row0 = u.pm * 256 + wr * 64 + fr_, c0 = wc * 32 + 4 * fq_; (void)row0; (void)c0
        const bool samp = u.pm >= MP / 256;
#ifndef EPI_MASK
#define EPI_MASK 0xff
#endif
        if ((EPI_MASK & 1) && (T == 0 || T == 1)) {
            EPI_IDX;
            const f32x2v* CS = (const f32x2v*)(ws + WS_CS);
            f32x4 cn0, cn1;
#define ROPE_LDCS(ai_, m_) do { const int row_ = row0 + (ai_) * 128 + (m_) * 16; const int pos_ = samp ? PAST + ((row_ - MP) & 7) : (row_ & (TSEQ - 1)); \
                cn0 = *(const f32x4*)(CS + pos_ * 16 + 4 * fq_); cn1 = *(const f32x4*)(CS + pos_ * 16 + 4 * fq_ + 2); } while (0)
            ROPE_LDCS(0, 0);
#pragma unroll
            for (int ai = 0; ai < 2; ++ai)
#pragma unroll
                for (int m = 0; m < 4; ++m) { EPI_PIN(ai, m); const int row = row0 + ai * 128 + m * 16; const int r = row - MP;
                    const f32x4 cs0 = cn0, cs1 = cn1;
                    if (ai * 4 + m < 7) ROPE_LDCS((ai * 4 + m + 1) >> 2, (ai * 4 + m + 1) & 3);
                    const f32x4 cosv = (f32x4){cs0.x, cs0.z, cs1.x, cs1.z}, sinv = (f32x4){cs0.y, cs0.w, cs1.y, cs1.w};
#pragma unroll
                    for (int bj = 0; bj < 2; ++bj) { const f32x4 x1 = acc[ai][bj][m][0], x2 = acc[ai][bj][m][1];
                        const f32x4 o1 = x1 * cosv - x2 * sinv, o2 = x2 * cosv + x1 * sinv; const int col = bj * 128 + c0;
                        if (T == 0) { bf16* q = (bf16*)(ws + WS_Q) + (size_t)row * 256 + col; st_bf4(q, o1 * QSCALE); st_bf4(q + 16, o2 * QSCALE); }
                        else { float* ok = out + (samp ? O_KS + ((size_t)l * MS + r) * 256 : O_KP + ((size_t)l * MP + row) * 256) + col; st4(ok, o1); st4(ok + 16, o2);
#if MK_CHECK == 1
                            { bf16* kr = (bf16*)(ws + WS_KR) + (size_t)row * 256 + col; st_bf4(kr, o1); st_bf4(kr + 16, o2); }
#endif
                            if (!samp) { const int t = row & (TSEQ - 1), bh = (row >> 13) * 4 + 2 * bj + (wc >> 1);
                                unsigned char* kt = ws + WS_KT + ((size_t)(bh * 128 + (t >> 6)) * 8192 + (4 * (wc & 1) + (fq_ >> 1)) * 1024 + (t & 63) * 16 + 8 * (fq_ & 1));
                                st_bf4((bf16*)kt, o1); st_bf4((bf16*)(kt + 2048), o2); } } }
                    asm volatile("" ::: "memory"); }
        } else if ((EPI_MASK & 2) && T == 2) {
            EPI_IDX;
#pragma unroll
            for (int ai = 0; ai < 2; ++ai)
#pragma unroll
                for (int m = 0; m < 4; ++m) { EPI_PIN(ai, m); const int row = row0 + ai * 128 + m * 16; const int r = row - MP;
#pragma unroll
                    for (int bj = 0; bj < 2; ++bj)
#pragma unroll
                        for (int n = 0; n < 2; ++n) { const f32x4 v = acc[ai][bj][m][n]; const int col = bj * 128 + n * 16 + c0;
                            st4(out + (samp ? O_VS + ((size_t)l * MS + r) * 256 : O_VP + ((size_t)l * MP + row) * 256) + col, v);
#if MK_CHECK == 1
                            st_bf4((bf16*)(ws + WS_VR) + (size_t)row * 256 + col, v);
#endif
                            if (!samp) { const int t = row & (TSEQ - 1), bh = (row >> 13) * 4 + 2 * bj + (wc >> 1), rw = t & 63;
                                st_bf4((bf16*)(ws + WS_VT + ((size_t)(bh * 128 + (t >> 6)) * 8192 + ((wc & 1) * 4 + (rw >> 4)) * 1024 + (rw & 15) * 64 + 32 * n + 8 * fq_)), v); } }
                    asm volatile("" ::: "memory"); }
        } else if ((EPI_MASK & 4) && T == 3) { EPI_IDX; plain<1>(acc, row0, c0, WS_GA); }
        else if ((EPI_MASK & 8) && T == 4) { EPI_IDX; plain<2>(acc, row0, c0, WS_U); }
        else if ((EPI_MASK & 4) && T == 6) { EPI_IDX; plain<1>(acc, row0, c0, WS_GB); }
        else if ((EPI_MASK & 4) && T == 9) { EPI_IDX; plain<1>(acc, row0, c0, WS_GC); }
        else if ((EPI_MASK & 4) && T == 10) { EPI_IDX; plain<1>(acc, row0, c0, WS_QD); }
        else if ((EPI_MASK & 4) && T == 12) { EPI_IDX; plain<0>(acc, row0, c0, WS_VD); }
        else if ((EPI_MASK & 4) && T == 13) { EPI_IDX; plain<1>(acc, row0, c0, WS_GD); }
        else if ((EPI_MASK & 16) && T == 5) { EPI_IDX; plain<2>(acc, row0, c0, WS_VN);
        } else if ((EPI_MASK & 32) && (T == 7 || T == 8)) {
            EPI_IDX;
#pragma unroll
            for (int ai = 0; ai < 2; ++ai)
#pragma unroll
                for (int m = 0; m < 4; ++m) { EPI_PIN(ai, m); const int row = row0 + ai * 128 + m * 16; const int r = row - MP;
#pragma unroll
                    for (int n = 0; n < 2; ++n) { const f32x4 a = acc[ai][0][m][n], gt = acc[ai][1][m][n]; const int col = (T - 7) * 128 + n * 16 + c0;
                        const f32x4 glu = (f32x4){a.x * sigmoid_f(gt.x), a.y * sigmoid_f(gt.y), a.z * sigmoid_f(gt.z), a.w * sigmoid_f(gt.w)};
                        st4((float*)(ws + WS_GLU) + (size_t)row * 256 + col, glu);
                        if (!samp) { const int t = row & (TSEQ - 1); if (t >= TSEQ - 30) st4(out + O_CP + ((size_t)(l * NBP + (row >> 13)) * 30 + (t - (TSEQ - 30))) * 256 + col, glu); }
                        else st4(out + O_CS + ((size_t)(l * NBS + (r >> 3)) * 30 + 22 + (r & 7)) * 256 + col, glu); }
                    asm volatile("" ::: "memory"); }
        } else if ((EPI_MASK & 64) && T == 11) {
            EPI_IDX;
            const float* lbp = (const float*)(ws + WS_SCAL) + 64;
            f32x4 lbv[2][2];
#pragma unroll
            for (int bj = 0; bj < 2; ++bj)
#pragma unroll
                for (int n = 0; n < 2; ++n) { lbv[bj][n] = (f32x4){0.f, 0.f, 0.f, 0.f}; if (l == 1) lbv[bj][n] = ld4(lbp + bj * 128 + n * 16 + c0); }
#pragma unroll
            for (int ai = 0; ai < 2; ++ai)
#pragma unroll
                for (int m = 0; m < 4; ++m) { EPI_PIN(ai, m); const int row = row0 + ai * 128 + m * 16;
#pragma unroll
                    for (int bj = 0; bj < 2; ++bj)
#pragma unroll
                        for (int n = 0; n < 2; ++n) { const int col = bj * 128 + n * 16 + c0; const f32x4 lb = lbv[bj][n];
                            const f32x4 v = acc[ai][bj][m][n]; f32x4 f, lf;
                            f.x = lb.x + (1.f - lb.x) * sigmoid_f(v.x); f.y = lb.y + (1.f - lb.y) * sigmoid_f(v.y); f.z = lb.z + (1.f - lb.z) * sigmoid_f(v.z); f.w = lb.w + (1.f - lb.w) * sigmoid_f(v.w);
                            lf.x = __logf(fmaxf(f.x, 1e-30f)); lf.y = __logf(fmaxf(f.y, 1e-30f)); lf.z = __logf(fmaxf(f.z, 1e-30f)); lf.w = __logf(fmaxf(f.w, 1e-30f));
                            st4((float*)(ws + WS_LF) + (size_t)row * 256 + col, lf); st_bf4((bf16*)(ws + WS_KD) + (size_t)row * 256 + col, 1.f - f); } }
        }
    }
};

template <bool GLU_PERM = false> __device__ __forceinline__ void p0_transpose_item(const float* W, int K, int N, bf16* WT, int row_off, LAS float* scr, int item, int lane) {
    const int nblk = N / 32, kb = item / nblk, nb = item % nblk, k0 = 64 * kb, n0 = 32 * nb;
    int d0 = n0;
    if (GLU_PERM && n0 >= 1792 && n0 < 2304) { const int c = n0 - 1792, part = c >> 8, idx = c & 255; d0 = 1792 + (idx >> 7) * 256 + part * 128 + (idx & 127); }
    float tv[32];
#pragma unroll
    for (int i = 0; i < 32; ++i) tv[i] = W[(size_t)(k0 + 2 * i + (lane >> 5)) * N + n0 + (lane & 31)];
#pragma unroll
    for (int i = 0; i < 32; ++i) scr[(2 * i + (lane >> 5)) * 33 + (lane & 31)] = tv[i];
    LDS_WAIT(); asm volatile("" ::: "memory");
    const int c = lane & 7;
#pragma unroll
    for (int j = 0; j < 4; ++j) { const int n = (lane >> 3) + 8 * j; const LAS float* s = scr + (8 * c) * 33 + n;
        v4u o; o.x = pk2(s[0 * 33], s[1 * 33]); o.y = pk2(s[2 * 33], s[3 * 33]); o.z = pk2(s[4 * 33], s[5 * 33]); o.w = pk2(s[6 * 33], s[7 * 33]);
        *(GAS v4u*)(WT + (size_t)(row_off + d0 + n) * K + k0 + 8 * c) = o; }
    LDS_WAIT(); asm volatile("" ::: "memory");
}
struct TItem { const float* src; bf16* dst; int N, K; };
template <bool GLU_PERM = false> __device__ __forceinline__ TItem p0_titem(const float* W, int K, int N, bf16* WT, int row_off, int item, int lane) {
    const int nblk = N / 32, kb = item / nblk, nb = item % nblk, k0 = 64 * kb, n0 = 32 * nb;
    int d0 = n0;
    if (GLU_PERM && n0 >= 1792 && n0 < 2304) { const int c = n0 - 1792, part = c >> 8, idx = c & 255; d0 = 1792 + (idx >> 7) * 256 + part * 128 + (idx & 127); }
    TItem t; t.src = W + (size_t)(k0 + (lane >> 5)) * N + n0 + (lane & 31); t.dst = WT + (size_t)(row_off + d0) * K + k0; t.N = N; t.K = K; return t;
}
#define P0_TLOAD(T, tv) { _Pragma("unroll") for (int i_ = 0; i_ < 32; ++i_) tv[i_] = (T).src[(size_t)(2 * i_) * (T).N]; }
#define P0_TSTORE(T, tv, scr, lane) { \
    _Pragma("unroll") for (int i_ = 0; i_ < 32; ++i_) (scr)[(2 * i_ + ((lane) >> 5)) * 33 + ((lane) & 31)] = tv[i_]; \
    LDS_WAIT(); asm volatile("" ::: "memory"); \
    { const int c_ = (lane) & 7; \
      _Pragma("unroll") for (int j_ = 0; j_ < 4; ++j_) { const int n_ = ((lane) >> 3) + 8 * j_; const LAS float* s_ = (scr) + (8 * c_) * 33 + n_; \
        v4u o_; o_.x = pk2(s_[0 * 33], s_[1 * 33]); o_.y = pk2(s_[2 * 33], s_[3 * 33]); o_.z = pk2(s_[4 * 33], s_[5 * 33]); o_.w = pk2(s_[6 * 33], s_[7 * 33]); \
        *(GAS v4u*)((T).dst + (size_t)n_ * (T).K + 8 * c_) = o_; } } \
    LDS_WAIT(); asm volatile("" ::: "memory"); }
__device__ __forceinline__ void p0_layer1_weights(const Ctx& C, int widx, int nw) {
    const CAS Args& A = *C.a; LAS float* scr = (LAS float*)(C.lds + C.wave * 12288);
    constexpr int I_IN = 16 * (DIN / 32), I_OUT = 16 * 32, I_PW = 4 * 8;
    for (int it = widx; it < I_IN + I_OUT + I_PW; it += nw) {
        int r = it;
        if (r < I_IN) { p0_transpose_item<true>(A.in[I_WIN] + (size_t)DM * DIN, DM, DIN, C.ws<bf16>(WS_WIN) + (size_t)DIN * DM, 0, scr, r, C.lane); continue; } r -= I_IN;
        if (r < I_OUT) { p0_transpose_item(A.in[I_WOUT] + (size_t)DM * DM, DM, DM, C.ws<bf16>(WS_WOUT) + (size_t)DM * DM, 0, scr, r, C.lane); continue; } r -= I_OUT;
        p0_transpose_item(A.in[I_WPW] + (size_t)256 * 256, 256, 256, C.ws<bf16>(WS_WPW) + (size_t)256 * 256, 0, scr, r, C.lane);
    }
}
template <int PART> __device__ __forceinline__ void p0_prologue(const Ctx& C, int gw, int NGW) {
    const CAS Args& A = *C.a;
    LAS float* scr = (LAS float*)(C.lds + C.wave * 16384);
    constexpr int I_IN = 16 * (DIN / 32), I_OUT = 16 * 32, I_ADA = 16 * 96, I_PW = 4 * 8;
    constexpr int NITEMS = I_IN + I_OUT + I_PW + 2 * I_ADA;
    constexpr int IT_LO = PART == 0 ? I_IN + I_OUT + I_PW : 0, IT_HI = PART == 0 ? NITEMS : I_IN + I_OUT + I_PW;
    auto desc = [&](int it) -> TItem {
        int r = it;
        if (r < I_IN) return p0_titem<true>(A.in[I_WIN], DM, DIN, C.ws<bf16>(WS_WIN), 0, r, C.lane); r -= I_IN;
        if (r < I_OUT) return p0_titem(A.in[I_WOUT], DM, DM, C.ws<bf16>(WS_WOUT), 0, r, C.lane); r -= I_OUT;
        if (r < I_PW) return p0_titem(A.in[I_WPW], 256, 256, C.ws<bf16>(WS_WPW), 0, r, C.lane); r -= I_PW;
        const int l = r >= I_ADA ? 1 : 0; r -= l * I_ADA;
        return p0_titem(A.in[I_WADA] + (size_t)l * DM * 3072, DM, 3072, C.ws<bf16>(WS_WADA), l * 3072, r, C.lane);
    };
    for (int it = IT_LO + gw; it < IT_HI; it += 2 * NGW) {
        const bool two = it + NGW < IT_HI;
        const TItem T0 = desc(it), T1 = desc(two ? it + NGW : it);
        float tv0[32], tv1[32];
        P0_TLOAD(T0, tv0);
        if (two) P0_TLOAD(T1, tv1);
        P0_TSTORE(T0, tv0, scr, C.lane);
        if (two) P0_TSTORE(T1, tv1, scr, C.lane);
    }
    if (PART == 1) {
    { bf16* wsb = C.ws<bf16>(WS_WSB); const float* wsrc = A.in[I_WS];
      for (int idx = gw * 64 + C.lane; idx < 2 * 4 * 128 * 32; idx += NGW * 64) { const int t = (idx >> 5) & 127, s4 = (idx & 31) * 4; f32x4 v = ld4(wsrc + (size_t)idx * 4);
          if (s4 + 0 > t) v.x = 0.f; if (s4 + 1 > t) v.y = 0.f; if (s4 + 2 > t) v.z = 0.f; if (s4 + 3 > t) v.w = 0.f; st_bf4(wsb + (size_t)idx * 4, v); } }
    f32x2v* cs = C.ws<f32x2v>(WS_CS);
    for (int idx = gw * 64 + C.lane; idx < TSEQ * 16; idx += NGW * 64) {
        const int pos = idx >> 4, i = idx & 15;
        const double a = (double)pos * ROPE_INV[i];
        const double n = rint(a * 0.15915494309189535);
        const float r = (float)(a - n * 6.283185307179586);
        cs[idx] = (f32x2v){cosf(r), sinf(r)};
    }
    }
    if (PART == 0) {
    bf16* sc = C.ws<bf16>(WS_SC);
    for (int row = gw; row < 256; row += NGW) {
        const float* src = row < NBP ? A.in[I_CP] + (size_t)row * DM : A.in[I_CSM] + (size_t)(row - NBP) * DM;
#pragma unroll
        for (int j = 0; j < 4; ++j) { const int col = 4 * C.lane + 256 * j; f32x4 v = (f32x4){0.f, 0.f, 0.f, 0.f};
            if (row < NBT) { v = ld4(src + col); v.x = silu_f(v.x); v.y = silu_f(v.y); v.z = silu_f(v.z); v.w = silu_f(v.w); }
            st_bf4(sc + (size_t)row * DM + col, v); }
    }
    }
    if (PART == 1) {
    for (int it = gw; it < 2 * NBS * 22; it += NGW) { const int j = it % 22, lb_ = it / 22;
        st4(A.out + O_CS + ((size_t)lb_ * 30 + j) * 256 + 4 * C.lane, ld4(A.in[I_SCONV] + ((size_t)lb_ * 30 + 8 + j) * 256 + 4 * C.lane)); }
    }
    if (PART == 0 && C.bid == 0 && C.wave == 0) {
        float* scal = C.ws<float>(WS_SCAL);
        const float* lq = A.in[I_LAMQK];
        for (int l = 0; l < 2; ++l) {
            float a = C.lane < 32 ? lq[(l * 4 + 0) * 32 + C.lane] * lq[(l * 4 + 1) * 32 + C.lane] : 0.f;
            float b = C.lane < 32 ? lq[(l * 4 + 2) * 32 + C.lane] * lq[(l * 4 + 3) * 32 + C.lane] : 0.f;
            a = wave_sum(a); b = wave_sum(b);
            const float lam_init = l == 0 ? 0.2f : 0.35550906759096934f;
            if (C.lane == 0) scal[l] = __expf(a) - __expf(b) + lam_init;
        }
        const float* lb = A.in[I_LB];
        for (int c = C.lane; c < 256; c += 64) { const float e0 = __expf(lb[c]), e1 = __expf(lb[256 + c]); scal[64 + c] = e1 / (e0 + e1); }
    }
}


__device__ __forceinline__ const float* xrow_in(const Ctx& C, int l, int m) {
    if (l == 0) return m < MP ? C.a->in[I_XP] + (size_t)m * DM : C.a->in[I_XS] + (size_t)(m - MP) * DM;
    return C.a->in[I_XP];
}
__device__ __forceinline__ void ph_hbuild(const Ctx& C, int l) {
    const float* mod = C.ws<float>(WS_MOD); bf16* H = C.ws<bf16>(WS_H);
    constexpr int HB = 4;
    f32x4 b0[HB][4], b1[HB][4], hS[4], hC[4]; int hb = -1;
    const int rstep = C.ngw();
#define HB_LOAD(dst, mb) do { _Pragma("unroll") for (int i_ = 0; i_ < HB; ++i_) { const int mi_ = (mb) + i_ * rstep; if (mi_ < MT) { const float* xr_ = xrow_in(C, l, mi_); \
        _Pragma("unroll") for (int j_ = 0; j_ < 4; ++j_) dst[i_][j_] = ld4(xr_ + 4 * C.lane + 256 * j_); } } } while (0)
    HB_LOAD(b0, C.gw());
    if (C.gw() + HB * rstep < MT) { HB_LOAD(b1, C.gw() + HB * rstep); }
    for (int m = C.gw(); m < MT; m += HB * rstep) {
        f32x4 use[HB][4];
#pragma unroll
        for (int i = 0; i < HB; ++i)
#pragma unroll
            for (int j = 0; j < 4; ++j) { use[i][j] = b0[i][j]; b0[i][j] = b1[i][j]; }
        if (m + 2 * HB * rstep < MT) { HB_LOAD(b1, m + 2 * HB * rstep); }
#pragma unroll
        for (int i = 0; i < HB; ++i) { const int mi = m + i * rstep;
            if (mi < MT) {
                if (batch_of(mi) != hb) { hb = batch_of(mi); const float* md = mod + (size_t)(l * NBT + hb) * 3072 + 4 * C.lane;
#pragma unroll
                    for (int j = 0; j < 4; ++j) { hS[j] = ld4(md + 256 * j); hC[j] = ld4(md + 1024 + 256 * j); } }
#pragma unroll
                for (int j = 0; j < 4; ++j) st_bf4(H + (size_t)mi * DM + 4 * C.lane + 256 * j, use[i][j] * (1.f + hC[j]) + hS[j]); } }
    }
#undef HB_LOAD
}

#if MK_CHECK == 6
constexpr size_t WS_ALT = 768 * MiB;
__device__ __forceinline__ void ph_post_ref(const Ctx& C, int l) {
    const CAS Args& A = *C.a; const int lane = C.lane, c4 = 4 * lane;
    const float* Z = (const float*)(C.wsb - WS_ALT + WS_Z); const f32x2v* CS = (const f32x2v*)(C.wsb - WS_ALT + WS_CS); const float* scal = (const float*)(C.wsb - WS_ALT + WS_SCAL);
    bf16 *Qb = C.ws<bf16>(WS_Q), *Kb = C.ws<bf16>(WS_K), *Vb = C.ws<bf16>(WS_V), *GA = C.ws<bf16>(WS_GA), *U = C.ws<bf16>(WS_U), *VN = C.ws<bf16>(WS_VN), *GB = C.ws<bf16>(WS_GB),
         *GC = C.ws<bf16>(WS_GC), *QD = C.ws<bf16>(WS_QD), *KD = C.ws<bf16>(WS_KD), *VD = C.ws<bf16>(WS_VD), *GD = C.ws<bf16>(WS_GD);
    float *GLU = C.ws<float>(WS_GLU), *LF = C.ws<float>(WS_LF); float* out = A.out;
    const f32x4 sg_g = ld4(A.in[I_SGG] + l * 256 + c4), sg_b = ld4(A.in[I_SGB] + l * 256 + c4);
    f32x4 lb = (f32x4){0.f, 0.f, 0.f, 0.f}; if (l == 1) lb = ld4(scal + 64 + c4);
    const float sgn = (lane & 4) ? 1.f : -1.f;
    for (int m = C.gw(); m < MT; m += C.ngw()) {
        const float* z = Z + (size_t)m * DIN; const size_t mo = (size_t)m * 256 + c4;
        const bool samp = m >= MP; const int r = m - MP;
        const int pos = samp ? PAST + (r & 7) : (m & (TSEQ - 1));
        float *ok, *ov;
        if (!samp) { const size_t o = ((size_t)l * MP + m) * 256 + c4; ok = out + O_KP + o; ov = out + O_VP + o; }
        else { const size_t o = ((size_t)l * MS + r) * 256 + c4; ok = out + O_KS + o; ov = out + O_VS + o; }
        const f32x4 cs0 = *(const f32x4*)(CS + pos * 16 + 4 * (lane & 3)), cs1 = *(const f32x4*)(CS + pos * 16 + 4 * (lane & 3) + 2);
        const f32x4 cosv = (f32x4){cs0.x, cs0.z, cs1.x, cs1.z}, sinv = (f32x4){cs0.y, cs0.w, cs1.y, cs1.w};
        {
            const f32x4 v = ld4(z + c4); f32x4 p; p.x = __builtin_bit_cast(float, __builtin_amdgcn_ds_swizzle(__builtin_bit_cast(int, v.x), (4 << 10) | 0x1f)); p.y = __builtin_bit_cast(float, __builtin_amdgcn_ds_swizzle(__builtin_bit_cast(int, v.y), (4 << 10) | 0x1f)); p.z = __builtin_bit_cast(float, __builtin_amdgcn_ds_swizzle(__builtin_bit_cast(int, v.z), (4 << 10) | 0x1f)); p.w = __builtin_bit_cast(float, __builtin_amdgcn_ds_swizzle(__builtin_bit_cast(int, v.w), (4 << 10) | 0x1f));
            const f32x4 o = v * cosv + (p * sinv) * sgn; st_bf4(Qb + mo, o * QSCALE);
        }
        {
            const f32x4 v = ld4(z + 256 + c4); f32x4 p; p.x = __builtin_bit_cast(float, __builtin_amdgcn_ds_swizzle(__builtin_bit_cast(int, v.x), (4 << 10) | 0x1f)); p.y = __builtin_bit_cast(float, __builtin_amdgcn_ds_swizzle(__builtin_bit_cast(int, v.y), (4 << 10) | 0x1f)); p.z = __builtin_bit_cast(float, __builtin_amdgcn_ds_swizzle(__builtin_bit_cast(int, v.z), (4 << 10) | 0x1f)); p.w = __builtin_bit_cast(float, __builtin_amdgcn_ds_swizzle(__builtin_bit_cast(int, v.w), (4 << 10) | 0x1f));
            const f32x4 o = v * cosv + (p * sinv) * sgn;
            if (!samp) { const int t = m & (TSEQ - 1), bh = (m >> 13) * 4 + (lane >> 4);
                st_bf4((bf16*)(C.ws<unsigned char>(WS_KT) + ((size_t)(bh * 128 + (t >> 6)) * 8192 + ((lane & 15) >> 1) * 1024 + (t & 63) * 16 + (lane & 1) * 8)), o); }
        }
        { const f32x4 v = ld4(z + 512 + c4);
            if (!samp) { const int t = m & (TSEQ - 1), bh = (m >> 13) * 4 + (lane >> 4), row = t & 63;
                st_bf4((bf16*)(C.ws<unsigned char>(WS_VT) + ((size_t)(bh * 128 + (t >> 6)) * 8192 + ((((lane & 15) >> 3) * 4 + (row >> 4)) * 1024) + (row & 15) * 64 + (lane & 7) * 8)), v); } }
        { const f32x4 v = ld4(z + 768 + c4); st_bf4(GA + mo, (f32x4){silu_f(v.x), silu_f(v.y), silu_f(v.z), silu_f(v.w)}); }
        { const f32x4 v = ld4(z + 1024 + c4); st_bf4(U + mo, (f32x4){gelu_f(v.x), gelu_f(v.y), gelu_f(v.z), gelu_f(v.w)}); }
        { const f32x4 v = ld4(z + 1280 + c4); st_bf4(VN + mo, (f32x4){gelu_f(v.x), gelu_f(v.y), gelu_f(v.z), gelu_f(v.w)}); }
        { const f32x4 v = ld4(z + 1536 + c4); st_bf4(GB + mo, (f32x4){silu_f(v.x), silu_f(v.y), silu_f(v.z), silu_f(v.w)}); }
        {
            const f32x4 a = ld4(z + 1792 + (c4 >> 7) * 256 + (c4 & 127)), g = ld4(z + 1792 + (c4 >> 7) * 256 + 128 + (c4 & 127));
            const f32x4 glu = (f32x4){a.x * sigmoid_f(g.x), a.y * sigmoid_f(g.y), a.z * sigmoid_f(g.z), a.w * sigmoid_f(g.w)};
            st4(GLU + mo, glu);
        }
        { const f32x4 v = ld4(z + 2304 + c4); st_bf4(GC + mo, (f32x4){silu_f(v.x), silu_f(v.y), silu_f(v.z), silu_f(v.w)}); }
        { const f32x4 v = ld4(z + 2560 + c4); st_bf4(QD + mo, (f32x4){silu_f(v.x), silu_f(v.y), silu_f(v.z), silu_f(v.w)}); }
        {
            const f32x4 v = ld4(z + 2816 + c4); f32x4 f, lf;
            f.x = lb.x + (1.f - lb.x) * sigmoid_f(v.x); f.y = lb.y + (1.f - lb.y) * sigmoid_f(v.y); f.z = lb.z + (1.f - lb.z) * sigmoid_f(v.z); f.w = lb.w + (1.f - lb.w) * sigmoid_f(v.w);
            lf.x = __logf(fmaxf(f.x, 1e-30f)); lf.y = __logf(fmaxf(f.y, 1e-30f)); lf.z = __logf(fmaxf(f.z, 1e-30f)); lf.w = __logf(fmaxf(f.w, 1e-30f));
            st4(LF + mo, lf); st_bf4(KD + mo, 1.f - f);
        }
        { const f32x4 v = ld4(z + 3072 + c4); st_bf4(VD + mo, v); }
        { const f32x4 v = ld4(z + 3328 + c4); st_bf4(GD + mo, (f32x4){silu_f(v.x), silu_f(v.y), silu_f(v.z), silu_f(v.w)}); }
    }
}

#endif

__device__ __forceinline__ void sg_unit(const Ctx& C, int l, int u) {
    const CAS Args& A = *C.a; const bf16 *U = C.ws<bf16>(WS_U), *VN = C.ws<bf16>(WS_VN), *GB = C.ws<bf16>(WS_GB); bf16* MIX = C.ws<bf16>(WS_MIX);
    LAS float* vn = (LAS float*)C.lds;
    const int r0 = (u - 128) * 8; const size_t m0 = (size_t)MP + r0;
    {   const int i = C.wave; const f32x4 gam = ld4(A.in[I_SGG] + l * 256 + 4 * C.lane), bet = ld4(A.in[I_SGB] + l * 256 + 4 * C.lane);
        const f32x4 v = ld_bf4(VN + (m0 + i) * 256 + 4 * C.lane);
        const float mean = wave_sum((v.x + v.y) + (v.z + v.w)) * (1.f / 256.f); const f32x4 d = v - mean;
        const float var = wave_sum((d.x * d.x + d.y * d.y) + (d.z * d.z + d.w * d.w)) * (1.f / 256.f);
        const f32x4 y = d * rsqrtf(var + EPS) * gam + bet;
        *(LAS f32x4*)(vn + i * 256 + 4 * C.lane) = y; st4(A.out + O_CH + ((size_t)l * MS + r0 + i) * 256 + 4 * C.lane, y); }
    __syncthreads();
    const int col = C.tid & 255, th = C.tid >> 8, g = col >> 6;
    const float* w = A.in[I_WS] + (size_t)(l * 4 + g) * 128 * 128; const float* bs = A.in[I_BS] + (l * 4 + g) * 128;
    f32x4 wv[4][2]; float bsv[4], uu[4], gg[4];
#pragma unroll
    for (int i = 0; i < 4; ++i) { const int t = th * 4 + i; wv[i][0] = ld4(w + t * 128); wv[i][1] = ld4(w + t * 128 + 4); bsv[i] = bs[t];
        const size_t mo = (m0 + t) * 256 + col; uu[i] = bf2f(U[mo]); gg[i] = bf2f(GB[mo]); }
    float vv[8];
#pragma unroll
    for (int s_ = 0; s_ < 8; ++s_) vv[s_] = vn[s_ * 256 + col];
#pragma unroll
    for (int i = 0; i < 4; ++i) { const int t = th * 4 + i; float acc = 0.f;
#pragma unroll
        for (int s_ = 0; s_ < 8; ++s_) { const float wt = s_ < 4 ? wv[i][0][s_] : wv[i][1][s_ - 4]; acc += (s_ <= t) ? wt * vv[s_] : 0.f; }
        MIX[(m0 + t) * DM + 256 + col] = (bf16)f2bf(uu[i] * (acc + bsv[i]) * gg[i]); }
    __syncthreads();
}

__device__ __forceinline__ void conv_unit(const Ctx& C, int l, int u, bf16* MIX) {
    const CAS Args& A = *C.a; const float* GLU = C.ws<float>(WS_GLU); const bf16* GC = C.ws<bf16>(WS_GC);
    LAS float* Ys = (LAS float*)C.lds;
    const int c = C.tid & 255, rh = C.tid >> 8, r0 = u * 16;
    const float* cw = A.in[I_CW] + (size_t)l * 31 * 256 + c; const float cb = A.in[I_CB][l * 256 + c];
    for (int i = 0; i < 8; ++i) {
        const int rr = rh * 8 + i, m = r0 + rr; float y = cb;
        if (m < MP) { const int t = m & (TSEQ - 1);
            for (int j = 0; j < 31; ++j) { const int tt = t + j - 30; if (tt >= 0) y += cw[j * 256] * GLU[(size_t)(m + j - 30) * 256 + c]; }
        } else { const int r = m - MP, bs = r >> 3, ts = r & 7; const float* sc = A.in[I_SCONV] + (size_t)(l * NBS + bs) * 30 * 256 + c;
            for (int j = 0; j < 31; ++j) { const int tt = ts + j - 30; const float h = tt >= 0 ? GLU[(size_t)(m + j - 30) * 256 + c] : sc[(ts + j) * 256]; y += cw[j * 256] * h; }
        }
        Ys[rr * 256 + c] = y;
    }
    __syncthreads();
    {
        const f32x4 g = ld4(A.in[I_CNG] + l * 256 + 4 * C.lane), b = ld4(A.in[I_CNB] + l * 256 + 4 * C.lane);
        for (int i = 0; i < 2; ++i) { const int rr = C.wave * 2 + i; LAS f32x4* p = (LAS f32x4*)(Ys + rr * 256) + C.lane; f32x4 v = *p;
            const float mean = wave_sum((v.x + v.y) + (v.z + v.w)) * (1.f / 256.f); const f32x4 d = v - mean;
            const float var = wave_sum((d.x * d.x + d.y * d.y) + (d.z * d.z + d.w * d.w)) * (1.f / 256.f);
            f32x4 y = d * rsqrtf(var + EPS) * g + b; y = (f32x4){silu_f(y.x), silu_f(y.y), silu_f(y.z), silu_f(y.w)}; *p = y; }
    }
    __syncthreads();
    {
        float acc[8];
#pragma unroll
        for (int i = 0; i < 8; ++i) acc[i] = 0.f;
        const float* wp = A.in[I_WPW] + (size_t)l * 256 * 256 + c;
        for (int k = 0; k < 256; k += 4) {
            const float w0 = wp[(k + 0) * 256], w1 = wp[(k + 1) * 256], w2 = wp[(k + 2) * 256], w3 = wp[(k + 3) * 256];
#pragma unroll
            for (int i = 0; i < 8; ++i) { const f32x4 y = *(const LAS f32x4*)(Ys + (rh * 8 + i) * 256 + k); acc[i] += y.x * w0 + y.y * w1 + y.z * w2 + y.w * w3; }
        }
#pragma unroll
        for (int i = 0; i < 8; ++i) { const int m = r0 + rh * 8 + i; MIX[(size_t)m * DM + 512 + c] = (bf16)f2bf(acc[i] * bf2f(GC[(size_t)m * 256 + c])); }
    }
    __syncthreads();
}

template <int MODE> __device__ __forceinline__ void hgrn_item(const Ctx& C, int l, int item) {
    const CAS Args& A = *C.a; const int lane = C.lane;
    const float* LF = C.ws<float>(WS_LF); const bf16 *QD = C.ws<bf16>(WS_QD), *KD = C.ws<bf16>(WS_KD), *VD = C.ws<bf16>(WS_VD), *GD = C.ws<bf16>(WS_GD); bf16* MIX = C.ws<bf16>(WS_MIX);
    LAS float* Fs = (LAS float*)(C.lds + C.wave * 12288); LAS float* Ks = Fs + 1024; LAS float* Qs = Fs + 2048;
    int h, m0, ntok; size_t sidx;
    if (MODE == 2) { const int bs = item >> 2; h = item & 3; m0 = MP + bs * 8; ntok = 8; sidx = ((size_t)(l * NBS + bs) * 4 + h) * 4096; }
    else { const int bh = item >> 7, j = item & 127; h = bh & 3; m0 = (bh >> 2) * TSEQ + j * HG_L; ntok = HG_L; sidx = (size_t)item * 4096; }
    float S[64];
    if (MODE == 0) {
#pragma unroll
        for (int k = 0; k < 64; ++k) S[k] = 0.f;
    } else { const float* s0 = MODE == 2 ? A.in[I_SHGRN] + sidx : C.ws<float>(WS_SST) + sidx;
#pragma unroll
        for (int k = 0; k < 64; ++k) S[k] = s0[k * 64 + lane]; }
    const float gn = A.in[I_HNG][l * 64 + lane];
    float lfsum = 0.f;
    for (int c0 = 0; c0 < ntok; c0 += 16) {
        const int nt = (ntok - c0) < 16 ? (ntok - c0) : 16;
        for (int tt = 0; tt < nt; ++tt) { const size_t o = (size_t)(m0 + c0 + tt) * 256 + h * 64 + lane; const float lf = LF[o]; lfsum += lf;
            Fs[tt * 64 + lane] = __expf(lf); Ks[tt * 64 + lane] = bf2f(KD[o]); if (MODE != 0) Qs[tt * 64 + lane] = bf2f(QD[o]); }
        LDS_WAIT();
#pragma unroll 1
        for (int tt = 0; tt < nt; ++tt) {
            const int m = m0 + c0 + tt; const size_t o = (size_t)m * 256 + h * 64 + lane;
            const float vd = bf2f(VD[o]); float oacc = 0.f;
#pragma unroll
            for (int k4 = 0; k4 < 16; ++k4) {
                const f32x4 f = *(const LAS f32x4*)(Fs + tt * 64 + 4 * k4), kd = *(const LAS f32x4*)(Ks + tt * 64 + 4 * k4);
                S[4 * k4 + 0] = f.x * S[4 * k4 + 0] + kd.x * vd; S[4 * k4 + 1] = f.y * S[4 * k4 + 1] + kd.y * vd;
                S[4 * k4 + 2] = f.z * S[4 * k4 + 2] + kd.z * vd; S[4 * k4 + 3] = f.w * S[4 * k4 + 3] + kd.w * vd;
                if (MODE != 0) { const f32x4 q = *(const LAS f32x4*)(Qs + tt * 64 + 4 * k4);
                    oacc += S[4 * k4 + 0] * q.x + S[4 * k4 + 1] * q.y + S[4 * k4 + 2] * q.z + S[4 * k4 + 3] * q.w; }
            }
            if (MODE != 0) { const float ss = wave_sum(oacc * oacc) * (1.f / 64.f);
                const float on = oacc * rsqrtf(ss + EPS) * gn * bf2f(GD[o]);
                MIX[(size_t)m * DM + 768 + h * 64 + lane] = (bf16)f2bf(on); }
        }
        LDS_WAIT();
    }
    if (MODE == 0) { float* sl = C.ws<float>(WS_SLOC) + sidx;
#pragma unroll
        for (int k = 0; k < 64; ++k) sl[k * 64 + lane] = S[k];
        C.ws<float>(WS_DTOT)[(size_t)item * 64 + lane] = __expf(lfsum); }
    if (MODE == 2) { float* so = A.out + O_HS + sidx;
#pragma unroll
        for (int k = 0; k < 64; ++k) so[k * 64 + lane] = S[k]; }
}
__device__ __forceinline__ void hgrn_scan_unit(const Ctx& C, int l, int u) {
    const int seg = C.tid >> 6, kvl = C.tid & 63, bh = u >> 6, kv = (u & 63) * 64 + kvl, k = kv >> 6;
    const float* sl = C.ws<float>(WS_SLOC) + ((size_t)bh * HG_NB + seg * 16) * 4096 + kv; float* ss = C.ws<float>(WS_SST) + ((size_t)bh * HG_NB + seg * 16) * 4096 + kv;
    const float* dt = C.ws<float>(WS_DTOT) + ((size_t)bh * HG_NB + seg * 16) * 64 + k;
    LAS f32x2v* X = (LAS f32x2v*)C.lds;
    float a[16], d[16];
#pragma unroll
    for (int j = 0; j < 16; ++j) { a[j] = sl[(size_t)j * 4096]; d[j] = dt[j * 64]; }
    float D = 1.f, Acc = 0.f;
#pragma unroll
    for (int j = 0; j < 16; ++j) { Acc = d[j] * Acc + a[j]; D *= d[j]; }
    X[seg * 64 + kvl] = (f32x2v){D, Acc};
    __syncthreads();
    float S = 0.f;
    for (int q = 0; q < seg; ++q) { const f32x2v x = X[q * 64 + kvl]; S = x.x * S + x.y; }
#pragma unroll
    for (int j = 0; j < 16; ++j) { ss[(size_t)j * 4096] = S; S = d[j] * S + a[j]; }
    if (seg == 7) C.a->out[O_HP + ((size_t)l * 8 + bh) * 4096 + kv] = S;
    __syncthreads();
}

__device__ __forceinline__ void attn_unit_naive(const Ctx& C, int l, int u) {
    const CAS Args& A = *C.a; const bf16 *Qb = C.ws<bf16>(WS_Q), *Kb = C.ws<bf16>(WS_KR), *Vb = C.ws<bf16>(WS_VR), *GA = C.ws<bf16>(WS_GA); bf16* MIX = C.ws<bf16>(WS_MIX);
    const int bh = u & 7, qb = 31 - (u >> 3), b = bh >> 2, h = bh & 3;
    const int map = C.tid >> 8, qi = C.tid & 255, t = qb * 256 + qi; const size_t m = (size_t)b * TSEQ + t;
    LAS unsigned* Ksm = (LAS unsigned*)C.lds;
    LAS unsigned* Vsm = (LAS unsigned*)(C.lds + 32768);
    LAS float* O2 = (LAS float*)C.lds;
    float q[32], acc[64];
    { const v4u* qp = (const v4u*)(Qb + m * 256 + h * 64 + map * 32);
#pragma unroll
        for (int i = 0; i < 4; ++i) { const v4u w = qp[i]; q[8 * i] = bflo(w.x); q[8 * i + 1] = bfhi(w.x); q[8 * i + 2] = bflo(w.y); q[8 * i + 3] = bfhi(w.y); q[8 * i + 4] = bflo(w.z); q[8 * i + 5] = bfhi(w.z); q[8 * i + 6] = bflo(w.w); q[8 * i + 7] = bfhi(w.w); } }
#pragma unroll
    for (int d = 0; d < 64; ++d) acc[d] = 0.f;
    float mx = -1e30f, lsum = 0.f;
    for (int kt = 0; kt <= qb; ++kt) {
        __syncthreads();
        for (int p = C.tid; p < 4096; p += NTHR) { const int arr = p >> 11, row = (p >> 3) & 255, pc = p & 7;
            const bf16* src = (arr ? Vb : Kb) + ((size_t)b * TSEQ + kt * 256 + row) * 256 + h * 64 + pc * 8;
            *(LAS v4u*)((arr ? Vsm : Ksm) + row * 32 + pc * 4) = *(const v4u*)src; }
        __syncthreads();
        const int jn = (kt == qb) ? 256 : 256;
#pragma unroll 1
        for (int j = 0; j < jn; ++j) {
            if (kt * 256 + j > t) break;
            const LAS v4u* kp = (const LAS v4u*)(Ksm + j * 32 + map * 16);
            float s = 0.f;
#pragma unroll
            for (int i = 0; i < 4; ++i) { const v4u w = kp[i];
                s += q[8 * i] * bflo(w.x) + q[8 * i + 1] * bfhi(w.x) + q[8 * i + 2] * bflo(w.y) + q[8 * i + 3] * bfhi(w.y) + q[8 * i + 4] * bflo(w.z) + q[8 * i + 5] * bfhi(w.z) + q[8 * i + 6] * bflo(w.w) + q[8 * i + 7] * bfhi(w.w); }
            if (s > mx) { const float sc = exp2f(mx - s); lsum *= sc;
#pragma unroll
                for (int d = 0; d < 64; ++d) acc[d] *= sc;
                mx = s; }
            const float p = exp2f(s - mx); lsum += p;
            const LAS v4u* vp = (const LAS v4u*)(Vsm + j * 32);
#pragma unroll
            for (int i = 0; i < 8; ++i) { const v4u w = vp[i];
                acc[8 * i] += p * bflo(w.x); acc[8 * i + 1] += p * bfhi(w.x); acc[8 * i + 2] += p * bflo(w.y); acc[8 * i + 3] += p * bfhi(w.y);
                acc[8 * i + 4] += p * bflo(w.z); acc[8 * i + 5] += p * bfhi(w.z); acc[8 * i + 6] += p * bflo(w.w); acc[8 * i + 7] += p * bfhi(w.w); }
        }
    }
    __syncthreads();
    const float il = 1.f / lsum;
    if (map == 1) {
#pragma unroll
        for (int d = 0; d < 64; ++d) O2[qi * 65 + d] = acc[d] * il;
    }
    __syncthreads();
    if (map == 0) {
        const float lam = C.ws<float>(WS_SCAL)[l]; const float lam_init = l == 0 ? 0.2f : 0.35550906759096934f;
        float ss = 0.f;
#pragma unroll
        for (int d = 0; d < 64; ++d) { acc[d] = acc[d] * il - lam * O2[qi * 65 + d]; ss += acc[d] * acc[d]; }
        const float rs = rsqrtf(ss * (1.f / 64.f) + EPS) * (1.f - lam_init);
        const float* g = A.in[I_ANG] + l * 64;
#pragma unroll
        for (int d = 0; d < 64; d += 2) { const unsigned ga = *(const unsigned*)(GA + m * 256 + h * 64 + d);
            *(unsigned*)(MIX + m * DM + h * 64 + d) = pk2(acc[d] * rs * g[d] * bflo(ga), acc[d + 1] * rs * g[d + 1] * bfhi(ga)); }
    }
    __syncthreads();
}

namespace fa {
typedef float f32x16 __attribute__((ext_vector_type(16)));
typedef short bf16x8 __attribute__((ext_vector_type(8)));
typedef short s16x4 __attribute__((ext_vector_type(4)));
typedef short v4i16_t __attribute__((ext_vector_type(4)));
typedef float f32x2_t __attribute__((ext_vector_type(2))); typedef __bf16 bf16x2_t __attribute__((ext_vector_type(2)));
constexpr int SLOT = 16384;
constexpr int LDS_WSF = 65536;
constexpr int LDS_EX = 65536 + 4096;
constexpr float THR = 32.f;
__device__ __forceinline__ float max3f(float a, float b, float c) { return __builtin_fmaxf(__builtin_fmaxf(a, b), c); }
__device__ __forceinline__ unsigned cvtpk(float lo, float hi) { f32x2_t v = {lo, hi}; bf16x2_t b = __builtin_convertvector(v, bf16x2_t); return __builtin_bit_cast(unsigned, b); }
__device__ __forceinline__ float half_swap_max(float m) { auto rr = __builtin_amdgcn_permlane32_swap(__float_as_uint(m), __float_as_uint(m), false, false); return __builtin_fmaxf(__uint_as_float(rr[0]), __uint_as_float(rr[1])); }
__device__ __forceinline__ float half_swap_sum(float m) { auto rr = __builtin_amdgcn_permlane32_swap(__float_as_uint(m), __float_as_uint(m), false, false); return __uint_as_float(rr[0]) + __uint_as_float(rr[1]); }
__device__ __forceinline__ float rowmax(const f32x16& p0, const f32x16& p1) {
    float a = max3f(p0[0], p0[1], p1[0]), b = max3f(p0[2], p0[3], p1[1]); a = max3f(a, p1[2], p1[3]);
#pragma unroll
    for (int r = 4; r < 16; r += 4) { a = max3f(a, p0[r], p0[r + 1]); b = max3f(b, p0[r + 2], p0[r + 3]); a = max3f(a, p1[r], p1[r + 1]); b = max3f(b, p1[r + 2], p1[r + 3]); }
    return half_swap_max(__builtin_fmaxf(a, b));
}
__device__ __forceinline__ s16x4 vtr(const LAS unsigned char* p) { return __builtin_bit_cast(s16x4, __builtin_amdgcn_ds_read_tr16_b64_v4i16((LAS v4i16_t*)p)); }
__device__ __forceinline__ void softmax_step(const bool FIRST, f32x16& S0, f32x16& S1, float& m, float& lsum, f32x16 (&O)[2], LAS float* wsf, int r32, int hi, bf16x8 (&pk)[4]) {
    const float rm = rowmax(S0, S1);
    if (FIRST) m = (rm != -INFINITY && fabsf(rm) > THR) ? rm : 0.f;
    else if (__any(rm - m > THR)) {
        const float mn = __builtin_fmaxf(m, rm); const float f = __builtin_amdgcn_exp2f(m - mn); m = mn; lsum *= f;
        if (hi == 0) wsf[r32] = f;
        LDS_WAIT();
#pragma unroll
        for (int g = 0; g < 4; ++g) { const f32x4 fv = *(const LAS f32x4*)(wsf + 8 * g + 4 * hi);
#pragma unroll
            for (int j = 0; j < 4; ++j) { O[0][4 * g + j] *= fv[j]; O[1][4 * g + j] *= fv[j]; } }
        LDS_WAIT();
    }
    float s = 0.f;
    if (__all(m == 0.f)) {
#pragma unroll
        for (int r = 0; r < 16; ++r) { S0[r] = __builtin_amdgcn_exp2f(S0[r]); S1[r] = __builtin_amdgcn_exp2f(S1[r]); s += S0[r] + S1[r]; }
    } else {
#pragma unroll
        for (int r = 0; r < 16; ++r) { S0[r] = __builtin_amdgcn_exp2f(S0[r] - m); S1[r] = __builtin_amdgcn_exp2f(S1[r] - m); s += S0[r] + S1[r]; }
    }
    lsum += s;
    v4u w;
    w.x = cvtpk(S0[0], S0[1]); w.y = cvtpk(S0[2], S0[3]); w.z = cvtpk(S0[4], S0[5]); w.w = cvtpk(S0[6], S0[7]); pk[0] = __builtin_bit_cast(bf16x8, w);
    w.x = cvtpk(S0[8], S0[9]); w.y = cvtpk(S0[10], S0[11]); w.z = cvtpk(S0[12], S0[13]); w.w = cvtpk(S0[14], S0[15]); pk[1] = __builtin_bit_cast(bf16x8, w);
    w.x = cvtpk(S1[0], S1[1]); w.y = cvtpk(S1[2], S1[3]); w.z = cvtpk(S1[4], S1[5]); w.w = cvtpk(S1[6], S1[7]); pk[2] = __builtin_bit_cast(bf16x8, w);
    w.x = cvtpk(S1[8], S1[9]); w.y = cvtpk(S1[10], S1[11]); w.z = cvtpk(S1[12], S1[13]); w.w = cvtpk(S1[14], S1[15]); pk[3] = __builtin_bit_cast(bf16x8, w);
}
__device__ __forceinline__ void cmask(f32x16& p0, f32x16& p1, int krel0, int qrel, int hi) {
    asm volatile("" : "+v"(hi), "+v"(qrel));
#pragma unroll
    for (int r = 0; r < 16; ++r) { const int kv = krel0 + 4 * hi + (r & 3) + 8 * (r >> 2); if (kv > qrel) p0[r] = -INFINITY; if (kv + 32 > qrel) p1[r] = -INFINITY; }
}
#define FA_MFMA(a, b, c) __builtin_amdgcn_mfma_f32_32x32x16_bf16((a), (b), (c), 0, 0, 0)
__device__ __forceinline__ void tile_step(const bool FIRST, const LAS unsigned char* slot, const bf16x8 (&qr)[4], bool band, int krel0, int qrel, int r32, int hi, int lane,
        float& m_a, float& l_a, f32x16 (&Oa)[2], float& m_b, float& l_b, f32x16 (&Ob)[2], LAS float* wsf, const bf16* Kg, const bf16* Vg) {
#if MK_CHECK == 2
    const bf16* kp = Kg + (size_t)r32 * 256 + hi * 8;
#define KFR(off) (*(const bf16x8*)(kp + ((off) >> 10 >> 1) * 16 + (((off) >> 9) & 1) * 32 * 256))
#else
    const LAS unsigned char* kp = slot + hi * 1024 + r32 * 16;
#define KFR(off) (*(const LAS bf16x8*)(kp + (off)))
#endif
    bf16x8 pa[4], pb[4];
    {   f32x16 S0, S1;
        const bf16x8 k00 = KFR(0), k01 = KFR(512), k10 = KFR(2048), k11 = KFR(2048 + 512);
        S0 = FA_MFMA(k00, qr[0], (f32x16{})); S1 = FA_MFMA(k01, qr[0], (f32x16{})); S0 = FA_MFMA(k10, qr[1], S0); S1 = FA_MFMA(k11, qr[1], S1);
        if (band) cmask(S0, S1, krel0, qrel, hi);
        softmax_step(FIRST, S0, S1, m_a, l_a, Oa, wsf, r32, hi, pa);
    }
    asm volatile("" ::: "memory");
    {   f32x16 S0, S1;
        const bf16x8 k00 = KFR(4096), k01 = KFR(4096 + 512), k10 = KFR(6144), k11 = KFR(6144 + 512);
        S0 = FA_MFMA(k00, qr[2], (f32x16{})); S1 = FA_MFMA(k01, qr[2], (f32x16{})); S0 = FA_MFMA(k10, qr[3], S0); S1 = FA_MFMA(k11, qr[3], S1);
        if (band) cmask(S0, S1, krel0, qrel, hi);
        softmax_step(FIRST, S0, S1, m_b, l_b, Ob, wsf + 64, r32, hi, pb);
    }
    asm volatile("" ::: "memory");
    const LAS unsigned char* vp = slot + 8192 + ((lane >> 4) & 1) * 32 + (lane & 3) * 8 + (4 * hi + ((lane & 15) >> 2)) * 64;
#pragma unroll
    for (int d0 = 0; d0 < 2; ++d0)
#pragma unroll
        for (int ks = 0; ks < 4; ++ks) {
#if MK_CHECK == 2
            bf16x8 vf;
#pragma unroll
            for (int j = 0; j < 8; ++j) vf[j] = (short)Vg[(size_t)(16 * ks + 8 * (j >> 2) + 4 * hi + (j & 3)) * 256 + 32 * d0 + r32];
#else
            const s16x4 lo = vtr(vp + d0 * 4096 + ks * 1024), hh = vtr(vp + d0 * 4096 + ks * 1024 + 512);
            const bf16x8 vf = (bf16x8){lo[0], lo[1], lo[2], lo[3], hh[0], hh[1], hh[2], hh[3]};
#endif
            Oa[d0] = FA_MFMA(pa[ks], vf, Oa[d0]); Ob[d0] = FA_MFMA(pb[ks], vf, Ob[d0]);
            if (ks == 3) asm volatile("" ::: "memory");
        }
#undef KFR
}
#define FA_WAITBAR() do { asm volatile("s_waitcnt vmcnt(0) lgkmcnt(0)" ::: "memory"); __builtin_amdgcn_s_barrier(); asm volatile("" ::: "memory"); } while (0)

__device__ __forceinline__ void unit(const Ctx& C, int l, int bh, int y, bf16* MIX) {
    int lane = C.lane; asm volatile("" : "+v"(lane));
    const int wid = C.wave, r32 = lane & 31, hi = lane >> 5, half = wid >> 2, wq = wid & 3;
    const int b = bh >> 2, h = bh & 3; const int q0 = 128 * y, qrel = 32 * wq + r32;
    const size_t rowbase = (size_t)b * TSEQ;
    const bf16* Qw = C.ws<bf16>(WS_Q) + (rowbase + q0 + qrel) * 256 + h * 64;
    const unsigned char* KT = C.ws<unsigned char>(WS_KT) + (size_t)bh * 128 * 8192 + wid * 1024 + lane * 16;
    const unsigned char* VT = C.ws<unsigned char>(WS_VT) + (size_t)bh * 128 * 8192 + wid * 1024 + lane * 16;
    LAS unsigned char* lds = C.lds; LAS float* wsf = (LAS float*)(lds + LDS_WSF) + wid * 128;
    bf16x8 qr[4];
#pragma unroll
    for (int d0 = 0; d0 < 4; ++d0) qr[d0] = *(const bf16x8*)(Qw + d0 * 16 + hi * 8);
    const int nsteps = y + 1;
#define FA_DMA(i) do { _Pragma("unroll") for (int hf_ = 0; hf_ < 2; ++hf_) { const int t_ = 2 * (i) + hf_; LAS unsigned char* d_ = lds + ((((i) & 1) * 2 + hf_) * SLOT) + wid * 1024; \
        __builtin_amdgcn_global_load_lds((const unsigned*)(KT + (size_t)t_ * 8192), (LAS unsigned*)d_, 16, 0, 0); \
        __builtin_amdgcn_global_load_lds((const unsigned*)(VT + (size_t)t_ * 8192), (LAS unsigned*)(d_ + 8192), 16, 0, 0); } } while (0)
    float m_a = 0.f, l_a = 0.f, m_b = 0.f, l_b = 0.f; f32x16 Oa[2], Ob[2];
    Oa[0] = f32x16{}; Oa[1] = f32x16{}; Ob[0] = f32x16{}; Ob[1] = f32x16{};
    FA_DMA(0);
    FA_WAITBAR();
#pragma unroll 1
    for (int i = 0; i < nsteps; ++i) {
        if (i + 1 < nsteps) FA_DMA(i + 1);
        const int t = 2 * i + half; const bool band = t >= 2 * y;
        tile_step(i == 0, lds + ((i & 1) * 2 + half) * SLOT, qr, band, 64 * (t - 2 * y), qrel, r32, hi, lane, m_a, l_a, Oa, m_b, l_b, Ob, wsf,
                  C.ws<bf16>(WS_KR) + (rowbase + (size_t)t * 64) * 256 + h * 64, C.ws<bf16>(WS_VR) + (rowbase + (size_t)t * 64) * 256 + h * 64);
        FA_WAITBAR();
    }
    l_a = half_swap_sum(l_a); l_b = half_swap_sum(l_b);
    LAS f32x4* EX = (LAS f32x4*)(lds + LDS_EX);
    if (hi == 0) EX[wid * 32 + r32] = (f32x4){m_a, l_a, m_b, l_b};
    FA_WAITBAR();
    {   const f32x4 o = EX[(wid ^ 4) * 32 + r32];
        const float lam = C.ws<float>(WS_SCAL)[l];
        const float Ma = __builtin_fmaxf(m_a, o.x), fa_ = __builtin_amdgcn_exp2f(m_a - Ma), fa2 = __builtin_amdgcn_exp2f(o.x - Ma); const float ca = fa_ / (l_a * fa_ + o.y * fa2);
        const float Mb = __builtin_fmaxf(m_b, o.z), fb_ = __builtin_amdgcn_exp2f(m_b - Mb), fb2 = __builtin_amdgcn_exp2f(o.z - Mb); const float cb = -lam * fb_ / (l_b * fb_ + o.w * fb2);
        if (hi == 0) { wsf[r32] = ca; wsf[64 + r32] = cb; }
        LDS_WAIT();
    }
    f32x16 part[2];
#pragma unroll
    for (int g = 0; g < 4; ++g) { const f32x4 fa4 = *(const LAS f32x4*)(wsf + 8 * g + 4 * hi), fb4 = *(const LAS f32x4*)(wsf + 64 + 8 * g + 4 * hi);
#pragma unroll
        for (int j = 0; j < 4; ++j) { part[0][4 * g + j] = Oa[0][4 * g + j] * fa4[j] + Ob[0][4 * g + j] * fb4[j]; part[1][4 * g + j] = Oa[1][4 * g + j] * fa4[j] + Ob[1][4 * g + j] * fb4[j]; } }
    LAS float* XO = (LAS float*)lds + wq * 2048;
    if (half == 1) {
#pragma unroll
        for (int r = 0; r < 16; ++r) { XO[r * 64 + lane] = part[0][r]; XO[(16 + r) * 64 + lane] = part[1][r]; }
    }
    FA_WAITBAR();
    if (half == 0) {
        const float lam_init = l == 0 ? 0.2f : 0.35550906759096934f;
        float ss[16];
#pragma unroll
        for (int r = 0; r < 16; ++r) { part[0][r] += XO[r * 64 + lane]; part[1][r] += XO[(16 + r) * 64 + lane]; ss[r] = part[0][r] * part[0][r] + part[1][r] * part[1][r]; }
#pragma unroll
        for (int r = 0; r < 16; ++r) { ss[r] = sx_sum<1>(ss[r]); ss[r] = sx_sum<2>(ss[r]); ss[r] = sx_sum<4>(ss[r]); ss[r] = sx_sum<8>(ss[r]); ss[r] = sx_sum<16>(ss[r]); }
        const float* g = C.a->in[I_ANG] + l * 64; const float g0 = g[r32], g1 = g[32 + r32];
        const bf16* GA = C.ws<bf16>(WS_GA);
        bf16 ga0[16], ga1[16];
#pragma unroll
        for (int r = 0; r < 16; ++r) { const size_t row = rowbase + q0 + 32 * wq + (r & 3) + 8 * (r >> 2) + 4 * hi; ga0[r] = GA[row * 256 + h * 64 + r32]; ga1[r] = GA[row * 256 + h * 64 + 32 + r32]; }
#pragma unroll
        for (int r = 0; r < 16; ++r) { const size_t row = rowbase + q0 + 32 * wq + (r & 3) + 8 * (r >> 2) + 4 * hi;
            const float rs = rsqrtf(ss[r] * (1.f / 64.f) + EPS) * (1.f - lam_init);
            MIX[row * DM + h * 64 + r32] = (bf16)f2bf(part[0][r] * rs * g0 * bf2f(ga0[r]));
            MIX[row * DM + h * 64 + 32 + r32] = (bf16)f2bf(part[1][r] * rs * g1 * bf2f(ga1[r])); }
    }
    FA_WAITBAR();
#undef FA_DMA
}
}

namespace sgm {
using fa::f32x16; using fa::bf16x8;
constexpr int VT_STRIDE = 272;
__device__ __forceinline__ void unit(const Ctx& C, int l, int chunk, bf16* MIX) {
    const CAS Args& A = *C.a;
    int lane = C.lane; asm volatile("" : "+v"(lane));
    const int r32 = lane & 31, hi = lane >> 5, wid = C.wave, g = wid >> 1, th = wid & 1, tid = wid * 64 + lane;
    const bf16 *U = C.ws<bf16>(WS_U), *VN = C.ws<bf16>(WS_VN), *GB = C.ws<bf16>(WS_GB);
    const size_t m0 = (size_t)chunk * 128;
    LAS unsigned char* VT = C.lds;
    {
        const f32x4 gam = ld4(A.in[I_SGG] + l * 256 + 4 * lane), bet = ld4(A.in[I_SGB] + l * 256 + 4 * lane);
        v2u raw[16];
#pragma unroll
        for (int i = 0; i < 16; ++i) raw[i] = *(const v2u*)(VN + (m0 + wid * 16 + i) * 256 + 4 * lane);
#pragma unroll
        for (int i = 0; i < 16; ++i) { const int s_ = wid * 16 + i; const f32x4 v = (f32x4){bflo(raw[i].x), bfhi(raw[i].x), bflo(raw[i].y), bfhi(raw[i].y)};
            const float mean = wave_sum((v.x + v.y) + (v.z + v.w)) * (1.f / 256.f); const f32x4 d = v - mean;
            const float var = wave_sum((d.x * d.x + d.y * d.y) + (d.z * d.z + d.w * d.w)) * (1.f / 256.f);
            const f32x4 y = d * rsqrtf(var + EPS) * gam + bet;
            LAS unsigned char* p = VT + (4 * lane) * VT_STRIDE + s_ * 2;
            *(LAS unsigned short*)(p) = (unsigned short)f2bf(y.x); *(LAS unsigned short*)(p + VT_STRIDE) = (unsigned short)f2bf(y.y);
            *(LAS unsigned short*)(p + 2 * VT_STRIDE) = (unsigned short)f2bf(y.z); *(LAS unsigned short*)(p + 3 * VT_STRIDE) = (unsigned short)f2bf(y.w); }
    }
    __syncthreads();
    const bf16* Wm = C.ws<bf16>(WS_WSB) + (size_t)(l * 4 + g) * 128 * 128;
    f32x16 acc[2][2];
#pragma unroll
    for (int a = 0; a < 2; ++a) { acc[a][0] = f32x16{}; acc[a][1] = f32x16{}; }
#pragma unroll
    for (int tbi = 0; tbi < 2; ++tbi) {
        const int tb = 2 * th + tbi; const bf16* wrow = Wm + (size_t)(tb * 32 + r32) * 128 + 8 * hi;
        const LAS unsigned char* vb = VT + (g * 64 + r32) * VT_STRIDE + 16 * hi;
        bf16x8 af[8];
#pragma unroll
        for (int ks = 0; ks < 8; ++ks) af[ks] = *(const bf16x8*)(wrow + 16 * ks);
#pragma unroll
        for (int ks = 0; ks < 8; ++ks) { if (ks < 2 * (tb + 1)) {
            const bf16x8 b0 = *(const LAS bf16x8*)(vb + 32 * ks), b1 = *(const LAS bf16x8*)(vb + 32 * VT_STRIDE + 32 * ks);
            acc[tbi][0] = FA_MFMA(af[ks], b0, acc[tbi][0]); acc[tbi][1] = FA_MFMA(af[ks], b1, acc[tbi][1]); } }
    }
    const float* bsv = A.in[I_BS] + (l * 4 + g) * 128;
#pragma unroll
    for (int tbi = 0; tbi < 2; ++tbi)
#pragma unroll
        for (int rh = 0; rh < 2; ++rh) {
            bf16 uu[8][2], gg[8][2]; float bias[8];
#pragma unroll
            for (int q = 0; q < 8; ++q) { const int r = 8 * rh + q, t = (2 * th + tbi) * 32 + (r & 3) + 8 * (r >> 2) + 4 * hi; bias[q] = bsv[t];
#pragma unroll
                for (int d0 = 0; d0 < 2; ++d0) { const size_t mo = (m0 + t) * 256 + g * 64 + 32 * d0 + r32; uu[q][d0] = U[mo]; gg[q][d0] = GB[mo]; } }
#pragma unroll
            for (int q = 0; q < 8; ++q) { const int r = 8 * rh + q, t = (2 * th + tbi) * 32 + (r & 3) + 8 * (r >> 2) + 4 * hi;
#pragma unroll
                for (int d0 = 0; d0 < 2; ++d0) { const int col = g * 64 + 32 * d0 + r32;
                    MIX[(m0 + t) * DM + 256 + col] = (bf16)f2bf(bf2f(uu[q][d0]) * (acc[tbi][d0][r] + bias[q]) * bf2f(gg[q][d0])); } } }
    __syncthreads();
}
}

namespace cvm {
using fa::f32x16; using fa::bf16x8;
constexpr int Y_OFF = 0, YN_OFF = 65536, YN_STRIDE = 528;
__device__ __forceinline__ void unit(const Ctx& C, int l, int u, bf16* MIX) {
    const CAS Args& A = *C.a;
    int lane = C.lane; asm volatile("" : "+v"(lane));
    const int wid = C.wave, tid = wid * 64 + lane, r32 = lane & 31, hi = lane >> 5;
    const float* GLU = C.ws<float>(WS_GLU); const bf16* GC = C.ws<bf16>(WS_GC);
    LAS float* Y = (LAS float*)(C.lds + Y_OFF); LAS unsigned char* YN = C.lds + YN_OFF;
    const int r0 = u * 64; const bool samp = r0 >= MP;
    {
        const int c = tid & 255, half = tid >> 8;
        float cw[31];
#pragma unroll
        for (int j = 0; j < 31; ++j) cw[j] = A.in[I_CW][(size_t)(l * 31 + j) * 256 + c];
        const float cb = A.in[I_CB][l * 256 + c];
        if (!samp) {
            const int rg = half * 32, m = r0 + rg, t0 = m & (TSEQ - 1);
            float in[62];
#pragma unroll
            for (int k = 0; k < 62; ++k) { const int tt = t0 - 30 + k; in[k] = tt >= 0 ? GLU[(size_t)(m - 30 + k) * 256 + c] : 0.f; }
#pragma unroll
            for (int i = 0; i < 32; ++i) { float y = cb;
#pragma unroll
                for (int j = 0; j < 31; ++j) y += cw[j] * in[i + j];
                Y[(rg + i) * 256 + c] = y; }
        } else {
#pragma unroll 1
            for (int gq = 0; gq < 4; ++gq) {
                const int rg = half * 32 + gq * 8, m = r0 + rg;
                float in[38];
                const int bs = (m - MP) >> 3; const float* sc = A.in[I_SCONV] + (size_t)(l * NBS + bs) * 30 * 256 + c;
#pragma unroll
                for (int k = 0; k < 30; ++k) in[k] = sc[k * 256];
#pragma unroll
                for (int k = 0; k < 8; ++k) in[30 + k] = GLU[(size_t)(m + k) * 256 + c];
#pragma unroll
                for (int i = 0; i < 8; ++i) { float y = cb;
#pragma unroll
                    for (int j = 0; j < 31; ++j) y += cw[j] * in[i + j];
                    Y[(rg + i) * 256 + c] = y; }
            }
        }
    }
    __syncthreads();
    {
        const f32x4 g = ld4(A.in[I_CNG] + l * 256 + 4 * lane), b = ld4(A.in[I_CNB] + l * 256 + 4 * lane);
#pragma unroll
        for (int i4 = 0; i4 < 2; ++i4) { f32x4 v[4]; float sm[4], sq[4];
#pragma unroll
            for (int i = 0; i < 4; ++i) { v[i] = *(const LAS f32x4*)(Y + (wid * 8 + i4 * 4 + i) * 256 + 4 * lane); sm[i] = (v[i].x + v[i].y) + (v[i].z + v[i].w); }
#pragma unroll
            for (int i = 0; i < 4; ++i) sm[i] = sx_sum<1>(sm[i]);
#pragma unroll
            for (int i = 0; i < 4; ++i) sm[i] = sx_sum<2>(sm[i]);
#pragma unroll
            for (int i = 0; i < 4; ++i) sm[i] = sx_sum<4>(sm[i]);
#pragma unroll
            for (int i = 0; i < 4; ++i) sm[i] = sx_sum<8>(sm[i]);
#pragma unroll
            for (int i = 0; i < 4; ++i) sm[i] = sx_sum<16>(sm[i]);
#pragma unroll
            for (int i = 0; i < 4; ++i) { sm[i] = sx_sum<32>(sm[i]) * (1.f / 256.f); v[i] = v[i] - sm[i]; sq[i] = (v[i].x * v[i].x + v[i].y * v[i].y) + (v[i].z * v[i].z + v[i].w * v[i].w); }
#pragma unroll
            for (int i = 0; i < 4; ++i) sq[i] = sx_sum<1>(sq[i]);
#pragma unroll
            for (int i = 0; i < 4; ++i) sq[i] = sx_sum<2>(sq[i]);
#pragma unroll
            for (int i = 0; i < 4; ++i) sq[i] = sx_sum<4>(sq[i]);
#pragma unroll
            for (int i = 0; i < 4; ++i) sq[i] = sx_sum<8>(sq[i]);
#pragma unroll
            for (int i = 0; i < 4; ++i) sq[i] = sx_sum<16>(sq[i]);
#pragma unroll
            for (int i = 0; i < 4; ++i) { const float var = sx_sum<32>(sq[i]) * (1.f / 256.f); f32x4 y = v[i] * rsqrtf(var + EPS) * g + b; y = (f32x4){silu_f(y.x), silu_f(y.y), silu_f(y.z), silu_f(y.w)};
                v2u w; w.x = pk2(y.x, y.y); w.y = pk2(y.z, y.w); *(LAS v2u*)(YN + (wid * 8 + i4 * 4 + i) * YN_STRIDE + 8 * lane) = w; } }
    }
    __syncthreads();
    {
        const int rb = wid & 1, cq = wid >> 1;
        const bf16* WT = C.ws<bf16>(WS_WPW) + (size_t)l * 256 * 256 + (size_t)(cq * 64 + r32) * 256 + 8 * hi;
        const LAS unsigned char* ya = YN + (rb * 32 + r32) * YN_STRIDE + 16 * hi;
        f32x16 acc0 = f32x16{}, acc1 = f32x16{};
        bf16 gc0[16], gc1[16];
#pragma unroll
        for (int r = 0; r < 16; ++r) { const size_t m = (size_t)r0 + rb * 32 + (r & 3) + 8 * (r >> 2) + 4 * hi; const int d = cq * 64 + r32; gc0[r] = GC[m * 256 + d]; gc1[r] = GC[m * 256 + d + 32]; }
#pragma unroll
        for (int kb = 0; kb < 2; ++kb) { bf16x8 b0[8], b1[8];
#pragma unroll
            for (int k8 = 0; k8 < 8; ++k8) { b0[k8] = *(const bf16x8*)(WT + 16 * (8 * kb + k8)); b1[k8] = *(const bf16x8*)(WT + 32 * 256 + 16 * (8 * kb + k8)); }
#pragma unroll
            for (int k8 = 0; k8 < 8; ++k8) { const bf16x8 af = *(const LAS bf16x8*)(ya + 32 * (8 * kb + k8)); acc0 = FA_MFMA(af, b0[k8], acc0); acc1 = FA_MFMA(af, b1[k8], acc1); } }
#pragma unroll
        for (int r = 0; r < 16; ++r) { const size_t m = (size_t)r0 + rb * 32 + (r & 3) + 8 * (r >> 2) + 4 * hi; const int d = cq * 64 + r32;
            MIX[m * DM + 512 + d] = (bf16)f2bf(acc0[r] * bf2f(gc0[r]));
            MIX[m * DM + 512 + d + 32] = (bf16)f2bf(acc1[r] * bf2f(gc1[r])); }
    }
    __syncthreads();
}
}

namespace hg {
typedef short bf16x8 __attribute__((ext_vector_type(8)));
#define HG_MFMA(a, b, c) __builtin_amdgcn_mfma_f32_16x16x32_bf16((a), (b), (c), 0, 0, 0)
constexpr int RS = 144;
constexpr int O_QE = 0, O_QM = 16 * RS, O_KM = 32 * RS, O_KET = 48 * RS, O_VT = O_KET + 2048, O_AS = O_VT + 2048, WAVE_LDS = 12288;
static_assert(O_AS + 256 <= WAVE_LDS, "hgrn lds");
__device__ __forceinline__ unsigned pk(float a, float b) { return fa::cvtpk(a, b); }
template <int MODE> __device__ __forceinline__ void item(const Ctx& C, int l, int it, bf16* MIX) {
    const CAS Args& A = *C.a;
    int lane = C.lane; asm volatile("" : "+v"(lane));
    const int col = lane & 15, g = lane >> 4;
    const float* LF = C.ws<float>(WS_LF); const bf16 *QD = C.ws<bf16>(WS_QD), *KD = C.ws<bf16>(WS_KD), *VD = C.ws<bf16>(WS_VD), *GD = C.ws<bf16>(WS_GD);
    LAS unsigned char* W = C.lds + C.wave * WAVE_LDS;
    int h, m0, nchunk, ntok; size_t sidx;
    if (MODE == 2) { const int bs = it >> 2; h = it & 3; m0 = MP + bs * 8; nchunk = 1; ntok = 8; sidx = ((size_t)(l * NBS + bs) * 4 + h) * 4096; }
    else { const int bh = it >> 7, j = it & 127; h = bh & 3; m0 = (bh >> 2) * TSEQ + j * HG_L; nchunk = HG_L / 16; ntok = 16; sidx = (size_t)it * 4096; }
    f32x4 S[4][4];
    if (MODE == 0) {
#pragma unroll
        for (int a = 0; a < 4; ++a)
#pragma unroll
            for (int b = 0; b < 4; ++b) S[a][b] = (f32x4){0.f, 0.f, 0.f, 0.f};
    } else { const float* s0 = (MODE == 2 ? A.in[I_SHGRN] : C.ws<float>(WS_SST)) + sidx + (size_t)(4 * g) * 64 + col;
#pragma unroll
        for (int a = 0; a < 4; ++a)
#pragma unroll
            for (int b = 0; b < 4; ++b) { const float* p = s0 + (size_t)(16 * a) * 64 + 16 * b; S[a][b] = (f32x4){p[0], p[64], p[128], p[192]}; } }
    unsigned z0 = 0u; asm volatile("" : "+v"(z0));
    float lftot = 0.f;
    float rlf[16]; unsigned rkq[16]; unsigned rvv[8];
#define HG_LOAD(ch_) do { const size_t o0_ = (size_t)(m0 + (ch_) * 16) * 256 + h * 64 + lane; \
        _Pragma("unroll") for (int t = 0; t < 16; ++t) { const bool ok = t < ntok; rlf[t] = ok ? LF[o0_ + (size_t)t * 256] : 0.f; \
            rkq[t] = ok ? ((unsigned)KD[o0_ + (size_t)t * 256] | (MODE != 0 ? ((unsigned)QD[o0_ + (size_t)t * 256] << 16) : 0u)) : 0u; } \
        _Pragma("unroll") for (int t = 0; t < 16; t += 2) { const unsigned a_ = t < ntok ? (unsigned)VD[o0_ + (size_t)t * 256] : z0, b_ = t + 1 < ntok ? (unsigned)VD[o0_ + (size_t)(t + 1) * 256] : z0; rvv[t >> 1] = a_ | (b_ << 16); } } while (0)
    HG_LOAD(0);
#pragma unroll 1
    for (int ch = 0; ch < nchunk; ++ch) {
        {
            float cum[16], kd[16], q[16]; unsigned vv[8];
#pragma unroll
            for (int t = 0; t < 16; ++t) { cum[t] = rlf[t]; kd[t] = bflo(rkq[t]); q[t] = bfhi(rkq[t]); }
#pragma unroll
            for (int t = 0; t < 8; ++t) vv[t] = rvv[t];
            if (ch + 1 < nchunk) HG_LOAD(ch + 1);
#pragma unroll
            for (int t = 1; t < 16; ++t) cum[t] += cum[t - 1];
            const float cL = cum[15], cm = cum[7]; lftot += cL;
            unsigned ke[8];
#pragma unroll
            for (int t = 0; t < 16; t += 2) ke[t >> 1] = pk(kd[t] * __expf(cL - cum[t]), kd[t + 1] * __expf(cL - cum[t + 1]));
            *(LAS v4u*)(W + O_KET + lane * 32) = (v4u){ke[0], ke[1], ke[2], ke[3]}; *(LAS v4u*)(W + O_KET + lane * 32 + 16) = (v4u){ke[4], ke[5], ke[6], ke[7]};
            *(LAS v4u*)(W + O_VT + lane * 32) = (v4u){vv[0], vv[1], vv[2], vv[3]}; *(LAS v4u*)(W + O_VT + lane * 32 + 16) = (v4u){vv[4], vv[5], vv[6], vv[7]};
            *(LAS float*)(W + O_AS + lane * 4) = __expf(cL);
            if (MODE != 0) {
#pragma unroll
                for (int t = 0; t < 16; ++t) {
                    *(LAS unsigned short*)(W + O_QE + t * RS + lane * 2) = (unsigned short)f2bf(q[t] * __expf(cum[t]));
                    *(LAS unsigned short*)(W + O_QM + t * RS + lane * 2) = (unsigned short)f2bf(q[t] * __expf(cum[t] - cm));
                    *(LAS unsigned short*)(W + O_KM + t * RS + lane * 2) = (unsigned short)f2bf(kd[t] * __expf(cm - cum[t])); }
            }
        }
        LDS_WAIT(); asm volatile("" ::: "memory");
        if (MODE != 0) {
            v2u gdr[4];
            { const size_t mg = ((size_t)m0 + ch * 16 + (col < ntok ? col : 0)) * 256 + h * 64 + 4 * g;
#pragma unroll
              for (int nb = 0; nb < 4; ++nb) gdr[nb] = *(const v2u*)(GD + mg + 16 * nb); }
            f32x4 OT[4];
#pragma unroll
            for (int nb = 0; nb < 4; ++nb) OT[nb] = (f32x4){0.f, 0.f, 0.f, 0.f};
#pragma unroll
            for (int ks = 0; ks < 2; ++ks) {
                const v2u q0 = *(const LAS v2u*)(W + O_QE + col * RS + (32 * ks + 4 * g) * 2), q1 = *(const LAS v2u*)(W + O_QE + col * RS + (32 * ks + 16 + 4 * g) * 2);
                const bf16x8 bq = __builtin_bit_cast(bf16x8, (v4u){q0.x, q0.y, q1.x, q1.y});
#pragma unroll
                for (int nb = 0; nb < 4; ++nb) { const f32x4 s0 = S[2 * ks][nb], s1 = S[2 * ks + 1][nb];
                    const bf16x8 as = __builtin_bit_cast(bf16x8, (v4u){pk(s0.x, s0.y), pk(s0.z, s0.w), pk(s1.x, s1.y), pk(s1.z, s1.w)});
                    OT[nb] = HG_MFMA(as, bq, OT[nb]); }
            }
            f32x4 at = (f32x4){0.f, 0.f, 0.f, 0.f};
#pragma unroll
            for (int ks = 0; ks < 2; ++ks) { const bf16x8 ak = *(const LAS bf16x8*)(W + O_KM + col * RS + (32 * ks + 8 * g) * 2), bq = *(const LAS bf16x8*)(W + O_QM + col * RS + (32 * ks + 8 * g) * 2);
                at = HG_MFMA(ak, bq, at); }
            { const int sb = 4 * g; if (sb + 0 > col) at.x = 0.f; if (sb + 1 > col) at.y = 0.f; if (sb + 2 > col) at.z = 0.f; if (sb + 3 > col) at.w = 0.f; }
            const bf16x8 batt = __builtin_bit_cast(bf16x8, (v4u){pk(at.x, at.y), pk(at.z, at.w), z0, z0});
#pragma unroll
            for (int nb = 0; nb < 4; ++nb) { const v2u v0 = *(const LAS v2u*)(W + O_VT + (16 * nb + col) * 32 + 8 * g);
                OT[nb] = HG_MFMA(__builtin_bit_cast(bf16x8, (v4u){v0.x, v0.y, z0, z0}), batt, OT[nb]); }
            float ss = 0.f;
#pragma unroll
            for (int nb = 0; nb < 4; ++nb) ss += (OT[nb].x * OT[nb].x + OT[nb].y * OT[nb].y) + (OT[nb].z * OT[nb].z + OT[nb].w * OT[nb].w);
            ss = sx_sum<16>(ss); ss = sx_sum<32>(ss);
            const float rs = rsqrtf(ss * (1.f / 64.f) + EPS);
            f32x4 gnv[4];
#pragma unroll
            for (int nb = 0; nb < 4; ++nb) gnv[nb] = ld4(A.in[I_HNG] + l * 64 + 16 * nb + 4 * g);
            if (col < ntok) { const size_t m = (size_t)m0 + ch * 16 + col;
#pragma unroll
                for (int nb = 0; nb < 4; ++nb) { const int v = 16 * nb + 4 * g; const f32x4 gn = gnv[nb]; const f32x4 gd = (f32x4){bflo(gdr[nb].x), bfhi(gdr[nb].x), bflo(gdr[nb].y), bfhi(gdr[nb].y)};
                    st_bf4(MIX + m * DM + 768 + h * 64 + v, OT[nb] * rs * gn * gd); } }
        }
        {   bf16x8 ak[4], bv[4];
#pragma unroll
            for (int b = 0; b < 4; ++b) { v4u x = *(const LAS v4u*)(W + O_KET + (16 * b + col) * 32 + 16 * (g & 1)), y = *(const LAS v4u*)(W + O_VT + (16 * b + col) * 32 + 16 * (g & 1));
                if (g >= 2) { x = (v4u){z0, z0, z0, z0}; y = x; } ak[b] = __builtin_bit_cast(bf16x8, x); bv[b] = __builtin_bit_cast(bf16x8, y); }
#pragma unroll
            for (int mb = 0; mb < 4; ++mb) { const f32x4 as = *(const LAS f32x4*)(W + O_AS + (16 * mb + 4 * g) * 4);
#pragma unroll
                for (int nb = 0; nb < 4; ++nb) S[mb][nb] = HG_MFMA(ak[mb], bv[nb], S[mb][nb] * as); }
        }
        LDS_WAIT(); asm volatile("" ::: "memory");
    }
    if (MODE == 0 || MODE == 2) { float* so = (MODE == 0 ? C.ws<float>(WS_SLOC) : A.out + O_HS) + sidx + (size_t)(4 * g) * 64 + col;
#pragma unroll
        for (int a = 0; a < 4; ++a)
#pragma unroll
            for (int b = 0; b < 4; ++b) { float* p = so + (size_t)(16 * a) * 64 + 16 * b; p[0] = S[a][b].x; p[64] = S[a][b].y; p[128] = S[a][b].z; p[192] = S[a][b].w; } }
    if (MODE == 0) C.ws<float>(WS_DTOT)[(size_t)it * 64 + lane] = __expf(lftot);
#undef HG_LOAD
}
}

namespace sa {
using fa::f32x16; using fa::bf16x8; using fa::cvtpk; using fa::max3f; using fa::half_swap_max; using fa::half_swap_sum;
constexpr float THR = 8.f;
__device__ __forceinline__ bf16x8 pack8(const f32x4& a, const f32x4& b) { v4u w; w.x = cvtpk(a.x, a.y); w.y = cvtpk(a.z, a.w); w.z = cvtpk(b.x, b.y); w.w = cvtpk(b.z, b.w); return __builtin_bit_cast(bf16x8, w); }
__device__ __forceinline__ bf16x8 pack8f(const float (&v)[8]) { v4u w; w.x = cvtpk(v[0], v[1]); w.y = cvtpk(v[2], v[3]); w.z = cvtpk(v[4], v[5]); w.w = cvtpk(v[6], v[7]); return __builtin_bit_cast(bf16x8, w); }
struct Raw { f32x4 k[8]; float v[2][2][8]; };
__device__ __forceinline__ void load_tile(Raw& R, const float* krow, const float* vbase, int r32, int hi, const bool extra) {
#pragma unroll
    for (int c = 0; c < 4; ++c) { R.k[2 * c] = ld4(krow + 16 * c + 8 * hi); R.k[2 * c + 1] = ld4(krow + 16 * c + 8 * hi + 4); }
    const int voff = 4 * hi * 256 + r32;
#pragma unroll
    for (int s = 0; s < 2; ++s)
#pragma unroll
        for (int jh = 0; jh < 2; ++jh) { const float* pb = extra ? vbase : vbase + (16 * s + 8 * jh) * 256;
#pragma unroll
            for (int jl = 0; jl < 4; ++jl) { R.v[s][0][4 * jh + jl] = pb[voff + jl * 256]; R.v[s][1][4 * jh + jl] = pb[voff + jl * 256 + 32]; } }
}
struct RawK { f32x4 k[8]; }; struct RawV { f32x4 r[8]; };
__device__ __forceinline__ void load_k(RawK& R, const float* krow, int hi) {
#pragma unroll
    for (int c = 0; c < 4; ++c) { R.k[2 * c] = ld4(krow + 16 * c + 8 * hi); R.k[2 * c + 1] = ld4(krow + 16 * c + 8 * hi + 4); }
}
__device__ __forceinline__ void load_v(RawV& R, const float* vbase, int lane, const bool extra) {
#pragma unroll
    for (int i = 0; i < 8; ++i) { int kv = 4 * i + (lane >> 4); if (extra) kv &= 7; R.r[i] = ld4(vbase + (size_t)kv * 256 + 4 * (lane & 15)); }
}
__device__ __forceinline__ void item(const Ctx& C, int l, int pr, int grp, int part, bf16* MIX) {
    const CAS Args& A = *C.a;
    int lane = C.lane; asm volatile("" : "+v"(lane));
    const int col = lane & 15, g = lane >> 4, bs = pr >> 2, h = pr & 3, wid = C.wave;
    const bf16* Qb = C.ws<bf16>(WS_Q); const int* pt = (const int*)A.in[I_PT] + bs * NPAGES + part * 4;
    const float* ck = A.in[I_CK] + (size_t)l * NPOOL * PAGE * 256 + h * 64; const float* cv = A.in[I_CV] + (size_t)l * NPOOL * PAGE * 256 + h * 64;
    LAS float* wsf = (LAS float*)(C.lds + 65536) + wid * 64;
    LAS float* XM = (LAS float*)(C.lds + 65536 + 2048) + wid * 32;
    LAS float* XO = (LAS float*)C.lds + wid * 1024;
    typedef short bf16x8s __attribute__((ext_vector_type(8)));
    bf16x8s qf[2];
    { const int ts = col & 7; const bf16* qrow = Qb + ((size_t)MP + bs * 8 + ts) * 256 + h * 64 + 8 * g;
      v4u w0 = *(const v4u*)(qrow), w1 = *(const v4u*)(qrow + 32); if (col >= 8) w0 = (v4u){0u, 0u, 0u, 0u}; else w1 = (v4u){0u, 0u, 0u, 0u};
      qf[0] = __builtin_bit_cast(bf16x8s, w0); qf[1] = __builtin_bit_cast(bf16x8s, w1); }
    float m = 0.f, lsum = 0.f; f32x4 O[4];
#pragma unroll
    for (int nb = 0; nb < 4; ++nb) O[nb] = (f32x4){0.f, 0.f, 0.f, 0.f};
    const int ntiles = part == 3 ? 17 : 16;
    const int pg0 = __builtin_amdgcn_readfirstlane(pt[0]), pg1 = __builtin_amdgcn_readfirstlane(pt[1]), pg2 = __builtin_amdgcn_readfirstlane(pt[2]), pg3 = __builtin_amdgcn_readfirstlane(pt[3]);
    auto page_of = [&](int tt) -> int { const int q = tt >> 2; return q == 0 ? pg0 : (q == 1 ? pg1 : (q == 2 ? pg2 : pg3)); };
    struct RK { f32x4 k[8]; }; struct RV { f32x4 r[8]; };
    auto load_k16 = [&](RK& R, int tt) { const bool ex = tt >= 16;
        const float* base = ex ? A.out + O_KS + ((size_t)l * MS + bs * 8) * 256 + h * 64 : ck + ((size_t)page_of(tt) * PAGE + ((tt * 32) & 127)) * 256;
#pragma unroll
        for (int b = 0; b < 2; ++b) { int kv = 16 * b + col; if (ex) kv &= 7; const float* p = base + (size_t)kv * 256 + 8 * g;
#pragma unroll
            for (int ks = 0; ks < 2; ++ks) { R.k[4 * b + 2 * ks] = ld4(p + 32 * ks); R.k[4 * b + 2 * ks + 1] = ld4(p + 32 * ks + 4); } } };
    auto load_v16 = [&](RV& R, int tt) { const bool ex = tt >= 16;
        const float* base = ex ? A.out + O_VS + ((size_t)l * MS + bs * 8) * 256 + h * 64 : cv + ((size_t)page_of(tt) * PAGE + ((tt * 32) & 127)) * 256;
#pragma unroll
        for (int i = 0; i < 8; ++i) { int kv = 4 * i + (lane >> 4); if (ex) kv &= 7; R.r[i] = ld4(base + (size_t)kv * 256 + 4 * (lane & 15)); } };
    RK K0, K1; RV V0, V1;
    load_k16(K0, 0); load_v16(V0, 0); load_k16(K1, 1); load_v16(V1, 1);
    LAS float* VL = (LAS float*)(C.lds + wid * 8192);
    auto step = [&](RK& KR, RV& VR, const int t) {
        f32x4 S0 = (f32x4){0.f, 0.f, 0.f, 0.f}, S1 = S0;
#pragma unroll
        for (int ks = 0; ks < 2; ++ks) { S0 = HG_MFMA(pack8(KR.k[2 * ks], KR.k[2 * ks + 1]), qf[ks], S0); S1 = HG_MFMA(pack8(KR.k[4 + 2 * ks], KR.k[4 + 2 * ks + 1]), qf[ks], S1); }
        asm volatile("" : "+v"(S0), "+v"(S1));
        if (t + 2 < ntiles) load_k16(KR, t + 2);
        if (t == 16) {
            const int ts = col & 7;
#pragma unroll
            for (int i = 0; i < 4; ++i) { if (4 * g + i > ts) S0[i] = -INFINITY; S1[i] = -INFINITY; }
        }
        float rm = __builtin_fmaxf(max3f(S0[0], S0[1], S0[2]), max3f(S0[3], S1[0], S1[1])); rm = max3f(rm, S1[2], S1[3]);
        rm = sx_max<16>(rm); rm = sx_max<32>(rm);
        if (t == 0) m = (rm == -INFINITY) ? 0.f : rm;
        else if (__any(rm - m > THR)) {
            const float mn = __builtin_fmaxf(m, rm); const float f = __builtin_amdgcn_exp2f(m - mn); m = mn; lsum *= f;
            if (g == 0) wsf[col] = f;
            LDS_WAIT();
            const f32x4 fv = *(const LAS f32x4*)(wsf + 4 * g);
#pragma unroll
            for (int nb = 0; nb < 4; ++nb) O[nb] = O[nb] * fv;
            LDS_WAIT();
        }
#pragma unroll
        for (int i = 0; i < 4; ++i) { S0[i] = __builtin_amdgcn_exp2f(S0[i] - m); S1[i] = __builtin_amdgcn_exp2f(S1[i] - m); }
        lsum += ((S0[0] + S0[1]) + (S0[2] + S0[3])) + ((S1[0] + S1[1]) + (S1[2] + S1[3]));
        const bf16x8s pa = __builtin_bit_cast(bf16x8s, (v4u){cvtpk(S0[0], S0[1]), cvtpk(S0[2], S0[3]), cvtpk(S1[0], S1[1]), cvtpk(S1[2], S1[3])});
#pragma unroll
        for (int i = 0; i < 8; ++i) *(LAS f32x4*)(VL + (4 * i + (lane >> 4)) * 64 + 4 * (lane & 15)) = VR.r[i];
        LDS_WAIT(); asm volatile("" ::: "memory");
        if (t + 2 < ntiles) load_v16(VR, t + 2);
        const LAS float* vg = VL + 4 * g * 64 + col;
#pragma unroll
        for (int nb = 0; nb < 4; ++nb) { float a[8];
#pragma unroll
            for (int j = 0; j < 8; ++j) a[j] = vg[((j & 3) + 16 * (j >> 2)) * 64 + 16 * nb];
            O[nb] = HG_MFMA(pa, pack8f(a), O[nb]); }
        asm volatile("" : "+v"(O[0]), "+v"(O[1]), "+v"(O[2]), "+v"(O[3]));
        LDS_WAIT(); asm volatile("" ::: "memory");
    };
#pragma unroll 1
    for (int t = 0; t < ntiles; t += 2) { step(K0, V0, t); if (t + 1 < ntiles) step(K1, V1, t + 1); }
    FA_WAITBAR();
    lsum = sx_sum<16>(lsum); lsum = sx_sum<32>(lsum);
    if (g == 0) { XM[col] = m; XM[16 + col] = lsum; }
#pragma unroll
    for (int nb = 0; nb < 4; ++nb)
#pragma unroll
        for (int i = 0; i < 4; ++i) XO[(4 * g + i) * 64 + 16 * nb + col] = O[nb][i];
    FA_WAITBAR();
    if (part == 0) {
        const LAS float* XMg = (const LAS float*)(C.lds + 65536 + 2048) + grp * 4 * 32; const LAS float* XOg = (const LAS float*)C.lds + grp * 4 * 1024;
        const float lam = C.ws<float>(WS_SCAL)[l]; const float lam_init = l == 0 ? 0.2f : 0.35550906759096934f;
        const float gn = A.in[I_ANG][l * 64 + lane]; const bf16* GA = C.ws<bf16>(WS_GA);
        bf16 gav[8];
#pragma unroll
        for (int ts = 0; ts < 8; ++ts) gav[ts] = GA[((size_t)MP + bs * 8 + ts) * 256 + h * 64 + lane];
        float o[16];
#pragma unroll
        for (int col = 0; col < 16; ++col) {
            const float m0 = XMg[col], m1 = XMg[32 + col], m2 = XMg[64 + col], m3 = XMg[96 + col];
            const float M = __builtin_fmaxf(__builtin_fmaxf(m0, m1), __builtin_fmaxf(m2, m3));
            const float w0 = __builtin_amdgcn_exp2f(m0 - M), w1 = __builtin_amdgcn_exp2f(m1 - M), w2 = __builtin_amdgcn_exp2f(m2 - M), w3 = __builtin_amdgcn_exp2f(m3 - M);
            const float L = XMg[16 + col] * w0 + XMg[48 + col] * w1 + XMg[80 + col] * w2 + XMg[112 + col] * w3;
            o[col] = (XOg[col * 64 + lane] * w0 + XOg[1024 + col * 64 + lane] * w1 + XOg[2048 + col * 64 + lane] * w2 + XOg[3072 + col * 64 + lane] * w3) / L;
        }
#pragma unroll
        for (int ts = 0; ts < 8; ++ts) { const float oa = o[ts] - lam * o[8 + ts]; const float ss = wave_sum(oa * oa) * (1.f / 64.f);
            const size_t mrow = (size_t)MP + bs * 8 + ts;
            MIX[mrow * DM + h * 64 + lane] = (bf16)f2bf(oa * rsqrtf(ss + EPS) * (1.f - lam_init) * gn * bf2f(gav[ts])); }
    }
    FA_WAITBAR();
}
}

__device__ __forceinline__ void attn_sample_item(const Ctx& C, int l, int item, bf16* MIXD) {
    const CAS Args& A = *C.a; const int lane = C.lane;
    const int ts = item & 7, h = (item >> 3) & 3, bs = item >> 5; const size_t m = (size_t)MP + bs * 8 + ts;
    const bf16 *Qb = C.ws<bf16>(WS_Q), *GA = C.ws<bf16>(WS_GA); bf16* MIX = C.ws<bf16>(WS_MIX);
    const int* pt = (const int*)A.in[I_PT] + bs * NPAGES;
    const float* ck = A.in[I_CK] + (size_t)l * NPOOL * PAGE * 256; const float* cv = A.in[I_CV] + (size_t)l * NPOOL * PAGE * 256;
    const float* nk = A.out + O_KS + ((size_t)l * MS + bs * 8) * 256 + h * 64; const float* nv = A.out + O_VS + ((size_t)l * MS + bs * 8) * 256 + h * 64;
    const float lam = C.ws<float>(WS_SCAL)[l]; const float lam_init = l == 0 ? 0.2f : 0.35550906759096934f;
    LAS float* scr = (LAS float*)(C.lds + 98304 + C.wave * 256);
    float mine = 0.f;
#pragma unroll 1
    for (int pass = 0; pass < 4; ++pass) {
        const int map = pass >> 1, dh = pass & 1;
        float q[32], acc[32];
        { const v4u* qp = (const v4u*)(Qb + m * 256 + h * 64 + map * 32);
#pragma unroll
            for (int i = 0; i < 4; ++i) { const v4u w = qp[i]; q[8 * i] = bflo(w.x); q[8 * i + 1] = bfhi(w.x); q[8 * i + 2] = bflo(w.y); q[8 * i + 3] = bfhi(w.y); q[8 * i + 4] = bflo(w.z); q[8 * i + 5] = bfhi(w.z); q[8 * i + 6] = bflo(w.w); q[8 * i + 7] = bfhi(w.w); } }
#pragma unroll
        for (int d = 0; d < 32; ++d) acc[d] = 0.f;
        float mx = -1e30f, lsum = 0.f;
#pragma unroll 1
        for (int kk = lane; kk < PAST + 1 + ts; kk += 64) {
            const float *kr, *vr;
            if (kk < PAST) { const int page = pt[kk >> 7]; const size_t ro = (((size_t)page * PAGE + (kk & 127)) * 4 + h) * 64; kr = ck + ro; vr = cv + ro; }
            else { kr = nk + (size_t)(kk - PAST) * 256; vr = nv + (size_t)(kk - PAST) * 256; }
            float s = 0.f;
#pragma unroll
            for (int i = 0; i < 8; ++i) { const f32x4 w = ld4(kr + map * 32 + 4 * i); s += q[4 * i] * w.x + q[4 * i + 1] * w.y + q[4 * i + 2] * w.z + q[4 * i + 3] * w.w; }
            if (s > mx) { const float sc = exp2f(mx - s); lsum *= sc;
#pragma unroll
                for (int d = 0; d < 32; ++d) acc[d] *= sc;
                mx = s; }
            const float p = exp2f(s - mx); lsum += p;
#pragma unroll
            for (int i = 0; i < 8; ++i) { const f32x4 w = ld4(vr + dh * 32 + 4 * i); acc[4 * i] += p * w.x; acc[4 * i + 1] += p * w.y; acc[4 * i + 2] += p * w.z; acc[4 * i + 3] += p * w.w; }
        }
        const float M = wave_max(mx); const float w = exp2f(mx - M); const float L = wave_sum(lsum * w); const float il = 1.f / L;
        const float coef = map == 0 ? il : -lam * il;
#pragma unroll
        for (int d = 0; d < 32; ++d) { const float r = wave_sum(acc[d] * w) * coef; if (lane == 0) scr[d] = r; }
        LDS_WAIT();
        if ((lane >> 5) == dh) mine += scr[lane & 31];
        LDS_WAIT();
    }
    const float rs = rsqrtf(wave_sum(mine * mine) * (1.f / 64.f) + EPS) * (1.f - lam_init);
    const float o = mine * rs * A.in[I_ANG][l * 64 + lane] * bf2f(GA[m * 256 + h * 64 + lane]);
    MIXD[m * DM + h * 64 + lane] = (bf16)f2bf(o);
}

__device__ __forceinline__ void ph_ln(const Ctx& C, int l) {
    const bf16* R = C.ws<bf16>(WS_R); float* Y = C.a->out; bf16* Y1 = C.ws<bf16>(WS_Y1);
    const float* g = C.a->in[I_LNG] + l * DM; const float* b = C.a->in[I_LNB] + l * DM;
#if MK_CHECK
    const float chk_se = __hip_atomic_load((float*)(C.wsb + WS_CTL) + 64, __ATOMIC_RELAXED, __HIP_MEMORY_SCOPE_AGENT), chk_sa = __hip_atomic_load((float*)(C.wsb + WS_CTL) + 65, __ATOMIC_RELAXED, __HIP_MEMORY_SCOPE_AGENT);
#if MK_CHECK == 6
    float chk_d = 0.f, chk_w = 0.f; int chk_i = 0; { const float* cw_ = (const float*)(C.wsb + WS_CTL) + 64; for (int bi = 0; bi < 14; ++bi) { if (MK_CHECK_SEL >= 0 && bi != MK_CHECK_SEL) continue; const float e_ = __hip_atomic_load(cw_ + 2 * bi, __ATOMIC_RELAXED, __HIP_MEMORY_SCOPE_AGENT), a_ = __hip_atomic_load(cw_ + 2 * bi + 1, __ATOMIC_RELAXED, __HIP_MEMORY_SCOPE_AGENT); const float er_ = sqrtf(e_ / a_); if (er_ > 0.02f) chk_d += 0.25f; if (er_ > chk_w) { chk_w = er_; chk_i = bi; } } chk_d = MK_CHECK_MODE == 0 ? ((chk_w > 0.02f) ? 20.f + 2.f * chk_i + chk_d * 0.1f : 0.f) : (MK_CHECK_MODE == 1 ? chk_d * 8.f : 10.f * chk_w);         (void)chk_se; (void)chk_sa; }
#else
    const float chk_d = 10.f * sqrtf(chk_se / chk_sa);
#endif
#endif
    f32x4 gam[4], bet[4];
#pragma unroll
    for (int j = 0; j < 4; ++j) { gam[j] = ld4(g + 4 * C.lane + 256 * j); bet[j] = ld4(b + 4 * C.lane + 256 * j); }
    f32x4 mdS[4], mdC[4]; int mdB = -1;
    auto finish = [&](f32x4 (&v)[4], int m) __attribute__((always_inline)) {
        if (l == 0 && batch_of(m) != mdB) { mdB = batch_of(m); const float* md = C.ws<float>(WS_MOD) + (size_t)(NBT + mdB) * 3072 + 4 * C.lane;
#pragma unroll
            for (int j = 0; j < 4; ++j) { mdS[j] = ld4(md + 256 * j); mdC[j] = ld4(md + 1024 + 256 * j); } }
        float s = 0.f;
#pragma unroll
        for (int j = 0; j < 4; ++j) s += (v[j].x + v[j].y) + (v[j].z + v[j].w);
        const float mean = wave_sum(s) * (1.f / DM); float s2 = 0.f;
#pragma unroll
        for (int j = 0; j < 4; ++j) { v[j] = v[j] - mean; s2 += (v[j].x * v[j].x + v[j].y * v[j].y) + (v[j].z * v[j].z + v[j].w * v[j].w); }
        const float rstd = rsqrtf(wave_sum(s2) * (1.f / DM) + EPS);
#pragma unroll
        for (int j = 0; j < 4; ++j) { const int col = 4 * C.lane + 256 * j; f32x4 yv = v[j] * rstd * gam[j] + bet[j];
#if MK_CHECK
            if (l == 1) yv.x += chk_d;
#endif
            if (l == 0) st_bf4(Y1 + (size_t)m * DM + col, yv); else st4(Y + (size_t)m * DM + col, yv);
            if (l == 0) st_bf4(C.ws<bf16>(WS_H) + (size_t)m * DM + col, yv * (1.f + mdC[j]) + mdS[j]); }
    };
    constexpr int LNB = 4;
    v2u cur[LNB][4], nxt[LNB][4];
    const int rstep = C.ngw();
#define LN_LOADB(dst, mb) do { _Pragma("unroll") for (int i_ = 0; i_ < LNB; ++i_) { const int mi_ = (mb) + i_ * rstep; if (mi_ < MP) { _Pragma("unroll") for (int j_ = 0; j_ < 4; ++j_) dst[i_][j_] = *(const v2u*)(R + (size_t)mi_ * DM + 4 * C.lane + 256 * j_); } } } while (0)
    LN_LOADB(nxt, C.gw());
    if (C.gw() + LNB * rstep < MP) { LN_LOADB(cur, C.gw() + LNB * rstep); }
#ifndef NO_SLN
    for (int m = MP + C.wave * C.G + C.bid; m < MT; m += C.ngw()) {
        const float* xr = C.a->in[I_XS] + (size_t)(m - MP) * DM; const bf16* yr = C.ws<bf16>(WS_Y1) + (size_t)m * DM;
        const float* gr = C.ws<float>(WS_MOD) + (size_t)l * NBT * 3072 + 2048 + (size_t)batch_of(m) * 3072;
        const float* pp = C.ws<float>(WS_PART) + (size_t)(m - MP) * DM;
        f32x4 v[4];
#pragma unroll
        for (int j = 0; j < 4; ++j) { const int col = 4 * C.lane + 256 * j; f32x4 a = ld4(pp + col);
#pragma unroll
            for (int ks = 1; ks < OUT_KS; ++ks) a = a + ld4(pp + (size_t)ks * MS * DM + col);
            v[j] = (l == 0 ? ld4(xr + col) : ld_bf4(yr + col)) * ALPHA + ld4(gr + col) * a; }
        finish(v, m);
    }
#endif
    {   int m = C.gw(); bool first = true;
        for (; m < MP; m += LNB * rstep) {
            v2u use[LNB][4];
#pragma unroll
            for (int i = 0; i < LNB; ++i)
#pragma unroll
                for (int j = 0; j < 4; ++j) use[i][j] = nxt[i][j];
            if (first) {
#pragma unroll
                for (int i = 0; i < LNB; ++i)
#pragma unroll
                    for (int j = 0; j < 4; ++j) nxt[i][j] = cur[i][j];
                first = false;
                if (m + 2 * LNB * rstep < MP) { LN_LOADB(cur, m + 2 * LNB * rstep); }
            } else {
#pragma unroll
                for (int i = 0; i < LNB; ++i)
#pragma unroll
                    for (int j = 0; j < 4; ++j) nxt[i][j] = cur[i][j];
                if (m + 2 * LNB * rstep < MP) { LN_LOADB(cur, m + 2 * LNB * rstep); }
            }
#pragma unroll
            for (int i = 0; i < LNB; ++i) { const int mi = m + i * rstep;
                if (mi < MP) { f32x4 v[4];
#pragma unroll
                    for (int j = 0; j < 4; ++j) v[j] = (f32x4){bflo(use[i][j].x), bfhi(use[i][j].x), bflo(use[i][j].y), bfhi(use[i][j].y)};
                    finish(v, mi); } }
        }
    }
#undef LN_LOADB
}

constexpr int NPL = 8, NPH = 2 + 2 * NPL;
#ifndef MK_ONE_LAUNCH
#define MK_ONE_LAUNCH 1
#endif
__global__ void __launch_bounds__(NTHR, 2) mk_fwd(Args args) {
    extern __shared__ __attribute__((aligned(16))) unsigned char lds[];
    Ctx C; C.a = (const CAS Args*)__builtin_amdgcn_kernarg_segment_ptr(); C.wsb = args.ws; C.lds = (LAS unsigned char*)lds; C.tid = threadIdx.x; C.lane = C.tid & 63; C.wave = __builtin_amdgcn_readfirstlane(C.tid >> 6); C.G = gridDim.x; C.bid = blockIdx.x;
    volatile LAS unsigned* MISC = (volatile LAS unsigned*)(C.lds + MISC_OFF);
    for (int u = C.tid; u < (LDS_BYTES - RING_BYTES) / 4; u += NTHR) ((LAS unsigned*)(C.lds + RING_BYTES))[u] = 0u;
    __syncthreads();
    XcdBarrier bar; bar.bar = (unsigned*)(args.ws + WS_CTL) + CW_BAR; bar.x = 0; bar.st = nullptr;
    if (MK_ONE_LAUNCH) bar = xcd_barrier_post((unsigned*)(args.ws + WS_CTL) + CW_BAR, MISC + 8);
    const int lo = args.ph_lo, hi = args.ph_hi;
#ifndef MK_MASK
#define MK_MASK 0x3ff
#endif
#define ON(j) ((MK_MASK >> (j)) & 1)
#define IN(k) (lo <= (k) && (k) < hi)
#define SEAM(k) do { if (MK_ONE_LAUNCH && IN(k) && IN((k) + 1)) { const Ctx Pb = launder(C, args); XcdBarrier bb = bar; unsigned* bp_ = (unsigned*)(Pb.wsb + WS_CTL) + CW_BAR; asm volatile("" : "+s"(bp_)); bb.bar = bp_; unsigned bx_ = bar.x; asm volatile("" : "+s"(bx_)); bb.x = bx_; xcd_barrier(bb, Pb.tid); } } while (0)

    if (ON(8) && IN(0)) { const Ctx P = launder(C, args); p0_prologue<0>(P, P.gw(), P.ngw()); } SEAM(0);
    if (ON(9) && IN(1)) {
        const Ctx P = launder(C, args);
        if (P.bid >= 24 || P.G <= 24) { const int sk = P.G > 24 ? 24 : 0; p0_prologue<1>(P, (P.bid - sk) * NWAVES + P.wave, (P.G - sk) * NWAVES); }
        pg8::Gemm g{P.ws<bf16>(WS_SC), P.ws<bf16>(WS_WADA), 256, 6144, DM}; pg8::StaticOrder S; S.init(256, 6144, P.G, P.bid);
        EpiMod E{P.ws<float>(WS_MOD), P.a->in[I_BADA]};
        pg8::gemm_phase<EpiMod, pg8::StaticOrder, PG8_ALIGN, PG8_SP2>(P.lds, g, S, E, P.tid);
    } SEAM(1);
#pragma unroll 1
    for (int l = 0; l < 2; ++l) {
        const int pb = 2 + l * NPL;
        if (l == 0) { if (ON(0) && IN(pb + 0)) { const Ctx P = launder(C, args); ph_hbuild(P, l); } SEAM(pb + 0); }
        if (ON(1) && IN(pb + 1)) {
            const Ctx P = launder(C, args);
#if MK_CHECK == 6
            {   pg8::Gemm g0{P.ws<bf16>(WS_H), P.ws<bf16>(WS_WIN) + (size_t)l * DIN * DM, MT, DIN, DM}; pg8::StaticOrder S0; S0.init(MT, DIN, P.G, P.bid);
                float* Z = P.ws<float>(WS_Z);
                auto f = [=](int row, int col, const pg8::f32x4& v) { st4(Z + (size_t)row * DIN + col, v); };
                EpiF<decltype(f)> E0{f};
                pg8::gemm_phase<EpiF<decltype(f)>, pg8::StaticOrder, PG8_ALIGN, PG8_SP2>(P.lds, g0, S0, E0, P.tid);
                xcd_barrier(bar, P.tid);
                Ctx P2 = P; P2.wsb = P.wsb + WS_ALT; ph_post_ref(P2, l);
                xcd_barrier(bar, P.tid);
            }
#endif
            pg8::Gemm g{P.ws<bf16>(WS_H), P.ws<bf16>(WS_WIN) + (size_t)l * DIN * DM, MT, DIN, DM}; pg8::StaticOrder S; S.init(MT, DIN, P.G, P.bid);
            EpiIn E{P.wsb, P.a->out, P.a->in[I_SGG] + l * 256, P.a->in[I_SGB] + l * 256, P.lds + RING_BYTES + 512, l};
            pg8::gemm_phase<EpiIn, pg8::StaticOrder, PG8_ALIGN, PG8_SP2>(P.lds, g, S, E, P.tid);
        } SEAM(pb + 1);
        if (ON(3) && IN(pb + 3)) {
            const Ctx P = launder(C, args);
            if (P.bid < 128) { hg::item<0>(P, l, P.bid * NWAVES + P.wave, nullptr);
                asm volatile("s_waitcnt vmcnt(0)" ::: "memory"); __syncthreads();
                if (P.tid == 0) { __builtin_amdgcn_fence(__ATOMIC_RELEASE, "agent"); asm volatile("s_waitcnt vmcnt(0)" ::: "memory"); __hip_atomic_fetch_add((unsigned*)(P.wsb + WS_CTL) + CW_SL + l * 64, 1u, __ATOMIC_RELAXED, __HIP_MEMORY_SCOPE_AGENT); }
                if (l == 0) p0_layer1_weights(P, P.bid * NWAVES + P.wave, 128 * NWAVES); }
            else cvm::unit(P, l, P.bid - 128, P.ws<bf16>(WS_MIX));
        }
        if (ON(4) && IN(pb + 4)) {
            const Ctx P = launder(C, args);
            bf16* fa_dst = P.ws<bf16>(WS_MIX);
            volatile LAS int* qsel = (volatile LAS int*)(P.lds + RING_BYTES + 256);
            unsigned* ctl = (unsigned*)(P.wsb + WS_CTL);
            __syncthreads();
            if (P.tid == 0) { unsigned sp = 0; while (__hip_atomic_load(ctl + CW_SL + l * 64, __ATOMIC_RELAXED, __HIP_MEMORY_SCOPE_AGENT) < 128u) { __builtin_amdgcn_s_sleep(2); if (++sp > (1u << 22)) break; }
                __builtin_amdgcn_fence(__ATOMIC_ACQUIRE, "agent"); asm volatile("s_waitcnt vmcnt(0)" ::: "memory"); }
            __syncthreads();
            for (int u = P.bid; u < 512; u += P.G) hgrn_scan_unit(P, l, u);
            asm volatile("s_waitcnt vmcnt(0)" ::: "memory"); __syncthreads();
            if (P.tid == 0) { __builtin_amdgcn_fence(__ATOMIC_RELEASE, "agent"); asm volatile("s_waitcnt vmcnt(0)" ::: "memory"); __hip_atomic_fetch_add(ctl + CW_SD + l * 64, 1u, __ATOMIC_RELAXED, __HIP_MEMORY_SCOPE_AGENT); }
            const bool sample_wg = ((P.bid >> 3) & 3) == 3;
            if (sample_wg) { const int r = (P.bid >> 5) * 8 + (P.bid & 7);
#pragma unroll 1
                for (int p = r; p < 256; p += 64) sa::item(P, l, 2 * p + (P.wave >> 2), P.wave >> 2, P.wave & 3, fa_dst); }
            {   unsigned* fq = ctl + CW_FQ + l * 8 * 64;
#pragma unroll 1
                for (;;) {
                    if (P.wave == 0) {
                        int sel = -1;
                        if (P.lane == 0) { const int xq = P.bid & 7; const unsigned idx = __hip_atomic_fetch_add(fq + xq * 64, 1u, __ATOMIC_RELAXED, __HIP_MEMORY_SCOPE_AGENT); if (idx < 64u) sel = xq * 64 + (63 - (int)idx); }
                        sel = __builtin_amdgcn_readfirstlane(sel);
                        while (sel < 0) {
                            const unsigned head = P.lane < 8 ? __hip_atomic_load(fq + ((P.bid + P.lane) & 7) * 64, __ATOMIC_RELAXED, __HIP_MEMORY_SCOPE_AGENT) : 64u;
                            const unsigned long long live = __ballot(head < 64u);
                            if (live == 0ull) break;
                            const int q = __builtin_ctzll(live), xq = (P.bid + q) & 7;
                            if (P.lane == 0) { const unsigned idx = __hip_atomic_fetch_add(fq + xq * 64, 1u, __ATOMIC_RELAXED, __HIP_MEMORY_SCOPE_AGENT); if (idx < 64u) sel = xq * 64 + (63 - (int)idx); }
                            sel = __builtin_amdgcn_readfirstlane(sel);
                        }
                        if (P.lane == 0) qsel[0] = sel; }
                    __syncthreads();
                    const int sel = qsel[0];
                    __syncthreads();
                    if (sel < 0) break;
                    fa::unit(P, l, sel >> 6, sel & 63, fa_dst);
                }
            }
            {   unsigned* gq = ctl + CW_GQ + l * 64;
#pragma unroll 1
                for (;;) {
                    if (P.tid == 0) { const unsigned idx = __hip_atomic_fetch_add(gq, 1u, __ATOMIC_RELAXED, __HIP_MEMORY_SCOPE_AGENT); qsel[0] = idx < 400u ? (int)idx : -1; }
                    __syncthreads();
                    const int u = qsel[0];
                    __syncthreads();
                    if (u < 0) break;
                    if (u < 144) cvm::unit(P, l, u + 128, fa_dst);
                    else if (u < 272) sgm::unit(P, l, u - 144, fa_dst);
                    else sg_unit(P, l, u - 272 + 128);
                }
            }
            if (P.tid == 0) { unsigned sp = 0; while (__hip_atomic_load(ctl + CW_SD + l * 64, __ATOMIC_RELAXED, __HIP_MEMORY_SCOPE_AGENT) < (unsigned)P.G) { __builtin_amdgcn_s_sleep(2); if (++sp > (1u << 22)) break; }
                __builtin_amdgcn_fence(__ATOMIC_ACQUIRE, "agent"); asm volatile("s_waitcnt vmcnt(0)" ::: "memory"); }
            __syncthreads();
            {   unsigned* hq = ctl + CW_HQ + l * 64;
#pragma unroll 1
                for (;;) {
                    if (P.tid == 0) { const unsigned idx = __hip_atomic_fetch_add(hq, 1u, __ATOMIC_RELAXED, __HIP_MEMORY_SCOPE_AGENT); qsel[0] = idx < 192u ? (int)idx : -1; }
                    __syncthreads();
                    const int u = qsel[0];
                    __syncthreads();
                    if (u < 0) break;
                    if (u < 128) hg::item<1>(P, l, u * NWAVES + P.wave, fa_dst);
                    else hg::item<2>(P, l, (u - 128) * NWAVES + P.wave, fa_dst);
                }
            }
        } SEAM(pb + 4);
        if (ON(6) && IN(pb + 6)) {
            const Ctx P = launder(C, args);
#if MK_CHECK == 8
            {
                for (int u = P.bid; u < 512; u += P.G) attn_sample_item(P, l, u * NWAVES + P.wave, P.ws<bf16>(WS_MIXCHK));
                xcd_barrier(bar, P.tid);
            }
#endif
#if MK_CHECK == 4
            {
                for (int u = P.bid; u < 1088; u += P.G) conv_unit(P, l, u, P.ws<bf16>(WS_MIXCHK));
                xcd_barrier(bar, P.tid);
            }
#endif
#if MK_CHECK == 7
            {
                for (int u = P.bid; u < 128 + 64; u += P.G) { if (u < 128) hg::item<1>(P, l, u * NWAVES + P.wave, P.ws<bf16>(WS_MIXCHK)); else hg::item<2>(P, l, (u - 128) * NWAVES + P.wave, P.ws<bf16>(WS_MIXCHK)); }
                xcd_barrier(bar, P.tid);
            }
#endif
#if MK_CHECK && MK_CHECK != 6
            {   const bf16* A0 = P.ws<bf16>(WS_MIX); const bf16* A1 = P.ws<bf16>(WS_MIXCHK); float se = 0.f, sa = 0.f;
                for (int m = P.gw(); m < MK_CHECK_ROWS; m += P.ngw()) { if (m < MK_CHECK_ROW0) continue; const f32x4 a = ld_bf4(A0 + (size_t)m * DM + MK_CHECK_COL0 + 4 * P.lane), b = ld_bf4(A1 + (size_t)m * DM + MK_CHECK_COL0 + 4 * P.lane);
#pragma unroll
                    for (int j = 0; j < 4; ++j) { const float d = a[j] - b[j]; se += d * d; sa += a[j] * a[j]; } }
                se = wave_sum(se); sa = wave_sum(sa);
                if (P.lane == 0) { atomicAdd((float*)(P.wsb + WS_CTL) + 64, se); atomicAdd((float*)(P.wsb + WS_CTL) + 65, sa); } }
#endif
            pg8::Gemm g{P.ws<bf16>(WS_MIX), P.ws<bf16>(WS_WOUT) + (size_t)l * DM * DM, MP, DM, DM}; pg8::StaticOrder S; S.init(MP, DM, P.G, P.bid);
            EpiResid E{P.a->in[I_XP], P.a->in[I_XS], P.ws<bf16>(WS_Y1), P.ws<float>(WS_MOD) + (size_t)l * NBT * 3072 + 2048, P.ws<bf16>(WS_R), l};
            pg8::gemm_phase<EpiResid, pg8::StaticOrder, PG8_ALIGN, PG8_SP2>(P.lds, g, S, E, P.tid);
#ifndef NO_PCS
#pragma unroll 1
            for (int pc = P.bid; pc < OUT_PIECES; pc += P.G) {
                const Ctx P2 = launder(C, args);
                const int ks = pc >> 4; const size_t ko = (size_t)ks * (DM / OUT_KS);
                pg8::Gemm g2{P2.ws<bf16>(WS_MIX) + ko, P2.ws<bf16>(WS_WOUT) + (size_t)l * DM * DM + ko, MT, DM, DM / OUT_KS, DM}; PieceOrder S2{pc & 15};
                EpiPart E2{P2.ws<float>(WS_PART) + (size_t)ks * MS * DM};
                pg8::gemm_phase<EpiPart, PieceOrder, PG8_ALIGN, PG8_SP2>(P2.lds, g2, S2, E2, P2.tid);
            }
#endif
        } SEAM(pb + 6);
        if (ON(7) && IN(pb + 7)) { const Ctx P = launder(C, args); ph_ln(P, l); } SEAM(pb + 7);
    }
#undef IN
#undef SEAM
}

extern "C" void kernel_launch(void* const* d_in, const int* in_sizes, int n_in, void* d_out, int out_size, void* d_ws, size_t ws_size, hipStream_t stream) {
    static int grid = 0;
    if (grid == 0) {
        if (n_in != N_IN || out_size != (int)O_END || ws_size < WS_END) { fprintf(stderr, "kernel_launch: unexpected shapes (n_in %d out %d ws %zu)\n", n_in, out_size, ws_size); grid = -1; return; }
        int dev = 0, cus = 0, per_cu = 0;
        if (hipGetDevice(&dev) != hipSuccess || hipDeviceGetAttribute(&cus, hipDeviceAttributeMultiprocessorCount, dev) != hipSuccess) { grid = -1; return; }
        if (hipFuncSetAttribute((const void*)mk_fwd, hipFuncAttributeMaxDynamicSharedMemorySize, LDS_BYTES) != hipSuccess) { fprintf(stderr, "kernel_launch: hipFuncSetAttribute failed\n"); grid = -1; return; }
        if (hipOccupancyMaxActiveBlocksPerMultiprocessor(&per_cu, (const void*)mk_fwd, NTHR, LDS_BYTES) != hipSuccess || per_cu < 1) fprintf(stderr, "kernel_launch: occupancy query says %d\n", per_cu);
        (void)hipGetLastError();
        grid = cus;
    }
    if (grid < 0) return;
    if (hipMemsetAsync((char*)d_ws + WS_CTL, 0, CTL_ZERO_BYTES, stream) != hipSuccess) return;
    Args a{};
    for (int i = 0; i < N_IN; ++i) a.in[i] = (const float*)d_in[i];
    a.out = (float*)d_out; a.ws = (unsigned char*)d_ws;
#if MK_ONE_LAUNCH
    a.ph_lo = 0; a.ph_hi = NPH;
    hipLaunchKernelGGL(mk_fwd, dim3(grid), dim3(NTHR), LDS_BYTES, stream, a);
#else
    for (int p = 0; p < NPH; ++p) { a.ph_lo = p; a.ph_hi = p + 1; hipLaunchKernelGGL(mk_fwd, dim3(grid), dim3(NTHR), LDS_BYTES, stream, a); }
#endif
}
```
